# Optimizing an MI355X kernel written in HIP

```python
import math
import jax, jax.numpy as jnp
from jax import lax
import numpy as np

D_MODEL = 1024
BATCH = 2
SEQ = 8192
DEPTH = 4

GRID_W = 64
CTX_LEN = 256
NORM_EPS = 1e-6
ROPE_BASE = 10000.0
DA_HEADS = 4
DA_HEAD_DIM = 64
DA_V_DIM = 2 * DA_HEAD_DIM
DA_WIDTH = DA_HEADS * DA_V_DIM
ATTN_BLOCK = 128
RET_HEADS = 4
RET_QK_DIM = 64
RET_V_DIM = 64
RET_WIDTH = RET_HEADS * RET_V_DIM
RET_CHUNK = 128
SG_GROUPS = 4
SG_GROUP_DIM = 64
SG_WIDTH = SG_GROUPS * SG_GROUP_DIM
SG_CHUNK = 128
MIX_WIDTH = DA_WIDTH + RET_WIDTH + SG_WIDTH
IN_SPLITS = (DA_HEADS * 2 * DA_HEAD_DIM, DA_HEADS * 2 * DA_HEAD_DIM, DA_WIDTH,
             RET_HEADS * RET_QK_DIM, RET_HEADS * RET_QK_DIM, RET_WIDTH, RET_WIDTH, RET_WIDTH,
             SG_WIDTH, SG_WIDTH)
IN_COLS = 3 * DA_WIDTH + 5 * RET_WIDTH + 2 * SG_WIDTH
N_EXPERTS = 16
EXPERT_FF = 2 * D_MODEL
EC_CAPACITY = 2

kernel_name = "hybrid_diffattn_retention_sgmlp_ec_moe_dit"


def rms_norm(x, g):
    xf = x.astype(jnp.float32)
    y = xf * lax.rsqrt(jnp.mean(xf * xf, axis=-1, keepdims=True) + NORM_EPS)
    return (y * g.astype(jnp.float32)).astype(x.dtype)


def layer_norm_f32(x):
    xf = x.astype(jnp.float32)
    mu = jnp.mean(xf, axis=-1, keepdims=True)
    var = jnp.mean(jnp.square(xf - mu), axis=-1, keepdims=True)
    return (xf - mu) * lax.rsqrt(var + NORM_EPS)


def split_cols(z):
    out, off = [], 0
    for w in IN_SPLITS:
        out.append(z[..., off:off + w])
        off += w
    return out


def split_heads(t, n_heads):
    b, n, _ = t.shape
    return t.reshape(b, n, n_heads, -1).transpose(0, 2, 1, 3)


def merge_heads(t):
    b, h, n, d = t.shape
    return t.transpose(0, 2, 1, 3).reshape(b, n, h * d)


def flip_seq(t):
    return t[:, :, ::-1]


def rotate_pairs(x, ang):
    m = ang.shape[-1]
    cos = jnp.cos(ang).astype(x.dtype)
    sin = jnp.sin(ang).astype(x.dtype)
    x1, x2 = x[..., :m], x[..., m:]
    return jnp.concatenate([x1 * cos - x2 * sin, x1 * sin + x2 * cos], axis=-1)


def axial_angles(n):
    rows = n // GRID_W
    row = jnp.broadcast_to(jnp.arange(rows, dtype=jnp.float32)[:, None], (rows, GRID_W)).reshape(-1)
    col = jnp.broadcast_to(jnp.arange(GRID_W, dtype=jnp.float32)[None, :], (rows, GRID_W)).reshape(-1)
    quarter = DA_HEAD_DIM // 4
    inv = ROPE_BASE ** (-jnp.arange(quarter, dtype=jnp.float32) / quarter)
    return row[:, None] * inv, col[:, None] * inv


def rope_2d(x, ang_r, ang_c):
    half = DA_HEAD_DIM // 2
    return jnp.concatenate([rotate_pairs(x[..., :half], ang_r), rotate_pairs(x[..., half:], ang_c)], axis=-1)


def retention_angles(n):
    inv = 1.0 / (ROPE_BASE ** jnp.linspace(0.0, 1.0, RET_QK_DIM // 2, dtype=jnp.float32))
    return jnp.arange(n, dtype=jnp.float32)[:, None] * inv


def da_split_norm(t, g):
    th = split_heads(t, DA_HEADS)
    return rms_norm(th[..., :DA_HEAD_DIM], g), rms_norm(th[..., DA_HEAD_DIM:], g)


def diff_attention(q1, q2, k1, k2, v, lam):
    scale = DA_HEAD_DIM ** -0.5
    s1 = jnp.einsum('bhqd,bhkd->bhqk', q1, k1).astype(jnp.float32) * scale
    s2 = jnp.einsum('bhqd,bhkd->bhqk', q2, k2).astype(jnp.float32) * scale
    a = jax.nn.softmax(s1, axis=-1) - lam * jax.nn.softmax(s2, axis=-1)
    return jnp.einsum('bhqk,bhkv->bhqv', a.astype(v.dtype), v)


def diff_attention_blocked(q1, q2, k1, k2, v, lam):
    b, h, n, dh = q1.shape
    nb = n // ATTN_BLOCK

    def to_blocks(q):
        return jnp.moveaxis(q.reshape(b, h, nb, ATTN_BLOCK, dh), 2, 0)

    out = lax.map(lambda qs: diff_attention(qs[0], qs[1], k1, k2, v, lam), (to_blocks(q1), to_blocks(q2)))
    return jnp.moveaxis(out, 0, 2).reshape(b, h, n, v.shape[-1])


def da_output(o, subln_g, lambda_init):
    return merge_heads(rms_norm(o, subln_g) * (1.0 - lambda_init))


def retention_chunkwise(q, k, v, log_gamma, s0):
    b, h, n, dk = q.shape
    dv = v.shape[-1]
    L = RET_CHUNK
    nc = n // L
    pos = jnp.arange(L, dtype=jnp.float32)
    lg = log_gamma.astype(jnp.float32)[:, None, None]
    dist = pos[:, None] - pos[None, :]
    intra = jnp.where(dist >= 0, jnp.exp(lg * jnp.maximum(dist, 0.0)), 0.0)
    q_decay = jnp.exp(lg[:, :, 0] * (pos + 1.0))[:, :, None]
    k_decay = jnp.exp(lg[:, :, 0] * (L - 1.0 - pos))[:, :, None]
    chunk_decay = jnp.exp(lg * L)

    def chunks(t):
        return jnp.moveaxis(t.astype(jnp.float32).reshape(b, h, nc, L, t.shape[-1]), 2, 0)

    def step(s, qkv):
        qc, kc, vc = qkv
        scores = jnp.einsum('bhid,bhjd->bhij', qc, kc) * intra
        o = jnp.einsum('bhij,bhjv->bhiv', scores, vc) + jnp.einsum('bhid,bhdv->bhiv', qc, s) * q_decay
        s = s * chunk_decay + jnp.einsum('bhjd,bhjv->bhdv', kc * k_decay, vc)
        return s, o

    s, o = lax.scan(step, s0.astype(jnp.float32), (chunks(q), chunks(k), chunks(v)))
    return jnp.moveaxis(o, 0, 2).reshape(b, h, n, dv), s


def ret_heads(rq, rk, rv, ang):
    q = split_heads(rq, RET_HEADS)
    k = split_heads(rk, RET_HEADS) * (RET_QK_DIM ** -0.5)
    v = split_heads(rv, RET_HEADS)
    if ang is not None:
        q = rotate_pairs(q, ang)
        k = rotate_pairs(k, ang)
    return q, k, v


def retention_output(o_f, o_b, g_f, g_b):
    y_f = merge_heads(layer_norm_f32(o_f)).astype(g_f.dtype) * jax.nn.silu(g_f)
    y_b = merge_heads(layer_norm_f32(o_b)).astype(g_b.dtype) * jax.nn.silu(g_b)
    return y_f + y_b


def spatial_gating(su, sv, norm_g, w_s, b_s):
    u = jax.nn.gelu(su)
    v = (layer_norm_f32(jax.nn.gelu(sv)) * norm_g.astype(jnp.float32)).astype(su.dtype)
    b, n, _ = v.shape
    vb = v.reshape(b, n // SG_CHUNK, SG_CHUNK, SG_GROUPS, SG_GROUP_DIM)
    s = jnp.einsum('gij,bcjgd->bcigd', w_s, vb) + jnp.swapaxes(b_s, 0, 1)[:, :, None]
    return u * s.reshape(b, n, SG_WIDTH)


def token_mixer(h_lat, h_ctx, w_in, w_out, q_norm_g, k_norm_g, lam, lambda_init, subln_g,
                log_gamma, sg_norm_g, sg_w, sg_b, ang_r, ang_c, ret_ang, need_ctx):
    aq, ak, av, rq, rk, rv, rgf, rgb, su, sv = split_cols(h_lat @ w_in)
    caq, cak, cav, crq, crk, crv, crgf, crgb, csu, csv = split_cols(h_ctx @ w_in)

    q1, q2 = da_split_norm(aq, q_norm_g)
    k1, k2 = da_split_norm(ak, k_norm_g)
    q1, q2, k1, k2 = (rope_2d(t, ang_r, ang_c) for t in (q1, q2, k1, k2))
    cq1, cq2 = da_split_norm(caq, q_norm_g)
    ck1, ck2 = da_split_norm(cak, k_norm_g)
    v = split_heads(av, DA_HEADS)
    cv = split_heads(cav, DA_HEADS)
    k1_all = jnp.concatenate([ck1, k1], axis=2)
    k2_all = jnp.concatenate([ck2, k2], axis=2)
    v_all = jnp.concatenate([cv, v], axis=2)
    a_lat = da_output(diff_attention_blocked(q1, q2, k1_all, k2_all, v_all, lam), subln_g, lambda_init)

    cq, ck, cvr = ret_heads(crq, crk, crv, None)
    b = h_lat.shape[0]
    zero = jnp.zeros((b, RET_HEADS, RET_QK_DIM, RET_V_DIM), jnp.float32)
    co_f, cs_f = retention_chunkwise(cq, ck, cvr, log_gamma[0], zero)
    co_b, cs_b = retention_chunkwise(flip_seq(cq), flip_seq(ck), flip_seq(cvr), log_gamma[1], zero)
    rq_h, rk_h, rv_h = ret_heads(rq, rk, rv, ret_ang)
    o_f, _ = retention_chunkwise(rq_h, rk_h, rv_h, log_gamma[0], cs_f)
    o_b, _ = retention_chunkwise(flip_seq(rq_h), flip_seq(rk_h), flip_seq(rv_h), log_gamma[1], cs_b)
    r_lat = retention_output(o_f, flip_seq(o_b), rgf, rgb)

    s_lat = spatial_gating(su, sv, sg_norm_g, sg_w, sg_b)

    y_lat = jnp.concatenate([a_lat, r_lat, s_lat], axis=-1) @ w_out
    if not need_ctx:
        return y_lat, None
    a_ctx = da_output(diff_attention(cq1, cq2, ck1, ck2, cv, lam), subln_g, lambda_init)
    r_ctx = retention_output(co_f, flip_seq(co_b), crgf, crgb)
    s_ctx = spatial_gating(csu, csv, sg_norm_g, sg_w, sg_b)
    y_ctx = jnp.concatenate([a_ctx, r_ctx, s_ctx], axis=-1) @ w_out
    return y_lat, y_ctx


def expert_choice_ffn(h, router_w, w_gate, w_up, w_down):
    b, n, d = h.shape
    cap = EC_CAPACITY * n // N_EXPERTS
    aff = jax.nn.softmax((h @ router_w).astype(jnp.float32), axis=-1)
    g, idx = lax.top_k(jnp.swapaxes(aff, 1, 2), cap)
    xs = jax.vmap(lambda hb, ib: hb[ib])(h, idx)
    a = jnp.einsum('becd,edf->becf', xs, w_gate)
    u = jnp.einsum('becd,edf->becf', xs, w_up)
    y = jnp.einsum('becf,efd->becd', jax.nn.silu(a) * u, w_down) * g[..., None].astype(h.dtype)
    return jax.vmap(lambda yb, ib: jnp.zeros((n, d), h.dtype).at[ib.reshape(-1)].add(yb.reshape(-1, d)))(y, idx)


def setup_inputs(seed: int = 0) -> dict:
    key = jax.random.key(seed)
    ks = jax.random.split(key, 26)
    D = D_MODEL

    def nrm(k, shape, scale):
        return jax.random.normal(k, shape, jnp.float32) * scale

    heads = jnp.arange(RET_HEADS, dtype=jnp.float32)
    ret_init = jnp.log(2.0 ** (5.0 + heads) - 1.0)
    return {
        'x': nrm(ks[0], (BATCH, SEQ, D), 1.0),
        'c': nrm(ks[1], (BATCH, D), 1.0),
        'ctx': nrm(ks[2], (BATCH, CTX_LEN, D), 1.0),
        'c_ctx': nrm(ks[3], (D,), 1.0),
        'w_mod': nrm(ks[4], (DEPTH, D, 6 * D), 0.5 * D ** -0.5),
        'b_mod': nrm(ks[5], (DEPTH, 6 * D), 0.02),
        'norm1_g': 1.0 + nrm(ks[6], (DEPTH, D), 0.05),
        'norm2_g': 1.0 + nrm(ks[7], (DEPTH, D), 0.05),
        'w_in': nrm(ks[8], (DEPTH, D, IN_COLS), D ** -0.5),
        'w_out': nrm(ks[9], (DEPTH, MIX_WIDTH, D), MIX_WIDTH ** -0.5),
        'da_q_norm_g': 1.0 + nrm(ks[10], (DEPTH, DA_HEAD_DIM), 0.05),
        'da_k_norm_g': 1.0 + nrm(ks[11], (DEPTH, DA_HEAD_DIM), 0.05),
        'da_lambda_q1': nrm(ks[12], (DEPTH, DA_HEAD_DIM), 0.1),
        'da_lambda_k1': nrm(ks[13], (DEPTH, DA_HEAD_DIM), 0.1),
        'da_lambda_q2': nrm(ks[14], (DEPTH, DA_HEAD_DIM), 0.1),
        'da_lambda_k2': nrm(ks[15], (DEPTH, DA_HEAD_DIM), 0.1),
        'da_subln_g': 1.0 + nrm(ks[16], (DEPTH, DA_V_DIM), 0.05),
        'ret_decay': ret_init + nrm(ks[17], (DEPTH, 2, RET_HEADS), 0.1),
        'sg_norm_g': 1.0 + nrm(ks[18], (DEPTH, SG_WIDTH), 0.05),
        'sg_w': nrm(ks[19], (DEPTH, SG_GROUPS, SG_CHUNK, SG_CHUNK), SG_CHUNK ** -0.5),
        'sg_b': 1.0 + nrm(ks[20], (DEPTH, SG_GROUPS, SG_CHUNK), 0.1),
        'router_w': nrm(ks[21], (DEPTH, D, N_EXPERTS), D ** -0.5),
        'ex_w_gate': nrm(ks[22], (DEPTH, N_EXPERTS, D, EXPERT_FF), D ** -0.5),
        'ex_w_up': nrm(ks[23], (DEPTH, N_EXPERTS, D, EXPERT_FF), D ** -0.5),
        'ex_w_down': nrm(ks[24], (DEPTH, N_EXPERTS, EXPERT_FF, D), EXPERT_FF ** -0.5),
    }


def reference(x, c, ctx, c_ctx, w_mod, b_mod, norm1_g, norm2_g, w_in, w_out, da_q_norm_g, da_k_norm_g,
              da_lambda_q1, da_lambda_k1, da_lambda_q2, da_lambda_k2, da_subln_g, ret_decay,
              sg_norm_g, sg_w, sg_b, router_w, ex_w_gate, ex_w_up, ex_w_down):
    n = x.shape[1]
    ang_r, ang_c = axial_angles(n)
    ret_ang = retention_angles(n)
    for layer in range(DEPTH):
        need_ctx = layer < DEPTH - 1
        lambda_init = 0.8 - 0.6 * math.exp(-0.3 * layer)
        mod = jax.nn.silu(c) @ w_mod[layer] + b_mod[layer]
        mod_c = jax.nn.silu(c_ctx) @ w_mod[layer] + b_mod[layer]
        sh1, sc1, g1, sh2, sc2, g2 = jnp.split(mod[:, None, :], 6, axis=-1)
        csh1, csc1, cg1, csh2, csc2, cg2 = jnp.split(mod_c, 6, axis=-1)
        lam = (jnp.exp(jnp.sum(da_lambda_q1[layer].astype(jnp.float32) * da_lambda_k1[layer].astype(jnp.float32)))
               - jnp.exp(jnp.sum(da_lambda_q2[layer].astype(jnp.float32) * da_lambda_k2[layer].astype(jnp.float32)))
               + lambda_init)
        log_gamma = jax.nn.log_sigmoid(ret_decay[layer].astype(jnp.float32))

        h_lat = rms_norm(x, norm1_g[layer]) * (1.0 + sc1) + sh1
        h_ctx = rms_norm(ctx, norm1_g[layer]) * (1.0 + csc1) + csh1
        y_lat, y_ctx = token_mixer(h_lat, h_ctx, w_in[layer], w_out[layer], da_q_norm_g[layer], da_k_norm_g[layer],
                                   lam, lambda_init, da_subln_g[layer], log_gamma, sg_norm_g[layer], sg_w[layer],
                                   sg_b[layer], ang_r, ang_c, ret_ang, need_ctx)
        x = x + g1 * y_lat
        f_lat = rms_norm(x, norm2_g[layer]) * (1.0 + sc2) + sh2
        x = x + g2 * expert_choice_ffn(f_lat, router_w[layer], ex_w_gate[layer], ex_w_up[layer], ex_w_down[layer])
        if need_ctx:
            ctx = ctx + cg1 * y_ctx
            f_ctx = rms_norm(ctx, norm2_g[layer]) * (1.0 + csc2) + csh2
            ctx = ctx + cg2 * expert_choice_ffn(f_ctx, router_w[layer], ex_w_gate[layer], ex_w_up[layer], ex_w_down[layer])
    return x
```

```cpp
#include <hip/hip_runtime.h>
#include <cstdio>
#include <cstdint>
#ifndef MK_ONE_LAUNCH
#define MK_ONE_LAUNCH 0
#endif
namespace pg8 {
#define PG8_LAS __attribute__((address_space(3)))
typedef unsigned short bf16_t;
typedef short bf16x8 __attribute__((ext_vector_type(8)));
typedef float f32x4 __attribute__((ext_vector_type(4)));
typedef unsigned u32x4 __attribute__((ext_vector_type(4)));
constexpr int BM = 256, BK = 64, HALF = 128, HTB = HALF * BK * 2  , STAGE_BYTES = 8 * HTB, NXCD = 8, WGM = 8;

__host__ __device__ __forceinline__ int lds_byte(int r, int c) { const int st = (r >> 4) * 2 + (c >> 5), rr = r & 15, cc = c & 31, ob = rr * 64 + cc * 2; return st * 1024 + (ob ^ (((ob >> 9) & 1) << 5)); }
__host__ __device__ __forceinline__ void stage_rc(int b, int& R, int& C) { const int st = b / 1024, sb = b % 1024, swz = sb ^ (((sb >> 9) & 1) << 5); R = (st >> 1) * 16 + swz / 64; C = (st & 1) * 32 + (swz % 64) / 2; }
__host__ __device__ __forceinline__ int perm32(int rho) { const int n = rho >> 4, i = rho & 15; return 8 * (i >> 2) + 4 * n + (i & 3); }

struct Unit { int pm, pn; };
struct Gemm { const bf16_t* A; const bf16_t* Bt; int M, N, K; };

struct StaticOrder {
    int nM, nN, nwg, G, c;
    __host__ __device__ void init(int M, int N, int G_, int c_) { nM = M / BM; nN = N / BM; nwg = nM * nN; G = G_; c = c_; }
    __host__ __device__ bool next(int i, Unit& u) const {
        const long L = (long)i * G + c; if (L >= nwg) return false;
        int wgid = (int)L; { const int q = nwg / NXCD, r = nwg % NXCD, xcd = wgid % NXCD, off = wgid / NXCD; wgid = (xcd < r ? xcd * (q + 1) : r * (q + 1) + (xcd - r) * q) + off; }
        const int nig = WGM * nN, gid = wgid / nig, fm = gid * WGM, gsz = (nM - fm) < WGM ? (nM - fm) : WGM;
        u.pm = fm + ((wgid % nig) % gsz); u.pn = (wgid % nig) / gsz; return true;
    }
    __device__ __forceinline__ void a_ready(const Unit&) const {}
    __device__ __forceinline__ void done(const Unit&) const {}
};

__device__ __forceinline__ unsigned cvt_pk_bf16(float lo, float hi) { unsigned r; asm volatile("v_cvt_pk_bf16_f32 %0, %1, %2" : "=v"(r) : "v"(lo), "v"(hi)); return r; }
typedef float f32x2 __attribute__((ext_vector_type(2)));
__device__ __forceinline__ f32x2 gelu_pk(f32x2 v) {
    const f32x2 av = __builtin_elementwise_abs(v), d = av * 0.2316418882f + 1.0f;
    f32x2 t; t.x = __builtin_amdgcn_rcpf(d.x); t.y = __builtin_amdgcn_rcpf(d.y);
    f32x2 q = t * 0.5307027145f + (-0.7265760135f); q = q * t + 0.7107068705f; q = q * t + (-0.142248368f); q = q * t + 0.127414796f; q = q * t;
    const f32x2 s = (v * v) * (-0.72134752044f);
    f32x2 e; e.x = __builtin_amdgcn_exp2f(s.x); e.y = __builtin_amdgcn_exp2f(s.y);
    const f32x2 m = v * (q * e), r = v - m;
    f32x2 o; o.x = v.x < 0.f ? m.x : r.x; o.y = v.y < 0.f ? m.y : r.y; return o;
}

template <int ACT  > struct EpiBf16 {
    static constexpr bool PERM = true, AFTER_DRAIN = false; static_assert(ACT == 0 || ACT == 1, "EpiBf16: ACT is 0 (none) or 1 (gelu_pk)");
    bf16_t* O; int ldc; const float* bias; int split_cols; size_t split_stride; float scale0;
    __device__ __forceinline__ void operator()(const f32x4 (&acc)[2][2][4][2], const Unit& u, int wr, int wc, int fr, int fq) const {
        const int row0 = u.pm * BM + wr * 64 + fr; int colt = u.pn * BM; bf16_t* base = O;
        float sc = 1.f; if (split_cols) { const int t = colt / split_cols; base += (size_t)t * split_stride; colt -= t * split_cols; if (t == 0) sc = scale0; }
        const int col0 = colt + wc * 32 + 8 * fq, bcol0 = u.pn * BM + wc * 32 + 8 * fq;
        f32x4 bv[2][2];
#pragma unroll
        for (int bj = 0; bj < 2; ++bj)
#pragma unroll
            for (int n = 0; n < 2; ++n) bv[bj][n] = bias ? *(const f32x4*)(bias + bcol0 + bj * HALF + 4 * n) : (f32x4){0.f, 0.f, 0.f, 0.f};
#pragma unroll
        for (int ai = 0; ai < 2; ++ai)
#pragma unroll
            for (int m = 0; m < 4; ++m) { bf16_t* rowp = base + (size_t)(row0 + ai * HALF + m * 16) * ldc + col0;
#pragma unroll
                for (int bj = 0; bj < 2; ++bj) { f32x4 v0 = acc[ai][bj][m][0] + bv[bj][0], v1 = acc[ai][bj][m][1] + bv[bj][1];
                    if (ACT == 1) { f32x2 a = gelu_pk((f32x2){v0[0], v0[1]}), b = gelu_pk((f32x2){v0[2], v0[3]}), c = gelu_pk((f32x2){v1[0], v1[1]}), d = gelu_pk((f32x2){v1[2], v1[3]});
                        v0 = (f32x4){a.x, a.y, b.x, b.y}; v1 = (f32x4){c.x, c.y, d.x, d.y}; }
                    v0 = v0 * sc; v1 = v1 * sc; u32x4 w; w.x = cvt_pk_bf16(v0[0], v0[1]); w.y = cvt_pk_bf16(v0[2], v0[3]); w.z = cvt_pk_bf16(v1[0], v1[1]); w.w = cvt_pk_bf16(v1[2], v1[3]);
                    *(u32x4*)(rowp + bj * HALF) = w; } }
    }
};
template <class Epi, class Sched, bool ALIGN_EPI = false, bool SP2 = false>
__device__ __forceinline__ void gemm_phase(PG8_LAS unsigned char* lds, const Gemm g, const Sched& S, const Epi& E) {
    int tid = threadIdx.x; asm volatile("" : "+v"(tid));
    const int wid = __builtin_amdgcn_readfirstlane(tid >> 6), lane = tid & 63, wr = wid >> 2, wc = wid & 3, fr = lane & 15, fq = lane >> 4;
    const int K = g.K, nt = K / BK;
    unsigned voffA[2], voffB[2];
#pragma unroll
    for (int i = 0; i < 2; ++i) { int R, C; stage_rc(tid * 16 + i * 8192, R, C); const int Rb = Epi::PERM ? ((R & ~31) + perm32(R & 31)) : R;
        voffA[i] = (unsigned)(R * K + C) * 2u; voffB[i] = (unsigned)(Rb * K + C) * 2u; }
    const size_t kstep = (size_t)(BK * 2);
    const size_t hstep = (size_t)HALF * K * 2;
    const size_t tstep = 2 * hstep;
    const unsigned ldsw = (unsigned)wid * 1024u;
    const int aoff = lds_byte(wr * 64 + fr, fq * 8), boff = lds_byte(wc * 32 + fr, fq * 8);
#define PG8_SA(b, h) (((b) * 2 + (h)) * HTB)
#define PG8_SB(b, h) ((4 + (b) * 2 + (h)) * HTB)
#define PG8_STAGE(bufoff, gbase, voff) do { _Pragma("unroll") for (int _i = 0; _i < 2; ++_i) \
        __builtin_amdgcn_global_load_lds((const unsigned*)((const char*)(gbase) + (voff)[_i]), (PG8_LAS unsigned*)(lds + (bufoff) + ldsw + _i * 8192), 16, 0, 0); } while (0)
#define PG8_LDA(dst, b, h) do { _Pragma("unroll") for (int m = 0; m < 4; ++m) _Pragma("unroll") for (int k = 0; k < 2; ++k) dst[m][k] = *(const PG8_LAS bf16x8*)(lds + PG8_SA(b, h) + aoff + m * 2048 + k * 1024); } while (0)
#define PG8_LDB(dst, b, h) do { _Pragma("unroll") for (int n = 0; n < 2; ++n) _Pragma("unroll") for (int k = 0; k < 2; ++k) dst[n][k] = *(const PG8_LAS bf16x8*)(lds + PG8_SB(b, h) + boff + n * 2048 + k * 1024); } while (0)
#define PG8_MMA(ai, bj, At, Bt) do { __builtin_amdgcn_s_setprio(1); _Pragma("unroll") for (int m = 0; m < 4; ++m) _Pragma("unroll") for (int n = 0; n < 2; ++n) _Pragma("unroll") for (int k = 0; k < 2; ++k) \
        acc[ai][bj][m][n] = __builtin_amdgcn_mfma_f32_16x16x32_bf16(Bt[n][k], At[m][k], acc[ai][bj][m][n], 0, 0, 0); __builtin_amdgcn_s_setprio(0); } while (0)
#define PG8_WAIT_V(n) asm volatile("s_waitcnt vmcnt(" #n ")" ::: "memory")
#define PG8_WAIT_L(n) asm volatile("s_waitcnt lgkmcnt(" #n ")" ::: "memory")
#define PG8_BAR __builtin_amdgcn_s_barrier()
#define PG8_SCHED __builtin_amdgcn_sched_barrier(0)
    Unit cur, nxt; int ui = 0;
    if (!S.next(0, cur)) return;
    f32x4 acc[2][2][4][2];
#pragma unroll
    for (int a = 0; a < 2; ++a)
#pragma unroll
        for (int b = 0; b < 2; ++b)
#pragma unroll
            for (int m = 0; m < 4; ++m)
#pragma unroll
                for (int n = 0; n < 2; ++n) acc[a][b][m][n] = (f32x4){0.f, 0.f, 0.f, 0.f};
    bf16x8 At[4][2], B0[2][2], B1[2][2];
    const char* cA = (const char*)g.A + (size_t)cur.pm * tstep; const char* cB = (const char*)g.Bt + (size_t)cur.pn * tstep;
    S.a_ready(cur);
    if constexpr (SP2) {
        PG8_STAGE(PG8_SB(0, 0), cB, voffB); PG8_STAGE(PG8_SB(0, 1), cB + hstep, voffB); PG8_STAGE(PG8_SA(0, 0), cA, voffA); PG8_STAGE(PG8_SA(0, 1), cA + hstep, voffA);
        if (wr == 1) PG8_BAR;
        PG8_WAIT_V(2); PG8_BAR;
        PG8_STAGE(PG8_SB(1, 0), cB + kstep, voffB); PG8_STAGE(PG8_SA(1, 0), cA + kstep, voffA); PG8_STAGE(PG8_SB(1, 1), cB + hstep + kstep, voffB);
        PG8_WAIT_V(6); PG8_BAR;
    } else {
        PG8_STAGE(PG8_SB(0, 0), cB, voffB); PG8_STAGE(PG8_SA(0, 0), cA, voffA); PG8_STAGE(PG8_SB(0, 1), cB + hstep, voffB); PG8_STAGE(PG8_SA(0, 1), cA + hstep, voffA);
        if (wr == 1) PG8_BAR;
        PG8_WAIT_V(4); PG8_BAR;
        PG8_STAGE(PG8_SB(1, 0), cB + kstep, voffB); PG8_STAGE(PG8_SA(1, 0), cA + kstep, voffA); PG8_STAGE(PG8_SB(1, 1), cB + hstep + kstep, voffB);
        PG8_WAIT_V(6); PG8_BAR;
    }
    for (;;) {
        const bool has_next = S.next(ui + 1, nxt);
        const char* nA = has_next ? (const char*)g.A + (size_t)nxt.pm * tstep : cA; const char* nB = has_next ? (const char*)g.Bt + (size_t)nxt.pn * tstep : cB;
        for (int t = 0; t < nt; t += 2) {
            const bool last = (t == nt - 2);
            const char* a1 = cA + (size_t)(t + 1) * kstep;
            const char* a2 = last ? nA : cA + (size_t)(t + 2) * kstep; const char* b2 = last ? nB : cB + (size_t)(t + 2) * kstep;
            const char* a3 = a2 + kstep; const char* b3 = b2 + kstep;
            if (last && has_next) S.a_ready(nxt);
            if constexpr (SP2) {
            PG8_LDB(B0, 0, 0); PG8_LDB(B1, 0, 1); PG8_SCHED; PG8_LDA(At, 0, 0); PG8_STAGE(PG8_SA(1, 1), a1 + hstep, voffA);
            PG8_WAIT_V(8); PG8_WAIT_L(0); PG8_BAR; PG8_MMA(0, 0, At, B0); PG8_MMA(0, 1, At, B1); PG8_BAR; PG8_SCHED;
            PG8_LDA(At, 0, 1); PG8_STAGE(PG8_SB(0, 0), b2, voffB); PG8_STAGE(PG8_SB(0, 1), b2 + hstep, voffB); PG8_STAGE(PG8_SA(0, 0), a2, voffA);
            PG8_WAIT_V(8); PG8_WAIT_L(0); PG8_BAR; PG8_MMA(1, 0, At, B0); PG8_MMA(1, 1, At, B1); PG8_BAR; PG8_SCHED;
            PG8_LDB(B0, 1, 0); PG8_LDB(B1, 1, 1); PG8_SCHED; PG8_LDA(At, 1, 0); PG8_STAGE(PG8_SA(0, 1), a2 + hstep, voffA);
            PG8_WAIT_V(8); PG8_WAIT_L(0); PG8_BAR; PG8_MMA(0, 0, At, B0); PG8_MMA(0, 1, At, B1); PG8_BAR; PG8_SCHED;
            PG8_LDA(At, 1, 1); PG8_STAGE(PG8_SB(1, 0), b3, voffB); PG8_STAGE(PG8_SB(1, 1), b3 + hstep, voffB); PG8_STAGE(PG8_SA(1, 0), a3, voffA);
            PG8_WAIT_V(8); PG8_WAIT_L(0); PG8_BAR; PG8_MMA(1, 0, At, B0); PG8_MMA(1, 1, At, B1); PG8_BAR; PG8_SCHED;
            } else {
            PG8_LDB(B0, 0, 0); PG8_SCHED; PG8_LDA(At, 0, 0); PG8_STAGE(PG8_SA(1, 1), a1 + hstep, voffA);
            PG8_WAIT_L(8); PG8_BAR; PG8_WAIT_L(0); PG8_MMA(0, 0, At, B0); PG8_BAR; PG8_SCHED;
            PG8_LDB(B1, 0, 1); PG8_STAGE(PG8_SB(0, 0), b2, voffB);
            PG8_BAR; PG8_WAIT_L(0); PG8_MMA(0, 1, At, B1); PG8_BAR;
            PG8_LDA(At, 0, 1); PG8_STAGE(PG8_SA(0, 0), a2, voffA);
            PG8_BAR; PG8_WAIT_L(0); PG8_MMA(1, 0, At, B0); PG8_BAR; PG8_SCHED;
            PG8_STAGE(PG8_SB(0, 1), b2 + hstep, voffB);
            PG8_WAIT_V(6); PG8_BAR; PG8_MMA(1, 1, At, B1); PG8_BAR;
            PG8_LDB(B0, 1, 0); PG8_SCHED; PG8_LDA(At, 1, 0); PG8_STAGE(PG8_SA(0, 1), a2 + hstep, voffA);
            PG8_WAIT_L(8); PG8_BAR; PG8_WAIT_L(0); PG8_MMA(0, 0, At, B0); PG8_BAR; PG8_SCHED;
            PG8_LDB(B1, 1, 1); PG8_STAGE(PG8_SB(1, 0), b3, voffB);
            PG8_BAR; PG8_WAIT_L(0); PG8_MMA(0, 1, At, B1); PG8_BAR;
            PG8_LDA(At, 1, 1); PG8_STAGE(PG8_SA(1, 0), a3, voffA);
            PG8_BAR; PG8_WAIT_L(0); PG8_MMA(1, 0, At, B0); PG8_BAR; PG8_SCHED;
            PG8_STAGE(PG8_SB(1, 1), b3 + hstep, voffB);
            PG8_WAIT_V(6); PG8_BAR; PG8_MMA(1, 1, At, B1); PG8_BAR;
            }
        }
        if constexpr (ALIGN_EPI) { if (wr == 0) PG8_BAR; }
        if constexpr (!Epi::AFTER_DRAIN) { E(acc, cur, wr, wc, fr, fq); S.done(cur); }
        if (!has_next) break;
#pragma unroll
        for (int a = 0; a < 2; ++a)
#pragma unroll
            for (int b = 0; b < 2; ++b)
#pragma unroll
                for (int m = 0; m < 4; ++m)
#pragma unroll
                    for (int n = 0; n < 2; ++n) acc[a][b][m][n] = (f32x4){0.f, 0.f, 0.f, 0.f};
        cur = nxt; cA = nA; cB = nB; ++ui;
        if constexpr (ALIGN_EPI) { if (wr == 1) PG8_BAR; }
    }
    PG8_WAIT_V(0);
    if constexpr (!ALIGN_EPI) { if (wr == 0) PG8_BAR; }
    PG8_BAR;
    if constexpr (Epi::AFTER_DRAIN) { E.fused(acc, cur, wr, wc, fr, fq, lds, wid, lane); S.done(cur); }
#undef PG8_SA
#undef PG8_SB
#undef PG8_STAGE
#undef PG8_LDA
#undef PG8_LDB
#undef PG8_MMA
#undef PG8_WAIT_V
#undef PG8_WAIT_L
#undef PG8_BAR
#undef PG8_SCHED
}
}

constexpr int DM = 1024, NB = 2, SEQ = 8192, CTXL = 256, DEPTH = 4;
constexpr int NLAT = NB * SEQ, NCTX = NB * CTXL, NROW = NLAT + NCTX;
constexpr int INC = 3328, NKEY = CTXL + SEQ;
constexpr int NE = 16, FF = 2048, EROWS = 2304;
constexpr int NCH = 66;
constexpr float EPS = 1e-6f;
constexpr int ZQ = 0, ZK = 512, ZV = 1024, ZRQ = 1536, ZRK = 1792, ZRV = 2048, ZGF = 2304, ZGB = 2560, ZSU = 2816, ZSV = 3072;
constexpr int NWAVES = 8, NTHR = 512;

constexpr size_t MiB = 1u << 20;
constexpr size_t WS_CTL = 0, CTL_ZERO_BYTES = 1 * MiB;
constexpr size_t WS_MOD = 1 * MiB;
constexpr size_t WS_LP = WS_MOD + 512 * 1024;
constexpr size_t WS_ROPE = 2 * MiB, WS_RETT = 4 * MiB;
constexpr size_t WS_SGW = 6 * MiB;
constexpr size_t WS_WIN = 8 * MiB;
constexpr size_t WS_WOUT = WS_WIN + 26 * MiB;
constexpr size_t WS_WGU = WS_WOUT + 8 * MiB;
constexpr size_t WS_WD = WS_WGU + 512 * MiB;
constexpr size_t WS_X = WS_WD + 256 * MiB;
constexpr size_t WS_HN = WS_X + 66 * MiB;
constexpr size_t WS_Z = WS_HN + 33 * MiB;
constexpr size_t WS_QH = WS_Z + 108 * MiB;
constexpr size_t WS_KH = WS_QH + 17 * MiB;
constexpr size_t WS_VH = WS_KH + 17 * MiB;
constexpr size_t WS_RQ = WS_VH + 17 * MiB;
constexpr size_t WS_RK = WS_RQ + 9 * MiB;
constexpr size_t WS_SVN = WS_RK + 9 * MiB;
constexpr size_t WS_KVT = WS_SVN + 9 * MiB;
constexpr size_t WS_SPREV = WS_KVT + 17 * MiB;
constexpr size_t WS_MIX = WS_SPREV + 17 * MiB;
constexpr size_t WS_SCR = WS_MIX + 33 * MiB;
constexpr size_t WS_AFF = WS_SCR + 32 * MiB;
constexpr size_t WS_SLOT = WS_AFF + 2 * MiB;
constexpr size_t WS_ROWIDX = WS_SLOT + 2 * MiB;
constexpr size_t WS_GATE = WS_ROWIDX + 1 * MiB;
constexpr size_t WS_XS = WS_GATE + 1 * MiB;
constexpr size_t WS_HH = WS_XS + 72 * MiB;
constexpr size_t WS_Y = WS_HH + 144 * MiB;
constexpr size_t WS_END = WS_Y + 72 * MiB;
static_assert((size_t)4 * INC * DM * 2 <= 26 * MiB && (size_t)NROW * DM * 4 <= 66 * MiB && (size_t)NROW * INC * 2 <= 108 * MiB && (size_t)NROW * 512 * 2 <= 17 * MiB, "ws map");
static_assert((size_t)NB * 4 * 2 * NCH * 4096 * 4 <= 17 * MiB && (size_t)NE * EROWS * DM * 2 <= 72 * MiB && (size_t)NE * EROWS * FF * 2 <= 144 * MiB, "ws map");
constexpr int CW_BAR = 4096;

constexpr int RING_BYTES = 131072;
constexpr int MISC_OFF = RING_BYTES + 320;
constexpr int LDS_BYTES = 147456;

#define GAS __attribute__((address_space(1)))
#define LAS __attribute__((address_space(3)))
typedef unsigned short bf16;
typedef unsigned v4u __attribute__((ext_vector_type(4)));
typedef float f32x4 __attribute__((ext_vector_type(4)));
typedef short bf16x8 __attribute__((ext_vector_type(8)));
typedef GAS unsigned gu32;
typedef GAS unsigned long long gu64;
#define RLX_AGENT __ATOMIC_RELAXED, __HIP_MEMORY_SCOPE_AGENT
#define LDS_WAIT() asm volatile("s_waitcnt lgkmcnt(0)" ::: "memory")
#define VM_WAIT() asm volatile("s_waitcnt vmcnt(0)" ::: "memory")
__device__ __forceinline__ unsigned long long rt() { return __builtin_amdgcn_s_memrealtime(); }
__device__ __forceinline__ unsigned f2bf(float f) { unsigned u = __builtin_bit_cast(unsigned, f); return (u + 0x7fffu + ((u >> 16) & 1u)) >> 16; }
__device__ __forceinline__ unsigned pk2(float lo, float hi) { return f2bf(lo) | (f2bf(hi) << 16); }

#define XB_TMO      128
#define XB_XCNT(j)  (256  + 64 * (j))
#define XB_XSUB(j)  (1280 + 64 * (j))
#define XB_XGEN(j)  (2304 + 64 * (j))
#define XB_TOP      3328
#define XB_TOPGEN   3392
#define XCD_BAR_WORDS 3456
#define XB_SPIN_CAP (1u << 18)

__device__ __forceinline__ unsigned xb_ld(unsigned* p)              { return __hip_atomic_load(p, __ATOMIC_RELAXED, __HIP_MEMORY_SCOPE_AGENT); }
__device__ __forceinline__ unsigned xb_add(unsigned* p, unsigned v) { return __hip_atomic_fetch_add(p, v, __ATOMIC_RELAXED, __HIP_MEMORY_SCOPE_AGENT); }
__device__ __forceinline__ unsigned xb_xcc_id() { return (unsigned)__builtin_amdgcn_s_getreg((3 << 11) | 20) & 0xFu; }
#define XB_SPIN(cond, bar) do { unsigned _sp = 0; while (cond) { __builtin_amdgcn_s_sleep(1); \
    if ((++_sp & 255u) == 0u) { if (xb_ld(&(bar)[XB_TMO])) break; if (_sp > XB_SPIN_CAP) { atomicAdd(&(bar)[XB_TMO], 1u); break; } } } } while (0)

struct XcdBarrier {
    unsigned* bar; unsigned x;
    volatile LAS unsigned* st;
};

__device__ __forceinline__ XcdBarrier xcd_barrier_post(unsigned* bar, volatile LAS unsigned* st) {
    XcdBarrier b; b.bar = bar; b.x = xb_xcc_id(); b.st = st;
    if (threadIdx.x == 0) (void)xb_add(&bar[XB_XCNT(b.x)], 1u);
    return b;
}
__device__ __forceinline__ void xcd_barrier_complete(unsigned* bar, unsigned x, unsigned& nloc, unsigned& nx) {
    const unsigned G = gridDim.x * gridDim.y * gridDim.z;
    unsigned sum, cnt, mine, sp = 0u;
    for (;;) {
        sum = 0u; cnt = 0u; mine = 0u;
#pragma unroll
        for (unsigned j = 0; j < 16; ++j) { const unsigned c = xb_ld(&bar[XB_XCNT(j)]); sum += c; cnt += (c > 0u) ? 1u : 0u; mine = (j == x) ? c : mine; }
        if (sum == G) break;
        __builtin_amdgcn_s_sleep(1);
        if ((++sp & 255u) == 0u) { if (xb_ld(&bar[XB_TMO])) break; if (sp > XB_SPIN_CAP) { atomicAdd(&bar[XB_TMO], 1u); break; } }
    }
    nloc = mine > 0u ? mine : 1u; nx = cnt > 0u ? cnt : 1u;
}

__device__ __forceinline__ void xcd_barrier(const XcdBarrier& b) {
    asm volatile("s_waitcnt vmcnt(0)" ::: "memory");
    __syncthreads();
    if (threadIdx.x == 0) {
        unsigned* bar = b.bar;
        __builtin_amdgcn_s_waitcnt(0);
        unsigned nloc = b.st[0], nx = b.st[1];
        if (nloc == 0u) { xcd_barrier_complete(bar, b.x, nloc, nx); b.st[0] = nloc; b.st[1] = nx; }
        const unsigned old = xb_add(&bar[XB_XSUB(b.x)], 1u);
        const unsigned gen = old / nloc;
        if (old + 1u == (gen + 1u) * nloc) {
            __builtin_amdgcn_fence(__ATOMIC_RELEASE, "agent");
            asm volatile("s_waitcnt vmcnt(0)" ::: "memory");
            const unsigned og = xb_add(&bar[XB_TOP], 1u);
            const unsigned tg = og / nx;
            if (og + 1u == (tg + 1u) * nx) xb_add(&bar[XB_TOPGEN], 1u);
            else XB_SPIN(xb_ld(&bar[XB_TOPGEN]) == tg, bar);
            __builtin_amdgcn_fence(__ATOMIC_ACQUIRE, "agent");
            xb_add(&bar[XB_XGEN(b.x)], 1u);
            asm volatile("s_waitcnt vmcnt(0)" ::: "memory");
        } else {
            XB_SPIN(xb_ld(&bar[XB_XGEN(b.x)]) == gen, bar);
            __builtin_amdgcn_fence(__ATOMIC_ACQUIRE, "agent");
            asm volatile("s_waitcnt vmcnt(0)" ::: "memory");
        }
    }
    __syncthreads();
}

typedef float f32x16 __attribute__((ext_vector_type(16)));
typedef short s16x4 __attribute__((ext_vector_type(4)));
typedef unsigned short u16x4 __attribute__((ext_vector_type(4)));
struct Frame {
    LAS unsigned char* lds;
    int tid, lane, wave, bid, G;
    const float* const* in;
    float* out;
    unsigned char* ws;
    __device__ __forceinline__ const float* x_in() const { return in[0]; }
    __device__ __forceinline__ const float* c_in() const { return in[1]; }
    __device__ __forceinline__ const float* ctx_in() const { return in[2]; }
    __device__ __forceinline__ const float* cctx_in() const { return in[3]; }
    __device__ __forceinline__ const float* w_mod() const { return in[4]; }
    __device__ __forceinline__ const float* b_mod() const { return in[5]; }
    __device__ __forceinline__ const float* n1g() const { return in[6]; }
    __device__ __forceinline__ const float* n2g() const { return in[7]; }
    __device__ __forceinline__ const float* w_in() const { return in[8]; }
    __device__ __forceinline__ const float* w_out() const { return in[9]; }
    __device__ __forceinline__ const float* qng() const { return in[10]; }
    __device__ __forceinline__ const float* kng() const { return in[11]; }
    __device__ __forceinline__ const float* lq1() const { return in[12]; }
    __device__ __forceinline__ const float* lk1() const { return in[13]; }
    __device__ __forceinline__ const float* lq2() const { return in[14]; }
    __device__ __forceinline__ const float* lk2() const { return in[15]; }
    __device__ __forceinline__ const float* subg() const { return in[16]; }
    __device__ __forceinline__ const float* retd() const { return in[17]; }
    __device__ __forceinline__ const float* sgng() const { return in[18]; }
    __device__ __forceinline__ const float* sgw() const { return in[19]; }
    __device__ __forceinline__ const float* sgb() const { return in[20]; }
    __device__ __forceinline__ const float* rw() const { return in[21]; }
    __device__ __forceinline__ const float* wg() const { return in[22]; }
    __device__ __forceinline__ const float* wu() const { return in[23]; }
    __device__ __forceinline__ const float* wd() const { return in[24]; }
    __device__ __forceinline__ float* MOD() const { return (float*)(ws + WS_MOD); }
    __device__ __forceinline__ float* LP() const { return (float*)(ws + WS_LP); }
    __device__ __forceinline__ float* ROPE() const { return (float*)(ws + WS_ROPE); }
    __device__ __forceinline__ float* RETT() const { return (float*)(ws + WS_RETT); }
    __device__ __forceinline__ float* X() const { return (float*)(ws + WS_X); }
    __device__ __forceinline__ float* KVT() const { return (float*)(ws + WS_KVT); }
    __device__ __forceinline__ float* SPREV() const { return (float*)(ws + WS_SPREV); }
    __device__ __forceinline__ float* SCR() const { return (float*)(ws + WS_SCR); }
    __device__ __forceinline__ float* AFF() const { return (float*)(ws + WS_AFF); }
    __device__ __forceinline__ float* GATE() const { return (float*)(ws + WS_GATE); }
    __device__ __forceinline__ bf16* SGW() const { return (bf16*)(ws + WS_SGW); }
    __device__ __forceinline__ bf16* WIN() const { return (bf16*)(ws + WS_WIN); }
    __device__ __forceinline__ bf16* WOUT() const { return (bf16*)(ws + WS_WOUT); }
    __device__ __forceinline__ bf16* WGU() const { return (bf16*)(ws + WS_WGU); }
    __device__ __forceinline__ bf16* WD() const { return (bf16*)(ws + WS_WD); }
    __device__ __forceinline__ bf16* HN() const { return (bf16*)(ws + WS_HN); }
    __device__ __forceinline__ bf16* Z() const { return (bf16*)(ws + WS_Z); }
    __device__ __forceinline__ bf16* QH() const { return (bf16*)(ws + WS_QH); }
    __device__ __forceinline__ bf16* KH() const { return (bf16*)(ws + WS_KH); }
    __device__ __forceinline__ bf16* VH() const { return (bf16*)(ws + WS_VH); }
    __device__ __forceinline__ bf16* RQ() const { return (bf16*)(ws + WS_RQ); }
    __device__ __forceinline__ bf16* RK() const { return (bf16*)(ws + WS_RK); }
    __device__ __forceinline__ bf16* SVN() const { return (bf16*)(ws + WS_SVN); }
    __device__ __forceinline__ bf16* MIX() const { return (bf16*)(ws + WS_MIX); }
    __device__ __forceinline__ bf16* XS() const { return (bf16*)(ws + WS_XS); }
    __device__ __forceinline__ bf16* HH() const { return (bf16*)(ws + WS_HH); }
    __device__ __forceinline__ bf16* Y() const { return (bf16*)(ws + WS_Y); }
    __device__ __forceinline__ int* SLOT() const { return (int*)(ws + WS_SLOT); }
    __device__ __forceinline__ int* ROWIDX() const { return (int*)(ws + WS_ROWIDX); }
};
__device__ __forceinline__ float bf2f(bf16 v) { return __builtin_bit_cast(float, (unsigned)v << 16); }
__device__ __forceinline__ float wave_sum(float v) {
#pragma unroll
    for (int o = 1; o < 64; o <<= 1) v += __shfl_xor(v, o);
    return v;
}
__device__ __forceinline__ float half_sum32(float v) {
#pragma unroll
    for (int o = 1; o < 32; o <<= 1) v += __shfl_xor(v, o);
    return v;
}
__device__ __forceinline__ float wave_max(float v) {
#pragma unroll
    for (int o = 1; o < 64; o <<= 1) v = fmaxf(v, __shfl_xor(v, o));
    return v;
}
__device__ __forceinline__ int crow(int r, int hi) { return (r & 3) + 8 * (r >> 2) + 4 * hi; }
__device__ __forceinline__ float gelu_t(float x) {
    const float u = 0.7978845608028654f * (x + 0.044715f * x * x * x);
    const float t = 1.f - 2.f / (1.f + __expf(2.f * u));
    return 0.5f * x * (1.f + t);
}
__device__ __forceinline__ float silu_f(float x) { return x / (1.f + __expf(-x)); }
__device__ __forceinline__ int row_vec(int r) { return r < SEQ ? 0 : (r < NLAT ? 1 : 2); }
__device__ __forceinline__ int chunk_row0(int b, int cc) { return cc < 2 ? NLAT + b * CTXL + cc * 128 : b * SEQ + (cc - 2) * 128; }

__device__ __forceinline__ f32x16 mma_nt(const LAS bf16* A, int lda, const LAS bf16* B, int ldb, int K, f32x16 acc, int lane) {
    const int r = lane & 31, h = lane >> 5;
#pragma unroll 2
    for (int k0 = 0; k0 < K; k0 += 16) {
        const bf16x8 a = *(const LAS bf16x8*)(A + r * lda + k0 + 8 * h);
        const bf16x8 b = *(const LAS bf16x8*)(B + r * ldb + k0 + 8 * h);
        acc = __builtin_amdgcn_mfma_f32_32x32x16_bf16(a, b, acc, 0, 0, 0);
    }
    return acc;
}

struct EpiResid {
    static constexpr bool PERM = true, AFTER_DRAIN = false;
    float* X; const float* modg;
    __device__ __forceinline__ void operator()(const pg8::f32x4 (&acc)[2][2][4][2], const pg8::Unit& u, int wr, int wc, int fr, int fq) const {
        const int row0 = u.pm * 256 + wr * 64 + fr, col0 = u.pn * 256 + wc * 32 + 8 * fq;
        const int v = u.pm < 32 ? 0 : (u.pm < 64 ? 1 : 2);
        pg8::f32x4 gv[2][2];
#pragma unroll
        for (int bj = 0; bj < 2; ++bj)
#pragma unroll
            for (int n = 0; n < 2; ++n) gv[bj][n] = *(const pg8::f32x4*)(modg + v * 6144 + col0 + bj * 128 + 4 * n);
#pragma unroll
        for (int ai = 0; ai < 2; ++ai)
#pragma unroll
            for (int m = 0; m < 4; ++m) { float* rowp = X + (size_t)(row0 + ai * 128 + m * 16) * DM + col0;
#pragma unroll
                for (int bj = 0; bj < 2; ++bj)
#pragma unroll
                    for (int n = 0; n < 2; ++n) { pg8::f32x4* p = (pg8::f32x4*)(rowp + bj * 128 + 4 * n); pg8::f32x4 xv = *p; xv = xv + gv[bj][n] * acc[ai][bj][m][n]; *p = xv; } }
    }
};
struct EpiSwiglu {
    static constexpr bool PERM = true, AFTER_DRAIN = false;
    bf16* H;
    __device__ __forceinline__ void operator()(const pg8::f32x4 (&acc)[2][2][4][2], const pg8::Unit& u, int wr, int wc, int fr, int fq) const {
        const int row0 = u.pm * 256 + wr * 64 + fr, col0 = (u.pn & 15) * 128 + wc * 32 + 8 * fq;
#pragma unroll
        for (int ai = 0; ai < 2; ++ai)
#pragma unroll
            for (int m = 0; m < 4; ++m) { bf16* rowp = H + (size_t)(row0 + ai * 128 + m * 16) * FF + col0;
                float h[8];
#pragma unroll
                for (int n = 0; n < 2; ++n)
#pragma unroll
                    for (int i = 0; i < 4; ++i) { const float g = acc[ai][0][m][n][i], up = acc[ai][1][m][n][i]; h[4 * n + i] = silu_f(g) * up; }
                pg8::u32x4 w; w.x = pg8::cvt_pk_bf16(h[0], h[1]); w.y = pg8::cvt_pk_bf16(h[2], h[3]); w.z = pg8::cvt_pk_bf16(h[4], h[5]); w.w = pg8::cvt_pk_bf16(h[6], h[7]);
                *(pg8::u32x4*)rowp = w; }
    }
};
struct MoeOrder {
    int G, c, npn, total;
    __device__ __forceinline__ bool next(int i, pg8::Unit& u) const {
        const long L = (long)i * G + c; if (L >= total) return false;
        const int per = 9 * npn, e = (int)L / per, rem = (int)L % per; const int pn = rem / 9, pm = rem % 9;
        u.pm = e * 9 + pm; u.pn = e * npn + pn; return true;
    }
    __device__ __forceinline__ void a_ready(const pg8::Unit&) const {}
    __device__ __forceinline__ void done(const pg8::Unit&) const {}
};

__device__ __forceinline__ void transpose_item(const float* W, int N, bf16* WT, int K, int k0, int n0, size_t drow0, LAS float* scr, int lane) {
#pragma unroll 8
    for (int i = 0; i < 32; ++i) { const int kk = 2 * i + (lane >> 5); scr[kk * 33 + (lane & 31)] = W[(size_t)(k0 + kk) * N + n0 + (lane & 31)]; }
    LDS_WAIT(); asm volatile("" ::: "memory");
    const int c = lane & 7;
#pragma unroll
    for (int j = 0; j < 4; ++j) { const int n = (lane >> 3) + 8 * j; const LAS float* s = scr + (8 * c) * 33 + n;
        v4u o; o.x = pk2(s[0 * 33], s[1 * 33]); o.y = pk2(s[2 * 33], s[3 * 33]); o.z = pk2(s[4 * 33], s[5 * 33]); o.w = pk2(s[6 * 33], s[7 * 33]);
        *(GAS v4u*)(WT + (drow0 + n) * K + k0 + 8 * c) = o; }
    LDS_WAIT(); asm volatile("" ::: "memory");
}
__device__ __forceinline__ void ph_prologue(const Frame& F) {
    const int tid = F.tid, lane = F.lane, wave = F.wave;
    LAS float* sc = (LAS float*)F.lds;
    LAS float* red = sc + 3072;
    for (int i = tid; i < 3072; i += NTHR) { const int v = i >> 10, k = i & 1023; const float c = v < 2 ? F.c_in()[v * DM + k] : F.cctx_in()[k]; sc[i] = c / (1.f + expf(-c)); }
    __syncthreads();
    for (int t = F.bid; t < 384; t += F.G) {
        const int L = t / 96, j0 = (t % 96) * 64;
        const float* W = F.w_mod() + (size_t)L * DM * 6144 + j0 + lane;
        float a0 = 0.f, a1 = 0.f, a2 = 0.f;
#pragma unroll 8
        for (int kk = 0; kk < 128; ++kk) { const int k = wave * 128 + kk; const float w = W[(size_t)k * 6144]; a0 += sc[k] * w; a1 += sc[1024 + k] * w; a2 += sc[2048 + k] * w; }
        red[(wave * 3 + 0) * 64 + lane] = a0; red[(wave * 3 + 1) * 64 + lane] = a1; red[(wave * 3 + 2) * 64 + lane] = a2;
        __syncthreads();
        if (tid < 192) { const int v = tid >> 6, l = tid & 63; float s = 0.f;
#pragma unroll
            for (int w = 0; w < 8; ++w) s += red[(w * 3 + v) * 64 + l];
            F.MOD()[(size_t)(L * 3 + v) * 6144 + j0 + l] = s + F.b_mod()[L * 6144 + j0 + l]; }
        __syncthreads();
    }
    if (F.bid == 0 && wave == 0) {
        for (int L = 0; L < DEPTH; ++L) {
            const float d1 = wave_sum(F.lq1()[L * 64 + lane] * F.lk1()[L * 64 + lane]), d2 = wave_sum(F.lq2()[L * 64 + lane] * F.lk2()[L * 64 + lane]);
            const float linit = 0.8f - 0.6f * expf(-0.3f * (float)L);
            if (lane == 0) { F.LP()[L * 16 + 0] = expf(d1) - expf(d2) + linit; F.LP()[L * 16 + 1] = 1.f - linit; }
            if (lane < 8) { const float xd = F.retd()[L * 8 + lane]; F.LP()[L * 16 + 2 + lane] = -log1pf(expf(-xd)); }
        }
    }
    const int gw = F.bid * NWAVES + wave, NGW = F.G * NWAVES;
    {
        const int i16 = lane & 15, which = lane >> 4, i32 = lane & 31;
        const float inv_a = powf(10000.f, -(float)i16 / 16.f);
        const float inv_r = 1.f / powf(10000.f, (float)i32 / 31.f);
        for (int n = gw; n < SEQ; n += NGW) {
            const float pos = (which & 1) ? (float)(n & 63) : (float)(n >> 6);
            const float ang = pos * inv_a;
            F.ROPE()[(size_t)n * 64 + lane] = (which < 2) ? (float)cos((double)ang) : (float)sin((double)ang);
            const float ang2 = (float)n * inv_r;
            F.RETT()[(size_t)n * 64 + lane] = (lane < 32) ? (float)cos((double)ang2) : (float)sin((double)ang2);
        }
    }
    for (int i = F.bid * NTHR + tid; i < DEPTH * 4 * 128 * 128; i += F.G * NTHR) F.SGW()[i] = (bf16)f2bf(F.sgw()[i]);
    LAS float* scr = (LAS float*)(F.lds + 32768 + wave * 8704);
    constexpr int I_IN = 16 * 104, I_OUT = 16 * 32, I_EX = 1024;
    constexpr int T_IN = DEPTH * I_IN, T_OUT = DEPTH * I_OUT, T_EX = DEPTH * NE * I_EX;
    constexpr int NITEMS = T_IN + T_OUT + 3 * T_EX;
    for (int it = gw; it < NITEMS; it += NGW) {
        int r = it;
        if (r < T_IN) { const int L = r / I_IN, q = r % I_IN, kb = q / 104, nb = q % 104;
            transpose_item(F.w_in() + (size_t)L * DM * INC, INC, F.WIN() + (size_t)L * INC * DM, DM, kb * 64, nb * 32, (size_t)nb * 32, scr, lane); continue; }
        r -= T_IN;
        if (r < T_OUT) { const int L = r / I_OUT, q = r % I_OUT, kb = q / 32, nb = q % 32;
            transpose_item(F.w_out() + (size_t)L * DM * DM, DM, F.WOUT() + (size_t)L * DM * DM, DM, kb * 64, nb * 32, (size_t)nb * 32, scr, lane); continue; }
        r -= T_OUT;
        if (r < 2 * T_EX) { const int up = r >= T_EX; if (up) r -= T_EX;
            const int le = r / I_EX, q = r % I_EX, kb = q / 64, nb = q % 64, n0 = nb * 32;
            const size_t drow0 = (size_t)(n0 >> 7) * 256 + (n0 & 127) + (up ? 128 : 0);
            transpose_item((up ? F.wu() : F.wg()) + (size_t)le * DM * FF, FF, F.WGU() + (size_t)le * 4096 * DM, DM, kb * 64, n0, drow0, scr, lane); continue; }
        r -= 2 * T_EX;
        { const int le = r / I_EX, q = r % I_EX, kb = q / 32, nb = q % 32;
            transpose_item(F.wd() + (size_t)le * FF * DM, DM, F.WD() + (size_t)le * DM * FF, FF, kb * 64, nb * 32, (size_t)nb * 32, scr, lane); }
    }
}

__device__ __forceinline__ void ph_norm1_first(const Frame& F) {
    const int lane = F.lane, gw = F.bid * NWAVES + F.wave, NGW = F.G * NWAVES;
    for (int r = gw; r < NROW; r += NGW) {
        const float* src = r < NLAT ? F.x_in() + (size_t)r * DM : F.ctx_in() + (size_t)(r - NLAT) * DM;
        const float* mod = F.MOD() + (size_t)row_vec(r) * 6144;
        f32x4 v[4]; float ss = 0.f;
#pragma unroll
        for (int j = 0; j < 4; ++j) { v[j] = *(const f32x4*)(src + 4 * lane + 256 * j); ss += (v[j].x * v[j].x + v[j].y * v[j].y) + (v[j].z * v[j].z + v[j].w * v[j].w); }
        const float rinv = rsqrtf(wave_sum(ss) * (1.f / DM) + EPS);
#pragma unroll
        for (int j = 0; j < 4; ++j) { const int c = 4 * lane + 256 * j;
            *(f32x4*)(F.X() + (size_t)r * DM + c) = v[j];
            const f32x4 g = *(const f32x4*)(F.n1g() + c), sh = *(const f32x4*)(mod + c), sc = *(const f32x4*)(mod + 1024 + c);
            const f32x4 h = v[j] * rinv * g * (sc + 1.f) + sh;
            *(unsigned long long*)(F.HN() + (size_t)r * DM + c) = (unsigned long long)pk2(h.x, h.y) | ((unsigned long long)pk2(h.z, h.w) << 32); }
    }
}

__device__ __forceinline__ void ph_prep(const Frame& F, int L) {
    const int lane = F.lane, gw = F.bid * NWAVES + F.wave, NGW = F.G * NWAVES;
    const float gq = F.qng()[L * 64 + lane], gk = F.kng()[L * 64 + lane];
    const f32x4 sgn = *(const f32x4*)(F.sgng() + L * 256 + lane * 4);
    const bool first16 = (lane & 16) == 0, first32 = lane < 32;
    for (int r = gw; r < NROW; r += NGW) {
        const bf16* zr = F.Z() + (size_t)r * INC;
        const bool lat = r < NLAT; const int b = lat ? (r >> 13) : ((r - NLAT) >> 8), n = lat ? (r & (SEQ - 1)) : ((r - NLAT) & (CTXL - 1));
        const size_t krow = (size_t)b * NKEY + (lat ? CTXL + n : n);
        float c1 = 1.f, s1 = 0.f, c2 = 1.f, s2 = 0.f;
        if (lat) { const float* T = F.ROPE() + (size_t)n * 64; const int half = lane >> 5, i = lane & 15; c1 = T[half * 16 + i]; s1 = T[32 + half * 16 + i];
                   const float* R = F.RETT() + (size_t)n * 64; c2 = R[lane & 31]; s2 = R[32 + (lane & 31)]; }
#pragma unroll 4
        for (int g = 0; g < 16; ++g) {
            const float v = bf2f(zr[g * 64 + lane]);
            const float ssq = wave_sum(v * v);
            const float y = v * rsqrtf(ssq * (1.f / 64.f) + EPS) * (g < 8 ? gq : gk);
            const float p = __shfl_xor(y, 16);
            const float o = first16 ? y * c1 - p * s1 : p * s1 + y * c1;
            const bf16 ob = (bf16)f2bf(o);
            if (g < 8) F.QH()[(size_t)r * 512 + g * 64 + lane] = ob; else F.KH()[krow * 512 + (g - 8) * 64 + lane] = ob;
        }
        *(bf16x8*)(F.VH() + krow * 512 + lane * 8) = *(const bf16x8*)(zr + ZV + lane * 8);
#pragma unroll
        for (int h = 0; h < 4; ++h) {
            const float v = bf2f(zr[ZRQ + h * 64 + lane]); const float p = __shfl_xor(v, 32);
            F.RQ()[(size_t)r * 256 + h * 64 + lane] = (bf16)f2bf(first32 ? v * c2 - p * s2 : p * s2 + v * c2);
            const float w = bf2f(zr[ZRK + h * 64 + lane]) * 0.125f; const float q = __shfl_xor(w, 32);
            F.RK()[(size_t)r * 256 + h * 64 + lane] = (bf16)f2bf(first32 ? w * c2 - q * s2 : q * s2 + w * c2);
        }
        { const u16x4 raw = *(const u16x4*)(zr + ZSV + lane * 4);
          float g0 = gelu_t(bf2f(raw[0])), g1 = gelu_t(bf2f(raw[1])), g2 = gelu_t(bf2f(raw[2])), g3 = gelu_t(bf2f(raw[3]));
          const float mu = wave_sum((g0 + g1) + (g2 + g3)) * (1.f / 256.f);
          g0 -= mu; g1 -= mu; g2 -= mu; g3 -= mu;
          const float rs = rsqrtf(wave_sum((g0 * g0 + g1 * g1) + (g2 * g2 + g3 * g3)) * (1.f / 256.f) + EPS);
          *(unsigned long long*)(F.SVN() + (size_t)r * 256 + lane * 4) = (unsigned long long)pk2(g0 * rs * sgn.x, g1 * rs * sgn.y) | ((unsigned long long)pk2(g2 * rs * sgn.z, g3 * rs * sgn.w) << 32); }
    }
}

__device__ __forceinline__ void ph_norm2_router(const Frame& F, int L) {
    const int lane = F.lane, tid = F.tid, gw = F.bid * NWAVES + F.wave, NGW = F.G * NWAVES;
    LAS float* rwT = (LAS float*)F.lds;
    for (int i = tid; i < DM * NE; i += NTHR) { const int k = i >> 4, e = i & 15; rwT[e * DM + k] = F.rw()[(size_t)L * DM * NE + i]; }
    __syncthreads();
    const int nrows = (L == DEPTH - 1) ? NLAT : NROW;
    for (int r = gw; r < nrows; r += NGW) {
        const float* xr = F.X() + (size_t)r * DM;
        const float* mod = F.MOD() + (size_t)(L * 3 + row_vec(r)) * 6144;
        f32x4 v[4]; float ss = 0.f;
#pragma unroll
        for (int j = 0; j < 4; ++j) { v[j] = *(const f32x4*)(xr + 4 * lane + 256 * j); ss += (v[j].x * v[j].x + v[j].y * v[j].y) + (v[j].z * v[j].z + v[j].w * v[j].w); }
        const float rinv = rsqrtf(wave_sum(ss) * (1.f / DM) + EPS);
#pragma unroll
        for (int j = 0; j < 4; ++j) { const int c = 4 * lane + 256 * j;
            const f32x4 g = *(const f32x4*)(F.n2g() + L * DM + c), sh = *(const f32x4*)(mod + 3072 + c), sc = *(const f32x4*)(mod + 4096 + c);
            v[j] = v[j] * rinv * g * (sc + 1.f) + sh;
            *(unsigned long long*)(F.HN() + (size_t)r * DM + c) = (unsigned long long)pk2(v[j].x, v[j].y) | ((unsigned long long)pk2(v[j].z, v[j].w) << 32); }
        float mylg = -INFINITY;
#pragma unroll 2
        for (int e = 0; e < 16; ++e) { float p = 0.f;
#pragma unroll
            for (int j = 0; j < 4; ++j) { const f32x4 w = *(const LAS f32x4*)(rwT + e * DM + 4 * lane + 256 * j); p += (v[j].x * w.x + v[j].y * w.y) + (v[j].z * w.z + v[j].w * w.w); }
            const float s = wave_sum(p); mylg = (lane == e) ? s : mylg; }
        const float mx = wave_max(mylg);
        const float ex = lane < 16 ? expf(mylg - mx) : 0.f;
        const float sum = wave_sum(ex);
        if (lane < 16) F.AFF()[(size_t)r * 16 + lane] = ex / sum;
    }
    __syncthreads();
}

__device__ __forceinline__ unsigned block_excl_scan(unsigned v, LAS unsigned* wtot, int lane, int wave) {
    unsigned inc = v;
#pragma unroll
    for (int o = 1; o < 64; o <<= 1) { const unsigned t = __shfl_up(inc, o); if (lane >= o) inc += t; }
    if (lane == 63) wtot[wave] = inc;
    __syncthreads();
    unsigned off = 0;
    for (int w = 0; w < wave; ++w) off += wtot[w];
    __syncthreads();
    return off + inc - v;
}
__device__ __forceinline__ void ph_topk(const Frame& F, int L) {
    const int tid = F.tid, lane = F.lane, wave = F.wave;
    LAS unsigned* keys = (LAS unsigned*)F.lds;
    LAS unsigned* hist = keys + 8192;
    LAS unsigned* wtot = hist + 256;
    LAS unsigned* bc = wtot + 16;
    const int nprob = (L == DEPTH - 1) ? 32 : 64;
    for (int p = F.bid; p < 64; p += F.G) {
        const int s = p >> 4, e = p & 15;
        const int n = s < 2 ? SEQ : CTXL, k = n >> 3;
        const int base = s < 2 ? s * SEQ : NLAT + (s - 2) * CTXL;
        const int sbase = s == 0 ? 0 : (s == 1 ? 1024 : (s == 2 ? 2048 : 2080));
        if (p >= nprob) {
            for (int i = tid; i < 32; i += NTHR) { F.ROWIDX()[e * EROWS + sbase + i] = -1; F.GATE()[e * EROWS + sbase + i] = 0.f; }
            if (s == 3) for (int rr = 2112 + tid; rr < EROWS; rr += NTHR) { F.ROWIDX()[e * EROWS + rr] = -1; F.GATE()[e * EROWS + rr] = 0.f; }
            continue; }
        for (int i = tid; i < n; i += NTHR) keys[i] = __float_as_uint(F.AFF()[(size_t)(base + i) * 16 + e]);
        __syncthreads();
        unsigned prefix = 0u, mask = 0u, need = (unsigned)k;
        for (int pass = 0; pass < 4; ++pass) {
            const int shift = 24 - 8 * pass;
            if (tid < 256) hist[tid] = 0u;
            __syncthreads();
            for (int i = tid; i < n; i += NTHR) { const unsigned key = keys[i]; if ((key & mask) == prefix) atomicAdd((unsigned*)&hist[(key >> shift) & 255u], 1u); }
            __syncthreads();
            if (wave == 0) {
                const unsigned h0 = hist[4 * lane], h1 = hist[4 * lane + 1], h2 = hist[4 * lane + 2], h3 = hist[4 * lane + 3];
                const unsigned tot = h0 + h1 + h2 + h3;
                unsigned suf = tot;
#pragma unroll
                for (int o = 1; o < 64; o <<= 1) { const unsigned t = __shfl_down(suf, o); if (lane + o < 64) suf += t; }
                const unsigned above = suf - tot;
                if (suf >= need && above < need) {
                    unsigned rem = need - above, bsel;
                    if (rem <= h3) bsel = 3u; else { rem -= h3; if (rem <= h2) bsel = 2u; else { rem -= h2; if (rem <= h1) bsel = 1u; else { rem -= h1; bsel = 0u; } } }
                    bc[0] = 4u * lane + bsel; bc[1] = rem;
                }
            }
            __syncthreads();
            prefix |= bc[0] << shift; mask |= 255u << shift; need = bc[1];
            __syncthreads();
        }
        const unsigned T = prefix;
        const int per = n >= NTHR ? n / NTHR : 1;
        const int i0 = tid * per; const bool act = i0 < n;
        unsigned eqc = 0u;
        if (act) for (int q = 0; q < per; ++q) eqc += (keys[i0 + q] == T) ? 1u : 0u;
        unsigned eqr = block_excl_scan(eqc, wtot, lane, wave);
        unsigned selc = 0u;
        if (act) for (int q = 0; q < per; ++q) { const unsigned key = keys[i0 + q]; if (key > T) ++selc; else if (key == T) { if (eqr < need) ++selc; ++eqr; } }
        unsigned slot = block_excl_scan(selc, wtot, lane, wave);
        eqr -= eqc;
        if (act) for (int q = 0; q < per; ++q) {
            const unsigned key = keys[i0 + q]; bool sel = key > T;
            if (key == T) { sel = eqr < need; ++eqr; }
            const int tok = base + i0 + q;
            if (sel) { const int rr = sbase + (int)slot; ++slot; F.ROWIDX()[e * EROWS + rr] = tok; F.GATE()[e * EROWS + rr] = __uint_as_float(key); F.SLOT()[(size_t)tok * 16 + e] = rr; }
            else F.SLOT()[(size_t)tok * 16 + e] = -1;
        }
        if (s == 3) for (int rr = 2112 + tid; rr < EROWS; rr += NTHR) { F.ROWIDX()[e * EROWS + rr] = -1; F.GATE()[e * EROWS + rr] = 0.f; }
        __syncthreads();
    }
}

__device__ __forceinline__ void ph_gather(const Frame& F) {
    const int lane = F.lane, gw = F.bid * NWAVES + F.wave, NGW = F.G * NWAVES;
    for (int idx = gw; idx < NE * EROWS; idx += NGW) {
        const int src = F.ROWIDX()[idx];
        bf16x8 a = {0, 0, 0, 0, 0, 0, 0, 0}, b = a;
        if (src >= 0) { a = *(const bf16x8*)(F.HN() + (size_t)src * DM + 8 * lane); b = *(const bf16x8*)(F.HN() + (size_t)src * DM + 512 + 8 * lane); }
        *(bf16x8*)(F.XS() + (size_t)idx * DM + 8 * lane) = a; *(bf16x8*)(F.XS() + (size_t)idx * DM + 512 + 8 * lane) = b;
    }
}

__device__ __forceinline__ void ph_combine(const Frame& F, int L) {
    const int lane = F.lane, gw = F.bid * NWAVES + F.wave, NGW = F.G * NWAVES;
    const bool last = (L == DEPTH - 1);
    const int nrows = last ? NLAT : NROW;
    for (int r = gw; r < nrows; r += NGW) {
        const int v = row_vec(r);
        const int sl = (lane < 16) ? F.SLOT()[(size_t)r * 16 + lane] : -1;
        float acc[16];
#pragma unroll
        for (int i = 0; i < 16; ++i) acc[i] = 0.f;
        for (int e = 0; e < 16; ++e) {
            const int s = __shfl(sl, e);
            if (s >= 0) {
                const float gv = F.GATE()[e * EROWS + s];
                const bf16* y = F.Y() + ((size_t)e * EROWS + s) * DM;
#pragma unroll
                for (int j = 0; j < 2; ++j) { const bf16x8 yv = *(const bf16x8*)(y + 8 * lane + 512 * j);
#pragma unroll
                    for (int i = 0; i < 8; ++i) acc[8 * j + i] += gv * bf2f((bf16)yv[i]); }
            }
        }
        const float* mod = F.MOD() + (size_t)(L * 3 + v) * 6144;
        float xn[16]; float ss = 0.f;
#pragma unroll
        for (int j = 0; j < 2; ++j)
#pragma unroll
            for (int q = 0; q < 2; ++q) { const int c = 8 * lane + 512 * j + 4 * q;
                const f32x4 xv = *(const f32x4*)(F.X() + (size_t)r * DM + c), g2 = *(const f32x4*)(mod + 5120 + c);
#pragma unroll
                for (int i = 0; i < 4; ++i) { const float t = xv[i] + g2[i] * acc[8 * j + 4 * q + i]; xn[8 * j + 4 * q + i] = t; ss += t * t; }
                const f32x4 o = {xn[8 * j + 4 * q], xn[8 * j + 4 * q + 1], xn[8 * j + 4 * q + 2], xn[8 * j + 4 * q + 3]};
                if (last) *(f32x4*)(F.out + (size_t)r * DM + c) = o; else *(f32x4*)(F.X() + (size_t)r * DM + c) = o; }
        if (!last) {
            const float rinv = rsqrtf(wave_sum(ss) * (1.f / DM) + EPS);
            const float* mod1 = F.MOD() + (size_t)((L + 1) * 3 + v) * 6144;
#pragma unroll
            for (int j = 0; j < 2; ++j) { const int c = 8 * lane + 512 * j; float h[8];
#pragma unroll
                for (int q = 0; q < 2; ++q) { const f32x4 g = *(const f32x4*)(F.n1g() + (L + 1) * DM + c + 4 * q), sh = *(const f32x4*)(mod1 + c + 4 * q), sc = *(const f32x4*)(mod1 + 1024 + c + 4 * q);
#pragma unroll
                    for (int i = 0; i < 4; ++i) h[4 * q + i] = xn[8 * j + 4 * q + i] * rinv * g[i] * (1.f + sc[i]) + sh[i]; }
                v4u w; w.x = pk2(h[0], h[1]); w.y = pk2(h[2], h[3]); w.z = pk2(h[4], h[5]); w.w = pk2(h[6], h[7]);
                *(v4u*)(F.HN() + (size_t)r * DM + c) = w; }
        }
    }
}

constexpr int LDP = 136, LDQK = 72;

__device__ __forceinline__ void unit_retkv(const Frame& F, int L, int b, int h, int cc) {
    const int tid = F.tid, lane = F.lane, wave = F.wave;
    LAS bf16* vT = (LAS bf16*)F.lds;
    LAS bf16* kfT = vT + 64 * LDP;
    LAS bf16* kbT = kfT + 64 * LDP;
    const int row0 = chunk_row0(b, cc);
    const float lgf = F.LP()[L * 16 + 2 + h], lgb = F.LP()[L * 16 + 6 + h];
#pragma unroll
    for (int q = 0; q < 2; ++q) {
        const int idx = tid + NTHR * q, j = idx >> 3, c8 = (idx & 7) * 8;
        const bf16x8 kv = *(const bf16x8*)(F.RK() + (size_t)(row0 + j) * 256 + h * 64 + c8);
        const bf16x8 vv = *(const bf16x8*)(F.Z() + (size_t)(row0 + j) * INC + ZRV + h * 64 + c8);
        const float df = __expf(lgf * (float)(127 - j)), db = __expf(lgb * (float)j);
#pragma unroll
        for (int i = 0; i < 8; ++i) { const float kf = bf2f((bf16)kv[i]);
            kfT[(c8 + i) * LDP + j] = (bf16)f2bf(kf * df); kbT[(c8 + i) * LDP + j] = (bf16)f2bf(kf * db); vT[(c8 + i) * LDP + j] = (bf16)vv[i]; }
    }
    __syncthreads();
    { const int dir = wave >> 2, ti = (wave >> 1) & 1, tj = wave & 1, r32 = lane & 31, hi = lane >> 5;
      f32x16 acc = {};
      acc = mma_nt(vT + ti * 32 * LDP, LDP, (dir ? kbT : kfT) + tj * 32 * LDP, LDP, 128, acc, lane);
      float* dst = F.KVT() + ((size_t)(((b * 4 + h) * 2 + dir) * NCH + cc)) * 4096;
#pragma unroll
      for (int x = 0; x < 16; ++x) dst[(ti * 32 + crow(x, hi)) * 64 + tj * 32 + r32] = acc[x]; }
    __syncthreads();
}

__device__ __forceinline__ void ph_scan(const Frame& F, int L) {
    const int t = F.bid * NTHR + F.tid;
    if (t < 65536) {
        const int elem = t & 4095, sq = t >> 12, dir = sq & 1, h = (sq >> 1) & 3, b = sq >> 3;
        const size_t base = (size_t)(((b * 4 + h) * 2 + dir) * NCH);
        const float decay = expf(F.LP()[L * 16 + 2 + dir * 4 + h] * 128.f);
        float s = 0.f;
        for (int step = 0; step < NCH; ++step) {
            const int cc = dir == 0 ? step : (step < 2 ? 1 - step : 67 - step);
            F.SPREV()[(base + cc) * 4096 + elem] = s;
            s = s * decay + F.KVT()[(base + cc) * 4096 + elem];
        }
    }
}

__device__ __forceinline__ void unit_retout(const Frame& F, int L, int b, int h, int cc) {
    int tid = F.tid; asm volatile("" : "+v"(tid));
    const int lane = tid & 63, wave = F.wave, r32 = lane & 31, hi = lane >> 5;
    LAS bf16* q_s = (LAS bf16*)F.lds;
    LAS bf16* k_s = q_s + 128 * LDQK;
    LAS bf16* vT = k_s + 128 * LDQK;
    LAS bf16* SfT = vT + 64 * LDP;
    LAS bf16* SbT = SfT + 64 * LDQK;
    LAS bf16* P = SbT + 64 * LDQK;
    LAS float* O_s = (LAS float*)P;
    constexpr int LDO = 66;
    const int row0 = chunk_row0(b, cc);
    const float lgf = F.LP()[L * 16 + 2 + h], lgb = F.LP()[L * 16 + 6 + h];
#pragma unroll
    for (int q = 0; q < 2; ++q) {
        const int idx = tid + NTHR * q, j = idx >> 3, c8 = (idx & 7) * 8;
        *(LAS bf16x8*)(q_s + j * LDQK + c8) = *(const bf16x8*)(F.RQ() + (size_t)(row0 + j) * 256 + h * 64 + c8);
        *(LAS bf16x8*)(k_s + j * LDQK + c8) = *(const bf16x8*)(F.RK() + (size_t)(row0 + j) * 256 + h * 64 + c8);
        const bf16x8 vv = *(const bf16x8*)(F.Z() + (size_t)(row0 + j) * INC + ZRV + h * 64 + c8);
#pragma unroll
        for (int i = 0; i < 8; ++i) vT[(c8 + i) * LDP + j] = (bf16)vv[i];
    }
    { const float* sf = F.SPREV() + ((size_t)(((b * 4 + h) * 2 + 0) * NCH + cc)) * 4096;
      const float* sb = F.SPREV() + ((size_t)(((b * 4 + h) * 2 + 1) * NCH + cc)) * 4096;
#pragma unroll
      for (int q = 0; q < 2; ++q) { const int idx = tid + NTHR * q, dv = idx >> 4, c4 = (idx & 15) * 4;
          const f32x4 a = *(const f32x4*)(sf + dv * 64 + c4), c = *(const f32x4*)(sb + dv * 64 + c4);
          *(LAS unsigned long long*)(SfT + dv * LDQK + c4) = (unsigned long long)pk2(a.x, a.y) | ((unsigned long long)pk2(a.z, a.w) << 32);
          *(LAS unsigned long long*)(SbT + dv * LDQK + c4) = (unsigned long long)pk2(c.x, c.y) | ((unsigned long long)pk2(c.z, c.w) << 32); } }
    __syncthreads();
    const int sti = wave >> 1, stj0 = (wave & 1) * 2;
    f32x16 S0 = {}, S1 = {};
    S0 = mma_nt(q_s + sti * 32 * LDQK, LDQK, k_s + stj0 * 32 * LDQK, LDQK, 64, S0, lane);
    S1 = mma_nt(q_s + sti * 32 * LDQK, LDQK, k_s + (stj0 + 1) * 32 * LDQK, LDQK, 64, S1, lane);
    const int ei = tid >> 2, ec = (tid & 3) * 16;
    float yo[16];
#pragma unroll
    for (int dir = 0; dir < 2; ++dir) {
        const float lg = dir ? lgb : lgf;
#pragma unroll
        for (int x = 0; x < 16; ++x) { const int i = sti * 32 + crow(x, hi);
            const int j0 = stj0 * 32 + r32, j1 = j0 + 32; const int d0 = dir ? j0 - i : i - j0, d1 = dir ? j1 - i : i - j1;
            const float p0 = d0 >= 0 ? S0[x] * __expf(lg * (float)d0) : 0.f, p1 = d1 >= 0 ? S1[x] * __expf(lg * (float)d1) : 0.f;
            const unsigned pk = pg8::cvt_pk_bf16(p0, p1);
            P[i * LDP + j0] = (bf16)(pk & 0xffffu); P[i * LDP + j1] = (bf16)(pk >> 16);
            if ((x & 3) == 3) __builtin_amdgcn_sched_barrier(0); }
        __syncthreads();
        f32x16 a0 = {}, a1 = {}, c0 = {}, c1 = {};
        if (wave < 4) {
            const LAS bf16* ST = dir ? SbT : SfT;
            a0 = mma_nt(P + wave * 32 * LDP, LDP, vT, LDP, 128, a0, lane);
            a1 = mma_nt(P + wave * 32 * LDP, LDP, vT + 32 * LDP, LDP, 128, a1, lane);
            c0 = mma_nt(q_s + wave * 32 * LDQK, LDQK, ST, LDQK, 64, c0, lane);
            c1 = mma_nt(q_s + wave * 32 * LDQK, LDQK, ST + 32 * LDQK, LDQK, 64, c1, lane);
        }
        __syncthreads();
        if (wave < 4) {
#pragma unroll
            for (int x = 0; x < 16; ++x) { const int i = wave * 32 + crow(x, hi);
                const float qd = __expf(lg * (float)(dir ? 128 - i : i + 1));
                O_s[i * LDO + r32] = a0[x] + c0[x] * qd; O_s[i * LDO + 32 + r32] = a1[x] + c1[x] * qd;
                if ((x & 3) == 3) __builtin_amdgcn_sched_barrier(0); }
        }
        __syncthreads();
        { float o[16]; float s = 0.f;
#pragma unroll
          for (int c = 0; c < 16; ++c) { o[c] = O_s[ei * LDO + ec + c]; s += o[c]; }
          s += __shfl_xor(s, 1); s += __shfl_xor(s, 2);
          const float mu = s * (1.f / 64.f); float s2 = 0.f;
#pragma unroll
          for (int c = 0; c < 16; ++c) { o[c] -= mu; s2 += o[c] * o[c]; }
          s2 += __shfl_xor(s2, 1); s2 += __shfl_xor(s2, 2);
          const float rs = rsqrtf(s2 * (1.f / 64.f) + EPS);
          const bf16* zr = F.Z() + (size_t)(row0 + ei) * INC + (dir ? ZGB : ZGF) + h * 64 + ec;
          const bf16x8 ga = *(const bf16x8*)zr, gb = *(const bf16x8*)(zr + 8);
#pragma unroll
          for (int c = 0; c < 16; ++c) { const float g = bf2f((bf16)(c < 8 ? ga[c & 7] : gb[c & 7])); const float y = o[c] * rs * silu_f(g);
              if (dir == 0) yo[c] = y; else yo[c] += y; }
          if (dir == 1) { bf16* mr = F.MIX() + (size_t)(row0 + ei) * DM + 512 + h * 64 + ec;
              v4u w0, w1; w0.x = pk2(yo[0], yo[1]); w0.y = pk2(yo[2], yo[3]); w0.z = pk2(yo[4], yo[5]); w0.w = pk2(yo[6], yo[7]);
              w1.x = pk2(yo[8], yo[9]); w1.y = pk2(yo[10], yo[11]); w1.z = pk2(yo[12], yo[13]); w1.w = pk2(yo[14], yo[15]);
              *(v4u*)mr = w0; *(v4u*)(mr + 8) = w1; } }
        __syncthreads();
    }
}

__device__ __forceinline__ void unit_sg(const Frame& F, int L, int b, int g, int cc) {
    const int tid = F.tid, lane = F.lane, wave = F.wave, r32 = lane & 31, hi = lane >> 5;
    LAS bf16* W_s = (LAS bf16*)F.lds;
    LAS bf16* vT = W_s + 128 * LDP;
    const int row0 = chunk_row0(b, cc);
    const bf16* Wg = F.SGW() + (size_t)(L * 4 + g) * 128 * 128;
#pragma unroll
    for (int q = 0; q < 4; ++q) { const int idx = tid + NTHR * q, i = idx >> 4, c8 = (idx & 15) * 8; *(LAS bf16x8*)(W_s + i * LDP + c8) = *(const bf16x8*)(Wg + i * 128 + c8); }
#pragma unroll
    for (int q = 0; q < 2; ++q) { const int idx = tid + NTHR * q, j = idx >> 3, c8 = (idx & 7) * 8;
        const bf16x8 vv = *(const bf16x8*)(F.SVN() + (size_t)(row0 + j) * 256 + g * 64 + c8);
#pragma unroll
        for (int i = 0; i < 8; ++i) vT[(c8 + i) * LDP + j] = (bf16)vv[i]; }
    __syncthreads();
    { const int ti = wave >> 1, tj = wave & 1;
      f32x16 acc = {};
      acc = mma_nt(W_s + ti * 32 * LDP, LDP, vT + tj * 32 * LDP, LDP, 128, acc, lane);
#pragma unroll
      for (int x = 0; x < 16; ++x) { const int i = ti * 32 + crow(x, hi), d = tj * 32 + r32;
          const float u = gelu_t(bf2f(F.Z()[(size_t)(row0 + i) * INC + ZSU + g * 64 + d]));
          F.MIX()[(size_t)(row0 + i) * DM + 768 + g * 64 + d] = (bf16)f2bf(u * (acc[x] + F.sgb()[(L * 4 + g) * 128 + i])); } }
    __syncthreads();
}

namespace att {
constexpr int KVBLK = 64;
constexpr float SCALE = 0.125f, THR = 8.f;
constexpr int LDQ = 512, LDK = 512, LDV = 512;
constexpr int SHM_V = KVBLK * 128 * 2, SHM_K = KVBLK * 64 * 2, SHM_ATTN = 2 * SHM_V + 2 * SHM_K + NWAVES * 64 * 4;
#define KSWZ(row, colB) ((row) * 128 + ((colB) ^ (((row) & 7) << 4)))
#define SBAR() __builtin_amdgcn_sched_barrier(0)
__device__ __forceinline__ unsigned cvtpk(float lo, float hi) { unsigned r; asm volatile("v_cvt_pk_bf16_f32 %0, %1, %2" : "=v"(r) : "v"(lo), "v"(hi)); return r; }
__device__ __forceinline__ void partialSM(f32x16& p0, f32x16& p1, float& m_reg, float& mn, float& alpha) {
    constexpr float C = SCALE * 1.4426950408889634f;
    float pmax = p0[0];
#pragma unroll
    for (int r = 1; r < 16; ++r) pmax = fmaxf(pmax, p0[r]);
#pragma unroll
    for (int r = 0; r < 16; ++r) pmax = fmaxf(pmax, p1[r]);
    { auto rr = __builtin_amdgcn_permlane32_swap(__float_as_uint(pmax), __float_as_uint(pmax), false, false);
      pmax = fmaxf(__uint_as_float(rr[0]), __uint_as_float(rr[1])); }
    if (__builtin_expect(__all(pmax - m_reg <= THR / SCALE), 1)) { mn = m_reg; alpha = 1.f; }
    else { mn = fmaxf(m_reg, pmax); alpha = __builtin_amdgcn_exp2f((m_reg - mn) * C); m_reg = mn; }
    const float mnC = -mn * C;
#pragma unroll
    for (int r = 0; r < 16; ++r) p0[r] = fmaf(p0[r], C, mnC);
#pragma unroll
    for (int r = 0; r < 16; ++r) p1[r] = fmaf(p1[r], C, mnC);
#pragma unroll
    for (int r = 0; r < 16; ++r) p0[r] = __builtin_amdgcn_exp2f(p0[r]);
}
__device__ __forceinline__ void finishSM(f32x16& p0, f32x16& p1, float alpha, float& l_reg, bf16x8& pa0, bf16x8& pa1, bf16x8& pa2, bf16x8& pa3) {
#pragma unroll
    for (int r = 0; r < 16; ++r) p1[r] = __builtin_amdgcn_exp2f(p1[r]);
    float ps = 0;
#pragma unroll
    for (int r = 0; r < 16; ++r) ps += p0[r];
#pragma unroll
    for (int r = 0; r < 16; ++r) ps += p1[r];
    { auto rr = __builtin_amdgcn_permlane32_swap(__float_as_uint(ps), __float_as_uint(ps), false, false);
      ps = __uint_as_float(rr[0]) + __uint_as_float(rr[1]); }
    l_reg = l_reg * alpha + ps;
#define PK4(P, BASE, OUT) do { unsigned a0 = cvtpk(P[BASE + 0], P[BASE + 1]), a1 = cvtpk(P[BASE + 2], P[BASE + 3]);   \
    unsigned b0 = cvtpk(P[BASE + 4], P[BASE + 5]), b1 = cvtpk(P[BASE + 6], P[BASE + 7]);                              \
    auto r0 = __builtin_amdgcn_permlane32_swap(a0, b0, false, false); auto r1 = __builtin_amdgcn_permlane32_swap(a1, b1, false, false); \
    v4u w = {r0[0], r1[0], r0[1], r1[1]}; OUT = __builtin_bit_cast(bf16x8, w); } while (0)
    PK4(p0, 0, pa0); PK4(p0, 8, pa1); PK4(p1, 0, pa2); PK4(p1, 8, pa3);
#undef PK4
}
__device__ __forceinline__ void qkt(f32x16& p0, f32x16& p1, const LAS char* Ks, const bf16x8* qr, int r32, int hi) {
    p0 = f32x16{}; p1 = f32x16{};
#pragma unroll
    for (int d0 = 0; d0 < 4; ++d0) { const int cb = (d0 * 16 + hi * 8) * 2;
        const bf16x8 b0 = *(const LAS bf16x8*)(Ks + KSWZ(r32, cb));
        const bf16x8 b1 = *(const LAS bf16x8*)(Ks + KSWZ(32 + r32, cb));
        p0 = __builtin_amdgcn_mfma_f32_32x32x16_bf16(b0, qr[d0], p0, 0, 0, 0);
        p1 = __builtin_amdgcn_mfma_f32_32x32x16_bf16(b1, qr[d0], p1, 0, 0, 0); }
}
__device__ __forceinline__ int v_st(int k, int c) { const int kk = (k & ~0xC) | ((k & 4) << 1) | ((k & 8) >> 1); return ((kk >> 3) * 4 + (c >> 5)) * 512 + ((kk & 7) * 32 + (c & 31)) * 2; }
__device__ __forceinline__ int v_rd_base(int lane) { return ((lane & 3) << 3) | (((lane >> 2) & 3) << 6) | (((lane >> 4) & 1) << 5) | (((lane >> 5) & 1) << 8); }
constexpr int v_rd_off(int d0, int ks, int half) { return d0 * 512 + ks * 4096 + half * 2048; }
template <int OFF> __device__ __forceinline__ s16x4 tr_read(int vb) {
    s16x4 r; asm volatile("ds_read_b64_tr_b16 %0, %1 offset:%2" : "=&v"(r) : "v"(vb), "i"(OFF) : "memory"); return r;
}
template <int D0> __device__ __forceinline__ void pv_one(f32x16& od, int vb, bf16x8 pa0, bf16x8 pa1, bf16x8 pa2, bf16x8 pa3) {
    const s16x4 l0 = tr_read<v_rd_off(D0, 0, 0)>(vb), h0 = tr_read<v_rd_off(D0, 0, 1)>(vb), l1 = tr_read<v_rd_off(D0, 1, 0)>(vb), h1 = tr_read<v_rd_off(D0, 1, 1)>(vb);
    const s16x4 l2 = tr_read<v_rd_off(D0, 2, 0)>(vb), h2 = tr_read<v_rd_off(D0, 2, 1)>(vb), l3 = tr_read<v_rd_off(D0, 3, 0)>(vb), h3 = tr_read<v_rd_off(D0, 3, 1)>(vb);
    asm volatile("s_waitcnt lgkmcnt(0)" ::: "memory"); SBAR();
#define PK(Lo, Hi) (bf16x8){Lo[0], Lo[1], Lo[2], Lo[3], Hi[0], Hi[1], Hi[2], Hi[3]}
    od = __builtin_amdgcn_mfma_f32_32x32x16_bf16(pa0, PK(l0, h0), od, 0, 0, 0);
    od = __builtin_amdgcn_mfma_f32_32x32x16_bf16(pa1, PK(l1, h1), od, 0, 0, 0);
    od = __builtin_amdgcn_mfma_f32_32x32x16_bf16(pa2, PK(l2, h2), od, 0, 0, 0);
    od = __builtin_amdgcn_mfma_f32_32x32x16_bf16(pa3, PK(l3, h3), od, 0, 0, 0);
#undef PK
}
__device__ __forceinline__ void pv_d0(f32x16* o, int vb, bf16x8 pa0, bf16x8 pa1, bf16x8 pa2, bf16x8 pa3) {
    pv_one<0>(o[0], vb, pa0, pa1, pa2, pa3); pv_one<1>(o[1], vb, pa0, pa1, pa2, pa3); pv_one<2>(o[2], vb, pa0, pa1, pa2, pa3); pv_one<3>(o[3], vb, pa0, pa1, pa2, pa3);
}
__device__ __forceinline__ void body(const bf16* __restrict__ Qb, const bf16* __restrict__ Kh, const bf16* __restrict__ Vh, int seq, LAS char* lds, f32x16 (&o)[4]) {
    int tid = threadIdx.x; asm volatile("" : "+v"(tid));
    const int wid = __builtin_amdgcn_readfirstlane(tid >> 6), lane = tid & 63, r32 = lane & 31, hi = lane >> 5;
    LAS char* V_lds = lds; LAS char* K_lds = lds + 2 * SHM_V;
    LAS float* ws = (LAS float*)(lds + 2 * SHM_V + 2 * SHM_K) + wid * 64; LAS float* li_l = ws; LAS float* al_l = ws + 32;
    float m_reg = -1e30f, l_reg = 0;
#pragma unroll
    for (int d = 0; d < 4; ++d) o[d] = f32x16{};
    bf16x8 qr[4];
    const bf16* Qw = Qb + (long)(wid * 32 + r32) * LDQ + hi * 8;
#pragma unroll
    for (int d0 = 0; d0 < 4; ++d0) qr[d0] = *(const bf16x8*)(Qw + d0 * 16);
    const int sr = tid >> 4, sc = (tid & 15) * 8, vst0 = v_st(sr, sc), vst1 = v_st(32 + sr, sc);
    const int kr = tid >> 3, kc = (tid & 7) * 8, kst = KSWZ(kr, kc * 2);
    const int vb0 = (int)(uintptr_t)V_lds + v_rd_base(lane);
    struct { bf16x8 vs0, vs1, ks0; } sr_[2];
#define SLOAD(i, k0) do { sr_[i].vs0 = *(const bf16x8*)(&Vh[(long)((k0) + sr) * LDV + sc]); sr_[i].vs1 = *(const bf16x8*)(&Vh[(long)((k0) + 32 + sr) * LDV + sc]); \
    sr_[i].ks0 = *(const bf16x8*)(&Kh[(long)((k0) + kr) * LDK + kc]); } while (0)
#define SWRITE(b, i) do { *(LAS bf16x8*)(V_lds + (b) * SHM_V + vst0) = sr_[i].vs0; *(LAS bf16x8*)(V_lds + (b) * SHM_V + vst1) = sr_[i].vs1; \
    *(LAS bf16x8*)(K_lds + (b) * SHM_K + kst) = sr_[i].ks0; } while (0)
#define SWAIT() asm volatile("s_waitcnt vmcnt(3)" ::: "memory")
#define RESC(a) do { if (__any((a) < 1.f)) { if (hi == 0) al_l[r32] = (a); asm volatile("s_waitcnt lgkmcnt(0)" ::: "memory"); \
    _Pragma("unroll") for (int d = 0; d < 4; ++d) _Pragma("unroll") for (int r = 0; r < 16; ++r) o[d][r] *= al_l[crow(r, hi)]; } } while (0)
    f32x16 pA0, pA1, pB0, pB1; float mnA, mnB, alA, alB; bf16x8 pa0, pa1, pa2, pa3; const int NT = seq / KVBLK;
    constexpr int SE = 0, SO = 1;
    SLOAD(SE, 0); asm volatile("s_waitcnt vmcnt(0)" ::: "memory"); SWRITE(0, SE); __syncthreads();
    qkt(pA0, pA1, K_lds, qr, r32, hi); partialSM(pA0, pA1, m_reg, mnA, alA);
    SLOAD(SO, KVBLK); if (2 < NT) SLOAD(SE, 2 * KVBLK);
    SWAIT(); SWRITE(1, SO); __syncthreads();
    for (int j = 1; j + 1 < NT; j += 2) {
        SBAR(); qkt(pB0, pB1, K_lds + SHM_K, qr, r32, hi);
        finishSM(pA0, pA1, alA, l_reg, pa0, pa1, pa2, pa3); SBAR();
        SLOAD(SO, (j + 2) * KVBLK); SBAR();
        pv_d0(o, vb0, pa0, pa1, pa2, pa3); partialSM(pB0, pB1, m_reg, mnB, alB);
        __syncthreads(); SWAIT(); SWRITE(0, SE);
        RESC(alB); __syncthreads();
        SBAR(); qkt(pA0, pA1, K_lds, qr, r32, hi);
        finishSM(pB0, pB1, alB, l_reg, pa0, pa1, pa2, pa3); SBAR();
        if (j + 3 < NT) SLOAD(SE, (j + 3) * KVBLK); SBAR();
        pv_d0(o, vb0 + (int)SHM_V, pa0, pa1, pa2, pa3); partialSM(pA0, pA1, m_reg, mnA, alA);
        __syncthreads(); SWAIT(); SWRITE(1, SO);
        RESC(alA); __syncthreads();
    }
    SBAR(); qkt(pB0, pB1, K_lds + SHM_K, qr, r32, hi);
    finishSM(pA0, pA1, alA, l_reg, pa0, pa1, pa2, pa3); SBAR();
    pv_d0(o, vb0, pa0, pa1, pa2, pa3); partialSM(pB0, pB1, m_reg, mnB, alB);
    __syncthreads(); RESC(alB);
    finishSM(pB0, pB1, alB, l_reg, pa0, pa1, pa2, pa3); SBAR();
    pv_d0(o, vb0 + (int)SHM_V, pa0, pa1, pa2, pa3);
    if (hi == 0) li_l[r32] = l_reg; asm volatile("s_waitcnt lgkmcnt(0)" ::: "memory");
#pragma unroll
    for (int r = 0; r < 16; ++r) { const float rl = __builtin_amdgcn_rcpf(li_l[crow(r, hi)]);
#pragma unroll
        for (int d0 = 0; d0 < 4; ++d0) o[d0][r] *= rl; }
    __syncthreads();
#undef SLOAD
#undef SWRITE
#undef SWAIT
#undef RESC
}
}

__device__ __forceinline__ void unit_attn(const Frame& F, int L, int b, int h, int qrow0  , int seq) {
    f32x16 o[4];
    for (int m = 0; m < 2; ++m) {
        att::body(F.QH() + (size_t)qrow0 * 512 + (h * 2 + m) * 64, F.KH() + (size_t)b * NKEY * 512 + (h * 2 + m) * 64, F.VH() + (size_t)b * NKEY * 512 + h * 128, seq, (LAS char*)F.lds, o);
        if (m == 0) {
            int tid = F.tid; asm volatile("" : "+v"(tid));
            const int lane = tid & 63, wave = __builtin_amdgcn_readfirstlane(tid >> 6), r32 = lane & 31, hi = lane >> 5;
            float* scr = F.SCR() + (size_t)F.bid * 256 * 128 + (size_t)(wave * 32) * 128;
#pragma unroll
            for (int r = 0; r < 16; ++r)
#pragma unroll
                for (int d0 = 0; d0 < 4; ++d0) scr[crow(r, hi) * 128 + d0 * 32 + r32] = o[d0][r];
            asm volatile("s_waitcnt vmcnt(0)" ::: "memory");
        }
    }
    int tid = F.tid; asm volatile("" : "+v"(tid));
    const int lane = tid & 63, wave = __builtin_amdgcn_readfirstlane(tid >> 6), r32 = lane & 31, hi = lane >> 5;
    const float lam = F.LP()[L * 16 + 0], oscale = F.LP()[L * 16 + 1];
    const float* scr = F.SCR() + (size_t)F.bid * 256 * 128 + (size_t)(wave * 32) * 128;
    float sg[4];
#pragma unroll
    for (int d0 = 0; d0 < 4; ++d0) sg[d0] = F.subg()[L * 128 + d0 * 32 + r32] * oscale;
#pragma unroll
    for (int r = 0; r < 16; ++r) {
        float d[4]; float ss = 0.f;
#pragma unroll
        for (int d0 = 0; d0 < 4; ++d0) { d[d0] = scr[crow(r, hi) * 128 + d0 * 32 + r32] - lam * o[d0][r]; ss += d[d0] * d[d0]; }
        const float rs = rsqrtf(half_sum32(ss) * (1.f / 128.f) + EPS);
        bf16* mr = F.MIX() + (size_t)(qrow0 + wave * 32 + crow(r, hi)) * DM + h * 128;
#pragma unroll
        for (int d0 = 0; d0 < 4; ++d0) mr[d0 * 32 + r32] = (bf16)f2bf(d[d0] * rs * sg[d0]);
    }
}

constexpr int NPH_L = 12, NPHASE = 2 + DEPTH * NPH_L;
struct Args { const float* in[25]; float* out; unsigned char* ws; int gp_lo, gp_hi; };
__global__ void __launch_bounds__(NTHR, 2) fwd(Args args) {
    extern __shared__ __attribute__((aligned(16))) unsigned char lds[];
    Frame F;
    F.lds = (LAS unsigned char*)lds;
    F.tid = threadIdx.x; F.lane = F.tid & 63; F.wave = __builtin_amdgcn_readfirstlane(F.tid >> 6); F.bid = blockIdx.x; F.G = gridDim.x;
    F.in = args.in; F.out = args.out; F.ws = args.ws;
    unsigned char* ws = args.ws;
    volatile LAS unsigned* MISC = (volatile LAS unsigned*)(F.lds + MISC_OFF);
    for (int u = F.tid; u < (LDS_BYTES - RING_BYTES) / 4; u += NTHR) ((LAS unsigned*)(F.lds + RING_BYTES))[u] = 0u;
    __syncthreads();
    const int lo = args.gp_lo, hi = args.gp_hi;
    unsigned* barw = (unsigned*)(ws + WS_CTL) + CW_BAR;
    XcdBarrier bar; bar.bar = barw; bar.x = 0; bar.st = nullptr;
    if (hi - lo > 1) bar = xcd_barrier_post(barw, MISC + 8);
#ifndef PHM
#define PHM 0xFFFF
#endif
#define PB(i) (((PHM) >> (i)) & 1)
#define IN(k) (lo <= (k) && (k) < hi)
#define SEAM(k) do { if (IN(k) && IN((k) + 1)) xcd_barrier(bar); } while (0)

    if (PB(0) && IN(0)) ph_prologue(F);
    SEAM(0);
    if (PB(1) && IN(1)) ph_norm1_first(F);
    SEAM(1);
    for (int L = 0; L < DEPTH; ++L) {
        const int base = 2 + NPH_L * L;
#define FRESH() do { F.tid = threadIdx.x; asm volatile("" : "+v"(F.tid)); F.lane = F.tid & 63; } while (0)
        if (PB(2) && IN(base + 0)) {
            pg8::Gemm g{F.HN(), F.WIN() + (size_t)L * INC * DM, NROW, INC, DM}; pg8::StaticOrder S; S.init(NROW, INC, F.G, F.bid);
            pg8::EpiBf16<0> E{F.Z(), INC, nullptr, 0, 0, 1.f};
            pg8::gemm_phase<pg8::EpiBf16<0>, pg8::StaticOrder, true, true>(F.lds, g, S, E);
        }
        SEAM(base + 0);
        if (PB(3) && IN(base + 1)) { FRESH(); ph_prep(F, L); }
        SEAM(base + 1);
        if (PB(4) && IN(base + 2)) {
            FRESH();
            for (int u = F.bid; u < 1056; u += F.G) {
                const int v = u < 528 ? u : u - 528; const int b = v / 264, hh = (v / NCH) & 3, cc = v % NCH;
                if (u < 528) unit_retkv(F, L, b, hh, cc); else unit_sg(F, L, b, hh, cc);
            }
        }
        SEAM(base + 2);
        if (PB(5) && IN(base + 3)) { FRESH(); ph_scan(F, L); }
        SEAM(base + 3);
        if (PB(6) && IN(base + 4)) {
            FRESH();
            for (int u = F.bid; u < 264 + 528; u += F.G) {
                if (u < 264) {
                    int b, hh, qrow0, seq;
                    if (u < 256) { const int bh = u & 7, qb = u >> 3; b = bh >> 2; hh = bh & 3; qrow0 = b * SEQ + qb * 256; seq = NKEY; }
                    else { const int v = u - 256; b = v >> 2; hh = v & 3; qrow0 = NLAT + b * CTXL; seq = CTXL; }
#ifndef NO_ATTN
                    unit_attn(F, L, b, hh, qrow0, seq);
#endif
                } else {
#ifndef NO_RETOUT
                    const int v = u - 264; unit_retout(F, L, v / 264, (v / NCH) & 3, v % NCH);
#endif
                }
            }
        }
        SEAM(base + 4);
        if (PB(7) && IN(base + 5)) {
            pg8::Gemm g{F.MIX(), F.WOUT() + (size_t)L * DM * DM, NROW, DM, DM}; pg8::StaticOrder S; S.init(NROW, DM, F.G, F.bid);
            EpiResid E{F.X(), F.MOD() + (size_t)L * 3 * 6144 + 2048};
            pg8::gemm_phase<EpiResid, pg8::StaticOrder, true, true>(F.lds, g, S, E);
        }
        SEAM(base + 5);
        if (PB(8) && IN(base + 6)) { FRESH(); ph_norm2_router(F, L); }
        SEAM(base + 6);
        if (PB(9) && IN(base + 7)) { FRESH(); ph_topk(F, L); }
        SEAM(base + 7);
        if (PB(10) && IN(base + 8)) { FRESH(); ph_gather(F); }
        SEAM(base + 8);
        if (PB(11) && IN(base + 9)) {
            pg8::Gemm g{F.XS(), F.WGU() + (size_t)L * NE * 4096 * DM, NE * EROWS, NE * 4096, DM}; MoeOrder S{F.G, F.bid, 16, NE * 9 * 16};
            EpiSwiglu E{F.HH()};
            pg8::gemm_phase<EpiSwiglu, MoeOrder, true, true>(F.lds, g, S, E);
        }
        SEAM(base + 9);
        if (PB(12) && IN(base + 10)) {
            pg8::Gemm g{F.HH(), F.WD() + (size_t)L * NE * DM * FF, NE * EROWS, NE * DM, FF}; MoeOrder S{F.G, F.bid, 4, NE * 9 * 4};
            pg8::EpiBf16<0> E{F.Y(), DM, nullptr, DM, 0, 1.f};
            pg8::gemm_phase<pg8::EpiBf16<0>, MoeOrder, true, true>(F.lds, g, S, E);
        }
        SEAM(base + 10);
        if (PB(13) && IN(base + 11)) { FRESH(); ph_combine(F, L); }
        SEAM(base + 11);
    }
#undef IN
#undef SEAM
}

extern "C" void kernel_launch(void* const* d_in, const int* in_sizes, int n_in, void* d_out, int out_size, void* d_ws, size_t ws_size, hipStream_t stream) {
    static int grid = 0;
    if (grid == 0) {
        if (n_in != 25 || in_sizes[0] != NLAT * DM || out_size != NLAT * DM || ws_size < WS_END) {
            fprintf(stderr, "kernel_launch: built for 25 inputs, x/out of %d floats, >= %zu bytes of workspace; got n_in %d, in0 %d, out %d, ws %zu; nothing launched\n", NLAT * DM, (size_t)WS_END, n_in, n_in > 0 ? in_sizes[0] : -1, out_size, ws_size);
            grid = -1; return; }
        int dev = 0, cus = 0, per_cu = 0;
        if (hipGetDevice(&dev) != hipSuccess || hipDeviceGetAttribute(&cus, hipDeviceAttributeMultiprocessorCount, dev) != hipSuccess) { fprintf(stderr, "kernel_launch: device query failed\n"); grid = -1; return; }
        if (hipFuncSetAttribute((const void*)fwd, hipFuncAttributeMaxDynamicSharedMemorySize, LDS_BYTES) != hipSuccess) { fprintf(stderr, "kernel_launch: hipFuncSetAttribute failed\n"); grid = -1; return; }
        if (hipOccupancyMaxActiveBlocksPerMultiprocessor(&per_cu, (const void*)fwd, NTHR, LDS_BYTES) != hipSuccess || per_cu < 1)
            fprintf(stderr, "kernel_launch: note: occupancy query reports %d workgroups per CU\n", per_cu);
        (void)hipGetLastError();
        grid = cus;
    }
    if (grid < 0) return;
    if (hipMemsetAsync((char*)d_ws + WS_CTL, 0, CTL_ZERO_BYTES, stream) != hipSuccess) { fprintf(stderr, "kernel_launch: memset failed\n"); return; }
    Args a{};
    for (int i = 0; i < 25; ++i) a.in[i] = (const float*)d_in[i];
    a.out = (float*)d_out; a.ws = (unsigned char*)d_ws;
#if MK_ONE_LAUNCH
    a.gp_lo = 0; a.gp_hi = NPHASE;
    hipLaunchKernelGGL(fwd, dim3(grid), dim3(NTHR), LDS_BYTES, stream, a);
#else
    for (int gp = 0; gp < NPHASE; ++gp) { a.gp_lo = gp; a.gp_hi = gp + 1; hipLaunchKernelGGL(fwd, dim3(grid), dim3(NTHR), LDS_BYTES, stream, a); }
#endif
    const hipError_t le = hipPeekAtLastError();
    if (le != hipSuccess) fprintf(stderr, "kernel_launch: launch failed: %s\n", hipGetErrorName(le));
}
```

```cpp
#include <hip/hip_runtime.h>
#include <cstdio>
#include <cstdint>
#ifndef MK_ONE_LAUNCH
#define MK_ONE_LAUNCH 1
#endif
namespace pg8 {
#define PG8_LAS __attribute__((address_space(3)))
typedef unsigned short bf16_t;
typedef short bf16x8 __attribute__((ext_vector_type(8)));
typedef float f32x4 __attribute__((ext_vector_type(4)));
typedef unsigned u32x4 __attribute__((ext_vector_type(4)));
constexpr int BM = 256, BK = 64, HALF = 128, HTB = HALF * BK * 2  , STAGE_BYTES = 8 * HTB, NXCD = 8, WGM = 8;

__host__ __device__ __forceinline__ int lds_byte(int r, int c) { const int st = (r >> 4) * 2 + (c >> 5), rr = r & 15, cc = c & 31, ob = rr * 64 + cc * 2; return st * 1024 + (ob ^ (((ob >> 9) & 1) << 5)); }
__host__ __device__ __forceinline__ void stage_rc(int b, int& R, int& C) { const int st = b / 1024, sb = b % 1024, swz = sb ^ (((sb >> 9) & 1) << 5); R = (st >> 1) * 16 + swz / 64; C = (st & 1) * 32 + (swz % 64) / 2; }
__host__ __device__ __forceinline__ int perm32(int rho) { const int n = rho >> 4, i = rho & 15; return 8 * (i >> 2) + 4 * n + (i & 3); }

struct Unit { int pm, pn; };
struct Gemm { const bf16_t* A; const bf16_t* Bt; int M, N, K; };

struct StaticOrder {
    int nM, nN, nwg, G, c;
    __host__ __device__ void init(int M, int N, int G_, int c_) { nM = M / BM; nN = N / BM; nwg = nM * nN; G = G_; c = c_; }
    __host__ __device__ bool next(int i, Unit& u) const {
        const long L = (long)i * G + c; if (L >= nwg) return false;
        int wgid = (int)L; { const int q = nwg / NXCD, r = nwg % NXCD, xcd = wgid % NXCD, off = wgid / NXCD; wgid = (xcd < r ? xcd * (q + 1) : r * (q + 1) + (xcd - r) * q) + off; }
        const int nig = WGM * nN, gid = wgid / nig, fm = gid * WGM, gsz = (nM - fm) < WGM ? (nM - fm) : WGM;
        u.pm = fm + ((wgid % nig) % gsz); u.pn = (wgid % nig) / gsz; return true;
    }
    __device__ __forceinline__ void a_ready(const Unit&) const {}
    __device__ __forceinline__ void done(const Unit&) const {}
    __device__ __forceinline__ bool half_only(const Unit&) const { return false; }
};

__device__ __forceinline__ unsigned cvt_pk_bf16(float lo, float hi) { unsigned r; asm volatile("v_cvt_pk_bf16_f32 %0, %1, %2" : "=v"(r) : "v"(lo), "v"(hi)); return r; }
typedef float f32x2 __attribute__((ext_vector_type(2)));
__device__ __forceinline__ f32x2 gelu_pk(f32x2 v) {
    const f32x2 av = __builtin_elementwise_abs(v), d = av * 0.2316418882f + 1.0f;
    f32x2 t; t.x = __builtin_amdgcn_rcpf(d.x); t.y = __builtin_amdgcn_rcpf(d.y);
    f32x2 q = t * 0.5307027145f + (-0.7265760135f); q = q * t + 0.7107068705f; q = q * t + (-0.142248368f); q = q * t + 0.127414796f; q = q * t;
    const f32x2 s = (v * v) * (-0.72134752044f);
    f32x2 e; e.x = __builtin_amdgcn_exp2f(s.x); e.y = __builtin_amdgcn_exp2f(s.y);
    const f32x2 m = v * (q * e), r = v - m;
    f32x2 o; o.x = v.x < 0.f ? m.x : r.x; o.y = v.y < 0.f ? m.y : r.y; return o;
}

template <int ACT  > struct EpiBf16 {
    static constexpr bool PERM = true, AFTER_DRAIN = false; static_assert(ACT == 0 || ACT == 1, "EpiBf16: ACT is 0 (none) or 1 (gelu_pk)");
    bf16_t* O; int ldc; const float* bias; int split_cols; size_t split_stride; float scale0;
    __device__ __forceinline__ void operator()(const f32x4 (&acc)[2][2][4][2], const Unit& u, int wr, int wc, int fr, int fq) const {
        const int row0 = u.pm * BM + wr * 64 + fr; int colt = u.pn * BM; bf16_t* base = O;
        float sc = 1.f; if (split_cols) { const int t = colt / split_cols; base += (size_t)t * split_stride; colt -= t * split_cols; if (t == 0) sc = scale0; }
        const int col0 = colt + wc * 32 + 8 * fq, bcol0 = u.pn * BM + wc * 32 + 8 * fq;
        f32x4 bv[2][2];
#pragma unroll
        for (int bj = 0; bj < 2; ++bj)
#pragma unroll
            for (int n = 0; n < 2; ++n) bv[bj][n] = bias ? *(const f32x4*)(bias + bcol0 + bj * HALF + 4 * n) : (f32x4){0.f, 0.f, 0.f, 0.f};
#pragma unroll
        for (int ai = 0; ai < 2; ++ai)
#pragma unroll
            for (int m = 0; m < 4; ++m) { bf16_t* rowp = base + (size_t)(row0 + ai * HALF + m * 16) * ldc + col0;
#pragma unroll
                for (int bj = 0; bj < 2; ++bj) { f32x4 v0 = acc[ai][bj][m][0] + bv[bj][0], v1 = acc[ai][bj][m][1] + bv[bj][1];
                    if (ACT == 1) { f32x2 a = gelu_pk((f32x2){v0[0], v0[1]}), b = gelu_pk((f32x2){v0[2], v0[3]}), c = gelu_pk((f32x2){v1[0], v1[1]}), d = gelu_pk((f32x2){v1[2], v1[3]});
                        v0 = (f32x4){a.x, a.y, b.x, b.y}; v1 = (f32x4){c.x, c.y, d.x, d.y}; }
                    v0 = v0 * sc; v1 = v1 * sc; u32x4 w; w.x = cvt_pk_bf16(v0[0], v0[1]); w.y = cvt_pk_bf16(v0[2], v0[3]); w.z = cvt_pk_bf16(v1[0], v1[1]); w.w = cvt_pk_bf16(v1[2], v1[3]);
                    *(u32x4*)(rowp + bj * HALF) = w; } }
    }
};
template <class Epi, class Sched, bool ALIGN_EPI = false, bool SP2 = false>
__device__ __forceinline__ void gemm_phase(PG8_LAS unsigned char* lds, const Gemm g, const Sched& S, const Epi& E) {
    int tid = threadIdx.x; asm volatile("" : "+v"(tid));
    const int wid = __builtin_amdgcn_readfirstlane(tid >> 6), lane = tid & 63, wr = wid >> 2, wc = wid & 3, fr = lane & 15, fq = lane >> 4;
    const int K = g.K, nt = K / BK;
    unsigned voffA[2], voffB[2];
#pragma unroll
    for (int i = 0; i < 2; ++i) { int R, C; stage_rc(tid * 16 + i * 8192, R, C); const int Rb = Epi::PERM ? ((R & ~31) + perm32(R & 31)) : R;
        voffA[i] = (unsigned)(R * K + C) * 2u; voffB[i] = (unsigned)(Rb * K + C) * 2u; }
    const size_t kstep = (size_t)(BK * 2);
    const size_t hstep = (size_t)HALF * K * 2;
    const size_t tstep = 2 * hstep;
    const unsigned ldsw = (unsigned)wid * 1024u;
    const int aoff = lds_byte(wr * 64 + fr, fq * 8), boff = lds_byte(wc * 32 + fr, fq * 8);
#define PG8_SA(b, h) (((b) * 2 + (h)) * HTB)
#define PG8_SB(b, h) ((4 + (b) * 2 + (h)) * HTB)
#define PG8_STAGE(bufoff, gbase, voff) do { _Pragma("unroll") for (int _i = 0; _i < 2; ++_i) \
        __builtin_amdgcn_global_load_lds((const unsigned*)((const char*)(gbase) + (voff)[_i]), (PG8_LAS unsigned*)(lds + (bufoff) + ldsw + _i * 8192), 16, 0, 0); } while (0)
#define PG8_LDA(dst, b, h) do { _Pragma("unroll") for (int m = 0; m < 4; ++m) _Pragma("unroll") for (int k = 0; k < 2; ++k) dst[m][k] = *(const PG8_LAS bf16x8*)(lds + PG8_SA(b, h) + aoff + m * 2048 + k * 1024); } while (0)
#define PG8_LDB(dst, b, h) do { _Pragma("unroll") for (int n = 0; n < 2; ++n) _Pragma("unroll") for (int k = 0; k < 2; ++k) dst[n][k] = *(const PG8_LAS bf16x8*)(lds + PG8_SB(b, h) + boff + n * 2048 + k * 1024); } while (0)
#define PG8_MMA(ai, bj, At, Bt) do { __builtin_amdgcn_s_setprio(1); _Pragma("unroll") for (int m = 0; m < 4; ++m) _Pragma("unroll") for (int n = 0; n < 2; ++n) _Pragma("unroll") for (int k = 0; k < 2; ++k) \
        acc[ai][bj][m][n] = __builtin_amdgcn_mfma_f32_16x16x32_bf16(Bt[n][k], At[m][k], acc[ai][bj][m][n], 0, 0, 0); __builtin_amdgcn_s_setprio(0); } while (0)
#define PG8_WAIT_V(n) asm volatile("s_waitcnt vmcnt(" #n ")" ::: "memory")
#define PG8_WAIT_L(n) asm volatile("s_waitcnt lgkmcnt(" #n ")" ::: "memory")
#define PG8_BAR __builtin_amdgcn_s_barrier()
#define PG8_SCHED __builtin_amdgcn_sched_barrier(0)
    Unit cur, nxt; int ui = 0;
    if (!S.next(0, cur)) return;
    f32x4 acc[2][2][4][2];
#pragma unroll
    for (int a = 0; a < 2; ++a)
#pragma unroll
        for (int b = 0; b < 2; ++b)
#pragma unroll
            for (int m = 0; m < 4; ++m)
#pragma unroll
                for (int n = 0; n < 2; ++n) acc[a][b][m][n] = (f32x4){0.f, 0.f, 0.f, 0.f};
    bf16x8 At[4][2], B0[2][2], B1[2][2];
    const char* cA = (const char*)g.A + (size_t)cur.pm * tstep; const char* cB = (const char*)g.Bt + (size_t)cur.pn * tstep;
    S.a_ready(cur);
    if constexpr (SP2) {
        PG8_STAGE(PG8_SB(0, 0), cB, voffB); PG8_STAGE(PG8_SB(0, 1), cB + hstep, voffB); PG8_STAGE(PG8_SA(0, 0), cA, voffA); PG8_STAGE(PG8_SA(0, 1), cA + hstep, voffA);
        if (wr == 1) PG8_BAR;
        PG8_WAIT_V(2); PG8_BAR;
        PG8_STAGE(PG8_SB(1, 0), cB + kstep, voffB); PG8_STAGE(PG8_SA(1, 0), cA + kstep, voffA); PG8_STAGE(PG8_SB(1, 1), cB + hstep + kstep, voffB);
        PG8_WAIT_V(6); PG8_BAR;
    } else {
        PG8_STAGE(PG8_SB(0, 0), cB, voffB); PG8_STAGE(PG8_SA(0, 0), cA, voffA); PG8_STAGE(PG8_SB(0, 1), cB + hstep, voffB); PG8_STAGE(PG8_SA(0, 1), cA + hstep, voffA);
        if (wr == 1) PG8_BAR;
        PG8_WAIT_V(4); PG8_BAR;
        PG8_STAGE(PG8_SB(1, 0), cB + kstep, voffB); PG8_STAGE(PG8_SA(1, 0), cA + kstep, voffA); PG8_STAGE(PG8_SB(1, 1), cB + hstep + kstep, voffB);
        PG8_WAIT_V(6); PG8_BAR;
    }
    for (;;) {
        const bool has_next = S.next(ui + 1, nxt);
        const bool ho = S.half_only(cur);
        const char* nA = has_next ? (const char*)g.A + (size_t)nxt.pm * tstep : cA; const char* nB = has_next ? (const char*)g.Bt + (size_t)nxt.pn * tstep : cB;
        for (int t = 0; t < nt; t += 2) {
            const bool last = (t == nt - 2);
            const char* a1 = cA + (size_t)(t + 1) * kstep;
            const char* a2 = last ? nA : cA + (size_t)(t + 2) * kstep; const char* b2 = last ? nB : cB + (size_t)(t + 2) * kstep;
            const char* a3 = a2 + kstep; const char* b3 = b2 + kstep;
            if (last && has_next) S.a_ready(nxt);
            if constexpr (SP2) {
            PG8_LDB(B0, 0, 0); PG8_LDB(B1, 0, 1); PG8_SCHED; PG8_LDA(At, 0, 0); PG8_STAGE(PG8_SA(1, 1), a1 + hstep, voffA);
            PG8_WAIT_V(8); PG8_WAIT_L(0); PG8_BAR; PG8_MMA(0, 0, At, B0); PG8_MMA(0, 1, At, B1); PG8_BAR; PG8_SCHED;
            PG8_LDA(At, 0, 1); PG8_STAGE(PG8_SB(0, 0), b2, voffB); PG8_STAGE(PG8_SB(0, 1), b2 + hstep, voffB); PG8_STAGE(PG8_SA(0, 0), a2, voffA);
            PG8_WAIT_V(8); PG8_WAIT_L(0); PG8_BAR; if (!ho) { PG8_MMA(1, 0, At, B0); PG8_MMA(1, 1, At, B1); } PG8_BAR; PG8_SCHED;
            PG8_LDB(B0, 1, 0); PG8_LDB(B1, 1, 1); PG8_SCHED; PG8_LDA(At, 1, 0); PG8_STAGE(PG8_SA(0, 1), a2 + hstep, voffA);
            PG8_WAIT_V(8); PG8_WAIT_L(0); PG8_BAR; PG8_MMA(0, 0, At, B0); PG8_MMA(0, 1, At, B1); PG8_BAR; PG8_SCHED;
            PG8_LDA(At, 1, 1); PG8_STAGE(PG8_SB(1, 0), b3, voffB); PG8_STAGE(PG8_SB(1, 1), b3 + hstep, voffB); PG8_STAGE(PG8_SA(1, 0), a3, voffA);
            PG8_WAIT_V(8); PG8_WAIT_L(0); PG8_BAR; if (!ho) { PG8_MMA(1, 0, At, B0); PG8_MMA(1, 1, At, B1); } PG8_BAR; PG8_SCHED;
            } else {
            PG8_LDB(B0, 0, 0); PG8_SCHED; PG8_LDA(At, 0, 0); PG8_STAGE(PG8_SA(1, 1), a1 + hstep, voffA);
            PG8_WAIT_L(8); PG8_BAR; PG8_WAIT_L(0); PG8_MMA(0, 0, At, B0); PG8_BAR; PG8_SCHED;
            PG8_LDB(B1, 0, 1); PG8_STAGE(PG8_SB(0, 0), b2, voffB);
            PG8_BAR; PG8_WAIT_L(0); PG8_MMA(0, 1, At, B1); PG8_BAR;
            PG8_LDA(At, 0, 1); PG8_STAGE(PG8_SA(0, 0), a2, voffA);
            PG8_BAR; PG8_WAIT_L(0); PG8_MMA(1, 0, At, B0); PG8_BAR; PG8_SCHED;
            PG8_STAGE(PG8_SB(0, 1), b2 + hstep, voffB);
            PG8_WAIT_V(6); PG8_BAR; PG8_MMA(1, 1, At, B1); PG8_BAR;
            PG8_LDB(B0, 1, 0); PG8_SCHED; PG8_LDA(At, 1, 0); PG8_STAGE(PG8_SA(0, 1), a2 + hstep, voffA);
            PG8_WAIT_L(8); PG8_BAR; PG8_WAIT_L(0); PG8_MMA(0, 0, At, B0); PG8_BAR; PG8_SCHED;
            PG8_LDB(B1, 1, 1); PG8_STAGE(PG8_SB(1, 0), b3, voffB);
            PG8_BAR; PG8_WAIT_L(0); PG8_MMA(0, 1, At, B1); PG8_BAR;
            PG8_LDA(At, 1, 1); PG8_STAGE(PG8_SA(1, 0), a3, voffA);
            PG8_BAR; PG8_WAIT_L(0); PG8_MMA(1, 0, At, B0); PG8_BAR; PG8_SCHED;
            PG8_STAGE(PG8_SB(1, 1), b3 + hstep, voffB);
            PG8_WAIT_V(6); PG8_BAR; PG8_MMA(1, 1, At, B1); PG8_BAR;
            }
        }
        if constexpr (ALIGN_EPI) { if (wr == 0) PG8_BAR; }
        if constexpr (!Epi::AFTER_DRAIN) { E(acc, cur, wr, wc, fr, fq); S.done(cur); }
        if (!has_next) break;
#pragma unroll
        for (int a = 0; a < 2; ++a)
#pragma unroll
            for (int b = 0; b < 2; ++b)
#pragma unroll
                for (int m = 0; m < 4; ++m)
#pragma unroll
                    for (int n = 0; n < 2; ++n) acc[a][b][m][n] = (f32x4){0.f, 0.f, 0.f, 0.f};
        cur = nxt; cA = nA; cB = nB; ++ui;
        if constexpr (ALIGN_EPI) { if (wr == 1) PG8_BAR; }
    }
    PG8_WAIT_V(0);
    if constexpr (!ALIGN_EPI) { if (wr == 0) PG8_BAR; }
    PG8_BAR;
    if constexpr (Epi::AFTER_DRAIN) { E.fused(acc, cur, wr, wc, fr, fq, lds, wid, lane); S.done(cur); }
#undef PG8_SA
#undef PG8_SB
#undef PG8_STAGE
#undef PG8_LDA
#undef PG8_LDB
#undef PG8_MMA
#undef PG8_WAIT_V
#undef PG8_WAIT_L
#undef PG8_BAR
#undef PG8_SCHED
}
}
namespace pg8 {
template <class Epi, class Sched>
__device__ __forceinline__ void gemm_phase_ga(PG8_LAS unsigned char* lds, const Gemm g, const Sched& S, const Epi& E, const int* rowidx, int zrow, PG8_LAS int* islot) {
    constexpr bool ALIGN_EPI = true;
    int tid = threadIdx.x; asm volatile("" : "+v"(tid));
    const int wid = __builtin_amdgcn_readfirstlane(tid >> 6), lane = tid & 63, wr = wid >> 2, wc = wid & 3, fr = lane & 15, fq = lane >> 4;
    const int K = g.K, nt = K / BK;
    unsigned voffB[2]; int RA[2], CA[2];
#pragma unroll
    for (int i = 0; i < 2; ++i) { int R, C; stage_rc(tid * 16 + i * 8192, R, C); const int Rb = Epi::PERM ? ((R & ~31) + perm32(R & 31)) : R;
        RA[i] = R; CA[i] = C; voffB[i] = (unsigned)(Rb * K + C) * 2u; }
    unsigned voC[2][2], voN[2][2];
    const size_t kstep = (size_t)(BK * 2);
    const size_t hstep = (size_t)HALF * K * 2;
    const size_t tstep = 2 * hstep;
    const unsigned ldsw = (unsigned)wid * 1024u;
    const int aoff = lds_byte(wr * 64 + fr, fq * 8), boff = lds_byte(wc * 32 + fr, fq * 8);
#define PG8_SA(b, h) (((b) * 2 + (h)) * HTB)
#define PG8_SB(b, h) ((4 + (b) * 2 + (h)) * HTB)
#define PG8_STAGE(bufoff, gbase, voff) do { _Pragma("unroll") for (int _i = 0; _i < 2; ++_i) \
        __builtin_amdgcn_global_load_lds((const unsigned*)((const char*)(gbase) + (voff)[_i]), (PG8_LAS unsigned*)(lds + (bufoff) + ldsw + _i * 8192), 16, 0, 0); } while (0)
#define PG8_LDA(dst, b, h) do { _Pragma("unroll") for (int m = 0; m < 4; ++m) _Pragma("unroll") for (int k = 0; k < 2; ++k) dst[m][k] = *(const PG8_LAS bf16x8*)(lds + PG8_SA(b, h) + aoff + m * 2048 + k * 1024); } while (0)
#define PG8_LDB(dst, b, h) do { _Pragma("unroll") for (int n = 0; n < 2; ++n) _Pragma("unroll") for (int k = 0; k < 2; ++k) dst[n][k] = *(const PG8_LAS bf16x8*)(lds + PG8_SB(b, h) + boff + n * 2048 + k * 1024); } while (0)
#define PG8_MMA(ai, bj, At, Bt) do { __builtin_amdgcn_s_setprio(1); _Pragma("unroll") for (int m = 0; m < 4; ++m) _Pragma("unroll") for (int n = 0; n < 2; ++n) _Pragma("unroll") for (int k = 0; k < 2; ++k) \
        acc[ai][bj][m][n] = __builtin_amdgcn_mfma_f32_16x16x32_bf16(Bt[n][k], At[m][k], acc[ai][bj][m][n], 0, 0, 0); __builtin_amdgcn_s_setprio(0); } while (0)
#define PG8_WAIT_V(n) asm volatile("s_waitcnt vmcnt(" #n ")" ::: "memory")
#define PG8_WAIT_L(n) asm volatile("s_waitcnt lgkmcnt(" #n ")" ::: "memory")
#define PG8_BAR __builtin_amdgcn_s_barrier()
#define PG8_SCHED __builtin_amdgcn_sched_barrier(0)
    constexpr bool SP2 = true;
    Unit cur, nxt; int ui = 0;
    if (!S.next(0, cur)) return;
    f32x4 acc[2][2][4][2];
#pragma unroll
    for (int a = 0; a < 2; ++a)
#pragma unroll
        for (int b = 0; b < 2; ++b)
#pragma unroll
            for (int m = 0; m < 4; ++m)
#pragma unroll
                for (int n = 0; n < 2; ++n) acc[a][b][m][n] = (f32x4){0.f, 0.f, 0.f, 0.f};
    bf16x8 At[4][2], B0[2][2], B1[2][2];
    const char* const Ab = (const char*)g.A; const char* cB = (const char*)g.Bt + (size_t)cur.pn * tstep;
    S.a_ready(cur);
#pragma unroll
    for (int h = 0; h < 2; ++h)
#pragma unroll
        for (int i = 0; i < 2; ++i) { const int s = rowidx[cur.pm * BM + h * HALF + RA[i]]; voC[h][i] = (unsigned)((s < 0 ? zrow : s) * K + CA[i]) * 2u; voN[h][i] = voC[h][i]; }
    asm volatile("s_waitcnt vmcnt(0)" ::: "memory");
    if constexpr (SP2) {
        PG8_STAGE(PG8_SB(0, 0), cB, voffB); PG8_STAGE(PG8_SB(0, 1), cB + hstep, voffB); PG8_STAGE(PG8_SA(0, 0), Ab, voC[0]); PG8_STAGE(PG8_SA(0, 1), Ab, voC[1]);
        if (wr == 1) PG8_BAR;
        PG8_WAIT_V(2); PG8_BAR;
        PG8_STAGE(PG8_SB(1, 0), cB + kstep, voffB); PG8_STAGE(PG8_SA(1, 0), Ab + kstep, voC[0]); PG8_STAGE(PG8_SB(1, 1), cB + hstep + kstep, voffB);
        PG8_WAIT_V(6); PG8_BAR;
    }
    for (;;) {
        const bool has_next = S.next(ui + 1, nxt);
        const bool ho = S.half_only(cur);
        const char* nB = has_next ? (const char*)g.Bt + (size_t)nxt.pn * tstep : cB;
        if (has_next && wid == 0) __builtin_amdgcn_global_load_lds((const unsigned*)(rowidx + nxt.pm * BM + lane * 4), (PG8_LAS unsigned*)(islot + ((ui + 1) & 1) * BM), 16, 0, 0);
        for (int t = 0; t < nt; t += 2) {
            const bool last = (t == nt - 2);
            const char* a1 = Ab + (size_t)(t + 1) * kstep;
            const char* a2 = last ? Ab : Ab + (size_t)(t + 2) * kstep; const char* b2 = last ? nB : cB + (size_t)(t + 2) * kstep;
            const char* a3 = a2 + kstep; const char* b3 = b2 + kstep;
            if (last && has_next) { S.a_ready(nxt);
                const PG8_LAS int* sl = islot + ((ui + 1) & 1) * BM;
#pragma unroll
                for (int h = 0; h < 2; ++h)
#pragma unroll
                    for (int i = 0; i < 2; ++i) { const int s = sl[h * HALF + RA[i]]; voN[h][i] = (unsigned)((s < 0 ? zrow : s) * K + CA[i]) * 2u; } }
            unsigned vo2[2][2];
#pragma unroll
            for (int h = 0; h < 2; ++h)
#pragma unroll
                for (int i = 0; i < 2; ++i) vo2[h][i] = last ? voN[h][i] : voC[h][i];
            if constexpr (SP2) {
            PG8_LDB(B0, 0, 0); PG8_LDB(B1, 0, 1); PG8_SCHED; PG8_LDA(At, 0, 0); PG8_STAGE(PG8_SA(1, 1), a1, voC[1]);
            PG8_WAIT_V(8); PG8_WAIT_L(0); PG8_BAR; PG8_MMA(0, 0, At, B0); PG8_MMA(0, 1, At, B1); PG8_BAR; PG8_SCHED;
            PG8_LDA(At, 0, 1); PG8_STAGE(PG8_SB(0, 0), b2, voffB); PG8_STAGE(PG8_SB(0, 1), b2 + hstep, voffB); PG8_STAGE(PG8_SA(0, 0), a2, vo2[0]);
            PG8_WAIT_V(8); PG8_WAIT_L(0); PG8_BAR; if (!ho) { PG8_MMA(1, 0, At, B0); PG8_MMA(1, 1, At, B1); } PG8_BAR; PG8_SCHED;
            PG8_LDB(B0, 1, 0); PG8_LDB(B1, 1, 1); PG8_SCHED; PG8_LDA(At, 1, 0); PG8_STAGE(PG8_SA(0, 1), a2, vo2[1]);
            PG8_WAIT_V(8); PG8_WAIT_L(0); PG8_BAR; PG8_MMA(0, 0, At, B0); PG8_MMA(0, 1, At, B1); PG8_BAR; PG8_SCHED;
            PG8_LDA(At, 1, 1); PG8_STAGE(PG8_SB(1, 0), b3, voffB); PG8_STAGE(PG8_SB(1, 1), b3 + hstep, voffB); PG8_STAGE(PG8_SA(1, 0), a3, vo2[0]);
            PG8_WAIT_V(8); PG8_WAIT_L(0); PG8_BAR; if (!ho) { PG8_MMA(1, 0, At, B0); PG8_MMA(1, 1, At, B1); } PG8_BAR; PG8_SCHED;
            }
        }
        if constexpr (ALIGN_EPI) { if (wr == 0) PG8_BAR; }
        if constexpr (!Epi::AFTER_DRAIN) { E(acc, cur, wr, wc, fr, fq); S.done(cur); }
        if (!has_next) break;
#pragma unroll
        for (int a = 0; a < 2; ++a)
#pragma unroll
            for (int b = 0; b < 2; ++b)
#pragma unroll
                for (int m = 0; m < 4; ++m)
#pragma unroll
                    for (int n = 0; n < 2; ++n) acc[a][b][m][n] = (f32x4){0.f, 0.f, 0.f, 0.f};
        cur = nxt; cB = nB; ++ui;
#pragma unroll
        for (int h = 0; h < 2; ++h)
#pragma unroll
            for (int i = 0; i < 2; ++i) voC[h][i] = voN[h][i];
        if constexpr (ALIGN_EPI) { if (wr == 1) PG8_BAR; }
    }
    PG8_WAIT_V(0);
    if constexpr (!ALIGN_EPI) { if (wr == 0) PG8_BAR; }
    PG8_BAR;
    if constexpr (Epi::AFTER_DRAIN) { E.fused(acc, cur, wr, wc, fr, fq, lds, wid, lane); S.done(cur); }
#undef PG8_SA
#undef PG8_SB
#undef PG8_STAGE
#undef PG8_LDA
#undef PG8_LDB
#undef PG8_MMA
#undef PG8_WAIT_V
#undef PG8_WAIT_L
#undef PG8_BAR
#undef PG8_SCHED
}
}

constexpr int DM = 1024, NB = 2, SEQ = 8192, CTXL = 256, DEPTH = 4;
constexpr int NLAT = NB * SEQ, NCTX = NB * CTXL, NROW = NLAT + NCTX;
constexpr int INC = 3328, NKEY = CTXL + SEQ;
constexpr int NE = 16, FF = 2048, EROWS = 2304;
constexpr int NCH = 66;
constexpr float EPS = 1e-6f;
constexpr int ZQ = 0, ZK = 512, ZV = 1024, ZRQ = 1536, ZRK = 1792, ZRV = 2048, ZGF = 2304, ZGB = 2560, ZSU = 2816, ZSV = 3072;
constexpr int NWAVES = 8, NTHR = 512;
constexpr int RWLD = DM + 8;

constexpr size_t MiB = 1u << 20;
constexpr size_t WS_CTL = 0, CTL_ZERO_BYTES = 1 * MiB;
constexpr size_t WS_MOD = 1 * MiB;
constexpr size_t WS_LP = WS_MOD + 512 * 1024;
constexpr size_t WS_ROPE = 2 * MiB, WS_RETT = 4 * MiB;
constexpr size_t WS_SGW = 6 * MiB;
constexpr size_t WS_RWS = 7 * MiB;
constexpr size_t WS_WIN = 8 * MiB;
constexpr size_t WS_WOUT = WS_WIN + 26 * MiB;
constexpr size_t WS_WGU = WS_WOUT + 8 * MiB;
constexpr size_t WS_WD = WS_WGU + 512 * MiB;
constexpr size_t WS_X = WS_WD + 256 * MiB;
constexpr size_t WS_HN = WS_X + 66 * MiB;
constexpr size_t WS_Z = WS_HN + 34 * MiB;
constexpr size_t WS_QH = WS_Z + 108 * MiB;
constexpr size_t WS_KH = WS_QH + 17 * MiB;
constexpr size_t WS_VH = WS_KH + 17 * MiB;
constexpr size_t WS_RQ = WS_VH + 17 * MiB;
constexpr size_t WS_RK = WS_RQ + 9 * MiB;
constexpr size_t WS_SVN = WS_RK + 9 * MiB;
constexpr size_t WS_KVT = WS_SVN + 9 * MiB;
constexpr size_t WS_SPREV = WS_KVT + 17 * MiB;
constexpr size_t WS_MIX = WS_SPREV + 17 * MiB;
constexpr size_t WS_SCR = WS_MIX + 33 * MiB;
constexpr size_t WS_AFF = WS_SCR + 32 * MiB;
constexpr size_t WS_SLOT = WS_AFF + 2 * MiB;
constexpr size_t WS_ROWIDX = WS_SLOT + 2 * MiB;
constexpr size_t WS_GATE = WS_ROWIDX + 1 * MiB;
constexpr size_t WS_XS = WS_GATE + 1 * MiB;
constexpr size_t WS_HH = WS_XS + 72 * MiB;
constexpr size_t WS_Y = WS_HH + 144 * MiB;
constexpr size_t WS_END = WS_Y + 72 * MiB;
static_assert((size_t)4 * INC * DM * 2 <= 26 * MiB && (size_t)NROW * DM * 4 <= 66 * MiB && (size_t)NROW * INC * 2 <= 108 * MiB && (size_t)NROW * 512 * 2 <= 17 * MiB, "ws map");
static_assert((size_t)NB * 4 * 2 * NCH * 4096 * 4 <= 17 * MiB && (size_t)NE * EROWS * DM * 2 <= 72 * MiB && (size_t)NE * EROWS * FF * 2 <= 144 * MiB, "ws map");
constexpr int CW_BAR = 4096;

constexpr int RING_BYTES = 131072;
constexpr int MISC_OFF = RING_BYTES + 320;
constexpr int ISLOT_OFF = RING_BYTES + 1024;
constexpr int LDS_BYTES = 147456;

#define GAS __attribute__((address_space(1)))
#define LAS __attribute__((address_space(3)))
typedef unsigned short bf16;
typedef unsigned v4u __attribute__((ext_vector_type(4)));
typedef float f32x4 __attribute__((ext_vector_type(4)));
typedef short bf16x8 __attribute__((ext_vector_type(8)));
typedef GAS unsigned gu32;
typedef GAS unsigned long long gu64;
#define RLX_AGENT __ATOMIC_RELAXED, __HIP_MEMORY_SCOPE_AGENT
#define LDS_WAIT() asm volatile("s_waitcnt lgkmcnt(0)" ::: "memory")
#define VM_WAIT() asm volatile("s_waitcnt vmcnt(0)" ::: "memory")
__device__ __forceinline__ unsigned long long rt() { return __builtin_amdgcn_s_memrealtime(); }
__device__ __forceinline__ unsigned f2bf(float f) { unsigned u = __builtin_bit_cast(unsigned, f); return (u + 0x7fffu + ((u >> 16) & 1u)) >> 16; }
__device__ __forceinline__ unsigned pk2(float lo, float hi) { return f2bf(lo) | (f2bf(hi) << 16); }

#define XB_TMO      128
#define XB_XCNT(j)  (256  + 64 * (j))
#define XB_XSUB(j)  (1280 + 64 * (j))
#define XB_XGEN(j)  (2304 + 64 * (j))
#define XB_TOP      3328
#define XB_TOPGEN   3392
#define XCD_BAR_WORDS 3456
#define XB_SPIN_CAP (1u << 18)

__device__ __forceinline__ unsigned xb_ld(unsigned* p)              { return __hip_atomic_load(p, __ATOMIC_RELAXED, __HIP_MEMORY_SCOPE_AGENT); }
__device__ __forceinline__ unsigned xb_add(unsigned* p, unsigned v) { return __hip_atomic_fetch_add(p, v, __ATOMIC_RELAXED, __HIP_MEMORY_SCOPE_AGENT); }
__device__ __forceinline__ unsigned xb_xcc_id() { return (unsigned)__builtin_amdgcn_s_getreg((3 << 11) | 20) & 0xFu; }
#define XB_SPIN(cond, bar) do { unsigned _sp = 0; while (cond) { __builtin_amdgcn_s_sleep(1); \
    if ((++_sp & 255u) == 0u) { if (xb_ld(&(bar)[XB_TMO])) break; if (_sp > XB_SPIN_CAP) { atomicAdd(&(bar)[XB_TMO], 1u); break; } } } } while (0)

struct XcdBarrier {
    unsigned* bar; unsigned x;
    volatile LAS unsigned* st;
};

__device__ __forceinline__ XcdBarrier xcd_barrier_post(unsigned* bar, volatile LAS unsigned* st) {
    XcdBarrier b; b.bar = bar; b.x = xb_xcc_id(); b.st = st;
    if (threadIdx.x == 0) (void)xb_add(&bar[XB_XCNT(b.x)], 1u);
    return b;
}
__device__ __forceinline__ void xcd_barrier_complete(unsigned* bar, unsigned x, unsigned& nloc, unsigned& nx) {
    const unsigned G = gridDim.x * gridDim.y * gridDim.z;
    unsigned sum, cnt, mine, sp = 0u;
    for (;;) {
        sum = 0u; cnt = 0u; mine = 0u;
#pragma unroll
        for (unsigned j = 0; j < 16; ++j) { const unsigned c = xb_ld(&bar[XB_XCNT(j)]); sum += c; cnt += (c > 0u) ? 1u : 0u; mine = (j == x) ? c : mine; }
        if (sum == G) break;
        __builtin_amdgcn_s_sleep(1);
        if ((++sp & 255u) == 0u) { if (xb_ld(&bar[XB_TMO])) break; if (sp > XB_SPIN_CAP) { atomicAdd(&bar[XB_TMO], 1u); break; } }
    }
    nloc = mine > 0u ? mine : 1u; nx = cnt > 0u ? cnt : 1u;
}

__device__ __forceinline__ void xcd_barrier(const XcdBarrier& b) {
    asm volatile("s_waitcnt vmcnt(0)" ::: "memory");
    __syncthreads();
    if (threadIdx.x == 0) {
        unsigned* bar = b.bar;
        __builtin_amdgcn_s_waitcnt(0);
        unsigned nloc = b.st[0], nx = b.st[1];
        if (nloc == 0u) { xcd_barrier_complete(bar, b.x, nloc, nx); b.st[0] = nloc; b.st[1] = nx; }
        const unsigned old = xb_add(&bar[XB_XSUB(b.x)], 1u);
        const unsigned gen = old / nloc;
        if (old + 1u == (gen + 1u) * nloc) {
            __builtin_amdgcn_fence(__ATOMIC_RELEASE, "agent");
            asm volatile("s_waitcnt vmcnt(0)" ::: "memory");
            const unsigned og = xb_add(&bar[XB_TOP], 1u);
            const unsigned tg = og / nx;
            if (og + 1u == (tg + 1u) * nx) xb_add(&bar[XB_TOPGEN], 1u);
            else XB_SPIN(xb_ld(&bar[XB_TOPGEN]) == tg, bar);
            __builtin_amdgcn_fence(__ATOMIC_ACQUIRE, "agent");
            xb_add(&bar[XB_XGEN(b.x)], 1u);
            asm volatile("s_waitcnt vmcnt(0)" ::: "memory");
        } else {
            XB_SPIN(xb_ld(&bar[XB_XGEN(b.x)]) == gen, bar);
            __builtin_amdgcn_fence(__ATOMIC_ACQUIRE, "agent");
            asm volatile("s_waitcnt vmcnt(0)" ::: "memory");
        }
    }
    __syncthreads();
}

typedef float f32x16 __attribute__((ext_vector_type(16)));
typedef short s16x4 __attribute__((ext_vector_type(4)));
typedef unsigned short u16x4 __attribute__((ext_vector_type(4)));
struct Frame {
    LAS unsigned char* lds;
    int tid, lane, wave, bid, G;
    const float* const* in;
    float* out;
    unsigned char* ws;
    __device__ __forceinline__ const float* x_in() const { return in[0]; }
    __device__ __forceinline__ const float* c_in() const { return in[1]; }
    __device__ __forceinline__ const float* ctx_in() const { return in[2]; }
    __device__ __forceinline__ const float* cctx_in() const { return in[3]; }
    __device__ __forceinline__ const float* w_mod() const { return in[4]; }
    __device__ __forceinline__ const float* b_mod() const { return in[5]; }
    __device__ __forceinline__ const float* n1g() const { return in[6]; }
    __device__ __forceinline__ const float* n2g() const { return in[7]; }
    __device__ __forceinline__ const float* w_in() const { return in[8]; }
    __device__ __forceinline__ const float* w_out() const { return in[9]; }
    __device__ __forceinline__ const float* qng() const { return in[10]; }
    __device__ __forceinline__ const float* kng() const { return in[11]; }
    __device__ __forceinline__ const float* lq1() const { return in[12]; }
    __device__ __forceinline__ const float* lk1() const { return in[13]; }
    __device__ __forceinline__ const float* lq2() const { return in[14]; }
    __device__ __forceinline__ const float* lk2() const { return in[15]; }
    __device__ __forceinline__ const float* subg() const { return in[16]; }
    __device__ __forceinline__ const float* retd() const { return in[17]; }
    __device__ __forceinline__ const float* sgng() const { return in[18]; }
    __device__ __forceinline__ const float* sgw() const { return in[19]; }
    __device__ __forceinline__ const float* sgb() const { return in[20]; }
    __device__ __forceinline__ const float* rw() const { return in[21]; }
    __device__ __forceinline__ const float* wg() const { return in[22]; }
    __device__ __forceinline__ const float* wu() const { return in[23]; }
    __device__ __forceinline__ const float* wd() const { return in[24]; }
    __device__ __forceinline__ float* MOD() const { return (float*)(ws + WS_MOD); }
    __device__ __forceinline__ float* LP() const { return (float*)(ws + WS_LP); }
    __device__ __forceinline__ float* ROPE() const { return (float*)(ws + WS_ROPE); }
    __device__ __forceinline__ float* RETT() const { return (float*)(ws + WS_RETT); }
    __device__ __forceinline__ bf16* X() const { return (bf16*)(ws + WS_X); }
    __device__ __forceinline__ float* KVT() const { return (float*)(ws + WS_KVT); }
    __device__ __forceinline__ float* SPREV() const { return (float*)(ws + WS_SPREV); }
    __device__ __forceinline__ float* SCR() const { return (float*)(ws + WS_SCR); }
    __device__ __forceinline__ float* AFF() const { return (float*)(ws + WS_AFF); }
    __device__ __forceinline__ float* GATE() const { return (float*)(ws + WS_GATE); }
    __device__ __forceinline__ bf16* SGW() const { return (bf16*)(ws + WS_SGW); }
    __device__ __forceinline__ bf16* WIN() const { return (bf16*)(ws + WS_WIN); }
    __device__ __forceinline__ bf16* WOUT() const { return (bf16*)(ws + WS_WOUT); }
    __device__ __forceinline__ bf16* WGU() const { return (bf16*)(ws + WS_WGU); }
    __device__ __forceinline__ bf16* WD() const { return (bf16*)(ws + WS_WD); }
    __device__ __forceinline__ bf16* HN() const { return (bf16*)(ws + WS_HN); }
    __device__ __forceinline__ bf16* Z() const { return (bf16*)(ws + WS_Z); }
    __device__ __forceinline__ bf16* QH() const { return (bf16*)(ws + WS_QH); }
    __device__ __forceinline__ bf16* KH() const { return (bf16*)(ws + WS_KH); }
    __device__ __forceinline__ bf16* VH() const { return (bf16*)(ws + WS_VH); }
    __device__ __forceinline__ bf16* RQ() const { return (bf16*)(ws + WS_RQ); }
    __device__ __forceinline__ bf16* RK() const { return (bf16*)(ws + WS_RK); }
    __device__ __forceinline__ bf16* SVN() const { return (bf16*)(ws + WS_SVN); }
    __device__ __forceinline__ bf16* MIX() const { return (bf16*)(ws + WS_MIX); }
    __device__ __forceinline__ bf16* XS() const { return (bf16*)(ws + WS_XS); }
    __device__ __forceinline__ bf16* HH() const { return (bf16*)(ws + WS_HH); }
    __device__ __forceinline__ bf16* Y() const { return (bf16*)(ws + WS_Y); }
    __device__ __forceinline__ bf16* RWS() const { return (bf16*)(ws + WS_RWS); }
    __device__ __forceinline__ int* SLOT() const { return (int*)(ws + WS_SLOT); }
    __device__ __forceinline__ int* ROWIDX() const { return (int*)(ws + WS_ROWIDX); }
};
__device__ __forceinline__ float bf2f(bf16 v) { return __builtin_bit_cast(float, (unsigned)v << 16); }
__device__ __forceinline__ float wave_sum(float v) {
#pragma unroll
    for (int o = 1; o < 64; o <<= 1) v += __shfl_xor(v, o);
    return v;
}
__device__ __forceinline__ float half_sum32(float v) {
#pragma unroll
    for (int o = 1; o < 32; o <<= 1) v += __shfl_xor(v, o);
    return v;
}
__device__ __forceinline__ float wave_max(float v) {
#pragma unroll
    for (int o = 1; o < 64; o <<= 1) v = fmaxf(v, __shfl_xor(v, o));
    return v;
}
__device__ __forceinline__ int crow(int r, int hi) { return (r & 3) + 8 * (r >> 2) + 4 * hi; }
__device__ __forceinline__ float gelu_t(float x) {
    const float u = 0.7978845608028654f * (x + 0.044715f * x * x * x);
    const float t = 1.f - 2.f * __builtin_amdgcn_rcpf(1.f + __expf(2.f * u));
    return 0.5f * x * (1.f + t);
}
__device__ __forceinline__ float silu_f(float x) { return x * __builtin_amdgcn_rcpf(1.f + __expf(-x)); }
__device__ __forceinline__ int row_vec(int r) { return r < SEQ ? 0 : (r < NLAT ? 1 : 2); }
__device__ __forceinline__ int chunk_row0(int b, int cc) { return cc < 2 ? NLAT + b * CTXL + cc * 128 : b * SEQ + (cc - 2) * 128; }

__device__ __forceinline__ f32x16 mma_nt(const LAS bf16* A, int lda, const LAS bf16* B, int ldb, int K, f32x16 acc, int lane) {
    const int r = lane & 31, h = lane >> 5;
#pragma unroll 2
    for (int k0 = 0; k0 < K; k0 += 16) {
        const bf16x8 a = *(const LAS bf16x8*)(A + r * lda + k0 + 8 * h);
        const bf16x8 b = *(const LAS bf16x8*)(B + r * ldb + k0 + 8 * h);
        acc = __builtin_amdgcn_mfma_f32_32x32x16_bf16(a, b, acc, 0, 0, 0);
    }
    return acc;
}

constexpr float QSCALE = 0.125f * 1.4426950408889634f;
struct EpiResid {
    static constexpr bool PERM = true, AFTER_DRAIN = false;
    bf16* X; const float* modg;
    const float* Xin;
    __device__ __forceinline__ void operator()(const pg8::f32x4 (&acc)[2][2][4][2], const pg8::Unit& u, int wr, int wc, int fr, int fq) const {
        const int row0 = u.pm * 256 + wr * 64 + fr, col0 = u.pn * 256 + wc * 32 + 8 * fq;
        const int v = u.pm < 32 ? 0 : (u.pm < 64 ? 1 : 2);
        pg8::f32x4 gv[2][2];
#pragma unroll
        for (int bj = 0; bj < 2; ++bj)
#pragma unroll
            for (int n = 0; n < 2; ++n) gv[bj][n] = *(const pg8::f32x4*)(modg + v * 6144 + col0 + bj * 128 + 4 * n);
        const bool in32 = Xin != nullptr;
#pragma unroll
        for (int ai = 0; ai < 2; ++ai)
#pragma unroll
            for (int m = 0; m < 4; ++m) { const size_t off = (size_t)(row0 + ai * 128 + m * 16) * DM + col0;
#pragma unroll
                for (int bj = 0; bj < 2; ++bj) {
                    pg8::f32x4 x0, x1;
                    if (in32) { x0 = *(const pg8::f32x4*)(Xin + off + bj * 128); x1 = *(const pg8::f32x4*)(Xin + off + bj * 128 + 4); }
                    else { const pg8::u32x4 w = *(const pg8::u32x4*)(X + off + bj * 128);
                        x0 = (pg8::f32x4){__builtin_bit_cast(float, w.x << 16), __builtin_bit_cast(float, w.x & 0xffff0000u), __builtin_bit_cast(float, w.y << 16), __builtin_bit_cast(float, w.y & 0xffff0000u)};
                        x1 = (pg8::f32x4){__builtin_bit_cast(float, w.z << 16), __builtin_bit_cast(float, w.z & 0xffff0000u), __builtin_bit_cast(float, w.w << 16), __builtin_bit_cast(float, w.w & 0xffff0000u)}; }
                    x0 = x0 + gv[bj][0] * acc[ai][bj][m][0]; x1 = x1 + gv[bj][1] * acc[ai][bj][m][1];
                    pg8::u32x4 o; o.x = pg8::cvt_pk_bf16(x0.x, x0.y); o.y = pg8::cvt_pk_bf16(x0.z, x0.w); o.z = pg8::cvt_pk_bf16(x1.x, x1.y); o.w = pg8::cvt_pk_bf16(x1.z, x1.w);
                    *(pg8::u32x4*)(X + off + bj * 128) = o; } }
    }
};
struct EpiZ {
    static constexpr bool PERM = true, AFTER_DRAIN = false;
    bf16* Z; bf16* VH; bf16* QH; bf16* KH; const float* gqk; const float* rope;
    __device__ __forceinline__ void operator()(const pg8::f32x4 (&acc)[2][2][4][2], const pg8::Unit& u, int wr, int wc, int fr, int fq) const {
        if (u.pn < 4) {
            const bool isk = u.pn >= 2; const int grp = (u.pn & 1) * 4 + wc;
            const float* g = gqk + (isk ? 64 : 0); const float sc = isk ? 1.f : QSCALE;
            float ga[2][8];
#pragma unroll
            for (int bj = 0; bj < 2; ++bj)
#pragma unroll
                for (int e = 0; e < 8; ++e) ga[bj][e] = g[32 * bj + 8 * fq + e] * sc;
            const bool first = fq < 2; const int i16 = 8 * (fq & 1);
            const bool lat = u.pm < 64;
#pragma unroll
            for (int ai = 0; ai < 2; ++ai) {
                float rc[8], rn[8];
                if (lat) { const float* T = rope + (size_t)(((u.pm * 256 + ai * 128 + wr * 64) & (SEQ - 1)) & ~63) * 64 + i16;
                    const pg8::f32x4 c0 = *(const pg8::f32x4*)T, c1 = *(const pg8::f32x4*)(T + 4), s0 = *(const pg8::f32x4*)(T + 32), s1 = *(const pg8::f32x4*)(T + 36);
#pragma unroll
                    for (int e = 0; e < 4; ++e) { rc[e] = c0[e]; rc[4 + e] = c1[e]; rn[e] = s0[e]; rn[4 + e] = s1[e]; } }
#pragma unroll
                for (int m = 0; m < 4; ++m) {
                    float ccm[8], cnm[8];
                    if (lat) { const float* T = rope + (size_t)(m * 16 + fr) * 64 + 16 + i16;
                        const pg8::f32x4 c0 = *(const pg8::f32x4*)T, c1 = *(const pg8::f32x4*)(T + 4), s0 = *(const pg8::f32x4*)(T + 32), s1 = *(const pg8::f32x4*)(T + 36);
#pragma unroll
                        for (int e = 0; e < 4; ++e) { ccm[e] = c0[e]; ccm[4 + e] = c1[e]; cnm[e] = s0[e]; cnm[4 + e] = s1[e]; } }
                    const int r = u.pm * 256 + ai * 128 + wr * 64 + m * 16 + fr;
                    const int b = lat ? (r >> 13) : ((r - NLAT) >> 8), n = lat ? (r & (SEQ - 1)) : ((r - NLAT) & (CTXL - 1));
                    float v[2][8]; float ss = 0.f;
#pragma unroll
                    for (int bj = 0; bj < 2; ++bj)
#pragma unroll
                        for (int e = 0; e < 8; ++e) { v[bj][e] = acc[ai][bj][m][e >> 2][e & 3]; ss += v[bj][e] * v[bj][e]; }
                    ss += __shfl_xor(ss, 16);
                    { const auto sw = __builtin_amdgcn_permlane32_swap(__float_as_uint(ss), __float_as_uint(ss), false, false); ss = __uint_as_float(sw[0]) + __uint_as_float(sw[1]); }
                    const float rinv = __builtin_amdgcn_rsqf(ss * (1.f / 64.f) + EPS);
                    bf16* dst = (isk ? KH + ((size_t)b * NKEY + (lat ? CTXL + n : n)) * 512 : QH + (size_t)r * 512) + grp * 64 + 8 * fq;
#pragma unroll
                    for (int bj = 0; bj < 2; ++bj) {
                        float y[8], o[8];
#pragma unroll
                        for (int e = 0; e < 8; ++e) y[e] = v[bj][e] * rinv * ga[bj][e];
                        if (lat) {
#pragma unroll
                            for (int e = 0; e < 8; ++e) { const auto sw = __builtin_amdgcn_permlane32_swap(__float_as_uint(y[e]), __float_as_uint(y[e]), false, false);
                                const float pp = __uint_as_float(first ? sw[1] : sw[0]); const float c = bj ? ccm[e] : rc[e], s = bj ? cnm[e] : rn[e];
                                o[e] = first ? y[e] * c - pp * s : pp * s + y[e] * c; }
                        } else {
#pragma unroll
                            for (int e = 0; e < 8; ++e) o[e] = y[e];
                        }
                        pg8::u32x4 w; w.x = pg8::cvt_pk_bf16(o[0], o[1]); w.y = pg8::cvt_pk_bf16(o[2], o[3]); w.z = pg8::cvt_pk_bf16(o[4], o[5]); w.w = pg8::cvt_pk_bf16(o[6], o[7]);
                        *(pg8::u32x4*)(dst + 32 * bj) = w;
                    }
                }
            }
            return;
        }
        const bool isv = (u.pn == 4) | (u.pn == 5);
        const size_t prow0 = isv ? (u.pm < 64 ? (size_t)u.pm * 256 + (size_t)((u.pm >> 5) + 1) * CTXL : (size_t)(u.pm - 64) * NKEY) : (size_t)u.pm * 256;
        bf16* base = isv ? VH + (u.pn - 4) * 256 : Z + u.pn * 256; const int ldc = isv ? 512 : INC;
        const int col0 = wc * 32 + 8 * fq;
#pragma unroll
        for (int ai = 0; ai < 2; ++ai)
#pragma unroll
            for (int m = 0; m < 4; ++m) { bf16* rowp = base + (prow0 + wr * 64 + fr + ai * 128 + m * 16) * ldc + col0;
#pragma unroll
                for (int bj = 0; bj < 2; ++bj) { const pg8::f32x4 v0 = acc[ai][bj][m][0], v1 = acc[ai][bj][m][1];
                    pg8::u32x4 w; w.x = pg8::cvt_pk_bf16(v0[0], v0[1]); w.y = pg8::cvt_pk_bf16(v0[2], v0[3]); w.z = pg8::cvt_pk_bf16(v1[0], v1[1]); w.w = pg8::cvt_pk_bf16(v1[2], v1[3]);
                    *(pg8::u32x4*)(rowp + bj * 128) = w; } }
    }
};
struct EpiSwiglu {
    static constexpr bool PERM = true, AFTER_DRAIN = false;
    bf16* H;
    __device__ __forceinline__ void operator()(const pg8::f32x4 (&acc)[2][2][4][2], const pg8::Unit& u, int wr, int wc, int fr, int fq) const {
        const int row0 = u.pm * 256 + wr * 64 + fr, col0 = (u.pn & 15) * 128 + wc * 32 + 8 * fq;
#pragma unroll
        for (int ai = 0; ai < 2; ++ai)
#pragma unroll
            for (int m = 0; m < 4; ++m) { bf16* rowp = H + (size_t)(row0 + ai * 128 + m * 16) * FF + col0;
                float h[8];
#pragma unroll
                for (int n = 0; n < 2; ++n)
#pragma unroll
                    for (int i = 0; i < 4; ++i) { const float g = acc[ai][0][m][n][i], up = acc[ai][1][m][n][i]; h[4 * n + i] = silu_f(g) * up; }
                pg8::u32x4 w; w.x = pg8::cvt_pk_bf16(h[0], h[1]); w.y = pg8::cvt_pk_bf16(h[2], h[3]); w.z = pg8::cvt_pk_bf16(h[4], h[5]); w.w = pg8::cvt_pk_bf16(h[6], h[7]);
                *(pg8::u32x4*)rowp = w; }
    }
};
struct MoeOrder {
    int G, c, npn, npm, total;
    __device__ __forceinline__ bool next(int i, pg8::Unit& u) const {
        const int per = npm * npn;
        if ((G & 7) == 0) {
            const int W = G >> 3, x = c & 7, r = c >> 3, q = i * W + r;
            if (q >= 2 * per) return false;
            const int e = 2 * x + q / per, rem = q % per, pn = rem / npm, pm = rem % npm;
            u.pm = e * 9 + pm; u.pn = e * npn + pn; return true;
        }
        const long L = (long)i * G + c; if (L >= total) return false;
        const int e = (int)L / per, rem = (int)L % per; const int pn = rem / npm, pm = rem % npm;
        u.pm = e * 9 + pm; u.pn = e * npn + pn; return true;
    }
    __device__ __forceinline__ void a_ready(const pg8::Unit&) const {}
    __device__ __forceinline__ void done(const pg8::Unit&) const {}
    __device__ __forceinline__ bool half_only(const pg8::Unit& u) const { return (u.pm % 9) == 8; }
};

__device__ __forceinline__ void transpose_item(const float* W, int N, bf16* WT, int K, int k0, int n0, size_t drow0, LAS float* scr, int lane) {
    f32x4 v[8];
#pragma unroll
    for (int i = 0; i < 8; ++i) v[i] = __builtin_nontemporal_load((const f32x4*)(W + (size_t)(k0 + 8 * i + (lane >> 3)) * N + n0 + 4 * (lane & 7)));
#pragma unroll
    for (int i = 0; i < 8; ++i) { LAS float* d = scr + (8 * i + (lane >> 3)) * 33 + 4 * (lane & 7); d[0] = v[i].x; d[1] = v[i].y; d[2] = v[i].z; d[3] = v[i].w; }
    LDS_WAIT(); asm volatile("" ::: "memory");
    const int c = lane & 7;
#pragma unroll
    for (int j = 0; j < 4; ++j) { const int n = (lane >> 3) + 8 * j; const LAS float* s = scr + (8 * c) * 33 + n;
        v4u o; o.x = pk2(s[0 * 33], s[1 * 33]); o.y = pk2(s[2 * 33], s[3 * 33]); o.z = pk2(s[4 * 33], s[5 * 33]); o.w = pk2(s[6 * 33], s[7 * 33]);
        *(GAS v4u*)(WT + (drow0 + n) * K + k0 + 8 * c) = o; }
    LDS_WAIT(); asm volatile("" ::: "memory");
}
constexpr unsigned CV_IN = 16 * 104, CV_OUT = 16 * 32, CV_EX = 1024;
constexpr unsigned CONV_SEG0 = DEPTH * (CV_IN + CV_OUT), CONV_PER_L = 3 * NE * CV_EX, CONV_TOTAL = CONV_SEG0 + DEPTH * CONV_PER_L;
constexpr int CW_Q = 64;
static_assert(CONV_TOTAL % 64 == 0, "whole batches");
__device__ __forceinline__ void conv_item(const Frame& F, unsigned it, LAS float* scr, int lane) {
    if (it < DEPTH * CV_IN) { const int L = it / CV_IN, q = it % CV_IN, kb = q / 104, nb = q % 104, n0 = nb * 32;
        const size_t drow0 = n0 < 1024 ? (size_t)(n0 & ~255) + 128 * ((n0 & 63) >> 5) + 32 * ((n0 & 255) >> 6) : (size_t)n0;
        transpose_item(F.w_in() + (size_t)L * DM * INC, INC, F.WIN() + (size_t)L * INC * DM, DM, kb * 64, n0, drow0, scr, lane); return; }
    it -= DEPTH * CV_IN;
    if (it < DEPTH * CV_OUT) { const int L = it / CV_OUT, q = it % CV_OUT, kb = q / 32, nb = q % 32;
        transpose_item(F.w_out() + (size_t)L * DM * DM, DM, F.WOUT() + (size_t)L * DM * DM, DM, kb * 64, nb * 32, (size_t)nb * 32, scr, lane); return; }
    it -= DEPTH * CV_OUT;
    const int L = it / CONV_PER_L, q0 = it % CONV_PER_L, kind = q0 / (NE * CV_EX), r = q0 % (NE * CV_EX), le = L * NE + r / CV_EX, q = r % CV_EX;
    if (kind < 2) { const int kb = q / 64, nb = q % 64, n0 = nb * 32;
        const size_t drow0 = (size_t)(n0 >> 7) * 256 + (n0 & 127) + (kind ? 128 : 0);
        transpose_item((kind ? F.wu() : F.wg()) + (size_t)le * DM * FF, FF, F.WGU() + (size_t)le * 4096 * DM, DM, kb * 64, n0, drow0, scr, lane); }
    else { const int kb = q / 32, nb = q % 32;
        transpose_item(F.wd() + (size_t)le * FF * DM, DM, F.WD() + (size_t)le * DM * FF, FF, kb * 64, nb * 32, (size_t)nb * 32, scr, lane); }
}
__device__ __forceinline__ bool conv_batch(const Frame& F) {
    LAS unsigned* bc = (LAS unsigned*)(F.lds + MISC_OFF + 64);
    LAS float* scr = (LAS float*)(F.lds + 32768 + F.wave * 8704);
    if (F.tid == 0) *bc = __hip_atomic_fetch_add((unsigned*)(F.ws + WS_CTL) + CW_Q, 64u, __ATOMIC_RELAXED, __HIP_MEMORY_SCOPE_AGENT);
    __syncthreads();
    const unsigned base = *bc;
    __syncthreads();
    if (base >= CONV_TOTAL) return false;
    for (int k = 0; k < 8; ++k) conv_item(F, base + 8 * k + F.wave, scr, F.lane);
    return true;
}
__device__ __forceinline__ void conv_n(const Frame& F, int n) { for (int i = 0; i < n; ++i) if (!conv_batch(F)) break; __syncthreads(); }
__device__ __forceinline__ void conv_until(const Frame& F, unsigned target) {
    for (;;) {
        const unsigned h = __hip_atomic_load((unsigned*)(F.ws + WS_CTL) + CW_Q, __ATOMIC_RELAXED, __HIP_MEMORY_SCOPE_AGENT);
        LAS unsigned* bc = (LAS unsigned*)(F.lds + MISC_OFF + 68);
        if (F.tid == 0) *bc = h;
        __syncthreads();
        const unsigned hh = *bc;
        __syncthreads();
        if (hh >= target) break;
        if (!conv_batch(F)) break;
    }
}
__device__ __forceinline__ void ph_prologue(const Frame& F) {
    const int tid = F.tid, lane = F.lane, wave = F.wave;
    LAS float* sc = (LAS float*)F.lds;
    LAS float* red = sc + 3072;
    for (int i = tid; i < 3072; i += NTHR) { const int v = i >> 10, k = i & 1023; const float c = v < 2 ? F.c_in()[v * DM + k] : F.cctx_in()[k]; sc[i] = c / (1.f + expf(-c)); }
    __syncthreads();
    for (int t = F.bid; t < 384; t += F.G) {
        const int L = t / 96, j0 = (t % 96) * 64;
        const float* W = F.w_mod() + (size_t)L * DM * 6144 + j0 + lane;
        float a0 = 0.f, a1 = 0.f, a2 = 0.f;
#pragma unroll 8
        for (int kk = 0; kk < 128; ++kk) { const int k = wave * 128 + kk; const float w = W[(size_t)k * 6144]; a0 += sc[k] * w; a1 += sc[1024 + k] * w; a2 += sc[2048 + k] * w; }
        red[(wave * 3 + 0) * 64 + lane] = a0; red[(wave * 3 + 1) * 64 + lane] = a1; red[(wave * 3 + 2) * 64 + lane] = a2;
        __syncthreads();
        if (tid < 192) { const int v = tid >> 6, l = tid & 63; float s = 0.f;
#pragma unroll
            for (int w = 0; w < 8; ++w) s += red[(w * 3 + v) * 64 + l];
            F.MOD()[(size_t)(L * 3 + v) * 6144 + j0 + l] = s + F.b_mod()[L * 6144 + j0 + l]; }
        __syncthreads();
    }
    if (F.bid == 0 && wave == 0) {
        for (int L = 0; L < DEPTH; ++L) {
            const float d1 = wave_sum(F.lq1()[L * 64 + lane] * F.lk1()[L * 64 + lane]), d2 = wave_sum(F.lq2()[L * 64 + lane] * F.lk2()[L * 64 + lane]);
            const float linit = 0.8f - 0.6f * expf(-0.3f * (float)L);
            if (lane == 0) { F.LP()[L * 16 + 0] = expf(d1) - expf(d2) + linit; F.LP()[L * 16 + 1] = 1.f - linit; }
            if (lane < 8) { const float xd = F.retd()[L * 8 + lane]; F.LP()[L * 16 + 2 + lane] = -log1pf(expf(-xd)); }
            F.LP()[DEPTH * 16 + L * 128 + lane] = F.qng()[L * 64 + lane]; F.LP()[DEPTH * 16 + L * 128 + 64 + lane] = F.kng()[L * 64 + lane];
            { const float mq = wave_max(fabsf(F.qng()[L * 64 + lane])), mk = wave_max(fabsf(F.kng()[L * 64 + lane])); if (lane == 0) F.LP()[L * 16 + 10] = 64.f * mq * mk * 1.02f; }
        }
    }
    const int gw = F.bid * NWAVES + wave, NGW = F.G * NWAVES;
    {
        const int i16 = lane & 15, which = lane >> 4, i32 = lane & 31;
        const float inv_a = powf(10000.f, -(float)i16 / 16.f);
        const float inv_r = 1.f / powf(10000.f, (float)i32 / 31.f);
        for (int n = gw; n < SEQ; n += NGW) {
            const float pos = (which & 1) ? (float)(n & 63) : (float)(n >> 6);
            const float ang = pos * inv_a;
            F.ROPE()[(size_t)n * 64 + lane] = (which < 2) ? (float)cos((double)ang) : (float)sin((double)ang);
            const float ang2 = (float)n * inv_r;
            F.RETT()[(size_t)n * 64 + lane] = (lane < 32) ? (float)cos((double)ang2) : (float)sin((double)ang2);
        }
    }
    if (F.bid == 0) for (int i = tid; i < DM / 2; i += NTHR) ((unsigned*)(F.HN() + (size_t)NROW * DM))[i] = 0u;
    for (int i = F.bid * NTHR + tid; i < DEPTH * 16 * DM; i += F.G * NTHR) { const int Lr = i / (16 * DM), q = i % (16 * DM), k = q >> 4, e = q & 15;
        const float w = F.rw()[i]; const unsigned h = f2bf(w); const float wl = w - __builtin_bit_cast(float, h << 16);
        F.RWS()[((size_t)(Lr * 2 + 0) * 16 + e) * RWLD + k] = (bf16)h; F.RWS()[((size_t)(Lr * 2 + 1) * 16 + e) * RWLD + k] = (bf16)f2bf(wl); }
    for (int i = F.bid * NTHR + tid; i < DEPTH * 4 * 128 * 128; i += F.G * NTHR) F.SGW()[i] = (bf16)f2bf(F.sgw()[i]);
    conv_until(F, CONV_SEG0);
}

__device__ __forceinline__ void ph_norm1_first(const Frame& F) {
    const int lane = F.lane, gw = F.bid * NWAVES + F.wave, NGW = F.G * NWAVES;
    for (int r = gw; r < NROW; r += NGW) {
        const float* src = r < NLAT ? F.x_in() + (size_t)r * DM : F.ctx_in() + (size_t)(r - NLAT) * DM;
        const float* mod = F.MOD() + (size_t)row_vec(r) * 6144;
        f32x4 v[4]; float ss = 0.f;
#pragma unroll
        for (int j = 0; j < 4; ++j) { v[j] = *(const f32x4*)(src + 4 * lane + 256 * j); ss += (v[j].x * v[j].x + v[j].y * v[j].y) + (v[j].z * v[j].z + v[j].w * v[j].w); }
        const float rinv = rsqrtf(wave_sum(ss) * (1.f / DM) + EPS);
#pragma unroll
        for (int j = 0; j < 4; ++j) { const int c = 4 * lane + 256 * j;
            const f32x4 g = *(const f32x4*)(F.n1g() + c), sh = *(const f32x4*)(mod + c), sc = *(const f32x4*)(mod + 1024 + c);
            const f32x4 h = v[j] * rinv * g * (sc + 1.f) + sh;
            *(unsigned long long*)(F.HN() + (size_t)r * DM + c) = (unsigned long long)pk2(h.x, h.y) | ((unsigned long long)pk2(h.z, h.w) << 32); }
    }
}

__device__ __forceinline__ void ph_prep(const Frame& F, int L) {
    const int lane = F.lane, gw = F.bid * NWAVES + F.wave, NGW = F.G * NWAVES;
    const int grp8 = lane >> 3, half = (lane >> 2) & 1, t4 = lane & 3, dA = half * 32 + 4 * t4;
    const f32x4 gqA = *(const f32x4*)(F.qng() + L * 64 + dA), gqB = *(const f32x4*)(F.qng() + L * 64 + dA + 16);
    const f32x4 gkA = *(const f32x4*)(F.kng() + L * 64 + dA), gkB = *(const f32x4*)(F.kng() + L * 64 + dA + 16);
    const int rsel = lane >> 5, rhead = (lane >> 3) & 3, t8 = lane & 7;
    const float rscale = rsel ? 0.125f : 1.f;
    const f32x4 sgn = *(const f32x4*)(F.sgng() + L * 256 + lane * 4);
    for (int r = gw; r < NROW; r += NGW) {
        const bf16* zr = F.Z() + (size_t)r * INC;
        const bool lat = r < NLAT; const int b = lat ? (r >> 13) : ((r - NLAT) >> 8), n = lat ? (r & (SEQ - 1)) : ((r - NLAT) & (CTXL - 1));
        const size_t krow = (size_t)b * NKEY + (lat ? CTXL + n : n);
        f32x4 cs = {1.f, 1.f, 1.f, 1.f}, sn = {0.f, 0.f, 0.f, 0.f}, cs2 = cs, sn2 = sn;
        if (lat) { const float* T = F.ROPE() + (size_t)n * 64; cs = *(const f32x4*)(T + half * 16 + 4 * t4); sn = *(const f32x4*)(T + 32 + half * 16 + 4 * t4);
                   const float* R = F.RETT() + (size_t)n * 64; cs2 = *(const f32x4*)(R + 4 * t8); sn2 = *(const f32x4*)(R + 32 + 4 * t8); }
#pragma unroll
        for (int pass = 0; pass < 2; ++pass) {
            const int col = pass * 512 + grp8 * 64 + dA;
            const u16x4 ra = *(const u16x4*)(zr + col), rb = *(const u16x4*)(zr + col + 16);
            f32x4 x1, x2; float ss = 0.f;
#pragma unroll
            for (int e = 0; e < 4; ++e) { x1[e] = bf2f(ra[e]); x2[e] = bf2f(rb[e]); ss += x1[e] * x1[e] + x2[e] * x2[e]; }
            ss += __shfl_xor(ss, 1); ss += __shfl_xor(ss, 2); ss += __shfl_xor(ss, 4);
            const float rinv = rsqrtf(ss * (1.f / 64.f) + EPS);
            const f32x4 y1 = x1 * rinv * (pass ? gkA : gqA * QSCALE), y2 = x2 * rinv * (pass ? gkB : gqB * QSCALE);
            const f32x4 o1 = y1 * cs - y2 * sn, o2 = y1 * sn + y2 * cs;
            bf16* dst = (pass ? F.KH() + krow * 512 : F.QH() + (size_t)r * 512) + grp8 * 64 + dA;
            *(unsigned long long*)dst = (unsigned long long)pk2(o1.x, o1.y) | ((unsigned long long)pk2(o1.z, o1.w) << 32);
            *(unsigned long long*)(dst + 16) = (unsigned long long)pk2(o2.x, o2.y) | ((unsigned long long)pk2(o2.z, o2.w) << 32);
        }
    }
}

__device__ __forceinline__ void ph_norm2_router(const Frame& F, int L) {
    const int lane = F.lane, tid = F.tid, gw = F.bid * NWAVES + F.wave, NGW = F.G * NWAVES;
    LAS bf16* rwl = (LAS bf16*)F.lds;
    { const bf16* src = F.RWS() + (size_t)L * 2 * 16 * RWLD;
      for (int i = tid; i < 2 * 16 * RWLD / 8; i += NTHR) *(LAS bf16x8*)(rwl + i * 8) = *(const bf16x8*)(src + i * 8); }
    __syncthreads();
    const int ntile = ((L == DEPTH - 1) ? NLAT : NROW) / 16;
    const int rr = lane & 15, kq = lane >> 4;
    for (int tile = gw; tile < ntile; tile += NGW) {
        const int r = tile * 16 + rr;
        const bf16* xr = F.X() + (size_t)r * DM + 8 * kq;
        const float* mod = F.MOD() + (size_t)(L * 3 + row_vec(tile * 16)) * 6144 + 8 * kq;
        const float* gn = F.n2g() + L * DM + 8 * kq;
        float ss = 0.f;
#pragma unroll 8
        for (int st = 0; st < 32; ++st) { const v4u w = *(const v4u*)(xr + 32 * st);
            const f32x4 a = {__builtin_bit_cast(float, w.x << 16), __builtin_bit_cast(float, w.x & 0xffff0000u), __builtin_bit_cast(float, w.y << 16), __builtin_bit_cast(float, w.y & 0xffff0000u)};
            const f32x4 c = {__builtin_bit_cast(float, w.z << 16), __builtin_bit_cast(float, w.z & 0xffff0000u), __builtin_bit_cast(float, w.w << 16), __builtin_bit_cast(float, w.w & 0xffff0000u)};
            ss += (a.x * a.x + a.y * a.y) + (a.z * a.z + a.w * a.w) + (c.x * c.x + c.y * c.y) + (c.z * c.z + c.w * c.w); }
        ss += __shfl_xor(ss, 16); ss += __shfl_xor(ss, 32);
        const float rinv = rsqrtf(ss * (1.f / DM) + EPS);
        f32x4 acc = {0.f, 0.f, 0.f, 0.f};
        bf16* hrow = F.HN() + (size_t)r * DM + 8 * kq;
#pragma unroll 4
        for (int st = 0; st < 32; ++st) {
            float f[8];
            const v4u xw = *(const v4u*)(xr + 32 * st);
#pragma unroll
            for (int q = 0; q < 2; ++q) { const unsigned w0 = q ? xw.z : xw.x, w1 = q ? xw.w : xw.y;
                const f32x4 xv = {__builtin_bit_cast(float, w0 << 16), __builtin_bit_cast(float, w0 & 0xffff0000u), __builtin_bit_cast(float, w1 << 16), __builtin_bit_cast(float, w1 & 0xffff0000u)};
                const f32x4 g = *(const f32x4*)(gn + 32 * st + 4 * q),
                                                      sh = *(const f32x4*)(mod + 3072 + 32 * st + 4 * q), sc = *(const f32x4*)(mod + 4096 + 32 * st + 4 * q);
                const f32x4 y = xv * rinv * g * (sc + 1.f) + sh; f[4 * q] = y.x; f[4 * q + 1] = y.y; f[4 * q + 2] = y.z; f[4 * q + 3] = y.w; }
            v4u hi, lo;
            hi.x = pk2(f[0], f[1]); hi.y = pk2(f[2], f[3]); hi.z = pk2(f[4], f[5]); hi.w = pk2(f[6], f[7]);
#define LOPK(w, i0, i1) pk2(f[i0] - __builtin_bit_cast(float, (w) << 16), f[i1] - __builtin_bit_cast(float, (w) & 0xffff0000u))
            lo.x = LOPK(hi.x, 0, 1); lo.y = LOPK(hi.y, 2, 3); lo.z = LOPK(hi.z, 4, 5); lo.w = LOPK(hi.w, 6, 7);
#undef LOPK
            *(v4u*)(hrow + 32 * st) = hi;
            const bf16x8 ah = __builtin_bit_cast(bf16x8, hi), al = __builtin_bit_cast(bf16x8, lo);
            const bf16x8 bh = *(const LAS bf16x8*)(rwl + rr * RWLD + 32 * st + 8 * kq), bl = *(const LAS bf16x8*)(rwl + (16 + rr) * RWLD + 32 * st + 8 * kq);
            acc = __builtin_amdgcn_mfma_f32_16x16x32_bf16(ah, bh, acc, 0, 0, 0);
            acc = __builtin_amdgcn_mfma_f32_16x16x32_bf16(ah, bl, acc, 0, 0, 0);
            acc = __builtin_amdgcn_mfma_f32_16x16x32_bf16(al, bh, acc, 0, 0, 0);
        }
#pragma unroll
        for (int q = 0; q < 4; ++q) {
            float mx = acc[q];
#pragma unroll
            for (int o = 1; o < 16; o <<= 1) mx = fmaxf(mx, __shfl_xor(mx, o));
            const float ex = expf(acc[q] - mx); float sum = ex;
#pragma unroll
            for (int o = 1; o < 16; o <<= 1) sum += __shfl_xor(sum, o);
            F.AFF()[(size_t)(tile * 16 + 4 * kq + q) * 16 + rr] = ex / sum;
        }
    }
    __syncthreads();
}

__device__ __forceinline__ unsigned block_excl_scan(unsigned v, LAS unsigned* wtot, int lane, int wave) {
    unsigned inc = v;
#pragma unroll
    for (int o = 1; o < 64; o <<= 1) { const unsigned t = __shfl_up(inc, o); if (lane >= o) inc += t; }
    if (lane == 63) wtot[wave] = inc;
    __syncthreads();
    unsigned off = 0;
    for (int w = 0; w < wave; ++w) off += wtot[w];
    __syncthreads();
    return off + inc - v;
}
__device__ __forceinline__ void ph_topk(const Frame& F, int L) {
    const int tid = F.tid, lane = F.lane, wave = F.wave;
    LAS unsigned* keys = (LAS unsigned*)F.lds;
    LAS unsigned* hist = keys + 8192;
    LAS unsigned* wtot = hist + 256;
    LAS unsigned* bc = wtot + 16;
    const int nprob = (L == DEPTH - 1) ? 32 : 64;
    for (int p = F.bid; p < 64; p += F.G) {
        const int s = p >> 4, e = p & 15;
        const int n = s < 2 ? SEQ : CTXL, k = n >> 3;
        const int base = s < 2 ? s * SEQ : NLAT + (s - 2) * CTXL;
        const int sbase = s == 0 ? 0 : (s == 1 ? 1024 : (s == 2 ? 2048 : 2080));
        if (p >= nprob) {
            for (int i = tid; i < 32; i += NTHR) { F.ROWIDX()[e * EROWS + sbase + i] = -1; F.GATE()[e * EROWS + sbase + i] = 0.f; }
            if (s == 3) for (int rr = 2112 + tid; rr < EROWS; rr += NTHR) { F.ROWIDX()[e * EROWS + rr] = -1; F.GATE()[e * EROWS + rr] = 0.f; }
            continue; }
        for (int i = tid; i < n; i += NTHR) keys[i] = __float_as_uint(F.AFF()[(size_t)(base + i) * 16 + e]);
        __syncthreads();
        unsigned prefix = 0u, mask = 0u, need = (unsigned)k;
        for (int pass = 0; pass < 4; ++pass) {
            const int shift = 24 - 8 * pass;
            if (tid < 256) hist[tid] = 0u;
            __syncthreads();
            for (int i = tid; i < n; i += NTHR) { const unsigned key = keys[i]; if ((key & mask) == prefix) atomicAdd((unsigned*)&hist[(key >> shift) & 255u], 1u); }
            __syncthreads();
            if (wave == 0) {
                const unsigned h0 = hist[4 * lane], h1 = hist[4 * lane + 1], h2 = hist[4 * lane + 2], h3 = hist[4 * lane + 3];
                const unsigned tot = h0 + h1 + h2 + h3;
                unsigned suf = tot;
#pragma unroll
                for (int o = 1; o < 64; o <<= 1) { const unsigned t = __shfl_down(suf, o); if (lane + o < 64) suf += t; }
                const unsigned above = suf - tot;
                if (suf >= need && above < need) {
                    unsigned rem = need - above, bsel;
                    if (rem <= h3) bsel = 3u; else { rem -= h3; if (rem <= h2) bsel = 2u; else { rem -= h2; if (rem <= h1) bsel = 1u; else { rem -= h1; bsel = 0u; } } }
                    bc[0] = 4u * lane + bsel; bc[1] = rem;
                }
            }
            __syncthreads();
            prefix |= bc[0] << shift; mask |= 255u << shift; need = bc[1];
            __syncthreads();
        }
        const unsigned T = prefix;
        const int per = n >= NTHR ? n / NTHR : 1;
        const int i0 = tid * per; const bool act = i0 < n;
        unsigned eqc = 0u;
        if (act) for (int q = 0; q < per; ++q) eqc += (keys[i0 + q] == T) ? 1u : 0u;
        unsigned eqr = block_excl_scan(eqc, wtot, lane, wave);
        unsigned selc = 0u;
        if (act) for (int q = 0; q < per; ++q) { const unsigned key = keys[i0 + q]; if (key > T) ++selc; else if (key == T) { if (eqr < need) ++selc; ++eqr; } }
        unsigned slot = block_excl_scan(selc, wtot, lane, wave);
        eqr -= eqc;
        if (act) for (int q = 0; q < per; ++q) {
            const unsigned key = keys[i0 + q]; bool sel = key > T;
            if (key == T) { sel = eqr < need; ++eqr; }
            const int tok = base + i0 + q;
            if (sel) { const int rr = sbase + (int)slot; ++slot; F.ROWIDX()[e * EROWS + rr] = tok; F.GATE()[e * EROWS + rr] = __uint_as_float(key); F.SLOT()[(size_t)tok * 16 + e] = rr; }
            else F.SLOT()[(size_t)tok * 16 + e] = -1;
        }
        if (s == 3) for (int rr = 2112 + tid; rr < EROWS; rr += NTHR) { F.ROWIDX()[e * EROWS + rr] = -1; F.GATE()[e * EROWS + rr] = 0.f; }
        __syncthreads();
    }
}

__device__ __forceinline__ void ph_gather(const Frame& F) {
    const int lane = F.lane, gw = F.bid * NWAVES + F.wave, NGW = F.G * NWAVES;
    for (int idx = gw; idx < NE * EROWS; idx += NGW) {
        const int src = F.ROWIDX()[idx];
        bf16x8 a = {0, 0, 0, 0, 0, 0, 0, 0}, b = a;
        if (src >= 0) { a = *(const bf16x8*)(F.HN() + (size_t)src * DM + 8 * lane); b = *(const bf16x8*)(F.HN() + (size_t)src * DM + 512 + 8 * lane); }
        *(bf16x8*)(F.XS() + (size_t)idx * DM + 8 * lane) = a; *(bf16x8*)(F.XS() + (size_t)idx * DM + 512 + 8 * lane) = b;
    }
}

__device__ __forceinline__ void ph_combine(const Frame& F, int L) {
    const int lane = F.lane, gw = F.bid * NWAVES + F.wave, NGW = F.G * NWAVES;
    const bool last = (L == DEPTH - 1);
    const int nrows = last ? NLAT : NROW;
    for (int r = gw; r < nrows; r += NGW) {
        const int v = row_vec(r);
        const int sl = (lane < 16) ? F.SLOT()[(size_t)r * 16 + lane] : -1;
        const float* mod = F.MOD() + (size_t)(L * 3 + v) * 6144;
        f32x4 xv[4], g2[4];
#pragma unroll
        for (int j = 0; j < 2; ++j)
#pragma unroll
            for (int q = 0; q < 2; ++q) { const int c = 8 * lane + 512 * j + 4 * q; const unsigned long long w = *(const unsigned long long*)(F.X() + (size_t)r * DM + c);
                const unsigned w0 = (unsigned)w, w1 = (unsigned)(w >> 32);
                xv[2 * j + q] = (f32x4){__builtin_bit_cast(float, w0 << 16), __builtin_bit_cast(float, w0 & 0xffff0000u), __builtin_bit_cast(float, w1 << 16), __builtin_bit_cast(float, w1 & 0xffff0000u)};
                g2[2 * j + q] = *(const f32x4*)(mod + 5120 + c); }
        float acc[16];
#pragma unroll
        for (int i = 0; i < 16; ++i) acc[i] = 0.f;
        unsigned long long m = __ballot(sl >= 0);
        while (m) {
            const int e0 = __builtin_ctzll(m); m &= m - 1;
            const int e1 = m ? __builtin_ctzll(m) : -1; if (m) m &= m - 1;
            const int s0 = __shfl(sl, e0), s1 = e1 >= 0 ? __shfl(sl, e1) : 0;
            const float gv0 = F.GATE()[e0 * EROWS + s0]; const bf16* y0 = F.Y() + ((size_t)e0 * EROWS + s0) * DM;
            const bf16x8 a0 = *(const bf16x8*)(y0 + 8 * lane), a1 = *(const bf16x8*)(y0 + 8 * lane + 512);
            float gv1 = 0.f; bf16x8 b0 = {0, 0, 0, 0, 0, 0, 0, 0}, b1 = b0;
            if (e1 >= 0) { gv1 = F.GATE()[e1 * EROWS + s1]; const bf16* y1 = F.Y() + ((size_t)e1 * EROWS + s1) * DM; b0 = *(const bf16x8*)(y1 + 8 * lane); b1 = *(const bf16x8*)(y1 + 8 * lane + 512); }
#pragma unroll
            for (int i = 0; i < 8; ++i) { acc[i] += gv0 * bf2f((bf16)a0[i]); acc[8 + i] += gv0 * bf2f((bf16)a1[i]); }
            if (e1 >= 0) {
#pragma unroll
                for (int i = 0; i < 8; ++i) { acc[i] += gv1 * bf2f((bf16)b0[i]); acc[8 + i] += gv1 * bf2f((bf16)b1[i]); } }
        }
        float xn[16]; float ss = 0.f;
#pragma unroll
        for (int j = 0; j < 2; ++j)
#pragma unroll
            for (int q = 0; q < 2; ++q) { const int c = 8 * lane + 512 * j + 4 * q;
#pragma unroll
                for (int i = 0; i < 4; ++i) { const float t = xv[2 * j + q][i] + g2[2 * j + q][i] * acc[8 * j + 4 * q + i]; xn[8 * j + 4 * q + i] = t; ss += t * t; }
                const f32x4 o = {xn[8 * j + 4 * q], xn[8 * j + 4 * q + 1], xn[8 * j + 4 * q + 2], xn[8 * j + 4 * q + 3]};
                if (last) *(f32x4*)(F.out + (size_t)r * DM + c) = o;
                else *(unsigned long long*)(F.X() + (size_t)r * DM + c) = (unsigned long long)pk2(o.x, o.y) | ((unsigned long long)pk2(o.z, o.w) << 32); }
        if (!last) {
            const float rinv = rsqrtf(wave_sum(ss) * (1.f / DM) + EPS);
            const float* mod1 = F.MOD() + (size_t)((L + 1) * 3 + v) * 6144;
#pragma unroll
            for (int j = 0; j < 2; ++j) { const int c = 8 * lane + 512 * j; float h[8];
#pragma unroll
                for (int q = 0; q < 2; ++q) { const f32x4 g = *(const f32x4*)(F.n1g() + (L + 1) * DM + c + 4 * q), sh = *(const f32x4*)(mod1 + c + 4 * q), sc = *(const f32x4*)(mod1 + 1024 + c + 4 * q);
#pragma unroll
                    for (int i = 0; i < 4; ++i) h[4 * q + i] = xn[8 * j + 4 * q + i] * rinv * g[i] * (1.f + sc[i]) + sh[i]; }
                v4u w; w.x = pk2(h[0], h[1]); w.y = pk2(h[2], h[3]); w.z = pk2(h[4], h[5]); w.w = pk2(h[6], h[7]);
                *(v4u*)(F.HN() + (size_t)r * DM + c) = w; }
        }
    }
}


constexpr int LDP = 136, LDQK = 72;

__device__ __forceinline__ void ret_rot(const Frame& F, const bf16* zh, int p, bool lat, int n, float scale, float (&o1)[8], float (&o2)[8]) {
    const bf16x8 r1 = *(const bf16x8*)(zh + 8 * p), r2 = *(const bf16x8*)(zh + 32 + 8 * p);
    float cs[8], sn[8];
    if (lat) { const float* R = F.RETT() + (size_t)n * 64 + 8 * p; const f32x4 c0 = *(const f32x4*)R, c1 = *(const f32x4*)(R + 4), s0 = *(const f32x4*)(R + 32), s1 = *(const f32x4*)(R + 36);
#pragma unroll
        for (int i = 0; i < 4; ++i) { cs[i] = c0[i]; cs[4 + i] = c1[i]; sn[i] = s0[i]; sn[4 + i] = s1[i]; } }
    else {
#pragma unroll
        for (int i = 0; i < 8; ++i) { cs[i] = 1.f; sn[i] = 0.f; } }
#pragma unroll
    for (int i = 0; i < 8; ++i) { const float x1 = bf2f((bf16)r1[i]) * scale, x2 = bf2f((bf16)r2[i]) * scale; o1[i] = x1 * cs[i] - x2 * sn[i]; o2[i] = x1 * sn[i] + x2 * cs[i]; }
}
__device__ __forceinline__ void unit_retkv(const Frame& F, int L, int b, int h, int cc) {
    const int tid = F.tid, lane = F.lane, wave = F.wave;
    LAS bf16* vT = (LAS bf16*)F.lds;
    LAS bf16* kfT = vT + 64 * LDP;
    LAS bf16* kbT = kfT + 64 * LDP;
    const int row0 = chunk_row0(b, cc);
    const float lgf = F.LP()[L * 16 + 2 + h], lgb = F.LP()[L * 16 + 6 + h];
    { const int j = tid >> 2, p = tid & 3;
      const bf16* zr = F.Z() + (size_t)(row0 + j) * INC;
      float k1[8], k2[8];
      ret_rot(F, zr + ZRK + h * 64, p, cc >= 2, (cc - 2) * 128 + j, 0.125f, k1, k2);
      const bf16x8 v1 = *(const bf16x8*)(zr + ZRV + h * 64 + 8 * p), v2 = *(const bf16x8*)(zr + ZRV + h * 64 + 32 + 8 * p);
      const float df = __expf(lgf * (float)(127 - j)), db = __expf(lgb * (float)j);
#pragma unroll
      for (int i = 0; i < 8; ++i) { const int d1 = 8 * p + i, d2 = 32 + 8 * p + i;
          kfT[d1 * LDP + j] = (bf16)f2bf(k1[i] * df); kbT[d1 * LDP + j] = (bf16)f2bf(k1[i] * db); vT[d1 * LDP + j] = (bf16)v1[i];
          kfT[d2 * LDP + j] = (bf16)f2bf(k2[i] * df); kbT[d2 * LDP + j] = (bf16)f2bf(k2[i] * db); vT[d2 * LDP + j] = (bf16)v2[i]; } }
    __syncthreads();
    { const int dir = wave >> 2, ti = (wave >> 1) & 1, tj = wave & 1, r32 = lane & 31, hi = lane >> 5;
      f32x16 acc = {};
      acc = mma_nt(vT + ti * 32 * LDP, LDP, (dir ? kbT : kfT) + tj * 32 * LDP, LDP, 128, acc, lane);
      float* dst = F.KVT() + ((size_t)(((b * 4 + h) * 2 + dir) * NCH + cc)) * 4096;
#pragma unroll
      for (int x = 0; x < 16; ++x) dst[(ti * 32 + crow(x, hi)) * 64 + tj * 32 + r32] = acc[x]; }
    __syncthreads();
}

__device__ __forceinline__ void ph_scan(const Frame& F, int L) {
    const int t = F.bid * NTHR + F.tid;
    if (t < 65536) {
        const int elem = t & 4095, sq = t >> 12, dir = sq & 1, h = (sq >> 1) & 3, b = sq >> 3;
        const size_t base = (size_t)(((b * 4 + h) * 2 + dir) * NCH);
        const float decay = expf(F.LP()[L * 16 + 2 + dir * 4 + h] * 128.f);
        float kv[NCH];
#pragma unroll
        for (int step = 0; step < NCH; ++step) { const int cc = dir == 0 ? step : (step < 2 ? 1 - step : 67 - step); kv[step] = F.KVT()[(base + cc) * 4096 + elem]; }
        float s = 0.f;
#pragma unroll
        for (int step = 0; step < NCH; ++step) { const int cc = dir == 0 ? step : (step < 2 ? 1 - step : 67 - step);
            F.SPREV()[(base + cc) * 4096 + elem] = s; s = s * decay + kv[step]; }
    }
}

__device__ __forceinline__ void unit_retout(const Frame& F, int L, int b, int h, int cc) {
    int tid = F.tid; asm volatile("" : "+v"(tid));
    const int lane = tid & 63, wave = F.wave, r32 = lane & 31, hi = lane >> 5;
    LAS bf16* q_s = (LAS bf16*)F.lds;
    LAS bf16* k_s = q_s + 128 * LDQK;
    LAS bf16* vT = k_s + 128 * LDQK;
    LAS bf16* SfT = vT + 64 * LDP;
    LAS bf16* SbT = SfT + 64 * LDQK;
    LAS bf16* P = SbT + 64 * LDQK;
    LAS float* O_s = (LAS float*)P;
    constexpr int LDO = 66;
    const int row0 = chunk_row0(b, cc);
    const float lgf = F.LP()[L * 16 + 2 + h], lgb = F.LP()[L * 16 + 6 + h];
    const bf16* zgt = F.Z() + (size_t)(row0 + (tid >> 2)) * INC + h * 64 + (tid & 3) * 16;
    const bf16x8 gfa = *(const bf16x8*)(zgt + ZGF), gfb = *(const bf16x8*)(zgt + ZGF + 8), gba = *(const bf16x8*)(zgt + ZGB), gbb = *(const bf16x8*)(zgt + ZGB + 8);
    { const int j = tid >> 2, p = tid & 3;
      const bf16* zr = F.Z() + (size_t)(row0 + j) * INC;
      float a1[8], a2[8];
      ret_rot(F, zr + ZRQ + h * 64, p, cc >= 2, (cc - 2) * 128 + j, 1.f, a1, a2);
      { v4u w; w.x = pk2(a1[0], a1[1]); w.y = pk2(a1[2], a1[3]); w.z = pk2(a1[4], a1[5]); w.w = pk2(a1[6], a1[7]); *(LAS v4u*)(q_s + j * LDQK + 8 * p) = w;
        w.x = pk2(a2[0], a2[1]); w.y = pk2(a2[2], a2[3]); w.z = pk2(a2[4], a2[5]); w.w = pk2(a2[6], a2[7]); *(LAS v4u*)(q_s + j * LDQK + 32 + 8 * p) = w; }
      ret_rot(F, zr + ZRK + h * 64, p, cc >= 2, (cc - 2) * 128 + j, 0.125f, a1, a2);
      { v4u w; w.x = pk2(a1[0], a1[1]); w.y = pk2(a1[2], a1[3]); w.z = pk2(a1[4], a1[5]); w.w = pk2(a1[6], a1[7]); *(LAS v4u*)(k_s + j * LDQK + 8 * p) = w;
        w.x = pk2(a2[0], a2[1]); w.y = pk2(a2[2], a2[3]); w.z = pk2(a2[4], a2[5]); w.w = pk2(a2[6], a2[7]); *(LAS v4u*)(k_s + j * LDQK + 32 + 8 * p) = w; }
      const bf16x8 v1 = *(const bf16x8*)(zr + ZRV + h * 64 + 8 * p), v2 = *(const bf16x8*)(zr + ZRV + h * 64 + 32 + 8 * p);
#pragma unroll
      for (int i = 0; i < 8; ++i) { vT[(8 * p + i) * LDP + j] = (bf16)v1[i]; vT[(32 + 8 * p + i) * LDP + j] = (bf16)v2[i]; } }
    { const float* sf = F.SPREV() + ((size_t)(((b * 4 + h) * 2 + 0) * NCH + cc)) * 4096;
      const float* sb = F.SPREV() + ((size_t)(((b * 4 + h) * 2 + 1) * NCH + cc)) * 4096;
#pragma unroll
      for (int q = 0; q < 2; ++q) { const int idx = tid + NTHR * q, dv = idx >> 4, c4 = (idx & 15) * 4;
          const f32x4 a = *(const f32x4*)(sf + dv * 64 + c4), c = *(const f32x4*)(sb + dv * 64 + c4);
          *(LAS unsigned long long*)(SfT + dv * LDQK + c4) = (unsigned long long)pk2(a.x, a.y) | ((unsigned long long)pk2(a.z, a.w) << 32);
          *(LAS unsigned long long*)(SbT + dv * LDQK + c4) = (unsigned long long)pk2(c.x, c.y) | ((unsigned long long)pk2(c.z, c.w) << 32); } }
    __syncthreads();
    const int sti = wave >> 1, stj0 = (wave & 1) * 2;
    f32x16 S0 = {}, S1 = {};
    S0 = mma_nt(q_s + sti * 32 * LDQK, LDQK, k_s + stj0 * 32 * LDQK, LDQK, 64, S0, lane);
    S1 = mma_nt(q_s + sti * 32 * LDQK, LDQK, k_s + (stj0 + 1) * 32 * LDQK, LDQK, 64, S1, lane);
    const int ei = tid >> 2, ec = (tid & 3) * 16;
    float yo[16];
#pragma unroll
    for (int dir = 0; dir < 2; ++dir) {
        const float lg = dir ? lgb : lgf;
#pragma unroll
        for (int x = 0; x < 16; ++x) { const int i = sti * 32 + crow(x, hi);
            const int j0 = stj0 * 32 + r32, j1 = j0 + 32; const int d0 = dir ? j0 - i : i - j0, d1 = dir ? j1 - i : i - j1;
            const float p0 = d0 >= 0 ? S0[x] * __expf(lg * (float)d0) : 0.f, p1 = d1 >= 0 ? S1[x] * __expf(lg * (float)d1) : 0.f;
            const unsigned pk = pg8::cvt_pk_bf16(p0, p1);
            P[i * LDP + j0] = (bf16)(pk & 0xffffu); P[i * LDP + j1] = (bf16)(pk >> 16);
            if ((x & 3) == 3) __builtin_amdgcn_sched_barrier(0); }
        __syncthreads();
        const int oti = wave >> 1, otj = wave & 1;
        f32x16 a0 = {}, c0 = {};
        { const LAS bf16* ST = dir ? SbT : SfT;
          a0 = mma_nt(P + oti * 32 * LDP, LDP, vT + otj * 32 * LDP, LDP, 128, a0, lane);
          c0 = mma_nt(q_s + oti * 32 * LDQK, LDQK, ST + otj * 32 * LDQK, LDQK, 64, c0, lane); }
        __syncthreads();
#pragma unroll
        for (int x = 0; x < 16; ++x) { const int i = oti * 32 + crow(x, hi);
            const float qd = __expf(lg * (float)(dir ? 128 - i : i + 1));
            O_s[i * LDO + otj * 32 + r32] = a0[x] + c0[x] * qd;
            if ((x & 3) == 3) __builtin_amdgcn_sched_barrier(0); }
        __syncthreads();
        { float o[16]; float s = 0.f;
#pragma unroll
          for (int c = 0; c < 16; ++c) { o[c] = O_s[ei * LDO + ec + c]; s += o[c]; }
          s += __shfl_xor(s, 1); s += __shfl_xor(s, 2);
          const float mu = s * (1.f / 64.f); float s2 = 0.f;
#pragma unroll
          for (int c = 0; c < 16; ++c) { o[c] -= mu; s2 += o[c] * o[c]; }
          s2 += __shfl_xor(s2, 1); s2 += __shfl_xor(s2, 2);
          const float rs = rsqrtf(s2 * (1.f / 64.f) + EPS);
          const bf16x8 ga = dir ? gba : gfa, gb = dir ? gbb : gfb;
#pragma unroll
          for (int c = 0; c < 16; ++c) { const float g = bf2f((bf16)(c < 8 ? ga[c & 7] : gb[c & 7])); const float y = o[c] * rs * silu_f(g);
              if (dir == 0) yo[c] = y; else yo[c] += y; }
          if (dir == 1) { bf16* mr = F.MIX() + (size_t)(row0 + ei) * DM + 512 + h * 64 + ec;
              v4u w0, w1; w0.x = pk2(yo[0], yo[1]); w0.y = pk2(yo[2], yo[3]); w0.z = pk2(yo[4], yo[5]); w0.w = pk2(yo[6], yo[7]);
              w1.x = pk2(yo[8], yo[9]); w1.y = pk2(yo[10], yo[11]); w1.z = pk2(yo[12], yo[13]); w1.w = pk2(yo[14], yo[15]);
              *(v4u*)mr = w0; *(v4u*)(mr + 8) = w1; } }
        __syncthreads();
    }
}

__device__ __forceinline__ void unit_sg(const Frame& F, int L, int b, int g, int cc) {
    const int tid = F.tid, lane = F.lane, wave = F.wave, r32 = lane & 31, hi = lane >> 5;
    LAS bf16* W_s = (LAS bf16*)F.lds;
    LAS bf16* vT = W_s + 128 * LDP;
    const int row0 = chunk_row0(b, cc);
    const bf16* Wg = F.SGW() + (size_t)(L * 4 + g) * 128 * 128;
    const bf16* zu = F.Z() + (size_t)(row0 + (tid >> 2)) * INC + ZSU + g * 64 + (tid & 3) * 16;
    const bf16x8 u0 = *(const bf16x8*)zu, u1 = *(const bf16x8*)(zu + 8);
    const float bi = F.sgb()[(L * 4 + g) * 128 + (tid >> 2)];
#pragma unroll
    for (int q = 0; q < 4; ++q) { const int idx = tid + NTHR * q, i = idx >> 4, c8 = (idx & 15) * 8; *(LAS bf16x8*)(W_s + i * LDP + c8) = *(const bf16x8*)(Wg + i * 128 + c8); }
    { const int j = tid >> 2, qd = tid & 3;
      const bf16* zr = F.Z() + (size_t)(row0 + j) * INC + ZSV + 64 * qd;
      float gv[64]; float sum = 0.f;
#pragma unroll
      for (int c = 0; c < 8; ++c) { const bf16x8 raw = *(const bf16x8*)(zr + 8 * c);
#pragma unroll
          for (int i = 0; i < 8; ++i) { const float t = gelu_t(bf2f((bf16)raw[i])); gv[8 * c + i] = t; sum += t; } }
      sum += __shfl_xor(sum, 1); sum += __shfl_xor(sum, 2);
      const float mu = sum * (1.f / 256.f); float s2 = 0.f;
#pragma unroll
      for (int c = 0; c < 64; ++c) { gv[c] -= mu; s2 += gv[c] * gv[c]; }
      s2 += __shfl_xor(s2, 1); s2 += __shfl_xor(s2, 2);
      const float rs = rsqrtf(s2 * (1.f / 256.f) + EPS);
      if (qd == g) { const float* gn = F.sgng() + L * 256 + g * 64;
#pragma unroll
          for (int c = 0; c < 64; ++c) vT[c * LDP + j] = (bf16)f2bf(gv[c] * rs * gn[c]); } }
    __syncthreads();
    LAS float* O_s = (LAS float*)W_s;
    { const int ti = wave >> 1, tj = wave & 1;
      f32x16 acc = {};
      acc = mma_nt(W_s + ti * 32 * LDP, LDP, vT + tj * 32 * LDP, LDP, 128, acc, lane);
      __syncthreads();
#pragma unroll
      for (int x = 0; x < 16; ++x) O_s[(ti * 32 + crow(x, hi)) * 66 + tj * 32 + r32] = acc[x]; }
    __syncthreads();
    { const int i = tid >> 2, ec = (tid & 3) * 16;
      float o[16];
#pragma unroll
      for (int c = 0; c < 16; ++c) o[c] = gelu_t(bf2f((bf16)(c < 8 ? u0[c & 7] : u1[c & 7]))) * (O_s[i * 66 + ec + c] + bi);
      bf16* mr = F.MIX() + (size_t)(row0 + i) * DM + 768 + g * 64 + ec;
      v4u w0, w1; w0.x = pk2(o[0], o[1]); w0.y = pk2(o[2], o[3]); w0.z = pk2(o[4], o[5]); w0.w = pk2(o[6], o[7]);
      w1.x = pk2(o[8], o[9]); w1.y = pk2(o[10], o[11]); w1.z = pk2(o[12], o[13]); w1.w = pk2(o[14], o[15]);
      *(v4u*)mr = w0; *(v4u*)(mr + 8) = w1; }
    __syncthreads();
}

__device__ __forceinline__ void unit_out_ctx(const Frame& F, int L, int mu) {
    int tid = F.tid; asm volatile("" : "+v"(tid));
    const int lane = tid & 63, wave = F.wave, r32 = lane & 31, hi = lane >> 5;
    const int rb = mu >> 5, cb = mu & 31, k0 = wave * 128 + 8 * hi;
    LAS float* P = (LAS float*)F.lds;
    const bf16* A0 = F.MIX() + (size_t)(NLAT + rb * 64 + r32) * DM + k0;
    const bf16* B0 = F.WOUT() + (size_t)L * DM * DM + (size_t)(cb * 32 + r32) * DM + k0;
    bf16x8 a0[8], a1[8], bb[8];
#pragma unroll
    for (int s = 0; s < 8; ++s) { a0[s] = *(const bf16x8*)(A0 + 16 * s); a1[s] = *(const bf16x8*)(A0 + 32 * DM + 16 * s); bb[s] = *(const bf16x8*)(B0 + 16 * s); }
    f32x16 c0 = {}, c1 = {};
#pragma unroll
    for (int s = 0; s < 8; ++s) { c0 = __builtin_amdgcn_mfma_f32_32x32x16_bf16(a0[s], bb[s], c0, 0, 0, 0); c1 = __builtin_amdgcn_mfma_f32_32x32x16_bf16(a1[s], bb[s], c1, 0, 0, 0); }
#pragma unroll
    for (int x = 0; x < 16; ++x) { P[((wave * 2 + 0) * 16 + x) * 64 + lane] = c0[x]; P[((wave * 2 + 1) * 16 + x) * 64 + lane] = c1[x]; }
    __syncthreads();
    const float* g1 = F.MOD() + (size_t)(L * 3 + 2) * 6144 + 2048 + cb * 32;
#pragma unroll
    for (int q = 0; q < 4; ++q) {
        const int idx = tid + NTHR * q, ln = idx & 63, x = (idx >> 6) & 15, t = idx >> 10;
        float s = 0.f;
#pragma unroll
        for (int w = 0; w < 8; ++w) s += P[((w * 2 + t) * 16 + x) * 64 + ln];
        const int row = 32 * t + crow(x, ln >> 5), col = ln & 31;
        const size_t xo = (size_t)(rb * 64 + row) * DM + cb * 32 + col;
        F.X()[(size_t)NLAT * DM + xo] = (bf16)f2bf((L == 0 ? F.ctx_in()[xo] : bf2f(F.X()[(size_t)NLAT * DM + xo])) + g1[col] * s);
    }
    __syncthreads();
}

namespace att {
constexpr int KVBLK = 64;
constexpr float SCALE = 0.125f, THR = 8.f;
constexpr int LDQ = 512, LDK = 512, LDV = 512;
constexpr int SHM_V = KVBLK * 128 * 2, SHM_K = KVBLK * 64 * 2, SHM_ATTN = 2 * SHM_V + 2 * SHM_K + NWAVES * 64 * 4;
#define KSWZ(row, colB) ((row) * 128 + ((colB) ^ ((((row) >> 1) & 7) << 4)))
#define SBAR() __builtin_amdgcn_sched_barrier(0)
__device__ __forceinline__ unsigned cvtpk(float lo, float hi) { unsigned r; asm volatile("v_cvt_pk_bf16_f32 %0, %1, %2" : "=v"(r) : "v"(lo), "v"(hi)); return r; }
template <bool OFF> __device__ __forceinline__ void partialSM(f32x16& p0, f32x16& p1, float off) {
#pragma unroll
    for (int r = 0; r < 16; ++r) { if (OFF) { p0[r] += off; p1[r] += off; } p0[r] = __builtin_amdgcn_exp2f(p0[r]); }
}
__device__ __forceinline__ void finishSM(f32x16& p0, f32x16& p1, float& l_reg, bf16x8& pa0, bf16x8& pa1, bf16x8& pa2, bf16x8& pa3) {
#pragma unroll
    for (int r = 0; r < 16; ++r) p1[r] = __builtin_amdgcn_exp2f(p1[r]);
    float ps = 0;
#pragma unroll
    for (int r = 0; r < 16; ++r) ps += p0[r];
#pragma unroll
    for (int r = 0; r < 16; ++r) ps += p1[r];
    { auto rr = __builtin_amdgcn_permlane32_swap(__float_as_uint(ps), __float_as_uint(ps), false, false);
      ps = __uint_as_float(rr[0]) + __uint_as_float(rr[1]); }
    l_reg += ps;
#define PK4(P, BASE, OUT) do { unsigned a0 = cvtpk(P[BASE + 0], P[BASE + 1]), a1 = cvtpk(P[BASE + 2], P[BASE + 3]);   \
    unsigned b0 = cvtpk(P[BASE + 4], P[BASE + 5]), b1 = cvtpk(P[BASE + 6], P[BASE + 7]);                              \
    auto r0 = __builtin_amdgcn_permlane32_swap(a0, b0, false, false); auto r1 = __builtin_amdgcn_permlane32_swap(a1, b1, false, false); \
    v4u w = {r0[0], r1[0], r0[1], r1[1]}; OUT = __builtin_bit_cast(bf16x8, w); } while (0)
    PK4(p0, 0, pa0); PK4(p0, 8, pa1); PK4(p1, 0, pa2); PK4(p1, 8, pa3);
#undef PK4
}
template <bool OFF> __device__ __forceinline__ void kload(bf16x8 (&kf)[8], const LAS char* Ks, int r32, int hi) {
    if (OFF) return;
#pragma unroll
    for (int d0 = 0; d0 < 4; ++d0) { const int cb = (d0 * 16 + hi * 8) * 2;
        kf[2 * d0] = *(const LAS bf16x8*)(Ks + KSWZ(r32, cb)); kf[2 * d0 + 1] = *(const LAS bf16x8*)(Ks + KSWZ(32 + r32, cb)); }
}
template <bool OFF> __device__ __forceinline__ void qkmma(f32x16& p0, f32x16& p1, const bf16x8 (&kf)[8], const bf16x8* qr, const LAS char* Ks, int r32, int hi) {
    p0 = f32x16{}; p1 = f32x16{};
#pragma unroll
    for (int d0 = 0; d0 < 4; ++d0) {
        if (OFF) { const int cb = (d0 * 16 + hi * 8) * 2;
            const bf16x8 b0 = *(const LAS bf16x8*)(Ks + KSWZ(r32, cb)), b1 = *(const LAS bf16x8*)(Ks + KSWZ(32 + r32, cb));
            p0 = __builtin_amdgcn_mfma_f32_32x32x16_bf16(b0, qr[d0], p0, 0, 0, 0); p1 = __builtin_amdgcn_mfma_f32_32x32x16_bf16(b1, qr[d0], p1, 0, 0, 0); }
        else { p0 = __builtin_amdgcn_mfma_f32_32x32x16_bf16(kf[2 * d0], qr[d0], p0, 0, 0, 0); p1 = __builtin_amdgcn_mfma_f32_32x32x16_bf16(kf[2 * d0 + 1], qr[d0], p1, 0, 0, 0); } }
}
__device__ __forceinline__ int v_st(int k, int c) { const int kk = (k & ~0xC) | ((k & 4) << 1) | ((k & 8) >> 1); return ((kk >> 3) * 4 + (c >> 5)) * 512 + ((kk & 7) * 32 + (c & 31)) * 2; }
__device__ __forceinline__ int v_rd_base(int lane) { return ((lane & 3) << 3) | (((lane >> 2) & 3) << 6) | (((lane >> 4) & 1) << 5) | (((lane >> 5) & 1) << 8); }
constexpr int v_rd_off(int d0, int ks, int half) { return d0 * 512 + ks * 4096 + half * 2048; }
template <int OFF> __device__ __forceinline__ s16x4 tr_read(int vb) {
    s16x4 r; asm volatile("ds_read_b64_tr_b16 %0, %1 offset:%2" : "=&v"(r) : "v"(vb), "i"(OFF) : "memory"); return r;
}
template <int D0> __device__ __forceinline__ void pv_one(f32x16& od, int vb, bf16x8 pa0, bf16x8 pa1, bf16x8 pa2, bf16x8 pa3) {
    const s16x4 l0 = tr_read<v_rd_off(D0, 0, 0)>(vb), h0 = tr_read<v_rd_off(D0, 0, 1)>(vb), l1 = tr_read<v_rd_off(D0, 1, 0)>(vb), h1 = tr_read<v_rd_off(D0, 1, 1)>(vb);
    const s16x4 l2 = tr_read<v_rd_off(D0, 2, 0)>(vb), h2 = tr_read<v_rd_off(D0, 2, 1)>(vb), l3 = tr_read<v_rd_off(D0, 3, 0)>(vb), h3 = tr_read<v_rd_off(D0, 3, 1)>(vb);
    asm volatile("s_waitcnt lgkmcnt(0)" ::: "memory"); SBAR();
#define PK(Lo, Hi) (bf16x8){Lo[0], Lo[1], Lo[2], Lo[3], Hi[0], Hi[1], Hi[2], Hi[3]}
    od = __builtin_amdgcn_mfma_f32_32x32x16_bf16(pa0, PK(l0, h0), od, 0, 0, 0);
    od = __builtin_amdgcn_mfma_f32_32x32x16_bf16(pa1, PK(l1, h1), od, 0, 0, 0);
    od = __builtin_amdgcn_mfma_f32_32x32x16_bf16(pa2, PK(l2, h2), od, 0, 0, 0);
    od = __builtin_amdgcn_mfma_f32_32x32x16_bf16(pa3, PK(l3, h3), od, 0, 0, 0);
#undef PK
}
__device__ __forceinline__ void pv_d0(f32x16* o, int vb, bf16x8 pa0, bf16x8 pa1, bf16x8 pa2, bf16x8 pa3) {
    pv_one<0>(o[0], vb, pa0, pa1, pa2, pa3); pv_one<1>(o[1], vb, pa0, pa1, pa2, pa3); pv_one<2>(o[2], vb, pa0, pa1, pa2, pa3); pv_one<3>(o[3], vb, pa0, pa1, pa2, pa3);
}
template <bool OFF> __device__ __forceinline__ void body(const bf16* __restrict__ Qb, const bf16* __restrict__ Kh, const bf16* __restrict__ Vh, int seq, float mfix, LAS char* lds, f32x16 (&o)[4]) {
    int tid = threadIdx.x; asm volatile("" : "+v"(tid));
    const int wid = __builtin_amdgcn_readfirstlane(tid >> 6), lane = tid & 63, r32 = lane & 31, hi = lane >> 5;
    LAS char* V_lds = lds; LAS char* K_lds = lds + 2 * SHM_V;
    LAS float* ws = (LAS float*)(lds + 2 * SHM_V + 2 * SHM_K) + wid * 64; LAS float* li_l = ws; LAS float* al_l = ws + 32;
    float l_reg = 0;
    const float soff = -mfix * (SCALE * 1.4426950408889634f);
#pragma unroll
    for (int d = 0; d < 4; ++d) o[d] = f32x16{};
    bf16x8 qr[4];
    const bf16* Qw = Qb + (long)(wid * 32 + r32) * LDQ + hi * 8;
#pragma unroll
    for (int d0 = 0; d0 < 4; ++d0) qr[d0] = *(const bf16x8*)(Qw + d0 * 16);
    const int sr = tid >> 4, sc = (tid & 15) * 8, vst0 = v_st(sr, sc), vst1 = v_st(32 + sr, sc);
    const int kr = tid >> 3, kc = (tid & 7) * 8, kst = KSWZ(kr, kc * 2);
    const int vb0 = (int)(uintptr_t)V_lds + v_rd_base(lane);
    struct { bf16x8 vs0, vs1, ks0; } sr_[2];
#define SLOAD(i, k0) do { sr_[i].vs0 = *(const bf16x8*)(&Vh[(long)((k0) + sr) * LDV + sc]); sr_[i].vs1 = *(const bf16x8*)(&Vh[(long)((k0) + 32 + sr) * LDV + sc]); \
    sr_[i].ks0 = *(const bf16x8*)(&Kh[(long)((k0) + kr) * LDK + kc]); } while (0)
#define SWRITE(b, i) do { *(LAS bf16x8*)(V_lds + (b) * SHM_V + vst0) = sr_[i].vs0; *(LAS bf16x8*)(V_lds + (b) * SHM_V + vst1) = sr_[i].vs1; \
    *(LAS bf16x8*)(K_lds + (b) * SHM_K + kst) = sr_[i].ks0; } while (0)
#define SWAIT() asm volatile("s_waitcnt vmcnt(3)" ::: "memory")
    f32x16 pA0, pA1, pB0, pB1; bf16x8 pa0, pa1, pa2, pa3; const int NT = seq / KVBLK;
    constexpr int SE = 0, SO = 1;
    SLOAD(SE, 0); asm volatile("s_waitcnt vmcnt(0)" ::: "memory"); SWRITE(0, SE); __syncthreads();
    bf16x8 kf[8];
    kload<OFF>(kf, K_lds, r32, hi); qkmma<OFF>(pA0, pA1, kf, qr, K_lds, r32, hi); partialSM<OFF>(pA0, pA1, soff);
    SLOAD(SO, KVBLK); if (2 < NT) SLOAD(SE, 2 * KVBLK);
    SWAIT(); SWRITE(1, SO); __syncthreads();
    for (int j = 1; j + 1 < NT; j += 2) {
        SBAR(); kload<OFF>(kf, K_lds + SHM_K, r32, hi); SBAR();
        qkmma<OFF>(pB0, pB1, kf, qr, K_lds + SHM_K, r32, hi); finishSM(pA0, pA1, l_reg, pa0, pa1, pa2, pa3); SBAR();
        SLOAD(SO, (j + 2) * KVBLK); SBAR();
        pv_d0(o, vb0, pa0, pa1, pa2, pa3); partialSM<OFF>(pB0, pB1, soff);
        __syncthreads(); SWAIT(); SWRITE(0, SE);
        __syncthreads();
        SBAR(); kload<OFF>(kf, K_lds, r32, hi); SBAR();
        qkmma<OFF>(pA0, pA1, kf, qr, K_lds, r32, hi); finishSM(pB0, pB1, l_reg, pa0, pa1, pa2, pa3); SBAR();
        if (j + 3 < NT) SLOAD(SE, (j + 3) * KVBLK); SBAR();
        pv_d0(o, vb0 + (int)SHM_V, pa0, pa1, pa2, pa3); partialSM<OFF>(pA0, pA1, soff);
        __syncthreads(); SWAIT(); SWRITE(1, SO);
        __syncthreads();
    }
    SBAR(); kload<OFF>(kf, K_lds + SHM_K, r32, hi); SBAR();
    qkmma<OFF>(pB0, pB1, kf, qr, K_lds + SHM_K, r32, hi); finishSM(pA0, pA1, l_reg, pa0, pa1, pa2, pa3); SBAR();
    pv_d0(o, vb0, pa0, pa1, pa2, pa3); partialSM<OFF>(pB0, pB1, soff);
    __syncthreads();
    finishSM(pB0, pB1, l_reg, pa0, pa1, pa2, pa3); SBAR();
    pv_d0(o, vb0 + (int)SHM_V, pa0, pa1, pa2, pa3);
    if (hi == 0) li_l[r32] = l_reg; asm volatile("s_waitcnt lgkmcnt(0)" ::: "memory");
#pragma unroll
    for (int r = 0; r < 16; ++r) { const float rl = __builtin_amdgcn_rcpf(li_l[crow(r, hi)]);
#pragma unroll
        for (int d0 = 0; d0 < 4; ++d0) o[d0][r] *= rl; }
    __syncthreads();
#undef SLOAD
#undef SWRITE
#undef SWAIT
}

constexpr int SLK = 8192, SLV = 16384, L_K = 0, L_V = 3 * SLK, L_WS = L_V + 3 * SLV;
typedef const LAS char* lds_cptr;
typedef short v4i16_t __attribute__((ext_vector_type(4)));
#define PIN(x) asm volatile("" : "+v"(x))
#define MFMA32(a, b, c) __builtin_amdgcn_mfma_f32_32x32x16_bf16(a, b, c, 0, 0, 0)
#define WAIT_BAR(N) asm volatile("s_waitcnt vmcnt(" #N ") lgkmcnt(0)\n\ts_barrier" ::: "memory")
__device__ __forceinline__ unsigned cvtpk2(float lo, float hi) { unsigned r; asm("v_cvt_pk_bf16_f32 %0, %1, %2" : "=v"(r) : "v"(lo), "v"(hi)); return r; }
__device__ __forceinline__ void glds16(const void* g, unsigned lds_base) {
    unsigned sv; asm volatile("s_mov_b32 %0, m0\n\ts_mov_b32 m0, %2\n\ts_nop 0\n\tglobal_load_lds_dwordx4 %1, off\n\ts_mov_b32 m0, %0" : "=&s"(sv) : "v"(g), "s"(lds_base) : "memory"); }
__device__ __forceinline__ void kload2(bf16x8* kf, lds_cptr kp, int d0) { kf[2 * d0] = *(const LAS bf16x8*)(kp + d0 * 2048); kf[2 * d0 + 1] = *(const LAS bf16x8*)(kp + d0 * 2048 + 512); }
__device__ __forceinline__ s16x4 vtr(lds_cptr p) { return __builtin_bit_cast(s16x4, __builtin_amdgcn_ds_read_tr16_b64_v4i16((LAS v4i16_t*)p)); }
__device__ __forceinline__ void body_fast(const bf16* __restrict__ Qb, const bf16* __restrict__ Kh, const bf16* __restrict__ Vh, int seq, LAS char* lds, f32x16 (&o)[4]) {
    int tid = threadIdx.x; asm volatile("" : "+v"(tid));
    const int wid = __builtin_amdgcn_readfirstlane(tid >> 6), lane = tid & 63, r32 = lane & 31, hi = lane >> 5;
    const int NT = seq / KVBLK;
    const unsigned lds0 = (unsigned)(uintptr_t)lds; LAS float* wsf = (LAS float*)(lds + L_WS) + wid * 64;
    const bf16* ksrc = Kh + (long)lane * LDK + wid * 8;
    const bf16* vsrc = Vh + (long)(16 * (wid & 3) + (lane >> 2)) * LDV + (wid >> 2) * 32 + (lane & 3) * 8;
    const unsigned kdst = lds0 + L_K + wid * 1024, vdst = lds0 + L_V + wid * 1024;
#define DMA_K(t, slot) glds16(ksrc + (long)(t) * KVBLK * LDK, (unsigned)__builtin_amdgcn_readfirstlane(kdst + (slot)))
#define DMA_V1(t, slot) glds16(vsrc + (long)(t) * KVBLK * LDV, (unsigned)__builtin_amdgcn_readfirstlane(vdst + 2 * (slot)))
#define DMA_V2(t, slot) glds16(vsrc + (long)(t) * KVBLK * LDV + 64, (unsigned)__builtin_amdgcn_readfirstlane(vdst + 2 * (slot) + 8192))
#define DMA_V(t, slot) do { glds16(vsrc + (long)(t) * KVBLK * LDV, (unsigned)__builtin_amdgcn_readfirstlane(vdst + 2 * (slot))); \
                            glds16(vsrc + (long)(t) * KVBLK * LDV + 64, (unsigned)__builtin_amdgcn_readfirstlane(vdst + 2 * (slot) + 8192)); } while (0)
    const lds_cptr vp0 = (lds_cptr)lds + L_V + ((lane >> 4) & 1) * 32 + (lane & 3) * 8 + (4 * hi + ((lane & 15) >> 2)) * 64;
    const lds_cptr kp0 = (lds_cptr)lds + L_K + hi * 1024 + r32 * 16;
    DMA_K(0, 0); DMA_V(0, 0); DMA_K(1, SLK);
    bf16x8 qr[4];
    const bf16* Qw = Qb + (long)(wid * 32 + r32) * LDQ + hi * 8;
#pragma unroll
    for (int d0 = 0; d0 < 4; ++d0) qr[d0] = *(const bf16x8*)(Qw + d0 * 16);
    float l_reg = 0.f;
#pragma unroll
    for (int d = 0; d < 4; ++d) o[d] = f32x16{};
    f32x16 pA0, pA1, pB0, pB1; bf16x8 kf[8]; s16x4 vlo[8], vhi[8]; v4u pw0, pw1, pw2, pw3;
    int sl_prev = 0, sl_cur = 0, sl_next = SLK;
#define ROT() do { sl_prev = sl_cur; sl_cur = sl_next; sl_next = (sl_next == 2 * SLK) ? 0 : sl_next + SLK; } while (0)
#define EX(v) __builtin_amdgcn_exp2f(v)
    DMA_K(2, 2 * SLK);
    WAIT_BAR(4);
    _Pragma("unroll") for (int d0 = 0; d0 < 4; ++d0) kload2(kf, kp0, d0);
    pA0 = MFMA32(kf[0], qr[0], f32x16{}); pA1 = MFMA32(kf[1], qr[0], f32x16{}); pA0 = MFMA32(kf[2], qr[1], pA0); pA1 = MFMA32(kf[3], qr[1], pA1);
    pA0 = MFMA32(kf[4], qr[2], pA0); pA1 = MFMA32(kf[5], qr[2], pA1); pA0 = MFMA32(kf[6], qr[3], pA0); pA1 = MFMA32(kf[7], qr[3], pA1);
#pragma unroll
    for (int r = 0; r < 16; ++r) { pA0[r] = EX(pA0[r]); pA1[r] = EX(pA1[r]); }
    WAIT_BAR(0);
    DMA_K(3, 0); DMA_V(1, SLK); ROT();
    _Pragma("unroll") for (int d0 = 0; d0 < 4; ++d0) kload2(kf, kp0 + sl_cur, d0);
    WAIT_BAR(3);
#define PKW(P, i) cvtpk2(P[i], P[i + 1])
#define PAF(k) __builtin_bit_cast(bf16x8, pw##k)
#define VFR(i) (bf16x8){vlo[i][0], vlo[i][1], vlo[i][2], vlo[i][3], vhi[i][0], vhi[i][1], vhi[i][2], vhi[i][3]}
#define VRD(s, fi) do { vlo[s] = vtr(vp_ + (((fi) >> 2) * 4096 + ((fi) & 3) * 1024)); vhi[s] = vtr(vp_ + (((fi) >> 2) * 4096 + ((fi) & 3) * 1024 + 512)); } while (0)
#define KRD(G, d0) do { if (G) { kload2(kf, kp0 + sl_next, d0); SBAR(); } } while (0)
#define GAPA(MF, a0, a1, a2, a3, W0, W1, PW) do { MF; sacc += a0; sacc2 += a1; sacc += a2; sacc2 += a3; W0; W1; PIN(PW); PIN(sacc); PIN(sacc2); SBAR(); } while (0)
#define GAPB(MF, X, i) do { MF; X[i] = EX(X[i]); X[i + 1] = EX(X[i + 1]); PIN(X); SBAR(); } while (0)
#define STEP(C0, C1, P0, P1, t, GK, GV, GL) do { SBAR(); \
    const lds_cptr vp_ = vp0 + 2 * sl_prev; \
    VRD(0, 0); SBAR(); float sacc = P0[0], sacc2 = P0[1]; \
                       GAPA(C0 = MFMA32(kf[0], qr[0], f32x16{}), P0[2], P0[3], P0[4], P0[5],     pw0[0] = PKW(P0, 0),  pw0[1] = PKW(P0, 2),  pw0); \
    VRD(4, 4); SBAR(); GAPA(C1 = MFMA32(kf[1], qr[0], f32x16{}), P0[6], P0[7], P0[8], P0[9],     pw0[2] = PKW(P0, 4),  pw0[3] = PKW(P0, 6),  pw0); \
    VRD(1, 1); SBAR(); GAPA(C0 = MFMA32(kf[2], qr[1], C0),       P0[10], P0[11], P0[12], P0[13], pw1[0] = PKW(P0, 8),  pw1[1] = PKW(P0, 10), pw1); \
    VRD(5, 5); SBAR(); GAPA(C1 = MFMA32(kf[3], qr[1], C1),       P0[14], P0[15], P1[0], P1[1],   pw1[2] = PKW(P0, 12), pw1[3] = PKW(P0, 14), pw1); \
    VRD(2, 2); SBAR(); GAPA(C0 = MFMA32(kf[4], qr[2], C0),       P1[2], P1[3], P1[4], P1[5],     pw2[0] = PKW(P1, 0),  pw2[1] = PKW(P1, 2),  pw2); \
    VRD(6, 6); SBAR(); GAPA(C1 = MFMA32(kf[5], qr[2], C1),       P1[6], P1[7], P1[8], P1[9],     pw2[2] = PKW(P1, 4),  pw2[3] = PKW(P1, 6),  pw2); \
    VRD(3, 3); SBAR(); GAPA(C0 = MFMA32(kf[6], qr[3], C0),       P1[10], P1[11], P1[12], P1[13], pw3[0] = PKW(P1, 8),  pw3[1] = PKW(P1, 10), pw3); \
    VRD(7, 7); SBAR(); GAPA(C1 = MFMA32(kf[7], qr[3], C1),       P1[14], P1[15], 0.f, 0.f,       pw3[2] = PKW(P1, 12), pw3[3] = PKW(P1, 14), pw3); \
    l_reg += sacc + sacc2; SBAR(); \
    GAPB(o[0] = MFMA32(PAF(0), VFR(0), o[0]), C0, 0);  VRD(0, 8);  SBAR(); \
    GAPB(o[1] = MFMA32(PAF(0), VFR(4), o[1]), C0, 2);  VRD(4, 12); SBAR(); \
    GAPB(o[0] = MFMA32(PAF(1), VFR(1), o[0]), C0, 4);  VRD(1, 9);  SBAR(); \
    GAPB(o[1] = MFMA32(PAF(1), VFR(5), o[1]), C0, 6);  VRD(5, 13); SBAR(); \
    GAPB(o[0] = MFMA32(PAF(2), VFR(2), o[0]), C0, 8);  VRD(2, 10); SBAR(); \
    GAPB(o[1] = MFMA32(PAF(2), VFR(6), o[1]), C0, 10); VRD(6, 14); SBAR(); \
    GAPB(o[0] = MFMA32(PAF(3), VFR(3), o[0]), C0, 12); VRD(3, 11); SBAR(); \
    GAPB(o[1] = MFMA32(PAF(3), VFR(7), o[1]), C0, 14); VRD(7, 15); SBAR(); \
    KRD(GL, 0); GAPB(o[2] = MFMA32(PAF(0), VFR(0), o[2]), C1, 0); \
    KRD(GL, 1); GAPB(o[3] = MFMA32(PAF(0), VFR(4), o[3]), C1, 2); \
    KRD(GL, 2); GAPB(o[2] = MFMA32(PAF(1), VFR(1), o[2]), C1, 4); \
    KRD(GL, 3); GAPB(o[3] = MFMA32(PAF(1), VFR(5), o[3]), C1, 6); \
    GAPB(o[2] = MFMA32(PAF(2), VFR(2), o[2]), C1, 8);  if (GK) { DMA_K((t) + 3, sl_cur); SBAR(); } \
    GAPB(o[3] = MFMA32(PAF(2), VFR(6), o[3]), C1, 10); if (GV) { DMA_V1((t) + 1, sl_next); SBAR(); } \
    GAPB(o[2] = MFMA32(PAF(3), VFR(3), o[2]), C1, 12); if (GV) { DMA_V2((t) + 1, sl_next); SBAR(); } \
    GAPB(o[3] = MFMA32(PAF(3), VFR(7), o[3]), C1, 14); \
    } while (0)
    int t = 1;
    for (; t + 5 < NT; t += 2) {
        STEP(pB0, pB1, pA0, pA1, t, true, true, true);     WAIT_BAR(3); ROT();
        STEP(pA0, pA1, pB0, pB1, t + 1, true, true, true); WAIT_BAR(3); ROT();
    }
#define ENDW(tt) do { if ((tt) + 3 < NT) { WAIT_BAR(3); } else if ((tt) + 2 < NT) { WAIT_BAR(2); } else { WAIT_BAR(0); } } while (0)
    for (; t + 1 < NT; t += 2) {
        STEP(pB0, pB1, pA0, pA1, t, (t + 3 < NT), (t + 1 < NT), (t + 1 < NT));         ENDW(t);     ROT();
        STEP(pA0, pA1, pB0, pB1, t + 1, (t + 4 < NT), (t + 2 < NT), (t + 2 < NT));     ENDW(t + 1); ROT();
    }
    STEP(pB0, pB1, pA0, pA1, NT - 1, false, false, false);
    { float sacc = pB0[0] + pB0[1];
#pragma unroll
      for (int r = 2; r < 16; ++r) sacc += pB0[r];
#pragma unroll
      for (int r = 0; r < 16; ++r) sacc += pB1[r];
      l_reg += sacc;
      pw0 = (v4u){PKW(pB0, 0), PKW(pB0, 2), PKW(pB0, 4), PKW(pB0, 6)}; pw1 = (v4u){PKW(pB0, 8), PKW(pB0, 10), PKW(pB0, 12), PKW(pB0, 14)};
      pw2 = (v4u){PKW(pB1, 0), PKW(pB1, 2), PKW(pB1, 4), PKW(pB1, 6)}; pw3 = (v4u){PKW(pB1, 8), PKW(pB1, 10), PKW(pB1, 12), PKW(pB1, 14)};
      const lds_cptr vp_ = vp0 + 2 * sl_cur;
      _Pragma("unroll") for (int i = 0; i < 8; ++i) VRD(i, i);
      o[0] = MFMA32(PAF(0), VFR(0), o[0]); o[1] = MFMA32(PAF(0), VFR(4), o[1]); o[0] = MFMA32(PAF(1), VFR(1), o[0]); o[1] = MFMA32(PAF(1), VFR(5), o[1]);
      o[0] = MFMA32(PAF(2), VFR(2), o[0]); o[1] = MFMA32(PAF(2), VFR(6), o[1]); o[0] = MFMA32(PAF(3), VFR(3), o[0]); o[1] = MFMA32(PAF(3), VFR(7), o[1]);
      SBAR();
      _Pragma("unroll") for (int i = 0; i < 8; ++i) VRD(i, 8 + i);
      o[2] = MFMA32(PAF(0), VFR(0), o[2]); o[3] = MFMA32(PAF(0), VFR(4), o[3]); o[2] = MFMA32(PAF(1), VFR(1), o[2]); o[3] = MFMA32(PAF(1), VFR(5), o[3]);
      o[2] = MFMA32(PAF(2), VFR(2), o[2]); o[3] = MFMA32(PAF(2), VFR(6), o[3]); o[2] = MFMA32(PAF(3), VFR(3), o[2]); o[3] = MFMA32(PAF(3), VFR(7), o[3]); }
    { auto rr = __builtin_amdgcn_permlane32_swap(__float_as_uint(l_reg), __float_as_uint(l_reg), false, false); l_reg = __uint_as_float(rr[0]) + __uint_as_float(rr[1]); }
    if (hi == 0) wsf[32 + r32] = l_reg; asm volatile("s_waitcnt lgkmcnt(0)" ::: "memory");
#pragma unroll
    for (int r = 0; r < 16; ++r) { const float rl = __builtin_amdgcn_rcpf(wsf[32 + crow(r, hi)]);
#pragma unroll
        for (int d0 = 0; d0 < 4; ++d0) o[d0][r] *= rl; }
    asm volatile("s_waitcnt lgkmcnt(0)\n\ts_barrier" ::: "memory");
#undef DMA_K
#undef DMA_V
#undef DMA_V1
#undef DMA_V2
#undef ROT
#undef EX
#undef PKW
#undef PAF
#undef VFR
#undef VRD
#undef KRD
#undef ENDW
#undef GAPA
#undef GAPB
#undef STEP
}
}

__device__ __forceinline__ void unit_attn(const Frame& F, int L, int b, int h, int qrow0  , int seq) {
    f32x16 o[4];
    for (int m = 0; m < 2; ++m) {
        const float mfix = F.LP()[L * 16 + 10];
        if (__builtin_expect(mfix * (att::SCALE * 1.4426950408889634f) > 64.f, 0))
            att::body<true>(F.QH() + (size_t)qrow0 * 512 + (h * 2 + m) * 64, F.KH() + (size_t)b * NKEY * 512 + (h * 2 + m) * 64, F.VH() + (size_t)b * NKEY * 512 + h * 128, seq, mfix, (LAS char*)F.lds, o);
        else
            att::body_fast(F.QH() + (size_t)qrow0 * 512 + (h * 2 + m) * 64, F.KH() + (size_t)b * NKEY * 512 + (h * 2 + m) * 64, F.VH() + (size_t)b * NKEY * 512 + h * 128, seq, (LAS char*)F.lds, o);
        if (m == 0) {
            int tid = F.tid; asm volatile("" : "+v"(tid));
            const int lane = tid & 63, wave = __builtin_amdgcn_readfirstlane(tid >> 6), r32 = lane & 31, hi = lane >> 5;
            float* scr = F.SCR() + (size_t)F.bid * 256 * 128 + (size_t)(wave * 32) * 128;
#pragma unroll
            for (int r = 0; r < 16; ++r)
#pragma unroll
                for (int d0 = 0; d0 < 4; ++d0) scr[crow(r, hi) * 128 + d0 * 32 + r32] = o[d0][r];
            asm volatile("s_waitcnt vmcnt(0)" ::: "memory");
        }
    }
    int tid = F.tid; asm volatile("" : "+v"(tid));
    const int lane = tid & 63, wave = __builtin_amdgcn_readfirstlane(tid >> 6), r32 = lane & 31, hi = lane >> 5;
    const float lam = F.LP()[L * 16 + 0], oscale = F.LP()[L * 16 + 1];
    const float* scr = F.SCR() + (size_t)F.bid * 256 * 128 + (size_t)(wave * 32) * 128;
    float sg[4];
#pragma unroll
    for (int d0 = 0; d0 < 4; ++d0) sg[d0] = F.subg()[L * 128 + d0 * 32 + r32] * oscale;
#pragma unroll
    for (int r = 0; r < 16; ++r) {
        float d[4]; float ss = 0.f;
#pragma unroll
        for (int d0 = 0; d0 < 4; ++d0) { d[d0] = scr[crow(r, hi) * 128 + d0 * 32 + r32] - lam * o[d0][r]; ss += d[d0] * d[d0]; }
        const float rs = rsqrtf(half_sum32(ss) * (1.f / 128.f) + EPS);
        bf16* mr = F.MIX() + (size_t)(qrow0 + wave * 32 + crow(r, hi)) * DM + h * 128;
#pragma unroll
        for (int d0 = 0; d0 < 4; ++d0) mr[d0 * 32 + r32] = (bf16)f2bf(d[d0] * rs * sg[d0]);
    }
}


constexpr int NPH_L = 12, NPHASE = 2 + DEPTH * NPH_L;
struct Args { const float* in[25]; float* out; unsigned char* ws; int gp_lo, gp_hi; };
__global__ void __launch_bounds__(NTHR, 2) fwd(Args args) {
    extern __shared__ __attribute__((aligned(16))) unsigned char lds[];
    Frame F;
    F.lds = (LAS unsigned char*)lds;
    F.tid = threadIdx.x; F.lane = F.tid & 63; F.wave = __builtin_amdgcn_readfirstlane(F.tid >> 6); F.bid = blockIdx.x; F.G = gridDim.x;
    F.in = args.in; F.out = args.out; F.ws = args.ws;
    unsigned char* ws = args.ws;
    volatile LAS unsigned* MISC = (volatile LAS unsigned*)(F.lds + MISC_OFF);
    for (int u = F.tid; u < (LDS_BYTES - RING_BYTES) / 4; u += NTHR) ((LAS unsigned*)(F.lds + RING_BYTES))[u] = 0u;
    __syncthreads();
#if MK_ONE_LAUNCH
    constexpr int lo = 0, hi = NPHASE;
#else
    const int lo = args.gp_lo, hi = args.gp_hi;
#endif
    unsigned* barw = (unsigned*)(ws + WS_CTL) + CW_BAR;
    XcdBarrier bar; bar.bar = barw; bar.x = 0; bar.st = nullptr;
    if (hi - lo > 1) bar = xcd_barrier_post(barw, MISC + 8);
#ifndef N_CV_N2
#define N_CV_N2 2
#endif
#ifndef N_CV_INP
#define N_CV_INP 1
#endif
#ifndef N_CV_OUT
#define N_CV_OUT 1
#endif
#ifndef N_CV_TOPK
#define N_CV_TOPK 1
#endif
#ifndef N_CV_DOWN
#define N_CV_DOWN 1
#endif
#ifndef PHM
#define PHM 0xFFFF
#endif
#define PB(i) (((PHM) >> (i)) & 1)
#ifndef DBLM
#define DBLM 0
#endif
#define REP(i) for (int rep_ = 0; rep_ < ((((DBLM) >> (i)) & 1) ? 2 : 1); ++rep_)
#define IN(k) (lo <= (k) && (k) < hi)
#ifndef BARX
#define BARX 1
#endif
#define SEAM(k) do { if (IN(k) && IN((k) + 1)) { for (int bx_ = 0; bx_ < BARX; ++bx_) xcd_barrier(bar); } } while (0)

    if (PB(0) && IN(0)) REP(0) ph_prologue(F);
    SEAM(0);
    if (PB(1) && IN(1)) REP(1) ph_norm1_first(F);
    SEAM(1);
    for (int L = 0; L < DEPTH; ++L) {
        const int base = 2 + NPH_L * L;
#define FRESH() do { F.tid = threadIdx.x; asm volatile("" : "+v"(F.tid)); F.lane = F.tid & 63; } while (0)
        if (PB(2) && IN(base + 0)) REP(2) {
            pg8::Gemm g{F.HN(), F.WIN() + (size_t)L * INC * DM, NROW, INC, DM}; pg8::StaticOrder S; S.init(NROW, INC, F.G, F.bid);
            EpiZ E{F.Z(), F.VH(), F.QH(), F.KH(), F.LP() + DEPTH * 16 + L * 128, F.ROPE()};
            pg8::gemm_phase<EpiZ, pg8::StaticOrder, true, true>(F.lds, g, S, E);
            if (F.bid >= (66 * 13) % 256) { FRESH(); conv_n(F, N_CV_INP); }
        }
        SEAM(base + 0);
        if (PB(3) && IN(base + 1)) REP(3) {
            FRESH();
            for (int u = F.bid; u < 1056; u += F.G) {
                const int v = u < 528 ? u : u - 528; const int b = v / 264, hh = (v / NCH) & 3, cc = v % NCH;
                if (u < 528) unit_retkv(F, L, b, hh, cc); else if (!(L == DEPTH - 1 && cc < 2)) unit_sg(F, L, b, hh, cc);
            }
        }
        SEAM(base + 1);
        if (PB(5) && IN(base + 3)) REP(5) { FRESH(); ph_scan(F, L); }
        SEAM(base + 3);
        if (PB(6) && IN(base + 4)) REP(6) {
            FRESH();
            for (int u = F.bid; u < 264 + 528; u += F.G) {
                if (u < 264) {
                    int b, hh, qrow0, seq;
                    if (u < 256) { const int bh = u & 7, qb = u >> 3; b = bh >> 2; hh = bh & 3; qrow0 = b * SEQ + qb * 256; seq = NKEY; }
                    else { if (L == DEPTH - 1) continue; const int v = u - 256; b = v >> 2; hh = v & 3; qrow0 = NLAT + b * CTXL; seq = CTXL; }
#ifndef NO_ATTN
                    unit_attn(F, L, b, hh, qrow0, seq);
#endif
                } else {
#ifndef NO_RETOUT
                    const int v = u - 264; if (!(L == DEPTH - 1 && (v % NCH) < 2)) unit_retout(F, L, v / 264, (v / NCH) & 3, v % NCH);
#endif
                }
            }
        }
        SEAM(base + 4);
        if (PB(7) && IN(base + 5)) REP(7) {
            pg8::Gemm g{F.MIX(), F.WOUT() + (size_t)L * DM * DM, NLAT, DM, DM}; pg8::StaticOrder S; S.init(NLAT, DM, F.G, F.bid);
#ifdef PROBE_OUT2
            { EpiResid E0{(bf16*)(F.ws + WS_Y), F.MOD() + (size_t)L * 3 * 6144 + 2048, L == 0 ? F.x_in() : nullptr}; pg8::gemm_phase<EpiResid, pg8::StaticOrder, true, true>(F.lds, g, S, E0); }
#endif
            EpiResid E{F.X(), F.MOD() + (size_t)L * 3 * 6144 + 2048, L == 0 ? F.x_in() : nullptr};
            pg8::gemm_phase<EpiResid, pg8::StaticOrder, true, true>(F.lds, g, S, E);
            if (L < DEPTH - 1) { FRESH(); for (int mu = F.bid; mu < 256; mu += F.G) unit_out_ctx(F, L, mu); }
        }
        SEAM(base + 5);
        if (PB(8) && IN(base + 6)) REP(8) { FRESH(); ph_norm2_router(F, L); if (F.bid >= (((L == DEPTH - 1) ? NLAT : NROW) / 16 + NWAVES - 1) / NWAVES) conv_n(F, N_CV_N2); }
        SEAM(base + 6);
        if (PB(9) && IN(base + 7)) REP(9) { FRESH(); ph_topk(F, L); if (F.bid >= ((L == DEPTH - 1) ? 32 : 64)) conv_n(F, N_CV_TOPK);
            conv_until(F, CONV_SEG0 + (unsigned)(L + 1) * CONV_PER_L); }
        SEAM(base + 7);
        if (PB(11) && IN(base + 9)) REP(11) {
            pg8::Gemm g{F.HN(), F.WGU() + (size_t)L * NE * 4096 * DM, NE * EROWS, NE * 4096, DM};        const int npm = (L == DEPTH - 1) ? 8 : 9; MoeOrder S{F.G, F.bid, 16, npm, NE * npm * 16};
            EpiSwiglu E{F.HH()};
            pg8::gemm_phase_ga<EpiSwiglu, MoeOrder>(F.lds, g, S, E, F.ROWIDX(), NROW, (LAS int*)(F.lds + ISLOT_OFF));
        }
        SEAM(base + 9);
        if (PB(12) && IN(base + 10)) REP(12) {
            pg8::Gemm g{F.HH(), F.WD() + (size_t)L * NE * DM * FF, NE * EROWS, NE * DM, FF}; const int npm = (L == DEPTH - 1) ? 8 : 9; MoeOrder S{F.G, F.bid, 4, npm, NE * npm * 4};
            pg8::EpiBf16<0> E{F.Y(), DM, nullptr, DM, 0, 1.f};
            pg8::gemm_phase<pg8::EpiBf16<0>, MoeOrder, true, true>(F.lds, g, S, E);
            if (L < DEPTH - 1 && F.bid >= 64) { FRESH(); conv_n(F, N_CV_DOWN); }
        }
        SEAM(base + 10);
        if (PB(13) && IN(base + 11)) REP(13) { FRESH(); ph_combine(F, L); }
        SEAM(base + 11);
    }
#undef IN
#undef SEAM
}

extern "C" void kernel_launch(void* const* d_in, const int* in_sizes, int n_in, void* d_out, int out_size, void* d_ws, size_t ws_size, hipStream_t stream) {
    static int grid = 0;
    if (grid == 0) {
        if (n_in != 25 || in_sizes[0] != NLAT * DM || out_size != NLAT * DM || ws_size < WS_END) {
            fprintf(stderr, "kernel_launch: built for 25 inputs, x/out of %d floats, >= %zu bytes of workspace; got n_in %d, in0 %d, out %d, ws %zu; nothing launched\n", NLAT * DM, (size_t)WS_END, n_in, n_in > 0 ? in_sizes[0] : -1, out_size, ws_size);
            grid = -1; return; }
        int dev = 0, cus = 0, per_cu = 0;
        if (hipGetDevice(&dev) != hipSuccess || hipDeviceGetAttribute(&cus, hipDeviceAttributeMultiprocessorCount, dev) != hipSuccess) { fprintf(stderr, "kernel_launch: device query failed\n"); grid = -1; return; }
        if (hipFuncSetAttribute((const void*)fwd, hipFuncAttributeMaxDynamicSharedMemorySize, LDS_BYTES) != hipSuccess) { fprintf(stderr, "kernel_launch: hipFuncSetAttribute failed\n"); grid = -1; return; }
        if (hipOccupancyMaxActiveBlocksPerMultiprocessor(&per_cu, (const void*)fwd, NTHR, LDS_BYTES) != hipSuccess || per_cu < 1)
            fprintf(stderr, "kernel_launch: note: occupancy query reports %d workgroups per CU\n", per_cu);
        (void)hipGetLastError();
        grid = cus;
    }
    if (grid < 0) return;
    if (hipMemsetAsync((char*)d_ws + WS_CTL, 0, CTL_ZERO_BYTES, stream) != hipSuccess) { fprintf(stderr, "kernel_launch: memset failed\n"); return; }
    Args a{};
    for (int i = 0; i < 25; ++i) a.in[i] = (const float*)d_in[i];
    a.out = (float*)d_out; a.ws = (unsigned char*)d_ws;
#if MK_ONE_LAUNCH
    a.gp_lo = 0; a.gp_hi = NPHASE;
    hipLaunchKernelGGL(fwd, dim3(grid), dim3(NTHR), LDS_BYTES, stream, a);
#else
    for (int gp = 0; gp < NPHASE; ++gp) { a.gp_lo = gp; a.gp_hi = gp + 1; hipLaunchKernelGGL(fwd, dim3(grid), dim3(NTHR), LDS_BYTES, stream, a); }
#endif
    const hipError_t le = hipPeekAtLastError();
    if (le != hipSuccess) fprintf(stderr, "kernel_launch: launch failed: %s\n", hipGetErrorName(le));
}
```

```cpp
#include <hip/hip_runtime.h>
#include <cstdio>
#include <cstdint>
#ifndef MK_ONE_LAUNCH
#define MK_ONE_LAUNCH 1
#endif
namespace pg8 {
#define PG8_LAS __attribute__((address_space(3)))
typedef unsigned short bf16_t;
typedef short bf16x8 __attribute__((ext_vector_type(8)));
typedef float f32x4 __attribute__((ext_vector_type(4)));
typedef unsigned u32x4 __attribute__((ext_vector_type(4)));
constexpr int BM = 256, BK = 64, HALF = 128, HTB = HALF * BK * 2  , STAGE_BYTES = 8 * HTB, NXCD = 8, WGM = 8;

__host__ __device__ __forceinline__ int lds_byte(int r, int c) { const int st = (r >> 4) * 2 + (c >> 5), rr = r & 15, cc = c & 31, ob = rr * 64 + cc * 2; return st * 1024 + (ob ^ (((ob >> 9) & 1) << 5)); }
__host__ __device__ __forceinline__ void stage_rc(int b, int& R, int& C) { const int st = b / 1024, sb = b % 1024, swz = sb ^ (((sb >> 9) & 1) << 5); R = (st >> 1) * 16 + swz / 64; C = (st & 1) * 32 + (swz % 64) / 2; }
__host__ __device__ __forceinline__ int perm32(int rho) { const int n = rho >> 4, i = rho & 15; return 8 * (i >> 2) + 4 * n + (i & 3); }

struct Unit { int pm, pn; };
struct Gemm { const bf16_t* A; const bf16_t* Bt; int M, N, K; };

struct StaticOrder {
    int nM, nN, nwg, G, c;
    __host__ __device__ void init(int M, int N, int G_, int c_) { nM = M / BM; nN = N / BM; nwg = nM * nN; G = G_; c = c_; }
    __host__ __device__ bool next(int i, Unit& u) const {
        const long L = (long)i * G + c; if (L >= nwg) return false;
        int wgid = (int)L; { const int q = nwg / NXCD, r = nwg % NXCD, xcd = wgid % NXCD, off = wgid / NXCD; wgid = (xcd < r ? xcd * (q + 1) : r * (q + 1) + (xcd - r) * q) + off; }
        const int nig = WGM * nN, gid = wgid / nig, fm = gid * WGM, gsz = (nM - fm) < WGM ? (nM - fm) : WGM;
        u.pm = fm + ((wgid % nig) % gsz); u.pn = (wgid % nig) / gsz; return true;
    }
    __device__ __forceinline__ void a_ready(const Unit&) const {}
    __device__ __forceinline__ void done(const Unit&) const {}
    __device__ __forceinline__ bool half_only(const Unit&) const { return false; }
};

__device__ __forceinline__ unsigned cvt_pk_bf16(float lo, float hi) { unsigned r; asm volatile("v_cvt_pk_bf16_f32 %0, %1, %2" : "=v"(r) : "v"(lo), "v"(hi)); return r; }
typedef float f32x2 __attribute__((ext_vector_type(2)));
__device__ __forceinline__ f32x2 gelu_pk(f32x2 v) {
    const f32x2 av = __builtin_elementwise_abs(v), d = av * 0.2316418882f + 1.0f;
    f32x2 t; t.x = __builtin_amdgcn_rcpf(d.x); t.y = __builtin_amdgcn_rcpf(d.y);
    f32x2 q = t * 0.5307027145f + (-0.7265760135f); q = q * t + 0.7107068705f; q = q * t + (-0.142248368f); q = q * t + 0.127414796f; q = q * t;
    const f32x2 s = (v * v) * (-0.72134752044f);
    f32x2 e; e.x = __builtin_amdgcn_exp2f(s.x); e.y = __builtin_amdgcn_exp2f(s.y);
    const f32x2 m = v * (q * e), r = v - m;
    f32x2 o; o.x = v.x < 0.f ? m.x : r.x; o.y = v.y < 0.f ? m.y : r.y; return o;
}

template <int ACT  > struct EpiBf16 {
    static constexpr bool PERM = true, AFTER_DRAIN = false; static_assert(ACT == 0 || ACT == 1, "EpiBf16: ACT is 0 (none) or 1 (gelu_pk)");
    bf16_t* O; int ldc; const float* bias; int split_cols; size_t split_stride; float scale0;
    __device__ __forceinline__ void operator()(const f32x4 (&acc)[2][2][4][2], const Unit& u, int wr, int wc, int fr, int fq) const {
        const int row0 = u.pm * BM + wr * 64 + fr; int colt = u.pn * BM; bf16_t* base = O;
        float sc = 1.f; if (split_cols) { const int t = colt / split_cols; base += (size_t)t * split_stride; colt -= t * split_cols; if (t == 0) sc = scale0; }
        const int col0 = colt + wc * 32 + 8 * fq, bcol0 = u.pn * BM + wc * 32 + 8 * fq;
        f32x4 bv[2][2];
#pragma unroll
        for (int bj = 0; bj < 2; ++bj)
#pragma unroll
            for (int n = 0; n < 2; ++n) bv[bj][n] = bias ? *(const f32x4*)(bias + bcol0 + bj * HALF + 4 * n) : (f32x4){0.f, 0.f, 0.f, 0.f};
#pragma unroll
        for (int ai = 0; ai < 2; ++ai)
#pragma unroll
            for (int m = 0; m < 4; ++m) { bf16_t* rowp = base + (size_t)(row0 + ai * HALF + m * 16) * ldc + col0;
#pragma unroll
                for (int bj = 0; bj < 2; ++bj) { f32x4 v0 = acc[ai][bj][m][0] + bv[bj][0], v1 = acc[ai][bj][m][1] + bv[bj][1];
                    if (ACT == 1) { f32x2 a = gelu_pk((f32x2){v0[0], v0[1]}), b = gelu_pk((f32x2){v0[2], v0[3]}), c = gelu_pk((f32x2){v1[0], v1[1]}), d = gelu_pk((f32x2){v1[2], v1[3]});
                        v0 = (f32x4){a.x, a.y, b.x, b.y}; v1 = (f32x4){c.x, c.y, d.x, d.y}; }
                    v0 = v0 * sc; v1 = v1 * sc; u32x4 w; w.x = cvt_pk_bf16(v0[0], v0[1]); w.y = cvt_pk_bf16(v0[2], v0[3]); w.z = cvt_pk_bf16(v1[0], v1[1]); w.w = cvt_pk_bf16(v1[2], v1[3]);
                    *(u32x4*)(rowp + bj * HALF) = w; } }
    }
};
template <class Epi, class Sched, bool ALIGN_EPI = false, bool SP2 = false>
__device__ __forceinline__ void gemm_phase(PG8_LAS unsigned char* lds, const Gemm g, const Sched& S, const Epi& E) {
    int tid = threadIdx.x; asm volatile("" : "+v"(tid));
    const int wid = __builtin_amdgcn_readfirstlane(tid >> 6), lane = tid & 63, wr = wid >> 2, wc = wid & 3, fr = lane & 15, fq = lane >> 4;
    const int K = g.K, nt = K / BK;
    unsigned voffA[2], voffB[2];
#pragma unroll
    for (int i = 0; i < 2; ++i) { int R, C; stage_rc(tid * 16 + i * 8192, R, C); const int Rb = Epi::PERM ? ((R & ~31) + perm32(R & 31)) : R;
        voffA[i] = (unsigned)(R * K + C) * 2u; voffB[i] = (unsigned)(Rb * K + C) * 2u; }
    const size_t kstep = (size_t)(BK * 2);
    const size_t hstep = (size_t)HALF * K * 2;
    const size_t tstep = 2 * hstep;
    const unsigned ldsw = (unsigned)wid * 1024u;
    const int aoff = lds_byte(wr * 64 + fr, fq * 8), boff = lds_byte(wc * 32 + fr, fq * 8);
#define PG8_SA(b, h) (((b) * 2 + (h)) * HTB)
#define PG8_SB(b, h) ((4 + (b) * 2 + (h)) * HTB)
#define PG8_STAGE(bufoff, gbase, voff) do { _Pragma("unroll") for (int _i = 0; _i < 2; ++_i) \
        __builtin_amdgcn_global_load_lds((const unsigned*)((const char*)(gbase) + (voff)[_i]), (PG8_LAS unsigned*)(lds + (bufoff) + ldsw + _i * 8192), 16, 0, 0); } while (0)
#define PG8_LDA(dst, b, h) do { _Pragma("unroll") for (int m = 0; m < 4; ++m) _Pragma("unroll") for (int k = 0; k < 2; ++k) dst[m][k] = *(const PG8_LAS bf16x8*)(lds + PG8_SA(b, h) + aoff + m * 2048 + k * 1024); } while (0)
#define PG8_LDB(dst, b, h) do { _Pragma("unroll") for (int n = 0; n < 2; ++n) _Pragma("unroll") for (int k = 0; k < 2; ++k) dst[n][k] = *(const PG8_LAS bf16x8*)(lds + PG8_SB(b, h) + boff + n * 2048 + k * 1024); } while (0)
#define PG8_MMA(ai, bj, At, Bt) do { __builtin_amdgcn_s_setprio(1); _Pragma("unroll") for (int m = 0; m < 4; ++m) _Pragma("unroll") for (int n = 0; n < 2; ++n) _Pragma("unroll") for (int k = 0; k < 2; ++k) \
        acc[ai][bj][m][n] = __builtin_amdgcn_mfma_f32_16x16x32_bf16(Bt[n][k], At[m][k], acc[ai][bj][m][n], 0, 0, 0); __builtin_amdgcn_s_setprio(0); } while (0)
#define PG8_WAIT_V(n) asm volatile("s_waitcnt vmcnt(" #n ")" ::: "memory")
#define PG8_WAIT_L(n) asm volatile("s_waitcnt lgkmcnt(" #n ")" ::: "memory")
#define PG8_BAR __builtin_amdgcn_s_barrier()
#define PG8_SCHED __builtin_amdgcn_sched_barrier(0)
    Unit cur, nxt; int ui = 0;
    if (!S.next(0, cur)) return;
    f32x4 acc[2][2][4][2];
#pragma unroll
    for (int a = 0; a < 2; ++a)
#pragma unroll
        for (int b = 0; b < 2; ++b)
#pragma unroll
            for (int m = 0; m < 4; ++m)
#pragma unroll
                for (int n = 0; n < 2; ++n) acc[a][b][m][n] = (f32x4){0.f, 0.f, 0.f, 0.f};
    bf16x8 At[4][2], B0[2][2], B1[2][2];
    const char* cA = (const char*)g.A + (size_t)cur.pm * tstep; const char* cB = (const char*)g.Bt + (size_t)cur.pn * tstep;
    S.a_ready(cur);
    if constexpr (SP2) {
        PG8_STAGE(PG8_SB(0, 0), cB, voffB); PG8_STAGE(PG8_SB(0, 1), cB + hstep, voffB); PG8_STAGE(PG8_SA(0, 0), cA, voffA); PG8_STAGE(PG8_SA(0, 1), cA + hstep, voffA);
        if (wr == 1) PG8_BAR;
        PG8_WAIT_V(2); PG8_BAR;
        PG8_STAGE(PG8_SB(1, 0), cB + kstep, voffB); PG8_STAGE(PG8_SA(1, 0), cA + kstep, voffA); PG8_STAGE(PG8_SB(1, 1), cB + hstep + kstep, voffB);
        PG8_WAIT_V(6); PG8_BAR;
    } else {
        PG8_STAGE(PG8_SB(0, 0), cB, voffB); PG8_STAGE(PG8_SA(0, 0), cA, voffA); PG8_STAGE(PG8_SB(0, 1), cB + hstep, voffB); PG8_STAGE(PG8_SA(0, 1), cA + hstep, voffA);
        if (wr == 1) PG8_BAR;
        PG8_WAIT_V(4); PG8_BAR;
        PG8_STAGE(PG8_SB(1, 0), cB + kstep, voffB); PG8_STAGE(PG8_SA(1, 0), cA + kstep, voffA); PG8_STAGE(PG8_SB(1, 1), cB + hstep + kstep, voffB);
        PG8_WAIT_V(6); PG8_BAR;
    }
    for (;;) {
        const bool has_next = S.next(ui + 1, nxt);
        const bool ho = S.half_only(cur);
        const char* nA = has_next ? (const char*)g.A + (size_t)nxt.pm * tstep : cA; const char* nB = has_next ? (const char*)g.Bt + (size_t)nxt.pn * tstep : cB;
        for (int t = 0; t < nt; t += 2) {
            const bool last = (t == nt - 2);
            const char* a1 = cA + (size_t)(t + 1) * kstep;
            const char* a2 = last ? nA : cA + (size_t)(t + 2) * kstep; const char* b2 = last ? nB : cB + (size_t)(t + 2) * kstep;
            const char* a3 = a2 + kstep; const char* b3 = b2 + kstep;
            if (last && has_next) S.a_ready(nxt);
            if constexpr (SP2) {
            PG8_LDB(B0, 0, 0); PG8_LDB(B1, 0, 1); PG8_SCHED; PG8_LDA(At, 0, 0); PG8_STAGE(PG8_SA(1, 1), a1 + hstep, voffA);
            PG8_WAIT_V(8); PG8_WAIT_L(0); PG8_BAR; PG8_MMA(0, 0, At, B0); PG8_MMA(0, 1, At, B1); PG8_BAR; PG8_SCHED;
            PG8_LDA(At, 0, 1); PG8_STAGE(PG8_SB(0, 0), b2, voffB); PG8_STAGE(PG8_SB(0, 1), b2 + hstep, voffB); PG8_STAGE(PG8_SA(0, 0), a2, voffA);
            PG8_WAIT_V(8); PG8_WAIT_L(0); PG8_BAR; if (!ho) { PG8_MMA(1, 0, At, B0); PG8_MMA(1, 1, At, B1); } PG8_BAR; PG8_SCHED;
            PG8_LDB(B0, 1, 0); PG8_LDB(B1, 1, 1); PG8_SCHED; PG8_LDA(At, 1, 0); PG8_STAGE(PG8_SA(0, 1), a2 + hstep, voffA);
            PG8_WAIT_V(8); PG8_WAIT_L(0); PG8_BAR; PG8_MMA(0, 0, At, B0); PG8_MMA(0, 1, At, B1); PG8_BAR; PG8_SCHED;
            PG8_LDA(At, 1, 1); PG8_STAGE(PG8_SB(1, 0), b3, voffB); PG8_STAGE(PG8_SB(1, 1), b3 + hstep, voffB); PG8_STAGE(PG8_SA(1, 0), a3, voffA);
            PG8_WAIT_V(8); PG8_WAIT_L(0); PG8_BAR; if (!ho) { PG8_MMA(1, 0, At, B0); PG8_MMA(1, 1, At, B1); } PG8_BAR; PG8_SCHED;
            } else {
            PG8_LDB(B0, 0, 0); PG8_SCHED; PG8_LDA(At, 0, 0); PG8_STAGE(PG8_SA(1, 1), a1 + hstep, voffA);
            PG8_WAIT_L(8); PG8_BAR; PG8_WAIT_L(0); PG8_MMA(0, 0, At, B0); PG8_BAR; PG8_SCHED;
            PG8_LDB(B1, 0, 1); PG8_STAGE(PG8_SB(0, 0), b2, voffB);
            PG8_BAR; PG8_WAIT_L(0); PG8_MMA(0, 1, At, B1); PG8_BAR;
            PG8_LDA(At, 0, 1); PG8_STAGE(PG8_SA(0, 0), a2, voffA);
            PG8_BAR; PG8_WAIT_L(0); PG8_MMA(1, 0, At, B0); PG8_BAR; PG8_SCHED;
            PG8_STAGE(PG8_SB(0, 1), b2 + hstep, voffB);
            PG8_WAIT_V(6); PG8_BAR; PG8_MMA(1, 1, At, B1); PG8_BAR;
            PG8_LDB(B0, 1, 0); PG8_SCHED; PG8_LDA(At, 1, 0); PG8_STAGE(PG8_SA(0, 1), a2 + hstep, voffA);
            PG8_WAIT_L(8); PG8_BAR; PG8_WAIT_L(0); PG8_MMA(0, 0, At, B0); PG8_BAR; PG8_SCHED;
            PG8_LDB(B1, 1, 1); PG8_STAGE(PG8_SB(1, 0), b3, voffB);
            PG8_BAR; PG8_WAIT_L(0); PG8_MMA(0, 1, At, B1); PG8_BAR;
            PG8_LDA(At, 1, 1); PG8_STAGE(PG8_SA(1, 0), a3, voffA);
            PG8_BAR; PG8_WAIT_L(0); PG8_MMA(1, 0, At, B0); PG8_BAR; PG8_SCHED;
            PG8_STAGE(PG8_SB(1, 1), b3 + hstep, voffB);
            PG8_WAIT_V(6); PG8_BAR; PG8_MMA(1, 1, At, B1); PG8_BAR;
            }
        }
        if constexpr (ALIGN_EPI) { if (wr == 0) PG8_BAR; }
        if constexpr (!Epi::AFTER_DRAIN) { E(acc, cur, wr, wc, fr, fq); S.done(cur); }
        if (!has_next) break;
#pragma unroll
        for (int a = 0; a < 2; ++a)
#pragma unroll
            for (int b = 0; b < 2; ++b)
#pragma unroll
                for (int m = 0; m < 4; ++m)
#pragma unroll
                    for (int n = 0; n < 2; ++n) acc[a][b][m][n] = (f32x4){0.f, 0.f, 0.f, 0.f};
        cur = nxt; cA = nA; cB = nB; ++ui;
        if constexpr (ALIGN_EPI) { if (wr == 1) PG8_BAR; }
    }
    PG8_WAIT_V(0);
    if constexpr (!ALIGN_EPI) { if (wr == 0) PG8_BAR; }
    PG8_BAR;
    if constexpr (Epi::AFTER_DRAIN) { E.fused(acc, cur, wr, wc, fr, fq, lds, wid, lane); S.done(cur); }
#undef PG8_SA
#undef PG8_SB
#undef PG8_STAGE
#undef PG8_LDA
#undef PG8_LDB
#undef PG8_MMA
#undef PG8_WAIT_V
#undef PG8_WAIT_L
#undef PG8_BAR
#undef PG8_SCHED
}
}
namespace pg8 {
template <class Epi, class Sched>
__device__ __forceinline__ void gemm_phase_ga(PG8_LAS unsigned char* lds, const Gemm g, const Sched& S, const Epi& E, const int* rowidx, int zrow, PG8_LAS int* islot) {
    constexpr bool ALIGN_EPI = true;
    int tid = threadIdx.x; asm volatile("" : "+v"(tid));
    const int wid = __builtin_amdgcn_readfirstlane(tid >> 6), lane = tid & 63, wr = wid >> 2, wc = wid & 3, fr = lane & 15, fq = lane >> 4;
    const int K = g.K, nt = K / BK;
    unsigned voffB[2]; int RA[2], CA[2];
#pragma unroll
    for (int i = 0; i < 2; ++i) { int R, C; stage_rc(tid * 16 + i * 8192, R, C); const int Rb = Epi::PERM ? ((R & ~31) + perm32(R & 31)) : R;
        RA[i] = R; CA[i] = C; voffB[i] = (unsigned)(Rb * K + C) * 2u; }
    unsigned voC[2][2], voN[2][2];
    const size_t kstep = (size_t)(BK * 2);
    const size_t hstep = (size_t)HALF * K * 2;
    const size_t tstep = 2 * hstep;
    const unsigned ldsw = (unsigned)wid * 1024u;
    const int aoff = lds_byte(wr * 64 + fr, fq * 8), boff = lds_byte(wc * 32 + fr, fq * 8);
#define PG8_SA(b, h) (((b) * 2 + (h)) * HTB)
#define PG8_SB(b, h) ((4 + (b) * 2 + (h)) * HTB)
#define PG8_STAGE(bufoff, gbase, voff) do { _Pragma("unroll") for (int _i = 0; _i < 2; ++_i) \
        __builtin_amdgcn_global_load_lds((const unsigned*)((const char*)(gbase) + (voff)[_i]), (PG8_LAS unsigned*)(lds + (bufoff) + ldsw + _i * 8192), 16, 0, 0); } while (0)
#define PG8_LDA(dst, b, h) do { _Pragma("unroll") for (int m = 0; m < 4; ++m) _Pragma("unroll") for (int k = 0; k < 2; ++k) dst[m][k] = *(const PG8_LAS bf16x8*)(lds + PG8_SA(b, h) + aoff + m * 2048 + k * 1024); } while (0)
#define PG8_LDB(dst, b, h) do { _Pragma("unroll") for (int n = 0; n < 2; ++n) _Pragma("unroll") for (int k = 0; k < 2; ++k) dst[n][k] = *(const PG8_LAS bf16x8*)(lds + PG8_SB(b, h) + boff + n * 2048 + k * 1024); } while (0)
#define PG8_MMA(ai, bj, At, Bt) do { __builtin_amdgcn_s_setprio(1); _Pragma("unroll") for (int m = 0; m < 4; ++m) _Pragma("unroll") for (int n = 0; n < 2; ++n) _Pragma("unroll") for (int k = 0; k < 2; ++k) \
        acc[ai][bj][m][n] = __builtin_amdgcn_mfma_f32_16x16x32_bf16(Bt[n][k], At[m][k], acc[ai][bj][m][n], 0, 0, 0); __builtin_amdgcn_s_setprio(0); } while (0)
#define PG8_WAIT_V(n) asm volatile("s_waitcnt vmcnt(" #n ")" ::: "memory")
#define PG8_WAIT_L(n) asm volatile("s_waitcnt lgkmcnt(" #n ")" ::: "memory")
#define PG8_BAR __builtin_amdgcn_s_barrier()
#define PG8_SCHED __builtin_amdgcn_sched_barrier(0)
    constexpr bool SP2 = true;
    Unit cur, nxt; int ui = 0;
    if (!S.next(0, cur)) return;
    f32x4 acc[2][2][4][2];
#pragma unroll
    for (int a = 0; a < 2; ++a)
#pragma unroll
        for (int b = 0; b < 2; ++b)
#pragma unroll
            for (int m = 0; m < 4; ++m)
#pragma unroll
                for (int n = 0; n < 2; ++n) acc[a][b][m][n] = (f32x4){0.f, 0.f, 0.f, 0.f};
    bf16x8 At[4][2], B0[2][2], B1[2][2];
    const char* const Ab = (const char*)g.A; const char* cB = (const char*)g.Bt + (size_t)cur.pn * tstep;
    S.a_ready(cur);
#pragma unroll
    for (int h = 0; h < 2; ++h)
#pragma unroll
        for (int i = 0; i < 2; ++i) { const int s = rowidx[cur.pm * BM + h * HALF + RA[i]]; voC[h][i] = (unsigned)((s < 0 ? zrow : s) * K + CA[i]) * 2u; voN[h][i] = voC[h][i]; }
    asm volatile("s_waitcnt vmcnt(0)" ::: "memory");
    if constexpr (SP2) {
        PG8_STAGE(PG8_SB(0, 0), cB, voffB); PG8_STAGE(PG8_SB(0, 1), cB + hstep, voffB); PG8_STAGE(PG8_SA(0, 0), Ab, voC[0]); PG8_STAGE(PG8_SA(0, 1), Ab, voC[1]);
        if (wr == 1) PG8_BAR;
        PG8_WAIT_V(2); PG8_BAR;
        PG8_STAGE(PG8_SB(1, 0), cB + kstep, voffB); PG8_STAGE(PG8_SA(1, 0), Ab + kstep, voC[0]); PG8_STAGE(PG8_SB(1, 1), cB + hstep + kstep, voffB);
        PG8_WAIT_V(6); PG8_BAR;
    }
    for (;;) {
        const bool has_next = S.next(ui + 1, nxt);
        const bool ho = S.half_only(cur);
        const char* nB = has_next ? (const char*)g.Bt + (size_t)nxt.pn * tstep : cB;
        if (has_next && wid == 0) __builtin_amdgcn_global_load_lds((const unsigned*)(rowidx + nxt.pm * BM + lane * 4), (PG8_LAS unsigned*)(islot + ((ui + 1) & 1) * BM), 16, 0, 0);
        for (int t = 0; t < nt; t += 2) {
            const bool last = (t == nt - 2);
            const char* a1 = Ab + (size_t)(t + 1) * kstep;
            const char* a2 = last ? Ab : Ab + (size_t)(t + 2) * kstep; const char* b2 = last ? nB : cB + (size_t)(t + 2) * kstep;
            const char* a3 = a2 + kstep; const char* b3 = b2 + kstep;
            if (last && has_next) { S.a_ready(nxt);
                const PG8_LAS int* sl = islot + ((ui + 1) & 1) * BM;
#pragma unroll
                for (int h = 0; h < 2; ++h)
#pragma unroll
                    for (int i = 0; i < 2; ++i) { const int s = sl[h * HALF + RA[i]]; voN[h][i] = (unsigned)((s < 0 ? zrow : s) * K + CA[i]) * 2u; } }
            unsigned vo2[2][2];
#pragma unroll
            for (int h = 0; h < 2; ++h)
#pragma unroll
                for (int i = 0; i < 2; ++i) vo2[h][i] = last ? voN[h][i] : voC[h][i];
            if constexpr (SP2) {
            PG8_LDB(B0, 0, 0); PG8_LDB(B1, 0, 1); PG8_SCHED; PG8_LDA(At, 0, 0); PG8_STAGE(PG8_SA(1, 1), a1, voC[1]);
            PG8_WAIT_V(8); PG8_WAIT_L(0); PG8_BAR; PG8_MMA(0, 0, At, B0); PG8_MMA(0, 1, At, B1); PG8_BAR; PG8_SCHED;
            PG8_LDA(At, 0, 1); PG8_STAGE(PG8_SB(0, 0), b2, voffB); PG8_STAGE(PG8_SB(0, 1), b2 + hstep, voffB); PG8_STAGE(PG8_SA(0, 0), a2, vo2[0]);
            PG8_WAIT_V(8); PG8_WAIT_L(0); PG8_BAR; if (!ho) { PG8_MMA(1, 0, At, B0); PG8_MMA(1, 1, At, B1); } PG8_BAR; PG8_SCHED;
            PG8_LDB(B0, 1, 0); PG8_LDB(B1, 1, 1); PG8_SCHED; PG8_LDA(At, 1, 0); PG8_STAGE(PG8_SA(0, 1), a2, vo2[1]);
            PG8_WAIT_V(8); PG8_WAIT_L(0); PG8_BAR; PG8_MMA(0, 0, At, B0); PG8_MMA(0, 1, At, B1); PG8_BAR; PG8_SCHED;
            PG8_LDA(At, 1, 1); PG8_STAGE(PG8_SB(1, 0), b3, voffB); PG8_STAGE(PG8_SB(1, 1), b3 + hstep, voffB); PG8_STAGE(PG8_SA(1, 0), a3, vo2[0]);
            PG8_WAIT_V(8); PG8_WAIT_L(0); PG8_BAR; if (!ho) { PG8_MMA(1, 0, At, B0); PG8_MMA(1, 1, At, B1); } PG8_BAR; PG8_SCHED;
            }
        }
        if constexpr (ALIGN_EPI) { if (wr == 0) PG8_BAR; }
        if constexpr (!Epi::AFTER_DRAIN) { E(acc, cur, wr, wc, fr, fq); S.done(cur); }
        if (!has_next) break;
#pragma unroll
        for (int a = 0; a < 2; ++a)
#pragma unroll
            for (int b = 0; b < 2; ++b)
#pragma unroll
                for (int m = 0; m < 4; ++m)
#pragma unroll
                    for (int n = 0; n < 2; ++n) acc[a][b][m][n] = (f32x4){0.f, 0.f, 0.f, 0.f};
        cur = nxt; cB = nB; ++ui;
#pragma unroll
        for (int h = 0; h < 2; ++h)
#pragma unroll
            for (int i = 0; i < 2; ++i) voC[h][i] = voN[h][i];
        if constexpr (ALIGN_EPI) { if (wr == 1) PG8_BAR; }
    }
    PG8_WAIT_V(0);
    if constexpr (!ALIGN_EPI) { if (wr == 0) PG8_BAR; }
    PG8_BAR;
    if constexpr (Epi::AFTER_DRAIN) { E.fused(acc, cur, wr, wc, fr, fq, lds, wid, lane); S.done(cur); }
#undef PG8_SA
#undef PG8_SB
#undef PG8_STAGE
#undef PG8_LDA
#undef PG8_LDB
#undef PG8_MMA
#undef PG8_WAIT_V
#undef PG8_WAIT_L
#undef PG8_BAR
#undef PG8_SCHED
}
}

constexpr int DM = 1024, NB = 2, SEQ = 8192, CTXL = 256, DEPTH = 4;
constexpr int NLAT = NB * SEQ, NCTX = NB * CTXL, NROW = NLAT + NCTX;
constexpr int INC = 3328, NKEY = CTXL + SEQ;
constexpr int NE = 16, FF = 2048, EROWS = 2304;
constexpr int NCH = 66;
constexpr float EPS = 1e-6f;
constexpr int ZQ = 0, ZK = 512, ZV = 1024, ZRQ = 1536, ZRK = 1792, ZRV = 2048, ZGF = 2304, ZGB = 2560, ZSU = 2816, ZSV = 3072;
constexpr int NWAVES = 8, NTHR = 512;
constexpr int RWLD = DM + 8;

constexpr size_t MiB = 1u << 20;
constexpr size_t WS_CTL = 0, CTL_ZERO_BYTES = 1 * MiB;
constexpr size_t WS_MOD = 1 * MiB;
constexpr size_t WS_LP = WS_MOD + 512 * 1024;
constexpr size_t WS_ROPE = 2 * MiB, WS_RETT = 4 * MiB;
constexpr size_t WS_SGW = 6 * MiB;
constexpr size_t WS_RWS = 7 * MiB;
constexpr size_t WS_WIN = 8 * MiB;
constexpr size_t WS_WOUT = WS_WIN + 26 * MiB;
constexpr size_t WS_WGU = WS_WOUT + 8 * MiB;
constexpr size_t WS_WD = WS_WGU + 512 * MiB;
constexpr size_t WS_X = WS_WD + 256 * MiB;
constexpr size_t WS_HN = WS_X + 66 * MiB;
constexpr size_t WS_Z = WS_HN + 34 * MiB;
constexpr size_t WS_QH = WS_Z + 108 * MiB;
constexpr size_t WS_KH = WS_QH + 17 * MiB;
constexpr size_t WS_VH = WS_KH + 17 * MiB;
constexpr size_t WS_RQ = WS_VH + 17 * MiB;
constexpr size_t WS_RK = WS_RQ + 9 * MiB;
constexpr size_t WS_SVN = WS_RK + 9 * MiB;
constexpr size_t WS_KVT = WS_SVN + 9 * MiB;
constexpr size_t WS_SPREV = WS_KVT + 17 * MiB;
constexpr size_t WS_MIX = WS_SPREV + 17 * MiB;
constexpr size_t WS_SCR = WS_MIX + 33 * MiB;
constexpr size_t WS_AFF = WS_SCR + 32 * MiB;
constexpr size_t WS_SLOT = WS_AFF + 2 * MiB;
constexpr size_t WS_ROWIDX = WS_SLOT + 2 * MiB;
constexpr size_t WS_GATE = WS_ROWIDX + 1 * MiB;
constexpr size_t WS_XS = WS_GATE + 1 * MiB;
constexpr size_t WS_HH = WS_XS + 72 * MiB;
constexpr size_t WS_Y = WS_HH + 144 * MiB;
constexpr size_t WS_END = WS_Y + 72 * MiB;
static_assert((size_t)4 * INC * DM * 2 <= 26 * MiB && (size_t)NROW * DM * 4 <= 66 * MiB && (size_t)NROW * INC * 2 <= 108 * MiB && (size_t)NROW * 512 * 2 <= 17 * MiB, "ws map");
static_assert((size_t)NB * 4 * 2 * NCH * 4096 * 4 <= 17 * MiB && (size_t)NE * EROWS * DM * 2 <= 72 * MiB && (size_t)NE * EROWS * FF * 2 <= 144 * MiB, "ws map");
constexpr int CW_BAR = 4096;

constexpr int RING_BYTES = 131072;
constexpr int MISC_OFF = RING_BYTES + 320;
constexpr int ISLOT_OFF = RING_BYTES + 1024;
constexpr int LDS_BYTES = 147456;

#define GAS __attribute__((address_space(1)))
#define LAS __attribute__((address_space(3)))
typedef unsigned short bf16;
typedef unsigned v4u __attribute__((ext_vector_type(4)));
typedef float f32x4 __attribute__((ext_vector_type(4)));
typedef short bf16x8 __attribute__((ext_vector_type(8)));
typedef GAS unsigned gu32;
typedef GAS unsigned long long gu64;
#define RLX_AGENT __ATOMIC_RELAXED, __HIP_MEMORY_SCOPE_AGENT
#define LDS_WAIT() asm volatile("s_waitcnt lgkmcnt(0)" ::: "memory")
#define VM_WAIT() asm volatile("s_waitcnt vmcnt(0)" ::: "memory")
__device__ __forceinline__ unsigned long long rt() { return __builtin_amdgcn_s_memrealtime(); }
__device__ __forceinline__ unsigned f2bf(float f) { unsigned u = __builtin_bit_cast(unsigned, f); return (u + 0x7fffu + ((u >> 16) & 1u)) >> 16; }
__device__ __forceinline__ unsigned pk2(float lo, float hi) { return f2bf(lo) | (f2bf(hi) << 16); }

#define XB_TMO      128
#define XB_XCNT(j)  (256  + 64 * (j))
#define XB_XSUB(j)  (1280 + 64 * (j))
#define XB_XGEN(j)  (2304 + 64 * (j))
#define XB_TOP      3328
#define XB_TOPGEN   3392
#define XCD_BAR_WORDS 3456
#define XB_SPIN_CAP (1u << 18)

__device__ __forceinline__ unsigned xb_ld(unsigned* p)              { return __hip_atomic_load(p, __ATOMIC_RELAXED, __HIP_MEMORY_SCOPE_AGENT); }
__device__ __forceinline__ unsigned xb_add(unsigned* p, unsigned v) { return __hip_atomic_fetch_add(p, v, __ATOMIC_RELAXED, __HIP_MEMORY_SCOPE_AGENT); }
__device__ __forceinline__ unsigned xb_xcc_id() { return (unsigned)__builtin_amdgcn_s_getreg((3 << 11) | 20) & 0xFu; }
#define XB_SPIN(cond, bar) do { unsigned _sp = 0; while (cond) { __builtin_amdgcn_s_sleep(1); \
    if ((++_sp & 255u) == 0u) { if (xb_ld(&(bar)[XB_TMO])) break; if (_sp > XB_SPIN_CAP) { atomicAdd(&(bar)[XB_TMO], 1u); break; } } } } while (0)

struct XcdBarrier {
    unsigned* bar; unsigned x;
    volatile LAS unsigned* st;
};

__device__ __forceinline__ XcdBarrier xcd_barrier_post(unsigned* bar, volatile LAS unsigned* st) {
    XcdBarrier b; b.bar = bar; b.x = xb_xcc_id(); b.st = st;
    if (threadIdx.x == 0) (void)xb_add(&bar[XB_XCNT(b.x)], 1u);
    return b;
}
__device__ __forceinline__ void xcd_barrier_complete(unsigned* bar, unsigned x, unsigned& nloc, unsigned& nx) {
    const unsigned G = gridDim.x * gridDim.y * gridDim.z;
    unsigned sum, cnt, mine, sp = 0u;
    for (;;) {
        sum = 0u; cnt = 0u; mine = 0u;
#pragma unroll
        for (unsigned j = 0; j < 16; ++j) { const unsigned c = xb_ld(&bar[XB_XCNT(j)]); sum += c; cnt += (c > 0u) ? 1u : 0u; mine = (j == x) ? c : mine; }
        if (sum == G) break;
        __builtin_amdgcn_s_sleep(1);
        if ((++sp & 255u) == 0u) { if (xb_ld(&bar[XB_TMO])) break; if (sp > XB_SPIN_CAP) { atomicAdd(&bar[XB_TMO], 1u); break; } }
    }
    nloc = mine > 0u ? mine : 1u; nx = cnt > 0u ? cnt : 1u;
}

__device__ __forceinline__ void xcd_barrier(const XcdBarrier& b) {
    asm volatile("s_waitcnt vmcnt(0)" ::: "memory");
    __syncthreads();
    if (threadIdx.x == 0) {
        unsigned* bar = b.bar;
        __builtin_amdgcn_s_waitcnt(0);
        unsigned nloc = b.st[0], nx = b.st[1];
        if (nloc == 0u) { xcd_barrier_complete(bar, b.x, nloc, nx); b.st[0] = nloc; b.st[1] = nx; }
        const unsigned old = xb_add(&bar[XB_XSUB(b.x)], 1u);
        const unsigned gen = old / nloc;
        if (old + 1u == (gen + 1u) * nloc) {
            __builtin_amdgcn_fence(__ATOMIC_RELEASE, "agent");
            asm volatile("s_waitcnt vmcnt(0)" ::: "memory");
            const unsigned og = xb_add(&bar[XB_TOP], 1u);
            const unsigned tg = og / nx;
            if (og + 1u == (tg + 1u) * nx) xb_add(&bar[XB_TOPGEN], 1u);
            else XB_SPIN(xb_ld(&bar[XB_TOPGEN]) == tg, bar);
            __builtin_amdgcn_fence(__ATOMIC_ACQUIRE, "agent");
            xb_add(&bar[XB_XGEN(b.x)], 1u);
            asm volatile("s_waitcnt vmcnt(0)" ::: "memory");
        } else {
            XB_SPIN(xb_ld(&bar[XB_XGEN(b.x)]) == gen, bar);
            __builtin_amdgcn_fence(__ATOMIC_ACQUIRE, "agent");
            asm volatile("s_waitcnt vmcnt(0)" ::: "memory");
        }
    }
    __syncthreads();
}

typedef float f32x16 __attribute__((ext_vector_type(16)));
typedef short s16x4 __attribute__((ext_vector_type(4)));
typedef unsigned short u16x4 __attribute__((ext_vector_type(4)));
struct Frame {
    LAS unsigned char* lds;
    int tid, lane, wave, bid, G;
    const float* const* in;
    float* out;
    unsigned char* ws;
    __device__ __forceinline__ const float* x_in() const { return in[0]; }
    __device__ __forceinline__ const float* c_in() const { return in[1]; }
    __device__ __forceinline__ const float* ctx_in() const { return in[2]; }
    __device__ __forceinline__ const float* cctx_in() const { return in[3]; }
    __device__ __forceinline__ const float* w_mod() const { return in[4]; }
    __device__ __forceinline__ const float* b_mod() const { return in[5]; }
    __device__ __forceinline__ const float* n1g() const { return in[6]; }
    __device__ __forceinline__ const float* n2g() const { return in[7]; }
    __device__ __forceinline__ const float* w_in() const { return in[8]; }
    __device__ __forceinline__ const float* w_out() const { return in[9]; }
    __device__ __forceinline__ const float* qng() const { return in[10]; }
    __device__ __forceinline__ const float* kng() const { return in[11]; }
    __device__ __forceinline__ const float* lq1() const { return in[12]; }
    __device__ __forceinline__ const float* lk1() const { return in[13]; }
    __device__ __forceinline__ const float* lq2() const { return in[14]; }
    __device__ __forceinline__ const float* lk2() const { return in[15]; }
    __device__ __forceinline__ const float* subg() const { return in[16]; }
    __device__ __forceinline__ const float* retd() const { return in[17]; }
    __device__ __forceinline__ const float* sgng() const { return in[18]; }
    __device__ __forceinline__ const float* sgw() const { return in[19]; }
    __device__ __forceinline__ const float* sgb() const { return in[20]; }
    __device__ __forceinline__ const float* rw() const { return in[21]; }
    __device__ __forceinline__ const float* wg() const { return in[22]; }
    __device__ __forceinline__ const float* wu() const { return in[23]; }
    __device__ __forceinline__ const float* wd() const { return in[24]; }
    __device__ __forceinline__ float* MOD() const { return (float*)(ws + WS_MOD); }
    __device__ __forceinline__ float* LP() const { return (float*)(ws + WS_LP); }
    __device__ __forceinline__ float* ROPE() const { return (float*)(ws + WS_ROPE); }
    __device__ __forceinline__ float* RETT() const { return (float*)(ws + WS_RETT); }
    __device__ __forceinline__ bf16* X() const { return (bf16*)(ws + WS_X); }
    __device__ __forceinline__ float* KVT() const { return (float*)(ws + WS_KVT); }
    __device__ __forceinline__ bf16* SPREV() const { return (bf16*)(ws + WS_SPREV); }
    __device__ __forceinline__ float* SCR() const { return (float*)(ws + WS_SCR); }
    __device__ __forceinline__ float* AFF() const { return (float*)(ws + WS_AFF); }
    __device__ __forceinline__ float* GATE() const { return (float*)(ws + WS_GATE); }
    __device__ __forceinline__ bf16* SGW() const { return (bf16*)(ws + WS_SGW); }
    __device__ __forceinline__ bf16* WIN() const { return (bf16*)(ws + WS_WIN); }
    __device__ __forceinline__ bf16* WOUT() const { return (bf16*)(ws + WS_WOUT); }
    __device__ __forceinline__ bf16* WGU() const { return (bf16*)(ws + WS_WGU); }
    __device__ __forceinline__ bf16* WD() const { return (bf16*)(ws + WS_WD); }
    __device__ __forceinline__ bf16* HN() const { return (bf16*)(ws + WS_HN); }
    __device__ __forceinline__ bf16* Z() const { return (bf16*)(ws + WS_Z); }
    __device__ __forceinline__ bf16* QH() const { return (bf16*)(ws + WS_QH); }
    __device__ __forceinline__ bf16* KH() const { return (bf16*)(ws + WS_KH); }
    __device__ __forceinline__ bf16* VH() const { return (bf16*)(ws + WS_VH); }
    __device__ __forceinline__ bf16* RQ() const { return (bf16*)(ws + WS_RQ); }
    __device__ __forceinline__ bf16* RK() const { return (bf16*)(ws + WS_RK); }
    __device__ __forceinline__ bf16* SVN() const { return (bf16*)(ws + WS_SVN); }
    __device__ __forceinline__ bf16* MIX() const { return (bf16*)(ws + WS_MIX); }
    __device__ __forceinline__ bf16* XS() const { return (bf16*)(ws + WS_XS); }
    __device__ __forceinline__ bf16* HH() const { return (bf16*)(ws + WS_HH); }
    __device__ __forceinline__ bf16* Y() const { return (bf16*)(ws + WS_Y); }
    __device__ __forceinline__ bf16* RWS() const { return (bf16*)(ws + WS_RWS); }
    __device__ __forceinline__ int* SLOT() const { return (int*)(ws + WS_SLOT); }
    __device__ __forceinline__ int* ROWIDX() const { return (int*)(ws + WS_ROWIDX); }
};
__device__ __forceinline__ float bf2f(bf16 v) { return __builtin_bit_cast(float, (unsigned)v << 16); }
__device__ __forceinline__ float wave_sum(float v) {
#pragma unroll
    for (int o = 1; o < 64; o <<= 1) v += __shfl_xor(v, o);
    return v;
}
__device__ __forceinline__ float half_sum32(float v) {
#pragma unroll
    for (int o = 1; o < 32; o <<= 1) v += __shfl_xor(v, o);
    return v;
}
__device__ __forceinline__ float wave_max(float v) {
#pragma unroll
    for (int o = 1; o < 64; o <<= 1) v = fmaxf(v, __shfl_xor(v, o));
    return v;
}
__device__ __forceinline__ int crow(int r, int hi) { return (r & 3) + 8 * (r >> 2) + 4 * hi; }
__device__ __forceinline__ float gelu_t(float x) {
    const float u = 0.7978845608028654f * (x + 0.044715f * x * x * x);
    const float t = 1.f - 2.f * __builtin_amdgcn_rcpf(1.f + __expf(2.f * u));
    return 0.5f * x * (1.f + t);
}
__device__ __forceinline__ float silu_f(float x) { return x * __builtin_amdgcn_rcpf(1.f + __expf(-x)); }
__device__ __forceinline__ int row_vec(int r) { return r < SEQ ? 0 : (r < NLAT ? 1 : 2); }
__device__ __forceinline__ int chunk_row0(int b, int cc) { return cc < 2 ? NLAT + b * CTXL + cc * 128 : b * SEQ + (cc - 2) * 128; }

__device__ __forceinline__ f32x16 mma_nt(const LAS bf16* A, int lda, const LAS bf16* B, int ldb, int K, f32x16 acc, int lane) {
    const int r = lane & 31, h = lane >> 5;
#pragma unroll 2
    for (int k0 = 0; k0 < K; k0 += 16) {
        const bf16x8 a = *(const LAS bf16x8*)(A + r * lda + k0 + 8 * h);
        const bf16x8 b = *(const LAS bf16x8*)(B + r * ldb + k0 + 8 * h);
        acc = __builtin_amdgcn_mfma_f32_32x32x16_bf16(a, b, acc, 0, 0, 0);
    }
    return acc;
}

constexpr float QSCALE = 0.125f * 1.4426950408889634f;
struct EpiResid {
    static constexpr bool PERM = true, AFTER_DRAIN = false;
    bf16* X; const float* modg;
    const float* Xin;
    __device__ __forceinline__ void operator()(const pg8::f32x4 (&acc)[2][2][4][2], const pg8::Unit& u, int wr, int wc, int fr, int fq) const {
        const int row0 = u.pm * 256 + wr * 64 + fr, col0 = u.pn * 256 + wc * 32 + 8 * fq;
        const int v = u.pm < 32 ? 0 : (u.pm < 64 ? 1 : 2);
        pg8::f32x4 gv[2][2];
#pragma unroll
        for (int bj = 0; bj < 2; ++bj)
#pragma unroll
            for (int n = 0; n < 2; ++n) gv[bj][n] = *(const pg8::f32x4*)(modg + v * 6144 + col0 + bj * 128 + 4 * n);
        const bool in32 = Xin != nullptr;
#pragma unroll
        for (int ai = 0; ai < 2; ++ai)
#pragma unroll
            for (int m = 0; m < 4; ++m) { const size_t off = (size_t)(row0 + ai * 128 + m * 16) * DM + col0;
#pragma unroll
                for (int bj = 0; bj < 2; ++bj) {
                    pg8::f32x4 x0, x1;
                    if (in32) { x0 = *(const pg8::f32x4*)(Xin + off + bj * 128); x1 = *(const pg8::f32x4*)(Xin + off + bj * 128 + 4); }
                    else { const pg8::u32x4 w = *(const pg8::u32x4*)(X + off + bj * 128);
                        x0 = (pg8::f32x4){__builtin_bit_cast(float, w.x << 16), __builtin_bit_cast(float, w.x & 0xffff0000u), __builtin_bit_cast(float, w.y << 16), __builtin_bit_cast(float, w.y & 0xffff0000u)};
                        x1 = (pg8::f32x4){__builtin_bit_cast(float, w.z << 16), __builtin_bit_cast(float, w.z & 0xffff0000u), __builtin_bit_cast(float, w.w << 16), __builtin_bit_cast(float, w.w & 0xffff0000u)}; }
                    x0 = x0 + gv[bj][0] * acc[ai][bj][m][0]; x1 = x1 + gv[bj][1] * acc[ai][bj][m][1];
                    pg8::u32x4 o; o.x = pg8::cvt_pk_bf16(x0.x, x0.y); o.y = pg8::cvt_pk_bf16(x0.z, x0.w); o.z = pg8::cvt_pk_bf16(x1.x, x1.y); o.w = pg8::cvt_pk_bf16(x1.z, x1.w);
                    *(pg8::u32x4*)(X + off + bj * 128) = o; } }
    }
};
struct EpiZ {
    static constexpr bool PERM = true, AFTER_DRAIN = false;
    bf16* Z; bf16* VH; bf16* QH; bf16* KH; const float* gqk; const float* rope;
    __device__ __forceinline__ void operator()(const pg8::f32x4 (&acc)[2][2][4][2], const pg8::Unit& u, int wr, int wc, int fr, int fq) const {
        if (u.pn < 4) {
            const bool isk = u.pn >= 2; const int grp = (u.pn & 1) * 4 + wc;
            const float* g = gqk + (isk ? 64 : 0); const float sc = isk ? 1.f : QSCALE;
            float ga[2][8];
#pragma unroll
            for (int bj = 0; bj < 2; ++bj)
#pragma unroll
                for (int e = 0; e < 8; ++e) ga[bj][e] = g[32 * bj + 8 * fq + e] * sc;
            const bool first = fq < 2; const int i16 = 8 * (fq & 1);
            const bool lat = u.pm < 64;
#pragma unroll
            for (int ai = 0; ai < 2; ++ai) {
                float rc[8], rn[8];
                if (lat) { const float* T = rope + (size_t)(((u.pm * 256 + ai * 128 + wr * 64) & (SEQ - 1)) & ~63) * 64 + i16;
                    const pg8::f32x4 c0 = *(const pg8::f32x4*)T, c1 = *(const pg8::f32x4*)(T + 4), s0 = *(const pg8::f32x4*)(T + 32), s1 = *(const pg8::f32x4*)(T + 36);
#pragma unroll
                    for (int e = 0; e < 4; ++e) { rc[e] = c0[e]; rc[4 + e] = c1[e]; rn[e] = s0[e]; rn[4 + e] = s1[e]; } }
#pragma unroll
                for (int m = 0; m < 4; ++m) {
                    float ccm[8], cnm[8];
                    if (lat) { const float* T = rope + (size_t)(m * 16 + fr) * 64 + 16 + i16;
                        const pg8::f32x4 c0 = *(const pg8::f32x4*)T, c1 = *(const pg8::f32x4*)(T + 4), s0 = *(const pg8::f32x4*)(T + 32), s1 = *(const pg8::f32x4*)(T + 36);
#pragma unroll
                        for (int e = 0; e < 4; ++e) { ccm[e] = c0[e]; ccm[4 + e] = c1[e]; cnm[e] = s0[e]; cnm[4 + e] = s1[e]; } }
                    const int r = u.pm * 256 + ai * 128 + wr * 64 + m * 16 + fr;
                    const int b = lat ? (r >> 13) : ((r - NLAT) >> 8), n = lat ? (r & (SEQ - 1)) : ((r - NLAT) & (CTXL - 1));
                    float v[2][8]; float ss = 0.f;
#pragma unroll
                    for (int bj = 0; bj < 2; ++bj)
#pragma unroll
                        for (int e = 0; e < 8; ++e) { v[bj][e] = acc[ai][bj][m][e >> 2][e & 3]; ss += v[bj][e] * v[bj][e]; }
                    ss += __shfl_xor(ss, 16);
                    { const auto sw = __builtin_amdgcn_permlane32_swap(__float_as_uint(ss), __float_as_uint(ss), false, false); ss = __uint_as_float(sw[0]) + __uint_as_float(sw[1]); }
                    const float rinv = __builtin_amdgcn_rsqf(ss * (1.f / 64.f) + EPS);
                    bf16* dst = (isk ? KH + ((size_t)b * NKEY + (lat ? CTXL + n : n)) * 512 : QH + (size_t)r * 512) + grp * 64 + 8 * fq;
#pragma unroll
                    for (int bj = 0; bj < 2; ++bj) {
                        float y[8], o[8];
#pragma unroll
                        for (int e = 0; e < 8; ++e) y[e] = v[bj][e] * rinv * ga[bj][e];
                        if (lat) {
#pragma unroll
                            for (int e = 0; e < 8; ++e) { const auto sw = __builtin_amdgcn_permlane32_swap(__float_as_uint(y[e]), __float_as_uint(y[e]), false, false);
                                const float pp = __uint_as_float(first ? sw[1] : sw[0]); const float c = bj ? ccm[e] : rc[e], s = bj ? cnm[e] : rn[e];
                                o[e] = first ? y[e] * c - pp * s : pp * s + y[e] * c; }
                        } else {
#pragma unroll
                            for (int e = 0; e < 8; ++e) o[e] = y[e];
                        }
                        pg8::u32x4 w; w.x = pg8::cvt_pk_bf16(o[0], o[1]); w.y = pg8::cvt_pk_bf16(o[2], o[3]); w.z = pg8::cvt_pk_bf16(o[4], o[5]); w.w = pg8::cvt_pk_bf16(o[6], o[7]);
                        *(pg8::u32x4*)(dst + 32 * bj) = w;
                    }
                }
            }
            return;
        }
        const bool isv = (u.pn == 4) | (u.pn == 5);
        const size_t prow0 = isv ? (u.pm < 64 ? (size_t)u.pm * 256 + (size_t)((u.pm >> 5) + 1) * CTXL : (size_t)(u.pm - 64) * NKEY) : (size_t)u.pm * 256;
        bf16* base = isv ? VH + (u.pn - 4) * 256 : Z + u.pn * 256; const int ldc = isv ? 512 : INC;
        const int col0 = wc * 32 + 8 * fq;
#pragma unroll
        for (int ai = 0; ai < 2; ++ai)
#pragma unroll
            for (int m = 0; m < 4; ++m) { bf16* rowp = base + (prow0 + wr * 64 + fr + ai * 128 + m * 16) * ldc + col0;
#pragma unroll
                for (int bj = 0; bj < 2; ++bj) { const pg8::f32x4 v0 = acc[ai][bj][m][0], v1 = acc[ai][bj][m][1];
                    pg8::u32x4 w; w.x = pg8::cvt_pk_bf16(v0[0], v0[1]); w.y = pg8::cvt_pk_bf16(v0[2], v0[3]); w.z = pg8::cvt_pk_bf16(v1[0], v1[1]); w.w = pg8::cvt_pk_bf16(v1[2], v1[3]);
                    *(pg8::u32x4*)(rowp + bj * 128) = w; } }
    }
};
struct EpiSwiglu {
    static constexpr bool PERM = true, AFTER_DRAIN = false;
    bf16* H;
    __device__ __forceinline__ void operator()(const pg8::f32x4 (&acc)[2][2][4][2], const pg8::Unit& u, int wr, int wc, int fr, int fq) const {
        const int row0 = u.pm * 256 + wr * 64 + fr, col0 = (u.pn & 15) * 128 + wc * 32 + 8 * fq;
#pragma unroll
        for (int ai = 0; ai < 2; ++ai)
#pragma unroll
            for (int m = 0; m < 4; ++m) { bf16* rowp = H + (size_t)(row0 + ai * 128 + m * 16) * FF + col0;
                float h[8];
#pragma unroll
                for (int n = 0; n < 2; ++n)
#pragma unroll
                    for (int i = 0; i < 4; ++i) { const float g = acc[ai][0][m][n][i], up = acc[ai][1][m][n][i]; h[4 * n + i] = silu_f(g) * up; }
                pg8::u32x4 w; w.x = pg8::cvt_pk_bf16(h[0], h[1]); w.y = pg8::cvt_pk_bf16(h[2], h[3]); w.z = pg8::cvt_pk_bf16(h[4], h[5]); w.w = pg8::cvt_pk_bf16(h[6], h[7]);
                *(pg8::u32x4*)rowp = w; }
    }
};
struct MoeOrder {
    int G, c, npn, npm, total;
    __device__ __forceinline__ bool next(int i, pg8::Unit& u) const {
        const int per = npm * npn;
        if ((G & 7) == 0) {
            const int W = G >> 3, x = c & 7, r = c >> 3, q = i * W + r;
            if (q >= 2 * per) return false;
            const int e = 2 * x + q / per, rem = q % per, pn = rem / npm, pm = rem % npm;
            u.pm = e * 9 + pm; u.pn = e * npn + pn; return true;
        }
        const long L = (long)i * G + c; if (L >= total) return false;
        const int e = (int)L / per, rem = (int)L % per; const int pn = rem / npm, pm = rem % npm;
        u.pm = e * 9 + pm; u.pn = e * npn + pn; return true;
    }
    __device__ __forceinline__ void a_ready(const pg8::Unit&) const {}
    __device__ __forceinline__ void done(const pg8::Unit&) const {}
    __device__ __forceinline__ bool half_only(const pg8::Unit& u) const { return (u.pm % 9) == 8; }
};

__device__ __forceinline__ void transpose_item(const float* W, int N, bf16* WT, int K, int k0, int n0, size_t drow0, LAS float* scr, int lane) {
    f32x4 v[8];
#pragma unroll
    for (int i = 0; i < 8; ++i) v[i] = __builtin_nontemporal_load((const f32x4*)(W + (size_t)(k0 + 8 * i + (lane >> 3)) * N + n0 + 4 * (lane & 7)));
#pragma unroll
    for (int i = 0; i < 8; ++i) { LAS float* d = scr + (8 * i + (lane >> 3)) * 33 + 4 * (lane & 7); d[0] = v[i].x; d[1] = v[i].y; d[2] = v[i].z; d[3] = v[i].w; }
    LDS_WAIT(); asm volatile("" ::: "memory");
    const int c = lane & 7;
#pragma unroll
    for (int j = 0; j < 4; ++j) { const int n = (lane >> 3) + 8 * j; const LAS float* s = scr + (8 * c) * 33 + n;
        v4u o; o.x = pk2(s[0 * 33], s[1 * 33]); o.y = pk2(s[2 * 33], s[3 * 33]); o.z = pk2(s[4 * 33], s[5 * 33]); o.w = pk2(s[6 * 33], s[7 * 33]);
        *(GAS v4u*)(WT + (drow0 + n) * K + k0 + 8 * c) = o; }
    LDS_WAIT(); asm volatile("" ::: "memory");
}
constexpr unsigned CV_IN = 16 * 104, CV_OUT = 16 * 32, CV_EX = 1024;
constexpr unsigned CONV_SEG0 = DEPTH * (CV_IN + CV_OUT), CONV_PER_L = 3 * NE * CV_EX, CONV_TOTAL = CONV_SEG0 + DEPTH * CONV_PER_L;
constexpr int CW_Q = 64;
static_assert(CONV_TOTAL % 64 == 0, "whole batches");
__device__ __forceinline__ void conv_item(const Frame& F, unsigned it, LAS float* scr, int lane) {
    if (it < DEPTH * CV_IN) { const int L = it / CV_IN, q = it % CV_IN, kb = q / 104, nb = q % 104, n0 = nb * 32;
        const size_t drow0 = n0 < 1024 ? (size_t)(n0 & ~255) + 128 * ((n0 & 63) >> 5) + 32 * ((n0 & 255) >> 6) : (size_t)n0;
        transpose_item(F.w_in() + (size_t)L * DM * INC, INC, F.WIN() + (size_t)L * INC * DM, DM, kb * 64, n0, drow0, scr, lane); return; }
    it -= DEPTH * CV_IN;
    if (it < DEPTH * CV_OUT) { const int L = it / CV_OUT, q = it % CV_OUT, kb = q / 32, nb = q % 32;
        transpose_item(F.w_out() + (size_t)L * DM * DM, DM, F.WOUT() + (size_t)L * DM * DM, DM, kb * 64, nb * 32, (size_t)nb * 32, scr, lane); return; }
    it -= DEPTH * CV_OUT;
    const int L = it / CONV_PER_L, q0 = it % CONV_PER_L, kind = q0 / (NE * CV_EX), r = q0 % (NE * CV_EX), le = L * NE + r / CV_EX, q = r % CV_EX;
    if (kind < 2) { const int kb = q / 64, nb = q % 64, n0 = nb * 32;
        const size_t drow0 = (size_t)(n0 >> 7) * 256 + (n0 & 127) + (kind ? 128 : 0);
        transpose_item((kind ? F.wu() : F.wg()) + (size_t)le * DM * FF, FF, F.WGU() + (size_t)le * 4096 * DM, DM, kb * 64, n0, drow0, scr, lane); }
    else { const int kb = q / 32, nb = q % 32;
        transpose_item(F.wd() + (size_t)le * FF * DM, DM, F.WD() + (size_t)le * DM * FF, FF, kb * 64, nb * 32, (size_t)nb * 32, scr, lane); }
}
__device__ __forceinline__ bool conv_batch(const Frame& F) {
    LAS unsigned* bc = (LAS unsigned*)(F.lds + MISC_OFF + 64);
    LAS float* scr = (LAS float*)(F.lds + 32768 + F.wave * 8704);
    if (F.tid == 0) *bc = __hip_atomic_fetch_add((unsigned*)(F.ws + WS_CTL) + CW_Q, 64u, __ATOMIC_RELAXED, __HIP_MEMORY_SCOPE_AGENT);
    __syncthreads();
    const unsigned base = *bc;
    __syncthreads();
    if (base >= CONV_TOTAL) return false;
    for (int k = 0; k < 8; ++k) conv_item(F, base + 8 * k + F.wave, scr, F.lane);
    return true;
}
__device__ __forceinline__ void conv_n(const Frame& F, int n) { for (int i = 0; i < n; ++i) if (!conv_batch(F)) break; __syncthreads(); }
__device__ __forceinline__ void conv_until(const Frame& F, unsigned target) {
    for (;;) {
        const unsigned h = __hip_atomic_load((unsigned*)(F.ws + WS_CTL) + CW_Q, __ATOMIC_RELAXED, __HIP_MEMORY_SCOPE_AGENT);
        LAS unsigned* bc = (LAS unsigned*)(F.lds + MISC_OFF + 68);
        if (F.tid == 0) *bc = h;
        __syncthreads();
        const unsigned hh = *bc;
        __syncthreads();
        if (hh >= target) break;
        if (!conv_batch(F)) break;
    }
}
__device__ __forceinline__ void ph_prologue(const Frame& F) {
    const int tid = F.tid, lane = F.lane, wave = F.wave;
    LAS float* sc = (LAS float*)F.lds;
    LAS float* red = sc + 3072;
    for (int i = tid; i < 3072; i += NTHR) { const int v = i >> 10, k = i & 1023; const float c = v < 2 ? F.c_in()[v * DM + k] : F.cctx_in()[k]; sc[i] = c / (1.f + expf(-c)); }
    __syncthreads();
    for (int t = F.bid; t < 384; t += F.G) {
        const int L = t / 96, j0 = (t % 96) * 64;
        const float* W = F.w_mod() + (size_t)L * DM * 6144 + j0 + lane;
        float a0 = 0.f, a1 = 0.f, a2 = 0.f;
#pragma unroll 8
        for (int kk = 0; kk < 128; ++kk) { const int k = wave * 128 + kk; const float w = W[(size_t)k * 6144]; a0 += sc[k] * w; a1 += sc[1024 + k] * w; a2 += sc[2048 + k] * w; }
        red[(wave * 3 + 0) * 64 + lane] = a0; red[(wave * 3 + 1) * 64 + lane] = a1; red[(wave * 3 + 2) * 64 + lane] = a2;
        __syncthreads();
        if (tid < 192) { const int v = tid >> 6, l = tid & 63; float s = 0.f;
#pragma unroll
            for (int w = 0; w < 8; ++w) s += red[(w * 3 + v) * 64 + l];
            F.MOD()[(size_t)(L * 3 + v) * 6144 + j0 + l] = s + F.b_mod()[L * 6144 + j0 + l]; }
        __syncthreads();
    }
    if (F.bid == 0 && wave == 0) {
        for (int L = 0; L < DEPTH; ++L) {
            const float d1 = wave_sum(F.lq1()[L * 64 + lane] * F.lk1()[L * 64 + lane]), d2 = wave_sum(F.lq2()[L * 64 + lane] * F.lk2()[L * 64 + lane]);
            const float linit = 0.8f - 0.6f * expf(-0.3f * (float)L);
            if (lane == 0) { F.LP()[L * 16 + 0] = expf(d1) - expf(d2) + linit; F.LP()[L * 16 + 1] = 1.f - linit; }
            if (lane < 8) { const float xd = F.retd()[L * 8 + lane]; F.LP()[L * 16 + 2 + lane] = -log1pf(expf(-xd)); }
            F.LP()[DEPTH * 16 + L * 128 + lane] = F.qng()[L * 64 + lane]; F.LP()[DEPTH * 16 + L * 128 + 64 + lane] = F.kng()[L * 64 + lane];
            { const float mq = wave_max(fabsf(F.qng()[L * 64 + lane])), mk = wave_max(fabsf(F.kng()[L * 64 + lane])); if (lane == 0) F.LP()[L * 16 + 10] = 64.f * mq * mk * 1.02f; }
        }
    }
    const int gw = F.bid * NWAVES + wave, NGW = F.G * NWAVES;
    {
        const int i16 = lane & 15, which = lane >> 4, i32 = lane & 31;
        const float inv_a = powf(10000.f, -(float)i16 / 16.f);
        const float inv_r = 1.f / powf(10000.f, (float)i32 / 31.f);
        for (int n = gw; n < SEQ; n += NGW) {
            const float pos = (which & 1) ? (float)(n & 63) : (float)(n >> 6);
            const float ang = pos * inv_a;
            F.ROPE()[(size_t)n * 64 + lane] = (which < 2) ? (float)cos((double)ang) : (float)sin((double)ang);
            const float ang2 = (float)n * inv_r;
            F.RETT()[(size_t)n * 64 + lane] = (lane < 32) ? (float)cos((double)ang2) : (float)sin((double)ang2);
        }
    }
    if (F.bid == 0) for (int i = tid; i < DM / 2; i += NTHR) ((unsigned*)(F.HN() + (size_t)NROW * DM))[i] = 0u;
    for (int i = F.bid * NTHR + tid; i < DEPTH * 16 * DM; i += F.G * NTHR) { const int Lr = i / (16 * DM), q = i % (16 * DM), k = q >> 4, e = q & 15;
        const float w = F.rw()[i]; const unsigned h = f2bf(w); const float wl = w - __builtin_bit_cast(float, h << 16);
        F.RWS()[((size_t)(Lr * 2 + 0) * 16 + e) * RWLD + k] = (bf16)h; F.RWS()[((size_t)(Lr * 2 + 1) * 16 + e) * RWLD + k] = (bf16)f2bf(wl); }
    for (int i = F.bid * NTHR + tid; i < DEPTH * 4 * 128 * 128; i += F.G * NTHR) F.SGW()[i] = (bf16)f2bf(F.sgw()[i]);
    conv_until(F, CONV_SEG0);
}

__device__ __forceinline__ void ph_norm1_first(const Frame& F) {
    const int lane = F.lane, gw = F.bid * NWAVES + F.wave, NGW = F.G * NWAVES;
    for (int r = gw; r < NROW; r += NGW) {
        const float* src = r < NLAT ? F.x_in() + (size_t)r * DM : F.ctx_in() + (size_t)(r - NLAT) * DM;
        const float* mod = F.MOD() + (size_t)row_vec(r) * 6144;
        f32x4 v[4]; float ss = 0.f;
#pragma unroll
        for (int j = 0; j < 4; ++j) { v[j] = *(const f32x4*)(src + 4 * lane + 256 * j); ss += (v[j].x * v[j].x + v[j].y * v[j].y) + (v[j].z * v[j].z + v[j].w * v[j].w); }
        const float rinv = rsqrtf(wave_sum(ss) * (1.f / DM) + EPS);
#pragma unroll
        for (int j = 0; j < 4; ++j) { const int c = 4 * lane + 256 * j;
            const f32x4 g = *(const f32x4*)(F.n1g() + c), sh = *(const f32x4*)(mod + c), sc = *(const f32x4*)(mod + 1024 + c);
            const f32x4 h = v[j] * rinv * g * (sc + 1.f) + sh;
            *(unsigned long long*)(F.HN() + (size_t)r * DM + c) = (unsigned long long)pk2(h.x, h.y) | ((unsigned long long)pk2(h.z, h.w) << 32); }
    }
}

__device__ __forceinline__ void ph_prep(const Frame& F, int L) {
    const int lane = F.lane, gw = F.bid * NWAVES + F.wave, NGW = F.G * NWAVES;
    const int grp8 = lane >> 3, half = (lane >> 2) & 1, t4 = lane & 3, dA = half * 32 + 4 * t4;
    const f32x4 gqA = *(const f32x4*)(F.qng() + L * 64 + dA), gqB = *(const f32x4*)(F.qng() + L * 64 + dA + 16);
    const f32x4 gkA = *(const f32x4*)(F.kng() + L * 64 + dA), gkB = *(const f32x4*)(F.kng() + L * 64 + dA + 16);
    const int rsel = lane >> 5, rhead = (lane >> 3) & 3, t8 = lane & 7;
    const float rscale = rsel ? 0.125f : 1.f;
    const f32x4 sgn = *(const f32x4*)(F.sgng() + L * 256 + lane * 4);
    for (int r = gw; r < NROW; r += NGW) {
        const bf16* zr = F.Z() + (size_t)r * INC;
        const bool lat = r < NLAT; const int b = lat ? (r >> 13) : ((r - NLAT) >> 8), n = lat ? (r & (SEQ - 1)) : ((r - NLAT) & (CTXL - 1));
        const size_t krow = (size_t)b * NKEY + (lat ? CTXL + n : n);
        f32x4 cs = {1.f, 1.f, 1.f, 1.f}, sn = {0.f, 0.f, 0.f, 0.f}, cs2 = cs, sn2 = sn;
        if (lat) { const float* T = F.ROPE() + (size_t)n * 64; cs = *(const f32x4*)(T + half * 16 + 4 * t4); sn = *(const f32x4*)(T + 32 + half * 16 + 4 * t4);
                   const float* R = F.RETT() + (size_t)n * 64; cs2 = *(const f32x4*)(R + 4 * t8); sn2 = *(const f32x4*)(R + 32 + 4 * t8); }
#pragma unroll
        for (int pass = 0; pass < 2; ++pass) {
            const int col = pass * 512 + grp8 * 64 + dA;
            const u16x4 ra = *(const u16x4*)(zr + col), rb = *(const u16x4*)(zr + col + 16);
            f32x4 x1, x2; float ss = 0.f;
#pragma unroll
            for (int e = 0; e < 4; ++e) { x1[e] = bf2f(ra[e]); x2[e] = bf2f(rb[e]); ss += x1[e] * x1[e] + x2[e] * x2[e]; }
            ss += __shfl_xor(ss, 1); ss += __shfl_xor(ss, 2); ss += __shfl_xor(ss, 4);
            const float rinv = rsqrtf(ss * (1.f / 64.f) + EPS);
            const f32x4 y1 = x1 * rinv * (pass ? gkA : gqA * QSCALE), y2 = x2 * rinv * (pass ? gkB : gqB * QSCALE);
            const f32x4 o1 = y1 * cs - y2 * sn, o2 = y1 * sn + y2 * cs;
            bf16* dst = (pass ? F.KH() + krow * 512 : F.QH() + (size_t)r * 512) + grp8 * 64 + dA;
            *(unsigned long long*)dst = (unsigned long long)pk2(o1.x, o1.y) | ((unsigned long long)pk2(o1.z, o1.w) << 32);
            *(unsigned long long*)(dst + 16) = (unsigned long long)pk2(o2.x, o2.y) | ((unsigned long long)pk2(o2.z, o2.w) << 32);
        }
    }
}

__device__ __forceinline__ void ph_norm2_router(const Frame& F, int L) {
    const int lane = F.lane, tid = F.tid, gw = F.bid * NWAVES + F.wave, NGW = F.G * NWAVES;
    LAS bf16* rwl = (LAS bf16*)F.lds;
    { const bf16* src = F.RWS() + (size_t)L * 2 * 16 * RWLD;
      for (int i = tid; i < 2 * 16 * RWLD / 8; i += NTHR) *(LAS bf16x8*)(rwl + i * 8) = *(const bf16x8*)(src + i * 8); }
    __syncthreads();
    const int ntile = ((L == DEPTH - 1) ? NLAT : NROW) / 16;
    const int rr = lane & 15, kq = lane >> 4;
    for (int tile = gw; tile < ntile; tile += NGW) {
        const int r = tile * 16 + rr;
        const bf16* xr = F.X() + (size_t)r * DM + 8 * kq;
        const float* mod = F.MOD() + (size_t)(L * 3 + row_vec(tile * 16)) * 6144 + 8 * kq;
        const float* gn = F.n2g() + L * DM + 8 * kq;
        float ss = 0.f;
#pragma unroll 8
        for (int st = 0; st < 32; ++st) { const v4u w = *(const v4u*)(xr + 32 * st);
            const f32x4 a = {__builtin_bit_cast(float, w.x << 16), __builtin_bit_cast(float, w.x & 0xffff0000u), __builtin_bit_cast(float, w.y << 16), __builtin_bit_cast(float, w.y & 0xffff0000u)};
            const f32x4 c = {__builtin_bit_cast(float, w.z << 16), __builtin_bit_cast(float, w.z & 0xffff0000u), __builtin_bit_cast(float, w.w << 16), __builtin_bit_cast(float, w.w & 0xffff0000u)};
            ss += (a.x * a.x + a.y * a.y) + (a.z * a.z + a.w * a.w) + (c.x * c.x + c.y * c.y) + (c.z * c.z + c.w * c.w); }
        ss += __shfl_xor(ss, 16); ss += __shfl_xor(ss, 32);
        const float rinv = rsqrtf(ss * (1.f / DM) + EPS);
        f32x4 acc = {0.f, 0.f, 0.f, 0.f};
        bf16* hrow = F.HN() + (size_t)r * DM + 8 * kq;
#pragma unroll 4
        for (int st = 0; st < 32; ++st) {
            float f[8];
            const v4u xw = *(const v4u*)(xr + 32 * st);
#pragma unroll
            for (int q = 0; q < 2; ++q) { const unsigned w0 = q ? xw.z : xw.x, w1 = q ? xw.w : xw.y;
                const f32x4 xv = {__builtin_bit_cast(float, w0 << 16), __builtin_bit_cast(float, w0 & 0xffff0000u), __builtin_bit_cast(float, w1 << 16), __builtin_bit_cast(float, w1 & 0xffff0000u)};
                const f32x4 g = *(const f32x4*)(gn + 32 * st + 4 * q),
                                                      sh = *(const f32x4*)(mod + 3072 + 32 * st + 4 * q), sc = *(const f32x4*)(mod + 4096 + 32 * st + 4 * q);
                const f32x4 y = xv * rinv * g * (sc + 1.f) + sh; f[4 * q] = y.x; f[4 * q + 1] = y.y; f[4 * q + 2] = y.z; f[4 * q + 3] = y.w; }
            v4u hi, lo;
            hi.x = pk2(f[0], f[1]); hi.y = pk2(f[2], f[3]); hi.z = pk2(f[4], f[5]); hi.w = pk2(f[6], f[7]);
#define LOPK(w, i0, i1) pk2(f[i0] - __builtin_bit_cast(float, (w) << 16), f[i1] - __builtin_bit_cast(float, (w) & 0xffff0000u))
            lo.x = LOPK(hi.x, 0, 1); lo.y = LOPK(hi.y, 2, 3); lo.z = LOPK(hi.z, 4, 5); lo.w = LOPK(hi.w, 6, 7);
#undef LOPK
            *(v4u*)(hrow + 32 * st) = hi;
            const bf16x8 ah = __builtin_bit_cast(bf16x8, hi), al = __builtin_bit_cast(bf16x8, lo);
            const bf16x8 bh = *(const LAS bf16x8*)(rwl + rr * RWLD + 32 * st + 8 * kq), bl = *(const LAS bf16x8*)(rwl + (16 + rr) * RWLD + 32 * st + 8 * kq);
            acc = __builtin_amdgcn_mfma_f32_16x16x32_bf16(ah, bh, acc, 0, 0, 0);
            acc = __builtin_amdgcn_mfma_f32_16x16x32_bf16(ah, bl, acc, 0, 0, 0);
            acc = __builtin_amdgcn_mfma_f32_16x16x32_bf16(al, bh, acc, 0, 0, 0);
        }
#pragma unroll
        for (int q = 0; q < 4; ++q) {
            float mx = acc[q];
#pragma unroll
            for (int o = 1; o < 16; o <<= 1) mx = fmaxf(mx, __shfl_xor(mx, o));
            const float ex = expf(acc[q] - mx); float sum = ex;
#pragma unroll
            for (int o = 1; o < 16; o <<= 1) sum += __shfl_xor(sum, o);
            F.AFF()[(size_t)(tile * 16 + 4 * kq + q) * 16 + rr] = ex / sum;
        }
    }
    __syncthreads();
}

__device__ __forceinline__ unsigned block_excl_scan(unsigned v, LAS unsigned* wtot, int lane, int wave) {
    unsigned inc = v;
#pragma unroll
    for (int o = 1; o < 64; o <<= 1) { const unsigned t = __shfl_up(inc, o); if (lane >= o) inc += t; }
    if (lane == 63) wtot[wave] = inc;
    __syncthreads();
    unsigned off = 0;
    for (int w = 0; w < wave; ++w) off += wtot[w];
    __syncthreads();
    return off + inc - v;
}
__device__ __forceinline__ void ph_topk(const Frame& F, int L) {
    const int tid = F.tid, lane = F.lane, wave = F.wave;
    LAS unsigned* keys = (LAS unsigned*)F.lds;
    LAS unsigned* hist = keys + 8192;
    LAS unsigned* wtot = hist + 256;
    LAS unsigned* bc = wtot + 16;
    const int nprob = (L == DEPTH - 1) ? 32 : 64;
    for (int p = F.bid; p < 64; p += F.G) {
        const int s = p >> 4, e = p & 15;
        const int n = s < 2 ? SEQ : CTXL, k = n >> 3;
        const int base = s < 2 ? s * SEQ : NLAT + (s - 2) * CTXL;
        const int sbase = s == 0 ? 0 : (s == 1 ? 1024 : (s == 2 ? 2048 : 2080));
        if (p >= nprob) {
            for (int i = tid; i < 32; i += NTHR) { F.ROWIDX()[e * EROWS + sbase + i] = -1; F.GATE()[e * EROWS + sbase + i] = 0.f; }
            if (s == 3) for (int rr = 2112 + tid; rr < EROWS; rr += NTHR) { F.ROWIDX()[e * EROWS + rr] = -1; F.GATE()[e * EROWS + rr] = 0.f; }
            continue; }
        for (int i = tid; i < n; i += NTHR) keys[i] = __float_as_uint(F.AFF()[(size_t)(base + i) * 16 + e]);
        __syncthreads();
        unsigned prefix = 0u, mask = 0u, need = (unsigned)k;
        for (int pass = 0; pass < 4; ++pass) {
            const int shift = 24 - 8 * pass;
            if (tid < 256) hist[tid] = 0u;
            __syncthreads();
            for (int i = tid; i < n; i += NTHR) { const unsigned key = keys[i]; if ((key & mask) == prefix) atomicAdd((unsigned*)&hist[(key >> shift) & 255u], 1u); }
            __syncthreads();
            if (wave == 0) {
                const unsigned h0 = hist[4 * lane], h1 = hist[4 * lane + 1], h2 = hist[4 * lane + 2], h3 = hist[4 * lane + 3];
                const unsigned tot = h0 + h1 + h2 + h3;
                unsigned suf = tot;
#pragma unroll
                for (int o = 1; o < 64; o <<= 1) { const unsigned t = __shfl_down(suf, o); if (lane + o < 64) suf += t; }
                const unsigned above = suf - tot;
                if (suf >= need && above < need) {
                    unsigned rem = need - above, bsel;
                    if (rem <= h3) bsel = 3u; else { rem -= h3; if (rem <= h2) bsel = 2u; else { rem -= h2; if (rem <= h1) bsel = 1u; else { rem -= h1; bsel = 0u; } } }
                    bc[0] = 4u * lane + bsel; bc[1] = rem;
                }
            }
            __syncthreads();
            prefix |= bc[0] << shift; mask |= 255u << shift; need = bc[1];
            __syncthreads();
        }
        const unsigned T = prefix;
        const int per = n >= NTHR ? n / NTHR : 1;
        const int i0 = tid * per; const bool act = i0 < n;
        unsigned eqc = 0u;
        if (act) for (int q = 0; q < per; ++q) eqc += (keys[i0 + q] == T) ? 1u : 0u;
        unsigned eqr = block_excl_scan(eqc, wtot, lane, wave);
        unsigned selc = 0u;
        if (act) for (int q = 0; q < per; ++q) { const unsigned key = keys[i0 + q]; if (key > T) ++selc; else if (key == T) { if (eqr < need) ++selc; ++eqr; } }
        unsigned slot = block_excl_scan(selc, wtot, lane, wave);
        eqr -= eqc;
        if (act) for (int q = 0; q < per; ++q) {
            const unsigned key = keys[i0 + q]; bool sel = key > T;
            if (key == T) { sel = eqr < need; ++eqr; }
            const int tok = base + i0 + q;
            if (sel) { const int rr = sbase + (int)slot; ++slot; F.ROWIDX()[e * EROWS + rr] = tok; F.GATE()[e * EROWS + rr] = __uint_as_float(key); F.SLOT()[(size_t)tok * 16 + e] = rr; }
            else F.SLOT()[(size_t)tok * 16 + e] = -1;
        }
        if (s == 3) for (int rr = 2112 + tid; rr < EROWS; rr += NTHR) { F.ROWIDX()[e * EROWS + rr] = -1; F.GATE()[e * EROWS + rr] = 0.f; }
        __syncthreads();
    }
}

__device__ __forceinline__ void ph_gather(const Frame& F) {
    const int lane = F.lane, gw = F.bid * NWAVES + F.wave, NGW = F.G * NWAVES;
    for (int idx = gw; idx < NE * EROWS; idx += NGW) {
        const int src = F.ROWIDX()[idx];
        bf16x8 a = {0, 0, 0, 0, 0, 0, 0, 0}, b = a;
        if (src >= 0) { a = *(const bf16x8*)(F.HN() + (size_t)src * DM + 8 * lane); b = *(const bf16x8*)(F.HN() + (size_t)src * DM + 512 + 8 * lane); }
        *(bf16x8*)(F.XS() + (size_t)idx * DM + 8 * lane) = a; *(bf16x8*)(F.XS() + (size_t)idx * DM + 512 + 8 * lane) = b;
    }
}

__device__ __forceinline__ void ph_combine(const Frame& F, int L) {
    const int lane = F.lane, gw = F.bid * NWAVES + F.wave, NGW = F.G * NWAVES;
    const bool last = (L == DEPTH - 1);
    const int nrows = last ? NLAT : NROW;
    for (int r = gw; r < nrows; r += NGW) {
        const int v = row_vec(r);
        const int sl = (lane < 16) ? F.SLOT()[(size_t)r * 16 + lane] : -1;
        const float* mod = F.MOD() + (size_t)(L * 3 + v) * 6144;
        f32x4 xv[4], g2[4];
#pragma unroll
        for (int j = 0; j < 2; ++j)
#pragma unroll
            for (int q = 0; q < 2; ++q) { const int c = 8 * lane + 512 * j + 4 * q; const unsigned long long w = *(const unsigned long long*)(F.X() + (size_t)r * DM + c);
                const unsigned w0 = (unsigned)w, w1 = (unsigned)(w >> 32);
                xv[2 * j + q] = (f32x4){__builtin_bit_cast(float, w0 << 16), __builtin_bit_cast(float, w0 & 0xffff0000u), __builtin_bit_cast(float, w1 << 16), __builtin_bit_cast(float, w1 & 0xffff0000u)};
                g2[2 * j + q] = *(const f32x4*)(mod + 5120 + c); }
        float acc[16];
#pragma unroll
        for (int i = 0; i < 16; ++i) acc[i] = 0.f;
        unsigned long long m = __ballot(sl >= 0);
        while (m) {
            const int e0 = __builtin_ctzll(m); m &= m - 1;
            const int e1 = m ? __builtin_ctzll(m) : -1; if (m) m &= m - 1;
            const int s0 = __shfl(sl, e0), s1 = e1 >= 0 ? __shfl(sl, e1) : 0;
            const float gv0 = F.GATE()[e0 * EROWS + s0]; const bf16* y0 = F.Y() + ((size_t)e0 * EROWS + s0) * DM;
            const bf16x8 a0 = *(const bf16x8*)(y0 + 8 * lane), a1 = *(const bf16x8*)(y0 + 8 * lane + 512);
            float gv1 = 0.f; bf16x8 b0 = {0, 0, 0, 0, 0, 0, 0, 0}, b1 = b0;
            if (e1 >= 0) { gv1 = F.GATE()[e1 * EROWS + s1]; const bf16* y1 = F.Y() + ((size_t)e1 * EROWS + s1) * DM; b0 = *(const bf16x8*)(y1 + 8 * lane); b1 = *(const bf16x8*)(y1 + 8 * lane + 512); }
#pragma unroll
            for (int i = 0; i < 8; ++i) { acc[i] += gv0 * bf2f((bf16)a0[i]); acc[8 + i] += gv0 * bf2f((bf16)a1[i]); }
            if (e1 >= 0) {
#pragma unroll
                for (int i = 0; i < 8; ++i) { acc[i] += gv1 * bf2f((bf16)b0[i]); acc[8 + i] += gv1 * bf2f((bf16)b1[i]); } }
        }
        float xn[16]; float ss = 0.f;
#pragma unroll
        for (int j = 0; j < 2; ++j)
#pragma unroll
            for (int q = 0; q < 2; ++q) { const int c = 8 * lane + 512 * j + 4 * q;
#pragma unroll
                for (int i = 0; i < 4; ++i) { const float t = xv[2 * j + q][i] + g2[2 * j + q][i] * acc[8 * j + 4 * q + i]; xn[8 * j + 4 * q + i] = t; ss += t * t; }
                const f32x4 o = {xn[8 * j + 4 * q], xn[8 * j + 4 * q + 1], xn[8 * j + 4 * q + 2], xn[8 * j + 4 * q + 3]};
                if (last) *(f32x4*)(F.out + (size_t)r * DM + c) = o;
                else *(unsigned long long*)(F.X() + (size_t)r * DM + c) = (unsigned long long)pk2(o.x, o.y) | ((unsigned long long)pk2(o.z, o.w) << 32); }
        if (!last) {
            const float rinv = rsqrtf(wave_sum(ss) * (1.f / DM) + EPS);
            const float* mod1 = F.MOD() + (size_t)((L + 1) * 3 + v) * 6144;
#pragma unroll
            for (int j = 0; j < 2; ++j) { const int c = 8 * lane + 512 * j; float h[8];
#pragma unroll
                for (int q = 0; q < 2; ++q) { const f32x4 g = *(const f32x4*)(F.n1g() + (L + 1) * DM + c + 4 * q), sh = *(const f32x4*)(mod1 + c + 4 * q), sc = *(const f32x4*)(mod1 + 1024 + c + 4 * q);
#pragma unroll
                    for (int i = 0; i < 4; ++i) h[4 * q + i] = xn[8 * j + 4 * q + i] * rinv * g[i] * (1.f + sc[i]) + sh[i]; }
                v4u w; w.x = pk2(h[0], h[1]); w.y = pk2(h[2], h[3]); w.z = pk2(h[4], h[5]); w.w = pk2(h[6], h[7]);
                *(v4u*)(F.HN() + (size_t)r * DM + c) = w; }
        }
    }
}


constexpr int LDP = 136, LDQK = 72;

__device__ __forceinline__ void ret_rot(const Frame& F, const bf16* zh, int p, bool lat, int n, float scale, float (&o1)[8], float (&o2)[8]) {
    const bf16x8 r1 = *(const bf16x8*)(zh + 8 * p), r2 = *(const bf16x8*)(zh + 32 + 8 * p);
    float cs[8], sn[8];
    if (lat) { const float* R = F.RETT() + (size_t)n * 64 + 8 * p; const f32x4 c0 = *(const f32x4*)R, c1 = *(const f32x4*)(R + 4), s0 = *(const f32x4*)(R + 32), s1 = *(const f32x4*)(R + 36);
#pragma unroll
        for (int i = 0; i < 4; ++i) { cs[i] = c0[i]; cs[4 + i] = c1[i]; sn[i] = s0[i]; sn[4 + i] = s1[i]; } }
    else {
#pragma unroll
        for (int i = 0; i < 8; ++i) { cs[i] = 1.f; sn[i] = 0.f; } }
#pragma unroll
    for (int i = 0; i < 8; ++i) { const float x1 = bf2f((bf16)r1[i]) * scale, x2 = bf2f((bf16)r2[i]) * scale; o1[i] = x1 * cs[i] - x2 * sn[i]; o2[i] = x1 * sn[i] + x2 * cs[i]; }
}
__device__ __forceinline__ void unit_retkv(const Frame& F, int L, int b, int h, int cc) {
    const int tid = F.tid, lane = F.lane, wave = F.wave;
    LAS bf16* vT = (LAS bf16*)F.lds;
    LAS bf16* kfT = vT + 64 * LDP;
    LAS bf16* kbT = kfT + 64 * LDP;
    const int row0 = chunk_row0(b, cc);
    const float lgf = F.LP()[L * 16 + 2 + h], lgb = F.LP()[L * 16 + 6 + h];
    { const int j = tid >> 2, p = tid & 3;
      const bf16* zr = F.Z() + (size_t)(row0 + j) * INC;
      float k1[8], k2[8];
      ret_rot(F, zr + ZRK + h * 64, p, cc >= 2, (cc - 2) * 128 + j, 0.125f, k1, k2);
      const bf16x8 v1 = *(const bf16x8*)(zr + ZRV + h * 64 + 8 * p), v2 = *(const bf16x8*)(zr + ZRV + h * 64 + 32 + 8 * p);
      const float df = __expf(lgf * (float)(127 - j)), db = __expf(lgb * (float)j);
#pragma unroll
      for (int i = 0; i < 8; ++i) { const int d1 = 8 * p + i, d2 = 32 + 8 * p + i;
          kfT[d1 * LDP + j] = (bf16)f2bf(k1[i] * df); kbT[d1 * LDP + j] = (bf16)f2bf(k1[i] * db); vT[d1 * LDP + j] = (bf16)v1[i];
          kfT[d2 * LDP + j] = (bf16)f2bf(k2[i] * df); kbT[d2 * LDP + j] = (bf16)f2bf(k2[i] * db); vT[d2 * LDP + j] = (bf16)v2[i]; } }
    __syncthreads();
    { const int dir = wave >> 2, ti = (wave >> 1) & 1, tj = wave & 1, r32 = lane & 31, hi = lane >> 5;
      f32x16 acc = {};
      acc = mma_nt(vT + ti * 32 * LDP, LDP, (dir ? kbT : kfT) + tj * 32 * LDP, LDP, 128, acc, lane);
      float* dst = F.KVT() + ((size_t)(((b * 4 + h) * 2 + dir) * NCH + cc)) * 4096;
#pragma unroll
      for (int x = 0; x < 16; ++x) dst[(ti * 32 + crow(x, hi)) * 64 + tj * 32 + r32] = acc[x]; }
    __syncthreads();
}

__device__ __forceinline__ void ph_scan(const Frame& F, int L) {
    const int t = F.bid * NTHR + F.tid;
    if (t < 65536) {
        const int elem = t & 4095, sq = t >> 12, dir = sq & 1, h = (sq >> 1) & 3, b = sq >> 3;
        const size_t base = (size_t)(((b * 4 + h) * 2 + dir) * NCH);
        const float decay = expf(F.LP()[L * 16 + 2 + dir * 4 + h] * 128.f);
        float kv[NCH];
#pragma unroll
        for (int step = 0; step < NCH; ++step) { const int cc = dir == 0 ? step : (step < 2 ? 1 - step : 67 - step); kv[step] = F.KVT()[(base + cc) * 4096 + elem]; }
        float s = 0.f;
#pragma unroll
        for (int step = 0; step < NCH; ++step) { const int cc = dir == 0 ? step : (step < 2 ? 1 - step : 67 - step);
            F.SPREV()[(base + cc) * 4096 + elem] = (bf16)f2bf(s); s = s * decay + kv[step]; }
    }
}

__device__ __forceinline__ void unit_retout(const Frame& F, int L, int b, int h, int cc) {
    int tid = F.tid; asm volatile("" : "+v"(tid));
    const int lane = tid & 63, wave = F.wave, r32 = lane & 31, hi = lane >> 5;
    LAS bf16* q_s = (LAS bf16*)F.lds;
    LAS bf16* k_s = q_s + 128 * LDQK;
    LAS bf16* vT = k_s + 128 * LDQK;
    LAS bf16* SfT = vT + 64 * LDP;
    LAS bf16* SbT = SfT + 64 * LDQK;
    LAS bf16* P = SbT + 64 * LDQK;
    LAS float* O_s = (LAS float*)P;
    constexpr int LDO = 66;
    const int row0 = chunk_row0(b, cc);
    const float lgf = F.LP()[L * 16 + 2 + h], lgb = F.LP()[L * 16 + 6 + h];
    { const int j = tid >> 2, p = tid & 3;
      const bf16* zr = F.Z() + (size_t)(row0 + j) * INC;
      float a1[8], a2[8];
      ret_rot(F, zr + ZRQ + h * 64, p, cc >= 2, (cc - 2) * 128 + j, 1.f, a1, a2);
      { v4u w; w.x = pk2(a1[0], a1[1]); w.y = pk2(a1[2], a1[3]); w.z = pk2(a1[4], a1[5]); w.w = pk2(a1[6], a1[7]); *(LAS v4u*)(q_s + j * LDQK + 8 * p) = w;
        w.x = pk2(a2[0], a2[1]); w.y = pk2(a2[2], a2[3]); w.z = pk2(a2[4], a2[5]); w.w = pk2(a2[6], a2[7]); *(LAS v4u*)(q_s + j * LDQK + 32 + 8 * p) = w; }
      ret_rot(F, zr + ZRK + h * 64, p, cc >= 2, (cc - 2) * 128 + j, 0.125f, a1, a2);
      { v4u w; w.x = pk2(a1[0], a1[1]); w.y = pk2(a1[2], a1[3]); w.z = pk2(a1[4], a1[5]); w.w = pk2(a1[6], a1[7]); *(LAS v4u*)(k_s + j * LDQK + 8 * p) = w;
        w.x = pk2(a2[0], a2[1]); w.y = pk2(a2[2], a2[3]); w.z = pk2(a2[4], a2[5]); w.w = pk2(a2[6], a2[7]); *(LAS v4u*)(k_s + j * LDQK + 32 + 8 * p) = w; }
      const bf16x8 v1 = *(const bf16x8*)(zr + ZRV + h * 64 + 8 * p), v2 = *(const bf16x8*)(zr + ZRV + h * 64 + 32 + 8 * p);
#pragma unroll
      for (int i = 0; i < 8; ++i) { vT[(8 * p + i) * LDP + j] = (bf16)v1[i]; vT[(32 + 8 * p + i) * LDP + j] = (bf16)v2[i]; } }
    { const bf16* sf = F.SPREV() + ((size_t)(((b * 4 + h) * 2 + 0) * NCH + cc)) * 4096;
      const bf16* sb = F.SPREV() + ((size_t)(((b * 4 + h) * 2 + 1) * NCH + cc)) * 4096;
      { const int dv = tid >> 3, c8 = (tid & 7) * 8;
          *(LAS v4u*)(SfT + dv * LDQK + c8) = *(const v4u*)(sf + dv * 64 + c8);
          *(LAS v4u*)(SbT + dv * LDQK + c8) = *(const v4u*)(sb + dv * 64 + c8); } }
    __syncthreads();
    const int sti = wave >> 1, stj0 = (wave & 1) * 2;
    f32x16 S0 = {}, S1 = {};
    S0 = mma_nt(q_s + sti * 32 * LDQK, LDQK, k_s + stj0 * 32 * LDQK, LDQK, 64, S0, lane);
    S1 = mma_nt(q_s + sti * 32 * LDQK, LDQK, k_s + (stj0 + 1) * 32 * LDQK, LDQK, 64, S1, lane);
    const int ei = tid >> 2, ec = (tid & 3) * 16;
    float yo[16];
#pragma unroll
    for (int dir = 0; dir < 2; ++dir) {
        const float lg = dir ? lgb : lgf;
#pragma unroll
        for (int x = 0; x < 16; ++x) { const int i = sti * 32 + crow(x, hi);
            const int j0 = stj0 * 32 + r32, j1 = j0 + 32; const int d0 = dir ? j0 - i : i - j0, d1 = dir ? j1 - i : i - j1;
            const float p0 = d0 >= 0 ? S0[x] * __expf(lg * (float)d0) : 0.f, p1 = d1 >= 0 ? S1[x] * __expf(lg * (float)d1) : 0.f;
            const unsigned pk = pg8::cvt_pk_bf16(p0, p1);
            P[i * LDP + j0] = (bf16)(pk & 0xffffu); P[i * LDP + j1] = (bf16)(pk >> 16);
            if ((x & 3) == 3) __builtin_amdgcn_sched_barrier(0); }
        __syncthreads();
        const int oti = wave >> 1, otj = wave & 1;
        f32x16 a0 = {}, c0 = {};
        { const LAS bf16* ST = dir ? SbT : SfT;
          a0 = mma_nt(P + oti * 32 * LDP, LDP, vT + otj * 32 * LDP, LDP, 128, a0, lane);
          c0 = mma_nt(q_s + oti * 32 * LDQK, LDQK, ST + otj * 32 * LDQK, LDQK, 64, c0, lane); }
        __syncthreads();
#pragma unroll
        for (int x = 0; x < 16; ++x) { const int i = oti * 32 + crow(x, hi);
            const float qd = __expf(lg * (float)(dir ? 128 - i : i + 1));
            O_s[i * LDO + otj * 32 + r32] = a0[x] + c0[x] * qd;
            if ((x & 3) == 3) __builtin_amdgcn_sched_barrier(0); }
        __syncthreads();
        { float o[16]; float s = 0.f;
#pragma unroll
          for (int c = 0; c < 16; ++c) { o[c] = O_s[ei * LDO + ec + c]; s += o[c]; }
          s += __shfl_xor(s, 1); s += __shfl_xor(s, 2);
          const float mu = s * (1.f / 64.f); float s2 = 0.f;
#pragma unroll
          for (int c = 0; c < 16; ++c) { o[c] -= mu; s2 += o[c] * o[c]; }
          s2 += __shfl_xor(s2, 1); s2 += __shfl_xor(s2, 2);
          const float rs = rsqrtf(s2 * (1.f / 64.f) + EPS);
          const bf16* zr = F.Z() + (size_t)(row0 + ei) * INC + (dir ? ZGB : ZGF) + h * 64 + ec;
          const bf16x8 ga = *(const bf16x8*)zr, gb = *(const bf16x8*)(zr + 8);
#pragma unroll
          for (int c = 0; c < 16; ++c) { const float g = bf2f((bf16)(c < 8 ? ga[c & 7] : gb[c & 7])); const float y = o[c] * rs * silu_f(g);
              if (dir == 0) yo[c] = y; else yo[c] += y; }
          if (dir == 1) { bf16* mr = F.MIX() + (size_t)(row0 + ei) * DM + 512 + h * 64 + ec;
              v4u w0, w1; w0.x = pk2(yo[0], yo[1]); w0.y = pk2(yo[2], yo[3]); w0.z = pk2(yo[4], yo[5]); w0.w = pk2(yo[6], yo[7]);
              w1.x = pk2(yo[8], yo[9]); w1.y = pk2(yo[10], yo[11]); w1.z = pk2(yo[12], yo[13]); w1.w = pk2(yo[14], yo[15]);
              *(v4u*)mr = w0; *(v4u*)(mr + 8) = w1; } }
        __syncthreads();
    }
}

__device__ __forceinline__ void unit_sg(const Frame& F, int L, int b, int g, int cc) {
    const int tid = F.tid, lane = F.lane, wave = F.wave, r32 = lane & 31, hi = lane >> 5;
    LAS bf16* W_s = (LAS bf16*)F.lds;
    LAS bf16* vT = W_s + 128 * LDP;
    const int row0 = chunk_row0(b, cc);
    const bf16* Wg = F.SGW() + (size_t)(L * 4 + g) * 128 * 128;
#pragma unroll
    for (int q = 0; q < 4; ++q) { const int idx = tid + NTHR * q, i = idx >> 4, c8 = (idx & 15) * 8; *(LAS bf16x8*)(W_s + i * LDP + c8) = *(const bf16x8*)(Wg + i * 128 + c8); }
    { const int j = tid >> 2, qd = tid & 3;
      const bf16* zr = F.Z() + (size_t)(row0 + j) * INC + ZSV + 64 * qd;
      float gv[64]; float sum = 0.f;
#pragma unroll
      for (int c = 0; c < 8; ++c) { const bf16x8 raw = *(const bf16x8*)(zr + 8 * c);
#pragma unroll
          for (int i = 0; i < 8; ++i) { const float t = gelu_t(bf2f((bf16)raw[i])); gv[8 * c + i] = t; sum += t; } }
      sum += __shfl_xor(sum, 1); sum += __shfl_xor(sum, 2);
      const float mu = sum * (1.f / 256.f); float s2 = 0.f;
#pragma unroll
      for (int c = 0; c < 64; ++c) { gv[c] -= mu; s2 += gv[c] * gv[c]; }
      s2 += __shfl_xor(s2, 1); s2 += __shfl_xor(s2, 2);
      const float rs = rsqrtf(s2 * (1.f / 256.f) + EPS);
      if (qd == g) { const float* gn = F.sgng() + L * 256 + g * 64;
#pragma unroll
          for (int c = 0; c < 64; ++c) vT[c * LDP + j] = (bf16)f2bf(gv[c] * rs * gn[c]); } }
    __syncthreads();
    LAS float* O_s = (LAS float*)W_s;
    { const int ti = wave >> 1, tj = wave & 1;
      f32x16 acc = {};
      acc = mma_nt(W_s + ti * 32 * LDP, LDP, vT + tj * 32 * LDP, LDP, 128, acc, lane);
      __syncthreads();
#pragma unroll
      for (int x = 0; x < 16; ++x) O_s[(ti * 32 + crow(x, hi)) * 66 + tj * 32 + r32] = acc[x]; }
    __syncthreads();
    { const int i = tid >> 2, ec = (tid & 3) * 16;
      const bf16* zu = F.Z() + (size_t)(row0 + i) * INC + ZSU + g * 64 + ec;
      const bf16x8 u0 = *(const bf16x8*)zu, u1 = *(const bf16x8*)(zu + 8);
      const float bi = F.sgb()[(L * 4 + g) * 128 + i];
      float o[16];
#pragma unroll
      for (int c = 0; c < 16; ++c) o[c] = gelu_t(bf2f((bf16)(c < 8 ? u0[c & 7] : u1[c & 7]))) * (O_s[i * 66 + ec + c] + bi);
      bf16* mr = F.MIX() + (size_t)(row0 + i) * DM + 768 + g * 64 + ec;
      v4u w0, w1; w0.x = pk2(o[0], o[1]); w0.y = pk2(o[2], o[3]); w0.z = pk2(o[4], o[5]); w0.w = pk2(o[6], o[7]);
      w1.x = pk2(o[8], o[9]); w1.y = pk2(o[10], o[11]); w1.z = pk2(o[12], o[13]); w1.w = pk2(o[14], o[15]);
      *(v4u*)mr = w0; *(v4u*)(mr + 8) = w1; }
    __syncthreads();
}

__device__ __forceinline__ void unit_out_ctx(const Frame& F, int L, int mu) {
    int tid = F.tid; asm volatile("" : "+v"(tid));
    const int lane = tid & 63, wave = F.wave, r32 = lane & 31, hi = lane >> 5;
    const int rb = mu >> 5, cb = mu & 31, k0 = wave * 128 + 8 * hi;
    LAS float* P = (LAS float*)F.lds;
    const bf16* A0 = F.MIX() + (size_t)(NLAT + rb * 64 + r32) * DM + k0;
    const bf16* B0 = F.WOUT() + (size_t)L * DM * DM + (size_t)(cb * 32 + r32) * DM + k0;
    bf16x8 a0[8], a1[8], bb[8];
#pragma unroll
    for (int s = 0; s < 8; ++s) { a0[s] = *(const bf16x8*)(A0 + 16 * s); a1[s] = *(const bf16x8*)(A0 + 32 * DM + 16 * s); bb[s] = *(const bf16x8*)(B0 + 16 * s); }
    f32x16 c0 = {}, c1 = {};
#pragma unroll
    for (int s = 0; s < 8; ++s) { c0 = __builtin_amdgcn_mfma_f32_32x32x16_bf16(a0[s], bb[s], c0, 0, 0, 0); c1 = __builtin_amdgcn_mfma_f32_32x32x16_bf16(a1[s], bb[s], c1, 0, 0, 0); }
#pragma unroll
    for (int x = 0; x < 16; ++x) { P[((wave * 2 + 0) * 16 + x) * 64 + lane] = c0[x]; P[((wave * 2 + 1) * 16 + x) * 64 + lane] = c1[x]; }
    __syncthreads();
    const float* g1 = F.MOD() + (size_t)(L * 3 + 2) * 6144 + 2048 + cb * 32;
#pragma unroll
    for (int q = 0; q < 4; ++q) {
        const int idx = tid + NTHR * q, ln = idx & 63, x = (idx >> 6) & 15, t = idx >> 10;
        float s = 0.f;
#pragma unroll
        for (int w = 0; w < 8; ++w) s += P[((w * 2 + t) * 16 + x) * 64 + ln];
        const int row = 32 * t + crow(x, ln >> 5), col = ln & 31;
        const size_t xo = (size_t)(rb * 64 + row) * DM + cb * 32 + col;
        F.X()[(size_t)NLAT * DM + xo] = (bf16)f2bf((L == 0 ? F.ctx_in()[xo] : bf2f(F.X()[(size_t)NLAT * DM + xo])) + g1[col] * s);
    }
    __syncthreads();
}

namespace att {
constexpr int KVBLK = 64;
constexpr float SCALE = 0.125f, THR = 8.f;
constexpr int LDQ = 512, LDK = 512, LDV = 512;
constexpr int SHM_V = KVBLK * 128 * 2, SHM_K = KVBLK * 64 * 2, SHM_ATTN = 2 * SHM_V + 2 * SHM_K + NWAVES * 64 * 4;
#define KSWZ(row, colB) ((row) * 128 + ((colB) ^ ((((row) >> 1) & 7) << 4)))
#define SBAR() __builtin_amdgcn_sched_barrier(0)
__device__ __forceinline__ unsigned cvtpk(float lo, float hi) { unsigned r; asm volatile("v_cvt_pk_bf16_f32 %0, %1, %2" : "=v"(r) : "v"(lo), "v"(hi)); return r; }
template <bool OFF> __device__ __forceinline__ void partialSM(f32x16& p0, f32x16& p1, float off) {
#pragma unroll
    for (int r = 0; r < 16; ++r) { if (OFF) { p0[r] += off; p1[r] += off; } p0[r] = __builtin_amdgcn_exp2f(p0[r]); }
}
__device__ __forceinline__ void finishSM(f32x16& p0, f32x16& p1, float& l_reg, bf16x8& pa0, bf16x8& pa1, bf16x8& pa2, bf16x8& pa3) {
#pragma unroll
    for (int r = 0; r < 16; ++r) p1[r] = __builtin_amdgcn_exp2f(p1[r]);
    float ps = 0;
#pragma unroll
    for (int r = 0; r < 16; ++r) ps += p0[r];
#pragma unroll
    for (int r = 0; r < 16; ++r) ps += p1[r];
    { auto rr = __builtin_amdgcn_permlane32_swap(__float_as_uint(ps), __float_as_uint(ps), false, false);
      ps = __uint_as_float(rr[0]) + __uint_as_float(rr[1]); }
    l_reg += ps;
#define PK4(P, BASE, OUT) do { unsigned a0 = cvtpk(P[BASE + 0], P[BASE + 1]), a1 = cvtpk(P[BASE + 2], P[BASE + 3]);   \
    unsigned b0 = cvtpk(P[BASE + 4], P[BASE + 5]), b1 = cvtpk(P[BASE + 6], P[BASE + 7]);                              \
    auto r0 = __builtin_amdgcn_permlane32_swap(a0, b0, false, false); auto r1 = __builtin_amdgcn_permlane32_swap(a1, b1, false, false); \
    v4u w = {r0[0], r1[0], r0[1], r1[1]}; OUT = __builtin_bit_cast(bf16x8, w); } while (0)
    PK4(p0, 0, pa0); PK4(p0, 8, pa1); PK4(p1, 0, pa2); PK4(p1, 8, pa3);
#undef PK4
}
template <bool OFF> __device__ __forceinline__ void kload(bf16x8 (&kf)[8], const LAS char* Ks, int r32, int hi) {
    if (OFF) return;
#pragma unroll
    for (int d0 = 0; d0 < 4; ++d0) { const int cb = (d0 * 16 + hi * 8) * 2;
        kf[2 * d0] = *(const LAS bf16x8*)(Ks + KSWZ(r32, cb)); kf[2 * d0 + 1] = *(const LAS bf16x8*)(Ks + KSWZ(32 + r32, cb)); }
}
template <bool OFF> __device__ __forceinline__ void qkmma(f32x16& p0, f32x16& p1, const bf16x8 (&kf)[8], const bf16x8* qr, const LAS char* Ks, int r32, int hi) {
    p0 = f32x16{}; p1 = f32x16{};
#pragma unroll
    for (int d0 = 0; d0 < 4; ++d0) {
        if (OFF) { const int cb = (d0 * 16 + hi * 8) * 2;
            const bf16x8 b0 = *(const LAS bf16x8*)(Ks + KSWZ(r32, cb)), b1 = *(const LAS bf16x8*)(Ks + KSWZ(32 + r32, cb));
            p0 = __builtin_amdgcn_mfma_f32_32x32x16_bf16(b0, qr[d0], p0, 0, 0, 0); p1 = __builtin_amdgcn_mfma_f32_32x32x16_bf16(b1, qr[d0], p1, 0, 0, 0); }
        else { p0 = __builtin_amdgcn_mfma_f32_32x32x16_bf16(kf[2 * d0], qr[d0], p0, 0, 0, 0); p1 = __builtin_amdgcn_mfma_f32_32x32x16_bf16(kf[2 * d0 + 1], qr[d0], p1, 0, 0, 0); } }
}
__device__ __forceinline__ int v_st(int k, int c) { const int kk = (k & ~0xC) | ((k & 4) << 1) | ((k & 8) >> 1); return ((kk >> 3) * 4 + (c >> 5)) * 512 + ((kk & 7) * 32 + (c & 31)) * 2; }
__device__ __forceinline__ int v_rd_base(int lane) { return ((lane & 3) << 3) | (((lane >> 2) & 3) << 6) | (((lane >> 4) & 1) << 5) | (((lane >> 5) & 1) << 8); }
constexpr int v_rd_off(int d0, int ks, int half) { return d0 * 512 + ks * 4096 + half * 2048; }
template <int OFF> __device__ __forceinline__ s16x4 tr_read(int vb) {
    s16x4 r; asm volatile("ds_read_b64_tr_b16 %0, %1 offset:%2" : "=&v"(r) : "v"(vb), "i"(OFF) : "memory"); return r;
}
template <int D0> __device__ __forceinline__ void pv_one(f32x16& od, int vb, bf16x8 pa0, bf16x8 pa1, bf16x8 pa2, bf16x8 pa3) {
    const s16x4 l0 = tr_read<v_rd_off(D0, 0, 0)>(vb), h0 = tr_read<v_rd_off(D0, 0, 1)>(vb), l1 = tr_read<v_rd_off(D0, 1, 0)>(vb), h1 = tr_read<v_rd_off(D0, 1, 1)>(vb);
    const s16x4 l2 = tr_read<v_rd_off(D0, 2, 0)>(vb), h2 = tr_read<v_rd_off(D0, 2, 1)>(vb), l3 = tr_read<v_rd_off(D0, 3, 0)>(vb), h3 = tr_read<v_rd_off(D0, 3, 1)>(vb);
    asm volatile("s_waitcnt lgkmcnt(0)" ::: "memory"); SBAR();
#define PK(Lo, Hi) (bf16x8){Lo[0], Lo[1], Lo[2], Lo[3], Hi[0], Hi[1], Hi[2], Hi[3]}
    od = __builtin_amdgcn_mfma_f32_32x32x16_bf16(pa0, PK(l0, h0), od, 0, 0, 0);
    od = __builtin_amdgcn_mfma_f32_32x32x16_bf16(pa1, PK(l1, h1), od, 0, 0, 0);
    od = __builtin_amdgcn_mfma_f32_32x32x16_bf16(pa2, PK(l2, h2), od, 0, 0, 0);
    od = __builtin_amdgcn_mfma_f32_32x32x16_bf16(pa3, PK(l3, h3), od, 0, 0, 0);
#undef PK
}
__device__ __forceinline__ void pv_d0(f32x16* o, int vb, bf16x8 pa0, bf16x8 pa1, bf16x8 pa2, bf16x8 pa3) {
    pv_one<0>(o[0], vb, pa0, pa1, pa2, pa3); pv_one<1>(o[1], vb, pa0, pa1, pa2, pa3); pv_one<2>(o[2], vb, pa0, pa1, pa2, pa3); pv_one<3>(o[3], vb, pa0, pa1, pa2, pa3);
}
template <bool OFF> __device__ __forceinline__ void body(const bf16* __restrict__ Qb, const bf16* __restrict__ Kh, const bf16* __restrict__ Vh, int seq, float mfix, LAS char* lds, f32x16 (&o)[4]) {
    int tid = threadIdx.x; asm volatile("" : "+v"(tid));
    const int wid = __builtin_amdgcn_readfirstlane(tid >> 6), lane = tid & 63, r32 = lane & 31, hi = lane >> 5;
    LAS char* V_lds = lds; LAS char* K_lds = lds + 2 * SHM_V;
    LAS float* ws = (LAS float*)(lds + 2 * SHM_V + 2 * SHM_K) + wid * 64; LAS float* li_l = ws; LAS float* al_l = ws + 32;
    float l_reg = 0;
    const float soff = -mfix * (SCALE * 1.4426950408889634f);
#pragma unroll
    for (int d = 0; d < 4; ++d) o[d] = f32x16{};
    bf16x8 qr[4];
    const bf16* Qw = Qb + (long)(wid * 32 + r32) * LDQ + hi * 8;
#pragma unroll
    for (int d0 = 0; d0 < 4; ++d0) qr[d0] = *(const bf16x8*)(Qw + d0 * 16);
    const int sr = tid >> 4, sc = (tid & 15) * 8, vst0 = v_st(sr, sc), vst1 = v_st(32 + sr, sc);
    const int kr = tid >> 3, kc = (tid & 7) * 8, kst = KSWZ(kr, kc * 2);
    const int vb0 = (int)(uintptr_t)V_lds + v_rd_base(lane);
    struct { bf16x8 vs0, vs1, ks0; } sr_[2];
#define SLOAD(i, k0) do { sr_[i].vs0 = *(const bf16x8*)(&Vh[(long)((k0) + sr) * LDV + sc]); sr_[i].vs1 = *(const bf16x8*)(&Vh[(long)((k0) + 32 + sr) * LDV + sc]); \
    sr_[i].ks0 = *(const bf16x8*)(&Kh[(long)((k0) + kr) * LDK + kc]); } while (0)
#define SWRITE(b, i) do { *(LAS bf16x8*)(V_lds + (b) * SHM_V + vst0) = sr_[i].vs0; *(LAS bf16x8*)(V_lds + (b) * SHM_V + vst1) = sr_[i].vs1; \
    *(LAS bf16x8*)(K_lds + (b) * SHM_K + kst) = sr_[i].ks0; } while (0)
#define SWAIT() asm volatile("s_waitcnt vmcnt(3)" ::: "memory")
    f32x16 pA0, pA1, pB0, pB1; bf16x8 pa0, pa1, pa2, pa3; const int NT = seq / KVBLK;
    constexpr int SE = 0, SO = 1;
    SLOAD(SE, 0); asm volatile("s_waitcnt vmcnt(0)" ::: "memory"); SWRITE(0, SE); __syncthreads();
    bf16x8 kf[8];
    kload<OFF>(kf, K_lds, r32, hi); qkmma<OFF>(pA0, pA1, kf, qr, K_lds, r32, hi); partialSM<OFF>(pA0, pA1, soff);
    SLOAD(SO, KVBLK); if (2 < NT) SLOAD(SE, 2 * KVBLK);
    SWAIT(); SWRITE(1, SO); __syncthreads();
    for (int j = 1; j + 1 < NT; j += 2) {
        SBAR(); kload<OFF>(kf, K_lds + SHM_K, r32, hi); SBAR();
        qkmma<OFF>(pB0, pB1, kf, qr, K_lds + SHM_K, r32, hi); finishSM(pA0, pA1, l_reg, pa0, pa1, pa2, pa3); SBAR();
        SLOAD(SO, (j + 2) * KVBLK); SBAR();
        pv_d0(o, vb0, pa0, pa1, pa2, pa3); partialSM<OFF>(pB0, pB1, soff);
        __syncthreads(); SWAIT(); SWRITE(0, SE);
        __syncthreads();
        SBAR(); kload<OFF>(kf, K_lds, r32, hi); SBAR();
        qkmma<OFF>(pA0, pA1, kf, qr, K_lds, r32, hi); finishSM(pB0, pB1, l_reg, pa0, pa1, pa2, pa3); SBAR();
        if (j + 3 < NT) SLOAD(SE, (j + 3) * KVBLK); SBAR();
        pv_d0(o, vb0 + (int)SHM_V, pa0, pa1, pa2, pa3); partialSM<OFF>(pA0, pA1, soff);
        __syncthreads(); SWAIT(); SWRITE(1, SO);
        __syncthreads();
    }
    SBAR(); kload<OFF>(kf, K_lds + SHM_K, r32, hi); SBAR();
    qkmma<OFF>(pB0, pB1, kf, qr, K_lds + SHM_K, r32, hi); finishSM(pA0, pA1, l_reg, pa0, pa1, pa2, pa3); SBAR();
    pv_d0(o, vb0, pa0, pa1, pa2, pa3); partialSM<OFF>(pB0, pB1, soff);
    __syncthreads();
    finishSM(pB0, pB1, l_reg, pa0, pa1, pa2, pa3); SBAR();
    pv_d0(o, vb0 + (int)SHM_V, pa0, pa1, pa2, pa3);
    if (hi == 0) li_l[r32] = l_reg; asm volatile("s_waitcnt lgkmcnt(0)" ::: "memory");
#pragma unroll
    for (int r = 0; r < 16; ++r) { const float rl = __builtin_amdgcn_rcpf(li_l[crow(r, hi)]);
#pragma unroll
        for (int d0 = 0; d0 < 4; ++d0) o[d0][r] *= rl; }
    __syncthreads();
#undef SLOAD
#undef SWRITE
#undef SWAIT
}

constexpr int SLK = 8192, SLV = 16384, L_K = 0, L_V = 3 * SLK, L_WS = L_V + 3 * SLV;
typedef const LAS char* lds_cptr;
typedef short v4i16_t __attribute__((ext_vector_type(4)));
#define PIN(x) asm volatile("" : "+v"(x))
#define MFMA32(a, b, c) __builtin_amdgcn_mfma_f32_32x32x16_bf16(a, b, c, 0, 0, 0)
#define WAIT_BAR(N) asm volatile("s_waitcnt vmcnt(" #N ") lgkmcnt(0)\n\ts_barrier" ::: "memory")
__device__ __forceinline__ unsigned cvtpk2(float lo, float hi) { unsigned r; asm("v_cvt_pk_bf16_f32 %0, %1, %2" : "=v"(r) : "v"(lo), "v"(hi)); return r; }
__device__ __forceinline__ void glds16(const void* g, unsigned lds_base) {
    unsigned sv; asm volatile("s_mov_b32 %0, m0\n\ts_mov_b32 m0, %2\n\ts_nop 0\n\tglobal_load_lds_dwordx4 %1, off\n\ts_mov_b32 m0, %0" : "=&s"(sv) : "v"(g), "s"(lds_base) : "memory"); }
__device__ __forceinline__ void kload2(bf16x8* kf, lds_cptr kp, int d0) { kf[2 * d0] = *(const LAS bf16x8*)(kp + d0 * 2048); kf[2 * d0 + 1] = *(const LAS bf16x8*)(kp + d0 * 2048 + 512); }
__device__ __forceinline__ s16x4 vtr(lds_cptr p) { return __builtin_bit_cast(s16x4, __builtin_amdgcn_ds_read_tr16_b64_v4i16((LAS v4i16_t*)p)); }
__device__ __forceinline__ void body_fast(const bf16* __restrict__ Qb, const bf16* __restrict__ Kh, const bf16* __restrict__ Vh, int seq, LAS char* lds, f32x16 (&o)[4]) {
    int tid = threadIdx.x; asm volatile("" : "+v"(tid));
    const int wid = __builtin_amdgcn_readfirstlane(tid >> 6), lane = tid & 63, r32 = lane & 31, hi = lane >> 5;
    const int NT = seq / KVBLK;
    const unsigned lds0 = (unsigned)(uintptr_t)lds; LAS float* wsf = (LAS float*)(lds + L_WS) + wid * 64;
    const bf16* ksrc = Kh + (long)lane * LDK + wid * 8;
    const bf16* vsrc = Vh + (long)(16 * (wid & 3) + (lane >> 2)) * LDV + (wid >> 2) * 32 + (lane & 3) * 8;
    const unsigned kdst = lds0 + L_K + wid * 1024, vdst = lds0 + L_V + wid * 1024;
#define DMA_K(t, slot) glds16(ksrc + (long)(t) * KVBLK * LDK, (unsigned)__builtin_amdgcn_readfirstlane(kdst + (slot)))
#define DMA_V1(t, slot) glds16(vsrc + (long)(t) * KVBLK * LDV, (unsigned)__builtin_amdgcn_readfirstlane(vdst + 2 * (slot)))
#define DMA_V2(t, slot) glds16(vsrc + (long)(t) * KVBLK * LDV + 64, (unsigned)__builtin_amdgcn_readfirstlane(vdst + 2 * (slot) + 8192))
#define DMA_V(t, slot) do { glds16(vsrc + (long)(t) * KVBLK * LDV, (unsigned)__builtin_amdgcn_readfirstlane(vdst + 2 * (slot))); \
                            glds16(vsrc + (long)(t) * KVBLK * LDV + 64, (unsigned)__builtin_amdgcn_readfirstlane(vdst + 2 * (slot) + 8192)); } while (0)
    const lds_cptr vp0 = (lds_cptr)lds + L_V + ((lane >> 4) & 1) * 32 + (lane & 3) * 8 + (4 * hi + ((lane & 15) >> 2)) * 64;
    const lds_cptr kp0 = (lds_cptr)lds + L_K + hi * 1024 + r32 * 16;
    DMA_K(0, 0); DMA_V(0, 0); DMA_K(1, SLK);
    bf16x8 qr[4];
    const bf16* Qw = Qb + (long)(wid * 32 + r32) * LDQ + hi * 8;
#pragma unroll
    for (int d0 = 0; d0 < 4; ++d0) qr[d0] = *(const bf16x8*)(Qw + d0 * 16);
    float l_reg = 0.f;
#pragma unroll
    for (int d = 0; d < 4; ++d) o[d] = f32x16{};
    f32x16 pA0, pA1, pB0, pB1; bf16x8 kf[8]; s16x4 vlo[8], vhi[8]; v4u pw0, pw1, pw2, pw3;
    int sl_prev = 0, sl_cur = 0, sl_next = SLK;
#define ROT() do { sl_prev = sl_cur; sl_cur = sl_next; sl_next = (sl_next == 2 * SLK) ? 0 : sl_next + SLK; } while (0)
#define EX(v) __builtin_amdgcn_exp2f(v)
    DMA_K(2, 2 * SLK);
    WAIT_BAR(4);
    _Pragma("unroll") for (int d0 = 0; d0 < 4; ++d0) kload2(kf, kp0, d0);
    pA0 = MFMA32(kf[0], qr[0], f32x16{}); pA1 = MFMA32(kf[1], qr[0], f32x16{}); pA0 = MFMA32(kf[2], qr[1], pA0); pA1 = MFMA32(kf[3], qr[1], pA1);
    pA0 = MFMA32(kf[4], qr[2], pA0); pA1 = MFMA32(kf[5], qr[2], pA1); pA0 = MFMA32(kf[6], qr[3], pA0); pA1 = MFMA32(kf[7], qr[3], pA1);
#pragma unroll
    for (int r = 0; r < 16; ++r) { pA0[r] = EX(pA0[r]); pA1[r] = EX(pA1[r]); }
    WAIT_BAR(0);
    DMA_K(3, 0); DMA_V(1, SLK); ROT();
    _Pragma("unroll") for (int d0 = 0; d0 < 4; ++d0) kload2(kf, kp0 + sl_cur, d0);
    WAIT_BAR(3);
#define PKW(P, i) cvtpk2(P[i], P[i + 1])
#define PAF(k) __builtin_bit_cast(bf16x8, pw##k)
#define VFR(i) (bf16x8){vlo[i][0], vlo[i][1], vlo[i][2], vlo[i][3], vhi[i][0], vhi[i][1], vhi[i][2], vhi[i][3]}
#define VRD(s, fi) do { vlo[s] = vtr(vp_ + (((fi) >> 2) * 4096 + ((fi) & 3) * 1024)); vhi[s] = vtr(vp_ + (((fi) >> 2) * 4096 + ((fi) & 3) * 1024 + 512)); } while (0)
#define KRD(G, d0) do { if (G) { kload2(kf, kp0 + sl_next, d0); SBAR(); } } while (0)
#define GAPA(MF, a0, a1, a2, a3, W0, W1, PW) do { MF; sacc += a0; sacc2 += a1; sacc += a2; sacc2 += a3; W0; W1; PIN(PW); PIN(sacc); PIN(sacc2); SBAR(); } while (0)
#define GAPB(MF, X, i) do { MF; X[i] = EX(X[i]); X[i + 1] = EX(X[i + 1]); PIN(X); SBAR(); } while (0)
#define STEP(C0, C1, P0, P1, t, GK, GV, GL) do { SBAR(); \
    const lds_cptr vp_ = vp0 + 2 * sl_prev; \
    VRD(0, 0); SBAR(); float sacc = P0[0], sacc2 = P0[1]; \
                       GAPA(C0 = MFMA32(kf[0], qr[0], f32x16{}), P0[2], P0[3], P0[4], P0[5],     pw0[0] = PKW(P0, 0),  pw0[1] = PKW(P0, 2),  pw0); \
    VRD(4, 4); SBAR(); GAPA(C1 = MFMA32(kf[1], qr[0], f32x16{}), P0[6], P0[7], P0[8], P0[9],     pw0[2] = PKW(P0, 4),  pw0[3] = PKW(P0, 6),  pw0); \
    VRD(1, 1); SBAR(); GAPA(C0 = MFMA32(kf[2], qr[1], C0),       P0[10], P0[11], P0[12], P0[13], pw1[0] = PKW(P0, 8),  pw1[1] = PKW(P0, 10), pw1); \
    VRD(5, 5); SBAR(); GAPA(C1 = MFMA32(kf[3], qr[1], C1),       P0[14], P0[15], P1[0], P1[1],   pw1[2] = PKW(P0, 12), pw1[3] = PKW(P0, 14), pw1); \
    VRD(2, 2); SBAR(); GAPA(C0 = MFMA32(kf[4], qr[2], C0),       P1[2], P1[3], P1[4], P1[5],     pw2[0] = PKW(P1, 0),  pw2[1] = PKW(P1, 2),  pw2); \
    VRD(6, 6); SBAR(); GAPA(C1 = MFMA32(kf[5], qr[2], C1),       P1[6], P1[7], P1[8], P1[9],     pw2[2] = PKW(P1, 4),  pw2[3] = PKW(P1, 6),  pw2); \
    VRD(3, 3); SBAR(); GAPA(C0 = MFMA32(kf[6], qr[3], C0),       P1[10], P1[11], P1[12], P1[13], pw3[0] = PKW(P1, 8),  pw3[1] = PKW(P1, 10), pw3); \
    VRD(7, 7); SBAR(); GAPA(C1 = MFMA32(kf[7], qr[3], C1),       P1[14], P1[15], 0.f, 0.f,       pw3[2] = PKW(P1, 12), pw3[3] = PKW(P1, 14), pw3); \
    l_reg += sacc + sacc2; SBAR(); \
    GAPB(o[0] = MFMA32(PAF(0), VFR(0), o[0]), C0, 0);  VRD(0, 8);  SBAR(); \
    GAPB(o[1] = MFMA32(PAF(0), VFR(4), o[1]), C0, 2);  VRD(4, 12); SBAR(); \
    GAPB(o[0] = MFMA32(PAF(1), VFR(1), o[0]), C0, 4);  VRD(1, 9);  SBAR(); \
    GAPB(o[1] = MFMA32(PAF(1), VFR(5), o[1]), C0, 6);  VRD(5, 13); SBAR(); \
    GAPB(o[0] = MFMA32(PAF(2), VFR(2), o[0]), C0, 8);  VRD(2, 10); SBAR(); \
    GAPB(o[1] = MFMA32(PAF(2), VFR(6), o[1]), C0, 10); VRD(6, 14); SBAR(); \
    GAPB(o[0] = MFMA32(PAF(3), VFR(3), o[0]), C0, 12); VRD(3, 11); SBAR(); \
    GAPB(o[1] = MFMA32(PAF(3), VFR(7), o[1]), C0, 14); VRD(7, 15); SBAR(); \
    KRD(GL, 0); GAPB(o[2] = MFMA32(PAF(0), VFR(0), o[2]), C1, 0); \
    KRD(GL, 1); GAPB(o[3] = MFMA32(PAF(0), VFR(4), o[3]), C1, 2); \
    KRD(GL, 2); GAPB(o[2] = MFMA32(PAF(1), VFR(1), o[2]), C1, 4); \
    KRD(GL, 3); GAPB(o[3] = MFMA32(PAF(1), VFR(5), o[3]), C1, 6); \
    GAPB(o[2] = MFMA32(PAF(2), VFR(2), o[2]), C1, 8);  if (GK) { DMA_K((t) + 3, sl_cur); SBAR(); } \
    GAPB(o[3] = MFMA32(PAF(2), VFR(6), o[3]), C1, 10); if (GV) { DMA_V1((t) + 1, sl_next); SBAR(); } \
    GAPB(o[2] = MFMA32(PAF(3), VFR(3), o[2]), C1, 12); if (GV) { DMA_V2((t) + 1, sl_next); SBAR(); } \
    GAPB(o[3] = MFMA32(PAF(3), VFR(7), o[3]), C1, 14); \
    } while (0)
    int t = 1;
    for (; t + 5 < NT; t += 2) {
        STEP(pB0, pB1, pA0, pA1, t, true, true, true);     WAIT_BAR(3); ROT();
        STEP(pA0, pA1, pB0, pB1, t + 1, true, true, true); WAIT_BAR(3); ROT();
    }
#define ENDW(tt) do { if ((tt) + 3 < NT) { WAIT_BAR(3); } else if ((tt) + 2 < NT) { WAIT_BAR(2); } else { WAIT_BAR(0); } } while (0)
    for (; t + 1 < NT; t += 2) {
        STEP(pB0, pB1, pA0, pA1, t, (t + 3 < NT), (t + 1 < NT), (t + 1 < NT));         ENDW(t);     ROT();
        STEP(pA0, pA1, pB0, pB1, t + 1, (t + 4 < NT), (t + 2 < NT), (t + 2 < NT));     ENDW(t + 1); ROT();
    }
    STEP(pB0, pB1, pA0, pA1, NT - 1, false, false, false);
    { float sacc = pB0[0] + pB0[1];
#pragma unroll
      for (int r = 2; r < 16; ++r) sacc += pB0[r];
#pragma unroll
      for (int r = 0; r < 16; ++r) sacc += pB1[r];
      l_reg += sacc;
      pw0 = (v4u){PKW(pB0, 0), PKW(pB0, 2), PKW(pB0, 4), PKW(pB0, 6)}; pw1 = (v4u){PKW(pB0, 8), PKW(pB0, 10), PKW(pB0, 12), PKW(pB0, 14)};
      pw2 = (v4u){PKW(pB1, 0), PKW(pB1, 2), PKW(pB1, 4), PKW(pB1, 6)}; pw3 = (v4u){PKW(pB1, 8), PKW(pB1, 10), PKW(pB1, 12), PKW(pB1, 14)};
      const lds_cptr vp_ = vp0 + 2 * sl_cur;
      _Pragma("unroll") for (int i = 0; i < 8; ++i) VRD(i, i);
      o[0] = MFMA32(PAF(0), VFR(0), o[0]); o[1] = MFMA32(PAF(0), VFR(4), o[1]); o[0] = MFMA32(PAF(1), VFR(1), o[0]); o[1] = MFMA32(PAF(1), VFR(5), o[1]);
      o[0] = MFMA32(PAF(2), VFR(2), o[0]); o[1] = MFMA32(PAF(2), VFR(6), o[1]); o[0] = MFMA32(PAF(3), VFR(3), o[0]); o[1] = MFMA32(PAF(3), VFR(7), o[1]);
      SBAR();
      _Pragma("unroll") for (int i = 0; i < 8; ++i) VRD(i, 8 + i);
      o[2] = MFMA32(PAF(0), VFR(0), o[2]); o[3] = MFMA32(PAF(0), VFR(4), o[3]); o[2] = MFMA32(PAF(1), VFR(1), o[2]); o[3] = MFMA32(PAF(1), VFR(5), o[3]);
      o[2] = MFMA32(PAF(2), VFR(2), o[2]); o[3] = MFMA32(PAF(2), VFR(6), o[3]); o[2] = MFMA32(PAF(3), VFR(3), o[2]); o[3] = MFMA32(PAF(3), VFR(7), o[3]); }
    { auto rr = __builtin_amdgcn_permlane32_swap(__float_as_uint(l_reg), __float_as_uint(l_reg), false, false); l_reg = __uint_as_float(rr[0]) + __uint_as_float(rr[1]); }
    if (hi == 0) wsf[32 + r32] = l_reg; asm volatile("s_waitcnt lgkmcnt(0)" ::: "memory");
#pragma unroll
    for (int r = 0; r < 16; ++r) { const float rl = __builtin_amdgcn_rcpf(wsf[32 + crow(r, hi)]);
#pragma unroll
        for (int d0 = 0; d0 < 4; ++d0) o[d0][r] *= rl; }
    asm volatile("s_waitcnt lgkmcnt(0)\n\ts_barrier" ::: "memory");
#undef DMA_K
#undef DMA_V
#undef DMA_V1
#undef DMA_V2
#undef ROT
#undef EX
#undef PKW
#undef PAF
#undef VFR
#undef VRD
#undef KRD
#undef ENDW
#undef GAPA
#undef GAPB
#undef STEP
}
}

__device__ __forceinline__ void unit_attn(const Frame& F, int L, int b, int h, int qrow0  , int seq) {
    f32x16 o[4];
    for (int m = 0; m < 2; ++m) {
        const float mfix = F.LP()[L * 16 + 10];
        if (__builtin_expect(mfix * (att::SCALE * 1.4426950408889634f) > 64.f, 0))
            att::body<true>(F.QH() + (size_t)qrow0 * 512 + (h * 2 + m) * 64, F.KH() + (size_t)b * NKEY * 512 + (h * 2 + m) * 64, F.VH() + (size_t)b * NKEY * 512 + h * 128, seq, mfix, (LAS char*)F.lds, o);
        else
            att::body_fast(F.QH() + (size_t)qrow0 * 512 + (h * 2 + m) * 64, F.KH() + (size_t)b * NKEY * 512 + (h * 2 + m) * 64, F.VH() + (size_t)b * NKEY * 512 + h * 128, seq, (LAS char*)F.lds, o);
        if (m == 0) {
            int tid = F.tid; asm volatile("" : "+v"(tid));
            const int lane = tid & 63, wave = __builtin_amdgcn_readfirstlane(tid >> 6), r32 = lane & 31, hi = lane >> 5;
            float* scr = F.SCR() + (size_t)F.bid * 256 * 128 + (size_t)(wave * 32) * 128;
#pragma unroll
            for (int r = 0; r < 16; ++r)
#pragma unroll
                for (int d0 = 0; d0 < 4; ++d0) scr[crow(r, hi) * 128 + d0 * 32 + r32] = o[d0][r];
            asm volatile("s_waitcnt vmcnt(0)" ::: "memory");
        }
    }
    int tid = F.tid; asm volatile("" : "+v"(tid));
    const int lane = tid & 63, wave = __builtin_amdgcn_readfirstlane(tid >> 6), r32 = lane & 31, hi = lane >> 5;
    const float lam = F.LP()[L * 16 + 0], oscale = F.LP()[L * 16 + 1];
    const float* scr = F.SCR() + (size_t)F.bid * 256 * 128 + (size_t)(wave * 32) * 128;
    float sg[4];
#pragma unroll
    for (int d0 = 0; d0 < 4; ++d0) sg[d0] = F.subg()[L * 128 + d0 * 32 + r32] * oscale;
#pragma unroll
    for (int r = 0; r < 16; ++r) {
        float d[4]; float ss = 0.f;
#pragma unroll
        for (int d0 = 0; d0 < 4; ++d0) { d[d0] = scr[crow(r, hi) * 128 + d0 * 32 + r32] - lam * o[d0][r]; ss += d[d0] * d[d0]; }
        const float rs = rsqrtf(half_sum32(ss) * (1.f / 128.f) + EPS);
        bf16* mr = F.MIX() + (size_t)(qrow0 + wave * 32 + crow(r, hi)) * DM + h * 128;
#pragma unroll
        for (int d0 = 0; d0 < 4; ++d0) mr[d0 * 32 + r32] = (bf16)f2bf(d[d0] * rs * sg[d0]);
    }
}


constexpr int NPH_L = 12, NPHASE = 2 + DEPTH * NPH_L;
struct Args { const float* in[25]; float* out; unsigned char* ws; int gp_lo, gp_hi; };
__global__ void __launch_bounds__(NTHR, 2) fwd(Args args) {
    extern __shared__ __attribute__((aligned(16))) unsigned char lds[];
    Frame F;
    F.lds = (LAS unsigned char*)lds;
    F.tid = threadIdx.x; F.lane = F.tid & 63; F.wave = __builtin_amdgcn_readfirstlane(F.tid >> 6); F.bid = blockIdx.x; F.G = gridDim.x;
    F.in = args.in; F.out = args.out; F.ws = args.ws;
    unsigned char* ws = args.ws;
    volatile LAS unsigned* MISC = (volatile LAS unsigned*)(F.lds + MISC_OFF);
    for (int u = F.tid; u < (LDS_BYTES - RING_BYTES) / 4; u += NTHR) ((LAS unsigned*)(F.lds + RING_BYTES))[u] = 0u;
    __syncthreads();
#if MK_ONE_LAUNCH
    constexpr int lo = 0, hi = NPHASE;
#else
    const int lo = args.gp_lo, hi = args.gp_hi;
#endif
    unsigned* barw = (unsigned*)(ws + WS_CTL) + CW_BAR;
    XcdBarrier bar; bar.bar = barw; bar.x = 0; bar.st = nullptr;
    if (hi - lo > 1) bar = xcd_barrier_post(barw, MISC + 8);
#ifndef N_CV_N2
#define N_CV_N2 2
#endif
#ifndef N_CV_INP
#define N_CV_INP 1
#endif
#ifndef N_CV_OUT
#define N_CV_OUT 1
#endif
#ifndef N_CV_TOPK
#define N_CV_TOPK 1
#endif
#ifndef N_CV_DOWN
#define N_CV_DOWN 1
#endif
#ifndef PHM
#define PHM 0xFFFF
#endif
#define PB(i) (((PHM) >> (i)) & 1)
#ifndef DBLM
#define DBLM 0
#endif
#define REP(i) for (int rep_ = 0; rep_ < ((((DBLM) >> (i)) & 1) ? 2 : 1); ++rep_)
#define IN(k) (lo <= (k) && (k) < hi)
#ifndef BARX
#define BARX 1
#endif
#define SEAM(k) do { if (IN(k) && IN((k) + 1)) { for (int bx_ = 0; bx_ < BARX; ++bx_) xcd_barrier(bar); } } while (0)

    if (PB(0) && IN(0)) REP(0) ph_prologue(F);
    SEAM(0);
    if (PB(1) && IN(1)) REP(1) ph_norm1_first(F);
    SEAM(1);
    for (int L = 0; L < DEPTH; ++L) {
        const int base = 2 + NPH_L * L;
#define FRESH() do { F.tid = threadIdx.x; asm volatile("" : "+v"(F.tid)); F.lane = F.tid & 63; } while (0)
        if (PB(2) && IN(base + 0)) REP(2) {
            pg8::Gemm g{F.HN(), F.WIN() + (size_t)L * INC * DM, NROW, INC, DM}; pg8::StaticOrder S; S.init(NROW, INC, F.G, F.bid);
            EpiZ E{F.Z(), F.VH(), F.QH(), F.KH(), F.LP() + DEPTH * 16 + L * 128, F.ROPE()};
            pg8::gemm_phase<EpiZ, pg8::StaticOrder, true, true>(F.lds, g, S, E);
            if (F.bid >= (66 * 13) % 256) { FRESH(); conv_n(F, N_CV_INP); }
        }
        SEAM(base + 0);
        if (PB(3) && IN(base + 1)) REP(3) {
            FRESH();
            for (int u = F.bid; u < 1056; u += F.G) {
                const int v = u < 528 ? u : u - 528; const int b = v / 264, hh = (v / NCH) & 3, cc = v % NCH;
                if (u < 528) unit_retkv(F, L, b, hh, cc); else if (!(L == DEPTH - 1 && cc < 2)) unit_sg(F, L, b, hh, cc);
            }
        }
        SEAM(base + 1);
        if (PB(5) && IN(base + 3)) REP(5) { FRESH(); ph_scan(F, L); }
        SEAM(base + 3);
        if (PB(6) && IN(base + 4)) REP(6) {
            FRESH();
            for (int u = F.bid; u < 264 + 528; u += F.G) {
                if (u < 264) {
                    int b, hh, qrow0, seq;
                    if (u < 256) { const int bh = u & 7, qb = u >> 3; b = bh >> 2; hh = bh & 3; qrow0 = b * SEQ + qb * 256; seq = NKEY; }
                    else { if (L == DEPTH - 1) continue; const int v = u - 256; b = v >> 2; hh = v & 3; qrow0 = NLAT + b * CTXL; seq = CTXL; }
#ifndef NO_ATTN
                    unit_attn(F, L, b, hh, qrow0, seq);
#endif
                } else {
#ifndef NO_RETOUT
                    const int v = u - 264; if (!(L == DEPTH - 1 && (v % NCH) < 2)) unit_retout(F, L, v / 264, (v / NCH) & 3, v % NCH);
#endif
                }
            }
        }
        SEAM(base + 4);
        if (PB(7) && IN(base + 5)) REP(7) {
            pg8::Gemm g{F.MIX(), F.WOUT() + (size_t)L * DM * DM, NLAT, DM, DM}; pg8::StaticOrder S; S.init(NLAT, DM, F.G, F.bid);
#ifdef PROBE_OUT2
            { EpiResid E0{(bf16*)(F.ws + WS_Y), F.MOD() + (size_t)L * 3 * 6144 + 2048, L == 0 ? F.x_in() : nullptr}; pg8::gemm_phase<EpiResid, pg8::StaticOrder, true, true>(F.lds, g, S, E0); }
#endif
            EpiResid E{F.X(), F.MOD() + (size_t)L * 3 * 6144 + 2048, L == 0 ? F.x_in() : nullptr};
            pg8::gemm_phase<EpiResid, pg8::StaticOrder, true, true>(F.lds, g, S, E);
            if (L < DEPTH - 1) { FRESH(); for (int mu = F.bid; mu < 256; mu += F.G) unit_out_ctx(F, L, mu); }
        }
        SEAM(base + 5);
        if (PB(8) && IN(base + 6)) REP(8) { FRESH(); ph_norm2_router(F, L); if (F.bid >= (((L == DEPTH - 1) ? NLAT : NROW) / 16 + NWAVES - 1) / NWAVES) conv_n(F, N_CV_N2); }
        SEAM(base + 6);
        if (PB(9) && IN(base + 7)) REP(9) { FRESH(); ph_topk(F, L); if (F.bid >= ((L == DEPTH - 1) ? 32 : 64)) conv_n(F, N_CV_TOPK);
            conv_until(F, CONV_SEG0 + (unsigned)(L + 1) * CONV_PER_L); }
        SEAM(base + 7);
        if (PB(11) && IN(base + 9)) REP(11) {
            pg8::Gemm g{F.HN(), F.WGU() + (size_t)L * NE * 4096 * DM, NE * EROWS, NE * 4096, DM};        const int npm = (L == DEPTH - 1) ? 8 : 9; MoeOrder S{F.G, F.bid, 16, npm, NE * npm * 16};
            EpiSwiglu E{F.HH()};
            pg8::gemm_phase_ga<EpiSwiglu, MoeOrder>(F.lds, g, S, E, F.ROWIDX(), NROW, (LAS int*)(F.lds + ISLOT_OFF));
        }
        SEAM(base + 9);
        if (PB(12) && IN(base + 10)) REP(12) {
            pg8::Gemm g{F.HH(), F.WD() + (size_t)L * NE * DM * FF, NE * EROWS, NE * DM, FF}; const int npm = (L == DEPTH - 1) ? 8 : 9; MoeOrder S{F.G, F.bid, 4, npm, NE * npm * 4};
            pg8::EpiBf16<0> E{F.Y(), DM, nullptr, DM, 0, 1.f};
            pg8::gemm_phase<pg8::EpiBf16<0>, MoeOrder, true, true>(F.lds, g, S, E);
            if (L < DEPTH - 1 && F.bid >= 64) { FRESH(); conv_n(F, N_CV_DOWN); }
        }
        SEAM(base + 10);
        if (PB(13) && IN(base + 11)) REP(13) { FRESH(); ph_combine(F, L); }
        SEAM(base + 11);
    }
#undef IN
#undef SEAM
}

extern "C" void kernel_launch(void* const* d_in, const int* in_sizes, int n_in, void* d_out, int out_size, void* d_ws, size_t ws_size, hipStream_t stream) {
    static int grid = 0;
    if (grid == 0) {
        if (n_in != 25 || in_sizes[0] != NLAT * DM || out_size != NLAT * DM || ws_size < WS_END) {
            fprintf(stderr, "kernel_launch: built for 25 inputs, x/out of %d floats, >= %zu bytes of workspace; got n_in %d, in0 %d, out %d, ws %zu; nothing launched\n", NLAT * DM, (size_t)WS_END, n_in, n_in > 0 ? in_sizes[0] : -1, out_size, ws_size);
            grid = -1; return; }
        int dev = 0, cus = 0, per_cu = 0;
        if (hipGetDevice(&dev) != hipSuccess || hipDeviceGetAttribute(&cus, hipDeviceAttributeMultiprocessorCount, dev) != hipSuccess) { fprintf(stderr, "kernel_launch: device query failed\n"); grid = -1; return; }
        if (hipFuncSetAttribute((const void*)fwd, hipFuncAttributeMaxDynamicSharedMemorySize, LDS_BYTES) != hipSuccess) { fprintf(stderr, "kernel_launch: hipFuncSetAttribute failed\n"); grid = -1; return; }
        if (hipOccupancyMaxActiveBlocksPerMultiprocessor(&per_cu, (const void*)fwd, NTHR, LDS_BYTES) != hipSuccess || per_cu < 1)
            fprintf(stderr, "kernel_launch: note: occupancy query reports %d workgroups per CU\n", per_cu);
        (void)hipGetLastError();
        grid = cus;
    }
    if (grid < 0) return;
    if (hipMemsetAsync((char*)d_ws + WS_CTL, 0, CTL_ZERO_BYTES, stream) != hipSuccess) { fprintf(stderr, "kernel_launch: memset failed\n"); return; }
    Args a{};
    for (int i = 0; i < 25; ++i) a.in[i] = (const float*)d_in[i];
    a.out = (float*)d_out; a.ws = (unsigned char*)d_ws;
#if MK_ONE_LAUNCH
    a.gp_lo = 0; a.gp_hi = NPHASE;
    hipLaunchKernelGGL(fwd, dim3(grid), dim3(NTHR), LDS_BYTES, stream, a);
#else
    for (int gp = 0; gp < NPHASE; ++gp) { a.gp_lo = gp; a.gp_hi = gp + 1; hipLaunchKernelGGL(fwd, dim3(grid), dim3(NTHR), LDS_BYTES, stream, a); }
#endif
    const hipError_t le = hipPeekAtLastError();
    if (le != hipSuccess) fprintf(stderr, "kernel_launch: launch failed: %s\n", hipGetErrorName(le));
}
```

```cpp
#include <hip/hip_runtime.h>
#include <cstdio>
#include <cstdint>
#ifndef MK_ONE_LAUNCH
#define MK_ONE_LAUNCH 1
#endif
namespace pg8 {
#define PG8_LAS __attribute__((address_space(3)))
typedef unsigned short bf16_t;
typedef short bf16x8 __attribute__((ext_vector_type(8)));
typedef float f32x4 __attribute__((ext_vector_type(4)));
typedef unsigned u32x4 __attribute__((ext_vector_type(4)));
constexpr int BM = 256, BK = 64, HALF = 128, HTB = HALF * BK * 2  , STAGE_BYTES = 8 * HTB, NXCD = 8, WGM = 8;

__host__ __device__ __forceinline__ int lds_byte(int r, int c) { const int st = (r >> 4) * 2 + (c >> 5), rr = r & 15, cc = c & 31, ob = rr * 64 + cc * 2; return st * 1024 + (ob ^ (((ob >> 9) & 1) << 5)); }
__host__ __device__ __forceinline__ void stage_rc(int b, int& R, int& C) { const int st = b / 1024, sb = b % 1024, swz = sb ^ (((sb >> 9) & 1) << 5); R = (st >> 1) * 16 + swz / 64; C = (st & 1) * 32 + (swz % 64) / 2; }
__host__ __device__ __forceinline__ int perm32(int rho) { const int n = rho >> 4, i = rho & 15; return 8 * (i >> 2) + 4 * n + (i & 3); }

struct Unit { int pm, pn; };
struct Gemm { const bf16_t* A; const bf16_t* Bt; int M, N, K; };

struct StaticOrder {
    int nM, nN, nwg, G, c;
    __host__ __device__ void init(int M, int N, int G_, int c_) { nM = M / BM; nN = N / BM; nwg = nM * nN; G = G_; c = c_; }
    __host__ __device__ bool next(int i, Unit& u) const {
        const long L = (long)i * G + c; if (L >= nwg) return false;
        int wgid = (int)L; { const int q = nwg / NXCD, r = nwg % NXCD, xcd = wgid % NXCD, off = wgid / NXCD; wgid = (xcd < r ? xcd * (q + 1) : r * (q + 1) + (xcd - r) * q) + off; }
        const int nig = WGM * nN, gid = wgid / nig, fm = gid * WGM, gsz = (nM - fm) < WGM ? (nM - fm) : WGM;
        u.pm = fm + ((wgid % nig) % gsz); u.pn = (wgid % nig) / gsz; return true;
    }
    __device__ __forceinline__ void a_ready(const Unit&) const {}
    __device__ __forceinline__ void done(const Unit&) const {}
    __device__ __forceinline__ bool half_only(const Unit&) const { return false; }
};

__device__ __forceinline__ unsigned cvt_pk_bf16(float lo, float hi) { unsigned r; asm volatile("v_cvt_pk_bf16_f32 %0, %1, %2" : "=v"(r) : "v"(lo), "v"(hi)); return r; }
typedef float f32x2 __attribute__((ext_vector_type(2)));
__device__ __forceinline__ f32x2 gelu_pk(f32x2 v) {
    const f32x2 av = __builtin_elementwise_abs(v), d = av * 0.2316418882f + 1.0f;
    f32x2 t; t.x = __builtin_amdgcn_rcpf(d.x); t.y = __builtin_amdgcn_rcpf(d.y);
    f32x2 q = t * 0.5307027145f + (-0.7265760135f); q = q * t + 0.7107068705f; q = q * t + (-0.142248368f); q = q * t + 0.127414796f; q = q * t;
    const f32x2 s = (v * v) * (-0.72134752044f);
    f32x2 e; e.x = __builtin_amdgcn_exp2f(s.x); e.y = __builtin_amdgcn_exp2f(s.y);
    const f32x2 m = v * (q * e), r = v - m;
    f32x2 o; o.x = v.x < 0.f ? m.x : r.x; o.y = v.y < 0.f ? m.y : r.y; return o;
}

template <int ACT  > struct EpiBf16 {
    static constexpr bool PERM = true, AFTER_DRAIN = false; static_assert(ACT == 0 || ACT == 1, "EpiBf16: ACT is 0 (none) or 1 (gelu_pk)");
    bf16_t* O; int ldc; const float* bias; int split_cols; size_t split_stride; float scale0;
    __device__ __forceinline__ void operator()(const f32x4 (&acc)[2][2][4][2], const Unit& u, int wr, int wc, int fr, int fq) const {
        const int row0 = u.pm * BM + wr * 64 + fr; int colt = u.pn * BM; bf16_t* base = O;
        float sc = 1.f; if (split_cols) { const int t = colt / split_cols; base += (size_t)t * split_stride; colt -= t * split_cols; if (t == 0) sc = scale0; }
        const int col0 = colt + wc * 32 + 8 * fq, bcol0 = u.pn * BM + wc * 32 + 8 * fq;
        f32x4 bv[2][2];
#pragma unroll
        for (int bj = 0; bj < 2; ++bj)
#pragma unroll
            for (int n = 0; n < 2; ++n) bv[bj][n] = bias ? *(const f32x4*)(bias + bcol0 + bj * HALF + 4 * n) : (f32x4){0.f, 0.f, 0.f, 0.f};
#pragma unroll
        for (int ai = 0; ai < 2; ++ai)
#pragma unroll
            for (int m = 0; m < 4; ++m) { bf16_t* rowp = base + (size_t)(row0 + ai * HALF + m * 16) * ldc + col0;
#pragma unroll
                for (int bj = 0; bj < 2; ++bj) { f32x4 v0 = acc[ai][bj][m][0] + bv[bj][0], v1 = acc[ai][bj][m][1] + bv[bj][1];
                    if (ACT == 1) { f32x2 a = gelu_pk((f32x2){v0[0], v0[1]}), b = gelu_pk((f32x2){v0[2], v0[3]}), c = gelu_pk((f32x2){v1[0], v1[1]}), d = gelu_pk((f32x2){v1[2], v1[3]});
                        v0 = (f32x4){a.x, a.y, b.x, b.y}; v1 = (f32x4){c.x, c.y, d.x, d.y}; }
                    v0 = v0 * sc; v1 = v1 * sc; u32x4 w; w.x = cvt_pk_bf16(v0[0], v0[1]); w.y = cvt_pk_bf16(v0[2], v0[3]); w.z = cvt_pk_bf16(v1[0], v1[1]); w.w = cvt_pk_bf16(v1[2], v1[3]);
                    *(u32x4*)(rowp + bj * HALF) = w; } }
    }
};
template <class Epi, class Sched, bool ALIGN_EPI = false, bool SP2 = false>
__device__ __forceinline__ void gemm_phase(PG8_LAS unsigned char* lds, const Gemm g, const Sched& S, const Epi& E) {
    int tid = threadIdx.x; asm volatile("" : "+v"(tid));
    const int wid = __builtin_amdgcn_readfirstlane(tid >> 6), lane = tid & 63, wr = wid >> 2, wc = wid & 3, fr = lane & 15, fq = lane >> 4;
    const int K = g.K, nt = K / BK;
    unsigned voffA[2], voffB[2];
#pragma unroll
    for (int i = 0; i < 2; ++i) { int R, C; stage_rc(tid * 16 + i * 8192, R, C); const int Rb = Epi::PERM ? ((R & ~31) + perm32(R & 31)) : R;
        voffA[i] = (unsigned)(R * K + C) * 2u; voffB[i] = (unsigned)(Rb * K + C) * 2u; }
    const size_t kstep = (size_t)(BK * 2);
    const size_t hstep = (size_t)HALF * K * 2;
    const size_t tstep = 2 * hstep;
    const unsigned ldsw = (unsigned)wid * 1024u;
    const int aoff = lds_byte(wr * 64 + fr, fq * 8), boff = lds_byte(wc * 32 + fr, fq * 8);
#define PG8_SA(b, h) (((b) * 2 + (h)) * HTB)
#define PG8_SB(b, h) ((4 + (b) * 2 + (h)) * HTB)
#define PG8_STAGE(bufoff, gbase, voff) do { _Pragma("unroll") for (int _i = 0; _i < 2; ++_i) \
        __builtin_amdgcn_global_load_lds((const unsigned*)((const char*)(gbase) + (voff)[_i]), (PG8_LAS unsigned*)(lds + (bufoff) + ldsw + _i * 8192), 16, 0, 0); } while (0)
#define PG8_LDA(dst, b, h) do { _Pragma("unroll") for (int m = 0; m < 4; ++m) _Pragma("unroll") for (int k = 0; k < 2; ++k) dst[m][k] = *(const PG8_LAS bf16x8*)(lds + PG8_SA(b, h) + aoff + m * 2048 + k * 1024); } while (0)
#define PG8_LDB(dst, b, h) do { _Pragma("unroll") for (int n = 0; n < 2; ++n) _Pragma("unroll") for (int k = 0; k < 2; ++k) dst[n][k] = *(const PG8_LAS bf16x8*)(lds + PG8_SB(b, h) + boff + n * 2048 + k * 1024); } while (0)
#define PG8_MMA(ai, bj, At, Bt) do { __builtin_amdgcn_s_setprio(1); _Pragma("unroll") for (int m = 0; m < 4; ++m) _Pragma("unroll") for (int n = 0; n < 2; ++n) _Pragma("unroll") for (int k = 0; k < 2; ++k) \
        acc[ai][bj][m][n] = __builtin_amdgcn_mfma_f32_16x16x32_bf16(Bt[n][k], At[m][k], acc[ai][bj][m][n], 0, 0, 0); __builtin_amdgcn_s_setprio(0); } while (0)
#define PG8_WAIT_V(n) asm volatile("s_waitcnt vmcnt(" #n ")" ::: "memory")
#define PG8_WAIT_L(n) asm volatile("s_waitcnt lgkmcnt(" #n ")" ::: "memory")
#define PG8_BAR __builtin_amdgcn_s_barrier()
#define PG8_SCHED __builtin_amdgcn_sched_barrier(0)
    Unit cur, nxt; int ui = 0;
    if (!S.next(0, cur)) return;
    f32x4 acc[2][2][4][2];
#pragma unroll
    for (int a = 0; a < 2; ++a)
#pragma unroll
        for (int b = 0; b < 2; ++b)
#pragma unroll
            for (int m = 0; m < 4; ++m)
#pragma unroll
                for (int n = 0; n < 2; ++n) acc[a][b][m][n] = (f32x4){0.f, 0.f, 0.f, 0.f};
    bf16x8 At[4][2], B0[2][2], B1[2][2];
    const char* cA = (const char*)g.A + (size_t)cur.pm * tstep; const char* cB = (const char*)g.Bt + (size_t)cur.pn * tstep;
    S.a_ready(cur);
    if constexpr (SP2) {
        PG8_STAGE(PG8_SB(0, 0), cB, voffB); PG8_STAGE(PG8_SB(0, 1), cB + hstep, voffB); PG8_STAGE(PG8_SA(0, 0), cA, voffA); PG8_STAGE(PG8_SA(0, 1), cA + hstep, voffA);
        if (wr == 1) PG8_BAR;
        PG8_WAIT_V(2); PG8_BAR;
        PG8_STAGE(PG8_SB(1, 0), cB + kstep, voffB); PG8_STAGE(PG8_SA(1, 0), cA + kstep, voffA); PG8_STAGE(PG8_SB(1, 1), cB + hstep + kstep, voffB);
        PG8_WAIT_V(6); PG8_BAR;
    } else {
        PG8_STAGE(PG8_SB(0, 0), cB, voffB); PG8_STAGE(PG8_SA(0, 0), cA, voffA); PG8_STAGE(PG8_SB(0, 1), cB + hstep, voffB); PG8_STAGE(PG8_SA(0, 1), cA + hstep, voffA);
        if (wr == 1) PG8_BAR;
        PG8_WAIT_V(4); PG8_BAR;
        PG8_STAGE(PG8_SB(1, 0), cB + kstep, voffB); PG8_STAGE(PG8_SA(1, 0), cA + kstep, voffA); PG8_STAGE(PG8_SB(1, 1), cB + hstep + kstep, voffB);
        PG8_WAIT_V(6); PG8_BAR;
    }
    for (;;) {
        const bool has_next = S.next(ui + 1, nxt);
        const bool ho = S.half_only(cur);
        const char* nA = has_next ? (const char*)g.A + (size_t)nxt.pm * tstep : cA; const char* nB = has_next ? (const char*)g.Bt + (size_t)nxt.pn * tstep : cB;
        for (int t = 0; t < nt; t += 2) {
            const bool last = (t == nt - 2);
            const char* a1 = cA + (size_t)(t + 1) * kstep;
            const char* a2 = last ? nA : cA + (size_t)(t + 2) * kstep; const char* b2 = last ? nB : cB + (size_t)(t + 2) * kstep;
            const char* a3 = a2 + kstep; const char* b3 = b2 + kstep;
            if (last && has_next) S.a_ready(nxt);
            if constexpr (SP2) {
            PG8_LDB(B0, 0, 0); PG8_LDB(B1, 0, 1); PG8_SCHED; PG8_LDA(At, 0, 0); PG8_STAGE(PG8_SA(1, 1), a1 + hstep, voffA);
            PG8_WAIT_V(8); PG8_WAIT_L(0); PG8_BAR; PG8_MMA(0, 0, At, B0); PG8_MMA(0, 1, At, B1); PG8_BAR; PG8_SCHED;
            PG8_LDA(At, 0, 1); PG8_STAGE(PG8_SB(0, 0), b2, voffB); PG8_STAGE(PG8_SB(0, 1), b2 + hstep, voffB); PG8_STAGE(PG8_SA(0, 0), a2, voffA);
            PG8_WAIT_V(8); PG8_WAIT_L(0); PG8_BAR; if (!ho) { PG8_MMA(1, 0, At, B0); PG8_MMA(1, 1, At, B1); } PG8_BAR; PG8_SCHED;
            PG8_LDB(B0, 1, 0); PG8_LDB(B1, 1, 1); PG8_SCHED; PG8_LDA(At, 1, 0); PG8_STAGE(PG8_SA(0, 1), a2 + hstep, voffA);
            PG8_WAIT_V(8); PG8_WAIT_L(0); PG8_BAR; PG8_MMA(0, 0, At, B0); PG8_MMA(0, 1, At, B1); PG8_BAR; PG8_SCHED;
            PG8_LDA(At, 1, 1); PG8_STAGE(PG8_SB(1, 0), b3, voffB); PG8_STAGE(PG8_SB(1, 1), b3 + hstep, voffB); PG8_STAGE(PG8_SA(1, 0), a3, voffA);
            PG8_WAIT_V(8); PG8_WAIT_L(0); PG8_BAR; if (!ho) { PG8_MMA(1, 0, At, B0); PG8_MMA(1, 1, At, B1); } PG8_BAR; PG8_SCHED;
            } else {
            PG8_LDB(B0, 0, 0); PG8_SCHED; PG8_LDA(At, 0, 0); PG8_STAGE(PG8_SA(1, 1), a1 + hstep, voffA);
            PG8_WAIT_L(8); PG8_BAR; PG8_WAIT_L(0); PG8_MMA(0, 0, At, B0); PG8_BAR; PG8_SCHED;
            PG8_LDB(B1, 0, 1); PG8_STAGE(PG8_SB(0, 0), b2, voffB);
            PG8_BAR; PG8_WAIT_L(0); PG8_MMA(0, 1, At, B1); PG8_BAR;
            PG8_LDA(At, 0, 1); PG8_STAGE(PG8_SA(0, 0), a2, voffA);
            PG8_BAR; PG8_WAIT_L(0); PG8_MMA(1, 0, At, B0); PG8_BAR; PG8_SCHED;
            PG8_STAGE(PG8_SB(0, 1), b2 + hstep, voffB);
            PG8_WAIT_V(6); PG8_BAR; PG8_MMA(1, 1, At, B1); PG8_BAR;
            PG8_LDB(B0, 1, 0); PG8_SCHED; PG8_LDA(At, 1, 0); PG8_STAGE(PG8_SA(0, 1), a2 + hstep, voffA);
            PG8_WAIT_L(8); PG8_BAR; PG8_WAIT_L(0); PG8_MMA(0, 0, At, B0); PG8_BAR; PG8_SCHED;
            PG8_LDB(B1, 1, 1); PG8_STAGE(PG8_SB(1, 0), b3, voffB);
            PG8_BAR; PG8_WAIT_L(0); PG8_MMA(0, 1, At, B1); PG8_BAR;
            PG8_LDA(At, 1, 1); PG8_STAGE(PG8_SA(1, 0), a3, voffA);
            PG8_BAR; PG8_WAIT_L(0); PG8_MMA(1, 0, At, B0); PG8_BAR; PG8_SCHED;
            PG8_STAGE(PG8_SB(1, 1), b3 + hstep, voffB);
            PG8_WAIT_V(6); PG8_BAR; PG8_MMA(1, 1, At, B1); PG8_BAR;
            }
        }
        if constexpr (ALIGN_EPI) { if (wr == 0) PG8_BAR; }
        if constexpr (!Epi::AFTER_DRAIN) { E(acc, cur, wr, wc, fr, fq); S.done(cur); }
        if (!has_next) break;
#pragma unroll
        for (int a = 0; a < 2; ++a)
#pragma unroll
            for (int b = 0; b < 2; ++b)
#pragma unroll
                for (int m = 0; m < 4; ++m)
#pragma unroll
                    for (int n = 0; n < 2; ++n) acc[a][b][m][n] = (f32x4){0.f, 0.f, 0.f, 0.f};
        cur = nxt; cA = nA; cB = nB; ++ui;
        if constexpr (ALIGN_EPI) { if (wr == 1) PG8_BAR; }
    }
    PG8_WAIT_V(0);
    if constexpr (!ALIGN_EPI) { if (wr == 0) PG8_BAR; }
    PG8_BAR;
    if constexpr (Epi::AFTER_DRAIN) { E.fused(acc, cur, wr, wc, fr, fq, lds, wid, lane); S.done(cur); }
#undef PG8_SA
#undef PG8_SB
#undef PG8_STAGE
#undef PG8_LDA
#undef PG8_LDB
#undef PG8_MMA
#undef PG8_WAIT_V
#undef PG8_WAIT_L
#undef PG8_BAR
#undef PG8_SCHED
}
}
namespace pg8 {
template <class Epi, class Sched>
__device__ __forceinline__ void gemm_phase_ga(PG8_LAS unsigned char* lds, const Gemm g, const Sched& S, const Epi& E, const int* rowidx, int zrow, PG8_LAS int* islot) {
    constexpr bool ALIGN_EPI = true;
    int tid = threadIdx.x; asm volatile("" : "+v"(tid));
    const int wid = __builtin_amdgcn_readfirstlane(tid >> 6), lane = tid & 63, wr = wid >> 2, wc = wid & 3, fr = lane & 15, fq = lane >> 4;
    const int K = g.K, nt = K / BK;
    unsigned voffB[2]; int RA[2], CA[2];
#pragma unroll
    for (int i = 0; i < 2; ++i) { int R, C; stage_rc(tid * 16 + i * 8192, R, C); const int Rb = Epi::PERM ? ((R & ~31) + perm32(R & 31)) : R;
        RA[i] = R; CA[i] = C; voffB[i] = (unsigned)(Rb * K + C) * 2u; }
    unsigned voC[2][2], voN[2][2];
    const size_t kstep = (size_t)(BK * 2);
    const size_t hstep = (size_t)HALF * K * 2;
    const size_t tstep = 2 * hstep;
    const unsigned ldsw = (unsigned)wid * 1024u;
    const int aoff = lds_byte(wr * 64 + fr, fq * 8), boff = lds_byte(wc * 32 + fr, fq * 8);
#define PG8_SA(b, h) (((b) * 2 + (h)) * HTB)
#define PG8_SB(b, h) ((4 + (b) * 2 + (h)) * HTB)
#define PG8_STAGE(bufoff, gbase, voff) do { _Pragma("unroll") for (int _i = 0; _i < 2; ++_i) \
        __builtin_amdgcn_global_load_lds((const unsigned*)((const char*)(gbase) + (voff)[_i]), (PG8_LAS unsigned*)(lds + (bufoff) + ldsw + _i * 8192), 16, 0, 0); } while (0)
#define PG8_LDA(dst, b, h) do { _Pragma("unroll") for (int m = 0; m < 4; ++m) _Pragma("unroll") for (int k = 0; k < 2; ++k) dst[m][k] = *(const PG8_LAS bf16x8*)(lds + PG8_SA(b, h) + aoff + m * 2048 + k * 1024); } while (0)
#define PG8_LDB(dst, b, h) do { _Pragma("unroll") for (int n = 0; n < 2; ++n) _Pragma("unroll") for (int k = 0; k < 2; ++k) dst[n][k] = *(const PG8_LAS bf16x8*)(lds + PG8_SB(b, h) + boff + n * 2048 + k * 1024); } while (0)
#define PG8_MMA(ai, bj, At, Bt) do { __builtin_amdgcn_s_setprio(1); _Pragma("unroll") for (int m = 0; m < 4; ++m) _Pragma("unroll") for (int n = 0; n < 2; ++n) _Pragma("unroll") for (int k = 0; k < 2; ++k) \
        acc[ai][bj][m][n] = __builtin_amdgcn_mfma_f32_16x16x32_bf16(Bt[n][k], At[m][k], acc[ai][bj][m][n], 0, 0, 0); __builtin_amdgcn_s_setprio(0); } while (0)
#define PG8_WAIT_V(n) asm volatile("s_waitcnt vmcnt(" #n ")" ::: "memory")
#define PG8_WAIT_L(n) asm volatile("s_waitcnt lgkmcnt(" #n ")" ::: "memory")
#define PG8_BAR __builtin_amdgcn_s_barrier()
#define PG8_SCHED __builtin_amdgcn_sched_barrier(0)
    constexpr bool SP2 = true;
    Unit cur, nxt; int ui = 0;
    if (!S.next(0, cur)) return;
    f32x4 acc[2][2][4][2];
#pragma unroll
    for (int a = 0; a < 2; ++a)
#pragma unroll
        for (int b = 0; b < 2; ++b)
#pragma unroll
            for (int m = 0; m < 4; ++m)
#pragma unroll
                for (int n = 0; n < 2; ++n) acc[a][b][m][n] = (f32x4){0.f, 0.f, 0.f, 0.f};
    bf16x8 At[4][2], B0[2][2], B1[2][2];
    const char* const Ab = (const char*)g.A; const char* cB = (const char*)g.Bt + (size_t)cur.pn * tstep;
    S.a_ready(cur);
#pragma unroll
    for (int h = 0; h < 2; ++h)
#pragma unroll
        for (int i = 0; i < 2; ++i) { const int s = rowidx[cur.pm * BM + h * HALF + RA[i]]; voC[h][i] = (unsigned)((s < 0 ? zrow : s) * K + CA[i]) * 2u; voN[h][i] = voC[h][i]; }
    asm volatile("s_waitcnt vmcnt(0)" ::: "memory");
    if constexpr (SP2) {
        PG8_STAGE(PG8_SB(0, 0), cB, voffB); PG8_STAGE(PG8_SB(0, 1), cB + hstep, voffB); PG8_STAGE(PG8_SA(0, 0), Ab, voC[0]); PG8_STAGE(PG8_SA(0, 1), Ab, voC[1]);
        if (wr == 1) PG8_BAR;
        PG8_WAIT_V(2); PG8_BAR;
        PG8_STAGE(PG8_SB(1, 0), cB + kstep, voffB); PG8_STAGE(PG8_SA(1, 0), Ab + kstep, voC[0]); PG8_STAGE(PG8_SB(1, 1), cB + hstep + kstep, voffB);
        PG8_WAIT_V(6); PG8_BAR;
    }
    for (;;) {
        const bool has_next = S.next(ui + 1, nxt);
        const bool ho = S.half_only(cur);
        const char* nB = has_next ? (const char*)g.Bt + (size_t)nxt.pn * tstep : cB;
        if (has_next && wid == 0) __builtin_amdgcn_global_load_lds((const unsigned*)(rowidx + nxt.pm * BM + lane * 4), (PG8_LAS unsigned*)(islot + ((ui + 1) & 1) * BM), 16, 0, 0);
        for (int t = 0; t < nt; t += 2) {
            const bool last = (t == nt - 2);
            const char* a1 = Ab + (size_t)(t + 1) * kstep;
            const char* a2 = last ? Ab : Ab + (size_t)(t + 2) * kstep; const char* b2 = last ? nB : cB + (size_t)(t + 2) * kstep;
            const char* a3 = a2 + kstep; const char* b3 = b2 + kstep;
            if (last && has_next) { S.a_ready(nxt);
                const PG8_LAS int* sl = islot + ((ui + 1) & 1) * BM;
#pragma unroll
                for (int h = 0; h < 2; ++h)
#pragma unroll
                    for (int i = 0; i < 2; ++i) { const int s = sl[h * HALF + RA[i]]; voN[h][i] = (unsigned)((s < 0 ? zrow : s) * K + CA[i]) * 2u; } }
            unsigned vo2[2][2];
#pragma unroll
            for (int h = 0; h < 2; ++h)
#pragma unroll
                for (int i = 0; i < 2; ++i) vo2[h][i] = last ? voN[h][i] : voC[h][i];
            if constexpr (SP2) {
            PG8_LDB(B0, 0, 0); PG8_LDB(B1, 0, 1); PG8_SCHED; PG8_LDA(At, 0, 0); PG8_STAGE(PG8_SA(1, 1), a1, voC[1]);
            PG8_WAIT_V(8); PG8_WAIT_L(0); PG8_BAR; PG8_MMA(0, 0, At, B0); PG8_MMA(0, 1, At, B1); PG8_BAR; PG8_SCHED;
            PG8_LDA(At, 0, 1); PG8_STAGE(PG8_SB(0, 0), b2, voffB); PG8_STAGE(PG8_SB(0, 1), b2 + hstep, voffB); PG8_STAGE(PG8_SA(0, 0), a2, vo2[0]);
            PG8_WAIT_V(8); PG8_WAIT_L(0); PG8_BAR; if (!ho) { PG8_MMA(1, 0, At, B0); PG8_MMA(1, 1, At, B1); } PG8_BAR; PG8_SCHED;
            PG8_LDB(B0, 1, 0); PG8_LDB(B1, 1, 1); PG8_SCHED; PG8_LDA(At, 1, 0); PG8_STAGE(PG8_SA(0, 1), a2, vo2[1]);
            PG8_WAIT_V(8); PG8_WAIT_L(0); PG8_BAR; PG8_MMA(0, 0, At, B0); PG8_MMA(0, 1, At, B1); PG8_BAR; PG8_SCHED;
            PG8_LDA(At, 1, 1); PG8_STAGE(PG8_SB(1, 0), b3, voffB); PG8_STAGE(PG8_SB(1, 1), b3 + hstep, voffB); PG8_STAGE(PG8_SA(1, 0), a3, vo2[0]);
            PG8_WAIT_V(8); PG8_WAIT_L(0); PG8_BAR; if (!ho) { PG8_MMA(1, 0, At, B0); PG8_MMA(1, 1, At, B1); } PG8_BAR; PG8_SCHED;
            }
        }
        if constexpr (ALIGN_EPI) { if (wr == 0) PG8_BAR; }
        if constexpr (!Epi::AFTER_DRAIN) { E(acc, cur, wr, wc, fr, fq); S.done(cur); }
        if (!has_next) break;
#pragma unroll
        for (int a = 0; a < 2; ++a)
#pragma unroll
            for (int b = 0; b < 2; ++b)
#pragma unroll
                for (int m = 0; m < 4; ++m)
#pragma unroll
                    for (int n = 0; n < 2; ++n) acc[a][b][m][n] = (f32x4){0.f, 0.f, 0.f, 0.f};
        cur = nxt; cB = nB; ++ui;
#pragma unroll
        for (int h = 0; h < 2; ++h)
#pragma unroll
            for (int i = 0; i < 2; ++i) voC[h][i] = voN[h][i];
        if constexpr (ALIGN_EPI) { if (wr == 1) PG8_BAR; }
    }
    PG8_WAIT_V(0);
    if constexpr (!ALIGN_EPI) { if (wr == 0) PG8_BAR; }
    PG8_BAR;
    if constexpr (Epi::AFTER_DRAIN) { E.fused(acc, cur, wr, wc, fr, fq, lds, wid, lane); S.done(cur); }
#undef PG8_SA
#undef PG8_SB
#undef PG8_STAGE
#undef PG8_LDA
#undef PG8_LDB
#undef PG8_MMA
#undef PG8_WAIT_V
#undef PG8_WAIT_L
#undef PG8_BAR
#undef PG8_SCHED
}
}

constexpr int DM = 1024, NB = 2, SEQ = 8192, CTXL = 256, DEPTH = 4;
constexpr int NLAT = NB * SEQ, NCTX = NB * CTXL, NROW = NLAT + NCTX;
constexpr int INC = 3328, NKEY = CTXL + SEQ;
constexpr int NE = 16, FF = 2048, EROWS = 2304;
constexpr int NCH = 66;
constexpr float EPS = 1e-6f;
constexpr int ZQ = 0, ZK = 512, ZV = 1024, ZRQ = 1536, ZRK = 1792, ZRV = 2048, ZGF = 2304, ZGB = 2560, ZSU = 2816, ZSV = 3072;
constexpr int NWAVES = 8, NTHR = 512;
constexpr int RWLD = DM + 8;

constexpr size_t MiB = 1u << 20;
constexpr size_t WS_CTL = 0, CTL_ZERO_BYTES = 1 * MiB;
constexpr size_t WS_MOD = 1 * MiB;
constexpr size_t WS_LP = WS_MOD + 512 * 1024;
constexpr size_t WS_ROPE = 2 * MiB, WS_RETT = 4 * MiB;
constexpr size_t WS_SGW = 6 * MiB;
constexpr size_t WS_RWS = 7 * MiB;
constexpr size_t WS_WIN = 8 * MiB;
constexpr size_t WS_WOUT = WS_WIN + 26 * MiB;
constexpr size_t WS_WGU = WS_WOUT + 8 * MiB;
constexpr size_t WS_WD = WS_WGU + 512 * MiB;
constexpr size_t WS_X = WS_WD + 256 * MiB;
constexpr size_t WS_HN = WS_X + 66 * MiB;
constexpr size_t WS_Z = WS_HN + 34 * MiB;
constexpr size_t WS_QH = WS_Z + 108 * MiB;
constexpr size_t WS_KH = WS_QH + 17 * MiB;
constexpr size_t WS_VH = WS_KH + 17 * MiB;
constexpr size_t WS_RQ = WS_VH + 17 * MiB;
constexpr size_t WS_RK = WS_RQ + 9 * MiB;
constexpr size_t WS_SVN = WS_RK + 9 * MiB;
constexpr size_t WS_KVT = WS_SVN + 9 * MiB;
constexpr size_t WS_SPREV = WS_KVT + 17 * MiB;
constexpr size_t WS_MIX = WS_SPREV + 17 * MiB;
constexpr size_t WS_SCR = WS_MIX + 33 * MiB;
constexpr size_t WS_AFF = WS_SCR + 32 * MiB;
constexpr size_t WS_SLOT = WS_AFF + 2 * MiB;
constexpr size_t WS_ROWIDX = WS_SLOT + 2 * MiB;
constexpr size_t WS_GATE = WS_ROWIDX + 1 * MiB;
constexpr size_t WS_XS = WS_GATE + 1 * MiB;
constexpr size_t WS_HH = WS_XS + 72 * MiB;
constexpr size_t WS_Y = WS_HH + 144 * MiB;
constexpr size_t WS_END = WS_Y + 72 * MiB;
static_assert((size_t)4 * INC * DM * 2 <= 26 * MiB && (size_t)NROW * DM * 4 <= 66 * MiB && (size_t)NROW * INC * 2 <= 108 * MiB && (size_t)NROW * 512 * 2 <= 17 * MiB, "ws map");
static_assert((size_t)NB * 4 * 2 * NCH * 4096 * 4 <= 17 * MiB && (size_t)NE * EROWS * DM * 2 <= 72 * MiB && (size_t)NE * EROWS * FF * 2 <= 144 * MiB, "ws map");
constexpr int CW_BAR = 4096;

constexpr int RING_BYTES = 131072;
constexpr int MISC_OFF = RING_BYTES + 320;
constexpr int ISLOT_OFF = RING_BYTES + 1024;
constexpr int LDS_BYTES = 147456;

#define GAS __attribute__((address_space(1)))
#define LAS __attribute__((address_space(3)))
typedef unsigned short bf16;
typedef unsigned v4u __attribute__((ext_vector_type(4)));
typedef float f32x4 __attribute__((ext_vector_type(4)));
typedef short bf16x8 __attribute__((ext_vector_type(8)));
typedef GAS unsigned gu32;
typedef GAS unsigned long long gu64;
#define RLX_AGENT __ATOMIC_RELAXED, __HIP_MEMORY_SCOPE_AGENT
#define LDS_WAIT() asm volatile("s_waitcnt lgkmcnt(0)" ::: "memory")
#define VM_WAIT() asm volatile("s_waitcnt vmcnt(0)" ::: "memory")
__device__ __forceinline__ unsigned long long rt() { return __builtin_amdgcn_s_memrealtime(); }
__device__ __forceinline__ unsigned f2bf(float f) { unsigned u = __builtin_bit_cast(unsigned, f); return (u + 0x7fffu + ((u >> 16) & 1u)) >> 16; }
__device__ __forceinline__ unsigned pk2(float lo, float hi) { return f2bf(lo) | (f2bf(hi) << 16); }

#define XB_TMO      128
#define XB_XCNT(j)  (256  + 64 * (j))
#define XB_XSUB(j)  (1280 + 64 * (j))
#define XB_XGEN(j)  (2304 + 64 * (j))
#define XB_TOP      3328
#define XB_TOPGEN   3392
#define XCD_BAR_WORDS 3456
#define XB_SPIN_CAP (1u << 18)

__device__ __forceinline__ unsigned xb_ld(unsigned* p)              { return __hip_atomic_load(p, __ATOMIC_RELAXED, __HIP_MEMORY_SCOPE_AGENT); }
__device__ __forceinline__ unsigned xb_add(unsigned* p, unsigned v) { return __hip_atomic_fetch_add(p, v, __ATOMIC_RELAXED, __HIP_MEMORY_SCOPE_AGENT); }
__device__ __forceinline__ unsigned xb_xcc_id() { return (unsigned)__builtin_amdgcn_s_getreg((3 << 11) | 20) & 0xFu; }
#define XB_SPIN(cond, bar) do { unsigned _sp = 0; while (cond) { __builtin_amdgcn_s_sleep(1); \
    if ((++_sp & 255u) == 0u) { if (xb_ld(&(bar)[XB_TMO])) break; if (_sp > XB_SPIN_CAP) { atomicAdd(&(bar)[XB_TMO], 1u); break; } } } } while (0)

struct XcdBarrier {
    unsigned* bar; unsigned x;
    volatile LAS unsigned* st;
};

__device__ __forceinline__ XcdBarrier xcd_barrier_post(unsigned* bar, volatile LAS unsigned* st) {
    XcdBarrier b; b.bar = bar; b.x = xb_xcc_id(); b.st = st;
    if (threadIdx.x == 0) (void)xb_add(&bar[XB_XCNT(b.x)], 1u);
    return b;
}
__device__ __forceinline__ void xcd_barrier_complete(unsigned* bar, unsigned x, unsigned& nloc, unsigned& nx) {
    const unsigned G = gridDim.x * gridDim.y * gridDim.z;
    unsigned sum, cnt, mine, sp = 0u;
    for (;;) {
        sum = 0u; cnt = 0u; mine = 0u;
#pragma unroll
        for (unsigned j = 0; j < 16; ++j) { const unsigned c = xb_ld(&bar[XB_XCNT(j)]); sum += c; cnt += (c > 0u) ? 1u : 0u; mine = (j == x) ? c : mine; }
        if (sum == G) break;
        __builtin_amdgcn_s_sleep(1);
        if ((++sp & 255u) == 0u) { if (xb_ld(&bar[XB_TMO])) break; if (sp > XB_SPIN_CAP) { atomicAdd(&bar[XB_TMO], 1u); break; } }
    }
    nloc = mine > 0u ? mine : 1u; nx = cnt > 0u ? cnt : 1u;
}

__device__ __forceinline__ void xcd_barrier(const XcdBarrier& b) {
    asm volatile("s_waitcnt vmcnt(0)" ::: "memory");
    __syncthreads();
    if (threadIdx.x == 0) {
        unsigned* bar = b.bar;
        __builtin_amdgcn_s_waitcnt(0);
        unsigned nloc = b.st[0], nx = b.st[1];
        if (nloc == 0u) { xcd_barrier_complete(bar, b.x, nloc, nx); b.st[0] = nloc; b.st[1] = nx; }
        const unsigned old = xb_add(&bar[XB_XSUB(b.x)], 1u);
        const unsigned gen = old / nloc;
        if (old + 1u == (gen + 1u) * nloc) {
            __builtin_amdgcn_fence(__ATOMIC_RELEASE, "agent");
            asm volatile("s_waitcnt vmcnt(0)" ::: "memory");
            const unsigned og = xb_add(&bar[XB_TOP], 1u);
            const unsigned tg = og / nx;
            if (og + 1u == (tg + 1u) * nx) xb_add(&bar[XB_TOPGEN], 1u);
            else XB_SPIN(xb_ld(&bar[XB_TOPGEN]) == tg, bar);
            __builtin_amdgcn_fence(__ATOMIC_ACQUIRE, "agent");
            xb_add(&bar[XB_XGEN(b.x)], 1u);
            asm volatile("s_waitcnt vmcnt(0)" ::: "memory");
        } else {
            XB_SPIN(xb_ld(&bar[XB_XGEN(b.x)]) == gen, bar);
            __builtin_amdgcn_fence(__ATOMIC_ACQUIRE, "agent");
            asm volatile("s_waitcnt vmcnt(0)" ::: "memory");
        }
    }
    __syncthreads();
}

typedef float f32x16 __attribute__((ext_vector_type(16)));
typedef short s16x4 __attribute__((ext_vector_type(4)));
typedef unsigned short u16x4 __attribute__((ext_vector_type(4)));
struct Frame {
    LAS unsigned char* lds;
    int tid, lane, wave, bid, G;
    const float* const* in;
    float* out;
    unsigned char* ws;
    __device__ __forceinline__ const float* x_in() const { return in[0]; }
    __device__ __forceinline__ const float* c_in() const { return in[1]; }
    __device__ __forceinline__ const float* ctx_in() const { return in[2]; }
    __device__ __forceinline__ const float* cctx_in() const { return in[3]; }
    __device__ __forceinline__ const float* w_mod() const { return in[4]; }
    __device__ __forceinline__ const float* b_mod() const { return in[5]; }
    __device__ __forceinline__ const float* n1g() const { return in[6]; }
    __device__ __forceinline__ const float* n2g() const { return in[7]; }
    __device__ __forceinline__ const float* w_in() const { return in[8]; }
    __device__ __forceinline__ const float* w_out() const { return in[9]; }
    __device__ __forceinline__ const float* qng() const { return in[10]; }
    __device__ __forceinline__ const float* kng() const { return in[11]; }
    __device__ __forceinline__ const float* lq1() const { return in[12]; }
    __device__ __forceinline__ const float* lk1() const { return in[13]; }
    __device__ __forceinline__ const float* lq2() const { return in[14]; }
    __device__ __forceinline__ const float* lk2() const { return in[15]; }
    __device__ __forceinline__ const float* subg() const { return in[16]; }
    __device__ __forceinline__ const float* retd() const { return in[17]; }
    __device__ __forceinline__ const float* sgng() const { return in[18]; }
    __device__ __forceinline__ const float* sgw() const { return in[19]; }
    __device__ __forceinline__ const float* sgb() const { return in[20]; }
    __device__ __forceinline__ const float* rw() const { return in[21]; }
    __device__ __forceinline__ const float* wg() const { return in[22]; }
    __device__ __forceinline__ const float* wu() const { return in[23]; }
    __device__ __forceinline__ const float* wd() const { return in[24]; }
    __device__ __forceinline__ float* MOD() const { return (float*)(ws + WS_MOD); }
    __device__ __forceinline__ float* LP() const { return (float*)(ws + WS_LP); }
    __device__ __forceinline__ float* ROPE() const { return (float*)(ws + WS_ROPE); }
    __device__ __forceinline__ float* RETT() const { return (float*)(ws + WS_RETT); }
    __device__ __forceinline__ bf16* X() const { return (bf16*)(ws + WS_X); }
    __device__ __forceinline__ float* KVT() const { return (float*)(ws + WS_KVT); }
    __device__ __forceinline__ bf16* SPREV() const { return (bf16*)(ws + WS_SPREV); }
    __device__ __forceinline__ float* SCR() const { return (float*)(ws + WS_SCR); }
    __device__ __forceinline__ float* AFF() const { return (float*)(ws + WS_AFF); }
    __device__ __forceinline__ float* GATE() const { return (float*)(ws + WS_GATE); }
    __device__ __forceinline__ bf16* SGW() const { return (bf16*)(ws + WS_SGW); }
    __device__ __forceinline__ bf16* WIN() const { return (bf16*)(ws + WS_WIN); }
    __device__ __forceinline__ bf16* WOUT() const { return (bf16*)(ws + WS_WOUT); }
    __device__ __forceinline__ bf16* WGU() const { return (bf16*)(ws + WS_WGU); }
    __device__ __forceinline__ bf16* WD() const { return (bf16*)(ws + WS_WD); }
    __device__ __forceinline__ bf16* HN() const { return (bf16*)(ws + WS_HN); }
    __device__ __forceinline__ bf16* Z() const { return (bf16*)(ws + WS_Z); }
    __device__ __forceinline__ bf16* QH() const { return (bf16*)(ws + WS_QH); }
    __device__ __forceinline__ bf16* KH() const { return (bf16*)(ws + WS_KH); }
    __device__ __forceinline__ bf16* VH() const { return (bf16*)(ws + WS_VH); }
    __device__ __forceinline__ bf16* RQ() const { return (bf16*)(ws + WS_RQ); }
    __device__ __forceinline__ bf16* RK() const { return (bf16*)(ws + WS_RK); }
    __device__ __forceinline__ bf16* SVN() const { return (bf16*)(ws + WS_SVN); }
    __device__ __forceinline__ bf16* MIX() const { return (bf16*)(ws + WS_MIX); }
    __device__ __forceinline__ bf16* XS() const { return (bf16*)(ws + WS_XS); }
    __device__ __forceinline__ bf16* HH() const { return (bf16*)(ws + WS_HH); }
    __device__ __forceinline__ bf16* Y() const { return (bf16*)(ws + WS_Y); }
    __device__ __forceinline__ bf16* RWS() const { return (bf16*)(ws + WS_RWS); }
    __device__ __forceinline__ int* SLOT() const { return (int*)(ws + WS_SLOT); }
    __device__ __forceinline__ int* ROWIDX() const { return (int*)(ws + WS_ROWIDX); }
};
__device__ __forceinline__ float bf2f(bf16 v) { return __builtin_bit_cast(float, (unsigned)v << 16); }
__device__ __forceinline__ float wave_sum(float v) {
#pragma unroll
    for (int o = 1; o < 64; o <<= 1) v += __shfl_xor(v, o);
    return v;
}
__device__ __forceinline__ float half_sum32(float v) {
#pragma unroll
    for (int o = 1; o < 32; o <<= 1) v += __shfl_xor(v, o);
    return v;
}
__device__ __forceinline__ float wave_max(float v) {
#pragma unroll
    for (int o = 1; o < 64; o <<= 1) v = fmaxf(v, __shfl_xor(v, o));
    return v;
}
__device__ __forceinline__ int crow(int r, int hi) { return (r & 3) + 8 * (r >> 2) + 4 * hi; }
__device__ __forceinline__ float gelu_t(float x) {
    const float u = 0.7978845608028654f * (x + 0.044715f * x * x * x);
    const float t = 1.f - 2.f * __builtin_amdgcn_rcpf(1.f + __expf(2.f * u));
    return 0.5f * x * (1.f + t);
}
__device__ __forceinline__ float silu_f(float x) { return x * __builtin_amdgcn_rcpf(1.f + __expf(-x)); }
__device__ __forceinline__ int row_vec(int r) { return r < SEQ ? 0 : (r < NLAT ? 1 : 2); }
__device__ __forceinline__ int chunk_row0(int b, int cc) { return cc < 2 ? NLAT + b * CTXL + cc * 128 : b * SEQ + (cc - 2) * 128; }

__device__ __forceinline__ f32x16 mma_nt(const LAS bf16* A, int lda, const LAS bf16* B, int ldb, int K, f32x16 acc, int lane) {
    const int r = lane & 31, h = lane >> 5;
#pragma unroll 2
    for (int k0 = 0; k0 < K; k0 += 16) {
        const bf16x8 a = *(const LAS bf16x8*)(A + r * lda + k0 + 8 * h);
        const bf16x8 b = *(const LAS bf16x8*)(B + r * ldb + k0 + 8 * h);
        acc = __builtin_amdgcn_mfma_f32_32x32x16_bf16(a, b, acc, 0, 0, 0);
    }
    return acc;
}

constexpr float QSCALE = 0.125f * 1.4426950408889634f;
struct EpiResid {
    static constexpr bool PERM = true, AFTER_DRAIN = false;
    bf16* X; const float* modg;
    const float* Xin;
    __device__ __forceinline__ void operator()(const pg8::f32x4 (&acc)[2][2][4][2], const pg8::Unit& u, int wr, int wc, int fr, int fq) const {
        const int row0 = u.pm * 256 + wr * 64 + fr, col0 = u.pn * 256 + wc * 32 + 8 * fq;
        const int v = u.pm < 32 ? 0 : (u.pm < 64 ? 1 : 2);
        pg8::f32x4 gv[2][2];
#pragma unroll
        for (int bj = 0; bj < 2; ++bj)
#pragma unroll
            for (int n = 0; n < 2; ++n) gv[bj][n] = *(const pg8::f32x4*)(modg + v * 6144 + col0 + bj * 128 + 4 * n);
        const bool in32 = Xin != nullptr;
#pragma unroll
        for (int ai = 0; ai < 2; ++ai)
#pragma unroll
            for (int m = 0; m < 4; ++m) { const size_t off = (size_t)(row0 + ai * 128 + m * 16) * DM + col0;
#pragma unroll
                for (int bj = 0; bj < 2; ++bj) {
                    pg8::f32x4 x0, x1;
                    if (in32) { x0 = *(const pg8::f32x4*)(Xin + off + bj * 128); x1 = *(const pg8::f32x4*)(Xin + off + bj * 128 + 4); }
                    else { const pg8::u32x4 w = *(const pg8::u32x4*)(X + off + bj * 128);
                        x0 = (pg8::f32x4){__builtin_bit_cast(float, w.x << 16), __builtin_bit_cast(float, w.x & 0xffff0000u), __builtin_bit_cast(float, w.y << 16), __builtin_bit_cast(float, w.y & 0xffff0000u)};
                        x1 = (pg8::f32x4){__builtin_bit_cast(float, w.z << 16), __builtin_bit_cast(float, w.z & 0xffff0000u), __builtin_bit_cast(float, w.w << 16), __builtin_bit_cast(float, w.w & 0xffff0000u)}; }
                    x0 = x0 + gv[bj][0] * acc[ai][bj][m][0]; x1 = x1 + gv[bj][1] * acc[ai][bj][m][1];
                    pg8::u32x4 o; o.x = pg8::cvt_pk_bf16(x0.x, x0.y); o.y = pg8::cvt_pk_bf16(x0.z, x0.w); o.z = pg8::cvt_pk_bf16(x1.x, x1.y); o.w = pg8::cvt_pk_bf16(x1.z, x1.w);
                    *(pg8::u32x4*)(X + off + bj * 128) = o; } }
    }
};
struct EpiZ {
    static constexpr bool PERM = true, AFTER_DRAIN = false;
    bf16* Z; bf16* VH; bf16* QH; bf16* KH; const float* gqk; const float* rope;
    __device__ __forceinline__ void operator()(const pg8::f32x4 (&acc)[2][2][4][2], const pg8::Unit& u, int wr, int wc, int fr, int fq) const {
        if (u.pn < 4) {
            const bool isk = u.pn >= 2; const int grp = (u.pn & 1) * 4 + wc;
            const float* g = gqk + (isk ? 64 : 0); const float sc = isk ? 1.f : QSCALE;
            float ga[2][8];
#pragma unroll
            for (int bj = 0; bj < 2; ++bj)
#pragma unroll
                for (int e = 0; e < 8; ++e) ga[bj][e] = g[32 * bj + 8 * fq + e] * sc;
            const bool first = fq < 2; const int i16 = 8 * (fq & 1);
            const bool lat = u.pm < 64;
#pragma unroll
            for (int ai = 0; ai < 2; ++ai) {
                float rc[8], rn[8];
                if (lat) { const float* T = rope + (size_t)(((u.pm * 256 + ai * 128 + wr * 64) & (SEQ - 1)) & ~63) * 64 + i16;
                    const pg8::f32x4 c0 = *(const pg8::f32x4*)T, c1 = *(const pg8::f32x4*)(T + 4), s0 = *(const pg8::f32x4*)(T + 32), s1 = *(const pg8::f32x4*)(T + 36);
#pragma unroll
                    for (int e = 0; e < 4; ++e) { rc[e] = c0[e]; rc[4 + e] = c1[e]; rn[e] = s0[e]; rn[4 + e] = s1[e]; } }
#pragma unroll
                for (int m = 0; m < 4; ++m) {
                    float ccm[8], cnm[8];
                    if (lat) { const float* T = rope + (size_t)(m * 16 + fr) * 64 + 16 + i16;
                        const pg8::f32x4 c0 = *(const pg8::f32x4*)T, c1 = *(const pg8::f32x4*)(T + 4), s0 = *(const pg8::f32x4*)(T + 32), s1 = *(const pg8::f32x4*)(T + 36);
#pragma unroll
                        for (int e = 0; e < 4; ++e) { ccm[e] = c0[e]; ccm[4 + e] = c1[e]; cnm[e] = s0[e]; cnm[4 + e] = s1[e]; } }
                    const int r = u.pm * 256 + ai * 128 + wr * 64 + m * 16 + fr;
                    const int b = lat ? (r >> 13) : ((r - NLAT) >> 8), n = lat ? (r & (SEQ - 1)) : ((r - NLAT) & (CTXL - 1));
                    float v[2][8]; float ss = 0.f;
#pragma unroll
                    for (int bj = 0; bj < 2; ++bj)
#pragma unroll
                        for (int e = 0; e < 8; ++e) { v[bj][e] = acc[ai][bj][m][e >> 2][e & 3]; ss += v[bj][e] * v[bj][e]; }
                    ss += __shfl_xor(ss, 16);
                    { const auto sw = __builtin_amdgcn_permlane32_swap(__float_as_uint(ss), __float_as_uint(ss), false, false); ss = __uint_as_float(sw[0]) + __uint_as_float(sw[1]); }
                    const float rinv = __builtin_amdgcn_rsqf(ss * (1.f / 64.f) + EPS);
                    bf16* dst = (isk ? KH + ((size_t)b * NKEY + (lat ? CTXL + n : n)) * 512 : QH + (size_t)r * 512) + grp * 64 + 8 * fq;
#pragma unroll
                    for (int bj = 0; bj < 2; ++bj) {
                        float y[8], o[8];
#pragma unroll
                        for (int e = 0; e < 8; ++e) y[e] = v[bj][e] * rinv * ga[bj][e];
                        if (lat) {
#pragma unroll
                            for (int e = 0; e < 8; ++e) { const auto sw = __builtin_amdgcn_permlane32_swap(__float_as_uint(y[e]), __float_as_uint(y[e]), false, false);
                                const float pp = __uint_as_float(first ? sw[1] : sw[0]); const float c = bj ? ccm[e] : rc[e], s = bj ? cnm[e] : rn[e];
                                o[e] = first ? y[e] * c - pp * s : pp * s + y[e] * c; }
                        } else {
#pragma unroll
                            for (int e = 0; e < 8; ++e) o[e] = y[e];
                        }
                        pg8::u32x4 w; w.x = pg8::cvt_pk_bf16(o[0], o[1]); w.y = pg8::cvt_pk_bf16(o[2], o[3]); w.z = pg8::cvt_pk_bf16(o[4], o[5]); w.w = pg8::cvt_pk_bf16(o[6], o[7]);
                        *(pg8::u32x4*)(dst + 32 * bj) = w;
                    }
                }
            }
            return;
        }
        const bool isv = (u.pn == 4) | (u.pn == 5);
        const size_t prow0 = isv ? (u.pm < 64 ? (size_t)u.pm * 256 + (size_t)((u.pm >> 5) + 1) * CTXL : (size_t)(u.pm - 64) * NKEY) : (size_t)u.pm * 256;
        bf16* base = isv ? VH + (u.pn - 4) * 256 : Z + u.pn * 256; const int ldc = isv ? 512 : INC;
        const int col0 = wc * 32 + 8 * fq;
#pragma unroll
        for (int ai = 0; ai < 2; ++ai)
#pragma unroll
            for (int m = 0; m < 4; ++m) { bf16* rowp = base + (prow0 + wr * 64 + fr + ai * 128 + m * 16) * ldc + col0;
#pragma unroll
                for (int bj = 0; bj < 2; ++bj) { const pg8::f32x4 v0 = acc[ai][bj][m][0], v1 = acc[ai][bj][m][1];
                    pg8::u32x4 w; w.x = pg8::cvt_pk_bf16(v0[0], v0[1]); w.y = pg8::cvt_pk_bf16(v0[2], v0[3]); w.z = pg8::cvt_pk_bf16(v1[0], v1[1]); w.w = pg8::cvt_pk_bf16(v1[2], v1[3]);
                    *(pg8::u32x4*)(rowp + bj * 128) = w; } }
    }
};
struct EpiSwiglu {
    static constexpr bool PERM = true, AFTER_DRAIN = false;
    bf16* H;
    __device__ __forceinline__ void operator()(const pg8::f32x4 (&acc)[2][2][4][2], const pg8::Unit& u, int wr, int wc, int fr, int fq) const {
        const int row0 = u.pm * 256 + wr * 64 + fr, col0 = (u.pn & 15) * 128 + wc * 32 + 8 * fq;
#pragma unroll
        for (int ai = 0; ai < 2; ++ai)
#pragma unroll
            for (int m = 0; m < 4; ++m) { bf16* rowp = H + (size_t)(row0 + ai * 128 + m * 16) * FF + col0;
                float h[8];
#pragma unroll
                for (int n = 0; n < 2; ++n)
#pragma unroll
                    for (int i = 0; i < 4; ++i) { const float g = acc[ai][0][m][n][i], up = acc[ai][1][m][n][i]; h[4 * n + i] = silu_f(g) * up; }
                pg8::u32x4 w; w.x = pg8::cvt_pk_bf16(h[0], h[1]); w.y = pg8::cvt_pk_bf16(h[2], h[3]); w.z = pg8::cvt_pk_bf16(h[4], h[5]); w.w = pg8::cvt_pk_bf16(h[6], h[7]);
                *(pg8::u32x4*)rowp = w; }
    }
};
struct MoeOrder {
    int G, c, npn, npm, total;
    __device__ __forceinline__ bool next(int i, pg8::Unit& u) const {
        const int per = npm * npn;
        if ((G & 7) == 0) {
            const int W = G >> 3, x = c & 7, r = c >> 3, q = i * W + r;
            if (q >= 2 * per) return false;
            const int e = 2 * x + q / per, rem = q % per, pn = rem / npm, pm = rem % npm;
            u.pm = e * 9 + pm; u.pn = e * npn + pn; return true;
        }
        const long L = (long)i * G + c; if (L >= total) return false;
        const int e = (int)L / per, rem = (int)L % per; const int pn = rem / npm, pm = rem % npm;
        u.pm = e * 9 + pm; u.pn = e * npn + pn; return true;
    }
    __device__ __forceinline__ void a_ready(const pg8::Unit&) const {}
    __device__ __forceinline__ void done(const pg8::Unit&) const {}
    __device__ __forceinline__ bool half_only(const pg8::Unit& u) const { return (u.pm % 9) == 8; }
};

__device__ __forceinline__ void transpose_item(const float* W, int N, bf16* WT, int K, int k0, int n0, size_t drow0, LAS float* scr, int lane) {
    f32x4 v[8];
#pragma unroll
    for (int i = 0; i < 8; ++i) v[i] = __builtin_nontemporal_load((const f32x4*)(W + (size_t)(k0 + 8 * i + (lane >> 3)) * N + n0 + 4 * (lane & 7)));
#pragma unroll
    for (int i = 0; i < 8; ++i) { LAS float* d = scr + (8 * i + (lane >> 3)) * 33 + 4 * (lane & 7); d[0] = v[i].x; d[1] = v[i].y; d[2] = v[i].z; d[3] = v[i].w; }
    LDS_WAIT(); asm volatile("" ::: "memory");
    const int c = lane & 7;
#pragma unroll
    for (int j = 0; j < 4; ++j) { const int n = (lane >> 3) + 8 * j; const LAS float* s = scr + (8 * c) * 33 + n;
        v4u o; o.x = pk2(s[0 * 33], s[1 * 33]); o.y = pk2(s[2 * 33], s[3 * 33]); o.z = pk2(s[4 * 33], s[5 * 33]); o.w = pk2(s[6 * 33], s[7 * 33]);
        *(GAS v4u*)(WT + (drow0 + n) * K + k0 + 8 * c) = o; }
    LDS_WAIT(); asm volatile("" ::: "memory");
}
constexpr unsigned CV_IN = 16 * 104, CV_OUT = 16 * 32, CV_EX = 1024;
constexpr unsigned CONV_SEG0 = DEPTH * (CV_IN + CV_OUT), CONV_PER_L = 3 * NE * CV_EX, CONV_TOTAL = CONV_SEG0 + DEPTH * CONV_PER_L;
constexpr int CW_Q = 64;
static_assert(CONV_TOTAL % 64 == 0, "whole batches");
__device__ __forceinline__ void conv_item(const Frame& F, unsigned it, LAS float* scr, int lane) {
    if (it < DEPTH * CV_IN) { const int L = it / CV_IN, q = it % CV_IN, kb = q / 104, nb = q % 104, n0 = nb * 32;
        const size_t drow0 = n0 < 1024 ? (size_t)(n0 & ~255) + 128 * ((n0 & 63) >> 5) + 32 * ((n0 & 255) >> 6) : (size_t)n0;
        transpose_item(F.w_in() + (size_t)L * DM * INC, INC, F.WIN() + (size_t)L * INC * DM, DM, kb * 64, n0, drow0, scr, lane); return; }
    it -= DEPTH * CV_IN;
    if (it < DEPTH * CV_OUT) { const int L = it / CV_OUT, q = it % CV_OUT, kb = q / 32, nb = q % 32;
        transpose_item(F.w_out() + (size_t)L * DM * DM, DM, F.WOUT() + (size_t)L * DM * DM, DM, kb * 64, nb * 32, (size_t)nb * 32, scr, lane); return; }
    it -= DEPTH * CV_OUT;
    const int L = it / CONV_PER_L, q0 = it % CONV_PER_L, kind = q0 / (NE * CV_EX), r = q0 % (NE * CV_EX), le = L * NE + r / CV_EX, q = r % CV_EX;
    if (kind < 2) { const int kb = q / 64, nb = q % 64, n0 = nb * 32;
        const size_t drow0 = (size_t)(n0 >> 7) * 256 + (n0 & 127) + (kind ? 128 : 0);
        transpose_item((kind ? F.wu() : F.wg()) + (size_t)le * DM * FF, FF, F.WGU() + (size_t)le * 4096 * DM, DM, kb * 64, n0, drow0, scr, lane); }
    else { const int kb = q / 32, nb = q % 32;
        transpose_item(F.wd() + (size_t)le * FF * DM, DM, F.WD() + (size_t)le * DM * FF, FF, kb * 64, nb * 32, (size_t)nb * 32, scr, lane); }
}
__device__ __forceinline__ bool conv_batch(const Frame& F) {
    LAS unsigned* bc = (LAS unsigned*)(F.lds + MISC_OFF + 64);
    LAS float* scr = (LAS float*)(F.lds + 32768 + F.wave * 8704);
    if (F.tid == 0) *bc = __hip_atomic_fetch_add((unsigned*)(F.ws + WS_CTL) + CW_Q, 64u, __ATOMIC_RELAXED, __HIP_MEMORY_SCOPE_AGENT);
    __syncthreads();
    const unsigned base = *bc;
    __syncthreads();
    if (base >= CONV_TOTAL) return false;
    for (int k = 0; k < 8; ++k) conv_item(F, base + 8 * k + F.wave, scr, F.lane);
    return true;
}
__device__ __forceinline__ void conv_n(const Frame& F, int n) { for (int i = 0; i < n; ++i) if (!conv_batch(F)) break; __syncthreads(); }
__device__ __forceinline__ void conv_until(const Frame& F, unsigned target) {
    for (;;) {
        const unsigned h = __hip_atomic_load((unsigned*)(F.ws + WS_CTL) + CW_Q, __ATOMIC_RELAXED, __HIP_MEMORY_SCOPE_AGENT);
        LAS unsigned* bc = (LAS unsigned*)(F.lds + MISC_OFF + 68);
        if (F.tid == 0) *bc = h;
        __syncthreads();
        const unsigned hh = *bc;
        __syncthreads();
        if (hh >= target) break;
        if (!conv_batch(F)) break;
    }
}
__device__ __forceinline__ void ph_prologue(const Frame& F) {
    const int tid = F.tid, lane = F.lane, wave = F.wave;
    LAS float* sc = (LAS float*)F.lds;
    LAS float* red = sc + 3072;
    for (int i = tid; i < 3072; i += NTHR) { const int v = i >> 10, k = i & 1023; const float c = v < 2 ? F.c_in()[v * DM + k] : F.cctx_in()[k]; sc[i] = c / (1.f + expf(-c)); }
    __syncthreads();
    for (int t = F.bid; t < 384; t += F.G) {
        const int L = t / 96, j0 = (t % 96) * 64;
        const float* W = F.w_mod() + (size_t)L * DM * 6144 + j0 + lane;
        float a0 = 0.f, a1 = 0.f, a2 = 0.f;
#pragma unroll 8
        for (int kk = 0; kk < 128; ++kk) { const int k = wave * 128 + kk; const float w = W[(size_t)k * 6144]; a0 += sc[k] * w; a1 += sc[1024 + k] * w; a2 += sc[2048 + k] * w; }
        red[(wave * 3 + 0) * 64 + lane] = a0; red[(wave * 3 + 1) * 64 + lane] = a1; red[(wave * 3 + 2) * 64 + lane] = a2;
        __syncthreads();
        if (tid < 192) { const int v = tid >> 6, l = tid & 63; float s = 0.f;
#pragma unroll
            for (int w = 0; w < 8; ++w) s += red[(w * 3 + v) * 64 + l];
            F.MOD()[(size_t)(L * 3 + v) * 6144 + j0 + l] = s + F.b_mod()[L * 6144 + j0 + l]; }
        __syncthreads();
    }
    if (F.bid == 0 && wave == 0) {
        for (int L = 0; L < DEPTH; ++L) {
            const float d1 = wave_sum(F.lq1()[L * 64 + lane] * F.lk1()[L * 64 + lane]), d2 = wave_sum(F.lq2()[L * 64 + lane] * F.lk2()[L * 64 + lane]);
            const float linit = 0.8f - 0.6f * expf(-0.3f * (float)L);
            if (lane == 0) { F.LP()[L * 16 + 0] = expf(d1) - expf(d2) + linit; F.LP()[L * 16 + 1] = 1.f - linit; }
            if (lane < 8) { const float xd = F.retd()[L * 8 + lane]; F.LP()[L * 16 + 2 + lane] = -log1pf(expf(-xd)); }
            F.LP()[DEPTH * 16 + L * 128 + lane] = F.qng()[L * 64 + lane]; F.LP()[DEPTH * 16 + L * 128 + 64 + lane] = F.kng()[L * 64 + lane];
            { const float mq = wave_max(fabsf(F.qng()[L * 64 + lane])), mk = wave_max(fabsf(F.kng()[L * 64 + lane])); if (lane == 0) F.LP()[L * 16 + 10] = 64.f * mq * mk * 1.02f; }
        }
    }
    const int gw = F.bid * NWAVES + wave, NGW = F.G * NWAVES;
    {
        const int i16 = lane & 15, which = lane >> 4, i32 = lane & 31;
        const float inv_a = powf(10000.f, -(float)i16 / 16.f);
        const float inv_r = 1.f / powf(10000.f, (float)i32 / 31.f);
        for (int n = gw; n < SEQ; n += NGW) {
            const float pos = (which & 1) ? (float)(n & 63) : (float)(n >> 6);
            const float ang = pos * inv_a;
            F.ROPE()[(size_t)n * 64 + lane] = (which < 2) ? (float)cos((double)ang) : (float)sin((double)ang);
            const float ang2 = (float)n * inv_r;
            F.RETT()[(size_t)n * 64 + lane] = (lane < 32) ? (float)cos((double)ang2) : (float)sin((double)ang2);
        }
    }
    if (F.bid == 0) for (int i = tid; i < DM / 2; i += NTHR) ((unsigned*)(F.HN() + (size_t)NROW * DM))[i] = 0u;
    for (int i = F.bid * NTHR + tid; i < DEPTH * 16 * DM; i += F.G * NTHR) { const int Lr = i / (16 * DM), q = i % (16 * DM), k = q >> 4, e = q & 15;
        const float w = F.rw()[i]; const unsigned h = f2bf(w); const float wl = w - __builtin_bit_cast(float, h << 16);
        F.RWS()[((size_t)(Lr * 2 + 0) * 16 + e) * RWLD + k] = (bf16)h; F.RWS()[((size_t)(Lr * 2 + 1) * 16 + e) * RWLD + k] = (bf16)f2bf(wl); }
    for (int i = F.bid * NTHR + tid; i < DEPTH * 4 * 128 * 128; i += F.G * NTHR) F.SGW()[i] = (bf16)f2bf(F.sgw()[i]);
    conv_until(F, CONV_SEG0);
}

__device__ __forceinline__ void ph_norm1_first(const Frame& F) {
    const int lane = F.lane, gw = F.bid * NWAVES + F.wave, NGW = F.G * NWAVES;
    for (int r = gw; r < NROW; r += NGW) {
        const float* src = r < NLAT ? F.x_in() + (size_t)r * DM : F.ctx_in() + (size_t)(r - NLAT) * DM;
        const float* mod = F.MOD() + (size_t)row_vec(r) * 6144;
        f32x4 v[4]; float ss = 0.f;
#pragma unroll
        for (int j = 0; j < 4; ++j) { v[j] = *(const f32x4*)(src + 4 * lane + 256 * j); ss += (v[j].x * v[j].x + v[j].y * v[j].y) + (v[j].z * v[j].z + v[j].w * v[j].w); }
        const float rinv = rsqrtf(wave_sum(ss) * (1.f / DM) + EPS);
#pragma unroll
        for (int j = 0; j < 4; ++j) { const int c = 4 * lane + 256 * j;
            const f32x4 g = *(const f32x4*)(F.n1g() + c), sh = *(const f32x4*)(mod + c), sc = *(const f32x4*)(mod + 1024 + c);
            const f32x4 h = v[j] * rinv * g * (sc + 1.f) + sh;
            *(unsigned long long*)(F.HN() + (size_t)r * DM + c) = (unsigned long long)pk2(h.x, h.y) | ((unsigned long long)pk2(h.z, h.w) << 32); }
    }
}

__device__ __forceinline__ void ph_prep(const Frame& F, int L) {
    const int lane = F.lane, gw = F.bid * NWAVES + F.wave, NGW = F.G * NWAVES;
    const int grp8 = lane >> 3, half = (lane >> 2) & 1, t4 = lane & 3, dA = half * 32 + 4 * t4;
    const f32x4 gqA = *(const f32x4*)(F.qng() + L * 64 + dA), gqB = *(const f32x4*)(F.qng() + L * 64 + dA + 16);
    const f32x4 gkA = *(const f32x4*)(F.kng() + L * 64 + dA), gkB = *(const f32x4*)(F.kng() + L * 64 + dA + 16);
    const int rsel = lane >> 5, rhead = (lane >> 3) & 3, t8 = lane & 7;
    const float rscale = rsel ? 0.125f : 1.f;
    const f32x4 sgn = *(const f32x4*)(F.sgng() + L * 256 + lane * 4);
    for (int r = gw; r < NROW; r += NGW) {
        const bf16* zr = F.Z() + (size_t)r * INC;
        const bool lat = r < NLAT; const int b = lat ? (r >> 13) : ((r - NLAT) >> 8), n = lat ? (r & (SEQ - 1)) : ((r - NLAT) & (CTXL - 1));
        const size_t krow = (size_t)b * NKEY + (lat ? CTXL + n : n);
        f32x4 cs = {1.f, 1.f, 1.f, 1.f}, sn = {0.f, 0.f, 0.f, 0.f}, cs2 = cs, sn2 = sn;
        if (lat) { const float* T = F.ROPE() + (size_t)n * 64; cs = *(const f32x4*)(T + half * 16 + 4 * t4); sn = *(const f32x4*)(T + 32 + half * 16 + 4 * t4);
                   const float* R = F.RETT() + (size_t)n * 64; cs2 = *(const f32x4*)(R + 4 * t8); sn2 = *(const f32x4*)(R + 32 + 4 * t8); }
#pragma unroll
        for (int pass = 0; pass < 2; ++pass) {
            const int col = pass * 512 + grp8 * 64 + dA;
            const u16x4 ra = *(const u16x4*)(zr + col), rb = *(const u16x4*)(zr + col + 16);
            f32x4 x1, x2; float ss = 0.f;
#pragma unroll
            for (int e = 0; e < 4; ++e) { x1[e] = bf2f(ra[e]); x2[e] = bf2f(rb[e]); ss += x1[e] * x1[e] + x2[e] * x2[e]; }
            ss += __shfl_xor(ss, 1); ss += __shfl_xor(ss, 2); ss += __shfl_xor(ss, 4);
            const float rinv = rsqrtf(ss * (1.f / 64.f) + EPS);
            const f32x4 y1 = x1 * rinv * (pass ? gkA : gqA * QSCALE), y2 = x2 * rinv * (pass ? gkB : gqB * QSCALE);
            const f32x4 o1 = y1 * cs - y2 * sn, o2 = y1 * sn + y2 * cs;
            bf16* dst = (pass ? F.KH() + krow * 512 : F.QH() + (size_t)r * 512) + grp8 * 64 + dA;
            *(unsigned long long*)dst = (unsigned long long)pk2(o1.x, o1.y) | ((unsigned long long)pk2(o1.z, o1.w) << 32);
            *(unsigned long long*)(dst + 16) = (unsigned long long)pk2(o2.x, o2.y) | ((unsigned long long)pk2(o2.z, o2.w) << 32);
        }
    }
}

__device__ __forceinline__ void ph_norm2_router(const Frame& F, int L) {
    const int lane = F.lane, tid = F.tid, gw = F.bid * NWAVES + F.wave, NGW = F.G * NWAVES;
    LAS bf16* rwl = (LAS bf16*)F.lds;
    { const bf16* src = F.RWS() + (size_t)L * 2 * 16 * RWLD;
      for (int i = tid; i < 2 * 16 * RWLD / 8; i += NTHR) *(LAS bf16x8*)(rwl + i * 8) = *(const bf16x8*)(src + i * 8); }
    __syncthreads();
    const int ntile = ((L == DEPTH - 1) ? NLAT : NROW) / 16;
    const int rr = lane & 15, kq = lane >> 4;
    for (int tile = gw; tile < ntile; tile += NGW) {
        const int r = tile * 16 + rr;
        const bf16* xr = F.X() + (size_t)r * DM + 8 * kq;
        const float* mod = F.MOD() + (size_t)(L * 3 + row_vec(tile * 16)) * 6144 + 8 * kq;
        const float* gn = F.n2g() + L * DM + 8 * kq;
        float ss = 0.f;
#pragma unroll 8
        for (int st = 0; st < 32; ++st) { const v4u w = *(const v4u*)(xr + 32 * st);
            const f32x4 a = {__builtin_bit_cast(float, w.x << 16), __builtin_bit_cast(float, w.x & 0xffff0000u), __builtin_bit_cast(float, w.y << 16), __builtin_bit_cast(float, w.y & 0xffff0000u)};
            const f32x4 c = {__builtin_bit_cast(float, w.z << 16), __builtin_bit_cast(float, w.z & 0xffff0000u), __builtin_bit_cast(float, w.w << 16), __builtin_bit_cast(float, w.w & 0xffff0000u)};
            ss += (a.x * a.x + a.y * a.y) + (a.z * a.z + a.w * a.w) + (c.x * c.x + c.y * c.y) + (c.z * c.z + c.w * c.w); }
        ss += __shfl_xor(ss, 16); ss += __shfl_xor(ss, 32);
        const float rinv = rsqrtf(ss * (1.f / DM) + EPS);
        f32x4 acc = {0.f, 0.f, 0.f, 0.f};
        bf16* hrow = F.HN() + (size_t)r * DM + 8 * kq;
#pragma unroll 4
        for (int st = 0; st < 32; ++st) {
            float f[8];
            const v4u xw = *(const v4u*)(xr + 32 * st);
#pragma unroll
            for (int q = 0; q < 2; ++q) { const unsigned w0 = q ? xw.z : xw.x, w1 = q ? xw.w : xw.y;
                const f32x4 xv = {__builtin_bit_cast(float, w0 << 16), __builtin_bit_cast(float, w0 & 0xffff0000u), __builtin_bit_cast(float, w1 << 16), __builtin_bit_cast(float, w1 & 0xffff0000u)};
                const f32x4 g = *(const f32x4*)(gn + 32 * st + 4 * q),
                                                      sh = *(const f32x4*)(mod + 3072 + 32 * st + 4 * q), sc = *(const f32x4*)(mod + 4096 + 32 * st + 4 * q);
                const f32x4 y = xv * rinv * g * (sc + 1.f) + sh; f[4 * q] = y.x; f[4 * q + 1] = y.y; f[4 * q + 2] = y.z; f[4 * q + 3] = y.w; }
            v4u hi, lo;
            hi.x = pk2(f[0], f[1]); hi.y = pk2(f[2], f[3]); hi.z = pk2(f[4], f[5]); hi.w = pk2(f[6], f[7]);
#define LOPK(w, i0, i1) pk2(f[i0] - __builtin_bit_cast(float, (w) << 16), f[i1] - __builtin_bit_cast(float, (w) & 0xffff0000u))
            lo.x = LOPK(hi.x, 0, 1); lo.y = LOPK(hi.y, 2, 3); lo.z = LOPK(hi.z, 4, 5); lo.w = LOPK(hi.w, 6, 7);
#undef LOPK
            *(v4u*)(hrow + 32 * st) = hi;
            const bf16x8 ah = __builtin_bit_cast(bf16x8, hi), al = __builtin_bit_cast(bf16x8, lo);
            const bf16x8 bh = *(const LAS bf16x8*)(rwl + rr * RWLD + 32 * st + 8 * kq), bl = *(const LAS bf16x8*)(rwl + (16 + rr) * RWLD + 32 * st + 8 * kq);
            acc = __builtin_amdgcn_mfma_f32_16x16x32_bf16(ah, bh, acc, 0, 0, 0);
            acc = __builtin_amdgcn_mfma_f32_16x16x32_bf16(ah, bl, acc, 0, 0, 0);
            acc = __builtin_amdgcn_mfma_f32_16x16x32_bf16(al, bh, acc, 0, 0, 0);
        }
#pragma unroll
        for (int q = 0; q < 4; ++q) {
            float mx = acc[q];
#pragma unroll
            for (int o = 1; o < 16; o <<= 1) mx = fmaxf(mx, __shfl_xor(mx, o));
            const float ex = expf(acc[q] - mx); float sum = ex;
#pragma unroll
            for (int o = 1; o < 16; o <<= 1) sum += __shfl_xor(sum, o);
            F.AFF()[(size_t)(tile * 16 + 4 * kq + q) * 16 + rr] = ex / sum;
        }
    }
    __syncthreads();
}

__device__ __forceinline__ unsigned block_excl_scan(unsigned v, LAS unsigned* wtot, int lane, int wave) {
    unsigned inc = v;
#pragma unroll
    for (int o = 1; o < 64; o <<= 1) { const unsigned t = __shfl_up(inc, o); if (lane >= o) inc += t; }
    if (lane == 63) wtot[wave] = inc;
    __syncthreads();
    unsigned off = 0;
    for (int w = 0; w < wave; ++w) off += wtot[w];
    __syncthreads();
    return off + inc - v;
}
__device__ __forceinline__ void ph_topk(const Frame& F, int L) {
    const int tid = F.tid, lane = F.lane, wave = F.wave;
    LAS unsigned* keys = (LAS unsigned*)F.lds;
    LAS unsigned* hist = keys + 8192;
    LAS unsigned* wtot = hist + 256;
    LAS unsigned* bc = wtot + 16;
    const int nprob = (L == DEPTH - 1) ? 32 : 64;
    for (int p = F.bid; p < 64; p += F.G) {
        const int s = p >> 4, e = p & 15;
        const int n = s < 2 ? SEQ : CTXL, k = n >> 3;
        const int base = s < 2 ? s * SEQ : NLAT + (s - 2) * CTXL;
        const int sbase = s == 0 ? 0 : (s == 1 ? 1024 : (s == 2 ? 2048 : 2080));
        if (p >= nprob) {
            for (int i = tid; i < 32; i += NTHR) { F.ROWIDX()[e * EROWS + sbase + i] = -1; F.GATE()[e * EROWS + sbase + i] = 0.f; }
            if (s == 3) for (int rr = 2112 + tid; rr < EROWS; rr += NTHR) { F.ROWIDX()[e * EROWS + rr] = -1; F.GATE()[e * EROWS + rr] = 0.f; }
            continue; }
        for (int i = tid; i < n; i += NTHR) keys[i] = __float_as_uint(F.AFF()[(size_t)(base + i) * 16 + e]);
        __syncthreads();
        unsigned prefix = 0u, mask = 0u, need = (unsigned)k;
        for (int pass = 0; pass < 4; ++pass) {
            const int shift = 24 - 8 * pass;
            if (tid < 256) hist[tid] = 0u;
            __syncthreads();
            for (int i = tid; i < n; i += NTHR) { const unsigned key = keys[i]; if ((key & mask) == prefix) atomicAdd((unsigned*)&hist[(key >> shift) & 255u], 1u); }
            __syncthreads();
            if (wave == 0) {
                const unsigned h0 = hist[4 * lane], h1 = hist[4 * lane + 1], h2 = hist[4 * lane + 2], h3 = hist[4 * lane + 3];
                const unsigned tot = h0 + h1 + h2 + h3;
                unsigned suf = tot;
#pragma unroll
                for (int o = 1; o < 64; o <<= 1) { const unsigned t = __shfl_down(suf, o); if (lane + o < 64) suf += t; }
                const unsigned above = suf - tot;
                if (suf >= need && above < need) {
                    unsigned rem = need - above, bsel;
                    if (rem <= h3) bsel = 3u; else { rem -= h3; if (rem <= h2) bsel = 2u; else { rem -= h2; if (rem <= h1) bsel = 1u; else { rem -= h1; bsel = 0u; } } }
                    bc[0] = 4u * lane + bsel; bc[1] = rem;
                }
            }
            __syncthreads();
            prefix |= bc[0] << shift; mask |= 255u << shift; need = bc[1];
            __syncthreads();
        }
        const unsigned T = prefix;
        const int per = n >= NTHR ? n / NTHR : 1;
        const int i0 = tid * per; const bool act = i0 < n;
        unsigned eqc = 0u;
        if (act) for (int q = 0; q < per; ++q) eqc += (keys[i0 + q] == T) ? 1u : 0u;
        unsigned eqr = block_excl_scan(eqc, wtot, lane, wave);
        unsigned selc = 0u;
        if (act) for (int q = 0; q < per; ++q) { const unsigned key = keys[i0 + q]; if (key > T) ++selc; else if (key == T) { if (eqr < need) ++selc; ++eqr; } }
        unsigned slot = block_excl_scan(selc, wtot, lane, wave);
        eqr -= eqc;
        if (act) for (int q = 0; q < per; ++q) {
            const unsigned key = keys[i0 + q]; bool sel = key > T;
            if (key == T) { sel = eqr < need; ++eqr; }
            const int tok = base + i0 + q;
            if (sel) { const int rr = sbase + (int)slot; ++slot; F.ROWIDX()[e * EROWS + rr] = tok; F.GATE()[e * EROWS + rr] = __uint_as_float(key); F.SLOT()[(size_t)tok * 16 + e] = rr; }
            else F.SLOT()[(size_t)tok * 16 + e] = -1;
        }
        if (s == 3) for (int rr = 2112 + tid; rr < EROWS; rr += NTHR) { F.ROWIDX()[e * EROWS + rr] = -1; F.GATE()[e * EROWS + rr] = 0.f; }
        __syncthreads();
    }
}

__device__ __forceinline__ void ph_gather(const Frame& F) {
    const int lane = F.lane, gw = F.bid * NWAVES + F.wave, NGW = F.G * NWAVES;
    for (int idx = gw; idx < NE * EROWS; idx += NGW) {
        const int src = F.ROWIDX()[idx];
        bf16x8 a = {0, 0, 0, 0, 0, 0, 0, 0}, b = a;
        if (src >= 0) { a = *(const bf16x8*)(F.HN() + (size_t)src * DM + 8 * lane); b = *(const bf16x8*)(F.HN() + (size_t)src * DM + 512 + 8 * lane); }
        *(bf16x8*)(F.XS() + (size_t)idx * DM + 8 * lane) = a; *(bf16x8*)(F.XS() + (size_t)idx * DM + 512 + 8 * lane) = b;
    }
}

__device__ __forceinline__ void ph_combine(const Frame& F, int L) {
    const int lane = F.lane, gw = F.bid * NWAVES + F.wave, NGW = F.G * NWAVES;
    const bool last = (L == DEPTH - 1);
    const int nrows = last ? NLAT : NROW;
    for (int r = gw; r < nrows; r += NGW) {
        const int v = row_vec(r);
        const int sl = (lane < 16) ? F.SLOT()[(size_t)r * 16 + lane] : -1;
        const float* mod = F.MOD() + (size_t)(L * 3 + v) * 6144;
        f32x4 xv[4], g2[4];
#pragma unroll
        for (int j = 0; j < 2; ++j)
#pragma unroll
            for (int q = 0; q < 2; ++q) { const int c = 8 * lane + 512 * j + 4 * q; const unsigned long long w = *(const unsigned long long*)(F.X() + (size_t)r * DM + c);
                const unsigned w0 = (unsigned)w, w1 = (unsigned)(w >> 32);
                xv[2 * j + q] = (f32x4){__builtin_bit_cast(float, w0 << 16), __builtin_bit_cast(float, w0 & 0xffff0000u), __builtin_bit_cast(float, w1 << 16), __builtin_bit_cast(float, w1 & 0xffff0000u)};
                g2[2 * j + q] = *(const f32x4*)(mod + 5120 + c); }
        float acc[16];
#pragma unroll
        for (int i = 0; i < 16; ++i) acc[i] = 0.f;
        unsigned long long m = __ballot(sl >= 0);
        while (m) {
            const int e0 = __builtin_ctzll(m); m &= m - 1;
            const int e1 = m ? __builtin_ctzll(m) : -1; if (m) m &= m - 1;
            const int s0 = __shfl(sl, e0), s1 = e1 >= 0 ? __shfl(sl, e1) : 0;
            const float gv0 = F.GATE()[e0 * EROWS + s0]; const bf16* y0 = F.Y() + ((size_t)e0 * EROWS + s0) * DM;
            const bf16x8 a0 = *(const bf16x8*)(y0 + 8 * lane), a1 = *(const bf16x8*)(y0 + 8 * lane + 512);
            float gv1 = 0.f; bf16x8 b0 = {0, 0, 0, 0, 0, 0, 0, 0}, b1 = b0;
            if (e1 >= 0) { gv1 = F.GATE()[e1 * EROWS + s1]; const bf16* y1 = F.Y() + ((size_t)e1 * EROWS + s1) * DM; b0 = *(const bf16x8*)(y1 + 8 * lane); b1 = *(const bf16x8*)(y1 + 8 * lane + 512); }
#pragma unroll
            for (int i = 0; i < 8; ++i) { acc[i] += gv0 * bf2f((bf16)a0[i]); acc[8 + i] += gv0 * bf2f((bf16)a1[i]); }
            if (e1 >= 0) {
#pragma unroll
                for (int i = 0; i < 8; ++i) { acc[i] += gv1 * bf2f((bf16)b0[i]); acc[8 + i] += gv1 * bf2f((bf16)b1[i]); } }
        }
        float xn[16]; float ss = 0.f;
#pragma unroll
        for (int j = 0; j < 2; ++j)
#pragma unroll
            for (int q = 0; q < 2; ++q) { const int c = 8 * lane + 512 * j + 4 * q;
#pragma unroll
                for (int i = 0; i < 4; ++i) { const float t = xv[2 * j + q][i] + g2[2 * j + q][i] * acc[8 * j + 4 * q + i]; xn[8 * j + 4 * q + i] = t; ss += t * t; }
                const f32x4 o = {xn[8 * j + 4 * q], xn[8 * j + 4 * q + 1], xn[8 * j + 4 * q + 2], xn[8 * j + 4 * q + 3]};
                if (last) *(f32x4*)(F.out + (size_t)r * DM + c) = o;
                else *(unsigned long long*)(F.X() + (size_t)r * DM + c) = (unsigned long long)pk2(o.x, o.y) | ((unsigned long long)pk2(o.z, o.w) << 32); }
        if (!last) {
            const float rinv = rsqrtf(wave_sum(ss) * (1.f / DM) + EPS);
            const float* mod1 = F.MOD() + (size_t)((L + 1) * 3 + v) * 6144;
#pragma unroll
            for (int j = 0; j < 2; ++j) { const int c = 8 * lane + 512 * j; float h[8];
#pragma unroll
                for (int q = 0; q < 2; ++q) { const f32x4 g = *(const f32x4*)(F.n1g() + (L + 1) * DM + c + 4 * q), sh = *(const f32x4*)(mod1 + c + 4 * q), sc = *(const f32x4*)(mod1 + 1024 + c + 4 * q);
#pragma unroll
                    for (int i = 0; i < 4; ++i) h[4 * q + i] = xn[8 * j + 4 * q + i] * rinv * g[i] * (1.f + sc[i]) + sh[i]; }
                v4u w; w.x = pk2(h[0], h[1]); w.y = pk2(h[2], h[3]); w.z = pk2(h[4], h[5]); w.w = pk2(h[6], h[7]);
                *(v4u*)(F.HN() + (size_t)r * DM + c) = w; }
        }
    }
}


constexpr int LDP = 136, LDQK = 72;

__device__ __forceinline__ void ret_rot(const Frame& F, const bf16* zh, int p, bool lat, int n, float scale, float (&o1)[8], float (&o2)[8]) {
    const bf16x8 r1 = *(const bf16x8*)(zh + 8 * p), r2 = *(const bf16x8*)(zh + 32 + 8 * p);
    float cs[8], sn[8];
    if (lat) { const float* R = F.RETT() + (size_t)n * 64 + 8 * p; const f32x4 c0 = *(const f32x4*)R, c1 = *(const f32x4*)(R + 4), s0 = *(const f32x4*)(R + 32), s1 = *(const f32x4*)(R + 36);
#pragma unroll
        for (int i = 0; i < 4; ++i) { cs[i] = c0[i]; cs[4 + i] = c1[i]; sn[i] = s0[i]; sn[4 + i] = s1[i]; } }
    else {
#pragma unroll
        for (int i = 0; i < 8; ++i) { cs[i] = 1.f; sn[i] = 0.f; } }
#pragma unroll
    for (int i = 0; i < 8; ++i) { const float x1 = bf2f((bf16)r1[i]) * scale, x2 = bf2f((bf16)r2[i]) * scale; o1[i] = x1 * cs[i] - x2 * sn[i]; o2[i] = x1 * sn[i] + x2 * cs[i]; }
}
__device__ __forceinline__ void unit_retkv(const Frame& F, int L, int b, int h, int cc) {
    const int tid = F.tid, lane = F.lane, wave = F.wave;
    LAS bf16* vT = (LAS bf16*)F.lds;
    LAS bf16* kfT = vT + 64 * LDP;
    LAS bf16* kbT = kfT + 64 * LDP;
    const int row0 = chunk_row0(b, cc);
    const float lgf = F.LP()[L * 16 + 2 + h], lgb = F.LP()[L * 16 + 6 + h];
    { const int j = tid >> 2, p = tid & 3;
      const bf16* zr = F.Z() + (size_t)(row0 + j) * INC;
      float k1[8], k2[8];
      ret_rot(F, zr + ZRK + h * 64, p, cc >= 2, (cc - 2) * 128 + j, 0.125f, k1, k2);
      const bf16x8 v1 = *(const bf16x8*)(zr + ZRV + h * 64 + 8 * p), v2 = *(const bf16x8*)(zr + ZRV + h * 64 + 32 + 8 * p);
      const float df = __expf(lgf * (float)(127 - j)), db = __expf(lgb * (float)j);
#pragma unroll
      for (int i = 0; i < 8; ++i) { const int d1 = 8 * p + i, d2 = 32 + 8 * p + i;
          kfT[d1 * LDP + j] = (bf16)f2bf(k1[i] * df); kbT[d1 * LDP + j] = (bf16)f2bf(k1[i] * db); vT[d1 * LDP + j] = (bf16)v1[i];
          kfT[d2 * LDP + j] = (bf16)f2bf(k2[i] * df); kbT[d2 * LDP + j] = (bf16)f2bf(k2[i] * db); vT[d2 * LDP + j] = (bf16)v2[i]; } }
    __syncthreads();
    { const int dir = wave >> 2, ti = (wave >> 1) & 1, tj = wave & 1, r32 = lane & 31, hi = lane >> 5;
      f32x16 acc = {};
      acc = mma_nt(vT + ti * 32 * LDP, LDP, (dir ? kbT : kfT) + tj * 32 * LDP, LDP, 128, acc, lane);
      float* dst = F.KVT() + ((size_t)(((b * 4 + h) * 2 + dir) * NCH + cc)) * 4096;
#pragma unroll
      for (int x = 0; x < 16; ++x) dst[(ti * 32 + crow(x, hi)) * 64 + tj * 32 + r32] = acc[x]; }
    __syncthreads();
}

__device__ __forceinline__ void ph_scan(const Frame& F, int L) {
    const int t = F.bid * NTHR + F.tid;
    if (t < 65536) {
        const int elem = t & 4095, sq = t >> 12, dir = sq & 1, h = (sq >> 1) & 3, b = sq >> 3;
        const size_t base = (size_t)(((b * 4 + h) * 2 + dir) * NCH);
        const float decay = expf(F.LP()[L * 16 + 2 + dir * 4 + h] * 128.f);
        float kv[NCH];
#pragma unroll
        for (int step = 0; step < NCH; ++step) { const int cc = dir == 0 ? step : (step < 2 ? 1 - step : 67 - step); kv[step] = F.KVT()[(base + cc) * 4096 + elem]; }
        float s = 0.f;
#pragma unroll
        for (int step = 0; step < NCH; ++step) { const int cc = dir == 0 ? step : (step < 2 ? 1 - step : 67 - step);
            F.SPREV()[(base + cc) * 4096 + elem] = (bf16)f2bf(s); s = s * decay + kv[step]; }
    }
}

__device__ __forceinline__ void unit_retout(const Frame& F, int L, int b, int h, int cc) {
    int tid = F.tid; asm volatile("" : "+v"(tid));
    const int lane = tid & 63, wave = F.wave, r32 = lane & 31, hi = lane >> 5;
    LAS bf16* q_s = (LAS bf16*)F.lds;
    LAS bf16* k_s = q_s + 128 * LDQK;
    LAS bf16* vT = k_s + 128 * LDQK;
    LAS bf16* SfT = vT + 64 * LDP;
    LAS bf16* SbT = SfT + 64 * LDQK;
    LAS bf16* P = SbT + 64 * LDQK;
    LAS float* O_s = (LAS float*)P;
    constexpr int LDO = 66;
    const int row0 = chunk_row0(b, cc);
    const float lgf = F.LP()[L * 16 + 2 + h], lgb = F.LP()[L * 16 + 6 + h];
    { const int j = tid >> 2, p = tid & 3;
      const bf16* zr = F.Z() + (size_t)(row0 + j) * INC;
      float a1[8], a2[8];
      ret_rot(F, zr + ZRQ + h * 64, p, cc >= 2, (cc - 2) * 128 + j, 1.f, a1, a2);
      { v4u w; w.x = pk2(a1[0], a1[1]); w.y = pk2(a1[2], a1[3]); w.z = pk2(a1[4], a1[5]); w.w = pk2(a1[6], a1[7]); *(LAS v4u*)(q_s + j * LDQK + 8 * p) = w;
        w.x = pk2(a2[0], a2[1]); w.y = pk2(a2[2], a2[3]); w.z = pk2(a2[4], a2[5]); w.w = pk2(a2[6], a2[7]); *(LAS v4u*)(q_s + j * LDQK + 32 + 8 * p) = w; }
      ret_rot(F, zr + ZRK + h * 64, p, cc >= 2, (cc - 2) * 128 + j, 0.125f, a1, a2);
      { v4u w; w.x = pk2(a1[0], a1[1]); w.y = pk2(a1[2], a1[3]); w.z = pk2(a1[4], a1[5]); w.w = pk2(a1[6], a1[7]); *(LAS v4u*)(k_s + j * LDQK + 8 * p) = w;
        w.x = pk2(a2[0], a2[1]); w.y = pk2(a2[2], a2[3]); w.z = pk2(a2[4], a2[5]); w.w = pk2(a2[6], a2[7]); *(LAS v4u*)(k_s + j * LDQK + 32 + 8 * p) = w; }
      const bf16x8 v1 = *(const bf16x8*)(zr + ZRV + h * 64 + 8 * p), v2 = *(const bf16x8*)(zr + ZRV + h * 64 + 32 + 8 * p);
#pragma unroll
      for (int i = 0; i < 8; ++i) { vT[(8 * p + i) * LDP + j] = (bf16)v1[i]; vT[(32 + 8 * p + i) * LDP + j] = (bf16)v2[i]; } }
    { const bf16* sf = F.SPREV() + ((size_t)(((b * 4 + h) * 2 + 0) * NCH + cc)) * 4096;
      const bf16* sb = F.SPREV() + ((size_t)(((b * 4 + h) * 2 + 1) * NCH + cc)) * 4096;
      { const int dv = tid >> 3, c8 = (tid & 7) * 8;
          *(LAS v4u*)(SfT + dv * LDQK + c8) = *(const v4u*)(sf + dv * 64 + c8);
          *(LAS v4u*)(SbT + dv * LDQK + c8) = *(const v4u*)(sb + dv * 64 + c8); } }
    __syncthreads();
    const int sti = wave >> 1, stj0 = (wave & 1) * 2;
    f32x16 S0 = {}, S1 = {};
    S0 = mma_nt(q_s + sti * 32 * LDQK, LDQK, k_s + stj0 * 32 * LDQK, LDQK, 64, S0, lane);
    S1 = mma_nt(q_s + sti * 32 * LDQK, LDQK, k_s + (stj0 + 1) * 32 * LDQK, LDQK, 64, S1, lane);
    const int ei = tid >> 2, ec = (tid & 3) * 16;
    float yo[16];
#pragma unroll
    for (int dir = 0; dir < 2; ++dir) {
        const float lg = dir ? lgb : lgf;
#pragma unroll
        for (int x = 0; x < 16; ++x) { const int i = sti * 32 + crow(x, hi);
            const int j0 = stj0 * 32 + r32, j1 = j0 + 32; const int d0 = dir ? j0 - i : i - j0, d1 = dir ? j1 - i : i - j1;
            const float p0 = d0 >= 0 ? S0[x] * __expf(lg * (float)d0) : 0.f, p1 = d1 >= 0 ? S1[x] * __expf(lg * (float)d1) : 0.f;
            const unsigned pk = pg8::cvt_pk_bf16(p0, p1);
            P[i * LDP + j0] = (bf16)(pk & 0xffffu); P[i * LDP + j1] = (bf16)(pk >> 16);
            if ((x & 3) == 3) __builtin_amdgcn_sched_barrier(0); }
        __syncthreads();
        const int oti = wave >> 1, otj = wave & 1;
        f32x16 a0 = {}, c0 = {};
        { const LAS bf16* ST = dir ? SbT : SfT;
          a0 = mma_nt(P + oti * 32 * LDP, LDP, vT + otj * 32 * LDP, LDP, 128, a0, lane);
          c0 = mma_nt(q_s + oti * 32 * LDQK, LDQK, ST + otj * 32 * LDQK, LDQK, 64, c0, lane); }
        __syncthreads();
#pragma unroll
        for (int x = 0; x < 16; ++x) { const int i = oti * 32 + crow(x, hi);
            const float qd = __expf(lg * (float)(dir ? 128 - i : i + 1));
            O_s[i * LDO + otj * 32 + r32] = a0[x] + c0[x] * qd;
            if ((x & 3) == 3) __builtin_amdgcn_sched_barrier(0); }
        __syncthreads();
        { float o[16]; float s = 0.f;
#pragma unroll
          for (int c = 0; c < 16; ++c) { o[c] = O_s[ei * LDO + ec + c]; s += o[c]; }
          s += __shfl_xor(s, 1); s += __shfl_xor(s, 2);
          const float mu = s * (1.f / 64.f); float s2 = 0.f;
#pragma unroll
          for (int c = 0; c < 16; ++c) { o[c] -= mu; s2 += o[c] * o[c]; }
          s2 += __shfl_xor(s2, 1); s2 += __shfl_xor(s2, 2);
          const float rs = rsqrtf(s2 * (1.f / 64.f) + EPS);
          const bf16* zr = F.Z() + (size_t)(row0 + ei) * INC + (dir ? ZGB : ZGF) + h * 64 + ec;
          const bf16x8 ga = *(const bf16x8*)zr, gb = *(const bf16x8*)(zr + 8);
#pragma unroll
          for (int c = 0; c < 16; ++c) { const float g = bf2f((bf16)(c < 8 ? ga[c & 7] : gb[c & 7])); const float y = o[c] * rs * silu_f(g);
              if (dir == 0) yo[c] = y; else yo[c] += y; }
          if (dir == 1) { bf16* mr = F.MIX() + (size_t)(row0 + ei) * DM + 512 + h * 64 + ec;
              v4u w0, w1; w0.x = pk2(yo[0], yo[1]); w0.y = pk2(yo[2], yo[3]); w0.z = pk2(yo[4], yo[5]); w0.w = pk2(yo[6], yo[7]);
              w1.x = pk2(yo[8], yo[9]); w1.y = pk2(yo[10], yo[11]); w1.z = pk2(yo[12], yo[13]); w1.w = pk2(yo[14], yo[15]);
              *(v4u*)mr = w0; *(v4u*)(mr + 8) = w1; } }
        __syncthreads();
    }
}

__device__ __forceinline__ void unit_sg(const Frame& F, int L, int b, int g, int cc) {
    const int tid = F.tid, lane = F.lane, wave = F.wave, r32 = lane & 31, hi = lane >> 5;
    LAS bf16* W_s = (LAS bf16*)F.lds;
    LAS bf16* vT = W_s + 128 * LDP;
    const int row0 = chunk_row0(b, cc);
    const bf16* Wg = F.SGW() + (size_t)(L * 4 + g) * 128 * 128;
#pragma unroll
    for (int q = 0; q < 4; ++q) { const int idx = tid + NTHR * q, i = idx >> 4, c8 = (idx & 15) * 8; *(LAS bf16x8*)(W_s + i * LDP + c8) = *(const bf16x8*)(Wg + i * 128 + c8); }
    { const int j = tid >> 2, qd = tid & 3;
      const bf16* zr = F.Z() + (size_t)(row0 + j) * INC + ZSV + 64 * qd;
      float gv[64]; float sum = 0.f;
#pragma unroll
      for (int c = 0; c < 8; ++c) { const bf16x8 raw = *(const bf16x8*)(zr + 8 * c);
#pragma unroll
          for (int i = 0; i < 8; ++i) { const float t = gelu_t(bf2f((bf16)raw[i])); gv[8 * c + i] = t; sum += t; } }
      sum += __shfl_xor(sum, 1); sum += __shfl_xor(sum, 2);
      const float mu = sum * (1.f / 256.f); float s2 = 0.f;
#pragma unroll
      for (int c = 0; c < 64; ++c) { gv[c] -= mu; s2 += gv[c] * gv[c]; }
      s2 += __shfl_xor(s2, 1); s2 += __shfl_xor(s2, 2);
      const float rs = rsqrtf(s2 * (1.f / 256.f) + EPS);
      if (qd == g) { const float* gn = F.sgng() + L * 256 + g * 64;
#pragma unroll
          for (int c = 0; c < 64; ++c) vT[c * LDP + j] = (bf16)f2bf(gv[c] * rs * gn[c]); } }
    __syncthreads();
    LAS float* O_s = (LAS float*)W_s;
    { const int ti = wave >> 1, tj = wave & 1;
      f32x16 acc = {};
      acc = mma_nt(W_s + ti * 32 * LDP, LDP, vT + tj * 32 * LDP, LDP, 128, acc, lane);
      __syncthreads();
#pragma unroll
      for (int x = 0; x < 16; ++x) O_s[(ti * 32 + crow(x, hi)) * 66 + tj * 32 + r32] = acc[x]; }
    __syncthreads();
    { const int i = tid >> 2, ec = (tid & 3) * 16;
      const bf16* zu = F.Z() + (size_t)(row0 + i) * INC + ZSU + g * 64 + ec;
      const bf16x8 u0 = *(const bf16x8*)zu, u1 = *(const bf16x8*)(zu + 8);
      const float bi = F.sgb()[(L * 4 + g) * 128 + i];
      float o[16];
#pragma unroll
      for (int c = 0; c < 16; ++c) o[c] = gelu_t(bf2f((bf16)(c < 8 ? u0[c & 7] : u1[c & 7]))) * (O_s[i * 66 + ec + c] + bi);
      bf16* mr = F.MIX() + (size_t)(row0 + i) * DM + 768 + g * 64 + ec;
      v4u w0, w1; w0.x = pk2(o[0], o[1]); w0.y = pk2(o[2], o[3]); w0.z = pk2(o[4], o[5]); w0.w = pk2(o[6], o[7]);
      w1.x = pk2(o[8], o[9]); w1.y = pk2(o[10], o[11]); w1.z = pk2(o[12], o[13]); w1.w = pk2(o[14], o[15]);
      *(v4u*)mr = w0; *(v4u*)(mr + 8) = w1; }
    __syncthreads();
}

__device__ __forceinline__ void unit_out_ctx(const Frame& F, int L, int mu) {
    int tid = F.tid; asm volatile("" : "+v"(tid));
    const int lane = tid & 63, wave = F.wave, r32 = lane & 31, hi = lane >> 5;
    const int rb = mu >> 5, cb = mu & 31, k0 = wave * 128 + 8 * hi;
    LAS float* P = (LAS float*)F.lds;
    const bf16* A0 = F.MIX() + (size_t)(NLAT + rb * 64 + r32) * DM + k0;
    const bf16* B0 = F.WOUT() + (size_t)L * DM * DM + (size_t)(cb * 32 + r32) * DM + k0;
    bf16x8 a0[8], a1[8], bb[8];
#pragma unroll
    for (int s = 0; s < 8; ++s) { a0[s] = *(const bf16x8*)(A0 + 16 * s); a1[s] = *(const bf16x8*)(A0 + 32 * DM + 16 * s); bb[s] = *(const bf16x8*)(B0 + 16 * s); }
    f32x16 c0 = {}, c1 = {};
#pragma unroll
    for (int s = 0; s < 8; ++s) { c0 = __builtin_amdgcn_mfma_f32_32x32x16_bf16(a0[s], bb[s], c0, 0, 0, 0); c1 = __builtin_amdgcn_mfma_f32_32x32x16_bf16(a1[s], bb[s], c1, 0, 0, 0); }
#pragma unroll
    for (int x = 0; x < 16; ++x) { P[((wave * 2 + 0) * 16 + x) * 64 + lane] = c0[x]; P[((wave * 2 + 1) * 16 + x) * 64 + lane] = c1[x]; }
    __syncthreads();
    const float* g1 = F.MOD() + (size_t)(L * 3 + 2) * 6144 + 2048 + cb * 32;
#pragma unroll
    for (int q = 0; q < 4; ++q) {
        const int idx = tid + NTHR * q, ln = idx & 63, x = (idx >> 6) & 15, t = idx >> 10;
        float s = 0.f;
#pragma unroll
        for (int w = 0; w < 8; ++w) s += P[((w * 2 + t) * 16 + x) * 64 + ln];
        const int row = 32 * t + crow(x, ln >> 5), col = ln & 31;
        const size_t xo = (size_t)(rb * 64 + row) * DM + cb * 32 + col;
        F.X()[(size_t)NLAT * DM + xo] = (bf16)f2bf((L == 0 ? F.ctx_in()[xo] : bf2f(F.X()[(size_t)NLAT * DM + xo])) + g1[col] * s);
    }
    __syncthreads();
}

namespace att {
constexpr int KVBLK = 64;
constexpr float SCALE = 0.125f, THR = 8.f;
constexpr int LDQ = 512, LDK = 512, LDV = 512;
constexpr int SHM_V = KVBLK * 128 * 2, SHM_K = KVBLK * 64 * 2, SHM_ATTN = 2 * SHM_V + 2 * SHM_K + NWAVES * 64 * 4;
#define KSWZ(row, colB) ((row) * 128 + ((colB) ^ ((((row) >> 1) & 7) << 4)))
#define SBAR() __builtin_amdgcn_sched_barrier(0)
__device__ __forceinline__ unsigned cvtpk(float lo, float hi) { unsigned r; asm volatile("v_cvt_pk_bf16_f32 %0, %1, %2" : "=v"(r) : "v"(lo), "v"(hi)); return r; }
template <bool OFF> __device__ __forceinline__ void partialSM(f32x16& p0, f32x16& p1, float off) {
#pragma unroll
    for (int r = 0; r < 16; ++r) { if (OFF) { p0[r] += off; p1[r] += off; } p0[r] = __builtin_amdgcn_exp2f(p0[r]); }
}
__device__ __forceinline__ void finishSM(f32x16& p0, f32x16& p1, float& l_reg, bf16x8& pa0, bf16x8& pa1, bf16x8& pa2, bf16x8& pa3) {
#pragma unroll
    for (int r = 0; r < 16; ++r) p1[r] = __builtin_amdgcn_exp2f(p1[r]);
    float ps = 0;
#pragma unroll
    for (int r = 0; r < 16; ++r) ps += p0[r];
#pragma unroll
    for (int r = 0; r < 16; ++r) ps += p1[r];
    { auto rr = __builtin_amdgcn_permlane32_swap(__float_as_uint(ps), __float_as_uint(ps), false, false);
      ps = __uint_as_float(rr[0]) + __uint_as_float(rr[1]); }
    l_reg += ps;
#define PK4(P, BASE, OUT) do { unsigned a0 = cvtpk(P[BASE + 0], P[BASE + 1]), a1 = cvtpk(P[BASE + 2], P[BASE + 3]);   \
    unsigned b0 = cvtpk(P[BASE + 4], P[BASE + 5]), b1 = cvtpk(P[BASE + 6], P[BASE + 7]);                              \
    auto r0 = __builtin_amdgcn_permlane32_swap(a0, b0, false, false); auto r1 = __builtin_amdgcn_permlane32_swap(a1, b1, false, false); \
    v4u w = {r0[0], r1[0], r0[1], r1[1]}; OUT = __builtin_bit_cast(bf16x8, w); } while (0)
    PK4(p0, 0, pa0); PK4(p0, 8, pa1); PK4(p1, 0, pa2); PK4(p1, 8, pa3);
#undef PK4
}
template <bool OFF> __device__ __forceinline__ void kload(bf16x8 (&kf)[8], const LAS char* Ks, int r32, int hi) {
    if (OFF) return;
#pragma unroll
    for (int d0 = 0; d0 < 4; ++d0) { const int cb = (d0 * 16 + hi * 8) * 2;
        kf[2 * d0] = *(const LAS bf16x8*)(Ks + KSWZ(r32, cb)); kf[2 * d0 + 1] = *(const LAS bf16x8*)(Ks + KSWZ(32 + r32, cb)); }
}
template <bool OFF> __device__ __forceinline__ void qkmma(f32x16& p0, f32x16& p1, const bf16x8 (&kf)[8], const bf16x8* qr, const LAS char* Ks, int r32, int hi) {
    p0 = f32x16{}; p1 = f32x16{};
#pragma unroll
    for (int d0 = 0; d0 < 4; ++d0) {
        if (OFF) { const int cb = (d0 * 16 + hi * 8) * 2;
            const bf16x8 b0 = *(const LAS bf16x8*)(Ks + KSWZ(r32, cb)), b1 = *(const LAS bf16x8*)(Ks + KSWZ(32 + r32, cb));
            p0 = __builtin_amdgcn_mfma_f32_32x32x16_bf16(b0, qr[d0], p0, 0, 0, 0); p1 = __builtin_amdgcn_mfma_f32_32x32x16_bf16(b1, qr[d0], p1, 0, 0, 0); }
        else { p0 = __builtin_amdgcn_mfma_f32_32x32x16_bf16(kf[2 * d0], qr[d0], p0, 0, 0, 0); p1 = __builtin_amdgcn_mfma_f32_32x32x16_bf16(kf[2 * d0 + 1], qr[d0], p1, 0, 0, 0); } }
}
__device__ __forceinline__ int v_st(int k, int c) { const int kk = (k & ~0xC) | ((k & 4) << 1) | ((k & 8) >> 1); return ((kk >> 3) * 4 + (c >> 5)) * 512 + ((kk & 7) * 32 + (c & 31)) * 2; }
__device__ __forceinline__ int v_rd_base(int lane) { return ((lane & 3) << 3) | (((lane >> 2) & 3) << 6) | (((lane >> 4) & 1) << 5) | (((lane >> 5) & 1) << 8); }
constexpr int v_rd_off(int d0, int ks, int half) { return d0 * 512 + ks * 4096 + half * 2048; }
template <int OFF> __device__ __forceinline__ s16x4 tr_read(int vb) {
    s16x4 r; asm volatile("ds_read_b64_tr_b16 %0, %1 offset:%2" : "=&v"(r) : "v"(vb), "i"(OFF) : "memory"); return r;
}
template <int D0> __device__ __forceinline__ void pv_one(f32x16& od, int vb, bf16x8 pa0, bf16x8 pa1, bf16x8 pa2, bf16x8 pa3) {
    const s16x4 l0 = tr_read<v_rd_off(D0, 0, 0)>(vb), h0 = tr_read<v_rd_off(D0, 0, 1)>(vb), l1 = tr_read<v_rd_off(D0, 1, 0)>(vb), h1 = tr_read<v_rd_off(D0, 1, 1)>(vb);
    const s16x4 l2 = tr_read<v_rd_off(D0, 2, 0)>(vb), h2 = tr_read<v_rd_off(D0, 2, 1)>(vb), l3 = tr_read<v_rd_off(D0, 3, 0)>(vb), h3 = tr_read<v_rd_off(D0, 3, 1)>(vb);
    asm volatile("s_waitcnt lgkmcnt(0)" ::: "memory"); SBAR();
#define PK(Lo, Hi) (bf16x8){Lo[0], Lo[1], Lo[2], Lo[3], Hi[0], Hi[1], Hi[2], Hi[3]}
    od = __builtin_amdgcn_mfma_f32_32x32x16_bf16(pa0, PK(l0, h0), od, 0, 0, 0);
    od = __builtin_amdgcn_mfma_f32_32x32x16_bf16(pa1, PK(l1, h1), od, 0, 0, 0);
    od = __builtin_amdgcn_mfma_f32_32x32x16_bf16(pa2, PK(l2, h2), od, 0, 0, 0);
    od = __builtin_amdgcn_mfma_f32_32x32x16_bf16(pa3, PK(l3, h3), od, 0, 0, 0);
#undef PK
}
__device__ __forceinline__ void pv_d0(f32x16* o, int vb, bf16x8 pa0, bf16x8 pa1, bf16x8 pa2, bf16x8 pa3) {
    pv_one<0>(o[0], vb, pa0, pa1, pa2, pa3); pv_one<1>(o[1], vb, pa0, pa1, pa2, pa3); pv_one<2>(o[2], vb, pa0, pa1, pa2, pa3); pv_one<3>(o[3], vb, pa0, pa1, pa2, pa3);
}
template <bool OFF> __device__ __forceinline__ void body(const bf16* __restrict__ Qb, const bf16* __restrict__ Kh, const bf16* __restrict__ Vh, int seq, float mfix, LAS char* lds, f32x16 (&o)[4]) {
    int tid = threadIdx.x; asm volatile("" : "+v"(tid));
    const int wid = __builtin_amdgcn_readfirstlane(tid >> 6), lane = tid & 63, r32 = lane & 31, hi = lane >> 5;
    LAS char* V_lds = lds; LAS char* K_lds = lds + 2 * SHM_V;
    LAS float* ws = (LAS float*)(lds + 2 * SHM_V + 2 * SHM_K) + wid * 64; LAS float* li_l = ws; LAS float* al_l = ws + 32;
    float l_reg = 0;
    const float soff = -mfix * (SCALE * 1.4426950408889634f);
#pragma unroll
    for (int d = 0; d < 4; ++d) o[d] = f32x16{};
    bf16x8 qr[4];
    const bf16* Qw = Qb + (long)(wid * 32 + r32) * LDQ + hi * 8;
#pragma unroll
    for (int d0 = 0; d0 < 4; ++d0) qr[d0] = *(const bf16x8*)(Qw + d0 * 16);
    const int sr = tid >> 4, sc = (tid & 15) * 8, vst0 = v_st(sr, sc), vst1 = v_st(32 + sr, sc);
    const int kr = tid >> 3, kc = (tid & 7) * 8, kst = KSWZ(kr, kc * 2);
    const int vb0 = (int)(uintptr_t)V_lds + v_rd_base(lane);
    struct { bf16x8 vs0, vs1, ks0; } sr_[2];
#define SLOAD(i, k0) do { sr_[i].vs0 = *(const bf16x8*)(&Vh[(long)((k0) + sr) * LDV + sc]); sr_[i].vs1 = *(const bf16x8*)(&Vh[(long)((k0) + 32 + sr) * LDV + sc]); \
    sr_[i].ks0 = *(const bf16x8*)(&Kh[(long)((k0) + kr) * LDK + kc]); } while (0)
#define SWRITE(b, i) do { *(LAS bf16x8*)(V_lds + (b) * SHM_V + vst0) = sr_[i].vs0; *(LAS bf16x8*)(V_lds + (b) * SHM_V + vst1) = sr_[i].vs1; \
    *(LAS bf16x8*)(K_lds + (b) * SHM_K + kst) = sr_[i].ks0; } while (0)
#define SWAIT() asm volatile("s_waitcnt vmcnt(3)" ::: "memory")
    f32x16 pA0, pA1, pB0, pB1; bf16x8 pa0, pa1, pa2, pa3; const int NT = seq / KVBLK;
    constexpr int SE = 0, SO = 1;
    SLOAD(SE, 0); asm volatile("s_waitcnt vmcnt(0)" ::: "memory"); SWRITE(0, SE); __syncthreads();
    bf16x8 kf[8];
    kload<OFF>(kf, K_lds, r32, hi); qkmma<OFF>(pA0, pA1, kf, qr, K_lds, r32, hi); partialSM<OFF>(pA0, pA1, soff);
    SLOAD(SO, KVBLK); if (2 < NT) SLOAD(SE, 2 * KVBLK);
    SWAIT(); SWRITE(1, SO); __syncthreads();
    for (int j = 1; j + 1 < NT; j += 2) {
        SBAR(); kload<OFF>(kf, K_lds + SHM_K, r32, hi); SBAR();
        qkmma<OFF>(pB0, pB1, kf, qr, K_lds + SHM_K, r32, hi); finishSM(pA0, pA1, l_reg, pa0, pa1, pa2, pa3); SBAR();
        SLOAD(SO, (j + 2) * KVBLK); SBAR();
        pv_d0(o, vb0, pa0, pa1, pa2, pa3); partialSM<OFF>(pB0, pB1, soff);
        __syncthreads(); SWAIT(); SWRITE(0, SE);
        __syncthreads();
        SBAR(); kload<OFF>(kf, K_lds, r32, hi); SBAR();
        qkmma<OFF>(pA0, pA1, kf, qr, K_lds, r32, hi); finishSM(pB0, pB1, l_reg, pa0, pa1, pa2, pa3); SBAR();
        if (j + 3 < NT) SLOAD(SE, (j + 3) * KVBLK); SBAR();
        pv_d0(o, vb0 + (int)SHM_V, pa0, pa1, pa2, pa3); partialSM<OFF>(pA0, pA1, soff);
        __syncthreads(); SWAIT(); SWRITE(1, SO);
        __syncthreads();
    }
    SBAR(); kload<OFF>(kf, K_lds + SHM_K, r32, hi); SBAR();
    qkmma<OFF>(pB0, pB1, kf, qr, K_lds + SHM_K, r32, hi); finishSM(pA0, pA1, l_reg, pa0, pa1, pa2, pa3); SBAR();
    pv_d0(o, vb0, pa0, pa1, pa2, pa3); partialSM<OFF>(pB0, pB1, soff);
    __syncthreads();
    finishSM(pB0, pB1, l_reg, pa0, pa1, pa2, pa3); SBAR();
    pv_d0(o, vb0 + (int)SHM_V, pa0, pa1, pa2, pa3);
    if (hi == 0) li_l[r32] = l_reg; asm volatile("s_waitcnt lgkmcnt(0)" ::: "memory");
#pragma unroll
    for (int r = 0; r < 16; ++r) { const float rl = __builtin_amdgcn_rcpf(li_l[crow(r, hi)]);
#pragma unroll
        for (int d0 = 0; d0 < 4; ++d0) o[d0][r] *= rl; }
    __syncthreads();
#undef SLOAD
#undef SWRITE
#undef SWAIT
}

constexpr int SLK = 8192, SLV = 16384, L_K = 0, L_V = 3 * SLK, L_WS = L_V + 3 * SLV;
typedef const LAS char* lds_cptr;
typedef short v4i16_t __attribute__((ext_vector_type(4)));
#define PIN(x) asm volatile("" : "+v"(x))
#define MFMA32(a, b, c) __builtin_amdgcn_mfma_f32_32x32x16_bf16(a, b, c, 0, 0, 0)
#define WAIT_BAR(N) asm volatile("s_waitcnt vmcnt(" #N ") lgkmcnt(0)\n\ts_barrier" ::: "memory")
__device__ __forceinline__ unsigned cvtpk2(float lo, float hi) { unsigned r; asm("v_cvt_pk_bf16_f32 %0, %1, %2" : "=v"(r) : "v"(lo), "v"(hi)); return r; }
__device__ __forceinline__ void glds16(const void* g, unsigned lds_base) {
    unsigned sv; asm volatile("s_mov_b32 %0, m0\n\ts_mov_b32 m0, %2\n\ts_nop 0\n\tglobal_load_lds_dwordx4 %1, off\n\ts_mov_b32 m0, %0" : "=&s"(sv) : "v"(g), "s"(lds_base) : "memory"); }
__device__ __forceinline__ void kload2(bf16x8* kf, lds_cptr kp, int d0) { kf[2 * d0] = *(const LAS bf16x8*)(kp + d0 * 2048); kf[2 * d0 + 1] = *(const LAS bf16x8*)(kp + d0 * 2048 + 512); }
__device__ __forceinline__ s16x4 vtr(lds_cptr p) { return __builtin_bit_cast(s16x4, __builtin_amdgcn_ds_read_tr16_b64_v4i16((LAS v4i16_t*)p)); }
__device__ __forceinline__ void body_fast(const bf16* __restrict__ Qb, const bf16* __restrict__ Kh, const bf16* __restrict__ Vh, int seq, LAS char* lds, f32x16 (&o)[4]) {
    int tid = threadIdx.x; asm volatile("" : "+v"(tid));
    const int wid = __builtin_amdgcn_readfirstlane(tid >> 6), lane = tid & 63, r32 = lane & 31, hi = lane >> 5;
    const int NT = seq / KVBLK;
    const unsigned lds0 = (unsigned)(uintptr_t)lds; LAS float* wsf = (LAS float*)(lds + L_WS) + wid * 64;
    const bool dma = wid < 4;
    const bf16* ksrc = Kh + (long)lane * LDK + (wid & 3) * 8;
    const bf16* vsrc = Vh + (long)(16 * (wid & 3) + (lane >> 2)) * LDV + (lane & 3) * 8;
    const unsigned kdst = lds0 + L_K + (wid & 3) * 1024, vdst = lds0 + L_V + (wid & 3) * 1024;
#define GL(p, d) glds16(p, (unsigned)__builtin_amdgcn_readfirstlane(d))
#define DMA_K(t, slot) do { if (dma) { GL(ksrc + (long)(t) * KVBLK * LDK, kdst + (slot)); GL(ksrc + (long)(t) * KVBLK * LDK + 32, kdst + (slot) + 4096); } } while (0)
#define DMA_V1(t, slot) do { if (dma) { GL(vsrc + (long)(t) * KVBLK * LDV, vdst + 2 * (slot)); GL(vsrc + (long)(t) * KVBLK * LDV + 32, vdst + 2 * (slot) + 4096); } } while (0)
#define DMA_V2(t, slot) do { if (dma) { GL(vsrc + (long)(t) * KVBLK * LDV + 64, vdst + 2 * (slot) + 8192); GL(vsrc + (long)(t) * KVBLK * LDV + 96, vdst + 2 * (slot) + 12288); } } while (0)
#define DMA_V(t, slot) do { DMA_V1(t, slot); DMA_V2(t, slot); } while (0)
    const lds_cptr vp0 = (lds_cptr)lds + L_V + ((lane >> 4) & 1) * 32 + (lane & 3) * 8 + (4 * hi + ((lane & 15) >> 2)) * 64;
    const lds_cptr kp0 = (lds_cptr)lds + L_K + hi * 1024 + r32 * 16;
    DMA_K(0, 0); DMA_V(0, 0); DMA_K(1, SLK);
    bf16x8 qr[4];
    const bf16* Qw = Qb + (long)(wid * 32 + r32) * LDQ + hi * 8;
#pragma unroll
    for (int d0 = 0; d0 < 4; ++d0) qr[d0] = *(const bf16x8*)(Qw + d0 * 16);
    float l_reg = 0.f;
#pragma unroll
    for (int d = 0; d < 4; ++d) o[d] = f32x16{};
    f32x16 pA0, pA1, pB0, pB1; bf16x8 kf[8]; s16x4 vlo[8], vhi[8]; v4u pw0, pw1, pw2, pw3;
    int sl_prev = 0, sl_cur = 0, sl_next = SLK;
#define ROT() do { sl_prev = sl_cur; sl_cur = sl_next; sl_next = (sl_next == 2 * SLK) ? 0 : sl_next + SLK; } while (0)
#define EX(v) __builtin_amdgcn_exp2f(v)
    DMA_K(2, 2 * SLK);
    WAIT_BAR(4);
    _Pragma("unroll") for (int d0 = 0; d0 < 4; ++d0) kload2(kf, kp0, d0);
    pA0 = MFMA32(kf[0], qr[0], f32x16{}); pA1 = MFMA32(kf[1], qr[0], f32x16{}); pA0 = MFMA32(kf[2], qr[1], pA0); pA1 = MFMA32(kf[3], qr[1], pA1);
    pA0 = MFMA32(kf[4], qr[2], pA0); pA1 = MFMA32(kf[5], qr[2], pA1); pA0 = MFMA32(kf[6], qr[3], pA0); pA1 = MFMA32(kf[7], qr[3], pA1);
#pragma unroll
    for (int r = 0; r < 16; ++r) { pA0[r] = EX(pA0[r]); pA1[r] = EX(pA1[r]); }
    WAIT_BAR(0);
    DMA_K(3, 0); DMA_V(1, SLK); ROT();
    _Pragma("unroll") for (int d0 = 0; d0 < 4; ++d0) kload2(kf, kp0 + sl_cur, d0);
    WAIT_BAR(6);
#define PKW(P, i) cvtpk2(P[i], P[i + 1])
#define PAF(k) __builtin_bit_cast(bf16x8, pw##k)
#define VFR(i) (bf16x8){vlo[i][0], vlo[i][1], vlo[i][2], vlo[i][3], vhi[i][0], vhi[i][1], vhi[i][2], vhi[i][3]}
#define VRD(s, fi) do { vlo[s] = vtr(vp_ + (((fi) >> 2) * 4096 + ((fi) & 3) * 1024)); vhi[s] = vtr(vp_ + (((fi) >> 2) * 4096 + ((fi) & 3) * 1024 + 512)); } while (0)
#define KRD(G, d0) do { if (G) { kload2(kf, kp0 + sl_next, d0); SBAR(); } } while (0)
#define GAPA(MF, a0, a1, a2, a3, W0, W1, PW) do { MF; sacc += a0; sacc2 += a1; sacc += a2; sacc2 += a3; W0; W1; PIN(PW); PIN(sacc); PIN(sacc2); SBAR(); } while (0)
#define GAPB(MF, X, i) do { MF; X[i] = EX(X[i]); X[i + 1] = EX(X[i + 1]); PIN(X); SBAR(); } while (0)
#define STEP(C0, C1, P0, P1, t, GK, GV, GL) do { SBAR(); \
    const lds_cptr vp_ = vp0 + 2 * sl_prev; \
    VRD(0, 0); SBAR(); float sacc = P0[0], sacc2 = P0[1]; \
                       GAPA(C0 = MFMA32(kf[0], qr[0], f32x16{}), P0[2], P0[3], P0[4], P0[5],     pw0[0] = PKW(P0, 0),  pw0[1] = PKW(P0, 2),  pw0); \
    VRD(4, 4); SBAR(); GAPA(C1 = MFMA32(kf[1], qr[0], f32x16{}), P0[6], P0[7], P0[8], P0[9],     pw0[2] = PKW(P0, 4),  pw0[3] = PKW(P0, 6),  pw0); \
    VRD(1, 1); SBAR(); GAPA(C0 = MFMA32(kf[2], qr[1], C0),       P0[10], P0[11], P0[12], P0[13], pw1[0] = PKW(P0, 8),  pw1[1] = PKW(P0, 10), pw1); \
    VRD(5, 5); SBAR(); GAPA(C1 = MFMA32(kf[3], qr[1], C1),       P0[14], P0[15], P1[0], P1[1],   pw1[2] = PKW(P0, 12), pw1[3] = PKW(P0, 14), pw1); \
    VRD(2, 2); SBAR(); GAPA(C0 = MFMA32(kf[4], qr[2], C0),       P1[2], P1[3], P1[4], P1[5],     pw2[0] = PKW(P1, 0),  pw2[1] = PKW(P1, 2),  pw2); \
    VRD(6, 6); SBAR(); GAPA(C1 = MFMA32(kf[5], qr[2], C1),       P1[6], P1[7], P1[8], P1[9],     pw2[2] = PKW(P1, 4),  pw2[3] = PKW(P1, 6),  pw2); \
    VRD(3, 3); SBAR(); GAPA(C0 = MFMA32(kf[6], qr[3], C0),       P1[10], P1[11], P1[12], P1[13], pw3[0] = PKW(P1, 8),  pw3[1] = PKW(P1, 10), pw3); \
    VRD(7, 7); SBAR(); GAPA(C1 = MFMA32(kf[7], qr[3], C1),       P1[14], P1[15], 0.f, 0.f,       pw3[2] = PKW(P1, 12), pw3[3] = PKW(P1, 14), pw3); \
    l_reg += sacc + sacc2; SBAR(); \
    GAPB(o[0] = MFMA32(PAF(0), VFR(0), o[0]), C0, 0);  VRD(0, 8);  SBAR(); \
    GAPB(o[1] = MFMA32(PAF(0), VFR(4), o[1]), C0, 2);  VRD(4, 12); SBAR(); \
    GAPB(o[0] = MFMA32(PAF(1), VFR(1), o[0]), C0, 4);  VRD(1, 9);  SBAR(); \
    GAPB(o[1] = MFMA32(PAF(1), VFR(5), o[1]), C0, 6);  VRD(5, 13); SBAR(); \
    GAPB(o[0] = MFMA32(PAF(2), VFR(2), o[0]), C0, 8);  VRD(2, 10); SBAR(); \
    GAPB(o[1] = MFMA32(PAF(2), VFR(6), o[1]), C0, 10); VRD(6, 14); SBAR(); \
    GAPB(o[0] = MFMA32(PAF(3), VFR(3), o[0]), C0, 12); VRD(3, 11); SBAR(); \
    GAPB(o[1] = MFMA32(PAF(3), VFR(7), o[1]), C0, 14); VRD(7, 15); SBAR(); \
    KRD(GL, 0); GAPB(o[2] = MFMA32(PAF(0), VFR(0), o[2]), C1, 0); \
    KRD(GL, 1); GAPB(o[3] = MFMA32(PAF(0), VFR(4), o[3]), C1, 2); \
    KRD(GL, 2); GAPB(o[2] = MFMA32(PAF(1), VFR(1), o[2]), C1, 4); \
    KRD(GL, 3); GAPB(o[3] = MFMA32(PAF(1), VFR(5), o[3]), C1, 6); \
    GAPB(o[2] = MFMA32(PAF(2), VFR(2), o[2]), C1, 8);  if (GK) { DMA_K((t) + 3, sl_cur); SBAR(); } \
    GAPB(o[3] = MFMA32(PAF(2), VFR(6), o[3]), C1, 10); if (GV) { DMA_V1((t) + 1, sl_next); SBAR(); } \
    GAPB(o[2] = MFMA32(PAF(3), VFR(3), o[2]), C1, 12); if (GV) { DMA_V2((t) + 1, sl_next); SBAR(); } \
    GAPB(o[3] = MFMA32(PAF(3), VFR(7), o[3]), C1, 14); \
    } while (0)
    int t = 1;
    for (; t + 5 < NT; t += 2) {
        STEP(pB0, pB1, pA0, pA1, t, true, true, true);     WAIT_BAR(6); ROT();
        STEP(pA0, pA1, pB0, pB1, t + 1, true, true, true); WAIT_BAR(6); ROT();
    }
#define ENDW(tt) do { if ((tt) + 3 < NT) { WAIT_BAR(6); } else if ((tt) + 2 < NT) { WAIT_BAR(4); } else { WAIT_BAR(0); } } while (0)
    for (; t + 1 < NT; t += 2) {
        STEP(pB0, pB1, pA0, pA1, t, (t + 3 < NT), (t + 1 < NT), (t + 1 < NT));         ENDW(t);     ROT();
        STEP(pA0, pA1, pB0, pB1, t + 1, (t + 4 < NT), (t + 2 < NT), (t + 2 < NT));     ENDW(t + 1); ROT();
    }
    STEP(pB0, pB1, pA0, pA1, NT - 1, false, false, false);
    { float sacc = pB0[0] + pB0[1];
#pragma unroll
      for (int r = 2; r < 16; ++r) sacc += pB0[r];
#pragma unroll
      for (int r = 0; r < 16; ++r) sacc += pB1[r];
      l_reg += sacc;
      pw0 = (v4u){PKW(pB0, 0), PKW(pB0, 2), PKW(pB0, 4), PKW(pB0, 6)}; pw1 = (v4u){PKW(pB0, 8), PKW(pB0, 10), PKW(pB0, 12), PKW(pB0, 14)};
      pw2 = (v4u){PKW(pB1, 0), PKW(pB1, 2), PKW(pB1, 4), PKW(pB1, 6)}; pw3 = (v4u){PKW(pB1, 8), PKW(pB1, 10), PKW(pB1, 12), PKW(pB1, 14)};
      const lds_cptr vp_ = vp0 + 2 * sl_cur;
      _Pragma("unroll") for (int i = 0; i < 8; ++i) VRD(i, i);
      o[0] = MFMA32(PAF(0), VFR(0), o[0]); o[1] = MFMA32(PAF(0), VFR(4), o[1]); o[0] = MFMA32(PAF(1), VFR(1), o[0]); o[1] = MFMA32(PAF(1), VFR(5), o[1]);
      o[0] = MFMA32(PAF(2), VFR(2), o[0]); o[1] = MFMA32(PAF(2), VFR(6), o[1]); o[0] = MFMA32(PAF(3), VFR(3), o[0]); o[1] = MFMA32(PAF(3), VFR(7), o[1]);
      SBAR();
      _Pragma("unroll") for (int i = 0; i < 8; ++i) VRD(i, 8 + i);
      o[2] = MFMA32(PAF(0), VFR(0), o[2]); o[3] = MFMA32(PAF(0), VFR(4), o[3]); o[2] = MFMA32(PAF(1), VFR(1), o[2]); o[3] = MFMA32(PAF(1), VFR(5), o[3]);
      o[2] = MFMA32(PAF(2), VFR(2), o[2]); o[3] = MFMA32(PAF(2), VFR(6), o[3]); o[2] = MFMA32(PAF(3), VFR(3), o[2]); o[3] = MFMA32(PAF(3), VFR(7), o[3]); }
    { auto rr = __builtin_amdgcn_permlane32_swap(__float_as_uint(l_reg), __float_as_uint(l_reg), false, false); l_reg = __uint_as_float(rr[0]) + __uint_as_float(rr[1]); }
    if (hi == 0) wsf[32 + r32] = l_reg; asm volatile("s_waitcnt lgkmcnt(0)" ::: "memory");
#pragma unroll
    for (int r = 0; r < 16; ++r) { const float rl = __builtin_amdgcn_rcpf(wsf[32 + crow(r, hi)]);
#pragma unroll
        for (int d0 = 0; d0 < 4; ++d0) o[d0][r] *= rl; }
    asm volatile("s_waitcnt lgkmcnt(0)\n\ts_barrier" ::: "memory");
#undef DMA_K
#undef DMA_V
#undef DMA_V1
#undef DMA_V2
#undef GL
#undef ROT
#undef EX
#undef PKW
#undef PAF
#undef VFR
#undef VRD
#undef KRD
#undef ENDW
#undef GAPA
#undef GAPB
#undef STEP
}
}

__device__ __forceinline__ void unit_attn(const Frame& F, int L, int b, int h, int qrow0  , int seq) {
    f32x16 o[4];
    for (int m = 0; m < 2; ++m) {
        const float mfix = F.LP()[L * 16 + 10];
        if (__builtin_expect(mfix * (att::SCALE * 1.4426950408889634f) > 64.f, 0))
            att::body<true>(F.QH() + (size_t)qrow0 * 512 + (h * 2 + m) * 64, F.KH() + (size_t)b * NKEY * 512 + (h * 2 + m) * 64, F.VH() + (size_t)b * NKEY * 512 + h * 128, seq, mfix, (LAS char*)F.lds, o);
        else
            att::body_fast(F.QH() + (size_t)qrow0 * 512 + (h * 2 + m) * 64, F.KH() + (size_t)b * NKEY * 512 + (h * 2 + m) * 64, F.VH() + (size_t)b * NKEY * 512 + h * 128, seq, (LAS char*)F.lds, o);
        if (m == 0) {
            int tid = F.tid; asm volatile("" : "+v"(tid));
            const int lane = tid & 63, wave = __builtin_amdgcn_readfirstlane(tid >> 6), r32 = lane & 31, hi = lane >> 5;
            float* scr = F.SCR() + (size_t)F.bid * 256 * 128 + (size_t)(wave * 32) * 128;
#pragma unroll
            for (int r = 0; r < 16; ++r)
#pragma unroll
                for (int d0 = 0; d0 < 4; ++d0) scr[crow(r, hi) * 128 + d0 * 32 + r32] = o[d0][r];
            asm volatile("s_waitcnt vmcnt(0)" ::: "memory");
        }
    }
    int tid = F.tid; asm volatile("" : "+v"(tid));
    const int lane = tid & 63, wave = __builtin_amdgcn_readfirstlane(tid >> 6), r32 = lane & 31, hi = lane >> 5;
    const float lam = F.LP()[L * 16 + 0], oscale = F.LP()[L * 16 + 1];
    const float* scr = F.SCR() + (size_t)F.bid * 256 * 128 + (size_t)(wave * 32) * 128;
    float sg[4];
#pragma unroll
    for (int d0 = 0; d0 < 4; ++d0) sg[d0] = F.subg()[L * 128 + d0 * 32 + r32] * oscale;
#pragma unroll
    for (int r = 0; r < 16; ++r) {
        float d[4]; float ss = 0.f;
#pragma unroll
        for (int d0 = 0; d0 < 4; ++d0) { d[d0] = scr[crow(r, hi) * 128 + d0 * 32 + r32] - lam * o[d0][r]; ss += d[d0] * d[d0]; }
        const float rs = rsqrtf(half_sum32(ss) * (1.f / 128.f) + EPS);
        bf16* mr = F.MIX() + (size_t)(qrow0 + wave * 32 + crow(r, hi)) * DM + h * 128;
#pragma unroll
        for (int d0 = 0; d0 < 4; ++d0) mr[d0 * 32 + r32] = (bf16)f2bf(d[d0] * rs * sg[d0]);
    }
}


constexpr int NPH_L = 12, NPHASE = 2 + DEPTH * NPH_L;
struct Args { const float* in[25]; float* out; unsigned char* ws; int gp_lo, gp_hi; };
__global__ void __launch_bounds__(NTHR, 2) fwd(Args args) {
    extern __shared__ __attribute__((aligned(16))) unsigned char lds[];
    Frame F;
    F.lds = (LAS unsigned char*)lds;
    F.tid = threadIdx.x; F.lane = F.tid & 63; F.wave = __builtin_amdgcn_readfirstlane(F.tid >> 6); F.bid = blockIdx.x; F.G = gridDim.x;
    F.in = args.in; F.out = args.out; F.ws = args.ws;
    unsigned char* ws = args.ws;
    volatile LAS unsigned* MISC = (volatile LAS unsigned*)(F.lds + MISC_OFF);
    for (int u = F.tid; u < (LDS_BYTES - RING_BYTES) / 4; u += NTHR) ((LAS unsigned*)(F.lds + RING_BYTES))[u] = 0u;
    __syncthreads();
#if MK_ONE_LAUNCH
    constexpr int lo = 0, hi = NPHASE;
#else
    const int lo = args.gp_lo, hi = args.gp_hi;
#endif
    unsigned* barw = (unsigned*)(ws + WS_CTL) + CW_BAR;
    XcdBarrier bar; bar.bar = barw; bar.x = 0; bar.st = nullptr;
    if (hi - lo > 1) bar = xcd_barrier_post(barw, MISC + 8);
#ifndef N_CV_N2
#define N_CV_N2 2
#endif
#ifndef N_CV_INP
#define N_CV_INP 1
#endif
#ifndef N_CV_OUT
#define N_CV_OUT 1
#endif
#ifndef N_CV_TOPK
#define N_CV_TOPK 1
#endif
#ifndef N_CV_DOWN
#define N_CV_DOWN 1
#endif
#ifndef PHM
#define PHM 0xFFFF
#endif
#define PB(i) (((PHM) >> (i)) & 1)
#ifndef DBLM
#define DBLM 0
#endif
#define REP(i) for (int rep_ = 0; rep_ < ((((DBLM) >> (i)) & 1) ? 2 : 1); ++rep_)
#define IN(k) (lo <= (k) && (k) < hi)
#ifndef BARX
#define BARX 1
#endif
#define SEAM(k) do { if (IN(k) && IN((k) + 1)) { for (int bx_ = 0; bx_ < BARX; ++bx_) xcd_barrier(bar); } } while (0)

    if (PB(0) && IN(0)) REP(0) ph_prologue(F);
    SEAM(0);
    if (PB(1) && IN(1)) REP(1) ph_norm1_first(F);
    SEAM(1);
    for (int L = 0; L < DEPTH; ++L) {
        const int base = 2 + NPH_L * L;
#define FRESH() do { F.tid = threadIdx.x; asm volatile("" : "+v"(F.tid)); F.lane = F.tid & 63; } while (0)
        if (PB(2) && IN(base + 0)) REP(2) {
            pg8::Gemm g{F.HN(), F.WIN() + (size_t)L * INC * DM, NROW, INC, DM}; pg8::StaticOrder S; S.init(NROW, INC, F.G, F.bid);
            EpiZ E{F.Z(), F.VH(), F.QH(), F.KH(), F.LP() + DEPTH * 16 + L * 128, F.ROPE()};
            pg8::gemm_phase<EpiZ, pg8::StaticOrder, true, true>(F.lds, g, S, E);
            if (F.bid >= (66 * 13) % 256) { FRESH(); conv_n(F, N_CV_INP); }
        }
        SEAM(base + 0);
        if (PB(3) && IN(base + 1)) REP(3) {
            FRESH();
            for (int u = F.bid; u < 1056; u += F.G) {
                const int v = u < 528 ? u : u - 528; const int b = v / 264, hh = (v / NCH) & 3, cc = v % NCH;
                if (u < 528) unit_retkv(F, L, b, hh, cc); else if (!(L == DEPTH - 1 && cc < 2)) unit_sg(F, L, b, hh, cc);
            }
        }
        SEAM(base + 1);
        if (PB(5) && IN(base + 3)) REP(5) { FRESH(); ph_scan(F, L); }
        SEAM(base + 3);
        if (PB(6) && IN(base + 4)) REP(6) {
            FRESH();
            for (int u = F.bid; u < 264 + 528; u += F.G) {
                if (u < 264) {
                    int b, hh, qrow0, seq;
                    if (u < 256) { const int bh = u & 7, qb = u >> 3; b = bh >> 2; hh = bh & 3; qrow0 = b * SEQ + qb * 256; seq = NKEY; }
                    else { if (L == DEPTH - 1) continue; const int v = u - 256; b = v >> 2; hh = v & 3; qrow0 = NLAT + b * CTXL; seq = CTXL; }
#ifndef NO_ATTN
                    unit_attn(F, L, b, hh, qrow0, seq);
#endif
                } else {
#ifndef NO_RETOUT
                    const int v = u - 264; if (!(L == DEPTH - 1 && (v % NCH) < 2)) unit_retout(F, L, v / 264, (v / NCH) & 3, v % NCH);
#endif
                }
            }
        }
        SEAM(base + 4);
        if (PB(7) && IN(base + 5)) REP(7) {
            pg8::Gemm g{F.MIX(), F.WOUT() + (size_t)L * DM * DM, NLAT, DM, DM}; pg8::StaticOrder S; S.init(NLAT, DM, F.G, F.bid);
#ifdef PROBE_OUT2
            { EpiResid E0{(bf16*)(F.ws + WS_Y), F.MOD() + (size_t)L * 3 * 6144 + 2048, L == 0 ? F.x_in() : nullptr}; pg8::gemm_phase<EpiResid, pg8::StaticOrder, true, true>(F.lds, g, S, E0); }
#endif
            EpiResid E{F.X(), F.MOD() + (size_t)L * 3 * 6144 + 2048, L == 0 ? F.x_in() : nullptr};
            pg8::gemm_phase<EpiResid, pg8::StaticOrder, true, true>(F.lds, g, S, E);
            if (L < DEPTH - 1) { FRESH(); for (int mu = F.bid; mu < 256; mu += F.G) unit_out_ctx(F, L, mu); }
        }
        SEAM(base + 5);
        if (PB(8) && IN(base + 6)) REP(8) { FRESH(); ph_norm2_router(F, L); if (F.bid >= (((L == DEPTH - 1) ? NLAT : NROW) / 16 + NWAVES - 1) / NWAVES) conv_n(F, N_CV_N2); }
        SEAM(base + 6);
        if (PB(9) && IN(base + 7)) REP(9) { FRESH(); ph_topk(F, L); if (F.bid >= ((L == DEPTH - 1) ? 32 : 64)) conv_n(F, N_CV_TOPK);
            conv_until(F, CONV_SEG0 + (unsigned)(L + 1) * CONV_PER_L); }
        SEAM(base + 7);
        if (PB(11) && IN(base + 9)) REP(11) {
            pg8::Gemm g{F.HN(), F.WGU() + (size_t)L * NE * 4096 * DM, NE * EROWS, NE * 4096, DM};        const int npm = (L == DEPTH - 1) ? 8 : 9; MoeOrder S{F.G, F.bid, 16, npm, NE * npm * 16};
            EpiSwiglu E{F.HH()};
            pg8::gemm_phase_ga<EpiSwiglu, MoeOrder>(F.lds, g, S, E, F.ROWIDX(), NROW, (LAS int*)(F.lds + ISLOT_OFF));
        }
        SEAM(base + 9);
        if (PB(12) && IN(base + 10)) REP(12) {
            pg8::Gemm g{F.HH(), F.WD() + (size_t)L * NE * DM * FF, NE * EROWS, NE * DM, FF}; const int npm = (L == DEPTH - 1) ? 8 : 9; MoeOrder S{F.G, F.bid, 4, npm, NE * npm * 4};
            pg8::EpiBf16<0> E{F.Y(), DM, nullptr, DM, 0, 1.f};
            pg8::gemm_phase<pg8::EpiBf16<0>, MoeOrder, true, true>(F.lds, g, S, E);
            if (L < DEPTH - 1 && F.bid >= 64) { FRESH(); conv_n(F, N_CV_DOWN); }
        }
        SEAM(base + 10);
        if (PB(13) && IN(base + 11)) REP(13) { FRESH(); ph_combine(F, L); }
        SEAM(base + 11);
    }
#undef IN
#undef SEAM
}

extern "C" void kernel_launch(void* const* d_in, const int* in_sizes, int n_in, void* d_out, int out_size, void* d_ws, size_t ws_size, hipStream_t stream) {
    static int grid = 0;
    if (grid == 0) {
        if (n_in != 25 || in_sizes[0] != NLAT * DM || out_size != NLAT * DM || ws_size < WS_END) {
            fprintf(stderr, "kernel_launch: built for 25 inputs, x/out of %d floats, >= %zu bytes of workspace; got n_in %d, in0 %d, out %d, ws %zu; nothing launched\n", NLAT * DM, (size_t)WS_END, n_in, n_in > 0 ? in_sizes[0] : -1, out_size, ws_size);
            grid = -1; return; }
        int dev = 0, cus = 0, per_cu = 0;
        if (hipGetDevice(&dev) != hipSuccess || hipDeviceGetAttribute(&cus, hipDeviceAttributeMultiprocessorCount, dev) != hipSuccess) { fprintf(stderr, "kernel_launch: device query failed\n"); grid = -1; return; }
        if (hipFuncSetAttribute((const void*)fwd, hipFuncAttributeMaxDynamicSharedMemorySize, LDS_BYTES) != hipSuccess) { fprintf(stderr, "kernel_launch: hipFuncSetAttribute failed\n"); grid = -1; return; }
        if (hipOccupancyMaxActiveBlocksPerMultiprocessor(&per_cu, (const void*)fwd, NTHR, LDS_BYTES) != hipSuccess || per_cu < 1)
            fprintf(stderr, "kernel_launch: note: occupancy query reports %d workgroups per CU\n", per_cu);
        (void)hipGetLastError();
        grid = cus;
    }
    if (grid < 0) return;
    if (hipMemsetAsync((char*)d_ws + WS_CTL, 0, CTL_ZERO_BYTES, stream) != hipSuccess) { fprintf(stderr, "kernel_launch: memset failed\n"); return; }
    Args a{};
    for (int i = 0; i < 25; ++i) a.in[i] = (const float*)d_in[i];
    a.out = (float*)d_out; a.ws = (unsigned char*)d_ws;
#if MK_ONE_LAUNCH
    a.gp_lo = 0; a.gp_hi = NPHASE;
    hipLaunchKernelGGL(fwd, dim3(grid), dim3(NTHR), LDS_BYTES, stream, a);
#else
    for (int gp = 0; gp < NPHASE; ++gp) { a.gp_lo = gp; a.gp_hi = gp + 1; hipLaunchKernelGGL(fwd, dim3(grid), dim3(NTHR), LDS_BYTES, stream, a); }
#endif
    const hipError_t le = hipPeekAtLastError();
    if (le != hipSuccess) fprintf(stderr, "kernel_launch: launch failed: %s\n", hipGetErrorName(le));
}
```

```cpp
#include <hip/hip_runtime.h>
#include <cstdio>
#include <cstdint>
#ifndef MK_ONE_LAUNCH
#define MK_ONE_LAUNCH 1
#endif
namespace pg8 {
#define PG8_LAS __attribute__((address_space(3)))
typedef unsigned short bf16_t;
typedef short bf16x8 __attribute__((ext_vector_type(8)));
typedef float f32x4 __attribute__((ext_vector_type(4)));
typedef unsigned u32x4 __attribute__((ext_vector_type(4)));
constexpr int BM = 256, BK = 64, HALF = 128, HTB = HALF * BK * 2  , STAGE_BYTES = 8 * HTB, NXCD = 8, WGM = 8;

__host__ __device__ __forceinline__ int lds_byte(int r, int c) { const int st = (r >> 4) * 2 + (c >> 5), rr = r & 15, cc = c & 31, ob = rr * 64 + cc * 2; return st * 1024 + (ob ^ (((ob >> 9) & 1) << 5)); }
__host__ __device__ __forceinline__ void stage_rc(int b, int& R, int& C) { const int st = b / 1024, sb = b % 1024, swz = sb ^ (((sb >> 9) & 1) << 5); R = (st >> 1) * 16 + swz / 64; C = (st & 1) * 32 + (swz % 64) / 2; }
__host__ __device__ __forceinline__ int perm32(int rho) { const int n = rho >> 4, i = rho & 15; return 8 * (i >> 2) + 4 * n + (i & 3); }

struct Unit { int pm, pn; };
struct Gemm { const bf16_t* A; const bf16_t* Bt; int M, N, K; };

struct StaticOrder {
    int nM, nN, nwg, G, c;
    __host__ __device__ void init(int M, int N, int G_, int c_) { nM = M / BM; nN = N / BM; nwg = nM * nN; G = G_; c = c_; }
    __host__ __device__ bool next(int i, Unit& u) const {
        const long L = (long)i * G + c; if (L >= nwg) return false;
        int wgid = (int)L; { const int q = nwg / NXCD, r = nwg % NXCD, xcd = wgid % NXCD, off = wgid / NXCD; wgid = (xcd < r ? xcd * (q + 1) : r * (q + 1) + (xcd - r) * q) + off; }
        const int nig = WGM * nN, gid = wgid / nig, fm = gid * WGM, gsz = (nM - fm) < WGM ? (nM - fm) : WGM;
        u.pm = fm + ((wgid % nig) % gsz); u.pn = (wgid % nig) / gsz; return true;
    }
    __device__ __forceinline__ void a_ready(const Unit&) const {}
    __device__ __forceinline__ void done(const Unit&) const {}
    __device__ __forceinline__ bool half_only(const Unit&) const { return false; }
};

__device__ __forceinline__ unsigned cvt_pk_bf16(float lo, float hi) { unsigned r; asm volatile("v_cvt_pk_bf16_f32 %0, %1, %2" : "=v"(r) : "v"(lo), "v"(hi)); return r; }
typedef float f32x2 __attribute__((ext_vector_type(2)));
__device__ __forceinline__ f32x2 gelu_pk(f32x2 v) {
    const f32x2 av = __builtin_elementwise_abs(v), d = av * 0.2316418882f + 1.0f;
    f32x2 t; t.x = __builtin_amdgcn_rcpf(d.x); t.y = __builtin_amdgcn_rcpf(d.y);
    f32x2 q = t * 0.5307027145f + (-0.7265760135f); q = q * t + 0.7107068705f; q = q * t + (-0.142248368f); q = q * t + 0.127414796f; q = q * t;
    const f32x2 s = (v * v) * (-0.72134752044f);
    f32x2 e; e.x = __builtin_amdgcn_exp2f(s.x); e.y = __builtin_amdgcn_exp2f(s.y);
    const f32x2 m = v * (q * e), r = v - m;
    f32x2 o; o.x = v.x < 0.f ? m.x : r.x; o.y = v.y < 0.f ? m.y : r.y; return o;
}

template <int ACT  > struct EpiBf16 {
    static constexpr bool PERM = true, AFTER_DRAIN = false; static_assert(ACT == 0 || ACT == 1, "EpiBf16: ACT is 0 (none) or 1 (gelu_pk)");
    bf16_t* O; int ldc; const float* bias; int split_cols; size_t split_stride; float scale0;
    __device__ __forceinline__ void operator()(const f32x4 (&acc)[2][2][4][2], const Unit& u, int wr, int wc, int fr, int fq) const {
        const int row0 = u.pm * BM + wr * 64 + fr; int colt = u.pn * BM; bf16_t* base = O;
        float sc = 1.f; if (split_cols) { const int t = colt / split_cols; base += (size_t)t * split_stride; colt -= t * split_cols; if (t == 0) sc = scale0; }
        const int col0 = colt + wc * 32 + 8 * fq, bcol0 = u.pn * BM + wc * 32 + 8 * fq;
        f32x4 bv[2][2];
#pragma unroll
        for (int bj = 0; bj < 2; ++bj)
#pragma unroll
            for (int n = 0; n < 2; ++n) bv[bj][n] = bias ? *(const f32x4*)(bias + bcol0 + bj * HALF + 4 * n) : (f32x4){0.f, 0.f, 0.f, 0.f};
#pragma unroll
        for (int ai = 0; ai < 2; ++ai)
#pragma unroll
            for (int m = 0; m < 4; ++m) { bf16_t* rowp = base + (size_t)(row0 + ai * HALF + m * 16) * ldc + col0;
#pragma unroll
                for (int bj = 0; bj < 2; ++bj) { f32x4 v0 = acc[ai][bj][m][0] + bv[bj][0], v1 = acc[ai][bj][m][1] + bv[bj][1];
                    if (ACT == 1) { f32x2 a = gelu_pk((f32x2){v0[0], v0[1]}), b = gelu_pk((f32x2){v0[2], v0[3]}), c = gelu_pk((f32x2){v1[0], v1[1]}), d = gelu_pk((f32x2){v1[2], v1[3]});
                        v0 = (f32x4){a.x, a.y, b.x, b.y}; v1 = (f32x4){c.x, c.y, d.x, d.y}; }
                    v0 = v0 * sc; v1 = v1 * sc; u32x4 w; w.x = cvt_pk_bf16(v0[0], v0[1]); w.y = cvt_pk_bf16(v0[2], v0[3]); w.z = cvt_pk_bf16(v1[0], v1[1]); w.w = cvt_pk_bf16(v1[2], v1[3]);
                    *(u32x4*)(rowp + bj * HALF) = w; } }
    }
};
template <class Epi, class Sched, bool ALIGN_EPI = false, bool SP2 = false>
__device__ __forceinline__ void gemm_phase(PG8_LAS unsigned char* lds, const Gemm g, const Sched& S, const Epi& E) {
    int tid = threadIdx.x; asm volatile("" : "+v"(tid));
    const int wid = __builtin_amdgcn_readfirstlane(tid >> 6), lane = tid & 63, wr = wid >> 2, wc = wid & 3, fr = lane & 15, fq = lane >> 4;
    const int K = g.K, nt = K / BK;
    unsigned voffA[2], voffB[2];
#pragma unroll
    for (int i = 0; i < 2; ++i) { int R, C; stage_rc(tid * 16 + i * 8192, R, C); const int Rb = Epi::PERM ? ((R & ~31) + perm32(R & 31)) : R;
        voffA[i] = (unsigned)(R * K + C) * 2u; voffB[i] = (unsigned)(Rb * K + C) * 2u; }
    const size_t kstep = (size_t)(BK * 2);
    const size_t hstep = (size_t)HALF * K * 2;
    const size_t tstep = 2 * hstep;
    const unsigned ldsw = (unsigned)wid * 1024u;
    const int aoff = lds_byte(wr * 64 + fr, fq * 8), boff = lds_byte(wc * 32 + fr, fq * 8);
#define PG8_SA(b, h) (((b) * 2 + (h)) * HTB)
#define PG8_SB(b, h) ((4 + (b) * 2 + (h)) * HTB)
#define PG8_STAGE(bufoff, gbase, voff) do { _Pragma("unroll") for (int _i = 0; _i < 2; ++_i) \
        __builtin_amdgcn_global_load_lds((const unsigned*)((const char*)(gbase) + (voff)[_i]), (PG8_LAS unsigned*)(lds + (bufoff) + ldsw + _i * 8192), 16, 0, 0); } while (0)
#define PG8_LDA(dst, b, h) do { _Pragma("unroll") for (int m = 0; m < 4; ++m) _Pragma("unroll") for (int k = 0; k < 2; ++k) dst[m][k] = *(const PG8_LAS bf16x8*)(lds + PG8_SA(b, h) + aoff + m * 2048 + k * 1024); } while (0)
#define PG8_LDB(dst, b, h) do { _Pragma("unroll") for (int n = 0; n < 2; ++n) _Pragma("unroll") for (int k = 0; k < 2; ++k) dst[n][k] = *(const PG8_LAS bf16x8*)(lds + PG8_SB(b, h) + boff + n * 2048 + k * 1024); } while (0)
#define PG8_MMA(ai, bj, At, Bt) do { __builtin_amdgcn_s_setprio(1); _Pragma("unroll") for (int m = 0; m < 4; ++m) _Pragma("unroll") for (int n = 0; n < 2; ++n) _Pragma("unroll") for (int k = 0; k < 2; ++k) \
        acc[ai][bj][m][n] = __builtin_amdgcn_mfma_f32_16x16x32_bf16(Bt[n][k], At[m][k], acc[ai][bj][m][n], 0, 0, 0); __builtin_amdgcn_s_setprio(0); } while (0)
#define PG8_WAIT_V(n) asm volatile("s_waitcnt vmcnt(" #n ")" ::: "memory")
#define PG8_WAIT_L(n) asm volatile("s_waitcnt lgkmcnt(" #n ")" ::: "memory")
#define PG8_BAR __builtin_amdgcn_s_barrier()
#define PG8_SCHED __builtin_amdgcn_sched_barrier(0)
    Unit cur, nxt; int ui = 0;
    if (!S.next(0, cur)) return;
    f32x4 acc[2][2][4][2];
#pragma unroll
    for (int a = 0; a < 2; ++a)
#pragma unroll
        for (int b = 0; b < 2; ++b)
#pragma unroll
            for (int m = 0; m < 4; ++m)
#pragma unroll
                for (int n = 0; n < 2; ++n) acc[a][b][m][n] = (f32x4){0.f, 0.f, 0.f, 0.f};
    bf16x8 At[4][2], B0[2][2], B1[2][2];
    const char* cA = (const char*)g.A + (size_t)cur.pm * tstep; const char* cB = (const char*)g.Bt + (size_t)cur.pn * tstep;
    S.a_ready(cur);
    if constexpr (SP2) {
        PG8_STAGE(PG8_SB(0, 0), cB, voffB); PG8_STAGE(PG8_SB(0, 1), cB + hstep, voffB); PG8_STAGE(PG8_SA(0, 0), cA, voffA); PG8_STAGE(PG8_SA(0, 1), cA + hstep, voffA);
        if (wr == 1) PG8_BAR;
        PG8_WAIT_V(2); PG8_BAR;
        PG8_STAGE(PG8_SB(1, 0), cB + kstep, voffB); PG8_STAGE(PG8_SA(1, 0), cA + kstep, voffA); PG8_STAGE(PG8_SB(1, 1), cB + hstep + kstep, voffB);
        PG8_WAIT_V(6); PG8_BAR;
    } else {
        PG8_STAGE(PG8_SB(0, 0), cB, voffB); PG8_STAGE(PG8_SA(0, 0), cA, voffA); PG8_STAGE(PG8_SB(0, 1), cB + hstep, voffB); PG8_STAGE(PG8_SA(0, 1), cA + hstep, voffA);
        if (wr == 1) PG8_BAR;
        PG8_WAIT_V(4); PG8_BAR;
        PG8_STAGE(PG8_SB(1, 0), cB + kstep, voffB); PG8_STAGE(PG8_SA(1, 0), cA + kstep, voffA); PG8_STAGE(PG8_SB(1, 1), cB + hstep + kstep, voffB);
        PG8_WAIT_V(6); PG8_BAR;
    }
    for (;;) {
        const bool has_next = S.next(ui + 1, nxt);
        const bool ho = S.half_only(cur);
        const char* nA = has_next ? (const char*)g.A + (size_t)nxt.pm * tstep : cA; const char* nB = has_next ? (const char*)g.Bt + (size_t)nxt.pn * tstep : cB;
        for (int t = 0; t < nt; t += 2) {
            const bool last = (t == nt - 2);
            const char* a1 = cA + (size_t)(t + 1) * kstep;
            const char* a2 = last ? nA : cA + (size_t)(t + 2) * kstep; const char* b2 = last ? nB : cB + (size_t)(t + 2) * kstep;
            const char* a3 = a2 + kstep; const char* b3 = b2 + kstep;
            if (last && has_next) S.a_ready(nxt);
            if constexpr (SP2) {
            PG8_LDB(B0, 0, 0); PG8_LDB(B1, 0, 1); PG8_SCHED; PG8_LDA(At, 0, 0); PG8_STAGE(PG8_SA(1, 1), a1 + hstep, voffA);
            PG8_WAIT_V(8); PG8_WAIT_L(0); PG8_BAR; PG8_MMA(0, 0, At, B0); PG8_MMA(0, 1, At, B1); PG8_BAR; PG8_SCHED;
            PG8_LDA(At, 0, 1); PG8_STAGE(PG8_SB(0, 0), b2, voffB); PG8_STAGE(PG8_SB(0, 1), b2 + hstep, voffB); PG8_STAGE(PG8_SA(0, 0), a2, voffA);
            PG8_WAIT_V(8); PG8_WAIT_L(0); PG8_BAR; if (!ho) { PG8_MMA(1, 0, At, B0); PG8_MMA(1, 1, At, B1); } PG8_BAR; PG8_SCHED;
            PG8_LDB(B0, 1, 0); PG8_LDB(B1, 1, 1); PG8_SCHED; PG8_LDA(At, 1, 0); PG8_STAGE(PG8_SA(0, 1), a2 + hstep, voffA);
            PG8_WAIT_V(8); PG8_WAIT_L(0); PG8_BAR; PG8_MMA(0, 0, At, B0); PG8_MMA(0, 1, At, B1); PG8_BAR; PG8_SCHED;
            PG8_LDA(At, 1, 1); PG8_STAGE(PG8_SB(1, 0), b3, voffB); PG8_STAGE(PG8_SB(1, 1), b3 + hstep, voffB); PG8_STAGE(PG8_SA(1, 0), a3, voffA);
            PG8_WAIT_V(8); PG8_WAIT_L(0); PG8_BAR; if (!ho) { PG8_MMA(1, 0, At, B0); PG8_MMA(1, 1, At, B1); } PG8_BAR; PG8_SCHED;
            } else {
            PG8_LDB(B0, 0, 0); PG8_SCHED; PG8_LDA(At, 0, 0); PG8_STAGE(PG8_SA(1, 1), a1 + hstep, voffA);
            PG8_WAIT_L(8); PG8_BAR; PG8_WAIT_L(0); PG8_MMA(0, 0, At, B0); PG8_BAR; PG8_SCHED;
            PG8_LDB(B1, 0, 1); PG8_STAGE(PG8_SB(0, 0), b2, voffB);
            PG8_BAR; PG8_WAIT_L(0); PG8_MMA(0, 1, At, B1); PG8_BAR;
            PG8_LDA(At, 0, 1); PG8_STAGE(PG8_SA(0, 0), a2, voffA);
            PG8_BAR; PG8_WAIT_L(0); PG8_MMA(1, 0, At, B0); PG8_BAR; PG8_SCHED;
            PG8_STAGE(PG8_SB(0, 1), b2 + hstep, voffB);
            PG8_WAIT_V(6); PG8_BAR; PG8_MMA(1, 1, At, B1); PG8_BAR;
            PG8_LDB(B0, 1, 0); PG8_SCHED; PG8_LDA(At, 1, 0); PG8_STAGE(PG8_SA(0, 1), a2 + hstep, voffA);
            PG8_WAIT_L(8); PG8_BAR; PG8_WAIT_L(0); PG8_MMA(0, 0, At, B0); PG8_BAR; PG8_SCHED;
            PG8_LDB(B1, 1, 1); PG8_STAGE(PG8_SB(1, 0), b3, voffB);
            PG8_BAR; PG8_WAIT_L(0); PG8_MMA(0, 1, At, B1); PG8_BAR;
            PG8_LDA(At, 1, 1); PG8_STAGE(PG8_SA(1, 0), a3, voffA);
            PG8_BAR; PG8_WAIT_L(0); PG8_MMA(1, 0, At, B0); PG8_BAR; PG8_SCHED;
            PG8_STAGE(PG8_SB(1, 1), b3 + hstep, voffB);
            PG8_WAIT_V(6); PG8_BAR; PG8_MMA(1, 1, At, B1); PG8_BAR;
            }
        }
        if constexpr (ALIGN_EPI) { if (wr == 0) PG8_BAR; }
        if constexpr (!Epi::AFTER_DRAIN) { E(acc, cur, wr, wc, fr, fq); S.done(cur); }
        if (!has_next) break;
#pragma unroll
        for (int a = 0; a < 2; ++a)
#pragma unroll
            for (int b = 0; b < 2; ++b)
#pragma unroll
                for (int m = 0; m < 4; ++m)
#pragma unroll
                    for (int n = 0; n < 2; ++n) acc[a][b][m][n] = (f32x4){0.f, 0.f, 0.f, 0.f};
        cur = nxt; cA = nA; cB = nB; ++ui;
        if constexpr (ALIGN_EPI) { if (wr == 1) PG8_BAR; }
    }
    PG8_WAIT_V(0);
    if constexpr (!ALIGN_EPI) { if (wr == 0) PG8_BAR; }
    PG8_BAR;
    if constexpr (Epi::AFTER_DRAIN) { E.fused(acc, cur, wr, wc, fr, fq, lds, wid, lane); S.done(cur); }
#undef PG8_SA
#undef PG8_SB
#undef PG8_STAGE
#undef PG8_LDA
#undef PG8_LDB
#undef PG8_MMA
#undef PG8_WAIT_V
#undef PG8_WAIT_L
#undef PG8_BAR
#undef PG8_SCHED
}
}
namespace pg8 {
template <class Epi, class Sched>
__device__ __forceinline__ void gemm_phase_ga(PG8_LAS unsigned char* lds, const Gemm g, const Sched& S, const Epi& E, const int* rowidx, int zrow, PG8_LAS int* islot) {
    constexpr bool ALIGN_EPI = true;
    int tid = threadIdx.x; asm volatile("" : "+v"(tid));
    const int wid = __builtin_amdgcn_readfirstlane(tid >> 6), lane = tid & 63, wr = wid >> 2, wc = wid & 3, fr = lane & 15, fq = lane >> 4;
    const int K = g.K, nt = K / BK;
    unsigned voffB[2]; int RA[2], CA[2];
#pragma unroll
    for (int i = 0; i < 2; ++i) { int R, C; stage_rc(tid * 16 + i * 8192, R, C); const int Rb = Epi::PERM ? ((R & ~31) + perm32(R & 31)) : R;
        RA[i] = R; CA[i] = C; voffB[i] = (unsigned)(Rb * K + C) * 2u; }
    unsigned voC[2][2], voN[2][2];
    const size_t kstep = (size_t)(BK * 2);
    const size_t hstep = (size_t)HALF * K * 2;
    const size_t tstep = 2 * hstep;
    const unsigned ldsw = (unsigned)wid * 1024u;
    const int aoff = lds_byte(wr * 64 + fr, fq * 8), boff = lds_byte(wc * 32 + fr, fq * 8);
#define PG8_SA(b, h) (((b) * 2 + (h)) * HTB)
#define PG8_SB(b, h) ((4 + (b) * 2 + (h)) * HTB)
#define PG8_STAGE(bufoff, gbase, voff) do { _Pragma("unroll") for (int _i = 0; _i < 2; ++_i) \
        __builtin_amdgcn_global_load_lds((const unsigned*)((const char*)(gbase) + (voff)[_i]), (PG8_LAS unsigned*)(lds + (bufoff) + ldsw + _i * 8192), 16, 0, 0); } while (0)
#define PG8_LDA(dst, b, h) do { _Pragma("unroll") for (int m = 0; m < 4; ++m) _Pragma("unroll") for (int k = 0; k < 2; ++k) dst[m][k] = *(const PG8_LAS bf16x8*)(lds + PG8_SA(b, h) + aoff + m * 2048 + k * 1024); } while (0)
#define PG8_LDB(dst, b, h) do { _Pragma("unroll") for (int n = 0; n < 2; ++n) _Pragma("unroll") for (int k = 0; k < 2; ++k) dst[n][k] = *(const PG8_LAS bf16x8*)(lds + PG8_SB(b, h) + boff + n * 2048 + k * 1024); } while (0)
#define PG8_MMA(ai, bj, At, Bt) do { __builtin_amdgcn_s_setprio(1); _Pragma("unroll") for (int m = 0; m < 4; ++m) _Pragma("unroll") for (int n = 0; n < 2; ++n) _Pragma("unroll") for (int k = 0; k < 2; ++k) \
        acc[ai][bj][m][n] = __builtin_amdgcn_mfma_f32_16x16x32_bf16(Bt[n][k], At[m][k], acc[ai][bj][m][n], 0, 0, 0); __builtin_amdgcn_s_setprio(0); } while (0)
#define PG8_WAIT_V(n) asm volatile("s_waitcnt vmcnt(" #n ")" ::: "memory")
#define PG8_WAIT_L(n) asm volatile("s_waitcnt lgkmcnt(" #n ")" ::: "memory")
#define PG8_BAR __builtin_amdgcn_s_barrier()
#define PG8_SCHED __builtin_amdgcn_sched_barrier(0)
    constexpr bool SP2 = true;
    Unit cur, nxt; int ui = 0;
    if (!S.next(0, cur)) return;
    f32x4 acc[2][2][4][2];
#pragma unroll
    for (int a = 0; a < 2; ++a)
#pragma unroll
        for (int b = 0; b < 2; ++b)
#pragma unroll
            for (int m = 0; m < 4; ++m)
#pragma unroll
                for (int n = 0; n < 2; ++n) acc[a][b][m][n] = (f32x4){0.f, 0.f, 0.f, 0.f};
    bf16x8 At[4][2], B0[2][2], B1[2][2];
    const char* const Ab = (const char*)g.A; const char* cB = (const char*)g.Bt + (size_t)cur.pn * tstep;
    S.a_ready(cur);
#pragma unroll
    for (int h = 0; h < 2; ++h)
#pragma unroll
        for (int i = 0; i < 2; ++i) { const int s = rowidx[cur.pm * BM + h * HALF + RA[i]]; voC[h][i] = (unsigned)((s < 0 ? zrow : s) * K + CA[i]) * 2u; voN[h][i] = voC[h][i]; }
    asm volatile("s_waitcnt vmcnt(0)" ::: "memory");
    if constexpr (SP2) {
        PG8_STAGE(PG8_SB(0, 0), cB, voffB); PG8_STAGE(PG8_SB(0, 1), cB + hstep, voffB); PG8_STAGE(PG8_SA(0, 0), Ab, voC[0]); PG8_STAGE(PG8_SA(0, 1), Ab, voC[1]);
        if (wr == 1) PG8_BAR;
        PG8_WAIT_V(2); PG8_BAR;
        PG8_STAGE(PG8_SB(1, 0), cB + kstep, voffB); PG8_STAGE(PG8_SA(1, 0), Ab + kstep, voC[0]); PG8_STAGE(PG8_SB(1, 1), cB + hstep + kstep, voffB);
        PG8_WAIT_V(6); PG8_BAR;
    }
    for (;;) {
        const bool has_next = S.next(ui + 1, nxt);
        const bool ho = S.half_only(cur);
        const char* nB = has_next ? (const char*)g.Bt + (size_t)nxt.pn * tstep : cB;
        if (has_next && wid == 0) __builtin_amdgcn_global_load_lds((const unsigned*)(rowidx + nxt.pm * BM + lane * 4), (PG8_LAS unsigned*)(islot + ((ui + 1) & 1) * BM), 16, 0, 0);
        for (int t = 0; t < nt; t += 2) {
            const bool last = (t == nt - 2);
            const char* a1 = Ab + (size_t)(t + 1) * kstep;
            const char* a2 = last ? Ab : Ab + (size_t)(t + 2) * kstep; const char* b2 = last ? nB : cB + (size_t)(t + 2) * kstep;
            const char* a3 = a2 + kstep; const char* b3 = b2 + kstep;
            if (last && has_next) { S.a_ready(nxt);
                const PG8_LAS int* sl = islot + ((ui + 1) & 1) * BM;
#pragma unroll
                for (int h = 0; h < 2; ++h)
#pragma unroll
                    for (int i = 0; i < 2; ++i) { const int s = sl[h * HALF + RA[i]]; voN[h][i] = (unsigned)((s < 0 ? zrow : s) * K + CA[i]) * 2u; } }
            unsigned vo2[2][2];
#pragma unroll
            for (int h = 0; h < 2; ++h)
#pragma unroll
                for (int i = 0; i < 2; ++i) vo2[h][i] = last ? voN[h][i] : voC[h][i];
            if constexpr (SP2) {
            PG8_LDB(B0, 0, 0); PG8_LDB(B1, 0, 1); PG8_SCHED; PG8_LDA(At, 0, 0); PG8_STAGE(PG8_SA(1, 1), a1, voC[1]);
            PG8_WAIT_V(8); PG8_WAIT_L(0); PG8_BAR; PG8_MMA(0, 0, At, B0); PG8_MMA(0, 1, At, B1); PG8_BAR; PG8_SCHED;
            PG8_LDA(At, 0, 1); PG8_STAGE(PG8_SB(0, 0), b2, voffB); PG8_STAGE(PG8_SB(0, 1), b2 + hstep, voffB); PG8_STAGE(PG8_SA(0, 0), a2, vo2[0]);
            PG8_WAIT_V(8); PG8_WAIT_L(0); PG8_BAR; if (!ho) { PG8_MMA(1, 0, At, B0); PG8_MMA(1, 1, At, B1); } PG8_BAR; PG8_SCHED;
            PG8_LDB(B0, 1, 0); PG8_LDB(B1, 1, 1); PG8_SCHED; PG8_LDA(At, 1, 0); PG8_STAGE(PG8_SA(0, 1), a2, vo2[1]);
            PG8_WAIT_V(8); PG8_WAIT_L(0); PG8_BAR; PG8_MMA(0, 0, At, B0); PG8_MMA(0, 1, At, B1); PG8_BAR; PG8_SCHED;
            PG8_LDA(At, 1, 1); PG8_STAGE(PG8_SB(1, 0), b3, voffB); PG8_STAGE(PG8_SB(1, 1), b3 + hstep, voffB); PG8_STAGE(PG8_SA(1, 0), a3, vo2[0]);
            PG8_WAIT_V(8); PG8_WAIT_L(0); PG8_BAR; if (!ho) { PG8_MMA(1, 0, At, B0); PG8_MMA(1, 1, At, B1); } PG8_BAR; PG8_SCHED;
            }
        }
        if constexpr (ALIGN_EPI) { if (wr == 0) PG8_BAR; }
        if constexpr (!Epi::AFTER_DRAIN) { E(acc, cur, wr, wc, fr, fq); S.done(cur); }
        if (!has_next) break;
#pragma unroll
        for (int a = 0; a < 2; ++a)
#pragma unroll
            for (int b = 0; b < 2; ++b)
#pragma unroll
                for (int m = 0; m < 4; ++m)
#pragma unroll
                    for (int n = 0; n < 2; ++n) acc[a][b][m][n] = (f32x4){0.f, 0.f, 0.f, 0.f};
        cur = nxt; cB = nB; ++ui;
#pragma unroll
        for (int h = 0; h < 2; ++h)
#pragma unroll
            for (int i = 0; i < 2; ++i) voC[h][i] = voN[h][i];
        if constexpr (ALIGN_EPI) { if (wr == 1) PG8_BAR; }
    }
    PG8_WAIT_V(0);
    if constexpr (!ALIGN_EPI) { if (wr == 0) PG8_BAR; }
    PG8_BAR;
    if constexpr (Epi::AFTER_DRAIN) { E.fused(acc, cur, wr, wc, fr, fq, lds, wid, lane); S.done(cur); }
#undef PG8_SA
#undef PG8_SB
#undef PG8_STAGE
#undef PG8_LDA
#undef PG8_LDB
#undef PG8_MMA
#undef PG8_WAIT_V
#undef PG8_WAIT_L
#undef PG8_BAR
#undef PG8_SCHED
}
}

constexpr int DM = 1024, NB = 2, SEQ = 8192, CTXL = 256, DEPTH = 4;
constexpr int NLAT = NB * SEQ, NCTX = NB * CTXL, NROW = NLAT + NCTX;
constexpr int INC = 3328, NKEY = CTXL + SEQ;
constexpr int NE = 16, FF = 2048, EROWS = 2304;
constexpr int NCH = 66;
constexpr float EPS = 1e-6f;
constexpr int ZQ = 0, ZK = 512, ZV = 1024, ZRQ = 1536, ZRK = 1792, ZRV = 2048, ZGF = 2304, ZGB = 2560, ZSU = 2816, ZSV = 3072;
constexpr int NWAVES = 8, NTHR = 512;
constexpr int RWLD = DM + 8;

constexpr size_t MiB = 1u << 20;
constexpr size_t WS_CTL = 0, CTL_ZERO_BYTES = 1 * MiB;
constexpr size_t WS_MOD = 1 * MiB;
constexpr size_t WS_LP = WS_MOD + 512 * 1024;
constexpr size_t WS_ROPE = 2 * MiB, WS_RETT = 4 * MiB;
constexpr size_t WS_SGW = 6 * MiB;
constexpr size_t WS_RWS = 7 * MiB;
constexpr size_t WS_WIN = 8 * MiB;
constexpr size_t WS_WOUT = WS_WIN + 26 * MiB;
constexpr size_t WS_WGU = WS_WOUT + 8 * MiB;
constexpr size_t WS_WD = WS_WGU + 512 * MiB;
constexpr size_t WS_X = WS_WD + 256 * MiB;
constexpr size_t WS_HN = WS_X + 66 * MiB;
constexpr size_t WS_Z = WS_HN + 34 * MiB;
constexpr size_t WS_QH = WS_Z + 108 * MiB;
constexpr size_t WS_KH = WS_QH + 17 * MiB;
constexpr size_t WS_VH = WS_KH + 17 * MiB;
constexpr size_t WS_RQ = WS_VH + 17 * MiB;
constexpr size_t WS_RK = WS_RQ + 9 * MiB;
constexpr size_t WS_SVN = WS_RK + 9 * MiB;
constexpr size_t WS_KVT = WS_SVN + 9 * MiB;
constexpr size_t WS_SPREV = WS_KVT + 17 * MiB;
constexpr size_t WS_MIX = WS_SPREV + 17 * MiB;
constexpr size_t WS_SCR = WS_MIX + 33 * MiB;
constexpr size_t WS_AFF = WS_SCR + 32 * MiB;
constexpr size_t WS_SLOT = WS_AFF + 2 * MiB;
constexpr size_t WS_ROWIDX = WS_SLOT + 2 * MiB;
constexpr size_t WS_GATE = WS_ROWIDX + 1 * MiB;
constexpr size_t WS_XS = WS_GATE + 1 * MiB;
constexpr size_t WS_HH = WS_XS + 72 * MiB;
constexpr size_t WS_Y = WS_HH + 144 * MiB;
constexpr size_t WS_END = WS_Y + 72 * MiB;
static_assert((size_t)4 * INC * DM * 2 <= 26 * MiB && (size_t)NROW * DM * 4 <= 66 * MiB && (size_t)NROW * INC * 2 <= 108 * MiB && (size_t)NROW * 512 * 2 <= 17 * MiB, "ws map");
static_assert((size_t)NB * 4 * 2 * NCH * 4096 * 4 <= 17 * MiB && (size_t)NE * EROWS * DM * 2 <= 72 * MiB && (size_t)NE * EROWS * FF * 2 <= 144 * MiB, "ws map");
constexpr int CW_BAR = 4096;

constexpr int RING_BYTES = 131072;
constexpr int MISC_OFF = RING_BYTES + 320;
constexpr int ISLOT_OFF = RING_BYTES + 1024;
constexpr int LDS_BYTES = 147456;

#define GAS __attribute__((address_space(1)))
#define LAS __attribute__((address_space(3)))
typedef unsigned short bf16;
typedef unsigned v4u __attribute__((ext_vector_type(4)));
typedef float f32x4 __attribute__((ext_vector_type(4)));
typedef short bf16x8 __attribute__((ext_vector_type(8)));
typedef GAS unsigned gu32;
typedef GAS unsigned long long gu64;
#define RLX_AGENT __ATOMIC_RELAXED, __HIP_MEMORY_SCOPE_AGENT
#define LDS_WAIT() asm volatile("s_waitcnt lgkmcnt(0)" ::: "memory")
#define VM_WAIT() asm volatile("s_waitcnt vmcnt(0)" ::: "memory")
__device__ __forceinline__ unsigned long long rt() { return __builtin_amdgcn_s_memrealtime(); }
__device__ __forceinline__ unsigned f2bf(float f) { unsigned u = __builtin_bit_cast(unsigned, f); return (u + 0x7fffu + ((u >> 16) & 1u)) >> 16; }
__device__ __forceinline__ unsigned pk2(float lo, float hi) { return f2bf(lo) | (f2bf(hi) << 16); }

#define XB_TMO      128
#define XB_XCNT(j)  (256  + 64 * (j))
#define XB_XSUB(j)  (1280 + 64 * (j))
#define XB_XGEN(j)  (2304 + 64 * (j))
#define XB_TOP      3328
#define XB_TOPGEN   3392
#define XCD_BAR_WORDS 3456
#define XB_SPIN_CAP (1u << 18)

__device__ __forceinline__ unsigned xb_ld(unsigned* p)              { return __hip_atomic_load(p, __ATOMIC_RELAXED, __HIP_MEMORY_SCOPE_AGENT); }
__device__ __forceinline__ unsigned xb_add(unsigned* p, unsigned v) { return __hip_atomic_fetch_add(p, v, __ATOMIC_RELAXED, __HIP_MEMORY_SCOPE_AGENT); }
__device__ __forceinline__ unsigned xb_xcc_id() { return (unsigned)__builtin_amdgcn_s_getreg((3 << 11) | 20) & 0xFu; }
#define XB_SPIN(cond, bar) do { unsigned _sp = 0; while (cond) { __builtin_amdgcn_s_sleep(1); \
    if ((++_sp & 255u) == 0u) { if (xb_ld(&(bar)[XB_TMO])) break; if (_sp > XB_SPIN_CAP) { atomicAdd(&(bar)[XB_TMO], 1u); break; } } } } while (0)

struct XcdBarrier {
    unsigned* bar; unsigned x;
    volatile LAS unsigned* st;
};

__device__ __forceinline__ XcdBarrier xcd_barrier_post(unsigned* bar, volatile LAS unsigned* st) {
    XcdBarrier b; b.bar = bar; b.x = xb_xcc_id(); b.st = st;
    if (threadIdx.x == 0) (void)xb_add(&bar[XB_XCNT(b.x)], 1u);
    return b;
}
__device__ __forceinline__ void xcd_barrier_complete(unsigned* bar, unsigned x, unsigned& nloc, unsigned& nx) {
    const unsigned G = gridDim.x * gridDim.y * gridDim.z;
    unsigned sum, cnt, mine, sp = 0u;
    for (;;) {
        sum = 0u; cnt = 0u; mine = 0u;
#pragma unroll
        for (unsigned j = 0; j < 16; ++j) { const unsigned c = xb_ld(&bar[XB_XCNT(j)]); sum += c; cnt += (c > 0u) ? 1u : 0u; mine = (j == x) ? c : mine; }
        if (sum == G) break;
        __builtin_amdgcn_s_sleep(1);
        if ((++sp & 255u) == 0u) { if (xb_ld(&bar[XB_TMO])) break; if (sp > XB_SPIN_CAP) { atomicAdd(&bar[XB_TMO], 1u); break; } }
    }
    nloc = mine > 0u ? mine : 1u; nx = cnt > 0u ? cnt : 1u;
}

__device__ __forceinline__ void xcd_barrier(const XcdBarrier& b) {
    asm volatile("s_waitcnt vmcnt(0)" ::: "memory");
    __syncthreads();
    if (threadIdx.x == 0) {
        unsigned* bar = b.bar;
        __builtin_amdgcn_s_waitcnt(0);
        unsigned nloc = b.st[0], nx = b.st[1];
        if (nloc == 0u) { xcd_barrier_complete(bar, b.x, nloc, nx); b.st[0] = nloc; b.st[1] = nx; }
        const unsigned old = xb_add(&bar[XB_XSUB(b.x)], 1u);
        const unsigned gen = old / nloc;
        if (old + 1u == (gen + 1u) * nloc) {
            __builtin_amdgcn_fence(__ATOMIC_RELEASE, "agent");
            asm volatile("s_waitcnt vmcnt(0)" ::: "memory");
            const unsigned og = xb_add(&bar[XB_TOP], 1u);
            const unsigned tg = og / nx;
            if (og + 1u == (tg + 1u) * nx) xb_add(&bar[XB_TOPGEN], 1u);
            else XB_SPIN(xb_ld(&bar[XB_TOPGEN]) == tg, bar);
            __builtin_amdgcn_fence(__ATOMIC_ACQUIRE, "agent");
            xb_add(&bar[XB_XGEN(b.x)], 1u);
            asm volatile("s_waitcnt vmcnt(0)" ::: "memory");
        } else {
            XB_SPIN(xb_ld(&bar[XB_XGEN(b.x)]) == gen, bar);
            __builtin_amdgcn_fence(__ATOMIC_ACQUIRE, "agent");
            asm volatile("s_waitcnt vmcnt(0)" ::: "memory");
        }
    }
    __syncthreads();
}

typedef float f32x16 __attribute__((ext_vector_type(16)));
typedef short s16x4 __attribute__((ext_vector_type(4)));
typedef unsigned short u16x4 __attribute__((ext_vector_type(4)));
struct Frame {
    LAS unsigned char* lds;
    int tid, lane, wave, bid, G;
    const float* const* in;
    float* out;
    unsigned char* ws;
    __device__ __forceinline__ const float* x_in() const { return in[0]; }
    __device__ __forceinline__ const float* c_in() const { return in[1]; }
    __device__ __forceinline__ const float* ctx_in() const { return in[2]; }
    __device__ __forceinline__ const float* cctx_in() const { return in[3]; }
    __device__ __forceinline__ const float* w_mod() const { return in[4]; }
    __device__ __forceinline__ const float* b_mod() const { return in[5]; }
    __device__ __forceinline__ const float* n1g() const { return in[6]; }
    __device__ __forceinline__ const float* n2g() const { return in[7]; }
    __device__ __forceinline__ const float* w_in() const { return in[8]; }
    __device__ __forceinline__ const float* w_out() const { return in[9]; }
    __device__ __forceinline__ const float* qng() const { return in[10]; }
    __device__ __forceinline__ const float* kng() const { return in[11]; }
    __device__ __forceinline__ const float* lq1() const { return in[12]; }
    __device__ __forceinline__ const float* lk1() const { return in[13]; }
    __device__ __forceinline__ const float* lq2() const { return in[14]; }
    __device__ __forceinline__ const float* lk2() const { return in[15]; }
    __device__ __forceinline__ const float* subg() const { return in[16]; }
    __device__ __forceinline__ const float* retd() const { return in[17]; }
    __device__ __forceinline__ const float* sgng() const { return in[18]; }
    __device__ __forceinline__ const float* sgw() const { return in[19]; }
    __device__ __forceinline__ const float* sgb() const { return in[20]; }
    __device__ __forceinline__ const float* rw() const { return in[21]; }
    __device__ __forceinline__ const float* wg() const { return in[22]; }
    __device__ __forceinline__ const float* wu() const { return in[23]; }
    __device__ __forceinline__ const float* wd() const { return in[24]; }
    __device__ __forceinline__ float* MOD() const { return (float*)(ws + WS_MOD); }
    __device__ __forceinline__ float* LP() const { return (float*)(ws + WS_LP); }
    __device__ __forceinline__ float* ROPE() const { return (float*)(ws + WS_ROPE); }
    __device__ __forceinline__ float* RETT() const { return (float*)(ws + WS_RETT); }
    __device__ __forceinline__ bf16* X() const { return (bf16*)(ws + WS_X); }
    __device__ __forceinline__ float* KVT() const { return (float*)(ws + WS_KVT); }
    __device__ __forceinline__ bf16* SPREV() const { return (bf16*)(ws + WS_SPREV); }
    __device__ __forceinline__ float* SCR() const { return (float*)(ws + WS_SCR); }
    __device__ __forceinline__ float* AFF() const { return (float*)(ws + WS_AFF); }
    __device__ __forceinline__ float* GATE() const { return (float*)(ws + WS_GATE); }
    __device__ __forceinline__ bf16* SGW() const { return (bf16*)(ws + WS_SGW); }
    __device__ __forceinline__ bf16* WIN() const { return (bf16*)(ws + WS_WIN); }
    __device__ __forceinline__ bf16* WOUT() const { return (bf16*)(ws + WS_WOUT); }
    __device__ __forceinline__ bf16* WGU() const { return (bf16*)(ws + WS_WGU); }
    __device__ __forceinline__ bf16* WD() const { return (bf16*)(ws + WS_WD); }
    __device__ __forceinline__ bf16* HN() const { return (bf16*)(ws + WS_HN); }
    __device__ __forceinline__ bf16* Z() const { return (bf16*)(ws + WS_Z); }
    __device__ __forceinline__ bf16* QH() const { return (bf16*)(ws + WS_QH); }
    __device__ __forceinline__ bf16* KH() const { return (bf16*)(ws + WS_KH); }
    __device__ __forceinline__ bf16* VH() const { return (bf16*)(ws + WS_VH); }
    __device__ __forceinline__ bf16* RQ() const { return (bf16*)(ws + WS_RQ); }
    __device__ __forceinline__ bf16* RK() const { return (bf16*)(ws + WS_RK); }
    __device__ __forceinline__ bf16* SVN() const { return (bf16*)(ws + WS_SVN); }
    __device__ __forceinline__ bf16* MIX() const { return (bf16*)(ws + WS_MIX); }
    __device__ __forceinline__ bf16* XS() const { return (bf16*)(ws + WS_XS); }
    __device__ __forceinline__ bf16* HH() const { return (bf16*)(ws + WS_HH); }
    __device__ __forceinline__ bf16* Y() const { return (bf16*)(ws + WS_Y); }
    __device__ __forceinline__ bf16* RWS() const { return (bf16*)(ws + WS_RWS); }
    __device__ __forceinline__ int* SLOT() const { return (int*)(ws + WS_SLOT); }
    __device__ __forceinline__ int* ROWIDX() const { return (int*)(ws + WS_ROWIDX); }
};
__device__ __forceinline__ float bf2f(bf16 v) { return __builtin_bit_cast(float, (unsigned)v << 16); }
__device__ __forceinline__ float wave_sum(float v) {
#pragma unroll
    for (int o = 1; o < 64; o <<= 1) v += __shfl_xor(v, o);
    return v;
}
__device__ __forceinline__ float half_sum32(float v) {
#pragma unroll
    for (int o = 1; o < 32; o <<= 1) v += __shfl_xor(v, o);
    return v;
}
__device__ __forceinline__ float wave_max(float v) {
#pragma unroll
    for (int o = 1; o < 64; o <<= 1) v = fmaxf(v, __shfl_xor(v, o));
    return v;
}
__device__ __forceinline__ int crow(int r, int hi) { return (r & 3) + 8 * (r >> 2) + 4 * hi; }
__device__ __forceinline__ float gelu_t(float x) {
    const float u = 0.7978845608028654f * (x + 0.044715f * x * x * x);
    const float t = 1.f - 2.f * __builtin_amdgcn_rcpf(1.f + __expf(2.f * u));
    return 0.5f * x * (1.f + t);
}
__device__ __forceinline__ float silu_f(float x) { return x * __builtin_amdgcn_rcpf(1.f + __expf(-x)); }
__device__ __forceinline__ int row_vec(int r) { return r < SEQ ? 0 : (r < NLAT ? 1 : 2); }
__device__ __forceinline__ int chunk_row0(int b, int cc) { return cc < 2 ? NLAT + b * CTXL + cc * 128 : b * SEQ + (cc - 2) * 128; }

__device__ __forceinline__ f32x16 mma_nt(const LAS bf16* A, int lda, const LAS bf16* B, int ldb, int K, f32x16 acc, int lane) {
    const int r = lane & 31, h = lane >> 5;
#pragma unroll 2
    for (int k0 = 0; k0 < K; k0 += 16) {
        const bf16x8 a = *(const LAS bf16x8*)(A + r * lda + k0 + 8 * h);
        const bf16x8 b = *(const LAS bf16x8*)(B + r * ldb + k0 + 8 * h);
        acc = __builtin_amdgcn_mfma_f32_32x32x16_bf16(a, b, acc, 0, 0, 0);
    }
    return acc;
}

constexpr float QSCALE = 0.125f * 1.4426950408889634f;
struct EpiResid {
    static constexpr bool PERM = true, AFTER_DRAIN = false;
    bf16* X; const float* modg;
    const float* Xin;
    __device__ __forceinline__ void operator()(const pg8::f32x4 (&acc)[2][2][4][2], const pg8::Unit& u, int wr, int wc, int fr, int fq) const {
        const int row0 = u.pm * 256 + wr * 64 + fr, col0 = u.pn * 256 + wc * 32 + 8 * fq;
        const int v = u.pm < 32 ? 0 : (u.pm < 64 ? 1 : 2);
        pg8::f32x4 gv[2][2];
#pragma unroll
        for (int bj = 0; bj < 2; ++bj)
#pragma unroll
            for (int n = 0; n < 2; ++n) gv[bj][n] = *(const pg8::f32x4*)(modg + v * 6144 + col0 + bj * 128 + 4 * n);
        const bool in32 = Xin != nullptr;
#pragma unroll
        for (int ai = 0; ai < 2; ++ai)
#pragma unroll
            for (int m = 0; m < 4; ++m) { const size_t off = (size_t)(row0 + ai * 128 + m * 16) * DM + col0;
#pragma unroll
                for (int bj = 0; bj < 2; ++bj) {
                    pg8::f32x4 x0, x1;
                    if (in32) { x0 = *(const pg8::f32x4*)(Xin + off + bj * 128); x1 = *(const pg8::f32x4*)(Xin + off + bj * 128 + 4); }
                    else { const pg8::u32x4 w = *(const pg8::u32x4*)(X + off + bj * 128);
                        x0 = (pg8::f32x4){__builtin_bit_cast(float, w.x << 16), __builtin_bit_cast(float, w.x & 0xffff0000u), __builtin_bit_cast(float, w.y << 16), __builtin_bit_cast(float, w.y & 0xffff0000u)};
                        x1 = (pg8::f32x4){__builtin_bit_cast(float, w.z << 16), __builtin_bit_cast(float, w.z & 0xffff0000u), __builtin_bit_cast(float, w.w << 16), __builtin_bit_cast(float, w.w & 0xffff0000u)}; }
                    x0 = x0 + gv[bj][0] * acc[ai][bj][m][0]; x1 = x1 + gv[bj][1] * acc[ai][bj][m][1];
                    pg8::u32x4 o; o.x = pg8::cvt_pk_bf16(x0.x, x0.y); o.y = pg8::cvt_pk_bf16(x0.z, x0.w); o.z = pg8::cvt_pk_bf16(x1.x, x1.y); o.w = pg8::cvt_pk_bf16(x1.z, x1.w);
                    *(pg8::u32x4*)(X + off + bj * 128) = o; } }
    }
};
struct EpiZ {
    static constexpr bool PERM = true, AFTER_DRAIN = false;
    bf16* Z; bf16* VH; bf16* QH; bf16* KH; const float* gqk; const float* rope;
    __device__ __forceinline__ void operator()(const pg8::f32x4 (&acc)[2][2][4][2], const pg8::Unit& u, int wr, int wc, int fr, int fq) const {
        if (u.pn < 4) {
            const bool isk = u.pn >= 2; const int grp = (u.pn & 1) * 4 + wc;
            const float* g = gqk + (isk ? 64 : 0); const float sc = isk ? 1.f : QSCALE;
            float ga[2][8];
#pragma unroll
            for (int bj = 0; bj < 2; ++bj)
#pragma unroll
                for (int e = 0; e < 8; ++e) ga[bj][e] = g[32 * bj + 8 * fq + e] * sc;
            const bool first = fq < 2; const int i16 = 8 * (fq & 1);
            const bool lat = u.pm < 64;
#pragma unroll
            for (int ai = 0; ai < 2; ++ai) {
                float rc[8], rn[8];
                if (lat) { const float* T = rope + (size_t)(((u.pm * 256 + ai * 128 + wr * 64) & (SEQ - 1)) & ~63) * 64 + i16;
                    const pg8::f32x4 c0 = *(const pg8::f32x4*)T, c1 = *(const pg8::f32x4*)(T + 4), s0 = *(const pg8::f32x4*)(T + 32), s1 = *(const pg8::f32x4*)(T + 36);
#pragma unroll
                    for (int e = 0; e < 4; ++e) { rc[e] = c0[e]; rc[4 + e] = c1[e]; rn[e] = s0[e]; rn[4 + e] = s1[e]; } }
#pragma unroll
                for (int m = 0; m < 4; ++m) {
                    float ccm[8], cnm[8];
                    if (lat) { const float* T = rope + (size_t)(m * 16 + fr) * 64 + 16 + i16;
                        const pg8::f32x4 c0 = *(const pg8::f32x4*)T, c1 = *(const pg8::f32x4*)(T + 4), s0 = *(const pg8::f32x4*)(T + 32), s1 = *(const pg8::f32x4*)(T + 36);
#pragma unroll
                        for (int e = 0; e < 4; ++e) { ccm[e] = c0[e]; ccm[4 + e] = c1[e]; cnm[e] = s0[e]; cnm[4 + e] = s1[e]; } }
                    const int r = u.pm * 256 + ai * 128 + wr * 64 + m * 16 + fr;
                    const int b = lat ? (r >> 13) : ((r - NLAT) >> 8), n = lat ? (r & (SEQ - 1)) : ((r - NLAT) & (CTXL - 1));
                    float v[2][8]; float ss = 0.f;
#pragma unroll
                    for (int bj = 0; bj < 2; ++bj)
#pragma unroll
                        for (int e = 0; e < 8; ++e) { v[bj][e] = acc[ai][bj][m][e >> 2][e & 3]; ss += v[bj][e] * v[bj][e]; }
                    ss += __shfl_xor(ss, 16);
                    { const auto sw = __builtin_amdgcn_permlane32_swap(__float_as_uint(ss), __float_as_uint(ss), false, false); ss = __uint_as_float(sw[0]) + __uint_as_float(sw[1]); }
                    const float rinv = __builtin_amdgcn_rsqf(ss * (1.f / 64.f) + EPS);
                    bf16* dst = (isk ? KH + ((size_t)b * NKEY + (lat ? CTXL + n : n)) * 512 : QH + (size_t)r * 512) + grp * 64 + 8 * fq;
#pragma unroll
                    for (int bj = 0; bj < 2; ++bj) {
                        float y[8], o[8];
#pragma unroll
                        for (int e = 0; e < 8; ++e) y[e] = v[bj][e] * rinv * ga[bj][e];
                        if (lat) {
#pragma unroll
                            for (int e = 0; e < 8; ++e) { const auto sw = __builtin_amdgcn_permlane32_swap(__float_as_uint(y[e]), __float_as_uint(y[e]), false, false);
                                const float pp = __uint_as_float(first ? sw[1] : sw[0]); const float c = bj ? ccm[e] : rc[e], s = bj ? cnm[e] : rn[e];
                                o[e] = first ? y[e] * c - pp * s : pp * s + y[e] * c; }
                        } else {
#pragma unroll
                            for (int e = 0; e < 8; ++e) o[e] = y[e];
                        }
                        pg8::u32x4 w; w.x = pg8::cvt_pk_bf16(o[0], o[1]); w.y = pg8::cvt_pk_bf16(o[2], o[3]); w.z = pg8::cvt_pk_bf16(o[4], o[5]); w.w = pg8::cvt_pk_bf16(o[6], o[7]);
                        *(pg8::u32x4*)(dst + 32 * bj) = w;
                    }
                }
            }
            return;
        }
        const bool isv = (u.pn == 4) | (u.pn == 5);
        const size_t prow0 = isv ? (u.pm < 64 ? (size_t)u.pm * 256 + (size_t)((u.pm >> 5) + 1) * CTXL : (size_t)(u.pm - 64) * NKEY) : (size_t)u.pm * 256;
        bf16* base = isv ? VH + (u.pn - 4) * 256 : Z + u.pn * 256; const int ldc = isv ? 512 : INC;
        const int col0 = wc * 32 + 8 * fq;
#pragma unroll
        for (int ai = 0; ai < 2; ++ai)
#pragma unroll
            for (int m = 0; m < 4; ++m) { bf16* rowp = base + (prow0 + wr * 64 + fr + ai * 128 + m * 16) * ldc + col0;
#pragma unroll
                for (int bj = 0; bj < 2; ++bj) { const pg8::f32x4 v0 = acc[ai][bj][m][0], v1 = acc[ai][bj][m][1];
                    pg8::u32x4 w; w.x = pg8::cvt_pk_bf16(v0[0], v0[1]); w.y = pg8::cvt_pk_bf16(v0[2], v0[3]); w.z = pg8::cvt_pk_bf16(v1[0], v1[1]); w.w = pg8::cvt_pk_bf16(v1[2], v1[3]);
                    *(pg8::u32x4*)(rowp + bj * 128) = w; } }
    }
};
struct EpiSwiglu {
    static constexpr bool PERM = true, AFTER_DRAIN = false;
    bf16* H;
    __device__ __forceinline__ void operator()(const pg8::f32x4 (&acc)[2][2][4][2], const pg8::Unit& u, int wr, int wc, int fr, int fq) const {
        const int row0 = u.pm * 256 + wr * 64 + fr, col0 = (u.pn & 15) * 128 + wc * 32 + 8 * fq;
#pragma unroll
        for (int ai = 0; ai < 2; ++ai)
#pragma unroll
            for (int m = 0; m < 4; ++m) { bf16* rowp = H + (size_t)(row0 + ai * 128 + m * 16) * FF + col0;
                float h[8];
#pragma unroll
                for (int n = 0; n < 2; ++n)
#pragma unroll
                    for (int i = 0; i < 4; ++i) { const float g = acc[ai][0][m][n][i], up = acc[ai][1][m][n][i]; h[4 * n + i] = silu_f(g) * up; }
                pg8::u32x4 w; w.x = pg8::cvt_pk_bf16(h[0], h[1]); w.y = pg8::cvt_pk_bf16(h[2], h[3]); w.z = pg8::cvt_pk_bf16(h[4], h[5]); w.w = pg8::cvt_pk_bf16(h[6], h[7]);
                *(pg8::u32x4*)rowp = w; }
    }
};
struct MoeOrder {
    int G, c, npn, npm, total;
    __device__ __forceinline__ bool next(int i, pg8::Unit& u) const {
        const int per = npm * npn;
        if ((G & 7) == 0) {
            const int W = G >> 3, x = c & 7, r = c >> 3, q = i * W + r;
            if (q >= 2 * per) return false;
            const int e = 2 * x + q / per, rem = q % per, pn = rem / npm, pm = rem % npm;
            u.pm = e * 9 + pm; u.pn = e * npn + pn; return true;
        }
        const long L = (long)i * G + c; if (L >= total) return false;
        const int e = (int)L / per, rem = (int)L % per; const int pn = rem / npm, pm = rem % npm;
        u.pm = e * 9 + pm; u.pn = e * npn + pn; return true;
    }
    __device__ __forceinline__ void a_ready(const pg8::Unit&) const {}
    __device__ __forceinline__ void done(const pg8::Unit&) const {}
    __device__ __forceinline__ bool half_only(const pg8::Unit& u) const { return (u.pm % 9) == 8; }
};

__device__ __forceinline__ void transpose_item(const float* W, int N, bf16* WT, int K, int k0, int n0, size_t drow0, LAS float* scr, int lane) {
    f32x4 v[8];
#pragma unroll
    for (int i = 0; i < 8; ++i) v[i] = __builtin_nontemporal_load((const f32x4*)(W + (size_t)(k0 + 8 * i + (lane >> 3)) * N + n0 + 4 * (lane & 7)));
#pragma unroll
    for (int i = 0; i < 8; ++i) { LAS float* d = scr + (8 * i + (lane >> 3)) * 33 + 4 * (lane & 7); d[0] = v[i].x; d[1] = v[i].y; d[2] = v[i].z; d[3] = v[i].w; }
    LDS_WAIT(); asm volatile("" ::: "memory");
    const int c = lane & 7;
#pragma unroll
    for (int j = 0; j < 4; ++j) { const int n = (lane >> 3) + 8 * j; const LAS float* s = scr + (8 * c) * 33 + n;
        v4u o; o.x = pk2(s[0 * 33], s[1 * 33]); o.y = pk2(s[2 * 33], s[3 * 33]); o.z = pk2(s[4 * 33], s[5 * 33]); o.w = pk2(s[6 * 33], s[7 * 33]);
        *(GAS v4u*)(WT + (drow0 + n) * K + k0 + 8 * c) = o; }
    LDS_WAIT(); asm volatile("" ::: "memory");
}
constexpr unsigned CV_IN = 16 * 104, CV_OUT = 16 * 32, CV_EX = 1024;
constexpr unsigned CONV_SEG0 = DEPTH * (CV_IN + CV_OUT), CONV_PER_L = 3 * NE * CV_EX, CONV_TOTAL = CONV_SEG0 + DEPTH * CONV_PER_L;
constexpr int CW_Q = 64;
static_assert(CONV_TOTAL % 64 == 0, "whole batches");
__device__ __forceinline__ void conv_item(const Frame& F, unsigned it, LAS float* scr, int lane) {
    if (it < DEPTH * CV_IN) { const int L = it / CV_IN, q = it % CV_IN, kb = q / 104, nb = q % 104, n0 = nb * 32;
        const size_t drow0 = n0 < 1024 ? (size_t)(n0 & ~255) + 128 * ((n0 & 63) >> 5) + 32 * ((n0 & 255) >> 6) : (size_t)n0;
        transpose_item(F.w_in() + (size_t)L * DM * INC, INC, F.WIN() + (size_t)L * INC * DM, DM, kb * 64, n0, drow0, scr, lane); return; }
    it -= DEPTH * CV_IN;
    if (it < DEPTH * CV_OUT) { const int L = it / CV_OUT, q = it % CV_OUT, kb = q / 32, nb = q % 32;
        transpose_item(F.w_out() + (size_t)L * DM * DM, DM, F.WOUT() + (size_t)L * DM * DM, DM, kb * 64, nb * 32, (size_t)nb * 32, scr, lane); return; }
    it -= DEPTH * CV_OUT;
    const int L = it / CONV_PER_L, q0 = it % CONV_PER_L, kind = q0 / (NE * CV_EX), r = q0 % (NE * CV_EX), le = L * NE + r / CV_EX, q = r % CV_EX;
    if (kind < 2) { const int kb = q / 64, nb = q % 64, n0 = nb * 32;
        const size_t drow0 = (size_t)(n0 >> 7) * 256 + (n0 & 127) + (kind ? 128 : 0);
        transpose_item((kind ? F.wu() : F.wg()) + (size_t)le * DM * FF, FF, F.WGU() + (size_t)le * 4096 * DM, DM, kb * 64, n0, drow0, scr, lane); }
    else { const int kb = q / 32, nb = q % 32;
        transpose_item(F.wd() + (size_t)le * FF * DM, DM, F.WD() + (size_t)le * DM * FF, FF, kb * 64, nb * 32, (size_t)nb * 32, scr, lane); }
}
__device__ __forceinline__ bool conv_batch(const Frame& F) {
    LAS unsigned* bc = (LAS unsigned*)(F.lds + MISC_OFF + 64);
    LAS float* scr = (LAS float*)(F.lds + 32768 + F.wave * 8704);
    if (F.tid == 0) *bc = __hip_atomic_fetch_add((unsigned*)(F.ws + WS_CTL) + CW_Q, 64u, __ATOMIC_RELAXED, __HIP_MEMORY_SCOPE_AGENT);
    __syncthreads();
    const unsigned base = *bc;
    __syncthreads();
    if (base >= CONV_TOTAL) return false;
    for (int k = 0; k < 8; ++k) conv_item(F, base + 8 * k + F.wave, scr, F.lane);
    return true;
}
__device__ __forceinline__ void conv_n(const Frame& F, int n) { for (int i = 0; i < n; ++i) if (!conv_batch(F)) break; __syncthreads(); }
__device__ __forceinline__ void conv_until(const Frame& F, unsigned target) {
    for (;;) {
        const unsigned h = __hip_atomic_load((unsigned*)(F.ws + WS_CTL) + CW_Q, __ATOMIC_RELAXED, __HIP_MEMORY_SCOPE_AGENT);
        LAS unsigned* bc = (LAS unsigned*)(F.lds + MISC_OFF + 68);
        if (F.tid == 0) *bc = h;
        __syncthreads();
        const unsigned hh = *bc;
        __syncthreads();
        if (hh >= target) break;
        if (!conv_batch(F)) break;
    }
}
__device__ __forceinline__ void ph_prologue(const Frame& F) {
    const int tid = F.tid, lane = F.lane, wave = F.wave;
    LAS float* sc = (LAS float*)F.lds;
    LAS float* red = sc + 3072;
    for (int i = tid; i < 3072; i += NTHR) { const int v = i >> 10, k = i & 1023; const float c = v < 2 ? F.c_in()[v * DM + k] : F.cctx_in()[k]; sc[i] = c / (1.f + expf(-c)); }
    __syncthreads();
    for (int t = F.bid; t < 384; t += F.G) {
        const int L = t / 96, j0 = (t % 96) * 64;
        const float* W = F.w_mod() + (size_t)L * DM * 6144 + j0 + lane;
        float a0 = 0.f, a1 = 0.f, a2 = 0.f;
#pragma unroll 8
        for (int kk = 0; kk < 128; ++kk) { const int k = wave * 128 + kk; const float w = W[(size_t)k * 6144]; a0 += sc[k] * w; a1 += sc[1024 + k] * w; a2 += sc[2048 + k] * w; }
        red[(wave * 3 + 0) * 64 + lane] = a0; red[(wave * 3 + 1) * 64 + lane] = a1; red[(wave * 3 + 2) * 64 + lane] = a2;
        __syncthreads();
        if (tid < 192) { const int v = tid >> 6, l = tid & 63; float s = 0.f;
#pragma unroll
            for (int w = 0; w < 8; ++w) s += red[(w * 3 + v) * 64 + l];
            F.MOD()[(size_t)(L * 3 + v) * 6144 + j0 + l] = s + F.b_mod()[L * 6144 + j0 + l]; }
        __syncthreads();
    }
    if (F.bid == 0 && wave == 0) {
        for (int L = 0; L < DEPTH; ++L) {
            const float d1 = wave_sum(F.lq1()[L * 64 + lane] * F.lk1()[L * 64 + lane]), d2 = wave_sum(F.lq2()[L * 64 + lane] * F.lk2()[L * 64 + lane]);
            const float linit = 0.8f - 0.6f * expf(-0.3f * (float)L);
            if (lane == 0) { F.LP()[L * 16 + 0] = expf(d1) - expf(d2) + linit; F.LP()[L * 16 + 1] = 1.f - linit; }
            if (lane < 8) { const float xd = F.retd()[L * 8 + lane]; F.LP()[L * 16 + 2 + lane] = -log1pf(expf(-xd)); }
            F.LP()[DEPTH * 16 + L * 128 + lane] = F.qng()[L * 64 + lane]; F.LP()[DEPTH * 16 + L * 128 + 64 + lane] = F.kng()[L * 64 + lane];
            { const float mq = wave_max(fabsf(F.qng()[L * 64 + lane])), mk = wave_max(fabsf(F.kng()[L * 64 + lane])); if (lane == 0) F.LP()[L * 16 + 10] = 64.f * mq * mk * 1.02f; }
        }
    }
    const int gw = F.bid * NWAVES + wave, NGW = F.G * NWAVES;
    {
        const int i16 = lane & 15, which = lane >> 4, i32 = lane & 31;
        const float inv_a = powf(10000.f, -(float)i16 / 16.f);
        const float inv_r = 1.f / powf(10000.f, (float)i32 / 31.f);
        for (int n = gw; n < SEQ; n += NGW) {
            const float pos = (which & 1) ? (float)(n & 63) : (float)(n >> 6);
            const float ang = pos * inv_a;
            F.ROPE()[(size_t)n * 64 + lane] = (which < 2) ? (float)cos((double)ang) : (float)sin((double)ang);
            const float ang2 = (float)n * inv_r;
            F.RETT()[(size_t)n * 64 + lane] = (lane < 32) ? (float)cos((double)ang2) : (float)sin((double)ang2);
        }
    }
    if (F.bid == 0) for (int i = tid; i < DM / 2; i += NTHR) ((unsigned*)(F.HN() + (size_t)NROW * DM))[i] = 0u;
    for (int i = F.bid * NTHR + tid; i < DEPTH * 16 * DM; i += F.G * NTHR) { const int Lr = i / (16 * DM), q = i % (16 * DM), k = q >> 4, e = q & 15;
        const float w = F.rw()[i]; const unsigned h = f2bf(w); const float wl = w - __builtin_bit_cast(float, h << 16);
        F.RWS()[((size_t)(Lr * 2 + 0) * 16 + e) * RWLD + k] = (bf16)h; F.RWS()[((size_t)(Lr * 2 + 1) * 16 + e) * RWLD + k] = (bf16)f2bf(wl); }
    for (int i = F.bid * NTHR + tid; i < DEPTH * 4 * 128 * 128; i += F.G * NTHR) F.SGW()[i] = (bf16)f2bf(F.sgw()[i]);
    conv_until(F, CONV_SEG0);
}

__device__ __forceinline__ void ph_norm1_first(const Frame& F) {
    const int lane = F.lane, gw = F.bid * NWAVES + F.wave, NGW = F.G * NWAVES;
    for (int r = gw; r < NROW; r += NGW) {
        const float* src = r < NLAT ? F.x_in() + (size_t)r * DM : F.ctx_in() + (size_t)(r - NLAT) * DM;
        const float* mod = F.MOD() + (size_t)row_vec(r) * 6144;
        f32x4 v[4]; float ss = 0.f;
#pragma unroll
        for (int j = 0; j < 4; ++j) { v[j] = *(const f32x4*)(src + 4 * lane + 256 * j); ss += (v[j].x * v[j].x + v[j].y * v[j].y) + (v[j].z * v[j].z + v[j].w * v[j].w); }
        const float rinv = rsqrtf(wave_sum(ss) * (1.f / DM) + EPS);
#pragma unroll
        for (int j = 0; j < 4; ++j) { const int c = 4 * lane + 256 * j;
            const f32x4 g = *(const f32x4*)(F.n1g() + c), sh = *(const f32x4*)(mod + c), sc = *(const f32x4*)(mod + 1024 + c);
            const f32x4 h = v[j] * rinv * g * (sc + 1.f) + sh;
            *(unsigned long long*)(F.HN() + (size_t)r * DM + c) = (unsigned long long)pk2(h.x, h.y) | ((unsigned long long)pk2(h.z, h.w) << 32); }
    }
}

__device__ __forceinline__ void ph_prep(const Frame& F, int L) {
    const int lane = F.lane, gw = F.bid * NWAVES + F.wave, NGW = F.G * NWAVES;
    const int grp8 = lane >> 3, half = (lane >> 2) & 1, t4 = lane & 3, dA = half * 32 + 4 * t4;
    const f32x4 gqA = *(const f32x4*)(F.qng() + L * 64 + dA), gqB = *(const f32x4*)(F.qng() + L * 64 + dA + 16);
    const f32x4 gkA = *(const f32x4*)(F.kng() + L * 64 + dA), gkB = *(const f32x4*)(F.kng() + L * 64 + dA + 16);
    const int rsel = lane >> 5, rhead = (lane >> 3) & 3, t8 = lane & 7;
    const float rscale = rsel ? 0.125f : 1.f;
    const f32x4 sgn = *(const f32x4*)(F.sgng() + L * 256 + lane * 4);
    for (int r = gw; r < NROW; r += NGW) {
        const bf16* zr = F.Z() + (size_t)r * INC;
        const bool lat = r < NLAT; const int b = lat ? (r >> 13) : ((r - NLAT) >> 8), n = lat ? (r & (SEQ - 1)) : ((r - NLAT) & (CTXL - 1));
        const size_t krow = (size_t)b * NKEY + (lat ? CTXL + n : n);
        f32x4 cs = {1.f, 1.f, 1.f, 1.f}, sn = {0.f, 0.f, 0.f, 0.f}, cs2 = cs, sn2 = sn;
        if (lat) { const float* T = F.ROPE() + (size_t)n * 64; cs = *(const f32x4*)(T + half * 16 + 4 * t4); sn = *(const f32x4*)(T + 32 + half * 16 + 4 * t4);
                   const float* R = F.RETT() + (size_t)n * 64; cs2 = *(const f32x4*)(R + 4 * t8); sn2 = *(const f32x4*)(R + 32 + 4 * t8); }
#pragma unroll
        for (int pass = 0; pass < 2; ++pass) {
            const int col = pass * 512 + grp8 * 64 + dA;
            const u16x4 ra = *(const u16x4*)(zr + col), rb = *(const u16x4*)(zr + col + 16);
            f32x4 x1, x2; float ss = 0.f;
#pragma unroll
            for (int e = 0; e < 4; ++e) { x1[e] = bf2f(ra[e]); x2[e] = bf2f(rb[e]); ss += x1[e] * x1[e] + x2[e] * x2[e]; }
            ss += __shfl_xor(ss, 1); ss += __shfl_xor(ss, 2); ss += __shfl_xor(ss, 4);
            const float rinv = rsqrtf(ss * (1.f / 64.f) + EPS);
            const f32x4 y1 = x1 * rinv * (pass ? gkA : gqA * QSCALE), y2 = x2 * rinv * (pass ? gkB : gqB * QSCALE);
            const f32x4 o1 = y1 * cs - y2 * sn, o2 = y1 * sn + y2 * cs;
            bf16* dst = (pass ? F.KH() + krow * 512 : F.QH() + (size_t)r * 512) + grp8 * 64 + dA;
            *(unsigned long long*)dst = (unsigned long long)pk2(o1.x, o1.y) | ((unsigned long long)pk2(o1.z, o1.w) << 32);
            *(unsigned long long*)(dst + 16) = (unsigned long long)pk2(o2.x, o2.y) | ((unsigned long long)pk2(o2.z, o2.w) << 32);
        }
    }
}

__device__ __forceinline__ void ph_norm2_router(const Frame& F, int L) {
    const int lane = F.lane, tid = F.tid, gw = F.bid * NWAVES + F.wave, NGW = F.G * NWAVES;
    LAS bf16* rwl = (LAS bf16*)F.lds;
    { const bf16* src = F.RWS() + (size_t)L * 2 * 16 * RWLD;
      for (int i = tid; i < 2 * 16 * RWLD / 8; i += NTHR) *(LAS bf16x8*)(rwl + i * 8) = *(const bf16x8*)(src + i * 8); }
    __syncthreads();
    const int ntile = ((L == DEPTH - 1) ? NLAT : NROW) / 16;
    const int rr = lane & 15, kq = lane >> 4;
    for (int tile = gw; tile < ntile; tile += NGW) {
        const int r = tile * 16 + rr;
        const bf16* xr = F.X() + (size_t)r * DM + 8 * kq;
        const float* mod = F.MOD() + (size_t)(L * 3 + row_vec(tile * 16)) * 6144 + 8 * kq;
        const float* gn = F.n2g() + L * DM + 8 * kq;
        float ss = 0.f;
#pragma unroll 8
        for (int st = 0; st < 32; ++st) { const v4u w = *(const v4u*)(xr + 32 * st);
            const f32x4 a = {__builtin_bit_cast(float, w.x << 16), __builtin_bit_cast(float, w.x & 0xffff0000u), __builtin_bit_cast(float, w.y << 16), __builtin_bit_cast(float, w.y & 0xffff0000u)};
            const f32x4 c = {__builtin_bit_cast(float, w.z << 16), __builtin_bit_cast(float, w.z & 0xffff0000u), __builtin_bit_cast(float, w.w << 16), __builtin_bit_cast(float, w.w & 0xffff0000u)};
            ss += (a.x * a.x + a.y * a.y) + (a.z * a.z + a.w * a.w) + (c.x * c.x + c.y * c.y) + (c.z * c.z + c.w * c.w); }
        ss += __shfl_xor(ss, 16); ss += __shfl_xor(ss, 32);
        const float rinv = rsqrtf(ss * (1.f / DM) + EPS);
        f32x4 acc = {0.f, 0.f, 0.f, 0.f};
        bf16* hrow = F.HN() + (size_t)r * DM + 8 * kq;
#pragma unroll 4
        for (int st = 0; st < 32; ++st) {
            float f[8];
            const v4u xw = *(const v4u*)(xr + 32 * st);
#pragma unroll
            for (int q = 0; q < 2; ++q) { const unsigned w0 = q ? xw.z : xw.x, w1 = q ? xw.w : xw.y;
                const f32x4 xv = {__builtin_bit_cast(float, w0 << 16), __builtin_bit_cast(float, w0 & 0xffff0000u), __builtin_bit_cast(float, w1 << 16), __builtin_bit_cast(float, w1 & 0xffff0000u)};
                const f32x4 g = *(const f32x4*)(gn + 32 * st + 4 * q),
                                                      sh = *(const f32x4*)(mod + 3072 + 32 * st + 4 * q), sc = *(const f32x4*)(mod + 4096 + 32 * st + 4 * q);
                const f32x4 y = xv * rinv * g * (sc + 1.f) + sh; f[4 * q] = y.x; f[4 * q + 1] = y.y; f[4 * q + 2] = y.z; f[4 * q + 3] = y.w; }
            v4u hi, lo;
            hi.x = pk2(f[0], f[1]); hi.y = pk2(f[2], f[3]); hi.z = pk2(f[4], f[5]); hi.w = pk2(f[6], f[7]);
#define LOPK(w, i0, i1) pk2(f[i0] - __builtin_bit_cast(float, (w) << 16), f[i1] - __builtin_bit_cast(float, (w) & 0xffff0000u))
            lo.x = LOPK(hi.x, 0, 1); lo.y = LOPK(hi.y, 2, 3); lo.z = LOPK(hi.z, 4, 5); lo.w = LOPK(hi.w, 6, 7);
#undef LOPK
            *(v4u*)(hrow + 32 * st) = hi;
            const bf16x8 ah = __builtin_bit_cast(bf16x8, hi), al = __builtin_bit_cast(bf16x8, lo);
            const bf16x8 bh = *(const LAS bf16x8*)(rwl + rr * RWLD + 32 * st + 8 * kq), bl = *(const LAS bf16x8*)(rwl + (16 + rr) * RWLD + 32 * st + 8 * kq);
            acc = __builtin_amdgcn_mfma_f32_16x16x32_bf16(ah, bh, acc, 0, 0, 0);
            acc = __builtin_amdgcn_mfma_f32_16x16x32_bf16(ah, bl, acc, 0, 0, 0);
            acc = __builtin_amdgcn_mfma_f32_16x16x32_bf16(al, bh, acc, 0, 0, 0);
        }
#pragma unroll
        for (int q = 0; q < 4; ++q) {
            float mx = acc[q];
#pragma unroll
            for (int o = 1; o < 16; o <<= 1) mx = fmaxf(mx, __shfl_xor(mx, o));
            const float ex = expf(acc[q] - mx); float sum = ex;
#pragma unroll
            for (int o = 1; o < 16; o <<= 1) sum += __shfl_xor(sum, o);
            F.AFF()[(size_t)(tile * 16 + 4 * kq + q) * 16 + rr] = ex / sum;
        }
    }
    __syncthreads();
}

__device__ __forceinline__ unsigned block_excl_scan(unsigned v, LAS unsigned* wtot, int lane, int wave) {
    unsigned inc = v;
#pragma unroll
    for (int o = 1; o < 64; o <<= 1) { const unsigned t = __shfl_up(inc, o); if (lane >= o) inc += t; }
    if (lane == 63) wtot[wave] = inc;
    __syncthreads();
    unsigned off = 0;
    for (int w = 0; w < wave; ++w) off += wtot[w];
    __syncthreads();
    return off + inc - v;
}
__device__ __forceinline__ void ph_topk(const Frame& F, int L) {
    const int tid = F.tid, lane = F.lane, wave = F.wave;
    LAS unsigned* keys = (LAS unsigned*)F.lds;
    LAS unsigned* hist = keys + 8192;
    LAS unsigned* wtot = hist + 256;
    LAS unsigned* bc = wtot + 16;
    const int nprob = (L == DEPTH - 1) ? 32 : 64;
    for (int p = F.bid; p < 64; p += F.G) {
        const int s = p >> 4, e = p & 15;
        const int n = s < 2 ? SEQ : CTXL, k = n >> 3;
        const int base = s < 2 ? s * SEQ : NLAT + (s - 2) * CTXL;
        const int sbase = s == 0 ? 0 : (s == 1 ? 1024 : (s == 2 ? 2048 : 2080));
        if (p >= nprob) {
            for (int i = tid; i < 32; i += NTHR) { F.ROWIDX()[e * EROWS + sbase + i] = -1; F.GATE()[e * EROWS + sbase + i] = 0.f; }
            if (s == 3) for (int rr = 2112 + tid; rr < EROWS; rr += NTHR) { F.ROWIDX()[e * EROWS + rr] = -1; F.GATE()[e * EROWS + rr] = 0.f; }
            continue; }
        for (int i = tid; i < n; i += NTHR) keys[i] = __float_as_uint(F.AFF()[(size_t)(base + i) * 16 + e]);
        __syncthreads();
        unsigned prefix = 0u, mask = 0u, need = (unsigned)k;
        for (int pass = 0; pass < 4; ++pass) {
            const int shift = 24 - 8 * pass;
            if (tid < 256) hist[tid] = 0u;
            __syncthreads();
            for (int i = tid; i < n; i += NTHR) { const unsigned key = keys[i]; if ((key & mask) == prefix) atomicAdd((unsigned*)&hist[(key >> shift) & 255u], 1u); }
            __syncthreads();
            if (wave == 0) {
                const unsigned h0 = hist[4 * lane], h1 = hist[4 * lane + 1], h2 = hist[4 * lane + 2], h3 = hist[4 * lane + 3];
                const unsigned tot = h0 + h1 + h2 + h3;
                unsigned suf = tot;
#pragma unroll
                for (int o = 1; o < 64; o <<= 1) { const unsigned t = __shfl_down(suf, o); if (lane + o < 64) suf += t; }
                const unsigned above = suf - tot;
                if (suf >= need && above < need) {
                    unsigned rem = need - above, bsel;
                    if (rem <= h3) bsel = 3u; else { rem -= h3; if (rem <= h2) bsel = 2u; else { rem -= h2; if (rem <= h1) bsel = 1u; else { rem -= h1; bsel = 0u; } } }
                    bc[0] = 4u * lane + bsel; bc[1] = rem;
                }
            }
            __syncthreads();
            prefix |= bc[0] << shift; mask |= 255u << shift; need = bc[1];
            __syncthreads();
        }
        const unsigned T = prefix;
        const int per = n >= NTHR ? n / NTHR : 1;
        const int i0 = tid * per; const bool act = i0 < n;
        unsigned eqc = 0u;
        if (act) for (int q = 0; q < per; ++q) eqc += (keys[i0 + q] == T) ? 1u : 0u;
        unsigned eqr = block_excl_scan(eqc, wtot, lane, wave);
        unsigned selc = 0u;
        if (act) for (int q = 0; q < per; ++q) { const unsigned key = keys[i0 + q]; if (key > T) ++selc; else if (key == T) { if (eqr < need) ++selc; ++eqr; } }
        unsigned slot = block_excl_scan(selc, wtot, lane, wave);
        eqr -= eqc;
        if (act) for (int q = 0; q < per; ++q) {
            const unsigned key = keys[i0 + q]; bool sel = key > T;
            if (key == T) { sel = eqr < need; ++eqr; }
            const int tok = base + i0 + q;
            if (sel) { const int rr = sbase + (int)slot; ++slot; F.ROWIDX()[e * EROWS + rr] = tok; F.GATE()[e * EROWS + rr] = __uint_as_float(key); F.SLOT()[(size_t)tok * 16 + e] = rr; }
            else F.SLOT()[(size_t)tok * 16 + e] = -1;
        }
        if (s == 3) for (int rr = 2112 + tid; rr < EROWS; rr += NTHR) { F.ROWIDX()[e * EROWS + rr] = -1; F.GATE()[e * EROWS + rr] = 0.f; }
        __syncthreads();
    }
}

__device__ __forceinline__ void ph_gather(const Frame& F) {
    const int lane = F.lane, gw = F.bid * NWAVES + F.wave, NGW = F.G * NWAVES;
    for (int idx = gw; idx < NE * EROWS; idx += NGW) {
        const int src = F.ROWIDX()[idx];
        bf16x8 a = {0, 0, 0, 0, 0, 0, 0, 0}, b = a;
        if (src >= 0) { a = *(const bf16x8*)(F.HN() + (size_t)src * DM + 8 * lane); b = *(const bf16x8*)(F.HN() + (size_t)src * DM + 512 + 8 * lane); }
        *(bf16x8*)(F.XS() + (size_t)idx * DM + 8 * lane) = a; *(bf16x8*)(F.XS() + (size_t)idx * DM + 512 + 8 * lane) = b;
    }
}

__device__ __forceinline__ void ph_combine(const Frame& F, int L) {
    const int lane = F.lane, gw = F.bid * NWAVES + F.wave, NGW = F.G * NWAVES;
    const bool last = (L == DEPTH - 1);
    const int nrows = last ? NLAT : NROW;
    for (int r = gw; r < nrows; r += NGW) {
        const int v = row_vec(r);
        const int sl = (lane < 16) ? F.SLOT()[(size_t)r * 16 + lane] : -1;
        const float* mod = F.MOD() + (size_t)(L * 3 + v) * 6144;
        f32x4 xv[4], g2[4];
#pragma unroll
        for (int j = 0; j < 2; ++j)
#pragma unroll
            for (int q = 0; q < 2; ++q) { const int c = 8 * lane + 512 * j + 4 * q; const unsigned long long w = *(const unsigned long long*)(F.X() + (size_t)r * DM + c);
                const unsigned w0 = (unsigned)w, w1 = (unsigned)(w >> 32);
                xv[2 * j + q] = (f32x4){__builtin_bit_cast(float, w0 << 16), __builtin_bit_cast(float, w0 & 0xffff0000u), __builtin_bit_cast(float, w1 << 16), __builtin_bit_cast(float, w1 & 0xffff0000u)};
                g2[2 * j + q] = *(const f32x4*)(mod + 5120 + c); }
        float acc[16];
#pragma unroll
        for (int i = 0; i < 16; ++i) acc[i] = 0.f;
        unsigned long long m = __ballot(sl >= 0);
        while (m) {
            const int e0 = __builtin_ctzll(m); m &= m - 1;
            const int e1 = m ? __builtin_ctzll(m) : -1; if (m) m &= m - 1;
            const int s0 = __shfl(sl, e0), s1 = e1 >= 0 ? __shfl(sl, e1) : 0;
            const float gv0 = F.GATE()[e0 * EROWS + s0]; const bf16* y0 = F.Y() + ((size_t)e0 * EROWS + s0) * DM;
            const bf16x8 a0 = *(const bf16x8*)(y0 + 8 * lane), a1 = *(const bf16x8*)(y0 + 8 * lane + 512);
            float gv1 = 0.f; bf16x8 b0 = {0, 0, 0, 0, 0, 0, 0, 0}, b1 = b0;
            if (e1 >= 0) { gv1 = F.GATE()[e1 * EROWS + s1]; const bf16* y1 = F.Y() + ((size_t)e1 * EROWS + s1) * DM; b0 = *(const bf16x8*)(y1 + 8 * lane); b1 = *(const bf16x8*)(y1 + 8 * lane + 512); }
#pragma unroll
            for (int i = 0; i < 8; ++i) { acc[i] += gv0 * bf2f((bf16)a0[i]); acc[8 + i] += gv0 * bf2f((bf16)a1[i]); }
            if (e1 >= 0) {
#pragma unroll
                for (int i = 0; i < 8; ++i) { acc[i] += gv1 * bf2f((bf16)b0[i]); acc[8 + i] += gv1 * bf2f((bf16)b1[i]); } }
        }
        float xn[16]; float ss = 0.f;
#pragma unroll
        for (int j = 0; j < 2; ++j)
#pragma unroll
            for (int q = 0; q < 2; ++q) { const int c = 8 * lane + 512 * j + 4 * q;
#pragma unroll
                for (int i = 0; i < 4; ++i) { const float t = xv[2 * j + q][i] + g2[2 * j + q][i] * acc[8 * j + 4 * q + i]; xn[8 * j + 4 * q + i] = t; ss += t * t; }
                const f32x4 o = {xn[8 * j + 4 * q], xn[8 * j + 4 * q + 1], xn[8 * j + 4 * q + 2], xn[8 * j + 4 * q + 3]};
                if (last) *(f32x4*)(F.out + (size_t)r * DM + c) = o;
                else *(unsigned long long*)(F.X() + (size_t)r * DM + c) = (unsigned long long)pk2(o.x, o.y) | ((unsigned long long)pk2(o.z, o.w) << 32); }
        if (!last) {
            const float rinv = rsqrtf(wave_sum(ss) * (1.f / DM) + EPS);
            const float* mod1 = F.MOD() + (size_t)((L + 1) * 3 + v) * 6144;
#pragma unroll
            for (int j = 0; j < 2; ++j) { const int c = 8 * lane + 512 * j; float h[8];
#pragma unroll
                for (int q = 0; q < 2; ++q) { const f32x4 g = *(const f32x4*)(F.n1g() + (L + 1) * DM + c + 4 * q), sh = *(const f32x4*)(mod1 + c + 4 * q), sc = *(const f32x4*)(mod1 + 1024 + c + 4 * q);
#pragma unroll
                    for (int i = 0; i < 4; ++i) h[4 * q + i] = xn[8 * j + 4 * q + i] * rinv * g[i] * (1.f + sc[i]) + sh[i]; }
                v4u w; w.x = pk2(h[0], h[1]); w.y = pk2(h[2], h[3]); w.z = pk2(h[4], h[5]); w.w = pk2(h[6], h[7]);
                *(v4u*)(F.HN() + (size_t)r * DM + c) = w; }
        }
    }
}


constexpr int LDP = 136, LDQK = 72;

__device__ __forceinline__ void ret_rot(const Frame& F, const bf16* zh, int p, bool lat, int n, float scale, float (&o1)[8], float (&o2)[8]) {
    const bf16x8 r1 = *(const bf16x8*)(zh + 8 * p), r2 = *(const bf16x8*)(zh + 32 + 8 * p);
    float cs[8], sn[8];
    if (lat) { const float* R = F.RETT() + (size_t)n * 64 + 8 * p; const f32x4 c0 = *(const f32x4*)R, c1 = *(const f32x4*)(R + 4), s0 = *(const f32x4*)(R + 32), s1 = *(const f32x4*)(R + 36);
#pragma unroll
        for (int i = 0; i < 4; ++i) { cs[i] = c0[i]; cs[4 + i] = c1[i]; sn[i] = s0[i]; sn[4 + i] = s1[i]; } }
    else {
#pragma unroll
        for (int i = 0; i < 8; ++i) { cs[i] = 1.f; sn[i] = 0.f; } }
#pragma unroll
    for (int i = 0; i < 8; ++i) { const float x1 = bf2f((bf16)r1[i]) * scale, x2 = bf2f((bf16)r2[i]) * scale; o1[i] = x1 * cs[i] - x2 * sn[i]; o2[i] = x1 * sn[i] + x2 * cs[i]; }
}
__device__ __forceinline__ void unit_retkv(const Frame& F, int L, int b, int h, int cc) {
    const int tid = F.tid, lane = F.lane, wave = F.wave;
    LAS bf16* vT = (LAS bf16*)F.lds;
    LAS bf16* kfT = vT + 64 * LDP;
    LAS bf16* kbT = kfT + 64 * LDP;
    const int row0 = chunk_row0(b, cc);
    const float lgf = F.LP()[L * 16 + 2 + h], lgb = F.LP()[L * 16 + 6 + h];
    { const int j = tid >> 2, p = tid & 3;
      const bf16* zr = F.Z() + (size_t)(row0 + j) * INC;
      float k1[8], k2[8];
      ret_rot(F, zr + ZRK + h * 64, p, cc >= 2, (cc - 2) * 128 + j, 0.125f, k1, k2);
      const bf16x8 v1 = *(const bf16x8*)(zr + ZRV + h * 64 + 8 * p), v2 = *(const bf16x8*)(zr + ZRV + h * 64 + 32 + 8 * p);
      const float df = __expf(lgf * (float)(127 - j)), db = __expf(lgb * (float)j);
#pragma unroll
      for (int i = 0; i < 8; ++i) { const int d1 = 8 * p + i, d2 = 32 + 8 * p + i;
          kfT[d1 * LDP + j] = (bf16)f2bf(k1[i] * df); kbT[d1 * LDP + j] = (bf16)f2bf(k1[i] * db); vT[d1 * LDP + j] = (bf16)v1[i];
          kfT[d2 * LDP + j] = (bf16)f2bf(k2[i] * df); kbT[d2 * LDP + j] = (bf16)f2bf(k2[i] * db); vT[d2 * LDP + j] = (bf16)v2[i]; } }
    __syncthreads();
    { const int dir = wave >> 2, ti = (wave >> 1) & 1, tj = wave & 1, r32 = lane & 31, hi = lane >> 5;
      f32x16 acc = {};
      acc = mma_nt(vT + ti * 32 * LDP, LDP, (dir ? kbT : kfT) + tj * 32 * LDP, LDP, 128, acc, lane);
      float* dst = F.KVT() + ((size_t)(((b * 4 + h) * 2 + dir) * NCH + cc)) * 4096;
#pragma unroll
      for (int x = 0; x < 16; ++x) dst[(ti * 32 + crow(x, hi)) * 64 + tj * 32 + r32] = acc[x]; }
    __syncthreads();
}

__device__ __forceinline__ void ph_scan(const Frame& F, int L) {
    const int t = F.bid * NTHR + F.tid;
    if (t < 65536) {
        const int elem = t & 4095, sq = t >> 12, dir = sq & 1, h = (sq >> 1) & 3, b = sq >> 3;
        const size_t base = (size_t)(((b * 4 + h) * 2 + dir) * NCH);
        const float decay = expf(F.LP()[L * 16 + 2 + dir * 4 + h] * 128.f);
        float kv[NCH];
#pragma unroll
        for (int step = 0; step < NCH; ++step) { const int cc = dir == 0 ? step : (step < 2 ? 1 - step : 67 - step); kv[step] = F.KVT()[(base + cc) * 4096 + elem]; }
        float s = 0.f;
#pragma unroll
        for (int step = 0; step < NCH; ++step) { const int cc = dir == 0 ? step : (step < 2 ? 1 - step : 67 - step);
            F.SPREV()[(base + cc) * 4096 + elem] = (bf16)f2bf(s); s = s * decay + kv[step]; }
    }
}

__device__ __forceinline__ void unit_retout(const Frame& F, int L, int b, int h, int cc) {
    int tid = F.tid; asm volatile("" : "+v"(tid));
    const int lane = tid & 63, wave = F.wave, r32 = lane & 31, hi = lane >> 5;
    LAS bf16* q_s = (LAS bf16*)F.lds;
    LAS bf16* k_s = q_s + 128 * LDQK;
    LAS bf16* vT = k_s + 128 * LDQK;
    LAS bf16* SfT = vT + 64 * LDP;
    LAS bf16* SbT = SfT + 64 * LDQK;
    LAS bf16* P = SbT + 64 * LDQK;
    LAS float* O_s = (LAS float*)P;
    constexpr int LDO = 66;
    const int row0 = chunk_row0(b, cc);
    const float lgf = F.LP()[L * 16 + 2 + h], lgb = F.LP()[L * 16 + 6 + h];
    { const int j = tid >> 2, p = tid & 3;
      const bf16* zr = F.Z() + (size_t)(row0 + j) * INC;
      float a1[8], a2[8];
      ret_rot(F, zr + ZRQ + h * 64, p, cc >= 2, (cc - 2) * 128 + j, 1.f, a1, a2);
      { v4u w; w.x = pk2(a1[0], a1[1]); w.y = pk2(a1[2], a1[3]); w.z = pk2(a1[4], a1[5]); w.w = pk2(a1[6], a1[7]); *(LAS v4u*)(q_s + j * LDQK + 8 * p) = w;
        w.x = pk2(a2[0], a2[1]); w.y = pk2(a2[2], a2[3]); w.z = pk2(a2[4], a2[5]); w.w = pk2(a2[6], a2[7]); *(LAS v4u*)(q_s + j * LDQK + 32 + 8 * p) = w; }
      ret_rot(F, zr + ZRK + h * 64, p, cc >= 2, (cc - 2) * 128 + j, 0.125f, a1, a2);
      { v4u w; w.x = pk2(a1[0], a1[1]); w.y = pk2(a1[2], a1[3]); w.z = pk2(a1[4], a1[5]); w.w = pk2(a1[6], a1[7]); *(LAS v4u*)(k_s + j * LDQK + 8 * p) = w;
        w.x = pk2(a2[0], a2[1]); w.y = pk2(a2[2], a2[3]); w.z = pk2(a2[4], a2[5]); w.w = pk2(a2[6], a2[7]); *(LAS v4u*)(k_s + j * LDQK + 32 + 8 * p) = w; }
      const bf16x8 v1 = *(const bf16x8*)(zr + ZRV + h * 64 + 8 * p), v2 = *(const bf16x8*)(zr + ZRV + h * 64 + 32 + 8 * p);
#pragma unroll
      for (int i = 0; i < 8; ++i) { vT[(8 * p + i) * LDP + j] = (bf16)v1[i]; vT[(32 + 8 * p + i) * LDP + j] = (bf16)v2[i]; } }
    { const bf16* sf = F.SPREV() + ((size_t)(((b * 4 + h) * 2 + 0) * NCH + cc)) * 4096;
      const bf16* sb = F.SPREV() + ((size_t)(((b * 4 + h) * 2 + 1) * NCH + cc)) * 4096;
      { const int dv = tid >> 3, c8 = (tid & 7) * 8;
          *(LAS v4u*)(SfT + dv * LDQK + c8) = *(const v4u*)(sf + dv * 64 + c8);
          *(LAS v4u*)(SbT + dv * LDQK + c8) = *(const v4u*)(sb + dv * 64 + c8); } }
    __syncthreads();
    const int sti = wave >> 1, stj0 = (wave & 1) * 2;
    f32x16 S0 = {}, S1 = {};
    S0 = mma_nt(q_s + sti * 32 * LDQK, LDQK, k_s + stj0 * 32 * LDQK, LDQK, 64, S0, lane);
    S1 = mma_nt(q_s + sti * 32 * LDQK, LDQK, k_s + (stj0 + 1) * 32 * LDQK, LDQK, 64, S1, lane);
    const int ei = tid >> 2, ec = (tid & 3) * 16;
    float yo[16];
#pragma unroll
    for (int dir = 0; dir < 2; ++dir) {
        const float lg = dir ? lgb : lgf;
#pragma unroll
        for (int x = 0; x < 16; ++x) { const int i = sti * 32 + crow(x, hi);
            const int j0 = stj0 * 32 + r32, j1 = j0 + 32; const int d0 = dir ? j0 - i : i - j0, d1 = dir ? j1 - i : i - j1;
            const float p0 = d0 >= 0 ? S0[x] * __expf(lg * (float)d0) : 0.f, p1 = d1 >= 0 ? S1[x] * __expf(lg * (float)d1) : 0.f;
            const unsigned pk = pg8::cvt_pk_bf16(p0, p1);
            P[i * LDP + j0] = (bf16)(pk & 0xffffu); P[i * LDP + j1] = (bf16)(pk >> 16);
            if ((x & 3) == 3) __builtin_amdgcn_sched_barrier(0); }
        __syncthreads();
        const int oti = wave >> 1, otj = wave & 1;
        f32x16 a0 = {}, c0 = {};
        { const LAS bf16* ST = dir ? SbT : SfT;
          a0 = mma_nt(P + oti * 32 * LDP, LDP, vT + otj * 32 * LDP, LDP, 128, a0, lane);
          c0 = mma_nt(q_s + oti * 32 * LDQK, LDQK, ST + otj * 32 * LDQK, LDQK, 64, c0, lane); }
        __syncthreads();
#pragma unroll
        for (int x = 0; x < 16; ++x) { const int i = oti * 32 + crow(x, hi);
            const float qd = __expf(lg * (float)(dir ? 128 - i : i + 1));
            O_s[i * LDO + otj * 32 + r32] = a0[x] + c0[x] * qd;
            if ((x & 3) == 3) __builtin_amdgcn_sched_barrier(0); }
        __syncthreads();
        { float o[16]; float s = 0.f;
#pragma unroll
          for (int c = 0; c < 16; ++c) { o[c] = O_s[ei * LDO + ec + c]; s += o[c]; }
          s += __shfl_xor(s, 1); s += __shfl_xor(s, 2);
          const float mu = s * (1.f / 64.f); float s2 = 0.f;
#pragma unroll
          for (int c = 0; c < 16; ++c) { o[c] -= mu; s2 += o[c] * o[c]; }
          s2 += __shfl_xor(s2, 1); s2 += __shfl_xor(s2, 2);
          const float rs = rsqrtf(s2 * (1.f / 64.f) + EPS);
          const bf16* zr = F.Z() + (size_t)(row0 + ei) * INC + (dir ? ZGB : ZGF) + h * 64 + ec;
          const bf16x8 ga = *(const bf16x8*)zr, gb = *(const bf16x8*)(zr + 8);
#pragma unroll
          for (int c = 0; c < 16; ++c) { const float g = bf2f((bf16)(c < 8 ? ga[c & 7] : gb[c & 7])); const float y = o[c] * rs * silu_f(g);
              if (dir == 0) yo[c] = y; else yo[c] += y; }
          if (dir == 1) { bf16* mr = F.MIX() + (size_t)(row0 + ei) * DM + 512 + h * 64 + ec;
              v4u w0, w1; w0.x = pk2(yo[0], yo[1]); w0.y = pk2(yo[2], yo[3]); w0.z = pk2(yo[4], yo[5]); w0.w = pk2(yo[6], yo[7]);
              w1.x = pk2(yo[8], yo[9]); w1.y = pk2(yo[10], yo[11]); w1.z = pk2(yo[12], yo[13]); w1.w = pk2(yo[14], yo[15]);
              *(v4u*)mr = w0; *(v4u*)(mr + 8) = w1; } }
        __syncthreads();
    }
}

__device__ __forceinline__ void unit_sg(const Frame& F, int L, int b, int g, int cc) {
    const int tid = F.tid, lane = F.lane, wave = F.wave, r32 = lane & 31, hi = lane >> 5;
    LAS bf16* W_s = (LAS bf16*)F.lds;
    LAS bf16* vT = W_s + 128 * LDP;
    const int row0 = chunk_row0(b, cc);
    const bf16* Wg = F.SGW() + (size_t)(L * 4 + g) * 128 * 128;
#pragma unroll
    for (int q = 0; q < 4; ++q) { const int idx = tid + NTHR * q, i = idx >> 4, c8 = (idx & 15) * 8; *(LAS bf16x8*)(W_s + i * LDP + c8) = *(const bf16x8*)(Wg + i * 128 + c8); }
    { const int j = tid >> 2, qd = tid & 3;
      const bf16* zr = F.Z() + (size_t)(row0 + j) * INC + ZSV + 64 * qd;
      float gv[64]; float sum = 0.f;
#pragma unroll
      for (int c = 0; c < 8; ++c) { const bf16x8 raw = *(const bf16x8*)(zr + 8 * c);
#pragma unroll
          for (int i = 0; i < 8; ++i) { const float t = gelu_t(bf2f((bf16)raw[i])); gv[8 * c + i] = t; sum += t; } }
      sum += __shfl_xor(sum, 1); sum += __shfl_xor(sum, 2);
      const float mu = sum * (1.f / 256.f); float s2 = 0.f;
#pragma unroll
      for (int c = 0; c < 64; ++c) { gv[c] -= mu; s2 += gv[c] * gv[c]; }
      s2 += __shfl_xor(s2, 1); s2 += __shfl_xor(s2, 2);
      const float rs = rsqrtf(s2 * (1.f / 256.f) + EPS);
      if (qd == g) { const float* gn = F.sgng() + L * 256 + g * 64;
#pragma unroll
          for (int c = 0; c < 64; ++c) vT[c * LDP + j] = (bf16)f2bf(gv[c] * rs * gn[c]); } }
    __syncthreads();
    LAS float* O_s = (LAS float*)W_s;
    { const int ti = wave >> 1, tj = wave & 1;
      f32x16 acc = {};
      acc = mma_nt(W_s + ti * 32 * LDP, LDP, vT + tj * 32 * LDP, LDP, 128, acc, lane);
      __syncthreads();
#pragma unroll
      for (int x = 0; x < 16; ++x) O_s[(ti * 32 + crow(x, hi)) * 66 + tj * 32 + r32] = acc[x]; }
    __syncthreads();
    { const int i = tid >> 2, ec = (tid & 3) * 16;
      const bf16* zu = F.Z() + (size_t)(row0 + i) * INC + ZSU + g * 64 + ec;
      const bf16x8 u0 = *(const bf16x8*)zu, u1 = *(const bf16x8*)(zu + 8);
      const float bi = F.sgb()[(L * 4 + g) * 128 + i];
      float o[16];
#pragma unroll
      for (int c = 0; c < 16; ++c) o[c] = gelu_t(bf2f((bf16)(c < 8 ? u0[c & 7] : u1[c & 7]))) * (O_s[i * 66 + ec + c] + bi);
      bf16* mr = F.MIX() + (size_t)(row0 + i) * DM + 768 + g * 64 + ec;
      v4u w0, w1; w0.x = pk2(o[0], o[1]); w0.y = pk2(o[2], o[3]); w0.z = pk2(o[4], o[5]); w0.w = pk2(o[6], o[7]);
      w1.x = pk2(o[8], o[9]); w1.y = pk2(o[10], o[11]); w1.z = pk2(o[12], o[13]); w1.w = pk2(o[14], o[15]);
      *(v4u*)mr = w0; *(v4u*)(mr + 8) = w1; }
    __syncthreads();
}

__device__ __forceinline__ void unit_out_ctx(const Frame& F, int L, int mu) {
    int tid = F.tid; asm volatile("" : "+v"(tid));
    const int lane = tid & 63, wave = F.wave, r32 = lane & 31, hi = lane >> 5;
    const int rb = mu >> 5, cb = mu & 31, k0 = wave * 128 + 8 * hi;
    LAS float* P = (LAS float*)F.lds;
    const bf16* A0 = F.MIX() + (size_t)(NLAT + rb * 64 + r32) * DM + k0;
    const bf16* B0 = F.WOUT() + (size_t)L * DM * DM + (size_t)(cb * 32 + r32) * DM + k0;
    bf16x8 a0[8], a1[8], bb[8];
#pragma unroll
    for (int s = 0; s < 8; ++s) { a0[s] = *(const bf16x8*)(A0 + 16 * s); a1[s] = *(const bf16x8*)(A0 + 32 * DM + 16 * s); bb[s] = *(const bf16x8*)(B0 + 16 * s); }
    f32x16 c0 = {}, c1 = {};
#pragma unroll
    for (int s = 0; s < 8; ++s) { c0 = __builtin_amdgcn_mfma_f32_32x32x16_bf16(a0[s], bb[s], c0, 0, 0, 0); c1 = __builtin_amdgcn_mfma_f32_32x32x16_bf16(a1[s], bb[s], c1, 0, 0, 0); }
#pragma unroll
    for (int x = 0; x < 16; ++x) { P[((wave * 2 + 0) * 16 + x) * 64 + lane] = c0[x]; P[((wave * 2 + 1) * 16 + x) * 64 + lane] = c1[x]; }
    __syncthreads();
    const float* g1 = F.MOD() + (size_t)(L * 3 + 2) * 6144 + 2048 + cb * 32;
#pragma unroll
    for (int q = 0; q < 4; ++q) {
        const int idx = tid + NTHR * q, ln = idx & 63, x = (idx >> 6) & 15, t = idx >> 10;
        float s = 0.f;
#pragma unroll
        for (int w = 0; w < 8; ++w) s += P[((w * 2 + t) * 16 + x) * 64 + ln];
        const int row = 32 * t + crow(x, ln >> 5), col = ln & 31;
        const size_t xo = (size_t)(rb * 64 + row) * DM + cb * 32 + col;
        F.X()[(size_t)NLAT * DM + xo] = (bf16)f2bf((L == 0 ? F.ctx_in()[xo] : bf2f(F.X()[(size_t)NLAT * DM + xo])) + g1[col] * s);
    }
    __syncthreads();
}

namespace att {
constexpr int KVBLK = 64;
constexpr float SCALE = 0.125f, THR = 8.f;
constexpr int LDQ = 512, LDK = 512, LDV = 512;
constexpr int SHM_V = KVBLK * 128 * 2, SHM_K = KVBLK * 64 * 2, SHM_ATTN = 2 * SHM_V + 2 * SHM_K + NWAVES * 64 * 4;
#define KSWZ(row, colB) ((row) * 128 + ((colB) ^ ((((row) >> 1) & 7) << 4)))
#define SBAR() __builtin_amdgcn_sched_barrier(0)
__device__ __forceinline__ unsigned cvtpk(float lo, float hi) { unsigned r; asm volatile("v_cvt_pk_bf16_f32 %0, %1, %2" : "=v"(r) : "v"(lo), "v"(hi)); return r; }
template <bool OFF> __device__ __forceinline__ void partialSM(f32x16& p0, f32x16& p1, float off) {
#pragma unroll
    for (int r = 0; r < 16; ++r) { if (OFF) { p0[r] += off; p1[r] += off; } p0[r] = __builtin_amdgcn_exp2f(p0[r]); }
}
__device__ __forceinline__ void finishSM(f32x16& p0, f32x16& p1, float& l_reg, bf16x8& pa0, bf16x8& pa1, bf16x8& pa2, bf16x8& pa3) {
#pragma unroll
    for (int r = 0; r < 16; ++r) p1[r] = __builtin_amdgcn_exp2f(p1[r]);
    float ps = 0;
#pragma unroll
    for (int r = 0; r < 16; ++r) ps += p0[r];
#pragma unroll
    for (int r = 0; r < 16; ++r) ps += p1[r];
    { auto rr = __builtin_amdgcn_permlane32_swap(__float_as_uint(ps), __float_as_uint(ps), false, false);
      ps = __uint_as_float(rr[0]) + __uint_as_float(rr[1]); }
    l_reg += ps;
#define PK4(P, BASE, OUT) do { unsigned a0 = cvtpk(P[BASE + 0], P[BASE + 1]), a1 = cvtpk(P[BASE + 2], P[BASE + 3]);   \
    unsigned b0 = cvtpk(P[BASE + 4], P[BASE + 5]), b1 = cvtpk(P[BASE + 6], P[BASE + 7]);                              \
    auto r0 = __builtin_amdgcn_permlane32_swap(a0, b0, false, false); auto r1 = __builtin_amdgcn_permlane32_swap(a1, b1, false, false); \
    v4u w = {r0[0], r1[0], r0[1], r1[1]}; OUT = __builtin_bit_cast(bf16x8, w); } while (0)
    PK4(p0, 0, pa0); PK4(p0, 8, pa1); PK4(p1, 0, pa2); PK4(p1, 8, pa3);
#undef PK4
}
template <bool OFF> __device__ __forceinline__ void kload(bf16x8 (&kf)[8], const LAS char* Ks, int r32, int hi) {
    if (OFF) return;
#pragma unroll
    for (int d0 = 0; d0 < 4; ++d0) { const int cb = (d0 * 16 + hi * 8) * 2;
        kf[2 * d0] = *(const LAS bf16x8*)(Ks + KSWZ(r32, cb)); kf[2 * d0 + 1] = *(const LAS bf16x8*)(Ks + KSWZ(32 + r32, cb)); }
}
template <bool OFF> __device__ __forceinline__ void qkmma(f32x16& p0, f32x16& p1, const bf16x8 (&kf)[8], const bf16x8* qr, const LAS char* Ks, int r32, int hi) {
    p0 = f32x16{}; p1 = f32x16{};
#pragma unroll
    for (int d0 = 0; d0 < 4; ++d0) {
        if (OFF) { const int cb = (d0 * 16 + hi * 8) * 2;
            const bf16x8 b0 = *(const LAS bf16x8*)(Ks + KSWZ(r32, cb)), b1 = *(const LAS bf16x8*)(Ks + KSWZ(32 + r32, cb));
            p0 = __builtin_amdgcn_mfma_f32_32x32x16_bf16(b0, qr[d0], p0, 0, 0, 0); p1 = __builtin_amdgcn_mfma_f32_32x32x16_bf16(b1, qr[d0], p1, 0, 0, 0); }
        else { p0 = __builtin_amdgcn_mfma_f32_32x32x16_bf16(kf[2 * d0], qr[d0], p0, 0, 0, 0); p1 = __builtin_amdgcn_mfma_f32_32x32x16_bf16(kf[2 * d0 + 1], qr[d0], p1, 0, 0, 0); } }
}
__device__ __forceinline__ int v_st(int k, int c) { const int kk = (k & ~0xC) | ((k & 4) << 1) | ((k & 8) >> 1); return ((kk >> 3) * 4 + (c >> 5)) * 512 + ((kk & 7) * 32 + (c & 31)) * 2; }
__device__ __forceinline__ int v_rd_base(int lane) { return ((lane & 3) << 3) | (((lane >> 2) & 3) << 6) | (((lane >> 4) & 1) << 5) | (((lane >> 5) & 1) << 8); }
constexpr int v_rd_off(int d0, int ks, int half) { return d0 * 512 + ks * 4096 + half * 2048; }
template <int OFF> __device__ __forceinline__ s16x4 tr_read(int vb) {
    s16x4 r; asm volatile("ds_read_b64_tr_b16 %0, %1 offset:%2" : "=&v"(r) : "v"(vb), "i"(OFF) : "memory"); return r;
}
template <int D0> __device__ __forceinline__ void pv_one(f32x16& od, int vb, bf16x8 pa0, bf16x8 pa1, bf16x8 pa2, bf16x8 pa3) {
    const s16x4 l0 = tr_read<v_rd_off(D0, 0, 0)>(vb), h0 = tr_read<v_rd_off(D0, 0, 1)>(vb), l1 = tr_read<v_rd_off(D0, 1, 0)>(vb), h1 = tr_read<v_rd_off(D0, 1, 1)>(vb);
    const s16x4 l2 = tr_read<v_rd_off(D0, 2, 0)>(vb), h2 = tr_read<v_rd_off(D0, 2, 1)>(vb), l3 = tr_read<v_rd_off(D0, 3, 0)>(vb), h3 = tr_read<v_rd_off(D0, 3, 1)>(vb);
    asm volatile("s_waitcnt lgkmcnt(0)" ::: "memory"); SBAR();
#define PK(Lo, Hi) (bf16x8){Lo[0], Lo[1], Lo[2], Lo[3], Hi[0], Hi[1], Hi[2], Hi[3]}
    od = __builtin_amdgcn_mfma_f32_32x32x16_bf16(pa0, PK(l0, h0), od, 0, 0, 0);
    od = __builtin_amdgcn_mfma_f32_32x32x16_bf16(pa1, PK(l1, h1), od, 0, 0, 0);
    od = __builtin_amdgcn_mfma_f32_32x32x16_bf16(pa2, PK(l2, h2), od, 0, 0, 0);
    od = __builtin_amdgcn_mfma_f32_32x32x16_bf16(pa3, PK(l3, h3), od, 0, 0, 0);
#undef PK
}
__device__ __forceinline__ void pv_d0(f32x16* o, int vb, bf16x8 pa0, bf16x8 pa1, bf16x8 pa2, bf16x8 pa3) {
    pv_one<0>(o[0], vb, pa0, pa1, pa2, pa3); pv_one<1>(o[1], vb, pa0, pa1, pa2, pa3); pv_one<2>(o[2], vb, pa0, pa1, pa2, pa3); pv_one<3>(o[3], vb, pa0, pa1, pa2, pa3);
}
template <bool OFF> __device__ __forceinline__ void body(const bf16* __restrict__ Qb, const bf16* __restrict__ Kh, const bf16* __restrict__ Vh, int seq, float mfix, LAS char* lds, f32x16 (&o)[4]) {
    int tid = threadIdx.x; asm volatile("" : "+v"(tid));
    const int wid = __builtin_amdgcn_readfirstlane(tid >> 6), lane = tid & 63, r32 = lane & 31, hi = lane >> 5;
    LAS char* V_lds = lds; LAS char* K_lds = lds + 2 * SHM_V;
    LAS float* ws = (LAS float*)(lds + 2 * SHM_V + 2 * SHM_K) + wid * 64; LAS float* li_l = ws; LAS float* al_l = ws + 32;
    float l_reg = 0;
    const float soff = -mfix * (SCALE * 1.4426950408889634f);
#pragma unroll
    for (int d = 0; d < 4; ++d) o[d] = f32x16{};
    bf16x8 qr[4];
    const bf16* Qw = Qb + (long)(wid * 32 + r32) * LDQ + hi * 8;
#pragma unroll
    for (int d0 = 0; d0 < 4; ++d0) qr[d0] = *(const bf16x8*)(Qw + d0 * 16);
    const int sr = tid >> 4, sc = (tid & 15) * 8, vst0 = v_st(sr, sc), vst1 = v_st(32 + sr, sc);
    const int kr = tid >> 3, kc = (tid & 7) * 8, kst = KSWZ(kr, kc * 2);
    const int vb0 = (int)(uintptr_t)V_lds + v_rd_base(lane);
    struct { bf16x8 vs0, vs1, ks0; } sr_[2];
#define SLOAD(i, k0) do { sr_[i].vs0 = *(const bf16x8*)(&Vh[(long)((k0) + sr) * LDV + sc]); sr_[i].vs1 = *(const bf16x8*)(&Vh[(long)((k0) + 32 + sr) * LDV + sc]); \
    sr_[i].ks0 = *(const bf16x8*)(&Kh[(long)((k0) + kr) * LDK + kc]); } while (0)
#define SWRITE(b, i) do { *(LAS bf16x8*)(V_lds + (b) * SHM_V + vst0) = sr_[i].vs0; *(LAS bf16x8*)(V_lds + (b) * SHM_V + vst1) = sr_[i].vs1; \
    *(LAS bf16x8*)(K_lds + (b) * SHM_K + kst) = sr_[i].ks0; } while (0)
#define SWAIT() asm volatile("s_waitcnt vmcnt(3)" ::: "memory")
    f32x16 pA0, pA1, pB0, pB1; bf16x8 pa0, pa1, pa2, pa3; const int NT = seq / KVBLK;
    constexpr int SE = 0, SO = 1;
    SLOAD(SE, 0); asm volatile("s_waitcnt vmcnt(0)" ::: "memory"); SWRITE(0, SE); __syncthreads();
    bf16x8 kf[8];
    kload<OFF>(kf, K_lds, r32, hi); qkmma<OFF>(pA0, pA1, kf, qr, K_lds, r32, hi); partialSM<OFF>(pA0, pA1, soff);
    SLOAD(SO, KVBLK); if (2 < NT) SLOAD(SE, 2 * KVBLK);
    SWAIT(); SWRITE(1, SO); __syncthreads();
    for (int j = 1; j + 1 < NT; j += 2) {
        SBAR(); kload<OFF>(kf, K_lds + SHM_K, r32, hi); SBAR();
        qkmma<OFF>(pB0, pB1, kf, qr, K_lds + SHM_K, r32, hi); finishSM(pA0, pA1, l_reg, pa0, pa1, pa2, pa3); SBAR();
        SLOAD(SO, (j + 2) * KVBLK); SBAR();
        pv_d0(o, vb0, pa0, pa1, pa2, pa3); partialSM<OFF>(pB0, pB1, soff);
        __syncthreads(); SWAIT(); SWRITE(0, SE);
        __syncthreads();
        SBAR(); kload<OFF>(kf, K_lds, r32, hi); SBAR();
        qkmma<OFF>(pA0, pA1, kf, qr, K_lds, r32, hi); finishSM(pB0, pB1, l_reg, pa0, pa1, pa2, pa3); SBAR();
        if (j + 3 < NT) SLOAD(SE, (j + 3) * KVBLK); SBAR();
        pv_d0(o, vb0 + (int)SHM_V, pa0, pa1, pa2, pa3); partialSM<OFF>(pA0, pA1, soff);
        __syncthreads(); SWAIT(); SWRITE(1, SO);
        __syncthreads();
    }
    SBAR(); kload<OFF>(kf, K_lds + SHM_K, r32, hi); SBAR();
    qkmma<OFF>(pB0, pB1, kf, qr, K_lds + SHM_K, r32, hi); finishSM(pA0, pA1, l_reg, pa0, pa1, pa2, pa3); SBAR();
    pv_d0(o, vb0, pa0, pa1, pa2, pa3); partialSM<OFF>(pB0, pB1, soff);
    __syncthreads();
    finishSM(pB0, pB1, l_reg, pa0, pa1, pa2, pa3); SBAR();
    pv_d0(o, vb0 + (int)SHM_V, pa0, pa1, pa2, pa3);
    if (hi == 0) li_l[r32] = l_reg; asm volatile("s_waitcnt lgkmcnt(0)" ::: "memory");
#pragma unroll
    for (int r = 0; r < 16; ++r) { const float rl = __builtin_amdgcn_rcpf(li_l[crow(r, hi)]);
#pragma unroll
        for (int d0 = 0; d0 < 4; ++d0) o[d0][r] *= rl; }
    __syncthreads();
#undef SLOAD
#undef SWRITE
#undef SWAIT
}

constexpr int SLK = 8192, SLV = 16384, L_K = 0, L_V = 3 * SLK, L_WS = L_V + 3 * SLV;
typedef const LAS char* lds_cptr;
typedef short v4i16_t __attribute__((ext_vector_type(4)));
#define PIN(x) asm volatile("" : "+v"(x))
#define MFMA32(a, b, c) __builtin_amdgcn_mfma_f32_32x32x16_bf16(a, b, c, 0, 0, 0)
#define WAIT_BAR(N) asm volatile("s_waitcnt vmcnt(" #N ") lgkmcnt(0)\n\ts_barrier" ::: "memory")
__device__ __forceinline__ unsigned cvtpk2(float lo, float hi) { unsigned r; asm("v_cvt_pk_bf16_f32 %0, %1, %2" : "=v"(r) : "v"(lo), "v"(hi)); return r; }
__device__ __forceinline__ void glds16(const void* g, unsigned lds_base) {
    unsigned sv; asm volatile("s_mov_b32 %0, m0\n\ts_mov_b32 m0, %2\n\ts_nop 0\n\tglobal_load_lds_dwordx4 %1, off\n\ts_mov_b32 m0, %0" : "=&s"(sv) : "v"(g), "s"(lds_base) : "memory"); }
__device__ __forceinline__ void kload2(bf16x8* kf, lds_cptr kp, int d0) { kf[2 * d0] = *(const LAS bf16x8*)(kp + d0 * 2048); kf[2 * d0 + 1] = *(const LAS bf16x8*)(kp + d0 * 2048 + 512); }
__device__ __forceinline__ s16x4 vtr(lds_cptr p) { return __builtin_bit_cast(s16x4, __builtin_amdgcn_ds_read_tr16_b64_v4i16((LAS v4i16_t*)p)); }
__device__ __forceinline__ void body_fast(const bf16* __restrict__ Qb, const bf16* __restrict__ Kh, const bf16* __restrict__ Vh, int seq, LAS char* lds, f32x16 (&o)[4]) {
    int tid = threadIdx.x; asm volatile("" : "+v"(tid));
    const int wid = __builtin_amdgcn_readfirstlane(tid >> 6), lane = tid & 63, r32 = lane & 31, hi = lane >> 5;
    const int NT = seq / KVBLK;
    const unsigned lds0 = (unsigned)(uintptr_t)lds; LAS float* wsf = (LAS float*)(lds + L_WS) + wid * 64;
    const bool dma = wid < 4;
    const bf16* ksrc = Kh + (long)lane * LDK + (wid & 3) * 8;
    const bf16* vsrc = Vh + (long)(16 * (wid & 3) + (lane >> 2)) * LDV + (lane & 3) * 8;
    const unsigned kdst = lds0 + L_K + (wid & 3) * 1024, vdst = lds0 + L_V + (wid & 3) * 1024;
#define GL(p, d) glds16(p, (unsigned)__builtin_amdgcn_readfirstlane(d))
#define DMA_K(t, slot) do { if (dma) { GL(ksrc + (long)(t) * KVBLK * LDK, kdst + (slot)); GL(ksrc + (long)(t) * KVBLK * LDK + 32, kdst + (slot) + 4096); } } while (0)
#define DMA_V1(t, slot) do { if (dma) { GL(vsrc + (long)(t) * KVBLK * LDV, vdst + 2 * (slot)); GL(vsrc + (long)(t) * KVBLK * LDV + 32, vdst + 2 * (slot) + 4096); } } while (0)
#define DMA_V2(t, slot) do { if (dma) { GL(vsrc + (long)(t) * KVBLK * LDV + 64, vdst + 2 * (slot) + 8192); GL(vsrc + (long)(t) * KVBLK * LDV + 96, vdst + 2 * (slot) + 12288); } } while (0)
#define DMA_V(t, slot) do { DMA_V1(t, slot); DMA_V2(t, slot); } while (0)
    const lds_cptr vp0 = (lds_cptr)lds + L_V + ((lane >> 4) & 1) * 32 + (lane & 3) * 8 + (4 * hi + ((lane & 15) >> 2)) * 64;
    const lds_cptr kp0 = (lds_cptr)lds + L_K + hi * 1024 + r32 * 16;
    DMA_K(0, 0); DMA_V(0, 0); DMA_K(1, SLK);
    bf16x8 qr[4];
    const bf16* Qw = Qb + (long)(wid * 32 + r32) * LDQ + hi * 8;
#pragma unroll
    for (int d0 = 0; d0 < 4; ++d0) qr[d0] = *(const bf16x8*)(Qw + d0 * 16);
    float l_reg = 0.f;
#pragma unroll
    for (int d = 0; d < 4; ++d) o[d] = f32x16{};
    f32x16 pA0, pA1, pB0, pB1; bf16x8 kf[8]; s16x4 vlo[8], vhi[8]; v4u pw0, pw1, pw2, pw3;
    int sl_prev = 0, sl_cur = 0, sl_next = SLK;
#define ROT() do { sl_prev = sl_cur; sl_cur = sl_next; sl_next = (sl_next == 2 * SLK) ? 0 : sl_next + SLK; } while (0)
#define EX(v) __builtin_amdgcn_exp2f(v)
    DMA_K(2, 2 * SLK);
    WAIT_BAR(4);
    _Pragma("unroll") for (int d0 = 0; d0 < 4; ++d0) kload2(kf, kp0, d0);
    pA0 = MFMA32(kf[0], qr[0], f32x16{}); pA1 = MFMA32(kf[1], qr[0], f32x16{}); pA0 = MFMA32(kf[2], qr[1], pA0); pA1 = MFMA32(kf[3], qr[1], pA1);
    pA0 = MFMA32(kf[4], qr[2], pA0); pA1 = MFMA32(kf[5], qr[2], pA1); pA0 = MFMA32(kf[6], qr[3], pA0); pA1 = MFMA32(kf[7], qr[3], pA1);
#pragma unroll
    for (int r = 0; r < 16; ++r) { pA0[r] = EX(pA0[r]); pA1[r] = EX(pA1[r]); }
    WAIT_BAR(0);
    DMA_K(3, 0); DMA_V(1, SLK); ROT();
    _Pragma("unroll") for (int d0 = 0; d0 < 4; ++d0) kload2(kf, kp0 + sl_cur, d0);
    WAIT_BAR(6);
#define PKW(P, i) cvtpk2(P[i], P[i + 1])
#define PAF(k) __builtin_bit_cast(bf16x8, pw##k)
#define VFR(i) (bf16x8){vlo[i][0], vlo[i][1], vlo[i][2], vlo[i][3], vhi[i][0], vhi[i][1], vhi[i][2], vhi[i][3]}
#define VRD(s, fi) do { vlo[s] = vtr(vp_ + (((fi) >> 2) * 4096 + ((fi) & 3) * 1024)); vhi[s] = vtr(vp_ + (((fi) >> 2) * 4096 + ((fi) & 3) * 1024 + 512)); } while (0)
#define KRD(G, d0) do { if (G) { kload2(kf, kp0 + sl_next, d0); SBAR(); } } while (0)
#define GAPA(MF, a0, a1, a2, a3, W0, W1, PW) do { MF; sacc += a0; sacc2 += a1; sacc += a2; sacc2 += a3; W0; W1; PIN(PW); PIN(sacc); PIN(sacc2); SBAR(); } while (0)
#define GAPB(MF, X, i) do { MF; X[i] = EX(X[i]); X[i + 1] = EX(X[i + 1]); PIN(X); SBAR(); } while (0)
#define STEP(C0, C1, P0, P1, t, GK, GV, GL) do { SBAR(); \
    const lds_cptr vp_ = vp0 + 2 * sl_prev; \
    VRD(0, 0); SBAR(); float sacc = P0[0], sacc2 = P0[1]; \
                       GAPA(C0 = MFMA32(kf[0], qr[0], f32x16{}), P0[2], P0[3], P0[4], P0[5],     pw0[0] = PKW(P0, 0),  pw0[1] = PKW(P0, 2),  pw0); \
    VRD(4, 4); SBAR(); GAPA(C1 = MFMA32(kf[1], qr[0], f32x16{}), P0[6], P0[7], P0[8], P0[9],     pw0[2] = PKW(P0, 4),  pw0[3] = PKW(P0, 6),  pw0); \
    VRD(1, 1); SBAR(); GAPA(C0 = MFMA32(kf[2], qr[1], C0),       P0[10], P0[11], P0[12], P0[13], pw1[0] = PKW(P0, 8),  pw1[1] = PKW(P0, 10), pw1); \
    VRD(5, 5); SBAR(); GAPA(C1 = MFMA32(kf[3], qr[1], C1),       P0[14], P0[15], P1[0], P1[1],   pw1[2] = PKW(P0, 12), pw1[3] = PKW(P0, 14), pw1); \
    VRD(2, 2); SBAR(); GAPA(C0 = MFMA32(kf[4], qr[2], C0),       P1[2], P1[3], P1[4], P1[5],     pw2[0] = PKW(P1, 0),  pw2[1] = PKW(P1, 2),  pw2); \
    VRD(6, 6); SBAR(); GAPA(C1 = MFMA32(kf[5], qr[2], C1),       P1[6], P1[7], P1[8], P1[9],     pw2[2] = PKW(P1, 4),  pw2[3] = PKW(P1, 6),  pw2); \
    VRD(3, 3); SBAR(); GAPA(C0 = MFMA32(kf[6], qr[3], C0),       P1[10], P1[11], P1[12], P1[13], pw3[0] = PKW(P1, 8),  pw3[1] = PKW(P1, 10), pw3); \
    VRD(7, 7); SBAR(); GAPA(C1 = MFMA32(kf[7], qr[3], C1),       P1[14], P1[15], 0.f, 0.f,       pw3[2] = PKW(P1, 12), pw3[3] = PKW(P1, 14), pw3); \
    l_reg += sacc + sacc2; SBAR(); \
    GAPB(o[0] = MFMA32(PAF(0), VFR(0), o[0]), C0, 0);  VRD(0, 8);  SBAR(); \
    GAPB(o[1] = MFMA32(PAF(0), VFR(4), o[1]), C0, 2);  VRD(4, 12); SBAR(); \
    GAPB(o[0] = MFMA32(PAF(1), VFR(1), o[0]), C0, 4);  VRD(1, 9);  SBAR(); \
    GAPB(o[1] = MFMA32(PAF(1), VFR(5), o[1]), C0, 6);  VRD(5, 13); SBAR(); \
    GAPB(o[0] = MFMA32(PAF(2), VFR(2), o[0]), C0, 8);  VRD(2, 10); SBAR(); \
    GAPB(o[1] = MFMA32(PAF(2), VFR(6), o[1]), C0, 10); VRD(6, 14); SBAR(); \
    GAPB(o[0] = MFMA32(PAF(3), VFR(3), o[0]), C0, 12); VRD(3, 11); SBAR(); \
    GAPB(o[1] = MFMA32(PAF(3), VFR(7), o[1]), C0, 14); VRD(7, 15); SBAR(); \
    KRD(GL, 0); GAPB(o[2] = MFMA32(PAF(0), VFR(0), o[2]), C1, 0); \
    KRD(GL, 1); GAPB(o[3] = MFMA32(PAF(0), VFR(4), o[3]), C1, 2); \
    KRD(GL, 2); GAPB(o[2] = MFMA32(PAF(1), VFR(1), o[2]), C1, 4); \
    KRD(GL, 3); GAPB(o[3] = MFMA32(PAF(1), VFR(5), o[3]), C1, 6); \
    GAPB(o[2] = MFMA32(PAF(2), VFR(2), o[2]), C1, 8);  if (dma) { if (GK) DMA_K((t) + 3, sl_cur); if (GV) DMA_V((t) + 1, sl_next); } SBAR(); \
    GAPB(o[3] = MFMA32(PAF(2), VFR(6), o[3]), C1, 10); \
    GAPB(o[2] = MFMA32(PAF(3), VFR(3), o[2]), C1, 12); \
    GAPB(o[3] = MFMA32(PAF(3), VFR(7), o[3]), C1, 14); \
    } while (0)
    int t = 1;
    for (; t + 5 < NT; t += 2) {
        STEP(pB0, pB1, pA0, pA1, t, true, true, true);     WAIT_BAR(6); ROT();
        STEP(pA0, pA1, pB0, pB1, t + 1, true, true, true); WAIT_BAR(6); ROT();
    }
#define ENDW(tt) do { if ((tt) + 3 < NT) { WAIT_BAR(6); } else if ((tt) + 2 < NT) { WAIT_BAR(4); } else { WAIT_BAR(0); } } while (0)
    for (; t + 1 < NT; t += 2) {
        STEP(pB0, pB1, pA0, pA1, t, (t + 3 < NT), (t + 1 < NT), (t + 1 < NT));         ENDW(t);     ROT();
        STEP(pA0, pA1, pB0, pB1, t + 1, (t + 4 < NT), (t + 2 < NT), (t + 2 < NT));     ENDW(t + 1); ROT();
    }
    STEP(pB0, pB1, pA0, pA1, NT - 1, false, false, false);
    { float sacc = pB0[0] + pB0[1];
#pragma unroll
      for (int r = 2; r < 16; ++r) sacc += pB0[r];
#pragma unroll
      for (int r = 0; r < 16; ++r) sacc += pB1[r];
      l_reg += sacc;
      pw0 = (v4u){PKW(pB0, 0), PKW(pB0, 2), PKW(pB0, 4), PKW(pB0, 6)}; pw1 = (v4u){PKW(pB0, 8), PKW(pB0, 10), PKW(pB0, 12), PKW(pB0, 14)};
      pw2 = (v4u){PKW(pB1, 0), PKW(pB1, 2), PKW(pB1, 4), PKW(pB1, 6)}; pw3 = (v4u){PKW(pB1, 8), PKW(pB1, 10), PKW(pB1, 12), PKW(pB1, 14)};
      const lds_cptr vp_ = vp0 + 2 * sl_cur;
      _Pragma("unroll") for (int i = 0; i < 8; ++i) VRD(i, i);
      o[0] = MFMA32(PAF(0), VFR(0), o[0]); o[1] = MFMA32(PAF(0), VFR(4), o[1]); o[0] = MFMA32(PAF(1), VFR(1), o[0]); o[1] = MFMA32(PAF(1), VFR(5), o[1]);
      o[0] = MFMA32(PAF(2), VFR(2), o[0]); o[1] = MFMA32(PAF(2), VFR(6), o[1]); o[0] = MFMA32(PAF(3), VFR(3), o[0]); o[1] = MFMA32(PAF(3), VFR(7), o[1]);
      SBAR();
      _Pragma("unroll") for (int i = 0; i < 8; ++i) VRD(i, 8 + i);
      o[2] = MFMA32(PAF(0), VFR(0), o[2]); o[3] = MFMA32(PAF(0), VFR(4), o[3]); o[2] = MFMA32(PAF(1), VFR(1), o[2]); o[3] = MFMA32(PAF(1), VFR(5), o[3]);
      o[2] = MFMA32(PAF(2), VFR(2), o[2]); o[3] = MFMA32(PAF(2), VFR(6), o[3]); o[2] = MFMA32(PAF(3), VFR(3), o[2]); o[3] = MFMA32(PAF(3), VFR(7), o[3]); }
    { auto rr = __builtin_amdgcn_permlane32_swap(__float_as_uint(l_reg), __float_as_uint(l_reg), false, false); l_reg = __uint_as_float(rr[0]) + __uint_as_float(rr[1]); }
    if (hi == 0) wsf[32 + r32] = l_reg; asm volatile("s_waitcnt lgkmcnt(0)" ::: "memory");
#pragma unroll
    for (int r = 0; r < 16; ++r) { const float rl = __builtin_amdgcn_rcpf(wsf[32 + crow(r, hi)]);
#pragma unroll
        for (int d0 = 0; d0 < 4; ++d0) o[d0][r] *= rl; }
    asm volatile("s_waitcnt lgkmcnt(0)\n\ts_barrier" ::: "memory");
#undef DMA_K
#undef DMA_V
#undef DMA_V1
#undef DMA_V2
#undef GL
#undef ROT
#undef EX
#undef PKW
#undef PAF
#undef VFR
#undef VRD
#undef KRD
#undef ENDW
#undef GAPA
#undef GAPB
#undef STEP
}
}

__device__ __forceinline__ void unit_attn(const Frame& F, int L, int b, int h, int qrow0  , int seq) {
    f32x16 o[4];
    for (int m = 0; m < 2; ++m) {
        const float mfix = F.LP()[L * 16 + 10];
        if (__builtin_expect(mfix * (att::SCALE * 1.4426950408889634f) > 64.f, 0))
            att::body<true>(F.QH() + (size_t)qrow0 * 512 + (h * 2 + m) * 64, F.KH() + (size_t)b * NKEY * 512 + (h * 2 + m) * 64, F.VH() + (size_t)b * NKEY * 512 + h * 128, seq, mfix, (LAS char*)F.lds, o);
        else
            att::body_fast(F.QH() + (size_t)qrow0 * 512 + (h * 2 + m) * 64, F.KH() + (size_t)b * NKEY * 512 + (h * 2 + m) * 64, F.VH() + (size_t)b * NKEY * 512 + h * 128, seq, (LAS char*)F.lds, o);
        if (m == 0) {
            int tid = F.tid; asm volatile("" : "+v"(tid));
            const int lane = tid & 63, wave = __builtin_amdgcn_readfirstlane(tid >> 6), r32 = lane & 31, hi = lane >> 5;
            float* scr = F.SCR() + (size_t)F.bid * 256 * 128 + (size_t)(wave * 32) * 128;
#pragma unroll
            for (int r = 0; r < 16; ++r)
#pragma unroll
                for (int d0 = 0; d0 < 4; ++d0) scr[crow(r, hi) * 128 + d0 * 32 + r32] = o[d0][r];
            asm volatile("s_waitcnt vmcnt(0)" ::: "memory");
        }
    }
    int tid = F.tid; asm volatile("" : "+v"(tid));
    const int lane = tid & 63, wave = __builtin_amdgcn_readfirstlane(tid >> 6), r32 = lane & 31, hi = lane >> 5;
    const float lam = F.LP()[L * 16 + 0], oscale = F.LP()[L * 16 + 1];
    const float* scr = F.SCR() + (size_t)F.bid * 256 * 128 + (size_t)(wave * 32) * 128;
    float sg[4];
#pragma unroll
    for (int d0 = 0; d0 < 4; ++d0) sg[d0] = F.subg()[L * 128 + d0 * 32 + r32] * oscale;
#pragma unroll
    for (int r = 0; r < 16; ++r) {
        float d[4]; float ss = 0.f;
#pragma unroll
        for (int d0 = 0; d0 < 4; ++d0) { d[d0] = scr[crow(r, hi) * 128 + d0 * 32 + r32] - lam * o[d0][r]; ss += d[d0] * d[d0]; }
        const float rs = rsqrtf(half_sum32(ss) * (1.f / 128.f) + EPS);
        bf16* mr = F.MIX() + (size_t)(qrow0 + wave * 32 + crow(r, hi)) * DM + h * 128;
#pragma unroll
        for (int d0 = 0; d0 < 4; ++d0) mr[d0 * 32 + r32] = (bf16)f2bf(d[d0] * rs * sg[d0]);
    }
}


constexpr int NPH_L = 12, NPHASE = 2 + DEPTH * NPH_L;
struct Args { const float* in[25]; float* out; unsigned char* ws; int gp_lo, gp_hi; };
__global__ void __launch_bounds__(NTHR, 2) fwd(Args args) {
    extern __shared__ __attribute__((aligned(16))) unsigned char lds[];
    Frame F;
    F.lds = (LAS unsigned char*)lds;
    F.tid = threadIdx.x; F.lane = F.tid & 63; F.wave = __builtin_amdgcn_readfirstlane(F.tid >> 6); F.bid = blockIdx.x; F.G = gridDim.x;
    F.in = args.in; F.out = args.out; F.ws = args.ws;
    unsigned char* ws = args.ws;
    volatile LAS unsigned* MISC = (volatile LAS unsigned*)(F.lds + MISC_OFF);
    for (int u = F.tid; u < (LDS_BYTES - RING_BYTES) / 4; u += NTHR) ((LAS unsigned*)(F.lds + RING_BYTES))[u] = 0u;
    __syncthreads();
#if MK_ONE_LAUNCH
    constexpr int lo = 0, hi = NPHASE;
#else
    const int lo = args.gp_lo, hi = args.gp_hi;
#endif
    unsigned* barw = (unsigned*)(ws + WS_CTL) + CW_BAR;
    XcdBarrier bar; bar.bar = barw; bar.x = 0; bar.st = nullptr;
    if (hi - lo > 1) bar = xcd_barrier_post(barw, MISC + 8);
#ifndef N_CV_N2
#define N_CV_N2 2
#endif
#ifndef N_CV_INP
#define N_CV_INP 1
#endif
#ifndef N_CV_OUT
#define N_CV_OUT 1
#endif
#ifndef N_CV_TOPK
#define N_CV_TOPK 1
#endif
#ifndef N_CV_DOWN
#define N_CV_DOWN 1
#endif
#ifndef PHM
#define PHM 0xFFFF
#endif
#define PB(i) (((PHM) >> (i)) & 1)
#ifndef DBLM
#define DBLM 0
#endif
#define REP(i) for (int rep_ = 0; rep_ < ((((DBLM) >> (i)) & 1) ? 2 : 1); ++rep_)
#define IN(k) (lo <= (k) && (k) < hi)
#ifndef BARX
#define BARX 1
#endif
#define SEAM(k) do { if (IN(k) && IN((k) + 1)) { for (int bx_ = 0; bx_ < BARX; ++bx_) xcd_barrier(bar); } } while (0)

    if (PB(0) && IN(0)) REP(0) ph_prologue(F);
    SEAM(0);
    if (PB(1) && IN(1)) REP(1) ph_norm1_first(F);
    SEAM(1);
    for (int L = 0; L < DEPTH; ++L) {
        const int base = 2 + NPH_L * L;
#define FRESH() do { F.tid = threadIdx.x; asm volatile("" : "+v"(F.tid)); F.lane = F.tid & 63; } while (0)
        if (PB(2) && IN(base + 0)) REP(2) {
            pg8::Gemm g{F.HN(), F.WIN() + (size_t)L * INC * DM, NROW, INC, DM}; pg8::StaticOrder S; S.init(NROW, INC, F.G, F.bid);
            EpiZ E{F.Z(), F.VH(), F.QH(), F.KH(), F.LP() + DEPTH * 16 + L * 128, F.ROPE()};
            pg8::gemm_phase<EpiZ, pg8::StaticOrder, true, true>(F.lds, g, S, E);
            if (F.bid >= (66 * 13) % 256) { FRESH(); conv_n(F, N_CV_INP); }
        }
        SEAM(base + 0);
        if (PB(3) && IN(base + 1)) REP(3) {
            FRESH();
            for (int u = F.bid; u < 1056; u += F.G) {
                const int v = u < 528 ? u : u - 528; const int b = v / 264, hh = (v / NCH) & 3, cc = v % NCH;
                if (u < 528) unit_retkv(F, L, b, hh, cc); else if (!(L == DEPTH - 1 && cc < 2)) unit_sg(F, L, b, hh, cc);
            }
        }
        SEAM(base + 1);
        if (PB(5) && IN(base + 3)) REP(5) { FRESH(); ph_scan(F, L); }
        SEAM(base + 3);
        if (PB(6) && IN(base + 4)) REP(6) {
            FRESH();
            for (int u = F.bid; u < 264 + 528; u += F.G) {
                if (u < 264) {
                    int b, hh, qrow0, seq;
                    if (u < 256) { const int bh = u & 7, qb = u >> 3; b = bh >> 2; hh = bh & 3; qrow0 = b * SEQ + qb * 256; seq = NKEY; }
                    else { if (L == DEPTH - 1) continue; const int v = u - 256; b = v >> 2; hh = v & 3; qrow0 = NLAT + b * CTXL; seq = CTXL; }
#ifndef NO_ATTN
                    unit_attn(F, L, b, hh, qrow0, seq);
#endif
                } else {
#ifndef NO_RETOUT
                    const int v = u - 264; if (!(L == DEPTH - 1 && (v % NCH) < 2)) unit_retout(F, L, v / 264, (v / NCH) & 3, v % NCH);
#endif
                }
            }
        }
        SEAM(base + 4);
        if (PB(7) && IN(base + 5)) REP(7) {
            pg8::Gemm g{F.MIX(), F.WOUT() + (size_t)L * DM * DM, NLAT, DM, DM}; pg8::StaticOrder S; S.init(NLAT, DM, F.G, F.bid);
#ifdef PROBE_OUT2
            { EpiResid E0{(bf16*)(F.ws + WS_Y), F.MOD() + (size_t)L * 3 * 6144 + 2048, L == 0 ? F.x_in() : nullptr}; pg8::gemm_phase<EpiResid, pg8::StaticOrder, true, true>(F.lds, g, S, E0); }
#endif
            EpiResid E{F.X(), F.MOD() + (size_t)L * 3 * 6144 + 2048, L == 0 ? F.x_in() : nullptr};
            pg8::gemm_phase<EpiResid, pg8::StaticOrder, true, true>(F.lds, g, S, E);
            if (L < DEPTH - 1) { FRESH(); for (int mu = F.bid; mu < 256; mu += F.G) unit_out_ctx(F, L, mu); }
        }
        SEAM(base + 5);
        if (PB(8) && IN(base + 6)) REP(8) { FRESH(); ph_norm2_router(F, L); if (F.bid >= (((L == DEPTH - 1) ? NLAT : NROW) / 16 + NWAVES - 1) / NWAVES) conv_n(F, N_CV_N2); }
        SEAM(base + 6);
        if (PB(9) && IN(base + 7)) REP(9) { FRESH(); ph_topk(F, L); if (F.bid >= ((L == DEPTH - 1) ? 32 : 64)) conv_n(F, N_CV_TOPK);
            conv_until(F, CONV_SEG0 + (unsigned)(L + 1) * CONV_PER_L); }
        SEAM(base + 7);
        if (PB(11) && IN(base + 9)) REP(11) {
            pg8::Gemm g{F.HN(), F.WGU() + (size_t)L * NE * 4096 * DM, NE * EROWS, NE * 4096, DM};        const int npm = (L == DEPTH - 1) ? 8 : 9; MoeOrder S{F.G, F.bid, 16, npm, NE * npm * 16};
            EpiSwiglu E{F.HH()};
            pg8::gemm_phase_ga<EpiSwiglu, MoeOrder>(F.lds, g, S, E, F.ROWIDX(), NROW, (LAS int*)(F.lds + ISLOT_OFF));
        }
        SEAM(base + 9);
        if (PB(12) && IN(base + 10)) REP(12) {
            pg8::Gemm g{F.HH(), F.WD() + (size_t)L * NE * DM * FF, NE * EROWS, NE * DM, FF}; const int npm = (L == DEPTH - 1) ? 8 : 9; MoeOrder S{F.G, F.bid, 4, npm, NE * npm * 4};
            pg8::EpiBf16<0> E{F.Y(), DM, nullptr, DM, 0, 1.f};
            pg8::gemm_phase<pg8::EpiBf16<0>, MoeOrder, true, true>(F.lds, g, S, E);
            if (L < DEPTH - 1 && F.bid >= 64) { FRESH(); conv_n(F, N_CV_DOWN); }
        }
        SEAM(base + 10);
        if (PB(13) && IN(base + 11)) REP(13) { FRESH(); ph_combine(F, L); }
        SEAM(base + 11);
    }
#undef IN
#undef SEAM
}

extern "C" void kernel_launch(void* const* d_in, const int* in_sizes, int n_in, void* d_out, int out_size, void* d_ws, size_t ws_size, hipStream_t stream) {
    static int grid = 0;
    if (grid == 0) {
        if (n_in != 25 || in_sizes[0] != NLAT * DM || out_size != NLAT * DM || ws_size < WS_END) {
            fprintf(stderr, "kernel_launch: built for 25 inputs, x/out of %d floats, >= %zu bytes of workspace; got n_in %d, in0 %d, out %d, ws %zu; nothing launched\n", NLAT * DM, (size_t)WS_END, n_in, n_in > 0 ? in_sizes[0] : -1, out_size, ws_size);
            grid = -1; return; }
        int dev = 0, cus = 0, per_cu = 0;
        if (hipGetDevice(&dev) != hipSuccess || hipDeviceGetAttribute(&cus, hipDeviceAttributeMultiprocessorCount, dev) != hipSuccess) { fprintf(stderr, "kernel_launch: device query failed\n"); grid = -1; return; }
        if (hipFuncSetAttribute((const void*)fwd, hipFuncAttributeMaxDynamicSharedMemorySize, LDS_BYTES) != hipSuccess) { fprintf(stderr, "kernel_launch: hipFuncSetAttribute failed\n"); grid = -1; return; }
        if (hipOccupancyMaxActiveBlocksPerMultiprocessor(&per_cu, (const void*)fwd, NTHR, LDS_BYTES) != hipSuccess || per_cu < 1)
            fprintf(stderr, "kernel_launch: note: occupancy query reports %d workgroups per CU\n", per_cu);
        (void)hipGetLastError();
        grid = cus;
    }
    if (grid < 0) return;
    if (hipMemsetAsync((char*)d_ws + WS_CTL, 0, CTL_ZERO_BYTES, stream) != hipSuccess) { fprintf(stderr, "kernel_launch: memset failed\n"); return; }
    Args a{};
    for (int i = 0; i < 25; ++i) a.in[i] = (const float*)d_in[i];
    a.out = (float*)d_out; a.ws = (unsigned char*)d_ws;
#if MK_ONE_LAUNCH
    a.gp_lo = 0; a.gp_hi = NPHASE;
    hipLaunchKernelGGL(fwd, dim3(grid), dim3(NTHR), LDS_BYTES, stream, a);
#else
    for (int gp = 0; gp < NPHASE; ++gp) { a.gp_lo = gp; a.gp_hi = gp + 1; hipLaunchKernelGGL(fwd, dim3(grid), dim3(NTHR), LDS_BYTES, stream, a); }
#endif
    const hipError_t le = hipPeekAtLastError();
    if (le != hipSuccess) fprintf(stderr, "kernel_launch: launch failed: %s\n", hipGetErrorName(le));
}
```

```cpp
#include <hip/hip_runtime.h>
#include <cstdio>
#include <cstdint>
#ifndef MK_ONE_LAUNCH
#define MK_ONE_LAUNCH 1
#endif
namespace pg8 {
#define PG8_LAS __attribute__((address_space(3)))
typedef unsigned short bf16_t;
typedef short bf16x8 __attribute__((ext_vector_type(8)));
typedef float f32x4 __attribute__((ext_vector_type(4)));
typedef unsigned u32x4 __attribute__((ext_vector_type(4)));
constexpr int BM = 256, BK = 64, HALF = 128, HTB = HALF * BK * 2  , STAGE_BYTES = 8 * HTB, NXCD = 8, WGM = 8;

__host__ __device__ __forceinline__ int lds_byte(int r, int c) { const int st = (r >> 4) * 2 + (c >> 5), rr = r & 15, cc = c & 31, ob = rr * 64 + cc * 2; return st * 1024 + (ob ^ (((ob >> 9) & 1) << 5)); }
__host__ __device__ __forceinline__ void stage_rc(int b, int& R, int& C) { const int st = b / 1024, sb = b % 1024, swz = sb ^ (((sb >> 9) & 1) << 5); R = (st >> 1) * 16 + swz / 64; C = (st & 1) * 32 + (swz % 64) / 2; }
__host__ __device__ __forceinline__ int perm32(int rho) { const int n = rho >> 4, i = rho & 15; return 8 * (i >> 2) + 4 * n + (i & 3); }

struct Unit { int pm, pn; };
struct Gemm { const bf16_t* A; const bf16_t* Bt; int M, N, K; };

struct StaticOrder {
    int nM, nN, nwg, G, c;
    __host__ __device__ void init(int M, int N, int G_, int c_) { nM = M / BM; nN = N / BM; nwg = nM * nN; G = G_; c = c_; }
    __host__ __device__ bool next(int i, Unit& u) const {
        const long L = (long)i * G + c; if (L >= nwg) return false;
        int wgid = (int)L; { const int q = nwg / NXCD, r = nwg % NXCD, xcd = wgid % NXCD, off = wgid / NXCD; wgid = (xcd < r ? xcd * (q + 1) : r * (q + 1) + (xcd - r) * q) + off; }
        const int nig = WGM * nN, gid = wgid / nig, fm = gid * WGM, gsz = (nM - fm) < WGM ? (nM - fm) : WGM;
        u.pm = fm + ((wgid % nig) % gsz); u.pn = (wgid % nig) / gsz; return true;
    }
    __device__ __forceinline__ void a_ready(const Unit&) const {}
    __device__ __forceinline__ void done(const Unit&) const {}
    __device__ __forceinline__ bool half_only(const Unit&) const { return false; }
};

__device__ __forceinline__ unsigned cvt_pk_bf16(float lo, float hi) { unsigned r; asm volatile("v_cvt_pk_bf16_f32 %0, %1, %2" : "=v"(r) : "v"(lo), "v"(hi)); return r; }
typedef float f32x2 __attribute__((ext_vector_type(2)));
__device__ __forceinline__ f32x2 gelu_pk(f32x2 v) {
    const f32x2 av = __builtin_elementwise_abs(v), d = av * 0.2316418882f + 1.0f;
    f32x2 t; t.x = __builtin_amdgcn_rcpf(d.x); t.y = __builtin_amdgcn_rcpf(d.y);
    f32x2 q = t * 0.5307027145f + (-0.7265760135f); q = q * t + 0.7107068705f; q = q * t + (-0.142248368f); q = q * t + 0.127414796f; q = q * t;
    const f32x2 s = (v * v) * (-0.72134752044f);
    f32x2 e; e.x = __builtin_amdgcn_exp2f(s.x); e.y = __builtin_amdgcn_exp2f(s.y);
    const f32x2 m = v * (q * e), r = v - m;
    f32x2 o; o.x = v.x < 0.f ? m.x : r.x; o.y = v.y < 0.f ? m.y : r.y; return o;
}

template <int ACT  > struct EpiBf16 {
    static constexpr bool PERM = true, AFTER_DRAIN = false; static_assert(ACT == 0 || ACT == 1, "EpiBf16: ACT is 0 (none) or 1 (gelu_pk)");
    bf16_t* O; int ldc; const float* bias; int split_cols; size_t split_stride; float scale0;
    __device__ __forceinline__ void operator()(const f32x4 (&acc)[2][2][4][2], const Unit& u, int wr, int wc, int fr, int fq) const {
        const int row0 = u.pm * BM + wr * 64 + fr; int colt = u.pn * BM; bf16_t* base = O;
        float sc = 1.f; if (split_cols) { const int t = colt / split_cols; base += (size_t)t * split_stride; colt -= t * split_cols; if (t == 0) sc = scale0; }
        const int col0 = colt + wc * 32 + 8 * fq, bcol0 = u.pn * BM + wc * 32 + 8 * fq;
        f32x4 bv[2][2];
#pragma unroll
        for (int bj = 0; bj < 2; ++bj)
#pragma unroll
            for (int n = 0; n < 2; ++n) bv[bj][n] = bias ? *(const f32x4*)(bias + bcol0 + bj * HALF + 4 * n) : (f32x4){0.f, 0.f, 0.f, 0.f};
#pragma unroll
        for (int ai = 0; ai < 2; ++ai)
#pragma unroll
            for (int m = 0; m < 4; ++m) { bf16_t* rowp = base + (size_t)(row0 + ai * HALF + m * 16) * ldc + col0;
#pragma unroll
                for (int bj = 0; bj < 2; ++bj) { f32x4 v0 = acc[ai][bj][m][0] + bv[bj][0], v1 = acc[ai][bj][m][1] + bv[bj][1];
                    if (ACT == 1) { f32x2 a = gelu_pk((f32x2){v0[0], v0[1]}), b = gelu_pk((f32x2){v0[2], v0[3]}), c = gelu_pk((f32x2){v1[0], v1[1]}), d = gelu_pk((f32x2){v1[2], v1[3]});
                        v0 = (f32x4){a.x, a.y, b.x, b.y}; v1 = (f32x4){c.x, c.y, d.x, d.y}; }
                    v0 = v0 * sc; v1 = v1 * sc; u32x4 w; w.x = cvt_pk_bf16(v0[0], v0[1]); w.y = cvt_pk_bf16(v0[2], v0[3]); w.z = cvt_pk_bf16(v1[0], v1[1]); w.w = cvt_pk_bf16(v1[2], v1[3]);
                    *(u32x4*)(rowp + bj * HALF) = w; } }
    }
};
template <class Epi, class Sched, bool ALIGN_EPI = false, bool SP2 = false>
__device__ __forceinline__ void gemm_phase(PG8_LAS unsigned char* lds, const Gemm g, const Sched& S, const Epi& E) {
    int tid = threadIdx.x; asm volatile("" : "+v"(tid));
    const int wid = __builtin_amdgcn_readfirstlane(tid >> 6), lane = tid & 63, wr = wid >> 2, wc = wid & 3, fr = lane & 15, fq = lane >> 4;
    const int K = g.K, nt = K / BK;
    unsigned voffA[2], voffB[2];
#pragma unroll
    for (int i = 0; i < 2; ++i) { int R, C; stage_rc(tid * 16 + i * 8192, R, C); const int Rb = Epi::PERM ? ((R & ~31) + perm32(R & 31)) : R;
        voffA[i] = (unsigned)(R * K + C) * 2u; voffB[i] = (unsigned)(Rb * K + C) * 2u; }
    const size_t kstep = (size_t)(BK * 2);
    const size_t hstep = (size_t)HALF * K * 2;
    const size_t tstep = 2 * hstep;
    const unsigned ldsw = (unsigned)wid * 1024u;
    const int aoff = lds_byte(wr * 64 + fr, fq * 8), boff = lds_byte(wc * 32 + fr, fq * 8);
#define PG8_SA(b, h) (((b) * 2 + (h)) * HTB)
#define PG8_SB(b, h) ((4 + (b) * 2 + (h)) * HTB)
#define PG8_STAGE(bufoff, gbase, voff) do { _Pragma("unroll") for (int _i = 0; _i < 2; ++_i) \
        __builtin_amdgcn_global_load_lds((const unsigned*)((const char*)(gbase) + (voff)[_i]), (PG8_LAS unsigned*)(lds + (bufoff) + ldsw + _i * 8192), 16, 0, 0); } while (0)
#define PG8_LDA(dst, b, h) do { _Pragma("unroll") for (int m = 0; m < 4; ++m) _Pragma("unroll") for (int k = 0; k < 2; ++k) dst[m][k] = *(const PG8_LAS bf16x8*)(lds + PG8_SA(b, h) + aoff + m * 2048 + k * 1024); } while (0)
#define PG8_LDB(dst, b, h) do { _Pragma("unroll") for (int n = 0; n < 2; ++n) _Pragma("unroll") for (int k = 0; k < 2; ++k) dst[n][k] = *(const PG8_LAS bf16x8*)(lds + PG8_SB(b, h) + boff + n * 2048 + k * 1024); } while (0)
#define PG8_MMA(ai, bj, At, Bt) do { __builtin_amdgcn_s_setprio(1); _Pragma("unroll") for (int m = 0; m < 4; ++m) _Pragma("unroll") for (int n = 0; n < 2; ++n) _Pragma("unroll") for (int k = 0; k < 2; ++k) \
        acc[ai][bj][m][n] = __builtin_amdgcn_mfma_f32_16x16x32_bf16(Bt[n][k], At[m][k], acc[ai][bj][m][n], 0, 0, 0); __builtin_amdgcn_s_setprio(0); } while (0)
#define PG8_WAIT_V(n) asm volatile("s_waitcnt vmcnt(" #n ")" ::: "memory")
#define PG8_WAIT_L(n) asm volatile("s_waitcnt lgkmcnt(" #n ")" ::: "memory")
#define PG8_BAR __builtin_amdgcn_s_barrier()
#define PG8_SCHED __builtin_amdgcn_sched_barrier(0)
    Unit cur, nxt; int ui = 0;
    if (!S.next(0, cur)) return;
    f32x4 acc[2][2][4][2];
#pragma unroll
    for (int a = 0; a < 2; ++a)
#pragma unroll
        for (int b = 0; b < 2; ++b)
#pragma unroll
            for (int m = 0; m < 4; ++m)
#pragma unroll
                for (int n = 0; n < 2; ++n) acc[a][b][m][n] = (f32x4){0.f, 0.f, 0.f, 0.f};
    bf16x8 At[4][2], B0[2][2], B1[2][2];
    const char* cA = (const char*)g.A + (size_t)cur.pm * tstep; const char* cB = (const char*)g.Bt + (size_t)cur.pn * tstep;
    S.a_ready(cur);
    if constexpr (SP2) {
        PG8_STAGE(PG8_SB(0, 0), cB, voffB); PG8_STAGE(PG8_SB(0, 1), cB + hstep, voffB); PG8_STAGE(PG8_SA(0, 0), cA, voffA); PG8_STAGE(PG8_SA(0, 1), cA + hstep, voffA);
        if (wr == 1) PG8_BAR;
        PG8_WAIT_V(2); PG8_BAR;
        PG8_STAGE(PG8_SB(1, 0), cB + kstep, voffB); PG8_STAGE(PG8_SA(1, 0), cA + kstep, voffA); PG8_STAGE(PG8_SB(1, 1), cB + hstep + kstep, voffB);
        PG8_WAIT_V(6); PG8_BAR;
    } else {
        PG8_STAGE(PG8_SB(0, 0), cB, voffB); PG8_STAGE(PG8_SA(0, 0), cA, voffA); PG8_STAGE(PG8_SB(0, 1), cB + hstep, voffB); PG8_STAGE(PG8_SA(0, 1), cA + hstep, voffA);
        if (wr == 1) PG8_BAR;
        PG8_WAIT_V(4); PG8_BAR;
        PG8_STAGE(PG8_SB(1, 0), cB + kstep, voffB); PG8_STAGE(PG8_SA(1, 0), cA + kstep, voffA); PG8_STAGE(PG8_SB(1, 1), cB + hstep + kstep, voffB);
        PG8_WAIT_V(6); PG8_BAR;
    }
    for (;;) {
        const bool has_next = S.next(ui + 1, nxt);
        const bool ho = S.half_only(cur);
        const char* nA = has_next ? (const char*)g.A + (size_t)nxt.pm * tstep : cA; const char* nB = has_next ? (const char*)g.Bt + (size_t)nxt.pn * tstep : cB;
        for (int t = 0; t < nt; t += 2) {
            const bool last = (t == nt - 2);
            const char* a1 = cA + (size_t)(t + 1) * kstep;
            const char* a2 = last ? nA : cA + (size_t)(t + 2) * kstep; const char* b2 = last ? nB : cB + (size_t)(t + 2) * kstep;
            const char* a3 = a2 + kstep; const char* b3 = b2 + kstep;
            if (last && has_next) S.a_ready(nxt);
            if constexpr (SP2) {
            PG8_LDB(B0, 0, 0); PG8_LDB(B1, 0, 1); PG8_SCHED; PG8_LDA(At, 0, 0); PG8_STAGE(PG8_SA(1, 1), a1 + hstep, voffA);
            PG8_WAIT_V(8); PG8_WAIT_L(0); PG8_BAR; PG8_MMA(0, 0, At, B0); PG8_MMA(0, 1, At, B1); PG8_BAR; PG8_SCHED;
            PG8_LDA(At, 0, 1); PG8_STAGE(PG8_SB(0, 0), b2, voffB); PG8_STAGE(PG8_SB(0, 1), b2 + hstep, voffB); PG8_STAGE(PG8_SA(0, 0), a2, voffA);
            PG8_WAIT_V(8); PG8_WAIT_L(0); PG8_BAR; if (!ho) { PG8_MMA(1, 0, At, B0); PG8_MMA(1, 1, At, B1); } PG8_BAR; PG8_SCHED;
            PG8_LDB(B0, 1, 0); PG8_LDB(B1, 1, 1); PG8_SCHED; PG8_LDA(At, 1, 0); PG8_STAGE(PG8_SA(0, 1), a2 + hstep, voffA);
            PG8_WAIT_V(8); PG8_WAIT_L(0); PG8_BAR; PG8_MMA(0, 0, At, B0); PG8_MMA(0, 1, At, B1); PG8_BAR; PG8_SCHED;
            PG8_LDA(At, 1, 1); PG8_STAGE(PG8_SB(1, 0), b3, voffB); PG8_STAGE(PG8_SB(1, 1), b3 + hstep, voffB); PG8_STAGE(PG8_SA(1, 0), a3, voffA);
            PG8_WAIT_V(8); PG8_WAIT_L(0); PG8_BAR; if (!ho) { PG8_MMA(1, 0, At, B0); PG8_MMA(1, 1, At, B1); } PG8_BAR; PG8_SCHED;
            } else {
            PG8_LDB(B0, 0, 0); PG8_SCHED; PG8_LDA(At, 0, 0); PG8_STAGE(PG8_SA(1, 1), a1 + hstep, voffA);
            PG8_WAIT_L(8); PG8_BAR; PG8_WAIT_L(0); PG8_MMA(0, 0, At, B0); PG8_BAR; PG8_SCHED;
            PG8_LDB(B1, 0, 1); PG8_STAGE(PG8_SB(0, 0), b2, voffB);
            PG8_BAR; PG8_WAIT_L(0); PG8_MMA(0, 1, At, B1); PG8_BAR;
            PG8_LDA(At, 0, 1); PG8_STAGE(PG8_SA(0, 0), a2, voffA);
            PG8_BAR; PG8_WAIT_L(0); PG8_MMA(1, 0, At, B0); PG8_BAR; PG8_SCHED;
            PG8_STAGE(PG8_SB(0, 1), b2 + hstep, voffB);
            PG8_WAIT_V(6); PG8_BAR; PG8_MMA(1, 1, At, B1); PG8_BAR;
            PG8_LDB(B0, 1, 0); PG8_SCHED; PG8_LDA(At, 1, 0); PG8_STAGE(PG8_SA(0, 1), a2 + hstep, voffA);
            PG8_WAIT_L(8); PG8_BAR; PG8_WAIT_L(0); PG8_MMA(0, 0, At, B0); PG8_BAR; PG8_SCHED;
            PG8_LDB(B1, 1, 1); PG8_STAGE(PG8_SB(1, 0), b3, voffB);
            PG8_BAR; PG8_WAIT_L(0); PG8_MMA(0, 1, At, B1); PG8_BAR;
            PG8_LDA(At, 1, 1); PG8_STAGE(PG8_SA(1, 0), a3, voffA);
            PG8_BAR; PG8_WAIT_L(0); PG8_MMA(1, 0, At, B0); PG8_BAR; PG8_SCHED;
            PG8_STAGE(PG8_SB(1, 1), b3 + hstep, voffB);
            PG8_WAIT_V(6); PG8_BAR; PG8_MMA(1, 1, At, B1); PG8_BAR;
            }
        }
        if constexpr (ALIGN_EPI) { if (wr == 0) PG8_BAR; }
        if constexpr (!Epi::AFTER_DRAIN) { E(acc, cur, wr, wc, fr, fq); S.done(cur); }
        if (!has_next) break;
#pragma unroll
        for (int a = 0; a < 2; ++a)
#pragma unroll
            for (int b = 0; b < 2; ++b)
#pragma unroll
                for (int m = 0; m < 4; ++m)
#pragma unroll
                    for (int n = 0; n < 2; ++n) acc[a][b][m][n] = (f32x4){0.f, 0.f, 0.f, 0.f};
        cur = nxt; cA = nA; cB = nB; ++ui;
        if constexpr (ALIGN_EPI) { if (wr == 1) PG8_BAR; }
    }
    PG8_WAIT_V(0);
    if constexpr (!ALIGN_EPI) { if (wr == 0) PG8_BAR; }
    PG8_BAR;
    if constexpr (Epi::AFTER_DRAIN) { E.fused(acc, cur, wr, wc, fr, fq, lds, wid, lane); S.done(cur); }
#undef PG8_SA
#undef PG8_SB
#undef PG8_STAGE
#undef PG8_LDA
#undef PG8_LDB
#undef PG8_MMA
#undef PG8_WAIT_V
#undef PG8_WAIT_L
#undef PG8_BAR
#undef PG8_SCHED
}
}
namespace pg8 {
template <class Epi, class Sched>
__device__ __forceinline__ void gemm_phase_ga(PG8_LAS unsigned char* lds, const Gemm g, const Sched& S, const Epi& E, const int* rowidx, int zrow, PG8_LAS int* islot) {
    constexpr bool ALIGN_EPI = true;
    int tid = threadIdx.x; asm volatile("" : "+v"(tid));
    const int wid = __builtin_amdgcn_readfirstlane(tid >> 6), lane = tid & 63, wr = wid >> 2, wc = wid & 3, fr = lane & 15, fq = lane >> 4;
    const int K = g.K, nt = K / BK;
    unsigned voffB[2]; int RA[2], CA[2];
#pragma unroll
    for (int i = 0; i < 2; ++i) { int R, C; stage_rc(tid * 16 + i * 8192, R, C); const int Rb = Epi::PERM ? ((R & ~31) + perm32(R & 31)) : R;
        RA[i] = R; CA[i] = C; voffB[i] = (unsigned)(Rb * K + C) * 2u; }
    unsigned voC[2][2], voN[2][2];
    const size_t kstep = (size_t)(BK * 2);
    const size_t hstep = (size_t)HALF * K * 2;
    const size_t tstep = 2 * hstep;
    const unsigned ldsw = (unsigned)wid * 1024u;
    const int aoff = lds_byte(wr * 64 + fr, fq * 8), boff = lds_byte(wc * 32 + fr, fq * 8);
#define PG8_SA(b, h) (((b) * 2 + (h)) * HTB)
#define PG8_SB(b, h) ((4 + (b) * 2 + (h)) * HTB)
#define PG8_STAGE(bufoff, gbase, voff) do { _Pragma("unroll") for (int _i = 0; _i < 2; ++_i) \
        __builtin_amdgcn_global_load_lds((const unsigned*)((const char*)(gbase) + (voff)[_i]), (PG8_LAS unsigned*)(lds + (bufoff) + ldsw + _i * 8192), 16, 0, 0); } while (0)
#define PG8_LDA(dst, b, h) do { _Pragma("unroll") for (int m = 0; m < 4; ++m) _Pragma("unroll") for (int k = 0; k < 2; ++k) dst[m][k] = *(const PG8_LAS bf16x8*)(lds + PG8_SA(b, h) + aoff + m * 2048 + k * 1024); } while (0)
#define PG8_LDB(dst, b, h) do { _Pragma("unroll") for (int n = 0; n < 2; ++n) _Pragma("unroll") for (int k = 0; k < 2; ++k) dst[n][k] = *(const PG8_LAS bf16x8*)(lds + PG8_SB(b, h) + boff + n * 2048 + k * 1024); } while (0)
#define PG8_MMA(ai, bj, At, Bt) do { __builtin_amdgcn_s_setprio(1); _Pragma("unroll") for (int m = 0; m < 4; ++m) _Pragma("unroll") for (int n = 0; n < 2; ++n) _Pragma("unroll") for (int k = 0; k < 2; ++k) \
        acc[ai][bj][m][n] = __builtin_amdgcn_mfma_f32_16x16x32_bf16(Bt[n][k], At[m][k], acc[ai][bj][m][n], 0, 0, 0); __builtin_amdgcn_s_setprio(0); } while (0)
#define PG8_WAIT_V(n) asm volatile("s_waitcnt vmcnt(" #n ")" ::: "memory")
#define PG8_WAIT_L(n) asm volatile("s_waitcnt lgkmcnt(" #n ")" ::: "memory")
#define PG8_BAR __builtin_amdgcn_s_barrier()
#define PG8_SCHED __builtin_amdgcn_sched_barrier(0)
    constexpr bool SP2 = true;
    Unit cur, nxt; int ui = 0;
    if (!S.next(0, cur)) return;
    f32x4 acc[2][2][4][2];
#pragma unroll
    for (int a = 0; a < 2; ++a)
#pragma unroll
        for (int b = 0; b < 2; ++b)
#pragma unroll
            for (int m = 0; m < 4; ++m)
#pragma unroll
                for (int n = 0; n < 2; ++n) acc[a][b][m][n] = (f32x4){0.f, 0.f, 0.f, 0.f};
    bf16x8 At[4][2], B0[2][2], B1[2][2];
    const char* const Ab = (const char*)g.A; const char* cB = (const char*)g.Bt + (size_t)cur.pn * tstep;
    S.a_ready(cur);
#pragma unroll
    for (int h = 0; h < 2; ++h)
#pragma unroll
        for (int i = 0; i < 2; ++i) { const int s = rowidx[cur.pm * BM + h * HALF + RA[i]]; voC[h][i] = (unsigned)((s < 0 ? zrow : s) * K + CA[i]) * 2u; voN[h][i] = voC[h][i]; }
    asm volatile("s_waitcnt vmcnt(0)" ::: "memory");
    if constexpr (SP2) {
        PG8_STAGE(PG8_SB(0, 0), cB, voffB); PG8_STAGE(PG8_SB(0, 1), cB + hstep, voffB); PG8_STAGE(PG8_SA(0, 0), Ab, voC[0]); PG8_STAGE(PG8_SA(0, 1), Ab, voC[1]);
        if (wr == 1) PG8_BAR;
        PG8_WAIT_V(2); PG8_BAR;
        PG8_STAGE(PG8_SB(1, 0), cB + kstep, voffB); PG8_STAGE(PG8_SA(1, 0), Ab + kstep, voC[0]); PG8_STAGE(PG8_SB(1, 1), cB + hstep + kstep, voffB);
        PG8_WAIT_V(6); PG8_BAR;
    }
    for (;;) {
        const bool has_next = S.next(ui + 1, nxt);
        const bool ho = S.half_only(cur);
        const char* nB = has_next ? (const char*)g.Bt + (size_t)nxt.pn * tstep : cB;
        if (has_next && wid == 0) __builtin_amdgcn_global_load_lds((const unsigned*)(rowidx + nxt.pm * BM + lane * 4), (PG8_LAS unsigned*)(islot + ((ui + 1) & 1) * BM), 16, 0, 0);
        for (int t = 0; t < nt; t += 2) {
            const bool last = (t == nt - 2);
            const char* a1 = Ab + (size_t)(t + 1) * kstep;
            const char* a2 = last ? Ab : Ab + (size_t)(t + 2) * kstep; const char* b2 = last ? nB : cB + (size_t)(t + 2) * kstep;
            const char* a3 = a2 + kstep; const char* b3 = b2 + kstep;
            if (last && has_next) { S.a_ready(nxt);
                const PG8_LAS int* sl = islot + ((ui + 1) & 1) * BM;
#pragma unroll
                for (int h = 0; h < 2; ++h)
#pragma unroll
                    for (int i = 0; i < 2; ++i) { const int s = sl[h * HALF + RA[i]]; voN[h][i] = (unsigned)((s < 0 ? zrow : s) * K + CA[i]) * 2u; } }
            unsigned vo2[2][2];
#pragma unroll
            for (int h = 0; h < 2; ++h)
#pragma unroll
                for (int i = 0; i < 2; ++i) vo2[h][i] = last ? voN[h][i] : voC[h][i];
            if constexpr (SP2) {
            PG8_LDB(B0, 0, 0); PG8_LDB(B1, 0, 1); PG8_SCHED; PG8_LDA(At, 0, 0); PG8_STAGE(PG8_SA(1, 1), a1, voC[1]);
            PG8_WAIT_V(8); PG8_WAIT_L(0); PG8_BAR; PG8_MMA(0, 0, At, B0); PG8_MMA(0, 1, At, B1); PG8_BAR; PG8_SCHED;
            PG8_LDA(At, 0, 1); PG8_STAGE(PG8_SB(0, 0), b2, voffB); PG8_STAGE(PG8_SB(0, 1), b2 + hstep, voffB); PG8_STAGE(PG8_SA(0, 0), a2, vo2[0]);
            PG8_WAIT_V(8); PG8_WAIT_L(0); PG8_BAR; if (!ho) { PG8_MMA(1, 0, At, B0); PG8_MMA(1, 1, At, B1); } PG8_BAR; PG8_SCHED;
            PG8_LDB(B0, 1, 0); PG8_LDB(B1, 1, 1); PG8_SCHED; PG8_LDA(At, 1, 0); PG8_STAGE(PG8_SA(0, 1), a2, vo2[1]);
            PG8_WAIT_V(8); PG8_WAIT_L(0); PG8_BAR; PG8_MMA(0, 0, At, B0); PG8_MMA(0, 1, At, B1); PG8_BAR; PG8_SCHED;
            PG8_LDA(At, 1, 1); PG8_STAGE(PG8_SB(1, 0), b3, voffB); PG8_STAGE(PG8_SB(1, 1), b3 + hstep, voffB); PG8_STAGE(PG8_SA(1, 0), a3, vo2[0]);
            PG8_WAIT_V(8); PG8_WAIT_L(0); PG8_BAR; if (!ho) { PG8_MMA(1, 0, At, B0); PG8_MMA(1, 1, At, B1); } PG8_BAR; PG8_SCHED;
            }
        }
        if constexpr (ALIGN_EPI) { if (wr == 0) PG8_BAR; }
        if constexpr (!Epi::AFTER_DRAIN) { E(acc, cur, wr, wc, fr, fq); S.done(cur); }
        if (!has_next) break;
#pragma unroll
        for (int a = 0; a < 2; ++a)
#pragma unroll
            for (int b = 0; b < 2; ++b)
#pragma unroll
                for (int m = 0; m < 4; ++m)
#pragma unroll
                    for (int n = 0; n < 2; ++n) acc[a][b][m][n] = (f32x4){0.f, 0.f, 0.f, 0.f};
        cur = nxt; cB = nB; ++ui;
#pragma unroll
        for (int h = 0; h < 2; ++h)
#pragma unroll
            for (int i = 0; i < 2; ++i) voC[h][i] = voN[h][i];
        if constexpr (ALIGN_EPI) { if (wr == 1) PG8_BAR; }
    }
    PG8_WAIT_V(0);
    if constexpr (!ALIGN_EPI) { if (wr == 0) PG8_BAR; }
    PG8_BAR;
    if constexpr (Epi::AFTER_DRAIN) { E.fused(acc, cur, wr, wc, fr, fq, lds, wid, lane); S.done(cur); }
#undef PG8_SA
#undef PG8_SB
#undef PG8_STAGE
#undef PG8_LDA
#undef PG8_LDB
#undef PG8_MMA
#undef PG8_WAIT_V
#undef PG8_WAIT_L
#undef PG8_BAR
#undef PG8_SCHED
}
}

constexpr int DM = 1024, NB = 2, SEQ = 8192, CTXL = 256, DEPTH = 4;
constexpr int NLAT = NB * SEQ, NCTX = NB * CTXL, NROW = NLAT + NCTX;
constexpr int INC = 3328, NKEY = CTXL + SEQ;
constexpr int NE = 16, FF = 2048, EROWS = 2304;
constexpr int NCH = 66;
constexpr float EPS = 1e-6f;
constexpr int ZQ = 0, ZK = 512, ZV = 1024, ZRQ = 1536, ZRK = 1792, ZRV = 2048, ZGF = 2304, ZGB = 2560, ZSU = 2816, ZSV = 3072;
constexpr int NWAVES = 8, NTHR = 512;
constexpr int RWLD = DM + 8;

constexpr size_t MiB = 1u << 20;
constexpr size_t WS_CTL = 0, CTL_ZERO_BYTES = 1 * MiB;
constexpr size_t WS_MOD = 1 * MiB;
constexpr size_t WS_LP = WS_MOD + 512 * 1024;
constexpr size_t WS_ROPE = 2 * MiB, WS_RETT = 4 * MiB;
constexpr size_t WS_SGW = 6 * MiB;
constexpr size_t WS_RWS = 7 * MiB;
constexpr size_t WS_WIN = 8 * MiB;
constexpr size_t WS_WOUT = WS_WIN + 26 * MiB;
constexpr size_t WS_WGU = WS_WOUT + 8 * MiB;
constexpr size_t WS_WD = WS_WGU + 512 * MiB;
constexpr size_t WS_X = WS_WD + 256 * MiB;
constexpr size_t WS_HN = WS_X + 66 * MiB;
constexpr size_t WS_Z = WS_HN + 34 * MiB;
constexpr size_t WS_QH = WS_Z + 108 * MiB;
constexpr size_t WS_KH = WS_QH + 17 * MiB;
constexpr size_t WS_VH = WS_KH + 17 * MiB;
constexpr size_t WS_RQ = WS_VH + 17 * MiB;
constexpr size_t WS_RK = WS_RQ + 9 * MiB;
constexpr size_t WS_SVN = WS_RK + 9 * MiB;
constexpr size_t WS_KVT = WS_SVN + 9 * MiB;
constexpr size_t WS_SPREV = WS_KVT + 17 * MiB;
constexpr size_t WS_MIX = WS_SPREV + 17 * MiB;
constexpr size_t WS_SCR = WS_MIX + 33 * MiB;
constexpr size_t WS_AFF = WS_SCR + 32 * MiB;
constexpr size_t WS_SLOT = WS_AFF + 2 * MiB;
constexpr size_t WS_ROWIDX = WS_SLOT + 2 * MiB;
constexpr size_t WS_GATE = WS_ROWIDX + 1 * MiB;
constexpr size_t WS_XS = WS_GATE + 1 * MiB;
constexpr size_t WS_HH = WS_XS + 72 * MiB;
constexpr size_t WS_Y = WS_HH + 144 * MiB;
constexpr size_t WS_END = WS_Y + 72 * MiB;
static_assert((size_t)4 * INC * DM * 2 <= 26 * MiB && (size_t)NROW * DM * 4 <= 66 * MiB && (size_t)NROW * INC * 2 <= 108 * MiB && (size_t)NROW * 512 * 2 <= 17 * MiB, "ws map");
static_assert((size_t)NB * 4 * 2 * NCH * 4096 * 4 <= 17 * MiB && (size_t)NE * EROWS * DM * 2 <= 72 * MiB && (size_t)NE * EROWS * FF * 2 <= 144 * MiB, "ws map");
constexpr int CW_BAR = 4096;

constexpr int RING_BYTES = 131072;
constexpr int MISC_OFF = RING_BYTES + 320;
constexpr int ISLOT_OFF = RING_BYTES + 1024;
constexpr int LDS_BYTES = 147456;

#define GAS __attribute__((address_space(1)))
#define LAS __attribute__((address_space(3)))
typedef unsigned short bf16;
typedef unsigned v4u __attribute__((ext_vector_type(4)));
typedef float f32x4 __attribute__((ext_vector_type(4)));
typedef short bf16x8 __attribute__((ext_vector_type(8)));
typedef GAS unsigned gu32;
typedef GAS unsigned long long gu64;
#define RLX_AGENT __ATOMIC_RELAXED, __HIP_MEMORY_SCOPE_AGENT
#define LDS_WAIT() asm volatile("s_waitcnt lgkmcnt(0)" ::: "memory")
#define VM_WAIT() asm volatile("s_waitcnt vmcnt(0)" ::: "memory")
__device__ __forceinline__ unsigned long long rt() { return __builtin_amdgcn_s_memrealtime(); }
__device__ __forceinline__ unsigned f2bf(float f) { unsigned u = __builtin_bit_cast(unsigned, f); return (u + 0x7fffu + ((u >> 16) & 1u)) >> 16; }
__device__ __forceinline__ unsigned pk2(float lo, float hi) { return f2bf(lo) | (f2bf(hi) << 16); }

#define XB_TMO      128
#define XB_XCNT(j)  (256  + 64 * (j))
#define XB_XSUB(j)  (1280 + 64 * (j))
#define XB_XGEN(j)  (2304 + 64 * (j))
#define XB_TOP      3328
#define XB_TOPGEN   3392
#define XCD_BAR_WORDS 3456
#define XB_SPIN_CAP (1u << 18)

__device__ __forceinline__ unsigned xb_ld(unsigned* p)              { return __hip_atomic_load(p, __ATOMIC_RELAXED, __HIP_MEMORY_SCOPE_AGENT); }
__device__ __forceinline__ unsigned xb_add(unsigned* p, unsigned v) { return __hip_atomic_fetch_add(p, v, __ATOMIC_RELAXED, __HIP_MEMORY_SCOPE_AGENT); }
__device__ __forceinline__ unsigned xb_xcc_id() { return (unsigned)__builtin_amdgcn_s_getreg((3 << 11) | 20) & 0xFu; }
#define XB_SPIN(cond, bar) do { unsigned _sp = 0; while (cond) { __builtin_amdgcn_s_sleep(1); \
    if ((++_sp & 255u) == 0u) { if (xb_ld(&(bar)[XB_TMO])) break; if (_sp > XB_SPIN_CAP) { atomicAdd(&(bar)[XB_TMO], 1u); break; } } } } while (0)

struct XcdBarrier {
    unsigned* bar; unsigned x;
    volatile LAS unsigned* st;
};

__device__ __forceinline__ XcdBarrier xcd_barrier_post(unsigned* bar, volatile LAS unsigned* st) {
    XcdBarrier b; b.bar = bar; b.x = xb_xcc_id(); b.st = st;
    if (threadIdx.x == 0) (void)xb_add(&bar[XB_XCNT(b.x)], 1u);
    return b;
}
__device__ __forceinline__ void xcd_barrier_complete(unsigned* bar, unsigned x, unsigned& nloc, unsigned& nx) {
    const unsigned G = gridDim.x * gridDim.y * gridDim.z;
    unsigned sum, cnt, mine, sp = 0u;
    for (;;) {
        sum = 0u; cnt = 0u; mine = 0u;
#pragma unroll
        for (unsigned j = 0; j < 16; ++j) { const unsigned c = xb_ld(&bar[XB_XCNT(j)]); sum += c; cnt += (c > 0u) ? 1u : 0u; mine = (j == x) ? c : mine; }
        if (sum == G) break;
        __builtin_amdgcn_s_sleep(1);
        if ((++sp & 255u) == 0u) { if (xb_ld(&bar[XB_TMO])) break; if (sp > XB_SPIN_CAP) { atomicAdd(&bar[XB_TMO], 1u); break; } }
    }
    nloc = mine > 0u ? mine : 1u; nx = cnt > 0u ? cnt : 1u;
}

__device__ __forceinline__ void xcd_barrier(const XcdBarrier& b) {
    asm volatile("s_waitcnt vmcnt(0)" ::: "memory");
    __syncthreads();
    if (threadIdx.x == 0) {
        unsigned* bar = b.bar;
        __builtin_amdgcn_s_waitcnt(0);
        unsigned nloc = b.st[0], nx = b.st[1];
        if (nloc == 0u) { xcd_barrier_complete(bar, b.x, nloc, nx); b.st[0] = nloc; b.st[1] = nx; }
        const unsigned old = xb_add(&bar[XB_XSUB(b.x)], 1u);
        const unsigned gen = old / nloc;
        if (old + 1u == (gen + 1u) * nloc) {
            __builtin_amdgcn_fence(__ATOMIC_RELEASE, "agent");
            asm volatile("s_waitcnt vmcnt(0)" ::: "memory");
            const unsigned og = xb_add(&bar[XB_TOP], 1u);
            const unsigned tg = og / nx;
            if (og + 1u == (tg + 1u) * nx) xb_add(&bar[XB_TOPGEN], 1u);
            else XB_SPIN(xb_ld(&bar[XB_TOPGEN]) == tg, bar);
            __builtin_amdgcn_fence(__ATOMIC_ACQUIRE, "agent");
            xb_add(&bar[XB_XGEN(b.x)], 1u);
            asm volatile("s_waitcnt vmcnt(0)" ::: "memory");
        } else {
            XB_SPIN(xb_ld(&bar[XB_XGEN(b.x)]) == gen, bar);
            __builtin_amdgcn_fence(__ATOMIC_ACQUIRE, "agent");
            asm volatile("s_waitcnt vmcnt(0)" ::: "memory");
        }
    }
    __syncthreads();
}

typedef float f32x16 __attribute__((ext_vector_type(16)));
typedef short s16x4 __attribute__((ext_vector_type(4)));
typedef unsigned short u16x4 __attribute__((ext_vector_type(4)));
struct Frame {
    LAS unsigned char* lds;
    int tid, lane, wave, bid, G;
    const float* const* in;
    float* out;
    unsigned char* ws;
    __device__ __forceinline__ const float* x_in() const { return in[0]; }
    __device__ __forceinline__ const float* c_in() const { return in[1]; }
    __device__ __forceinline__ const float* ctx_in() const { return in[2]; }
    __device__ __forceinline__ const float* cctx_in() const { return in[3]; }
    __device__ __forceinline__ const float* w_mod() const { return in[4]; }
    __device__ __forceinline__ const float* b_mod() const { return in[5]; }
    __device__ __forceinline__ const float* n1g() const { return in[6]; }
    __device__ __forceinline__ const float* n2g() const { return in[7]; }
    __device__ __forceinline__ const float* w_in() const { return in[8]; }
    __device__ __forceinline__ const float* w_out() const { return in[9]; }
    __device__ __forceinline__ const float* qng() const { return in[10]; }
    __device__ __forceinline__ const float* kng() const { return in[11]; }
    __device__ __forceinline__ const float* lq1() const { return in[12]; }
    __device__ __forceinline__ const float* lk1() const { return in[13]; }
    __device__ __forceinline__ const float* lq2() const { return in[14]; }
    __device__ __forceinline__ const float* lk2() const { return in[15]; }
    __device__ __forceinline__ const float* subg() const { return in[16]; }
    __device__ __forceinline__ const float* retd() const { return in[17]; }
    __device__ __forceinline__ const float* sgng() const { return in[18]; }
    __device__ __forceinline__ const float* sgw() const { return in[19]; }
    __device__ __forceinline__ const float* sgb() const { return in[20]; }
    __device__ __forceinline__ const float* rw() const { return in[21]; }
    __device__ __forceinline__ const float* wg() const { return in[22]; }
    __device__ __forceinline__ const float* wu() const { return in[23]; }
    __device__ __forceinline__ const float* wd() const { return in[24]; }
    __device__ __forceinline__ float* MOD() const { return (float*)(ws + WS_MOD); }
    __device__ __forceinline__ float* LP() const { return (float*)(ws + WS_LP); }
    __device__ __forceinline__ float* ROPE() const { return (float*)(ws + WS_ROPE); }
    __device__ __forceinline__ float* RETT() const { return (float*)(ws + WS_RETT); }
    __device__ __forceinline__ bf16* X() const { return (bf16*)(ws + WS_X); }
    __device__ __forceinline__ float* KVT() const { return (float*)(ws + WS_KVT); }
    __device__ __forceinline__ bf16* SPREV() const { return (bf16*)(ws + WS_SPREV); }
    __device__ __forceinline__ float* SCR() const { return (float*)(ws + WS_SCR); }
    __device__ __forceinline__ float* AFF() const { return (float*)(ws + WS_AFF); }
    __device__ __forceinline__ float* GATE() const { return (float*)(ws + WS_GATE); }
    __device__ __forceinline__ bf16* SGW() const { return (bf16*)(ws + WS_SGW); }
    __device__ __forceinline__ bf16* WIN() const { return (bf16*)(ws + WS_WIN); }
    __device__ __forceinline__ bf16* WOUT() const { return (bf16*)(ws + WS_WOUT); }
    __device__ __forceinline__ bf16* WGU() const { return (bf16*)(ws + WS_WGU); }
    __device__ __forceinline__ bf16* WD() const { return (bf16*)(ws + WS_WD); }
    __device__ __forceinline__ bf16* HN() const { return (bf16*)(ws + WS_HN); }
    __device__ __forceinline__ bf16* Z() const { return (bf16*)(ws + WS_Z); }
    __device__ __forceinline__ bf16* QH() const { return (bf16*)(ws + WS_QH); }
    __device__ __forceinline__ bf16* KH() const { return (bf16*)(ws + WS_KH); }
    __device__ __forceinline__ bf16* VH() const { return (bf16*)(ws + WS_VH); }
    __device__ __forceinline__ bf16* RQ() const { return (bf16*)(ws + WS_RQ); }
    __device__ __forceinline__ bf16* RK() const { return (bf16*)(ws + WS_RK); }
    __device__ __forceinline__ bf16* SVN() const { return (bf16*)(ws + WS_SVN); }
    __device__ __forceinline__ bf16* MIX() const { return (bf16*)(ws + WS_MIX); }
    __device__ __forceinline__ bf16* XS() const { return (bf16*)(ws + WS_XS); }
    __device__ __forceinline__ bf16* HH() const { return (bf16*)(ws + WS_HH); }
    __device__ __forceinline__ bf16* Y() const { return (bf16*)(ws + WS_Y); }
    __device__ __forceinline__ bf16* RWS() const { return (bf16*)(ws + WS_RWS); }
    __device__ __forceinline__ int* SLOT() const { return (int*)(ws + WS_SLOT); }
    __device__ __forceinline__ int* ROWIDX() const { return (int*)(ws + WS_ROWIDX); }
};
__device__ __forceinline__ float bf2f(bf16 v) { return __builtin_bit_cast(float, (unsigned)v << 16); }
__device__ __forceinline__ float wave_sum(float v) {
#pragma unroll
    for (int o = 1; o < 64; o <<= 1) v += __shfl_xor(v, o);
    return v;
}
__device__ __forceinline__ float half_sum32(float v) {
#pragma unroll
    for (int o = 1; o < 32; o <<= 1) v += __shfl_xor(v, o);
    return v;
}
__device__ __forceinline__ float wave_max(float v) {
#pragma unroll
    for (int o = 1; o < 64; o <<= 1) v = fmaxf(v, __shfl_xor(v, o));
    return v;
}
__device__ __forceinline__ int crow(int r, int hi) { return (r & 3) + 8 * (r >> 2) + 4 * hi; }
__device__ __forceinline__ float gelu_t(float x) {
    const float u = 0.7978845608028654f * (x + 0.044715f * x * x * x);
    const float t = 1.f - 2.f * __builtin_amdgcn_rcpf(1.f + __expf(2.f * u));
    return 0.5f * x * (1.f + t);
}
__device__ __forceinline__ float silu_f(float x) { return x * __builtin_amdgcn_rcpf(1.f + __expf(-x)); }
__device__ __forceinline__ int row_vec(int r) { return r < SEQ ? 0 : (r < NLAT ? 1 : 2); }
__device__ __forceinline__ int chunk_row0(int b, int cc) { return cc < 2 ? NLAT + b * CTXL + cc * 128 : b * SEQ + (cc - 2) * 128; }

__device__ __forceinline__ f32x16 mma_nt(const LAS bf16* A, int lda, const LAS bf16* B, int ldb, int K, f32x16 acc, int lane) {
    const int r = lane & 31, h = lane >> 5;
#pragma unroll 2
    for (int k0 = 0; k0 < K; k0 += 16) {
        const bf16x8 a = *(const LAS bf16x8*)(A + r * lda + k0 + 8 * h);
        const bf16x8 b = *(const LAS bf16x8*)(B + r * ldb + k0 + 8 * h);
        acc = __builtin_amdgcn_mfma_f32_32x32x16_bf16(a, b, acc, 0, 0, 0);
    }
    return acc;
}

constexpr float QSCALE = 0.125f * 1.4426950408889634f;
struct EpiResid {
    static constexpr bool PERM = true, AFTER_DRAIN = false;
    bf16* X; const float* modg;
    const float* Xin;
    __device__ __forceinline__ void operator()(const pg8::f32x4 (&acc)[2][2][4][2], const pg8::Unit& u, int wr, int wc, int fr, int fq) const {
        const int row0 = u.pm * 256 + wr * 64 + fr, col0 = u.pn * 256 + wc * 32 + 8 * fq;
        const int v = u.pm < 32 ? 0 : (u.pm < 64 ? 1 : 2);
        pg8::f32x4 gv[2][2];
#pragma unroll
        for (int bj = 0; bj < 2; ++bj)
#pragma unroll
            for (int n = 0; n < 2; ++n) gv[bj][n] = *(const pg8::f32x4*)(modg + v * 6144 + col0 + bj * 128 + 4 * n);
        const bool in32 = Xin != nullptr;
#pragma unroll
        for (int ai = 0; ai < 2; ++ai)
#pragma unroll
            for (int m = 0; m < 4; ++m) { const size_t off = (size_t)(row0 + ai * 128 + m * 16) * DM + col0;
#pragma unroll
                for (int bj = 0; bj < 2; ++bj) {
                    pg8::f32x4 x0, x1;
                    if (in32) { x0 = *(const pg8::f32x4*)(Xin + off + bj * 128); x1 = *(const pg8::f32x4*)(Xin + off + bj * 128 + 4); }
                    else { const pg8::u32x4 w = *(const pg8::u32x4*)(X + off + bj * 128);
                        x0 = (pg8::f32x4){__builtin_bit_cast(float, w.x << 16), __builtin_bit_cast(float, w.x & 0xffff0000u), __builtin_bit_cast(float, w.y << 16), __builtin_bit_cast(float, w.y & 0xffff0000u)};
                        x1 = (pg8::f32x4){__builtin_bit_cast(float, w.z << 16), __builtin_bit_cast(float, w.z & 0xffff0000u), __builtin_bit_cast(float, w.w << 16), __builtin_bit_cast(float, w.w & 0xffff0000u)}; }
                    x0 = x0 + gv[bj][0] * acc[ai][bj][m][0]; x1 = x1 + gv[bj][1] * acc[ai][bj][m][1];
                    pg8::u32x4 o; o.x = pg8::cvt_pk_bf16(x0.x, x0.y); o.y = pg8::cvt_pk_bf16(x0.z, x0.w); o.z = pg8::cvt_pk_bf16(x1.x, x1.y); o.w = pg8::cvt_pk_bf16(x1.z, x1.w);
                    *(pg8::u32x4*)(X + off + bj * 128) = o; } }
    }
};
struct EpiZ {
    static constexpr bool PERM = true, AFTER_DRAIN = false;
    bf16* Z; bf16* VH; bf16* QH; bf16* KH; const float* gqk; const float* rope;
    __device__ __forceinline__ void operator()(const pg8::f32x4 (&acc)[2][2][4][2], const pg8::Unit& u, int wr, int wc, int fr, int fq) const {
        if (u.pn < 4) {
            const bool isk = u.pn >= 2; const int grp = (u.pn & 1) * 4 + wc;
            const float* g = gqk + (isk ? 64 : 0); const float sc = isk ? 1.f : QSCALE;
            float ga[2][8];
#pragma unroll
            for (int bj = 0; bj < 2; ++bj)
#pragma unroll
                for (int e = 0; e < 8; ++e) ga[bj][e] = g[32 * bj + 8 * fq + e] * sc;
            const bool first = fq < 2; const int i16 = 8 * (fq & 1);
            const bool lat = u.pm < 64;
#pragma unroll
            for (int ai = 0; ai < 2; ++ai) {
                float rc[8], rn[8];
                if (lat) { const float* T = rope + (size_t)(((u.pm * 256 + ai * 128 + wr * 64) & (SEQ - 1)) & ~63) * 64 + i16;
                    const pg8::f32x4 c0 = *(const pg8::f32x4*)T, c1 = *(const pg8::f32x4*)(T + 4), s0 = *(const pg8::f32x4*)(T + 32), s1 = *(const pg8::f32x4*)(T + 36);
#pragma unroll
                    for (int e = 0; e < 4; ++e) { rc[e] = c0[e]; rc[4 + e] = c1[e]; rn[e] = s0[e]; rn[4 + e] = s1[e]; } }
#pragma unroll
                for (int m = 0; m < 4; ++m) {
                    float ccm[8], cnm[8];
                    if (lat) { const float* T = rope + (size_t)(m * 16 + fr) * 64 + 16 + i16;
                        const pg8::f32x4 c0 = *(const pg8::f32x4*)T, c1 = *(const pg8::f32x4*)(T + 4), s0 = *(const pg8::f32x4*)(T + 32), s1 = *(const pg8::f32x4*)(T + 36);
#pragma unroll
                        for (int e = 0; e < 4; ++e) { ccm[e] = c0[e]; ccm[4 + e] = c1[e]; cnm[e] = s0[e]; cnm[4 + e] = s1[e]; } }
                    const int r = u.pm * 256 + ai * 128 + wr * 64 + m * 16 + fr;
                    const int b = lat ? (r >> 13) : ((r - NLAT) >> 8), n = lat ? (r & (SEQ - 1)) : ((r - NLAT) & (CTXL - 1));
                    float v[2][8]; float ss = 0.f;
#pragma unroll
                    for (int bj = 0; bj < 2; ++bj)
#pragma unroll
                        for (int e = 0; e < 8; ++e) { v[bj][e] = acc[ai][bj][m][e >> 2][e & 3]; ss += v[bj][e] * v[bj][e]; }
                    ss += __shfl_xor(ss, 16);
                    { const auto sw = __builtin_amdgcn_permlane32_swap(__float_as_uint(ss), __float_as_uint(ss), false, false); ss = __uint_as_float(sw[0]) + __uint_as_float(sw[1]); }
                    const float rinv = __builtin_amdgcn_rsqf(ss * (1.f / 64.f) + EPS);
                    bf16* dst = (isk ? KH + ((size_t)b * NKEY + (lat ? CTXL + n : n)) * 512 : QH + (size_t)r * 512) + grp * 64 + 8 * fq;
#pragma unroll
                    for (int bj = 0; bj < 2; ++bj) {
                        float y[8], o[8];
#pragma unroll
                        for (int e = 0; e < 8; ++e) y[e] = v[bj][e] * rinv * ga[bj][e];
                        if (lat) {
#pragma unroll
                            for (int e = 0; e < 8; ++e) { const auto sw = __builtin_amdgcn_permlane32_swap(__float_as_uint(y[e]), __float_as_uint(y[e]), false, false);
                                const float pp = __uint_as_float(first ? sw[1] : sw[0]); const float c = bj ? ccm[e] : rc[e], s = bj ? cnm[e] : rn[e];
                                o[e] = first ? y[e] * c - pp * s : pp * s + y[e] * c; }
                        } else {
#pragma unroll
                            for (int e = 0; e < 8; ++e) o[e] = y[e];
                        }
                        pg8::u32x4 w; w.x = pg8::cvt_pk_bf16(o[0], o[1]); w.y = pg8::cvt_pk_bf16(o[2], o[3]); w.z = pg8::cvt_pk_bf16(o[4], o[5]); w.w = pg8::cvt_pk_bf16(o[6], o[7]);
                        *(pg8::u32x4*)(dst + 32 * bj) = w;
                    }
                }
            }
            return;
        }
        const bool isv = (u.pn == 4) | (u.pn == 5);
        const size_t prow0 = isv ? (u.pm < 64 ? (size_t)u.pm * 256 + (size_t)((u.pm >> 5) + 1) * CTXL : (size_t)(u.pm - 64) * NKEY) : (size_t)u.pm * 256;
        bf16* base = isv ? VH + (u.pn - 4) * 256 : Z + u.pn * 256; const int ldc = isv ? 512 : INC;
        const int col0 = wc * 32 + 8 * fq;
#pragma unroll
        for (int ai = 0; ai < 2; ++ai)
#pragma unroll
            for (int m = 0; m < 4; ++m) { bf16* rowp = base + (prow0 + wr * 64 + fr + ai * 128 + m * 16) * ldc + col0;
#pragma unroll
                for (int bj = 0; bj < 2; ++bj) { const pg8::f32x4 v0 = acc[ai][bj][m][0], v1 = acc[ai][bj][m][1];
                    pg8::u32x4 w; w.x = pg8::cvt_pk_bf16(v0[0], v0[1]); w.y = pg8::cvt_pk_bf16(v0[2], v0[3]); w.z = pg8::cvt_pk_bf16(v1[0], v1[1]); w.w = pg8::cvt_pk_bf16(v1[2], v1[3]);
                    *(pg8::u32x4*)(rowp + bj * 128) = w; } }
    }
};
struct EpiSwiglu {
    static constexpr bool PERM = true, AFTER_DRAIN = false;
    bf16* H;
    __device__ __forceinline__ void operator()(const pg8::f32x4 (&acc)[2][2][4][2], const pg8::Unit& u, int wr, int wc, int fr, int fq) const {
        const int row0 = u.pm * 256 + wr * 64 + fr, col0 = (u.pn & 15) * 128 + wc * 32 + 8 * fq;
#pragma unroll
        for (int ai = 0; ai < 2; ++ai)
#pragma unroll
            for (int m = 0; m < 4; ++m) { bf16* rowp = H + (size_t)(row0 + ai * 128 + m * 16) * FF + col0;
                float h[8];
#pragma unroll
                for (int n = 0; n < 2; ++n)
#pragma unroll
                    for (int i = 0; i < 4; ++i) { const float g = acc[ai][0][m][n][i], up = acc[ai][1][m][n][i]; h[4 * n + i] = silu_f(g) * up; }
                pg8::u32x4 w; w.x = pg8::cvt_pk_bf16(h[0], h[1]); w.y = pg8::cvt_pk_bf16(h[2], h[3]); w.z = pg8::cvt_pk_bf16(h[4], h[5]); w.w = pg8::cvt_pk_bf16(h[6], h[7]);
                *(pg8::u32x4*)rowp = w; }
    }
};
struct MoeOrder {
    int G, c, npn, npm, total;
    __device__ __forceinline__ bool next(int i, pg8::Unit& u) const {
        const int per = npm * npn;
        if ((G & 7) == 0) {
            const int W = G >> 3, x = c & 7, r = c >> 3, q = i * W + r;
            if (q >= 2 * per) return false;
            const int e = 2 * x + q / per, rem = q % per, pn = rem / npm, pm = rem % npm;
            u.pm = e * 9 + pm; u.pn = e * npn + pn; return true;
        }
        const long L = (long)i * G + c; if (L >= total) return false;
        const int e = (int)L / per, rem = (int)L % per; const int pn = rem / npm, pm = rem % npm;
        u.pm = e * 9 + pm; u.pn = e * npn + pn; return true;
    }
    __device__ __forceinline__ void a_ready(const pg8::Unit&) const {}
    __device__ __forceinline__ void done(const pg8::Unit&) const {}
    __device__ __forceinline__ bool half_only(const pg8::Unit& u) const { return (u.pm % 9) == 8; }
};

__device__ __forceinline__ void transpose_item(const float* W, int N, bf16* WT, int K, int k0, int n0, size_t drow0, LAS float* scr, int lane) {
    f32x4 v[8];
#pragma unroll
    for (int i = 0; i < 8; ++i) v[i] = __builtin_nontemporal_load((const f32x4*)(W + (size_t)(k0 + 8 * i + (lane >> 3)) * N + n0 + 4 * (lane & 7)));
#pragma unroll
    for (int i = 0; i < 8; ++i) { LAS float* d = scr + (8 * i + (lane >> 3)) * 33 + 4 * (lane & 7); d[0] = v[i].x; d[1] = v[i].y; d[2] = v[i].z; d[3] = v[i].w; }
    LDS_WAIT(); asm volatile("" ::: "memory");
    const int c = lane & 7;
#pragma unroll
    for (int j = 0; j < 4; ++j) { const int n = (lane >> 3) + 8 * j; const LAS float* s = scr + (8 * c) * 33 + n;
        v4u o; o.x = pk2(s[0 * 33], s[1 * 33]); o.y = pk2(s[2 * 33], s[3 * 33]); o.z = pk2(s[4 * 33], s[5 * 33]); o.w = pk2(s[6 * 33], s[7 * 33]);
        *(GAS v4u*)(WT + (drow0 + n) * K + k0 + 8 * c) = o; }
    LDS_WAIT(); asm volatile("" ::: "memory");
}
constexpr unsigned CV_IN = 16 * 104, CV_OUT = 16 * 32, CV_EX = 1024;
constexpr unsigned CONV_SEG0 = DEPTH * (CV_IN + CV_OUT), CONV_PER_L = 3 * NE * CV_EX, CONV_TOTAL = CONV_SEG0 + DEPTH * CONV_PER_L;
constexpr int CW_Q = 64;
static_assert(CONV_TOTAL % 64 == 0, "whole batches");
__device__ __forceinline__ void conv_item(const Frame& F, unsigned it, LAS float* scr, int lane) {
    if (it < DEPTH * CV_IN) { const int L = it / CV_IN, q = it % CV_IN, kb = q / 104, nb = q % 104, n0 = nb * 32;
        const size_t drow0 = n0 < 1024 ? (size_t)(n0 & ~255) + 128 * ((n0 & 63) >> 5) + 32 * ((n0 & 255) >> 6) : (size_t)n0;
        transpose_item(F.w_in() + (size_t)L * DM * INC, INC, F.WIN() + (size_t)L * INC * DM, DM, kb * 64, n0, drow0, scr, lane); return; }
    it -= DEPTH * CV_IN;
    if (it < DEPTH * CV_OUT) { const int L = it / CV_OUT, q = it % CV_OUT, kb = q / 32, nb = q % 32;
        transpose_item(F.w_out() + (size_t)L * DM * DM, DM, F.WOUT() + (size_t)L * DM * DM, DM, kb * 64, nb * 32, (size_t)nb * 32, scr, lane); return; }
    it -= DEPTH * CV_OUT;
    const int L = it / CONV_PER_L, q0 = it % CONV_PER_L, kind = q0 / (NE * CV_EX), r = q0 % (NE * CV_EX), le = L * NE + r / CV_EX, q = r % CV_EX;
    if (kind < 2) { const int kb = q / 64, nb = q % 64, n0 = nb * 32;
        const size_t drow0 = (size_t)(n0 >> 7) * 256 + (n0 & 127) + (kind ? 128 : 0);
        transpose_item((kind ? F.wu() : F.wg()) + (size_t)le * DM * FF, FF, F.WGU() + (size_t)le * 4096 * DM, DM, kb * 64, n0, drow0, scr, lane); }
    else { const int kb = q / 32, nb = q % 32;
        transpose_item(F.wd() + (size_t)le * FF * DM, DM, F.WD() + (size_t)le * DM * FF, FF, kb * 64, nb * 32, (size_t)nb * 32, scr, lane); }
}
__device__ __forceinline__ bool conv_batch(const Frame& F) {
    LAS unsigned* bc = (LAS unsigned*)(F.lds + MISC_OFF + 64);
    LAS float* scr = (LAS float*)(F.lds + 32768 + F.wave * 8704);
    if (F.tid == 0) *bc = __hip_atomic_fetch_add((unsigned*)(F.ws + WS_CTL) + CW_Q, 64u, __ATOMIC_RELAXED, __HIP_MEMORY_SCOPE_AGENT);
    __syncthreads();
    const unsigned base = *bc;
    __syncthreads();
    if (base >= CONV_TOTAL) return false;
    for (int k = 0; k < 8; ++k) conv_item(F, base + 8 * k + F.wave, scr, F.lane);
    return true;
}
__device__ __forceinline__ void conv_n(const Frame& F, int n) { for (int i = 0; i < n; ++i) if (!conv_batch(F)) break; __syncthreads(); }
__device__ __forceinline__ void conv_until(const Frame& F, unsigned target) {
    for (;;) {
        const unsigned h = __hip_atomic_load((unsigned*)(F.ws + WS_CTL) + CW_Q, __ATOMIC_RELAXED, __HIP_MEMORY_SCOPE_AGENT);
        LAS unsigned* bc = (LAS unsigned*)(F.lds + MISC_OFF + 68);
        if (F.tid == 0) *bc = h;
        __syncthreads();
        const unsigned hh = *bc;
        __syncthreads();
        if (hh >= target) break;
        if (!conv_batch(F)) break;
    }
}
__device__ __forceinline__ void ph_prologue(const Frame& F) {
    const int tid = F.tid, lane = F.lane, wave = F.wave;
    LAS float* sc = (LAS float*)F.lds;
    LAS float* red = sc + 3072;
    for (int i = tid; i < 3072; i += NTHR) { const int v = i >> 10, k = i & 1023; const float c = v < 2 ? F.c_in()[v * DM + k] : F.cctx_in()[k]; sc[i] = c / (1.f + expf(-c)); }
    __syncthreads();
    for (int t = F.bid; t < 384; t += F.G) {
        const int L = t / 96, j0 = (t % 96) * 64;
        const float* W = F.w_mod() + (size_t)L * DM * 6144 + j0 + lane;
        float a0 = 0.f, a1 = 0.f, a2 = 0.f;
#pragma unroll 8
        for (int kk = 0; kk < 128; ++kk) { const int k = wave * 128 + kk; const float w = W[(size_t)k * 6144]; a0 += sc[k] * w; a1 += sc[1024 + k] * w; a2 += sc[2048 + k] * w; }
        red[(wave * 3 + 0) * 64 + lane] = a0; red[(wave * 3 + 1) * 64 + lane] = a1; red[(wave * 3 + 2) * 64 + lane] = a2;
        __syncthreads();
        if (tid < 192) { const int v = tid >> 6, l = tid & 63; float s = 0.f;
#pragma unroll
            for (int w = 0; w < 8; ++w) s += red[(w * 3 + v) * 64 + l];
            F.MOD()[(size_t)(L * 3 + v) * 6144 + j0 + l] = s + F.b_mod()[L * 6144 + j0 + l]; }
        __syncthreads();
    }
    if (F.bid == 0 && wave == 0) {
        for (int L = 0; L < DEPTH; ++L) {
            const float d1 = wave_sum(F.lq1()[L * 64 + lane] * F.lk1()[L * 64 + lane]), d2 = wave_sum(F.lq2()[L * 64 + lane] * F.lk2()[L * 64 + lane]);
            const float linit = 0.8f - 0.6f * expf(-0.3f * (float)L);
            if (lane == 0) { F.LP()[L * 16 + 0] = expf(d1) - expf(d2) + linit; F.LP()[L * 16 + 1] = 1.f - linit; }
            if (lane < 8) { const float xd = F.retd()[L * 8 + lane]; F.LP()[L * 16 + 2 + lane] = -log1pf(expf(-xd)); }
            F.LP()[DEPTH * 16 + L * 128 + lane] = F.qng()[L * 64 + lane]; F.LP()[DEPTH * 16 + L * 128 + 64 + lane] = F.kng()[L * 64 + lane];
            { const float mq = wave_max(fabsf(F.qng()[L * 64 + lane])), mk = wave_max(fabsf(F.kng()[L * 64 + lane])); if (lane == 0) F.LP()[L * 16 + 10] = 64.f * mq * mk * 1.02f; }
        }
    }
    const int gw = F.bid * NWAVES + wave, NGW = F.G * NWAVES;
    {
        const int i16 = lane & 15, which = lane >> 4, i32 = lane & 31;
        const float inv_a = powf(10000.f, -(float)i16 / 16.f);
        const float inv_r = 1.f / powf(10000.f, (float)i32 / 31.f);
        for (int n = gw; n < SEQ; n += NGW) {
            const float pos = (which & 1) ? (float)(n & 63) : (float)(n >> 6);
            const float ang = pos * inv_a;
            F.ROPE()[(size_t)n * 64 + lane] = (which < 2) ? (float)cos((double)ang) : (float)sin((double)ang);
            const float ang2 = (float)n * inv_r;
            F.RETT()[(size_t)n * 64 + lane] = (lane < 32) ? (float)cos((double)ang2) : (float)sin((double)ang2);
        }
    }
    if (F.bid == 0) for (int i = tid; i < DM / 2; i += NTHR) ((unsigned*)(F.HN() + (size_t)NROW * DM))[i] = 0u;
    for (int i = F.bid * NTHR + tid; i < DEPTH * 16 * DM; i += F.G * NTHR) { const int Lr = i / (16 * DM), q = i % (16 * DM), k = q >> 4, e = q & 15;
        const float w = F.rw()[i]; const unsigned h = f2bf(w); const float wl = w - __builtin_bit_cast(float, h << 16);
        F.RWS()[((size_t)(Lr * 2 + 0) * 16 + e) * RWLD + k] = (bf16)h; F.RWS()[((size_t)(Lr * 2 + 1) * 16 + e) * RWLD + k] = (bf16)f2bf(wl); }
    for (int i = F.bid * NTHR + tid; i < DEPTH * 4 * 128 * 128; i += F.G * NTHR) F.SGW()[i] = (bf16)f2bf(F.sgw()[i]);
    conv_until(F, CONV_SEG0);
}

__device__ __forceinline__ void ph_norm1_first(const Frame& F) {
    const int lane = F.lane, gw = F.bid * NWAVES + F.wave, NGW = F.G * NWAVES;
    for (int r = gw; r < NROW; r += NGW) {
        const float* src = r < NLAT ? F.x_in() + (size_t)r * DM : F.ctx_in() + (size_t)(r - NLAT) * DM;
        const float* mod = F.MOD() + (size_t)row_vec(r) * 6144;
        f32x4 v[4]; float ss = 0.f;
#pragma unroll
        for (int j = 0; j < 4; ++j) { v[j] = *(const f32x4*)(src + 4 * lane + 256 * j); ss += (v[j].x * v[j].x + v[j].y * v[j].y) + (v[j].z * v[j].z + v[j].w * v[j].w); }
        const float rinv = rsqrtf(wave_sum(ss) * (1.f / DM) + EPS);
#pragma unroll
        for (int j = 0; j < 4; ++j) { const int c = 4 * lane + 256 * j;
            const f32x4 g = *(const f32x4*)(F.n1g() + c), sh = *(const f32x4*)(mod + c), sc = *(const f32x4*)(mod + 1024 + c);
            const f32x4 h = v[j] * rinv * g * (sc + 1.f) + sh;
            *(unsigned long long*)(F.HN() + (size_t)r * DM + c) = (unsigned long long)pk2(h.x, h.y) | ((unsigned long long)pk2(h.z, h.w) << 32); }
    }
}

__device__ __forceinline__ void ph_prep(const Frame& F, int L) {
    const int lane = F.lane, gw = F.bid * NWAVES + F.wave, NGW = F.G * NWAVES;
    const int grp8 = lane >> 3, half = (lane >> 2) & 1, t4 = lane & 3, dA = half * 32 + 4 * t4;
    const f32x4 gqA = *(const f32x4*)(F.qng() + L * 64 + dA), gqB = *(const f32x4*)(F.qng() + L * 64 + dA + 16);
    const f32x4 gkA = *(const f32x4*)(F.kng() + L * 64 + dA), gkB = *(const f32x4*)(F.kng() + L * 64 + dA + 16);
    const int rsel = lane >> 5, rhead = (lane >> 3) & 3, t8 = lane & 7;
    const float rscale = rsel ? 0.125f : 1.f;
    const f32x4 sgn = *(const f32x4*)(F.sgng() + L * 256 + lane * 4);
    for (int r = gw; r < NROW; r += NGW) {
        const bf16* zr = F.Z() + (size_t)r * INC;
        const bool lat = r < NLAT; const int b = lat ? (r >> 13) : ((r - NLAT) >> 8), n = lat ? (r & (SEQ - 1)) : ((r - NLAT) & (CTXL - 1));
        const size_t krow = (size_t)b * NKEY + (lat ? CTXL + n : n);
        f32x4 cs = {1.f, 1.f, 1.f, 1.f}, sn = {0.f, 0.f, 0.f, 0.f}, cs2 = cs, sn2 = sn;
        if (lat) { const float* T = F.ROPE() + (size_t)n * 64; cs = *(const f32x4*)(T + half * 16 + 4 * t4); sn = *(const f32x4*)(T + 32 + half * 16 + 4 * t4);
                   const float* R = F.RETT() + (size_t)n * 64; cs2 = *(const f32x4*)(R + 4 * t8); sn2 = *(const f32x4*)(R + 32 + 4 * t8); }
#pragma unroll
        for (int pass = 0; pass < 2; ++pass) {
            const int col = pass * 512 + grp8 * 64 + dA;
            const u16x4 ra = *(const u16x4*)(zr + col), rb = *(const u16x4*)(zr + col + 16);
            f32x4 x1, x2; float ss = 0.f;
#pragma unroll
            for (int e = 0; e < 4; ++e) { x1[e] = bf2f(ra[e]); x2[e] = bf2f(rb[e]); ss += x1[e] * x1[e] + x2[e] * x2[e]; }
            ss += __shfl_xor(ss, 1); ss += __shfl_xor(ss, 2); ss += __shfl_xor(ss, 4);
            const float rinv = rsqrtf(ss * (1.f / 64.f) + EPS);
            const f32x4 y1 = x1 * rinv * (pass ? gkA : gqA * QSCALE), y2 = x2 * rinv * (pass ? gkB : gqB * QSCALE);
            const f32x4 o1 = y1 * cs - y2 * sn, o2 = y1 * sn + y2 * cs;
            bf16* dst = (pass ? F.KH() + krow * 512 : F.QH() + (size_t)r * 512) + grp8 * 64 + dA;
            *(unsigned long long*)dst = (unsigned long long)pk2(o1.x, o1.y) | ((unsigned long long)pk2(o1.z, o1.w) << 32);
            *(unsigned long long*)(dst + 16) = (unsigned long long)pk2(o2.x, o2.y) | ((unsigned long long)pk2(o2.z, o2.w) << 32);
        }
    }
}

__device__ __forceinline__ void ph_norm2_router(const Frame& F, int L) {
    const int lane = F.lane, tid = F.tid, gw = F.bid * NWAVES + F.wave, NGW = F.G * NWAVES;
    LAS bf16* rwl = (LAS bf16*)F.lds;
    { const bf16* src = F.RWS() + (size_t)L * 2 * 16 * RWLD;
      for (int i = tid; i < 2 * 16 * RWLD / 8; i += NTHR) *(LAS bf16x8*)(rwl + i * 8) = *(const bf16x8*)(src + i * 8); }
    __syncthreads();
    const int ntile = ((L == DEPTH - 1) ? NLAT : NROW) / 16;
    const int rr = lane & 15, kq = lane >> 4;
    for (int tile = gw; tile < ntile; tile += NGW) {
        const int r = tile * 16 + rr;
        const bf16* xr = F.X() + (size_t)r * DM + 8 * kq;
        const float* mod = F.MOD() + (size_t)(L * 3 + row_vec(tile * 16)) * 6144 + 8 * kq;
        const float* gn = F.n2g() + L * DM + 8 * kq;
        float ss = 0.f;
#pragma unroll 8
        for (int st = 0; st < 32; ++st) { const v4u w = *(const v4u*)(xr + 32 * st);
            const f32x4 a = {__builtin_bit_cast(float, w.x << 16), __builtin_bit_cast(float, w.x & 0xffff0000u), __builtin_bit_cast(float, w.y << 16), __builtin_bit_cast(float, w.y & 0xffff0000u)};
            const f32x4 c = {__builtin_bit_cast(float, w.z << 16), __builtin_bit_cast(float, w.z & 0xffff0000u), __builtin_bit_cast(float, w.w << 16), __builtin_bit_cast(float, w.w & 0xffff0000u)};
            ss += (a.x * a.x + a.y * a.y) + (a.z * a.z + a.w * a.w) + (c.x * c.x + c.y * c.y) + (c.z * c.z + c.w * c.w); }
        ss += __shfl_xor(ss, 16); ss += __shfl_xor(ss, 32);
        const float rinv = rsqrtf(ss * (1.f / DM) + EPS);
        f32x4 acc = {0.f, 0.f, 0.f, 0.f};
        bf16* hrow = F.HN() + (size_t)r * DM + 8 * kq;
#pragma unroll 4
        for (int st = 0; st < 32; ++st) {
            float f[8];
            const v4u xw = *(const v4u*)(xr + 32 * st);
#pragma unroll
            for (int q = 0; q < 2; ++q) { const unsigned w0 = q ? xw.z : xw.x, w1 = q ? xw.w : xw.y;
                const f32x4 xv = {__builtin_bit_cast(float, w0 << 16), __builtin_bit_cast(float, w0 & 0xffff0000u), __builtin_bit_cast(float, w1 << 16), __builtin_bit_cast(float, w1 & 0xffff0000u)};
                const f32x4 g = *(const f32x4*)(gn + 32 * st + 4 * q),
                                                      sh = *(const f32x4*)(mod + 3072 + 32 * st + 4 * q), sc = *(const f32x4*)(mod + 4096 + 32 * st + 4 * q);
                const f32x4 y = xv * rinv * g * (sc + 1.f) + sh; f[4 * q] = y.x; f[4 * q + 1] = y.y; f[4 * q + 2] = y.z; f[4 * q + 3] = y.w; }
            v4u hi, lo;
            hi.x = pk2(f[0], f[1]); hi.y = pk2(f[2], f[3]); hi.z = pk2(f[4], f[5]); hi.w = pk2(f[6], f[7]);
#define LOPK(w, i0, i1) pk2(f[i0] - __builtin_bit_cast(float, (w) << 16), f[i1] - __builtin_bit_cast(float, (w) & 0xffff0000u))
            lo.x = LOPK(hi.x, 0, 1); lo.y = LOPK(hi.y, 2, 3); lo.z = LOPK(hi.z, 4, 5); lo.w = LOPK(hi.w, 6, 7);
#undef LOPK
            *(v4u*)(hrow + 32 * st) = hi;
            const bf16x8 ah = __builtin_bit_cast(bf16x8, hi), al = __builtin_bit_cast(bf16x8, lo);
            const bf16x8 bh = *(const LAS bf16x8*)(rwl + rr * RWLD + 32 * st + 8 * kq), bl = *(const LAS bf16x8*)(rwl + (16 + rr) * RWLD + 32 * st + 8 * kq);
            acc = __builtin_amdgcn_mfma_f32_16x16x32_bf16(ah, bh, acc, 0, 0, 0);
            acc = __builtin_amdgcn_mfma_f32_16x16x32_bf16(ah, bl, acc, 0, 0, 0);
            acc = __builtin_amdgcn_mfma_f32_16x16x32_bf16(al, bh, acc, 0, 0, 0);
        }
#pragma unroll
        for (int q = 0; q < 4; ++q) {
            float mx = acc[q];
#pragma unroll
            for (int o = 1; o < 16; o <<= 1) mx = fmaxf(mx, __shfl_xor(mx, o));
            const float ex = expf(acc[q] - mx); float sum = ex;
#pragma unroll
            for (int o = 1; o < 16; o <<= 1) sum += __shfl_xor(sum, o);
            F.AFF()[(size_t)(tile * 16 + 4 * kq + q) * 16 + rr] = ex / sum;
        }
    }
    __syncthreads();
}

__device__ __forceinline__ unsigned block_excl_scan(unsigned v, LAS unsigned* wtot, int lane, int wave) {
    unsigned inc = v;
#pragma unroll
    for (int o = 1; o < 64; o <<= 1) { const unsigned t = __shfl_up(inc, o); if (lane >= o) inc += t; }
    if (lane == 63) wtot[wave] = inc;
    __syncthreads();
    unsigned off = 0;
    for (int w = 0; w < wave; ++w) off += wtot[w];
    __syncthreads();
    return off + inc - v;
}
__device__ __forceinline__ void ph_topk(const Frame& F, int L) {
    const int tid = F.tid, lane = F.lane, wave = F.wave;
    LAS unsigned* keys = (LAS unsigned*)F.lds;
    LAS unsigned* hist = keys + 8192;
    LAS unsigned* wtot = hist + 256;
    LAS unsigned* bc = wtot + 16;
    const int nprob = (L == DEPTH - 1) ? 32 : 64;
    for (int p = F.bid; p < 64; p += F.G) {
        const int s = p >> 4, e = p & 15;
        const int n = s < 2 ? SEQ : CTXL, k = n >> 3;
        const int base = s < 2 ? s * SEQ : NLAT + (s - 2) * CTXL;
        const int sbase = s == 0 ? 0 : (s == 1 ? 1024 : (s == 2 ? 2048 : 2080));
        if (p >= nprob) {
            for (int i = tid; i < 32; i += NTHR) { F.ROWIDX()[e * EROWS + sbase + i] = -1; F.GATE()[e * EROWS + sbase + i] = 0.f; }
            if (s == 3) for (int rr = 2112 + tid; rr < EROWS; rr += NTHR) { F.ROWIDX()[e * EROWS + rr] = -1; F.GATE()[e * EROWS + rr] = 0.f; }
            continue; }
        for (int i = tid; i < n; i += NTHR) keys[i] = __float_as_uint(F.AFF()[(size_t)(base + i) * 16 + e]);
        __syncthreads();
        unsigned prefix = 0u, mask = 0u, need = (unsigned)k;
        for (int pass = 0; pass < 4; ++pass) {
            const int shift = 24 - 8 * pass;
            if (tid < 256) hist[tid] = 0u;
            __syncthreads();
            for (int i = tid; i < n; i += NTHR) { const unsigned key = keys[i]; if ((key & mask) == prefix) atomicAdd((unsigned*)&hist[(key >> shift) & 255u], 1u); }
            __syncthreads();
            if (wave == 0) {
                const unsigned h0 = hist[4 * lane], h1 = hist[4 * lane + 1], h2 = hist[4 * lane + 2], h3 = hist[4 * lane + 3];
                const unsigned tot = h0 + h1 + h2 + h3;
                unsigned suf = tot;
#pragma unroll
                for (int o = 1; o < 64; o <<= 1) { const unsigned t = __shfl_down(suf, o); if (lane + o < 64) suf += t; }
                const unsigned above = suf - tot;
                if (suf >= need && above < need) {
                    unsigned rem = need - above, bsel;
                    if (rem <= h3) bsel = 3u; else { rem -= h3; if (rem <= h2) bsel = 2u; else { rem -= h2; if (rem <= h1) bsel = 1u; else { rem -= h1; bsel = 0u; } } }
                    bc[0] = 4u * lane + bsel; bc[1] = rem;
                }
            }
            __syncthreads();
            prefix |= bc[0] << shift; mask |= 255u << shift; need = bc[1];
            __syncthreads();
        }
        const unsigned T = prefix;
        const int per = n >= NTHR ? n / NTHR : 1;
        const int i0 = tid * per; const bool act = i0 < n;
        unsigned eqc = 0u;
        if (act) for (int q = 0; q < per; ++q) eqc += (keys[i0 + q] == T) ? 1u : 0u;
        unsigned eqr = block_excl_scan(eqc, wtot, lane, wave);
        unsigned selc = 0u;
        if (act) for (int q = 0; q < per; ++q) { const unsigned key = keys[i0 + q]; if (key > T) ++selc; else if (key == T) { if (eqr < need) ++selc; ++eqr; } }
        unsigned slot = block_excl_scan(selc, wtot, lane, wave);
        eqr -= eqc;
        if (act) for (int q = 0; q < per; ++q) {
            const unsigned key = keys[i0 + q]; bool sel = key > T;
            if (key == T) { sel = eqr < need; ++eqr; }
            const int tok = base + i0 + q;
            if (sel) { const int rr = sbase + (int)slot; ++slot; F.ROWIDX()[e * EROWS + rr] = tok; F.GATE()[e * EROWS + rr] = __uint_as_float(key); F.SLOT()[(size_t)tok * 16 + e] = rr; }
            else F.SLOT()[(size_t)tok * 16 + e] = -1;
        }
        if (s == 3) for (int rr = 2112 + tid; rr < EROWS; rr += NTHR) { F.ROWIDX()[e * EROWS + rr] = -1; F.GATE()[e * EROWS + rr] = 0.f; }
        __syncthreads();
    }
}

__device__ __forceinline__ void ph_gather(const Frame& F) {
    const int lane = F.lane, gw = F.bid * NWAVES + F.wave, NGW = F.G * NWAVES;
    for (int idx = gw; idx < NE * EROWS; idx += NGW) {
        const int src = F.ROWIDX()[idx];
        bf16x8 a = {0, 0, 0, 0, 0, 0, 0, 0}, b = a;
        if (src >= 0) { a = *(const bf16x8*)(F.HN() + (size_t)src * DM + 8 * lane); b = *(const bf16x8*)(F.HN() + (size_t)src * DM + 512 + 8 * lane); }
        *(bf16x8*)(F.XS() + (size_t)idx * DM + 8 * lane) = a; *(bf16x8*)(F.XS() + (size_t)idx * DM + 512 + 8 * lane) = b;
    }
}

__device__ __forceinline__ void ph_combine(const Frame& F, int L) {
    const int lane = F.lane, gw = F.bid * NWAVES + F.wave, NGW = F.G * NWAVES;
    const bool last = (L == DEPTH - 1);
    const int nrows = last ? NLAT : NROW;
    for (int r = gw; r < nrows; r += NGW) {
        const int v = row_vec(r);
        const int sl = (lane < 16) ? F.SLOT()[(size_t)r * 16 + lane] : -1;
        const float* mod = F.MOD() + (size_t)(L * 3 + v) * 6144;
        f32x4 xv[4], g2[4];
#pragma unroll
        for (int j = 0; j < 2; ++j)
#pragma unroll
            for (int q = 0; q < 2; ++q) { const int c = 8 * lane + 512 * j + 4 * q; const unsigned long long w = *(const unsigned long long*)(F.X() + (size_t)r * DM + c);
                const unsigned w0 = (unsigned)w, w1 = (unsigned)(w >> 32);
                xv[2 * j + q] = (f32x4){__builtin_bit_cast(float, w0 << 16), __builtin_bit_cast(float, w0 & 0xffff0000u), __builtin_bit_cast(float, w1 << 16), __builtin_bit_cast(float, w1 & 0xffff0000u)};
                g2[2 * j + q] = *(const f32x4*)(mod + 5120 + c); }
        float acc[16];
#pragma unroll
        for (int i = 0; i < 16; ++i) acc[i] = 0.f;
        unsigned long long m = __ballot(sl >= 0);
        while (m) {
            const int e0 = __builtin_ctzll(m); m &= m - 1;
            const int e1 = m ? __builtin_ctzll(m) : -1; if (m) m &= m - 1;
            const int s0 = __shfl(sl, e0), s1 = e1 >= 0 ? __shfl(sl, e1) : 0;
            const float gv0 = F.GATE()[e0 * EROWS + s0]; const bf16* y0 = F.Y() + ((size_t)e0 * EROWS + s0) * DM;
            const bf16x8 a0 = *(const bf16x8*)(y0 + 8 * lane), a1 = *(const bf16x8*)(y0 + 8 * lane + 512);
            float gv1 = 0.f; bf16x8 b0 = {0, 0, 0, 0, 0, 0, 0, 0}, b1 = b0;
            if (e1 >= 0) { gv1 = F.GATE()[e1 * EROWS + s1]; const bf16* y1 = F.Y() + ((size_t)e1 * EROWS + s1) * DM; b0 = *(const bf16x8*)(y1 + 8 * lane); b1 = *(const bf16x8*)(y1 + 8 * lane + 512); }
#pragma unroll
            for (int i = 0; i < 8; ++i) { acc[i] += gv0 * bf2f((bf16)a0[i]); acc[8 + i] += gv0 * bf2f((bf16)a1[i]); }
            if (e1 >= 0) {
#pragma unroll
                for (int i = 0; i < 8; ++i) { acc[i] += gv1 * bf2f((bf16)b0[i]); acc[8 + i] += gv1 * bf2f((bf16)b1[i]); } }
        }
        float xn[16]; float ss = 0.f;
#pragma unroll
        for (int j = 0; j < 2; ++j)
#pragma unroll
            for (int q = 0; q < 2; ++q) { const int c = 8 * lane + 512 * j + 4 * q;
#pragma unroll
                for (int i = 0; i < 4; ++i) { const float t = xv[2 * j + q][i] + g2[2 * j + q][i] * acc[8 * j + 4 * q + i]; xn[8 * j + 4 * q + i] = t; ss += t * t; }
                const f32x4 o = {xn[8 * j + 4 * q], xn[8 * j + 4 * q + 1], xn[8 * j + 4 * q + 2], xn[8 * j + 4 * q + 3]};
                if (last) *(f32x4*)(F.out + (size_t)r * DM + c) = o;
                else *(unsigned long long*)(F.X() + (size_t)r * DM + c) = (unsigned long long)pk2(o.x, o.y) | ((unsigned long long)pk2(o.z, o.w) << 32); }
        if (!last) {
            const float rinv = rsqrtf(wave_sum(ss) * (1.f / DM) + EPS);
            const float* mod1 = F.MOD() + (size_t)((L + 1) * 3 + v) * 6144;
#pragma unroll
            for (int j = 0; j < 2; ++j) { const int c = 8 * lane + 512 * j; float h[8];
#pragma unroll
                for (int q = 0; q < 2; ++q) { const f32x4 g = *(const f32x4*)(F.n1g() + (L + 1) * DM + c + 4 * q), sh = *(const f32x4*)(mod1 + c + 4 * q), sc = *(const f32x4*)(mod1 + 1024 + c + 4 * q);
#pragma unroll
                    for (int i = 0; i < 4; ++i) h[4 * q + i] = xn[8 * j + 4 * q + i] * rinv * g[i] * (1.f + sc[i]) + sh[i]; }
                v4u w; w.x = pk2(h[0], h[1]); w.y = pk2(h[2], h[3]); w.z = pk2(h[4], h[5]); w.w = pk2(h[6], h[7]);
                *(v4u*)(F.HN() + (size_t)r * DM + c) = w; }
        }
    }
}


constexpr int LDP = 136, LDQK = 72;

__device__ __forceinline__ void ret_rot(const Frame& F, const bf16* zh, int p, bool lat, int n, float scale, float (&o1)[8], float (&o2)[8]) {
    const bf16x8 r1 = *(const bf16x8*)(zh + 8 * p), r2 = *(const bf16x8*)(zh + 32 + 8 * p);
    float cs[8], sn[8];
    if (lat) { const float* R = F.RETT() + (size_t)n * 64 + 8 * p; const f32x4 c0 = *(const f32x4*)R, c1 = *(const f32x4*)(R + 4), s0 = *(const f32x4*)(R + 32), s1 = *(const f32x4*)(R + 36);
#pragma unroll
        for (int i = 0; i < 4; ++i) { cs[i] = c0[i]; cs[4 + i] = c1[i]; sn[i] = s0[i]; sn[4 + i] = s1[i]; } }
    else {
#pragma unroll
        for (int i = 0; i < 8; ++i) { cs[i] = 1.f; sn[i] = 0.f; } }
#pragma unroll
    for (int i = 0; i < 8; ++i) { const float x1 = bf2f((bf16)r1[i]) * scale, x2 = bf2f((bf16)r2[i]) * scale; o1[i] = x1 * cs[i] - x2 * sn[i]; o2[i] = x1 * sn[i] + x2 * cs[i]; }
}
__device__ __forceinline__ void unit_retkv(const Frame& F, int L, int b, int h, int cc) {
    const int tid = F.tid, lane = F.lane, wave = F.wave;
    LAS bf16* vT = (LAS bf16*)F.lds;
    LAS bf16* kfT = vT + 64 * LDP;
    LAS bf16* kbT = kfT + 64 * LDP;
    const int row0 = chunk_row0(b, cc);
    const float lgf = F.LP()[L * 16 + 2 + h], lgb = F.LP()[L * 16 + 6 + h];
    { const int j = tid >> 2, p = tid & 3;
      const bf16* zr = F.Z() + (size_t)(row0 + j) * INC;
      float k1[8], k2[8];
      ret_rot(F, zr + ZRK + h * 64, p, cc >= 2, (cc - 2) * 128 + j, 0.125f, k1, k2);
      const bf16x8 v1 = *(const bf16x8*)(zr + ZRV + h * 64 + 8 * p), v2 = *(const bf16x8*)(zr + ZRV + h * 64 + 32 + 8 * p);
      const float df = __expf(lgf * (float)(127 - j)), db = __expf(lgb * (float)j);
#pragma unroll
      for (int i = 0; i < 8; ++i) { const int d1 = 8 * p + i, d2 = 32 + 8 * p + i;
          kfT[d1 * LDP + j] = (bf16)f2bf(k1[i] * df); kbT[d1 * LDP + j] = (bf16)f2bf(k1[i] * db); vT[d1 * LDP + j] = (bf16)v1[i];
          kfT[d2 * LDP + j] = (bf16)f2bf(k2[i] * df); kbT[d2 * LDP + j] = (bf16)f2bf(k2[i] * db); vT[d2 * LDP + j] = (bf16)v2[i]; } }
    __syncthreads();
    { const int dir = wave >> 2, ti = (wave >> 1) & 1, tj = wave & 1, r32 = lane & 31, hi = lane >> 5;
      f32x16 acc = {};
      acc = mma_nt(vT + ti * 32 * LDP, LDP, (dir ? kbT : kfT) + tj * 32 * LDP, LDP, 128, acc, lane);
      float* dst = F.KVT() + ((size_t)(((b * 4 + h) * 2 + dir) * NCH + cc)) * 4096;
#pragma unroll
      for (int x = 0; x < 16; ++x) dst[(ti * 32 + crow(x, hi)) * 64 + tj * 32 + r32] = acc[x]; }
    __syncthreads();
}

__device__ __forceinline__ void ph_scan(const Frame& F, int L) {
    const int t = F.bid * NTHR + F.tid;
    if (t < 65536) {
        const int elem = t & 4095, sq = t >> 12, dir = sq & 1, h = (sq >> 1) & 3, b = sq >> 3;
        const size_t base = (size_t)(((b * 4 + h) * 2 + dir) * NCH);
        const float decay = expf(F.LP()[L * 16 + 2 + dir * 4 + h] * 128.f);
        float kv[NCH];
#pragma unroll
        for (int step = 0; step < NCH; ++step) { const int cc = dir == 0 ? step : (step < 2 ? 1 - step : 67 - step); kv[step] = F.KVT()[(base + cc) * 4096 + elem]; }
        float s = 0.f;
#pragma unroll
        for (int step = 0; step < NCH; ++step) { const int cc = dir == 0 ? step : (step < 2 ? 1 - step : 67 - step);
            F.SPREV()[(base + cc) * 4096 + elem] = (bf16)f2bf(s); s = s * decay + kv[step]; }
    }
}

__device__ __forceinline__ void unit_retout(const Frame& F, int L, int b, int h, int cc) {
    int tid = F.tid; asm volatile("" : "+v"(tid));
    const int lane = tid & 63, wave = F.wave, r32 = lane & 31, hi = lane >> 5;
    LAS bf16* q_s = (LAS bf16*)F.lds;
    LAS bf16* k_s = q_s + 128 * LDQK;
    LAS bf16* vT = k_s + 128 * LDQK;
    LAS bf16* SfT = vT + 64 * LDP;
    LAS bf16* SbT = SfT + 64 * LDQK;
    LAS bf16* P = SbT + 64 * LDQK;
    LAS float* O_s = (LAS float*)P;
    constexpr int LDO = 66;
    const int row0 = chunk_row0(b, cc);
    const float lgf = F.LP()[L * 16 + 2 + h], lgb = F.LP()[L * 16 + 6 + h];
    { const int j = tid >> 2, p = tid & 3;
      const bf16* zr = F.Z() + (size_t)(row0 + j) * INC;
      float a1[8], a2[8];
      ret_rot(F, zr + ZRQ + h * 64, p, cc >= 2, (cc - 2) * 128 + j, 1.f, a1, a2);
      { v4u w; w.x = pk2(a1[0], a1[1]); w.y = pk2(a1[2], a1[3]); w.z = pk2(a1[4], a1[5]); w.w = pk2(a1[6], a1[7]); *(LAS v4u*)(q_s + j * LDQK + 8 * p) = w;
        w.x = pk2(a2[0], a2[1]); w.y = pk2(a2[2], a2[3]); w.z = pk2(a2[4], a2[5]); w.w = pk2(a2[6], a2[7]); *(LAS v4u*)(q_s + j * LDQK + 32 + 8 * p) = w; }
      ret_rot(F, zr + ZRK + h * 64, p, cc >= 2, (cc - 2) * 128 + j, 0.125f, a1, a2);
      { v4u w; w.x = pk2(a1[0], a1[1]); w.y = pk2(a1[2], a1[3]); w.z = pk2(a1[4], a1[5]); w.w = pk2(a1[6], a1[7]); *(LAS v4u*)(k_s + j * LDQK + 8 * p) = w;
        w.x = pk2(a2[0], a2[1]); w.y = pk2(a2[2], a2[3]); w.z = pk2(a2[4], a2[5]); w.w = pk2(a2[6], a2[7]); *(LAS v4u*)(k_s + j * LDQK + 32 + 8 * p) = w; }
      const bf16x8 v1 = *(const bf16x8*)(zr + ZRV + h * 64 + 8 * p), v2 = *(const bf16x8*)(zr + ZRV + h * 64 + 32 + 8 * p);
#pragma unroll
      for (int i = 0; i < 8; ++i) { vT[(8 * p + i) * LDP + j] = (bf16)v1[i]; vT[(32 + 8 * p + i) * LDP + j] = (bf16)v2[i]; } }
    { const bf16* sf = F.SPREV() + ((size_t)(((b * 4 + h) * 2 + 0) * NCH + cc)) * 4096;
      const bf16* sb = F.SPREV() + ((size_t)(((b * 4 + h) * 2 + 1) * NCH + cc)) * 4096;
      { const int dv = tid >> 3, c8 = (tid & 7) * 8;
          *(LAS v4u*)(SfT + dv * LDQK + c8) = *(const v4u*)(sf + dv * 64 + c8);
          *(LAS v4u*)(SbT + dv * LDQK + c8) = *(const v4u*)(sb + dv * 64 + c8); } }
    __syncthreads();
    const int sti = wave >> 1, stj0 = (wave & 1) * 2;
    f32x16 S0 = {}, S1 = {};
    S0 = mma_nt(q_s + sti * 32 * LDQK, LDQK, k_s + stj0 * 32 * LDQK, LDQK, 64, S0, lane);
    S1 = mma_nt(q_s + sti * 32 * LDQK, LDQK, k_s + (stj0 + 1) * 32 * LDQK, LDQK, 64, S1, lane);
    const int ei = tid >> 2, ec = (tid & 3) * 16;
    float yo[16];
#pragma unroll
    for (int dir = 0; dir < 2; ++dir) {
        const float lg = dir ? lgb : lgf;
#pragma unroll
        for (int x = 0; x < 16; ++x) { const int i = sti * 32 + crow(x, hi);
            const int j0 = stj0 * 32 + r32, j1 = j0 + 32; const int d0 = dir ? j0 - i : i - j0, d1 = dir ? j1 - i : i - j1;
            const float p0 = d0 >= 0 ? S0[x] * __expf(lg * (float)d0) : 0.f, p1 = d1 >= 0 ? S1[x] * __expf(lg * (float)d1) : 0.f;
            const unsigned pk = pg8::cvt_pk_bf16(p0, p1);
            P[i * LDP + j0] = (bf16)(pk & 0xffffu); P[i * LDP + j1] = (bf16)(pk >> 16);
            if ((x & 3) == 3) __builtin_amdgcn_sched_barrier(0); }
        __syncthreads();
        const int oti = wave >> 1, otj = wave & 1;
        f32x16 a0 = {}, c0 = {};
        { const LAS bf16* ST = dir ? SbT : SfT;
          a0 = mma_nt(P + oti * 32 * LDP, LDP, vT + otj * 32 * LDP, LDP, 128, a0, lane);
          c0 = mma_nt(q_s + oti * 32 * LDQK, LDQK, ST + otj * 32 * LDQK, LDQK, 64, c0, lane); }
        __syncthreads();
#pragma unroll
        for (int x = 0; x < 16; ++x) { const int i = oti * 32 + crow(x, hi);
            const float qd = __expf(lg * (float)(dir ? 128 - i : i + 1));
            O_s[i * LDO + otj * 32 + r32] = a0[x] + c0[x] * qd;
            if ((x & 3) == 3) __builtin_amdgcn_sched_barrier(0); }
        __syncthreads();
        { float o[16]; float s = 0.f;
#pragma unroll
          for (int c = 0; c < 16; ++c) { o[c] = O_s[ei * LDO + ec + c]; s += o[c]; }
          s += __shfl_xor(s, 1); s += __shfl_xor(s, 2);
          const float mu = s * (1.f / 64.f); float s2 = 0.f;
#pragma unroll
          for (int c = 0; c < 16; ++c) { o[c] -= mu; s2 += o[c] * o[c]; }
          s2 += __shfl_xor(s2, 1); s2 += __shfl_xor(s2, 2);
          const float rs = rsqrtf(s2 * (1.f / 64.f) + EPS);
          const bf16* zr = F.Z() + (size_t)(row0 + ei) * INC + (dir ? ZGB : ZGF) + h * 64 + ec;
          const bf16x8 ga = *(const bf16x8*)zr, gb = *(const bf16x8*)(zr + 8);
#pragma unroll
          for (int c = 0; c < 16; ++c) { const float g = bf2f((bf16)(c < 8 ? ga[c & 7] : gb[c & 7])); const float y = o[c] * rs * silu_f(g);
              if (dir == 0) yo[c] = y; else yo[c] += y; }
          if (dir == 1) { bf16* mr = F.MIX() + (size_t)(row0 + ei) * DM + 512 + h * 64 + ec;
              v4u w0, w1; w0.x = pk2(yo[0], yo[1]); w0.y = pk2(yo[2], yo[3]); w0.z = pk2(yo[4], yo[5]); w0.w = pk2(yo[6], yo[7]);
              w1.x = pk2(yo[8], yo[9]); w1.y = pk2(yo[10], yo[11]); w1.z = pk2(yo[12], yo[13]); w1.w = pk2(yo[14], yo[15]);
              *(v4u*)mr = w0; *(v4u*)(mr + 8) = w1; } }
        __syncthreads();
    }
}

__device__ __forceinline__ void unit_sg(const Frame& F, int L, int b, int g, int cc) {
    const int tid = F.tid, lane = F.lane, wave = F.wave, r32 = lane & 31, hi = lane >> 5;
    LAS bf16* W_s = (LAS bf16*)F.lds;
    LAS bf16* vT = W_s + 128 * LDP;
    const int row0 = chunk_row0(b, cc);
    const bf16* Wg = F.SGW() + (size_t)(L * 4 + g) * 128 * 128;
#pragma unroll
    for (int q = 0; q < 4; ++q) { const int idx = tid + NTHR * q, i = idx >> 4, c8 = (idx & 15) * 8; *(LAS bf16x8*)(W_s + i * LDP + c8) = *(const bf16x8*)(Wg + i * 128 + c8); }
    { const int j = tid >> 2, qd = tid & 3;
      const bf16* zr = F.Z() + (size_t)(row0 + j) * INC + ZSV + 64 * qd;
      float gv[64]; float sum = 0.f;
#pragma unroll
      for (int c = 0; c < 8; ++c) { const bf16x8 raw = *(const bf16x8*)(zr + 8 * c);
#pragma unroll
          for (int i = 0; i < 8; ++i) { const float t = gelu_t(bf2f((bf16)raw[i])); gv[8 * c + i] = t; sum += t; } }
      sum += __shfl_xor(sum, 1); sum += __shfl_xor(sum, 2);
      const float mu = sum * (1.f / 256.f); float s2 = 0.f;
#pragma unroll
      for (int c = 0; c < 64; ++c) { gv[c] -= mu; s2 += gv[c] * gv[c]; }
      s2 += __shfl_xor(s2, 1); s2 += __shfl_xor(s2, 2);
      const float rs = rsqrtf(s2 * (1.f / 256.f) + EPS);
      if (qd == g) { const float* gn = F.sgng() + L * 256 + g * 64;
#pragma unroll
          for (int c = 0; c < 64; ++c) vT[c * LDP + j] = (bf16)f2bf(gv[c] * rs * gn[c]); } }
    __syncthreads();
    LAS float* O_s = (LAS float*)W_s;
    { const int ti = wave >> 1, tj = wave & 1;
      f32x16 acc = {};
      acc = mma_nt(W_s + ti * 32 * LDP, LDP, vT + tj * 32 * LDP, LDP, 128, acc, lane);
      __syncthreads();
#pragma unroll
      for (int x = 0; x < 16; ++x) O_s[(ti * 32 + crow(x, hi)) * 66 + tj * 32 + r32] = acc[x]; }
    __syncthreads();
    { const int i = tid >> 2, ec = (tid & 3) * 16;
      const bf16* zu = F.Z() + (size_t)(row0 + i) * INC + ZSU + g * 64 + ec;
      const bf16x8 u0 = *(const bf16x8*)zu, u1 = *(const bf16x8*)(zu + 8);
      const float bi = F.sgb()[(L * 4 + g) * 128 + i];
      float o[16];
#pragma unroll
      for (int c = 0; c < 16; ++c) o[c] = gelu_t(bf2f((bf16)(c < 8 ? u0[c & 7] : u1[c & 7]))) * (O_s[i * 66 + ec + c] + bi);
      bf16* mr = F.MIX() + (size_t)(row0 + i) * DM + 768 + g * 64 + ec;
      v4u w0, w1; w0.x = pk2(o[0], o[1]); w0.y = pk2(o[2], o[3]); w0.z = pk2(o[4], o[5]); w0.w = pk2(o[6], o[7]);
      w1.x = pk2(o[8], o[9]); w1.y = pk2(o[10], o[11]); w1.z = pk2(o[12], o[13]); w1.w = pk2(o[14], o[15]);
      *(v4u*)mr = w0; *(v4u*)(mr + 8) = w1; }
    __syncthreads();
}

__device__ __forceinline__ void unit_out_ctx(const Frame& F, int L, int mu) {
    int tid = F.tid; asm volatile("" : "+v"(tid));
    const int lane = tid & 63, wave = F.wave, r32 = lane & 31, hi = lane >> 5;
    const int rb = mu >> 5, cb = mu & 31, k0 = wave * 128 + 8 * hi;
    LAS float* P = (LAS float*)F.lds;
    const bf16* A0 = F.MIX() + (size_t)(NLAT + rb * 64 + r32) * DM + k0;
    const bf16* B0 = F.WOUT() + (size_t)L * DM * DM + (size_t)(cb * 32 + r32) * DM + k0;
    bf16x8 a0[8], a1[8], bb[8];
#pragma unroll
    for (int s = 0; s < 8; ++s) { a0[s] = *(const bf16x8*)(A0 + 16 * s); a1[s] = *(const bf16x8*)(A0 + 32 * DM + 16 * s); bb[s] = *(const bf16x8*)(B0 + 16 * s); }
    f32x16 c0 = {}, c1 = {};
#pragma unroll
    for (int s = 0; s < 8; ++s) { c0 = __builtin_amdgcn_mfma_f32_32x32x16_bf16(a0[s], bb[s], c0, 0, 0, 0); c1 = __builtin_amdgcn_mfma_f32_32x32x16_bf16(a1[s], bb[s], c1, 0, 0, 0); }
#pragma unroll
    for (int x = 0; x < 16; ++x) { P[((wave * 2 + 0) * 16 + x) * 64 + lane] = c0[x]; P[((wave * 2 + 1) * 16 + x) * 64 + lane] = c1[x]; }
    __syncthreads();
    const float* g1 = F.MOD() + (size_t)(L * 3 + 2) * 6144 + 2048 + cb * 32;
#pragma unroll
    for (int q = 0; q < 4; ++q) {
        const int idx = tid + NTHR * q, ln = idx & 63, x = (idx >> 6) & 15, t = idx >> 10;
        float s = 0.f;
#pragma unroll
        for (int w = 0; w < 8; ++w) s += P[((w * 2 + t) * 16 + x) * 64 + ln];
        const int row = 32 * t + crow(x, ln >> 5), col = ln & 31;
        const size_t xo = (size_t)(rb * 64 + row) * DM + cb * 32 + col;
        F.X()[(size_t)NLAT * DM + xo] = (bf16)f2bf((L == 0 ? F.ctx_in()[xo] : bf2f(F.X()[(size_t)NLAT * DM + xo])) + g1[col] * s);
    }
    __syncthreads();
}

namespace att {
constexpr int KVBLK = 64;
constexpr float SCALE = 0.125f, THR = 8.f;
constexpr int LDQ = 512, LDK = 512, LDV = 512;
constexpr int SHM_V = KVBLK * 128 * 2, SHM_K = KVBLK * 64 * 2, SHM_ATTN = 2 * SHM_V + 2 * SHM_K + NWAVES * 64 * 4;
#define KSWZ(row, colB) ((row) * 128 + ((colB) ^ ((((row) >> 1) & 7) << 4)))
#define SBAR() __builtin_amdgcn_sched_barrier(0)
__device__ __forceinline__ unsigned cvtpk(float lo, float hi) { unsigned r; asm volatile("v_cvt_pk_bf16_f32 %0, %1, %2" : "=v"(r) : "v"(lo), "v"(hi)); return r; }
template <bool OFF> __device__ __forceinline__ void partialSM(f32x16& p0, f32x16& p1, float off) {
#pragma unroll
    for (int r = 0; r < 16; ++r) { if (OFF) { p0[r] += off; p1[r] += off; } p0[r] = __builtin_amdgcn_exp2f(p0[r]); }
}
__device__ __forceinline__ void finishSM(f32x16& p0, f32x16& p1, float& l_reg, bf16x8& pa0, bf16x8& pa1, bf16x8& pa2, bf16x8& pa3) {
#pragma unroll
    for (int r = 0; r < 16; ++r) p1[r] = __builtin_amdgcn_exp2f(p1[r]);
    float ps = 0;
#pragma unroll
    for (int r = 0; r < 16; ++r) ps += p0[r];
#pragma unroll
    for (int r = 0; r < 16; ++r) ps += p1[r];
    { auto rr = __builtin_amdgcn_permlane32_swap(__float_as_uint(ps), __float_as_uint(ps), false, false);
      ps = __uint_as_float(rr[0]) + __uint_as_float(rr[1]); }
    l_reg += ps;
#define PK4(P, BASE, OUT) do { unsigned a0 = cvtpk(P[BASE + 0], P[BASE + 1]), a1 = cvtpk(P[BASE + 2], P[BASE + 3]);   \
    unsigned b0 = cvtpk(P[BASE + 4], P[BASE + 5]), b1 = cvtpk(P[BASE + 6], P[BASE + 7]);                              \
    auto r0 = __builtin_amdgcn_permlane32_swap(a0, b0, false, false); auto r1 = __builtin_amdgcn_permlane32_swap(a1, b1, false, false); \
    v4u w = {r0[0], r1[0], r0[1], r1[1]}; OUT = __builtin_bit_cast(bf16x8, w); } while (0)
    PK4(p0, 0, pa0); PK4(p0, 8, pa1); PK4(p1, 0, pa2); PK4(p1, 8, pa3);
#undef PK4
}
template <bool OFF> __device__ __forceinline__ void kload(bf16x8 (&kf)[8], const LAS char* Ks, int r32, int hi) {
    if (OFF) return;
#pragma unroll
    for (int d0 = 0; d0 < 4; ++d0) { const int cb = (d0 * 16 + hi * 8) * 2;
        kf[2 * d0] = *(const LAS bf16x8*)(Ks + KSWZ(r32, cb)); kf[2 * d0 + 1] = *(const LAS bf16x8*)(Ks + KSWZ(32 + r32, cb)); }
}
template <bool OFF> __device__ __forceinline__ void qkmma(f32x16& p0, f32x16& p1, const bf16x8 (&kf)[8], const bf16x8* qr, const LAS char* Ks, int r32, int hi) {
    p0 = f32x16{}; p1 = f32x16{};
#pragma unroll
    for (int d0 = 0; d0 < 4; ++d0) {
        if (OFF) { const int cb = (d0 * 16 + hi * 8) * 2;
            const bf16x8 b0 = *(const LAS bf16x8*)(Ks + KSWZ(r32, cb)), b1 = *(const LAS bf16x8*)(Ks + KSWZ(32 + r32, cb));
            p0 = __builtin_amdgcn_mfma_f32_32x32x16_bf16(b0, qr[d0], p0, 0, 0, 0); p1 = __builtin_amdgcn_mfma_f32_32x32x16_bf16(b1, qr[d0], p1, 0, 0, 0); }
        else { p0 = __builtin_amdgcn_mfma_f32_32x32x16_bf16(kf[2 * d0], qr[d0], p0, 0, 0, 0); p1 = __builtin_amdgcn_mfma_f32_32x32x16_bf16(kf[2 * d0 + 1], qr[d0], p1, 0, 0, 0); } }
}
__device__ __forceinline__ int v_st(int k, int c) { const int kk = (k & ~0xC) | ((k & 4) << 1) | ((k & 8) >> 1); return ((kk >> 3) * 4 + (c >> 5)) * 512 + ((kk & 7) * 32 + (c & 31)) * 2; }
__device__ __forceinline__ int v_rd_base(int lane) { return ((lane & 3) << 3) | (((lane >> 2) & 3) << 6) | (((lane >> 4) & 1) << 5) | (((lane >> 5) & 1) << 8); }
constexpr int v_rd_off(int d0, int ks, int half) { return d0 * 512 + ks * 4096 + half * 2048; }
template <int OFF> __device__ __forceinline__ s16x4 tr_read(int vb) {
    s16x4 r; asm volatile("ds_read_b64_tr_b16 %0, %1 offset:%2" : "=&v"(r) : "v"(vb), "i"(OFF) : "memory"); return r;
}
template <int D0> __device__ __forceinline__ void pv_one(f32x16& od, int vb, bf16x8 pa0, bf16x8 pa1, bf16x8 pa2, bf16x8 pa3) {
    const s16x4 l0 = tr_read<v_rd_off(D0, 0, 0)>(vb), h0 = tr_read<v_rd_off(D0, 0, 1)>(vb), l1 = tr_read<v_rd_off(D0, 1, 0)>(vb), h1 = tr_read<v_rd_off(D0, 1, 1)>(vb);
    const s16x4 l2 = tr_read<v_rd_off(D0, 2, 0)>(vb), h2 = tr_read<v_rd_off(D0, 2, 1)>(vb), l3 = tr_read<v_rd_off(D0, 3, 0)>(vb), h3 = tr_read<v_rd_off(D0, 3, 1)>(vb);
    asm volatile("s_waitcnt lgkmcnt(0)" ::: "memory"); SBAR();
#define PK(Lo, Hi) (bf16x8){Lo[0], Lo[1], Lo[2], Lo[3], Hi[0], Hi[1], Hi[2], Hi[3]}
    od = __builtin_amdgcn_mfma_f32_32x32x16_bf16(pa0, PK(l0, h0), od, 0, 0, 0);
    od = __builtin_amdgcn_mfma_f32_32x32x16_bf16(pa1, PK(l1, h1), od, 0, 0, 0);
    od = __builtin_amdgcn_mfma_f32_32x32x16_bf16(pa2, PK(l2, h2), od, 0, 0, 0);
    od = __builtin_amdgcn_mfma_f32_32x32x16_bf16(pa3, PK(l3, h3), od, 0, 0, 0);
#undef PK
}
__device__ __forceinline__ void pv_d0(f32x16* o, int vb, bf16x8 pa0, bf16x8 pa1, bf16x8 pa2, bf16x8 pa3) {
    pv_one<0>(o[0], vb, pa0, pa1, pa2, pa3); pv_one<1>(o[1], vb, pa0, pa1, pa2, pa3); pv_one<2>(o[2], vb, pa0, pa1, pa2, pa3); pv_one<3>(o[3], vb, pa0, pa1, pa2, pa3);
}
template <bool OFF> __device__ __forceinline__ void body(const bf16* __restrict__ Qb, const bf16* __restrict__ Kh, const bf16* __restrict__ Vh, int seq, float mfix, LAS char* lds, f32x16 (&o)[4]) {
    int tid = threadIdx.x; asm volatile("" : "+v"(tid));
    const int wid = __builtin_amdgcn_readfirstlane(tid >> 6), lane = tid & 63, r32 = lane & 31, hi = lane >> 5;
    LAS char* V_lds = lds; LAS char* K_lds = lds + 2 * SHM_V;
    LAS float* ws = (LAS float*)(lds + 2 * SHM_V + 2 * SHM_K) + wid * 64; LAS float* li_l = ws; LAS float* al_l = ws + 32;
    float l_reg = 0;
    const float soff = -mfix * (SCALE * 1.4426950408889634f);
#pragma unroll
    for (int d = 0; d < 4; ++d) o[d] = f32x16{};
    bf16x8 qr[4];
    const bf16* Qw = Qb + (long)(wid * 32 + r32) * LDQ + hi * 8;
#pragma unroll
    for (int d0 = 0; d0 < 4; ++d0) qr[d0] = *(const bf16x8*)(Qw + d0 * 16);
    const int sr = tid >> 4, sc = (tid & 15) * 8, vst0 = v_st(sr, sc), vst1 = v_st(32 + sr, sc);
    const int kr = tid >> 3, kc = (tid & 7) * 8, kst = KSWZ(kr, kc * 2);
    const int vb0 = (int)(uintptr_t)V_lds + v_rd_base(lane);
    struct { bf16x8 vs0, vs1, ks0; } sr_[2];
#define SLOAD(i, k0) do { sr_[i].vs0 = *(const bf16x8*)(&Vh[(long)((k0) + sr) * LDV + sc]); sr_[i].vs1 = *(const bf16x8*)(&Vh[(long)((k0) + 32 + sr) * LDV + sc]); \
    sr_[i].ks0 = *(const bf16x8*)(&Kh[(long)((k0) + kr) * LDK + kc]); } while (0)
#define SWRITE(b, i) do { *(LAS bf16x8*)(V_lds + (b) * SHM_V + vst0) = sr_[i].vs0; *(LAS bf16x8*)(V_lds + (b) * SHM_V + vst1) = sr_[i].vs1; \
    *(LAS bf16x8*)(K_lds + (b) * SHM_K + kst) = sr_[i].ks0; } while (0)
#define SWAIT() asm volatile("s_waitcnt vmcnt(3)" ::: "memory")
    f32x16 pA0, pA1, pB0, pB1; bf16x8 pa0, pa1, pa2, pa3; const int NT = seq / KVBLK;
    constexpr int SE = 0, SO = 1;
    SLOAD(SE, 0); asm volatile("s_waitcnt vmcnt(0)" ::: "memory"); SWRITE(0, SE); __syncthreads();
    bf16x8 kf[8];
    kload<OFF>(kf, K_lds, r32, hi); qkmma<OFF>(pA0, pA1, kf, qr, K_lds, r32, hi); partialSM<OFF>(pA0, pA1, soff);
    SLOAD(SO, KVBLK); if (2 < NT) SLOAD(SE, 2 * KVBLK);
    SWAIT(); SWRITE(1, SO); __syncthreads();
    for (int j = 1; j + 1 < NT; j += 2) {
        SBAR(); kload<OFF>(kf, K_lds + SHM_K, r32, hi); SBAR();
        qkmma<OFF>(pB0, pB1, kf, qr, K_lds + SHM_K, r32, hi); finishSM(pA0, pA1, l_reg, pa0, pa1, pa2, pa3); SBAR();
        SLOAD(SO, (j + 2) * KVBLK); SBAR();
        pv_d0(o, vb0, pa0, pa1, pa2, pa3); partialSM<OFF>(pB0, pB1, soff);
        __syncthreads(); SWAIT(); SWRITE(0, SE);
        __syncthreads();
        SBAR(); kload<OFF>(kf, K_lds, r32, hi); SBAR();
        qkmma<OFF>(pA0, pA1, kf, qr, K_lds, r32, hi); finishSM(pB0, pB1, l_reg, pa0, pa1, pa2, pa3); SBAR();
        if (j + 3 < NT) SLOAD(SE, (j + 3) * KVBLK); SBAR();
        pv_d0(o, vb0 + (int)SHM_V, pa0, pa1, pa2, pa3); partialSM<OFF>(pA0, pA1, soff);
        __syncthreads(); SWAIT(); SWRITE(1, SO);
        __syncthreads();
    }
    SBAR(); kload<OFF>(kf, K_lds + SHM_K, r32, hi); SBAR();
    qkmma<OFF>(pB0, pB1, kf, qr, K_lds + SHM_K, r32, hi); finishSM(pA0, pA1, l_reg, pa0, pa1, pa2, pa3); SBAR();
    pv_d0(o, vb0, pa0, pa1, pa2, pa3); partialSM<OFF>(pB0, pB1, soff);
    __syncthreads();
    finishSM(pB0, pB1, l_reg, pa0, pa1, pa2, pa3); SBAR();
    pv_d0(o, vb0 + (int)SHM_V, pa0, pa1, pa2, pa3);
    if (hi == 0) li_l[r32] = l_reg; asm volatile("s_waitcnt lgkmcnt(0)" ::: "memory");
#pragma unroll
    for (int r = 0; r < 16; ++r) { const float rl = __builtin_amdgcn_rcpf(li_l[crow(r, hi)]);
#pragma unroll
        for (int d0 = 0; d0 < 4; ++d0) o[d0][r] *= rl; }
    __syncthreads();
#undef SLOAD
#undef SWRITE
#undef SWAIT
}

constexpr int SLK = 8192, SLV = 16384, L_K = 0, L_V = 3 * SLK, L_WS = L_V + 3 * SLV;
typedef const LAS char* lds_cptr;
typedef short v4i16_t __attribute__((ext_vector_type(4)));
#define PIN(x) asm volatile("" : "+v"(x))
#define MFMA32(a, b, c) __builtin_amdgcn_mfma_f32_32x32x16_bf16(a, b, c, 0, 0, 0)
#define WAIT_BAR(N) asm volatile("s_waitcnt vmcnt(" #N ") lgkmcnt(0)\n\ts_barrier" ::: "memory")
__device__ __forceinline__ unsigned cvtpk2(float lo, float hi) { unsigned r; asm("v_cvt_pk_bf16_f32 %0, %1, %2" : "=v"(r) : "v"(lo), "v"(hi)); return r; }
__device__ __forceinline__ void glds16(const void* g, unsigned lds_base) {
    unsigned sv; asm volatile("s_mov_b32 %0, m0\n\ts_mov_b32 m0, %2\n\ts_nop 0\n\tglobal_load_lds_dwordx4 %1, off\n\ts_mov_b32 m0, %0" : "=&s"(sv) : "v"(g), "s"(lds_base) : "memory"); }
__device__ __forceinline__ void kload2(bf16x8* kf, lds_cptr kp, int d0) { kf[2 * d0] = *(const LAS bf16x8*)(kp + d0 * 2048); kf[2 * d0 + 1] = *(const LAS bf16x8*)(kp + d0 * 2048 + 512); }
__device__ __forceinline__ s16x4 vtr(lds_cptr p) { return __builtin_bit_cast(s16x4, __builtin_amdgcn_ds_read_tr16_b64_v4i16((LAS v4i16_t*)p)); }
__device__ __forceinline__ void body_fast(const bf16* __restrict__ Qb, const bf16* __restrict__ Kh, const bf16* __restrict__ Vh, int seq, LAS char* lds, f32x16 (&o)[4]) {
    int tid = threadIdx.x; asm volatile("" : "+v"(tid));
    const int wid = __builtin_amdgcn_readfirstlane(tid >> 6), lane = tid & 63, r32 = lane & 31, hi = lane >> 5;
    const int NT = seq / KVBLK;
    const unsigned lds0 = (unsigned)(uintptr_t)lds; LAS float* wsf = (LAS float*)(lds + L_WS) + wid * 64;
    const bool dma = wid < 4;
    const unsigned kvo = (unsigned)(lane * LDK * 2 + (wid & 3) * 16);
    const unsigned vvo = (unsigned)((16 * (wid & 3) + (lane >> 2)) * LDV * 2 + (lane & 3) * 16);
    const unsigned kdst = lds0 + L_K + (wid & 3) * 1024, vdst = lds0 + L_V + (wid & 3) * 1024;
#define DMA_K(t, slot) do { if (dma) { unsigned sv_; asm volatile("s_mov_b32 %0, m0\n\ts_mov_b32 m0, %3\n\ts_nop 0\n\tglobal_load_lds_dwordx4 %1, %2\n\ts_add_u32 m0, m0, 0xfc0\n\ts_nop 0\n\t" \
        "global_load_lds_dwordx4 %1, %2 offset:64\n\ts_mov_b32 m0, %0" : "=&s"(sv_) : "v"(kvo), "s"((const char*)Kh + (size_t)(t) * (KVBLK * LDK * 2)), "s"(kdst + (slot)) : "memory", "scc"); } } while (0)
#define DMA_V(t, slot) do { if (dma) { unsigned sv_; asm volatile("s_mov_b32 %0, m0\n\ts_mov_b32 m0, %3\n\ts_nop 0\n\tglobal_load_lds_dwordx4 %1, %2\n\ts_add_u32 m0, m0, 0xfc0\n\ts_nop 0\n\t" \
        "global_load_lds_dwordx4 %1, %2 offset:64\n\ts_add_u32 m0, m0, 0xfc0\n\ts_nop 0\n\tglobal_load_lds_dwordx4 %1, %2 offset:128\n\ts_add_u32 m0, m0, 0xfc0\n\ts_nop 0\n\t" \
        "global_load_lds_dwordx4 %1, %2 offset:192\n\ts_mov_b32 m0, %0" : "=&s"(sv_) : "v"(vvo), "s"((const char*)Vh + (size_t)(t) * (KVBLK * LDV * 2)), "s"(vdst + 2 * (slot)) : "memory", "scc"); } } while (0)
    const lds_cptr vp0 = (lds_cptr)lds + L_V + ((lane >> 4) & 1) * 32 + (lane & 3) * 8 + (4 * hi + ((lane & 15) >> 2)) * 64;
    const lds_cptr kp0 = (lds_cptr)lds + L_K + hi * 1024 + r32 * 16;
    DMA_K(0, 0); DMA_V(0, 0); DMA_K(1, SLK);
    bf16x8 qr[4];
    const bf16* Qw = Qb + (long)(wid * 32 + r32) * LDQ + hi * 8;
#pragma unroll
    for (int d0 = 0; d0 < 4; ++d0) qr[d0] = *(const bf16x8*)(Qw + d0 * 16);
    float l_reg = 0.f;
#pragma unroll
    for (int d = 0; d < 4; ++d) o[d] = f32x16{};
    f32x16 pA0, pA1, pB0, pB1; bf16x8 kf[8]; s16x4 vlo[8], vhi[8]; v4u pw0, pw1, pw2, pw3;
    int sl_prev = 0, sl_cur = 0, sl_next = SLK;
#define ROT() do { sl_prev = sl_cur; sl_cur = sl_next; sl_next = (sl_next == 2 * SLK) ? 0 : sl_next + SLK; } while (0)
#define EX(v) __builtin_amdgcn_exp2f(v)
    DMA_K(2, 2 * SLK);
    WAIT_BAR(4);
    _Pragma("unroll") for (int d0 = 0; d0 < 4; ++d0) kload2(kf, kp0, d0);
    pA0 = MFMA32(kf[0], qr[0], f32x16{}); pA1 = MFMA32(kf[1], qr[0], f32x16{}); pA0 = MFMA32(kf[2], qr[1], pA0); pA1 = MFMA32(kf[3], qr[1], pA1);
    pA0 = MFMA32(kf[4], qr[2], pA0); pA1 = MFMA32(kf[5], qr[2], pA1); pA0 = MFMA32(kf[6], qr[3], pA0); pA1 = MFMA32(kf[7], qr[3], pA1);
#pragma unroll
    for (int r = 0; r < 16; ++r) { pA0[r] = EX(pA0[r]); pA1[r] = EX(pA1[r]); }
    WAIT_BAR(0);
    DMA_K(3, 0); DMA_V(1, SLK); ROT();
    _Pragma("unroll") for (int d0 = 0; d0 < 4; ++d0) kload2(kf, kp0 + sl_cur, d0);
    WAIT_BAR(6);
#define PKW(P, i) cvtpk2(P[i], P[i + 1])
#define PAF(k) __builtin_bit_cast(bf16x8, pw##k)
#define VFR(i) (bf16x8){vlo[i][0], vlo[i][1], vlo[i][2], vlo[i][3], vhi[i][0], vhi[i][1], vhi[i][2], vhi[i][3]}
#define VRD(s, fi) do { vlo[s] = vtr(vp_ + (((fi) >> 2) * 4096 + ((fi) & 3) * 1024)); vhi[s] = vtr(vp_ + (((fi) >> 2) * 4096 + ((fi) & 3) * 1024 + 512)); } while (0)
#define KRD(G, d0) do { if (G) { kload2(kf, kp0 + sl_next, d0); SBAR(); } } while (0)
#define GAPA(MF, a0, a1, a2, a3, W0, W1, PW) do { MF; sacc += a0; sacc2 += a1; sacc += a2; sacc2 += a3; W0; W1; PIN(PW); PIN(sacc); PIN(sacc2); SBAR(); } while (0)
#define GAPB(MF, X, i) do { MF; X[i] = EX(X[i]); X[i + 1] = EX(X[i + 1]); PIN(X); SBAR(); } while (0)
#define STEP(C0, C1, P0, P1, t, GK, GV, GL) do { SBAR(); \
    const lds_cptr vp_ = vp0 + 2 * sl_prev; \
    VRD(0, 0); SBAR(); float sacc = P0[0], sacc2 = P0[1]; \
                       GAPA(C0 = MFMA32(kf[0], qr[0], f32x16{}), P0[2], P0[3], P0[4], P0[5],     pw0[0] = PKW(P0, 0),  pw0[1] = PKW(P0, 2),  pw0); \
    VRD(4, 4); SBAR(); GAPA(C1 = MFMA32(kf[1], qr[0], f32x16{}), P0[6], P0[7], P0[8], P0[9],     pw0[2] = PKW(P0, 4),  pw0[3] = PKW(P0, 6),  pw0); \
    VRD(1, 1); SBAR(); GAPA(C0 = MFMA32(kf[2], qr[1], C0),       P0[10], P0[11], P0[12], P0[13], pw1[0] = PKW(P0, 8),  pw1[1] = PKW(P0, 10), pw1); \
    VRD(5, 5); SBAR(); GAPA(C1 = MFMA32(kf[3], qr[1], C1),       P0[14], P0[15], P1[0], P1[1],   pw1[2] = PKW(P0, 12), pw1[3] = PKW(P0, 14), pw1); \
    VRD(2, 2); SBAR(); GAPA(C0 = MFMA32(kf[4], qr[2], C0),       P1[2], P1[3], P1[4], P1[5],     pw2[0] = PKW(P1, 0),  pw2[1] = PKW(P1, 2),  pw2); \
    VRD(6, 6); SBAR(); GAPA(C1 = MFMA32(kf[5], qr[2], C1),       P1[6], P1[7], P1[8], P1[9],     pw2[2] = PKW(P1, 4),  pw2[3] = PKW(P1, 6),  pw2); \
    VRD(3, 3); SBAR(); GAPA(C0 = MFMA32(kf[6], qr[3], C0),       P1[10], P1[11], P1[12], P1[13], pw3[0] = PKW(P1, 8),  pw3[1] = PKW(P1, 10), pw3); \
    VRD(7, 7); SBAR(); GAPA(C1 = MFMA32(kf[7], qr[3], C1),       P1[14], P1[15], 0.f, 0.f,       pw3[2] = PKW(P1, 12), pw3[3] = PKW(P1, 14), pw3); \
    l_reg += sacc + sacc2; SBAR(); \
    GAPB(o[0] = MFMA32(PAF(0), VFR(0), o[0]), C0, 0);  VRD(0, 8);  SBAR(); \
    GAPB(o[1] = MFMA32(PAF(0), VFR(4), o[1]), C0, 2);  VRD(4, 12); SBAR(); \
    GAPB(o[0] = MFMA32(PAF(1), VFR(1), o[0]), C0, 4);  VRD(1, 9);  SBAR(); \
    GAPB(o[1] = MFMA32(PAF(1), VFR(5), o[1]), C0, 6);  VRD(5, 13); SBAR(); \
    GAPB(o[0] = MFMA32(PAF(2), VFR(2), o[0]), C0, 8);  VRD(2, 10); SBAR(); \
    GAPB(o[1] = MFMA32(PAF(2), VFR(6), o[1]), C0, 10); VRD(6, 14); SBAR(); \
    GAPB(o[0] = MFMA32(PAF(3), VFR(3), o[0]), C0, 12); VRD(3, 11); SBAR(); \
    GAPB(o[1] = MFMA32(PAF(3), VFR(7), o[1]), C0, 14); VRD(7, 15); SBAR(); \
    KRD(GL, 0); GAPB(o[2] = MFMA32(PAF(0), VFR(0), o[2]), C1, 0); \
    KRD(GL, 1); GAPB(o[3] = MFMA32(PAF(0), VFR(4), o[3]), C1, 2); \
    KRD(GL, 2); GAPB(o[2] = MFMA32(PAF(1), VFR(1), o[2]), C1, 4); \
    KRD(GL, 3); GAPB(o[3] = MFMA32(PAF(1), VFR(5), o[3]), C1, 6); \
    GAPB(o[2] = MFMA32(PAF(2), VFR(2), o[2]), C1, 8);  if (dma) { if (GK) DMA_K((t) + 3, sl_cur); if (GV) DMA_V((t) + 1, sl_next); } SBAR(); \
    GAPB(o[3] = MFMA32(PAF(2), VFR(6), o[3]), C1, 10); \
    GAPB(o[2] = MFMA32(PAF(3), VFR(3), o[2]), C1, 12); \
    GAPB(o[3] = MFMA32(PAF(3), VFR(7), o[3]), C1, 14); \
    } while (0)
    int t = 1;
    for (; t + 5 < NT; t += 2) {
        STEP(pB0, pB1, pA0, pA1, t, true, true, true);     WAIT_BAR(6); ROT();
        STEP(pA0, pA1, pB0, pB1, t + 1, true, true, true); WAIT_BAR(6); ROT();
    }
#define ENDW(tt) do { if ((tt) + 3 < NT) { WAIT_BAR(6); } else if ((tt) + 2 < NT) { WAIT_BAR(4); } else { WAIT_BAR(0); } } while (0)
    for (; t + 1 < NT; t += 2) {
        STEP(pB0, pB1, pA0, pA1, t, (t + 3 < NT), (t + 1 < NT), (t + 1 < NT));         ENDW(t);     ROT();
        STEP(pA0, pA1, pB0, pB1, t + 1, (t + 4 < NT), (t + 2 < NT), (t + 2 < NT));     ENDW(t + 1); ROT();
    }
    STEP(pB0, pB1, pA0, pA1, NT - 1, false, false, false);
    { float sacc = pB0[0] + pB0[1];
#pragma unroll
      for (int r = 2; r < 16; ++r) sacc += pB0[r];
#pragma unroll
      for (int r = 0; r < 16; ++r) sacc += pB1[r];
      l_reg += sacc;
      pw0 = (v4u){PKW(pB0, 0), PKW(pB0, 2), PKW(pB0, 4), PKW(pB0, 6)}; pw1 = (v4u){PKW(pB0, 8), PKW(pB0, 10), PKW(pB0, 12), PKW(pB0, 14)};
      pw2 = (v4u){PKW(pB1, 0), PKW(pB1, 2), PKW(pB1, 4), PKW(pB1, 6)}; pw3 = (v4u){PKW(pB1, 8), PKW(pB1, 10), PKW(pB1, 12), PKW(pB1, 14)};
      const lds_cptr vp_ = vp0 + 2 * sl_cur;
      _Pragma("unroll") for (int i = 0; i < 8; ++i) VRD(i, i);
      o[0] = MFMA32(PAF(0), VFR(0), o[0]); o[1] = MFMA32(PAF(0), VFR(4), o[1]); o[0] = MFMA32(PAF(1), VFR(1), o[0]); o[1] = MFMA32(PAF(1), VFR(5), o[1]);
      o[0] = MFMA32(PAF(2), VFR(2), o[0]); o[1] = MFMA32(PAF(2), VFR(6), o[1]); o[0] = MFMA32(PAF(3), VFR(3), o[0]); o[1] = MFMA32(PAF(3), VFR(7), o[1]);
      SBAR();
      _Pragma("unroll") for (int i = 0; i < 8; ++i) VRD(i, 8 + i);
      o[2] = MFMA32(PAF(0), VFR(0), o[2]); o[3] = MFMA32(PAF(0), VFR(4), o[3]); o[2] = MFMA32(PAF(1), VFR(1), o[2]); o[3] = MFMA32(PAF(1), VFR(5), o[3]);
      o[2] = MFMA32(PAF(2), VFR(2), o[2]); o[3] = MFMA32(PAF(2), VFR(6), o[3]); o[2] = MFMA32(PAF(3), VFR(3), o[2]); o[3] = MFMA32(PAF(3), VFR(7), o[3]); }
    { auto rr = __builtin_amdgcn_permlane32_swap(__float_as_uint(l_reg), __float_as_uint(l_reg), false, false); l_reg = __uint_as_float(rr[0]) + __uint_as_float(rr[1]); }
    if (hi == 0) wsf[32 + r32] = l_reg; asm volatile("s_waitcnt lgkmcnt(0)" ::: "memory");
#pragma unroll
    for (int r = 0; r < 16; ++r) { const float rl = __builtin_amdgcn_rcpf(wsf[32 + crow(r, hi)]);
#pragma unroll
        for (int d0 = 0; d0 < 4; ++d0) o[d0][r] *= rl; }
    asm volatile("s_waitcnt lgkmcnt(0)\n\ts_barrier" ::: "memory");
#undef DMA_K
#undef DMA_V
#undef ROT
#undef EX
#undef PKW
#undef PAF
#undef VFR
#undef VRD
#undef KRD
#undef ENDW
#undef GAPA
#undef GAPB
#undef STEP
}
}

__device__ __forceinline__ void unit_attn(const Frame& F, int L, int b, int h, int qrow0  , int seq) {
    f32x16 o[4];
    for (int m = 0; m < 2; ++m) {
        const float mfix = F.LP()[L * 16 + 10];
        if (__builtin_expect(mfix * (att::SCALE * 1.4426950408889634f) > 64.f, 0))
            att::body<true>(F.QH() + (size_t)qrow0 * 512 + (h * 2 + m) * 64, F.KH() + (size_t)b * NKEY * 512 + (h * 2 + m) * 64, F.VH() + (size_t)b * NKEY * 512 + h * 128, seq, mfix, (LAS char*)F.lds, o);
        else
            att::body_fast(F.QH() + (size_t)qrow0 * 512 + (h * 2 + m) * 64, F.KH() + (size_t)b * NKEY * 512 + (h * 2 + m) * 64, F.VH() + (size_t)b * NKEY * 512 + h * 128, seq, (LAS char*)F.lds, o);
        if (m == 0) {
            int tid = F.tid; asm volatile("" : "+v"(tid));
            const int lane = tid & 63, wave = __builtin_amdgcn_readfirstlane(tid >> 6), r32 = lane & 31, hi = lane >> 5;
            float* scr = F.SCR() + (size_t)F.bid * 256 * 128 + (size_t)(wave * 32) * 128;
#pragma unroll
            for (int r = 0; r < 16; ++r)
#pragma unroll
                for (int d0 = 0; d0 < 4; ++d0) scr[crow(r, hi) * 128 + d0 * 32 + r32] = o[d0][r];
            asm volatile("s_waitcnt vmcnt(0)" ::: "memory");
        }
    }
    int tid = F.tid; asm volatile("" : "+v"(tid));
    const int lane = tid & 63, wave = __builtin_amdgcn_readfirstlane(tid >> 6), r32 = lane & 31, hi = lane >> 5;
    const float lam = F.LP()[L * 16 + 0], oscale = F.LP()[L * 16 + 1];
    const float* scr = F.SCR() + (size_t)F.bid * 256 * 128 + (size_t)(wave * 32) * 128;
    float sg[4];
#pragma unroll
    for (int d0 = 0; d0 < 4; ++d0) sg[d0] = F.subg()[L * 128 + d0 * 32 + r32] * oscale;
#pragma unroll
    for (int r = 0; r < 16; ++r) {
        float d[4]; float ss = 0.f;
#pragma unroll
        for (int d0 = 0; d0 < 4; ++d0) { d[d0] = scr[crow(r, hi) * 128 + d0 * 32 + r32] - lam * o[d0][r]; ss += d[d0] * d[d0]; }
        const float rs = rsqrtf(half_sum32(ss) * (1.f / 128.f) + EPS);
        bf16* mr = F.MIX() + (size_t)(qrow0 + wave * 32 + crow(r, hi)) * DM + h * 128;
#pragma unroll
        for (int d0 = 0; d0 < 4; ++d0) mr[d0 * 32 + r32] = (bf16)f2bf(d[d0] * rs * sg[d0]);
    }
}


constexpr int NPH_L = 12, NPHASE = 2 + DEPTH * NPH_L;
struct Args { const float* in[25]; float* out; unsigned char* ws; int gp_lo, gp_hi; };
__global__ void __launch_bounds__(NTHR, 2) fwd(Args args) {
    extern __shared__ __attribute__((aligned(16))) unsigned char lds[];
    Frame F;
    F.lds = (LAS unsigned char*)lds;
    F.tid = threadIdx.x; F.lane = F.tid & 63; F.wave = __builtin_amdgcn_readfirstlane(F.tid >> 6); F.bid = blockIdx.x; F.G = gridDim.x;
    F.in = args.in; F.out = args.out; F.ws = args.ws;
    unsigned char* ws = args.ws;
    volatile LAS unsigned* MISC = (volatile LAS unsigned*)(F.lds + MISC_OFF);
    for (int u = F.tid; u < (LDS_BYTES - RING_BYTES) / 4; u += NTHR) ((LAS unsigned*)(F.lds + RING_BYTES))[u] = 0u;
    __syncthreads();
#if MK_ONE_LAUNCH
    constexpr int lo = 0, hi = NPHASE;
#else
    const int lo = args.gp_lo, hi = args.gp_hi;
#endif
    unsigned* barw = (unsigned*)(ws + WS_CTL) + CW_BAR;
    XcdBarrier bar; bar.bar = barw; bar.x = 0; bar.st = nullptr;
    if (hi - lo > 1) bar = xcd_barrier_post(barw, MISC + 8);
#ifndef N_CV_N2
#define N_CV_N2 2
#endif
#ifndef N_CV_INP
#define N_CV_INP 1
#endif
#ifndef N_CV_OUT
#define N_CV_OUT 1
#endif
#ifndef N_CV_TOPK
#define N_CV_TOPK 1
#endif
#ifndef N_CV_DOWN
#define N_CV_DOWN 1
#endif
#ifndef PHM
#define PHM 0xFFFF
#endif
#define PB(i) (((PHM) >> (i)) & 1)
#ifndef DBLM
#define DBLM 0
#endif
#define REP(i) for (int rep_ = 0; rep_ < ((((DBLM) >> (i)) & 1) ? 2 : 1); ++rep_)
#define IN(k) (lo <= (k) && (k) < hi)
#ifndef BARX
#define BARX 1
#endif
#define SEAM(k) do { if (IN(k) && IN((k) + 1)) { for (int bx_ = 0; bx_ < BARX; ++bx_) xcd_barrier(bar); } } while (0)

    if (PB(0) && IN(0)) REP(0) ph_prologue(F);
    SEAM(0);
    if (PB(1) && IN(1)) REP(1) ph_norm1_first(F);
    SEAM(1);
    for (int L = 0; L < DEPTH; ++L) {
        const int base = 2 + NPH_L * L;
#define FRESH() do { F.tid = threadIdx.x; asm volatile("" : "+v"(F.tid)); F.lane = F.tid & 63; } while (0)
        if (PB(2) && IN(base + 0)) REP(2) {
            pg8::Gemm g{F.HN(), F.WIN() + (size_t)L * INC * DM, NROW, INC, DM}; pg8::StaticOrder S; S.init(NROW, INC, F.G, F.bid);
            EpiZ E{F.Z(), F.VH(), F.QH(), F.KH(), F.LP() + DEPTH * 16 + L * 128, F.ROPE()};
            pg8::gemm_phase<EpiZ, pg8::StaticOrder, true, true>(F.lds, g, S, E);
            if (F.bid >= (66 * 13) % 256) { FRESH(); conv_n(F, N_CV_INP); }
        }
        SEAM(base + 0);
        if (PB(3) && IN(base + 1)) REP(3) {
            FRESH();
            for (int u = F.bid; u < 1056; u += F.G) {
                const int v = u < 528 ? u : u - 528; const int b = v / 264, hh = (v / NCH) & 3, cc = v % NCH;
                if (u < 528) unit_retkv(F, L, b, hh, cc); else if (!(L == DEPTH - 1 && cc < 2)) unit_sg(F, L, b, hh, cc);
            }
        }
        SEAM(base + 1);
        if (PB(5) && IN(base + 3)) REP(5) { FRESH(); ph_scan(F, L); }
        SEAM(base + 3);
        if (PB(6) && IN(base + 4)) REP(6) {
            FRESH();
            for (int u = F.bid; u < 264 + 528; u += F.G) {
                if (u < 264) {
                    int b, hh, qrow0, seq;
                    if (u < 256) { const int bh = u & 7, qb = u >> 3; b = bh >> 2; hh = bh & 3; qrow0 = b * SEQ + qb * 256; seq = NKEY; }
                    else { if (L == DEPTH - 1) continue; const int v = u - 256; b = v >> 2; hh = v & 3; qrow0 = NLAT + b * CTXL; seq = CTXL; }
#ifndef NO_ATTN
                    unit_attn(F, L, b, hh, qrow0, seq);
#endif
                } else {
#ifndef NO_RETOUT
                    const int v = u - 264; if (!(L == DEPTH - 1 && (v % NCH) < 2)) unit_retout(F, L, v / 264, (v / NCH) & 3, v % NCH);
#endif
                }
            }
        }
        SEAM(base + 4);
        if (PB(7) && IN(base + 5)) REP(7) {
            pg8::Gemm g{F.MIX(), F.WOUT() + (size_t)L * DM * DM, NLAT, DM, DM}; pg8::StaticOrder S; S.init(NLAT, DM, F.G, F.bid);
#ifdef PROBE_OUT2
            { EpiResid E0{(bf16*)(F.ws + WS_Y), F.MOD() + (size_t)L * 3 * 6144 + 2048, L == 0 ? F.x_in() : nullptr}; pg8::gemm_phase<EpiResid, pg8::StaticOrder, true, true>(F.lds, g, S, E0); }
#endif
            EpiResid E{F.X(), F.MOD() + (size_t)L * 3 * 6144 + 2048, L == 0 ? F.x_in() : nullptr};
            pg8::gemm_phase<EpiResid, pg8::StaticOrder, true, true>(F.lds, g, S, E);
            if (L < DEPTH - 1) { FRESH(); for (int mu = F.bid; mu < 256; mu += F.G) unit_out_ctx(F, L, mu); }
        }
        SEAM(base + 5);
        if (PB(8) && IN(base + 6)) REP(8) { FRESH(); ph_norm2_router(F, L); if (F.bid >= (((L == DEPTH - 1) ? NLAT : NROW) / 16 + NWAVES - 1) / NWAVES) conv_n(F, N_CV_N2); }
        SEAM(base + 6);
        if (PB(9) && IN(base + 7)) REP(9) { FRESH(); ph_topk(F, L); if (F.bid >= ((L == DEPTH - 1) ? 32 : 64)) conv_n(F, N_CV_TOPK);
            conv_until(F, CONV_SEG0 + (unsigned)(L + 1) * CONV_PER_L); }
        SEAM(base + 7);
        if (PB(11) && IN(base + 9)) REP(11) {
            pg8::Gemm g{F.HN(), F.WGU() + (size_t)L * NE * 4096 * DM, NE * EROWS, NE * 4096, DM};        const int npm = (L == DEPTH - 1) ? 8 : 9; MoeOrder S{F.G, F.bid, 16, npm, NE * npm * 16};
            EpiSwiglu E{F.HH()};
            pg8::gemm_phase_ga<EpiSwiglu, MoeOrder>(F.lds, g, S, E, F.ROWIDX(), NROW, (LAS int*)(F.lds + ISLOT_OFF));
        }
        SEAM(base + 9);
        if (PB(12) && IN(base + 10)) REP(12) {
            pg8::Gemm g{F.HH(), F.WD() + (size_t)L * NE * DM * FF, NE * EROWS, NE * DM, FF}; const int npm = (L == DEPTH - 1) ? 8 : 9; MoeOrder S{F.G, F.bid, 4, npm, NE * npm * 4};
            pg8::EpiBf16<0> E{F.Y(), DM, nullptr, DM, 0, 1.f};
            pg8::gemm_phase<pg8::EpiBf16<0>, MoeOrder, true, true>(F.lds, g, S, E);
            if (L < DEPTH - 1 && F.bid >= 64) { FRESH(); conv_n(F, N_CV_DOWN); }
        }
        SEAM(base + 10);
        if (PB(13) && IN(base + 11)) REP(13) { FRESH(); ph_combine(F, L); }
        SEAM(base + 11);
    }
#undef IN
#undef SEAM
}

extern "C" void kernel_launch(void* const* d_in, const int* in_sizes, int n_in, void* d_out, int out_size, void* d_ws, size_t ws_size, hipStream_t stream) {
    static int grid = 0;
    if (grid == 0) {
        if (n_in != 25 || in_sizes[0] != NLAT * DM || out_size != NLAT * DM || ws_size < WS_END) {
            fprintf(stderr, "kernel_launch: built for 25 inputs, x/out of %d floats, >= %zu bytes of workspace; got n_in %d, in0 %d, out %d, ws %zu; nothing launched\n", NLAT * DM, (size_t)WS_END, n_in, n_in > 0 ? in_sizes[0] : -1, out_size, ws_size);
            grid = -1; return; }
        int dev = 0, cus = 0, per_cu = 0;
        if (hipGetDevice(&dev) != hipSuccess || hipDeviceGetAttribute(&cus, hipDeviceAttributeMultiprocessorCount, dev) != hipSuccess) { fprintf(stderr, "kernel_launch: device query failed\n"); grid = -1; return; }
        if (hipFuncSetAttribute((const void*)fwd, hipFuncAttributeMaxDynamicSharedMemorySize, LDS_BYTES) != hipSuccess) { fprintf(stderr, "kernel_launch: hipFuncSetAttribute failed\n"); grid = -1; return; }
        if (hipOccupancyMaxActiveBlocksPerMultiprocessor(&per_cu, (const void*)fwd, NTHR, LDS_BYTES) != hipSuccess || per_cu < 1)
            fprintf(stderr, "kernel_launch: note: occupancy query reports %d workgroups per CU\n", per_cu);
        (void)hipGetLastError();
        grid = cus;
    }
    if (grid < 0) return;
    if (hipMemsetAsync((char*)d_ws + WS_CTL, 0, CTL_ZERO_BYTES, stream) != hipSuccess) { fprintf(stderr, "kernel_launch: memset failed\n"); return; }
    Args a{};
    for (int i = 0; i < 25; ++i) a.in[i] = (const float*)d_in[i];
    a.out = (float*)d_out; a.ws = (unsigned char*)d_ws;
#if MK_ONE_LAUNCH
    a.gp_lo = 0; a.gp_hi = NPHASE;
    hipLaunchKernelGGL(fwd, dim3(grid), dim3(NTHR), LDS_BYTES, stream, a);
#else
    for (int gp = 0; gp < NPHASE; ++gp) { a.gp_lo = gp; a.gp_hi = gp + 1; hipLaunchKernelGGL(fwd, dim3(grid), dim3(NTHR), LDS_BYTES, stream, a); }
#endif
    const hipError_t le = hipPeekAtLastError();
    if (le != hipSuccess) fprintf(stderr, "kernel_launch: launch failed: %s\n", hipGetErrorName(le));
}
```

```cpp
#include <hip/hip_runtime.h>
#include <cstdio>
#include <cstdint>
#ifndef MK_ONE_LAUNCH
#define MK_ONE_LAUNCH 1
#endif
namespace pg8 {
#define PG8_LAS __attribute__((address_space(3)))
typedef unsigned short bf16_t;
typedef short bf16x8 __attribute__((ext_vector_type(8)));
typedef float f32x4 __attribute__((ext_vector_type(4)));
typedef unsigned u32x4 __attribute__((ext_vector_type(4)));
constexpr int BM = 256, BK = 64, HALF = 128, HTB = HALF * BK * 2  , STAGE_BYTES = 8 * HTB, NXCD = 8, WGM = 8;

__host__ __device__ __forceinline__ int lds_byte(int r, int c) { const int st = (r >> 4) * 2 + (c >> 5), rr = r & 15, cc = c & 31, ob = rr * 64 + cc * 2; return st * 1024 + (ob ^ (((ob >> 9) & 1) << 5)); }
__host__ __device__ __forceinline__ void stage_rc(int b, int& R, int& C) { const int st = b / 1024, sb = b % 1024, swz = sb ^ (((sb >> 9) & 1) << 5); R = (st >> 1) * 16 + swz / 64; C = (st & 1) * 32 + (swz % 64) / 2; }
__host__ __device__ __forceinline__ int perm32(int rho) { const int n = rho >> 4, i = rho & 15; return 8 * (i >> 2) + 4 * n + (i & 3); }

struct Unit { int pm, pn; };
struct Gemm { const bf16_t* A; const bf16_t* Bt; int M, N, K; };

struct StaticOrder {
    int nM, nN, nwg, G, c;
    __host__ __device__ void init(int M, int N, int G_, int c_) { nM = M / BM; nN = N / BM; nwg = nM * nN; G = G_; c = c_; }
    __host__ __device__ bool next(int i, Unit& u) const {
        const long L = (long)i * G + c; if (L >= nwg) return false;
        int wgid = (int)L; { const int q = nwg / NXCD, r = nwg % NXCD, xcd = wgid % NXCD, off = wgid / NXCD; wgid = (xcd < r ? xcd * (q + 1) : r * (q + 1) + (xcd - r) * q) + off; }
        const int nig = WGM * nN, gid = wgid / nig, fm = gid * WGM, gsz = (nM - fm) < WGM ? (nM - fm) : WGM;
        u.pm = fm + ((wgid % nig) % gsz); u.pn = (wgid % nig) / gsz; return true;
    }
    __device__ __forceinline__ void a_ready(const Unit&) const {}
    __device__ __forceinline__ void done(const Unit&) const {}
    __device__ __forceinline__ bool half_only(const Unit&) const { return false; }
};

__device__ __forceinline__ unsigned cvt_pk_bf16(float lo, float hi) { unsigned r; asm volatile("v_cvt_pk_bf16_f32 %0, %1, %2" : "=v"(r) : "v"(lo), "v"(hi)); return r; }
typedef float f32x2 __attribute__((ext_vector_type(2)));
__device__ __forceinline__ f32x2 gelu_pk(f32x2 v) {
    const f32x2 av = __builtin_elementwise_abs(v), d = av * 0.2316418882f + 1.0f;
    f32x2 t; t.x = __builtin_amdgcn_rcpf(d.x); t.y = __builtin_amdgcn_rcpf(d.y);
    f32x2 q = t * 0.5307027145f + (-0.7265760135f); q = q * t + 0.7107068705f; q = q * t + (-0.142248368f); q = q * t + 0.127414796f; q = q * t;
    const f32x2 s = (v * v) * (-0.72134752044f);
    f32x2 e; e.x = __builtin_amdgcn_exp2f(s.x); e.y = __builtin_amdgcn_exp2f(s.y);
    const f32x2 m = v * (q * e), r = v - m;
    f32x2 o; o.x = v.x < 0.f ? m.x : r.x; o.y = v.y < 0.f ? m.y : r.y; return o;
}

template <int ACT  > struct EpiBf16 {
    static constexpr bool PERM = true, AFTER_DRAIN = false; static_assert(ACT == 0 || ACT == 1, "EpiBf16: ACT is 0 (none) or 1 (gelu_pk)");
    bf16_t* O; int ldc; const float* bias; int split_cols; size_t split_stride; float scale0;
    __device__ __forceinline__ void operator()(const f32x4 (&acc)[2][2][4][2], const Unit& u, int wr, int wc, int fr, int fq) const {
        const int row0 = u.pm * BM + wr * 64 + fr; int colt = u.pn * BM; bf16_t* base = O;
        float sc = 1.f; if (split_cols) { const int t = colt / split_cols; base += (size_t)t * split_stride; colt -= t * split_cols; if (t == 0) sc = scale0; }
        const int col0 = colt + wc * 32 + 8 * fq, bcol0 = u.pn * BM + wc * 32 + 8 * fq;
        f32x4 bv[2][2];
#pragma unroll
        for (int bj = 0; bj < 2; ++bj)
#pragma unroll
            for (int n = 0; n < 2; ++n) bv[bj][n] = bias ? *(const f32x4*)(bias + bcol0 + bj * HALF + 4 * n) : (f32x4){0.f, 0.f, 0.f, 0.f};
#pragma unroll
        for (int ai = 0; ai < 2; ++ai)
#pragma unroll
            for (int m = 0; m < 4; ++m) { bf16_t* rowp = base + (size_t)(row0 + ai * HALF + m * 16) * ldc + col0;
#pragma unroll
                for (int bj = 0; bj < 2; ++bj) { f32x4 v0 = acc[ai][bj][m][0] + bv[bj][0], v1 = acc[ai][bj][m][1] + bv[bj][1];
                    if (ACT == 1) { f32x2 a = gelu_pk((f32x2){v0[0], v0[1]}), b = gelu_pk((f32x2){v0[2], v0[3]}), c = gelu_pk((f32x2){v1[0], v1[1]}), d = gelu_pk((f32x2){v1[2], v1[3]});
                        v0 = (f32x4){a.x, a.y, b.x, b.y}; v1 = (f32x4){c.x, c.y, d.x, d.y}; }
                    v0 = v0 * sc; v1 = v1 * sc; u32x4 w; w.x = cvt_pk_bf16(v0[0], v0[1]); w.y = cvt_pk_bf16(v0[2], v0[3]); w.z = cvt_pk_bf16(v1[0], v1[1]); w.w = cvt_pk_bf16(v1[2], v1[3]);
                    *(u32x4*)(rowp + bj * HALF) = w; } }
    }
};
template <class Epi, class Sched, bool ALIGN_EPI = false, bool SP2 = false>
__device__ __forceinline__ void gemm_phase(PG8_LAS unsigned char* lds, const Gemm g, const Sched& S, const Epi& E) {
    int tid = threadIdx.x; asm volatile("" : "+v"(tid));
    const int wid = __builtin_amdgcn_readfirstlane(tid >> 6), lane = tid & 63, wr = wid >> 2, wc = wid & 3, fr = lane & 15, fq = lane >> 4;
    const int K = g.K, nt = K / BK;
    unsigned voffA[2], voffB[2];
#pragma unroll
    for (int i = 0; i < 2; ++i) { int R, C; stage_rc(tid * 16 + i * 8192, R, C); const int Rb = Epi::PERM ? ((R & ~31) + perm32(R & 31)) : R;
        voffA[i] = (unsigned)(R * K + C) * 2u; voffB[i] = (unsigned)(Rb * K + C) * 2u; }
    const size_t kstep = (size_t)(BK * 2);
    const size_t hstep = (size_t)HALF * K * 2;
    const size_t tstep = 2 * hstep;
    const unsigned ldsw = (unsigned)wid * 1024u;
    const int aoff = lds_byte(wr * 64 + fr, fq * 8), boff = lds_byte(wc * 32 + fr, fq * 8);
#define PG8_SA(b, h) (((b) * 2 + (h)) * HTB)
#define PG8_SB(b, h) ((4 + (b) * 2 + (h)) * HTB)
#define PG8_STAGE(bufoff, gbase, voff) do { _Pragma("unroll") for (int _i = 0; _i < 2; ++_i) \
        __builtin_amdgcn_global_load_lds((const unsigned*)((const char*)(gbase) + (voff)[_i]), (PG8_LAS unsigned*)(lds + (bufoff) + ldsw + _i * 8192), 16, 0, 0); } while (0)
#define PG8_LDA(dst, b, h) do { _Pragma("unroll") for (int m = 0; m < 4; ++m) _Pragma("unroll") for (int k = 0; k < 2; ++k) dst[m][k] = *(const PG8_LAS bf16x8*)(lds + PG8_SA(b, h) + aoff + m * 2048 + k * 1024); } while (0)
#define PG8_LDB(dst, b, h) do { _Pragma("unroll") for (int n = 0; n < 2; ++n) _Pragma("unroll") for (int k = 0; k < 2; ++k) dst[n][k] = *(const PG8_LAS bf16x8*)(lds + PG8_SB(b, h) + boff + n * 2048 + k * 1024); } while (0)
#define PG8_MMA(ai, bj, At, Bt) do { __builtin_amdgcn_s_setprio(1); _Pragma("unroll") for (int m = 0; m < 4; ++m) _Pragma("unroll") for (int n = 0; n < 2; ++n) _Pragma("unroll") for (int k = 0; k < 2; ++k) \
        acc[ai][bj][m][n] = __builtin_amdgcn_mfma_f32_16x16x32_bf16(Bt[n][k], At[m][k], acc[ai][bj][m][n], 0, 0, 0); __builtin_amdgcn_s_setprio(0); } while (0)
#define PG8_WAIT_V(n) asm volatile("s_waitcnt vmcnt(" #n ")" ::: "memory")
#define PG8_WAIT_L(n) asm volatile("s_waitcnt lgkmcnt(" #n ")" ::: "memory")
#define PG8_BAR __builtin_amdgcn_s_barrier()
#define PG8_SCHED __builtin_amdgcn_sched_barrier(0)
    Unit cur, nxt; int ui = 0;
    if (!S.next(0, cur)) return;
    f32x4 acc[2][2][4][2];
#pragma unroll
    for (int a = 0; a < 2; ++a)
#pragma unroll
        for (int b = 0; b < 2; ++b)
#pragma unroll
            for (int m = 0; m < 4; ++m)
#pragma unroll
                for (int n = 0; n < 2; ++n) acc[a][b][m][n] = (f32x4){0.f, 0.f, 0.f, 0.f};
    bf16x8 At[4][2], B0[2][2], B1[2][2];
    const char* cA = (const char*)g.A + (size_t)cur.pm * tstep; const char* cB = (const char*)g.Bt + (size_t)cur.pn * tstep;
    S.a_ready(cur);
    if constexpr (SP2) {
        PG8_STAGE(PG8_SB(0, 0), cB, voffB); PG8_STAGE(PG8_SB(0, 1), cB + hstep, voffB); PG8_STAGE(PG8_SA(0, 0), cA, voffA); PG8_STAGE(PG8_SA(0, 1), cA + hstep, voffA);
        if (wr == 1) PG8_BAR;
        PG8_WAIT_V(2); PG8_BAR;
        PG8_STAGE(PG8_SB(1, 0), cB + kstep, voffB); PG8_STAGE(PG8_SA(1, 0), cA + kstep, voffA); PG8_STAGE(PG8_SB(1, 1), cB + hstep + kstep, voffB);
        PG8_WAIT_V(6); PG8_BAR;
    } else {
        PG8_STAGE(PG8_SB(0, 0), cB, voffB); PG8_STAGE(PG8_SA(0, 0), cA, voffA); PG8_STAGE(PG8_SB(0, 1), cB + hstep, voffB); PG8_STAGE(PG8_SA(0, 1), cA + hstep, voffA);
        if (wr == 1) PG8_BAR;
        PG8_WAIT_V(4); PG8_BAR;
        PG8_STAGE(PG8_SB(1, 0), cB + kstep, voffB); PG8_STAGE(PG8_SA(1, 0), cA + kstep, voffA); PG8_STAGE(PG8_SB(1, 1), cB + hstep + kstep, voffB);
        PG8_WAIT_V(6); PG8_BAR;
    }
    for (;;) {
        const bool has_next = S.next(ui + 1, nxt);
        const bool ho = S.half_only(cur);
        const char* nA = has_next ? (const char*)g.A + (size_t)nxt.pm * tstep : cA; const char* nB = has_next ? (const char*)g.Bt + (size_t)nxt.pn * tstep : cB;
        for (int t = 0; t < nt; t += 2) {
            const bool last = (t == nt - 2);
            const char* a1 = cA + (size_t)(t + 1) * kstep;
            const char* a2 = last ? nA : cA + (size_t)(t + 2) * kstep; const char* b2 = last ? nB : cB + (size_t)(t + 2) * kstep;
            const char* a3 = a2 + kstep; const char* b3 = b2 + kstep;
            if (last && has_next) S.a_ready(nxt);
            if constexpr (SP2) {
            PG8_LDB(B0, 0, 0); PG8_LDB(B1, 0, 1); PG8_SCHED; PG8_LDA(At, 0, 0); PG8_STAGE(PG8_SA(1, 1), a1 + hstep, voffA);
            PG8_WAIT_V(8); PG8_WAIT_L(0); PG8_BAR; PG8_MMA(0, 0, At, B0); PG8_MMA(0, 1, At, B1); PG8_BAR; PG8_SCHED;
            PG8_LDA(At, 0, 1); PG8_STAGE(PG8_SB(0, 0), b2, voffB); PG8_STAGE(PG8_SB(0, 1), b2 + hstep, voffB); PG8_STAGE(PG8_SA(0, 0), a2, voffA);
            PG8_WAIT_V(8); PG8_WAIT_L(0); PG8_BAR; if (!ho) { PG8_MMA(1, 0, At, B0); PG8_MMA(1, 1, At, B1); } PG8_BAR; PG8_SCHED;
            PG8_LDB(B0, 1, 0); PG8_LDB(B1, 1, 1); PG8_SCHED; PG8_LDA(At, 1, 0); PG8_STAGE(PG8_SA(0, 1), a2 + hstep, voffA);
            PG8_WAIT_V(8); PG8_WAIT_L(0); PG8_BAR; PG8_MMA(0, 0, At, B0); PG8_MMA(0, 1, At, B1); PG8_BAR; PG8_SCHED;
            PG8_LDA(At, 1, 1); PG8_STAGE(PG8_SB(1, 0), b3, voffB); PG8_STAGE(PG8_SB(1, 1), b3 + hstep, voffB); PG8_STAGE(PG8_SA(1, 0), a3, voffA);
            PG8_WAIT_V(8); PG8_WAIT_L(0); PG8_BAR; if (!ho) { PG8_MMA(1, 0, At, B0); PG8_MMA(1, 1, At, B1); } PG8_BAR; PG8_SCHED;
            } else {
            PG8_LDB(B0, 0, 0); PG8_SCHED; PG8_LDA(At, 0, 0); PG8_STAGE(PG8_SA(1, 1), a1 + hstep, voffA);
            PG8_WAIT_L(8); PG8_BAR; PG8_WAIT_L(0); PG8_MMA(0, 0, At, B0); PG8_BAR; PG8_SCHED;
            PG8_LDB(B1, 0, 1); PG8_STAGE(PG8_SB(0, 0), b2, voffB);
            PG8_BAR; PG8_WAIT_L(0); PG8_MMA(0, 1, At, B1); PG8_BAR;
            PG8_LDA(At, 0, 1); PG8_STAGE(PG8_SA(0, 0), a2, voffA);
            PG8_BAR; PG8_WAIT_L(0); PG8_MMA(1, 0, At, B0); PG8_BAR; PG8_SCHED;
            PG8_STAGE(PG8_SB(0, 1), b2 + hstep, voffB);
            PG8_WAIT_V(6); PG8_BAR; PG8_MMA(1, 1, At, B1); PG8_BAR;
            PG8_LDB(B0, 1, 0); PG8_SCHED; PG8_LDA(At, 1, 0); PG8_STAGE(PG8_SA(0, 1), a2 + hstep, voffA);
            PG8_WAIT_L(8); PG8_BAR; PG8_WAIT_L(0); PG8_MMA(0, 0, At, B0); PG8_BAR; PG8_SCHED;
            PG8_LDB(B1, 1, 1); PG8_STAGE(PG8_SB(1, 0), b3, voffB);
            PG8_BAR; PG8_WAIT_L(0); PG8_MMA(0, 1, At, B1); PG8_BAR;
            PG8_LDA(At, 1, 1); PG8_STAGE(PG8_SA(1, 0), a3, voffA);
            PG8_BAR; PG8_WAIT_L(0); PG8_MMA(1, 0, At, B0); PG8_BAR; PG8_SCHED;
            PG8_STAGE(PG8_SB(1, 1), b3 + hstep, voffB);
            PG8_WAIT_V(6); PG8_BAR; PG8_MMA(1, 1, At, B1); PG8_BAR;
            }
        }
        if constexpr (ALIGN_EPI) { if (wr == 0) PG8_BAR; }
        if constexpr (!Epi::AFTER_DRAIN) { E(acc, cur, wr, wc, fr, fq); S.done(cur); }
        if (!has_next) break;
#pragma unroll
        for (int a = 0; a < 2; ++a)
#pragma unroll
            for (int b = 0; b < 2; ++b)
#pragma unroll
                for (int m = 0; m < 4; ++m)
#pragma unroll
                    for (int n = 0; n < 2; ++n) acc[a][b][m][n] = (f32x4){0.f, 0.f, 0.f, 0.f};
        cur = nxt; cA = nA; cB = nB; ++ui;
        if constexpr (ALIGN_EPI) { if (wr == 1) PG8_BAR; }
    }
    PG8_WAIT_V(0);
    if constexpr (!ALIGN_EPI) { if (wr == 0) PG8_BAR; }
    PG8_BAR;
    if constexpr (Epi::AFTER_DRAIN) { E.fused(acc, cur, wr, wc, fr, fq, lds, wid, lane); S.done(cur); }
#undef PG8_SA
#undef PG8_SB
#undef PG8_STAGE
#undef PG8_LDA
#undef PG8_LDB
#undef PG8_MMA
#undef PG8_WAIT_V
#undef PG8_WAIT_L
#undef PG8_BAR
#undef PG8_SCHED
}
}
namespace pg8 {
template <class Epi, class Sched>
__device__ __forceinline__ void gemm_phase_ga(PG8_LAS unsigned char* lds, const Gemm g, const Sched& S, const Epi& E, const int* rowidx, int zrow, PG8_LAS int* islot) {
    constexpr bool ALIGN_EPI = true;
    int tid = threadIdx.x; asm volatile("" : "+v"(tid));
    const int wid = __builtin_amdgcn_readfirstlane(tid >> 6), lane = tid & 63, wr = wid >> 2, wc = wid & 3, fr = lane & 15, fq = lane >> 4;
    const int K = g.K, nt = K / BK;
    unsigned voffB[2]; int RA[2], CA[2];
#pragma unroll
    for (int i = 0; i < 2; ++i) { int R, C; stage_rc(tid * 16 + i * 8192, R, C); const int Rb = Epi::PERM ? ((R & ~31) + perm32(R & 31)) : R;
        RA[i] = R; CA[i] = C; voffB[i] = (unsigned)(Rb * K + C) * 2u; }
    unsigned voC[2][2], voN[2][2];
    const size_t kstep = (size_t)(BK * 2);
    const size_t hstep = (size_t)HALF * K * 2;
    const size_t tstep = 2 * hstep;
    const unsigned ldsw = (unsigned)wid * 1024u;
    const int aoff = lds_byte(wr * 64 + fr, fq * 8), boff = lds_byte(wc * 32 + fr, fq * 8);
#define PG8_SA(b, h) (((b) * 2 + (h)) * HTB)
#define PG8_SB(b, h) ((4 + (b) * 2 + (h)) * HTB)
#define PG8_STAGE(bufoff, gbase, voff) do { _Pragma("unroll") for (int _i = 0; _i < 2; ++_i) \
        __builtin_amdgcn_global_load_lds((const unsigned*)((const char*)(gbase) + (voff)[_i]), (PG8_LAS unsigned*)(lds + (bufoff) + ldsw + _i * 8192), 16, 0, 0); } while (0)
#define PG8_LDA(dst, b, h) do { _Pragma("unroll") for (int m = 0; m < 4; ++m) _Pragma("unroll") for (int k = 0; k < 2; ++k) dst[m][k] = *(const PG8_LAS bf16x8*)(lds + PG8_SA(b, h) + aoff + m * 2048 + k * 1024); } while (0)
#define PG8_LDB(dst, b, h) do { _Pragma("unroll") for (int n = 0; n < 2; ++n) _Pragma("unroll") for (int k = 0; k < 2; ++k) dst[n][k] = *(const PG8_LAS bf16x8*)(lds + PG8_SB(b, h) + boff + n * 2048 + k * 1024); } while (0)
#define PG8_MMA(ai, bj, At, Bt) do { __builtin_amdgcn_s_setprio(1); _Pragma("unroll") for (int m = 0; m < 4; ++m) _Pragma("unroll") for (int n = 0; n < 2; ++n) _Pragma("unroll") for (int k = 0; k < 2; ++k) \
        acc[ai][bj][m][n] = __builtin_amdgcn_mfma_f32_16x16x32_bf16(Bt[n][k], At[m][k], acc[ai][bj][m][n], 0, 0, 0); __builtin_amdgcn_s_setprio(0); } while (0)
#define PG8_WAIT_V(n) asm volatile("s_waitcnt vmcnt(" #n ")" ::: "memory")
#define PG8_WAIT_L(n) asm volatile("s_waitcnt lgkmcnt(" #n ")" ::: "memory")
#define PG8_BAR __builtin_amdgcn_s_barrier()
#define PG8_SCHED __builtin_amdgcn_sched_barrier(0)
    constexpr bool SP2 = true;
    Unit cur, nxt; int ui = 0;
    if (!S.next(0, cur)) return;
    f32x4 acc[2][2][4][2];
#pragma unroll
    for (int a = 0; a < 2; ++a)
#pragma unroll
        for (int b = 0; b < 2; ++b)
#pragma unroll
            for (int m = 0; m < 4; ++m)
#pragma unroll
                for (int n = 0; n < 2; ++n) acc[a][b][m][n] = (f32x4){0.f, 0.f, 0.f, 0.f};
    bf16x8 At[4][2], B0[2][2], B1[2][2];
    const char* const Ab = (const char*)g.A; const char* cB = (const char*)g.Bt + (size_t)cur.pn * tstep;
    S.a_ready(cur);
#pragma unroll
    for (int h = 0; h < 2; ++h)
#pragma unroll
        for (int i = 0; i < 2; ++i) { const int s = rowidx[cur.pm * BM + h * HALF + RA[i]]; voC[h][i] = (unsigned)((s < 0 ? zrow : s) * K + CA[i]) * 2u; voN[h][i] = voC[h][i]; }
    asm volatile("s_waitcnt vmcnt(0)" ::: "memory");
    if constexpr (SP2) {
        PG8_STAGE(PG8_SB(0, 0), cB, voffB); PG8_STAGE(PG8_SB(0, 1), cB + hstep, voffB); PG8_STAGE(PG8_SA(0, 0), Ab, voC[0]); PG8_STAGE(PG8_SA(0, 1), Ab, voC[1]);
        if (wr == 1) PG8_BAR;
        PG8_WAIT_V(2); PG8_BAR;
        PG8_STAGE(PG8_SB(1, 0), cB + kstep, voffB); PG8_STAGE(PG8_SA(1, 0), Ab + kstep, voC[0]); PG8_STAGE(PG8_SB(1, 1), cB + hstep + kstep, voffB);
        PG8_WAIT_V(6); PG8_BAR;
    }
    for (;;) {
        const bool has_next = S.next(ui + 1, nxt);
        const bool ho = S.half_only(cur);
        const char* nB = has_next ? (const char*)g.Bt + (size_t)nxt.pn * tstep : cB;
        if (has_next && wid == 0) __builtin_amdgcn_global_load_lds((const unsigned*)(rowidx + nxt.pm * BM + lane * 4), (PG8_LAS unsigned*)(islot + ((ui + 1) & 1) * BM), 16, 0, 0);
        for (int t = 0; t < nt; t += 2) {
            const bool last = (t == nt - 2);
            const char* a1 = Ab + (size_t)(t + 1) * kstep;
            const char* a2 = last ? Ab : Ab + (size_t)(t + 2) * kstep; const char* b2 = last ? nB : cB + (size_t)(t + 2) * kstep;
            const char* a3 = a2 + kstep; const char* b3 = b2 + kstep;
            if (last && has_next) { S.a_ready(nxt);
                const PG8_LAS int* sl = islot + ((ui + 1) & 1) * BM;
#pragma unroll
                for (int h = 0; h < 2; ++h)
#pragma unroll
                    for (int i = 0; i < 2; ++i) { const int s = sl[h * HALF + RA[i]]; voN[h][i] = (unsigned)((s < 0 ? zrow : s) * K + CA[i]) * 2u; } }
            unsigned vo2[2][2];
#pragma unroll
            for (int h = 0; h < 2; ++h)
#pragma unroll
                for (int i = 0; i < 2; ++i) vo2[h][i] = last ? voN[h][i] : voC[h][i];
            if constexpr (SP2) {
            PG8_LDB(B0, 0, 0); PG8_LDB(B1, 0, 1); PG8_SCHED; PG8_LDA(At, 0, 0); PG8_STAGE(PG8_SA(1, 1), a1, voC[1]);
            PG8_WAIT_V(8); PG8_WAIT_L(0); PG8_BAR; PG8_MMA(0, 0, At, B0); PG8_MMA(0, 1, At, B1); PG8_BAR; PG8_SCHED;
            PG8_LDA(At, 0, 1); PG8_STAGE(PG8_SB(0, 0), b2, voffB); PG8_STAGE(PG8_SB(0, 1), b2 + hstep, voffB); PG8_STAGE(PG8_SA(0, 0), a2, vo2[0]);
            PG8_WAIT_V(8); PG8_WAIT_L(0); PG8_BAR; if (!ho) { PG8_MMA(1, 0, At, B0); PG8_MMA(1, 1, At, B1); } PG8_BAR; PG8_SCHED;
            PG8_LDB(B0, 1, 0); PG8_LDB(B1, 1, 1); PG8_SCHED; PG8_LDA(At, 1, 0); PG8_STAGE(PG8_SA(0, 1), a2, vo2[1]);
            PG8_WAIT_V(8); PG8_WAIT_L(0); PG8_BAR; PG8_MMA(0, 0, At, B0); PG8_MMA(0, 1, At, B1); PG8_BAR; PG8_SCHED;
            PG8_LDA(At, 1, 1); PG8_STAGE(PG8_SB(1, 0), b3, voffB); PG8_STAGE(PG8_SB(1, 1), b3 + hstep, voffB); PG8_STAGE(PG8_SA(1, 0), a3, vo2[0]);
            PG8_WAIT_V(8); PG8_WAIT_L(0); PG8_BAR; if (!ho) { PG8_MMA(1, 0, At, B0); PG8_MMA(1, 1, At, B1); } PG8_BAR; PG8_SCHED;
            }
        }
        if constexpr (ALIGN_EPI) { if (wr == 0) PG8_BAR; }
        if constexpr (!Epi::AFTER_DRAIN) { E(acc, cur, wr, wc, fr, fq); S.done(cur); }
        if (!has_next) break;
#pragma unroll
        for (int a = 0; a < 2; ++a)
#pragma unroll
            for (int b = 0; b < 2; ++b)
#pragma unroll
                for (int m = 0; m < 4; ++m)
#pragma unroll
                    for (int n = 0; n < 2; ++n) acc[a][b][m][n] = (f32x4){0.f, 0.f, 0.f, 0.f};
        cur = nxt; cB = nB; ++ui;
#pragma unroll
        for (int h = 0; h < 2; ++h)
#pragma unroll
            for (int i = 0; i < 2; ++i) voC[h][i] = voN[h][i];
        if constexpr (ALIGN_EPI) { if (wr == 1) PG8_BAR; }
    }
    PG8_WAIT_V(0);
    if constexpr (!ALIGN_EPI) { if (wr == 0) PG8_BAR; }
    PG8_BAR;
    if constexpr (Epi::AFTER_DRAIN) { E.fused(acc, cur, wr, wc, fr, fq, lds, wid, lane); S.done(cur); }
#undef PG8_SA
#undef PG8_SB
#undef PG8_STAGE
#undef PG8_LDA
#undef PG8_LDB
#undef PG8_MMA
#undef PG8_WAIT_V
#undef PG8_WAIT_L
#undef PG8_BAR
#undef PG8_SCHED
}
}

constexpr int DM = 1024, NB = 2, SEQ = 8192, CTXL = 256, DEPTH = 4;
constexpr int NLAT = NB * SEQ, NCTX = NB * CTXL, NROW = NLAT + NCTX;
constexpr int INC = 3328, NKEY = CTXL + SEQ;
constexpr int NE = 16, FF = 2048, EROWS = 2304;
constexpr int NCH = 66;
constexpr float EPS = 1e-6f;
constexpr int ZQ = 0, ZK = 512, ZV = 1024, ZRQ = 1536, ZRK = 1792, ZRV = 2048, ZGF = 2304, ZGB = 2560, ZSU = 2816, ZSV = 3072;
constexpr int NWAVES = 8, NTHR = 512;
constexpr int RWLD = DM + 8;

constexpr size_t MiB = 1u << 20;
constexpr size_t WS_CTL = 0, CTL_ZERO_BYTES = 1 * MiB;
constexpr size_t WS_MOD = 1 * MiB;
constexpr size_t WS_LP = WS_MOD + 512 * 1024;
constexpr size_t WS_ROPE = 2 * MiB, WS_RETT = 4 * MiB;
constexpr size_t WS_SGW = 6 * MiB;
constexpr size_t WS_RWS = 7 * MiB;
constexpr size_t WS_WIN = 8 * MiB;
constexpr size_t WS_WOUT = WS_WIN + 26 * MiB;
constexpr size_t WS_WGU = WS_WOUT + 8 * MiB;
constexpr size_t WS_WD = WS_WGU + 512 * MiB;
constexpr size_t WS_X = WS_WD + 256 * MiB;
constexpr size_t WS_HN = WS_X + 66 * MiB;
constexpr size_t WS_Z = WS_HN + 34 * MiB;
constexpr size_t WS_QH = WS_Z + 108 * MiB;
constexpr size_t WS_KH = WS_QH + 17 * MiB;
constexpr size_t WS_VH = WS_KH + 17 * MiB;
constexpr size_t WS_RQ = WS_VH + 17 * MiB;
constexpr size_t WS_RK = WS_RQ + 9 * MiB;
constexpr size_t WS_SVN = WS_RK + 9 * MiB;
constexpr size_t WS_KVT = WS_SVN + 9 * MiB;
constexpr size_t WS_SPREV = WS_KVT + 17 * MiB;
constexpr size_t WS_MIX = WS_SPREV + 17 * MiB;
constexpr size_t WS_SCR = WS_MIX + 33 * MiB;
constexpr size_t WS_AFF = WS_SCR + 32 * MiB;
constexpr size_t WS_SLOT = WS_AFF + 2 * MiB;
constexpr size_t WS_ROWIDX = WS_SLOT + 2 * MiB;
constexpr size_t WS_GATE = WS_ROWIDX + 1 * MiB;
constexpr size_t WS_XS = WS_GATE + 1 * MiB;
constexpr size_t WS_HH = WS_XS + 72 * MiB;
constexpr size_t WS_Y = WS_HH + 144 * MiB;
constexpr size_t WS_END = WS_Y + 72 * MiB;
static_assert((size_t)4 * INC * DM * 2 <= 26 * MiB && (size_t)NROW * DM * 4 <= 66 * MiB && (size_t)NROW * INC * 2 <= 108 * MiB && (size_t)NROW * 512 * 2 <= 17 * MiB, "ws map");
static_assert((size_t)NB * 4 * 2 * NCH * 4096 * 4 <= 17 * MiB && (size_t)NE * EROWS * DM * 2 <= 72 * MiB && (size_t)NE * EROWS * FF * 2 <= 144 * MiB, "ws map");
constexpr int CW_BAR = 4096;

constexpr int RING_BYTES = 131072;
constexpr int MISC_OFF = RING_BYTES + 320;
constexpr int ISLOT_OFF = RING_BYTES + 1024;
constexpr int LDS_BYTES = 147456;

#define GAS __attribute__((address_space(1)))
#define LAS __attribute__((address_space(3)))
typedef unsigned short bf16;
typedef unsigned v4u __attribute__((ext_vector_type(4)));
typedef float f32x4 __attribute__((ext_vector_type(4)));
typedef short bf16x8 __attribute__((ext_vector_type(8)));
typedef GAS unsigned gu32;
typedef GAS unsigned long long gu64;
#define RLX_AGENT __ATOMIC_RELAXED, __HIP_MEMORY_SCOPE_AGENT
#define LDS_WAIT() asm volatile("s_waitcnt lgkmcnt(0)" ::: "memory")
#define VM_WAIT() asm volatile("s_waitcnt vmcnt(0)" ::: "memory")
__device__ __forceinline__ unsigned long long rt() { return __builtin_amdgcn_s_memrealtime(); }
__device__ __forceinline__ unsigned f2bf(float f) { unsigned u = __builtin_bit_cast(unsigned, f); return (u + 0x7fffu + ((u >> 16) & 1u)) >> 16; }
__device__ __forceinline__ unsigned pk2(float lo, float hi) { return f2bf(lo) | (f2bf(hi) << 16); }

#define XB_TMO      128
#define XB_XCNT(j)  (256  + 64 * (j))
#define XB_XSUB(j)  (1280 + 64 * (j))
#define XB_XGEN(j)  (2304 + 64 * (j))
#define XB_TOP      3328
#define XB_TOPGEN   3392
#define XCD_BAR_WORDS 3456
#define XB_SPIN_CAP (1u << 18)

__device__ __forceinline__ unsigned xb_ld(unsigned* p)              { return __hip_atomic_load(p, __ATOMIC_RELAXED, __HIP_MEMORY_SCOPE_AGENT); }
__device__ __forceinline__ unsigned xb_add(unsigned* p, unsigned v) { return __hip_atomic_fetch_add(p, v, __ATOMIC_RELAXED, __HIP_MEMORY_SCOPE_AGENT); }
__device__ __forceinline__ unsigned xb_xcc_id() { return (unsigned)__builtin_amdgcn_s_getreg((3 << 11) | 20) & 0xFu; }
#define XB_SPIN(cond, bar) do { unsigned _sp = 0; while (cond) { __builtin_amdgcn_s_sleep(1); \
    if ((++_sp & 255u) == 0u) { if (xb_ld(&(bar)[XB_TMO])) break; if (_sp > XB_SPIN_CAP) { atomicAdd(&(bar)[XB_TMO], 1u); break; } } } } while (0)

struct XcdBarrier {
    unsigned* bar; unsigned x;
    volatile LAS unsigned* st;
};

__device__ __forceinline__ XcdBarrier xcd_barrier_post(unsigned* bar, volatile LAS unsigned* st) {
    XcdBarrier b; b.bar = bar; b.x = xb_xcc_id(); b.st = st;
    if (threadIdx.x == 0) (void)xb_add(&bar[XB_XCNT(b.x)], 1u);
    return b;
}
__device__ __forceinline__ void xcd_barrier_complete(unsigned* bar, unsigned x, unsigned& nloc, unsigned& nx) {
    const unsigned G = gridDim.x * gridDim.y * gridDim.z;
    unsigned sum, cnt, mine, sp = 0u;
    for (;;) {
        sum = 0u; cnt = 0u; mine = 0u;
#pragma unroll
        for (unsigned j = 0; j < 16; ++j) { const unsigned c = xb_ld(&bar[XB_XCNT(j)]); sum += c; cnt += (c > 0u) ? 1u : 0u; mine = (j == x) ? c : mine; }
        if (sum == G) break;
        __builtin_amdgcn_s_sleep(1);
        if ((++sp & 255u) == 0u) { if (xb_ld(&bar[XB_TMO])) break; if (sp > XB_SPIN_CAP) { atomicAdd(&bar[XB_TMO], 1u); break; } }
    }
    nloc = mine > 0u ? mine : 1u; nx = cnt > 0u ? cnt : 1u;
}

__device__ __forceinline__ void xcd_barrier(const XcdBarrier& b) {
    asm volatile("s_waitcnt vmcnt(0)" ::: "memory");
    __syncthreads();
    if (threadIdx.x == 0) {
        unsigned* bar = b.bar;
        __builtin_amdgcn_s_waitcnt(0);
        unsigned nloc = b.st[0], nx = b.st[1];
        if (nloc == 0u) { xcd_barrier_complete(bar, b.x, nloc, nx); b.st[0] = nloc; b.st[1] = nx; }
        const unsigned old = xb_add(&bar[XB_XSUB(b.x)], 1u);
        const unsigned gen = old / nloc;
        if (old + 1u == (gen + 1u) * nloc) {
            __builtin_amdgcn_fence(__ATOMIC_RELEASE, "agent");
            asm volatile("s_waitcnt vmcnt(0)" ::: "memory");
            const unsigned og = xb_add(&bar[XB_TOP], 1u);
            const unsigned tg = og / nx;
            if (og + 1u == (tg + 1u) * nx) xb_add(&bar[XB_TOPGEN], 1u);
            else XB_SPIN(xb_ld(&bar[XB_TOPGEN]) == tg, bar);
            __builtin_amdgcn_fence(__ATOMIC_ACQUIRE, "agent");
            xb_add(&bar[XB_XGEN(b.x)], 1u);
            asm volatile("s_waitcnt vmcnt(0)" ::: "memory");
        } else {
            XB_SPIN(xb_ld(&bar[XB_XGEN(b.x)]) == gen, bar);
            __builtin_amdgcn_fence(__ATOMIC_ACQUIRE, "agent");
            asm volatile("s_waitcnt vmcnt(0)" ::: "memory");
        }
    }
    __syncthreads();
}

typedef float f32x16 __attribute__((ext_vector_type(16)));
typedef short s16x4 __attribute__((ext_vector_type(4)));
typedef unsigned short u16x4 __attribute__((ext_vector_type(4)));
struct Frame {
    LAS unsigned char* lds;
    int tid, lane, wave, bid, G;
    const float* const* in;
    float* out;
    unsigned char* ws;
    __device__ __forceinline__ const float* x_in() const { return in[0]; }
    __device__ __forceinline__ const float* c_in() const { return in[1]; }
    __device__ __forceinline__ const float* ctx_in() const { return in[2]; }
    __device__ __forceinline__ const float* cctx_in() const { return in[3]; }
    __device__ __forceinline__ const float* w_mod() const { return in[4]; }
    __device__ __forceinline__ const float* b_mod() const { return in[5]; }
    __device__ __forceinline__ const float* n1g() const { return in[6]; }
    __device__ __forceinline__ const float* n2g() const { return in[7]; }
    __device__ __forceinline__ const float* w_in() const { return in[8]; }
    __device__ __forceinline__ const float* w_out() const { return in[9]; }
    __device__ __forceinline__ const float* qng() const { return in[10]; }
    __device__ __forceinline__ const float* kng() const { return in[11]; }
    __device__ __forceinline__ const float* lq1() const { return in[12]; }
    __device__ __forceinline__ const float* lk1() const { return in[13]; }
    __device__ __forceinline__ const float* lq2() const { return in[14]; }
    __device__ __forceinline__ const float* lk2() const { return in[15]; }
    __device__ __forceinline__ const float* subg() const { return in[16]; }
    __device__ __forceinline__ const float* retd() const { return in[17]; }
    __device__ __forceinline__ const float* sgng() const { return in[18]; }
    __device__ __forceinline__ const float* sgw() const { return in[19]; }
    __device__ __forceinline__ const float* sgb() const { return in[20]; }
    __device__ __forceinline__ const float* rw() const { return in[21]; }
    __device__ __forceinline__ const float* wg() const { return in[22]; }
    __device__ __forceinline__ const float* wu() const { return in[23]; }
    __device__ __forceinline__ const float* wd() const { return in[24]; }
    __device__ __forceinline__ float* MOD() const { return (float*)(ws + WS_MOD); }
    __device__ __forceinline__ float* LP() const { return (float*)(ws + WS_LP); }
    __device__ __forceinline__ float* ROPE() const { return (float*)(ws + WS_ROPE); }
    __device__ __forceinline__ float* RETT() const { return (float*)(ws + WS_RETT); }
    __device__ __forceinline__ bf16* X() const { return (bf16*)(ws + WS_X); }
    __device__ __forceinline__ float* KVT() const { return (float*)(ws + WS_KVT); }
    __device__ __forceinline__ bf16* SPREV() const { return (bf16*)(ws + WS_SPREV); }
    __device__ __forceinline__ float* SCR() const { return (float*)(ws + WS_SCR); }
    __device__ __forceinline__ float* AFF() const { return (float*)(ws + WS_AFF); }
    __device__ __forceinline__ float* GATE() const { return (float*)(ws + WS_GATE); }
    __device__ __forceinline__ bf16* SGW() const { return (bf16*)(ws + WS_SGW); }
    __device__ __forceinline__ bf16* WIN() const { return (bf16*)(ws + WS_WIN); }
    __device__ __forceinline__ bf16* WOUT() const { return (bf16*)(ws + WS_WOUT); }
    __device__ __forceinline__ bf16* WGU() const { return (bf16*)(ws + WS_WGU); }
    __device__ __forceinline__ bf16* WD() const { return (bf16*)(ws + WS_WD); }
    __device__ __forceinline__ bf16* HN() const { return (bf16*)(ws + WS_HN); }
    __device__ __forceinline__ bf16* Z() const { return (bf16*)(ws + WS_Z); }
    __device__ __forceinline__ bf16* QH() const { return (bf16*)(ws + WS_QH); }
    __device__ __forceinline__ bf16* KH() const { return (bf16*)(ws + WS_KH); }
    __device__ __forceinline__ bf16* VH() const { return (bf16*)(ws + WS_VH); }
    __device__ __forceinline__ bf16* RQ() const { return (bf16*)(ws + WS_RQ); }
    __device__ __forceinline__ bf16* RK() const { return (bf16*)(ws + WS_RK); }
    __device__ __forceinline__ bf16* SVN() const { return (bf16*)(ws + WS_SVN); }
    __device__ __forceinline__ bf16* MIX() const { return (bf16*)(ws + WS_MIX); }
    __device__ __forceinline__ bf16* XS() const { return (bf16*)(ws + WS_XS); }
    __device__ __forceinline__ bf16* HH() const { return (bf16*)(ws + WS_HH); }
    __device__ __forceinline__ bf16* Y() const { return (bf16*)(ws + WS_Y); }
    __device__ __forceinline__ bf16* RWS() const { return (bf16*)(ws + WS_RWS); }
    __device__ __forceinline__ int* SLOT() const { return (int*)(ws + WS_SLOT); }
    __device__ __forceinline__ int* ROWIDX() const { return (int*)(ws + WS_ROWIDX); }
};
__device__ __forceinline__ float bf2f(bf16 v) { return __builtin_bit_cast(float, (unsigned)v << 16); }
__device__ __forceinline__ float wave_sum(float v) {
#pragma unroll
    for (int o = 1; o < 64; o <<= 1) v += __shfl_xor(v, o);
    return v;
}
__device__ __forceinline__ float half_sum32(float v) {
#pragma unroll
    for (int o = 1; o < 32; o <<= 1) v += __shfl_xor(v, o);
    return v;
}
__device__ __forceinline__ float wave_max(float v) {
#pragma unroll
    for (int o = 1; o < 64; o <<= 1) v = fmaxf(v, __shfl_xor(v, o));
    return v;
}
__device__ __forceinline__ int crow(int r, int hi) { return (r & 3) + 8 * (r >> 2) + 4 * hi; }
__device__ __forceinline__ float gelu_t(float x) {
    const float u = 0.7978845608028654f * (x + 0.044715f * x * x * x);
    const float t = 1.f - 2.f * __builtin_amdgcn_rcpf(1.f + __expf(2.f * u));
    return 0.5f * x * (1.f + t);
}
__device__ __forceinline__ float silu_f(float x) { return x * __builtin_amdgcn_rcpf(1.f + __expf(-x)); }
__device__ __forceinline__ int row_vec(int r) { return r < SEQ ? 0 : (r < NLAT ? 1 : 2); }
__device__ __forceinline__ int chunk_row0(int b, int cc) { return cc < 2 ? NLAT + b * CTXL + cc * 128 : b * SEQ + (cc - 2) * 128; }

__device__ __forceinline__ f32x16 mma_nt(const LAS bf16* A, int lda, const LAS bf16* B, int ldb, int K, f32x16 acc, int lane) {
    const int r = lane & 31, h = lane >> 5;
#pragma unroll 2
    for (int k0 = 0; k0 < K; k0 += 16) {
        const bf16x8 a = *(const LAS bf16x8*)(A + r * lda + k0 + 8 * h);
        const bf16x8 b = *(const LAS bf16x8*)(B + r * ldb + k0 + 8 * h);
        acc = __builtin_amdgcn_mfma_f32_32x32x16_bf16(a, b, acc, 0, 0, 0);
    }
    return acc;
}

constexpr float QSCALE = 0.125f * 1.4426950408889634f;
struct EpiResid {
    static constexpr bool PERM = true, AFTER_DRAIN = false;
    bf16* X; const float* modg;
    const float* Xin;
    __device__ __forceinline__ void operator()(const pg8::f32x4 (&acc)[2][2][4][2], const pg8::Unit& u, int wr, int wc, int fr, int fq) const {
        const int row0 = u.pm * 256 + wr * 64 + fr, col0 = u.pn * 256 + wc * 32 + 8 * fq;
        const int v = u.pm < 32 ? 0 : (u.pm < 64 ? 1 : 2);
        pg8::f32x4 gv[2][2];
#pragma unroll
        for (int bj = 0; bj < 2; ++bj)
#pragma unroll
            for (int n = 0; n < 2; ++n) gv[bj][n] = *(const pg8::f32x4*)(modg + v * 6144 + col0 + bj * 128 + 4 * n);
        const bool in32 = Xin != nullptr;
#pragma unroll
        for (int ai = 0; ai < 2; ++ai)
#pragma unroll
            for (int m = 0; m < 4; ++m) { const size_t off = (size_t)(row0 + ai * 128 + m * 16) * DM + col0;
#pragma unroll
                for (int bj = 0; bj < 2; ++bj) {
                    pg8::f32x4 x0, x1;
                    if (in32) { x0 = *(const pg8::f32x4*)(Xin + off + bj * 128); x1 = *(const pg8::f32x4*)(Xin + off + bj * 128 + 4); }
                    else { const pg8::u32x4 w = *(const pg8::u32x4*)(X + off + bj * 128);
                        x0 = (pg8::f32x4){__builtin_bit_cast(float, w.x << 16), __builtin_bit_cast(float, w.x & 0xffff0000u), __builtin_bit_cast(float, w.y << 16), __builtin_bit_cast(float, w.y & 0xffff0000u)};
                        x1 = (pg8::f32x4){__builtin_bit_cast(float, w.z << 16), __builtin_bit_cast(float, w.z & 0xffff0000u), __builtin_bit_cast(float, w.w << 16), __builtin_bit_cast(float, w.w & 0xffff0000u)}; }
                    x0 = x0 + gv[bj][0] * acc[ai][bj][m][0]; x1 = x1 + gv[bj][1] * acc[ai][bj][m][1];
                    pg8::u32x4 o; o.x = pg8::cvt_pk_bf16(x0.x, x0.y); o.y = pg8::cvt_pk_bf16(x0.z, x0.w); o.z = pg8::cvt_pk_bf16(x1.x, x1.y); o.w = pg8::cvt_pk_bf16(x1.z, x1.w);
                    *(pg8::u32x4*)(X + off + bj * 128) = o; } }
    }
};
struct EpiZ {
    static constexpr bool PERM = true, AFTER_DRAIN = false;
    bf16* Z; bf16* VH; bf16* QH; bf16* KH; const float* gqk; const float* rope;
    __device__ __forceinline__ void operator()(const pg8::f32x4 (&acc)[2][2][4][2], const pg8::Unit& u, int wr, int wc, int fr, int fq) const {
        if (u.pn < 4) {
            const bool isk = u.pn >= 2; const int grp = (u.pn & 1) * 4 + wc;
            const float* g = gqk + (isk ? 64 : 0); const float sc = isk ? 1.f : QSCALE;
            float ga[2][8];
#pragma unroll
            for (int bj = 0; bj < 2; ++bj)
#pragma unroll
                for (int e = 0; e < 8; ++e) ga[bj][e] = g[32 * bj + 8 * fq + e] * sc;
            const bool first = fq < 2; const int i16 = 8 * (fq & 1);
            const bool lat = u.pm < 64;
#pragma unroll
            for (int ai = 0; ai < 2; ++ai) {
                float rc[8], rn[8];
                if (lat) { const float* T = rope + (size_t)(((u.pm * 256 + ai * 128 + wr * 64) & (SEQ - 1)) & ~63) * 64 + i16;
                    const pg8::f32x4 c0 = *(const pg8::f32x4*)T, c1 = *(const pg8::f32x4*)(T + 4), s0 = *(const pg8::f32x4*)(T + 32), s1 = *(const pg8::f32x4*)(T + 36);
#pragma unroll
                    for (int e = 0; e < 4; ++e) { rc[e] = c0[e]; rc[4 + e] = c1[e]; rn[e] = s0[e]; rn[4 + e] = s1[e]; } }
#pragma unroll
                for (int m = 0; m < 4; ++m) {
                    float ccm[8], cnm[8];
                    if (lat) { const float* T = rope + (size_t)(m * 16 + fr) * 64 + 16 + i16;
                        const pg8::f32x4 c0 = *(const pg8::f32x4*)T, c1 = *(const pg8::f32x4*)(T + 4), s0 = *(const pg8::f32x4*)(T + 32), s1 = *(const pg8::f32x4*)(T + 36);
#pragma unroll
                        for (int e = 0; e < 4; ++e) { ccm[e] = c0[e]; ccm[4 + e] = c1[e]; cnm[e] = s0[e]; cnm[4 + e] = s1[e]; } }
                    const int r = u.pm * 256 + ai * 128 + wr * 64 + m * 16 + fr;
                    const int b = lat ? (r >> 13) : ((r - NLAT) >> 8), n = lat ? (r & (SEQ - 1)) : ((r - NLAT) & (CTXL - 1));
                    float v[2][8]; float ss = 0.f;
#pragma unroll
                    for (int bj = 0; bj < 2; ++bj)
#pragma unroll
                        for (int e = 0; e < 8; ++e) { v[bj][e] = acc[ai][bj][m][e >> 2][e & 3]; ss += v[bj][e] * v[bj][e]; }
                    ss += __shfl_xor(ss, 16);
                    { const auto sw = __builtin_amdgcn_permlane32_swap(__float_as_uint(ss), __float_as_uint(ss), false, false); ss = __uint_as_float(sw[0]) + __uint_as_float(sw[1]); }
                    const float rinv = __builtin_amdgcn_rsqf(ss * (1.f / 64.f) + EPS);
                    bf16* dst = (isk ? KH + ((size_t)b * NKEY + (lat ? CTXL + n : n)) * 512 : QH + (size_t)r * 512) + grp * 64 + 8 * fq;
#pragma unroll
                    for (int bj = 0; bj < 2; ++bj) {
                        float y[8], o[8];
#pragma unroll
                        for (int e = 0; e < 8; ++e) y[e] = v[bj][e] * rinv * ga[bj][e];
                        if (lat) {
#pragma unroll
                            for (int e = 0; e < 8; ++e) { const auto sw = __builtin_amdgcn_permlane32_swap(__float_as_uint(y[e]), __float_as_uint(y[e]), false, false);
                                const float pp = __uint_as_float(first ? sw[1] : sw[0]); const float c = bj ? ccm[e] : rc[e], s = bj ? cnm[e] : rn[e];
                                o[e] = first ? y[e] * c - pp * s : pp * s + y[e] * c; }
                        } else {
#pragma unroll
                            for (int e = 0; e < 8; ++e) o[e] = y[e];
                        }
                        pg8::u32x4 w; w.x = pg8::cvt_pk_bf16(o[0], o[1]); w.y = pg8::cvt_pk_bf16(o[2], o[3]); w.z = pg8::cvt_pk_bf16(o[4], o[5]); w.w = pg8::cvt_pk_bf16(o[6], o[7]);
                        *(pg8::u32x4*)(dst + 32 * bj) = w;
                    }
                }
            }
            return;
        }
        const bool isv = (u.pn == 4) | (u.pn == 5);
        const size_t prow0 = isv ? (u.pm < 64 ? (size_t)u.pm * 256 + (size_t)((u.pm >> 5) + 1) * CTXL : (size_t)(u.pm - 64) * NKEY) : (size_t)u.pm * 256;
        bf16* base = isv ? VH + (u.pn - 4) * 256 : Z + u.pn * 256; const int ldc = isv ? 512 : INC;
        const int col0 = wc * 32 + 8 * fq;
#pragma unroll
        for (int ai = 0; ai < 2; ++ai)
#pragma unroll
            for (int m = 0; m < 4; ++m) { bf16* rowp = base + (prow0 + wr * 64 + fr + ai * 128 + m * 16) * ldc + col0;
#pragma unroll
                for (int bj = 0; bj < 2; ++bj) { const pg8::f32x4 v0 = acc[ai][bj][m][0], v1 = acc[ai][bj][m][1];
                    pg8::u32x4 w; w.x = pg8::cvt_pk_bf16(v0[0], v0[1]); w.y = pg8::cvt_pk_bf16(v0[2], v0[3]); w.z = pg8::cvt_pk_bf16(v1[0], v1[1]); w.w = pg8::cvt_pk_bf16(v1[2], v1[3]);
                    *(pg8::u32x4*)(rowp + bj * 128) = w; } }
    }
};
struct EpiSwiglu {
    static constexpr bool PERM = true, AFTER_DRAIN = false;
    bf16* H;
    __device__ __forceinline__ void operator()(const pg8::f32x4 (&acc)[2][2][4][2], const pg8::Unit& u, int wr, int wc, int fr, int fq) const {
        const int row0 = u.pm * 256 + wr * 64 + fr, col0 = (u.pn & 15) * 128 + wc * 32 + 8 * fq;
#pragma unroll
        for (int ai = 0; ai < 2; ++ai)
#pragma unroll
            for (int m = 0; m < 4; ++m) { bf16* rowp = H + (size_t)(row0 + ai * 128 + m * 16) * FF + col0;
                float h[8];
#pragma unroll
                for (int n = 0; n < 2; ++n)
#pragma unroll
                    for (int i = 0; i < 4; ++i) { const float g = acc[ai][0][m][n][i], up = acc[ai][1][m][n][i]; h[4 * n + i] = silu_f(g) * up; }
                pg8::u32x4 w; w.x = pg8::cvt_pk_bf16(h[0], h[1]); w.y = pg8::cvt_pk_bf16(h[2], h[3]); w.z = pg8::cvt_pk_bf16(h[4], h[5]); w.w = pg8::cvt_pk_bf16(h[6], h[7]);
                *(pg8::u32x4*)rowp = w; }
    }
};
struct MoeOrder {
    int G, c, npn, npm, total;
    __device__ __forceinline__ bool next(int i, pg8::Unit& u) const {
        const int per = npm * npn;
        if ((G & 7) == 0) {
            const int W = G >> 3, x = c & 7, r = c >> 3, q = i * W + r;
            if (q >= 2 * per) return false;
            const int e = 2 * x + q / per, rem = q % per, pn = rem / npm, pm = rem % npm;
            u.pm = e * 9 + pm; u.pn = e * npn + pn; return true;
        }
        const long L = (long)i * G + c; if (L >= total) return false;
        const int e = (int)L / per, rem = (int)L % per; const int pn = rem / npm, pm = rem % npm;
        u.pm = e * 9 + pm; u.pn = e * npn + pn; return true;
    }
    __device__ __forceinline__ void a_ready(const pg8::Unit&) const {}
    __device__ __forceinline__ void done(const pg8::Unit&) const {}
    __device__ __forceinline__ bool half_only(const pg8::Unit& u) const { return (u.pm % 9) == 8; }
};

__device__ __forceinline__ void transpose_item(const float* W, int N, bf16* WT, int K, int k0, int n0, size_t drow0, LAS float* scr, int lane) {
    f32x4 v[8];
#pragma unroll
    for (int i = 0; i < 8; ++i) v[i] = __builtin_nontemporal_load((const f32x4*)(W + (size_t)(k0 + 8 * i + (lane >> 3)) * N + n0 + 4 * (lane & 7)));
#pragma unroll
    for (int i = 0; i < 8; ++i) { LAS float* d = scr + (8 * i + (lane >> 3)) * 33 + 4 * (lane & 7); d[0] = v[i].x; d[1] = v[i].y; d[2] = v[i].z; d[3] = v[i].w; }
    LDS_WAIT(); asm volatile("" ::: "memory");
    const int c = lane & 7;
#pragma unroll
    for (int j = 0; j < 4; ++j) { const int n = (lane >> 3) + 8 * j; const LAS float* s = scr + (8 * c) * 33 + n;
        v4u o; o.x = pk2(s[0 * 33], s[1 * 33]); o.y = pk2(s[2 * 33], s[3 * 33]); o.z = pk2(s[4 * 33], s[5 * 33]); o.w = pk2(s[6 * 33], s[7 * 33]);
        *(GAS v4u*)(WT + (drow0 + n) * K + k0 + 8 * c) = o; }
    LDS_WAIT(); asm volatile("" ::: "memory");
}
constexpr unsigned CV_IN = 16 * 104, CV_OUT = 16 * 32, CV_EX = 1024;
constexpr unsigned CONV_SEG0 = DEPTH * (CV_IN + CV_OUT), CONV_PER_L = 3 * NE * CV_EX, CONV_TOTAL = CONV_SEG0 + DEPTH * CONV_PER_L;
constexpr int CW_Q = 64;
static_assert(CONV_TOTAL % 64 == 0, "whole batches");
__device__ __forceinline__ void conv_item(const Frame& F, unsigned it, LAS float* scr, int lane) {
    if (it < DEPTH * CV_IN) { const int L = it / CV_IN, q = it % CV_IN, kb = q / 104, nb = q % 104, n0 = nb * 32;
        const size_t drow0 = n0 < 1024 ? (size_t)(n0 & ~255) + 128 * ((n0 & 63) >> 5) + 32 * ((n0 & 255) >> 6) : (size_t)n0;
        transpose_item(F.w_in() + (size_t)L * DM * INC, INC, F.WIN() + (size_t)L * INC * DM, DM, kb * 64, n0, drow0, scr, lane); return; }
    it -= DEPTH * CV_IN;
    if (it < DEPTH * CV_OUT) { const int L = it / CV_OUT, q = it % CV_OUT, kb = q / 32, nb = q % 32;
        transpose_item(F.w_out() + (size_t)L * DM * DM, DM, F.WOUT() + (size_t)L * DM * DM, DM, kb * 64, nb * 32, (size_t)nb * 32, scr, lane); return; }
    it -= DEPTH * CV_OUT;
    const int L = it / CONV_PER_L, q0 = it % CONV_PER_L, kind = q0 / (NE * CV_EX), r = q0 % (NE * CV_EX), le = L * NE + r / CV_EX, q = r % CV_EX;
    if (kind < 2) { const int kb = q / 64, nb = q % 64, n0 = nb * 32;
        const size_t drow0 = (size_t)(n0 >> 7) * 256 + (n0 & 127) + (kind ? 128 : 0);
        transpose_item((kind ? F.wu() : F.wg()) + (size_t)le * DM * FF, FF, F.WGU() + (size_t)le * 4096 * DM, DM, kb * 64, n0, drow0, scr, lane); }
    else { const int kb = q / 32, nb = q % 32;
        transpose_item(F.wd() + (size_t)le * FF * DM, DM, F.WD() + (size_t)le * DM * FF, FF, kb * 64, nb * 32, (size_t)nb * 32, scr, lane); }
}
__device__ __forceinline__ bool conv_batch(const Frame& F) {
    LAS unsigned* bc = (LAS unsigned*)(F.lds + MISC_OFF + 64);
    LAS float* scr = (LAS float*)(F.lds + 32768 + F.wave * 8704);
    if (F.tid == 0) *bc = __hip_atomic_fetch_add((unsigned*)(F.ws + WS_CTL) + CW_Q, 64u, __ATOMIC_RELAXED, __HIP_MEMORY_SCOPE_AGENT);
    __syncthreads();
    const unsigned base = *bc;
    __syncthreads();
    if (base >= CONV_TOTAL) return false;
    for (int k = 0; k < 8; ++k) conv_item(F, base + 8 * k + F.wave, scr, F.lane);
    return true;
}
__device__ __forceinline__ void conv_n(const Frame& F, int n) { for (int i = 0; i < n; ++i) if (!conv_batch(F)) break; __syncthreads(); }
__device__ __forceinline__ void conv_until(const Frame& F, unsigned target) {
    for (;;) {
        const unsigned h = __hip_atomic_load((unsigned*)(F.ws + WS_CTL) + CW_Q, __ATOMIC_RELAXED, __HIP_MEMORY_SCOPE_AGENT);
        LAS unsigned* bc = (LAS unsigned*)(F.lds + MISC_OFF + 68);
        if (F.tid == 0) *bc = h;
        __syncthreads();
        const unsigned hh = *bc;
        __syncthreads();
        if (hh >= target) break;
        if (!conv_batch(F)) break;
    }
}
__device__ __forceinline__ void ph_prologue(const Frame& F) {
    const int tid = F.tid, lane = F.lane, wave = F.wave;
    LAS float* sc = (LAS float*)F.lds;
    LAS float* red = sc + 3072;
    for (int i = tid; i < 3072; i += NTHR) { const int v = i >> 10, k = i & 1023; const float c = v < 2 ? F.c_in()[v * DM + k] : F.cctx_in()[k]; sc[i] = c / (1.f + expf(-c)); }
    __syncthreads();
    for (int t = F.bid; t < 384; t += F.G) {
        const int L = t / 96, j0 = (t % 96) * 64;
        const float* W = F.w_mod() + (size_t)L * DM * 6144 + j0 + lane;
        float a0 = 0.f, a1 = 0.f, a2 = 0.f;
#pragma unroll 8
        for (int kk = 0; kk < 128; ++kk) { const int k = wave * 128 + kk; const float w = W[(size_t)k * 6144]; a0 += sc[k] * w; a1 += sc[1024 + k] * w; a2 += sc[2048 + k] * w; }
        red[(wave * 3 + 0) * 64 + lane] = a0; red[(wave * 3 + 1) * 64 + lane] = a1; red[(wave * 3 + 2) * 64 + lane] = a2;
        __syncthreads();
        if (tid < 192) { const int v = tid >> 6, l = tid & 63; float s = 0.f;
#pragma unroll
            for (int w = 0; w < 8; ++w) s += red[(w * 3 + v) * 64 + l];
            F.MOD()[(size_t)(L * 3 + v) * 6144 + j0 + l] = s + F.b_mod()[L * 6144 + j0 + l]; }
        __syncthreads();
    }
    if (F.bid == 0 && wave == 0) {
        for (int L = 0; L < DEPTH; ++L) {
            const float d1 = wave_sum(F.lq1()[L * 64 + lane] * F.lk1()[L * 64 + lane]), d2 = wave_sum(F.lq2()[L * 64 + lane] * F.lk2()[L * 64 + lane]);
            const float linit = 0.8f - 0.6f * expf(-0.3f * (float)L);
            if (lane == 0) { F.LP()[L * 16 + 0] = expf(d1) - expf(d2) + linit; F.LP()[L * 16 + 1] = 1.f - linit; }
            if (lane < 8) { const float xd = F.retd()[L * 8 + lane]; F.LP()[L * 16 + 2 + lane] = -log1pf(expf(-xd)); }
            F.LP()[DEPTH * 16 + L * 128 + lane] = F.qng()[L * 64 + lane]; F.LP()[DEPTH * 16 + L * 128 + 64 + lane] = F.kng()[L * 64 + lane];
            { const float mq = wave_max(fabsf(F.qng()[L * 64 + lane])), mk = wave_max(fabsf(F.kng()[L * 64 + lane])); if (lane == 0) F.LP()[L * 16 + 10] = 64.f * mq * mk * 1.02f; }
        }
    }
    const int gw = F.bid * NWAVES + wave, NGW = F.G * NWAVES;
    {
        const int i16 = lane & 15, which = lane >> 4, i32 = lane & 31;
        const float inv_a = powf(10000.f, -(float)i16 / 16.f);
        const float inv_r = 1.f / powf(10000.f, (float)i32 / 31.f);
        for (int n = gw; n < SEQ; n += NGW) {
            const float pos = (which & 1) ? (float)(n & 63) : (float)(n >> 6);
            const float ang = pos * inv_a;
            F.ROPE()[(size_t)n * 64 + lane] = (which < 2) ? (float)cos((double)ang) : (float)sin((double)ang);
            const float ang2 = (float)n * inv_r;
            F.RETT()[(size_t)n * 64 + lane] = (lane < 32) ? (float)cos((double)ang2) : (float)sin((double)ang2);
        }
    }
    if (F.bid == 0) for (int i = tid; i < DM / 2; i += NTHR) ((unsigned*)(F.HN() + (size_t)NROW * DM))[i] = 0u;
    for (int i = F.bid * NTHR + tid; i < DEPTH * 16 * DM; i += F.G * NTHR) { const int Lr = i / (16 * DM), q = i % (16 * DM), k = q >> 4, e = q & 15;
        const float w = F.rw()[i]; const unsigned h = f2bf(w); const float wl = w - __builtin_bit_cast(float, h << 16);
        F.RWS()[((size_t)(Lr * 2 + 0) * 16 + e) * RWLD + k] = (bf16)h; F.RWS()[((size_t)(Lr * 2 + 1) * 16 + e) * RWLD + k] = (bf16)f2bf(wl); }
    for (int i = F.bid * NTHR + tid; i < DEPTH * 4 * 128 * 128; i += F.G * NTHR) F.SGW()[i] = (bf16)f2bf(F.sgw()[i]);
    conv_until(F, CONV_SEG0);
}

__device__ __forceinline__ void ph_norm1_first(const Frame& F) {
    const int lane = F.lane, gw = F.bid * NWAVES + F.wave, NGW = F.G * NWAVES;
    for (int r = gw; r < NROW; r += NGW) {
        const float* src = r < NLAT ? F.x_in() + (size_t)r * DM : F.ctx_in() + (size_t)(r - NLAT) * DM;
        const float* mod = F.MOD() + (size_t)row_vec(r) * 6144;
        f32x4 v[4]; float ss = 0.f;
#pragma unroll
        for (int j = 0; j < 4; ++j) { v[j] = *(const f32x4*)(src + 4 * lane + 256 * j); ss += (v[j].x * v[j].x + v[j].y * v[j].y) + (v[j].z * v[j].z + v[j].w * v[j].w); }
        const float rinv = rsqrtf(wave_sum(ss) * (1.f / DM) + EPS);
#pragma unroll
        for (int j = 0; j < 4; ++j) { const int c = 4 * lane + 256 * j;
            const f32x4 g = *(const f32x4*)(F.n1g() + c), sh = *(const f32x4*)(mod + c), sc = *(const f32x4*)(mod + 1024 + c);
            const f32x4 h = v[j] * rinv * g * (sc + 1.f) + sh;
            *(unsigned long long*)(F.HN() + (size_t)r * DM + c) = (unsigned long long)pk2(h.x, h.y) | ((unsigned long long)pk2(h.z, h.w) << 32); }
    }
}

__device__ __forceinline__ void ph_prep(const Frame& F, int L) {
    const int lane = F.lane, gw = F.bid * NWAVES + F.wave, NGW = F.G * NWAVES;
    const int grp8 = lane >> 3, half = (lane >> 2) & 1, t4 = lane & 3, dA = half * 32 + 4 * t4;
    const f32x4 gqA = *(const f32x4*)(F.qng() + L * 64 + dA), gqB = *(const f32x4*)(F.qng() + L * 64 + dA + 16);
    const f32x4 gkA = *(const f32x4*)(F.kng() + L * 64 + dA), gkB = *(const f32x4*)(F.kng() + L * 64 + dA + 16);
    const int rsel = lane >> 5, rhead = (lane >> 3) & 3, t8 = lane & 7;
    const float rscale = rsel ? 0.125f : 1.f;
    const f32x4 sgn = *(const f32x4*)(F.sgng() + L * 256 + lane * 4);
    for (int r = gw; r < NROW; r += NGW) {
        const bf16* zr = F.Z() + (size_t)r * INC;
        const bool lat = r < NLAT; const int b = lat ? (r >> 13) : ((r - NLAT) >> 8), n = lat ? (r & (SEQ - 1)) : ((r - NLAT) & (CTXL - 1));
        const size_t krow = (size_t)b * NKEY + (lat ? CTXL + n : n);
        f32x4 cs = {1.f, 1.f, 1.f, 1.f}, sn = {0.f, 0.f, 0.f, 0.f}, cs2 = cs, sn2 = sn;
        if (lat) { const float* T = F.ROPE() + (size_t)n * 64; cs = *(const f32x4*)(T + half * 16 + 4 * t4); sn = *(const f32x4*)(T + 32 + half * 16 + 4 * t4);
                   const float* R = F.RETT() + (size_t)n * 64; cs2 = *(const f32x4*)(R + 4 * t8); sn2 = *(const f32x4*)(R + 32 + 4 * t8); }
#pragma unroll
        for (int pass = 0; pass < 2; ++pass) {
            const int col = pass * 512 + grp8 * 64 + dA;
            const u16x4 ra = *(const u16x4*)(zr + col), rb = *(const u16x4*)(zr + col + 16);
            f32x4 x1, x2; float ss = 0.f;
#pragma unroll
            for (int e = 0; e < 4; ++e) { x1[e] = bf2f(ra[e]); x2[e] = bf2f(rb[e]); ss += x1[e] * x1[e] + x2[e] * x2[e]; }
            ss += __shfl_xor(ss, 1); ss += __shfl_xor(ss, 2); ss += __shfl_xor(ss, 4);
            const float rinv = rsqrtf(ss * (1.f / 64.f) + EPS);
            const f32x4 y1 = x1 * rinv * (pass ? gkA : gqA * QSCALE), y2 = x2 * rinv * (pass ? gkB : gqB * QSCALE);
            const f32x4 o1 = y1 * cs - y2 * sn, o2 = y1 * sn + y2 * cs;
            bf16* dst = (pass ? F.KH() + krow * 512 : F.QH() + (size_t)r * 512) + grp8 * 64 + dA;
            *(unsigned long long*)dst = (unsigned long long)pk2(o1.x, o1.y) | ((unsigned long long)pk2(o1.z, o1.w) << 32);
            *(unsigned long long*)(dst + 16) = (unsigned long long)pk2(o2.x, o2.y) | ((unsigned long long)pk2(o2.z, o2.w) << 32);
        }
    }
}

__device__ __forceinline__ void ph_norm2_router(const Frame& F, int L) {
    const int lane = F.lane, tid = F.tid, gw = F.bid * NWAVES + F.wave, NGW = F.G * NWAVES;
    LAS bf16* rwl = (LAS bf16*)F.lds;
    { const bf16* src = F.RWS() + (size_t)L * 2 * 16 * RWLD;
      for (int i = tid; i < 2 * 16 * RWLD / 8; i += NTHR) *(LAS bf16x8*)(rwl + i * 8) = *(const bf16x8*)(src + i * 8); }
    __syncthreads();
    const int ntile = ((L == DEPTH - 1) ? NLAT : NROW) / 16;
    const int rr = lane & 15, kq = lane >> 4;
    for (int tile = gw; tile < ntile; tile += NGW) {
        const int r = tile * 16 + rr;
        const bf16* xr = F.X() + (size_t)r * DM + 8 * kq;
        const float* mod = F.MOD() + (size_t)(L * 3 + row_vec(tile * 16)) * 6144 + 8 * kq;
        const float* gn = F.n2g() + L * DM + 8 * kq;
        float ss = 0.f;
#pragma unroll 8
        for (int st = 0; st < 32; ++st) { const v4u w = *(const v4u*)(xr + 32 * st);
            const f32x4 a = {__builtin_bit_cast(float, w.x << 16), __builtin_bit_cast(float, w.x & 0xffff0000u), __builtin_bit_cast(float, w.y << 16), __builtin_bit_cast(float, w.y & 0xffff0000u)};
            const f32x4 c = {__builtin_bit_cast(float, w.z << 16), __builtin_bit_cast(float, w.z & 0xffff0000u), __builtin_bit_cast(float, w.w << 16), __builtin_bit_cast(float, w.w & 0xffff0000u)};
            ss += (a.x * a.x + a.y * a.y) + (a.z * a.z + a.w * a.w) + (c.x * c.x + c.y * c.y) + (c.z * c.z + c.w * c.w); }
        ss += __shfl_xor(ss, 16); ss += __shfl_xor(ss, 32);
        const float rinv = rsqrtf(ss * (1.f / DM) + EPS);
        f32x4 acc = {0.f, 0.f, 0.f, 0.f};
        bf16* hrow = F.HN() + (size_t)r * DM + 8 * kq;
#pragma unroll 4
        for (int st = 0; st < 32; ++st) {
            float f[8];
            const v4u xw = *(const v4u*)(xr + 32 * st);
#pragma unroll
            for (int q = 0; q < 2; ++q) { const unsigned w0 = q ? xw.z : xw.x, w1 = q ? xw.w : xw.y;
                const f32x4 xv = {__builtin_bit_cast(float, w0 << 16), __builtin_bit_cast(float, w0 & 0xffff0000u), __builtin_bit_cast(float, w1 << 16), __builtin_bit_cast(float, w1 & 0xffff0000u)};
                const f32x4 g = *(const f32x4*)(gn + 32 * st + 4 * q),
                                                      sh = *(const f32x4*)(mod + 3072 + 32 * st + 4 * q), sc = *(const f32x4*)(mod + 4096 + 32 * st + 4 * q);
                const f32x4 y = xv * rinv * g * (sc + 1.f) + sh; f[4 * q] = y.x; f[4 * q + 1] = y.y; f[4 * q + 2] = y.z; f[4 * q + 3] = y.w; }
            v4u hi, lo;
            hi.x = pk2(f[0], f[1]); hi.y = pk2(f[2], f[3]); hi.z = pk2(f[4], f[5]); hi.w = pk2(f[6], f[7]);
#define LOPK(w, i0, i1) pk2(f[i0] - __builtin_bit_cast(float, (w) << 16), f[i1] - __builtin_bit_cast(float, (w) & 0xffff0000u))
            lo.x = LOPK(hi.x, 0, 1); lo.y = LOPK(hi.y, 2, 3); lo.z = LOPK(hi.z, 4, 5); lo.w = LOPK(hi.w, 6, 7);
#undef LOPK
            *(v4u*)(hrow + 32 * st) = hi;
            const bf16x8 ah = __builtin_bit_cast(bf16x8, hi), al = __builtin_bit_cast(bf16x8, lo);
            const bf16x8 bh = *(const LAS bf16x8*)(rwl + rr * RWLD + 32 * st + 8 * kq), bl = *(const LAS bf16x8*)(rwl + (16 + rr) * RWLD + 32 * st + 8 * kq);
            acc = __builtin_amdgcn_mfma_f32_16x16x32_bf16(ah, bh, acc, 0, 0, 0);
            acc = __builtin_amdgcn_mfma_f32_16x16x32_bf16(ah, bl, acc, 0, 0, 0);
            acc = __builtin_amdgcn_mfma_f32_16x16x32_bf16(al, bh, acc, 0, 0, 0);
        }
#pragma unroll
        for (int q = 0; q < 4; ++q) {
            float mx = acc[q];
#pragma unroll
            for (int o = 1; o < 16; o <<= 1) mx = fmaxf(mx, __shfl_xor(mx, o));
            const float ex = expf(acc[q] - mx); float sum = ex;
#pragma unroll
            for (int o = 1; o < 16; o <<= 1) sum += __shfl_xor(sum, o);
            F.AFF()[(size_t)(tile * 16 + 4 * kq + q) * 16 + rr] = ex / sum;
        }
    }
    __syncthreads();
}

__device__ __forceinline__ unsigned block_excl_scan(unsigned v, LAS unsigned* wtot, int lane, int wave) {
    unsigned inc = v;
#pragma unroll
    for (int o = 1; o < 64; o <<= 1) { const unsigned t = __shfl_up(inc, o); if (lane >= o) inc += t; }
    if (lane == 63) wtot[wave] = inc;
    __syncthreads();
    unsigned off = 0;
    for (int w = 0; w < wave; ++w) off += wtot[w];
    __syncthreads();
    return off + inc - v;
}
__device__ __forceinline__ void ph_topk(const Frame& F, int L) {
    const int tid = F.tid, lane = F.lane, wave = F.wave;
    LAS unsigned* keys = (LAS unsigned*)F.lds;
    LAS unsigned* hist = keys + 8192;
    LAS unsigned* wtot = hist + 256;
    LAS unsigned* bc = wtot + 16;
    const int nprob = (L == DEPTH - 1) ? 32 : 64;
    for (int p = F.bid; p < 64; p += F.G) {
        const int s = p >> 4, e = p & 15;
        const int n = s < 2 ? SEQ : CTXL, k = n >> 3;
        const int base = s < 2 ? s * SEQ : NLAT + (s - 2) * CTXL;
        const int sbase = s == 0 ? 0 : (s == 1 ? 1024 : (s == 2 ? 2048 : 2080));
        if (p >= nprob) {
            for (int i = tid; i < 32; i += NTHR) { F.ROWIDX()[e * EROWS + sbase + i] = -1; F.GATE()[e * EROWS + sbase + i] = 0.f; }
            if (s == 3) for (int rr = 2112 + tid; rr < EROWS; rr += NTHR) { F.ROWIDX()[e * EROWS + rr] = -1; F.GATE()[e * EROWS + rr] = 0.f; }
            continue; }
        for (int i = tid; i < n; i += NTHR) keys[i] = __float_as_uint(F.AFF()[(size_t)(base + i) * 16 + e]);
        __syncthreads();
        unsigned prefix = 0u, mask = 0u, need = (unsigned)k;
        for (int pass = 0; pass < 4; ++pass) {
            const int shift = 24 - 8 * pass;
            if (tid < 256) hist[tid] = 0u;
            __syncthreads();
            for (int i = tid; i < n; i += NTHR) { const unsigned key = keys[i]; if ((key & mask) == prefix) atomicAdd((unsigned*)&hist[(key >> shift) & 255u], 1u); }
            __syncthreads();
            if (wave == 0) {
                const unsigned h0 = hist[4 * lane], h1 = hist[4 * lane + 1], h2 = hist[4 * lane + 2], h3 = hist[4 * lane + 3];
                const unsigned tot = h0 + h1 + h2 + h3;
                unsigned suf = tot;
#pragma unroll
                for (int o = 1; o < 64; o <<= 1) { const unsigned t = __shfl_down(suf, o); if (lane + o < 64) suf += t; }
                const unsigned above = suf - tot;
                if (suf >= need && above < need) {
                    unsigned rem = need - above, bsel;
                    if (rem <= h3) bsel = 3u; else { rem -= h3; if (rem <= h2) bsel = 2u; else { rem -= h2; if (rem <= h1) bsel = 1u; else { rem -= h1; bsel = 0u; } } }
                    bc[0] = 4u * lane + bsel; bc[1] = rem;
                }
            }
            __syncthreads();
            prefix |= bc[0] << shift; mask |= 255u << shift; need = bc[1];
            __syncthreads();
        }
        const unsigned T = prefix;
        const int per = n >= NTHR ? n / NTHR : 1;
        const int i0 = tid * per; const bool act = i0 < n;
        unsigned eqc = 0u;
        if (act) for (int q = 0; q < per; ++q) eqc += (keys[i0 + q] == T) ? 1u : 0u;
        unsigned eqr = block_excl_scan(eqc, wtot, lane, wave);
        unsigned selc = 0u;
        if (act) for (int q = 0; q < per; ++q) { const unsigned key = keys[i0 + q]; if (key > T) ++selc; else if (key == T) { if (eqr < need) ++selc; ++eqr; } }
        unsigned slot = block_excl_scan(selc, wtot, lane, wave);
        eqr -= eqc;
        if (act) for (int q = 0; q < per; ++q) {
            const unsigned key = keys[i0 + q]; bool sel = key > T;
            if (key == T) { sel = eqr < need; ++eqr; }
            const int tok = base + i0 + q;
            if (sel) { const int rr = sbase + (int)slot; ++slot; F.ROWIDX()[e * EROWS + rr] = tok; F.GATE()[e * EROWS + rr] = __uint_as_float(key); F.SLOT()[(size_t)tok * 16 + e] = rr; }
            else F.SLOT()[(size_t)tok * 16 + e] = -1;
        }
        if (s == 3) for (int rr = 2112 + tid; rr < EROWS; rr += NTHR) { F.ROWIDX()[e * EROWS + rr] = -1; F.GATE()[e * EROWS + rr] = 0.f; }
        __syncthreads();
    }
}

__device__ __forceinline__ void ph_gather(const Frame& F) {
    const int lane = F.lane, gw = F.bid * NWAVES + F.wave, NGW = F.G * NWAVES;
    for (int idx = gw; idx < NE * EROWS; idx += NGW) {
        const int src = F.ROWIDX()[idx];
        bf16x8 a = {0, 0, 0, 0, 0, 0, 0, 0}, b = a;
        if (src >= 0) { a = *(const bf16x8*)(F.HN() + (size_t)src * DM + 8 * lane); b = *(const bf16x8*)(F.HN() + (size_t)src * DM + 512 + 8 * lane); }
        *(bf16x8*)(F.XS() + (size_t)idx * DM + 8 * lane) = a; *(bf16x8*)(F.XS() + (size_t)idx * DM + 512 + 8 * lane) = b;
    }
}

__device__ __forceinline__ void ph_combine(const Frame& F, int L) {
    const int lane = F.lane, gw = F.bid * NWAVES + F.wave, NGW = F.G * NWAVES;
    const bool last = (L == DEPTH - 1);
    const int nrows = last ? NLAT : NROW;
    for (int r = gw; r < nrows; r += NGW) {
        const int v = row_vec(r);
        const int sl = (lane < 16) ? F.SLOT()[(size_t)r * 16 + lane] : -1;
        const float* mod = F.MOD() + (size_t)(L * 3 + v) * 6144;
        f32x4 xv[4], g2[4];
#pragma unroll
        for (int j = 0; j < 2; ++j)
#pragma unroll
            for (int q = 0; q < 2; ++q) { const int c = 8 * lane + 512 * j + 4 * q; const unsigned long long w = *(const unsigned long long*)(F.X() + (size_t)r * DM + c);
                const unsigned w0 = (unsigned)w, w1 = (unsigned)(w >> 32);
                xv[2 * j + q] = (f32x4){__builtin_bit_cast(float, w0 << 16), __builtin_bit_cast(float, w0 & 0xffff0000u), __builtin_bit_cast(float, w1 << 16), __builtin_bit_cast(float, w1 & 0xffff0000u)};
                g2[2 * j + q] = *(const f32x4*)(mod + 5120 + c); }
        float acc[16];
#pragma unroll
        for (int i = 0; i < 16; ++i) acc[i] = 0.f;
        unsigned long long m = __ballot(sl >= 0);
        while (m) {
            const int e0 = __builtin_ctzll(m); m &= m - 1;
            const int e1 = m ? __builtin_ctzll(m) : -1; if (m) m &= m - 1;
            const int s0 = __shfl(sl, e0), s1 = e1 >= 0 ? __shfl(sl, e1) : 0;
            const float gv0 = F.GATE()[e0 * EROWS + s0]; const bf16* y0 = F.Y() + ((size_t)e0 * EROWS + s0) * DM;
            const bf16x8 a0 = *(const bf16x8*)(y0 + 8 * lane), a1 = *(const bf16x8*)(y0 + 8 * lane + 512);
            float gv1 = 0.f; bf16x8 b0 = {0, 0, 0, 0, 0, 0, 0, 0}, b1 = b0;
            if (e1 >= 0) { gv1 = F.GATE()[e1 * EROWS + s1]; const bf16* y1 = F.Y() + ((size_t)e1 * EROWS + s1) * DM; b0 = *(const bf16x8*)(y1 + 8 * lane); b1 = *(const bf16x8*)(y1 + 8 * lane + 512); }
#pragma unroll
            for (int i = 0; i < 8; ++i) { acc[i] += gv0 * bf2f((bf16)a0[i]); acc[8 + i] += gv0 * bf2f((bf16)a1[i]); }
            if (e1 >= 0) {
#pragma unroll
                for (int i = 0; i < 8; ++i) { acc[i] += gv1 * bf2f((bf16)b0[i]); acc[8 + i] += gv1 * bf2f((bf16)b1[i]); } }
        }
        float xn[16]; float ss = 0.f;
#pragma unroll
        for (int j = 0; j < 2; ++j)
#pragma unroll
            for (int q = 0; q < 2; ++q) { const int c = 8 * lane + 512 * j + 4 * q;
#pragma unroll
                for (int i = 0; i < 4; ++i) { const float t = xv[2 * j + q][i] + g2[2 * j + q][i] * acc[8 * j + 4 * q + i]; xn[8 * j + 4 * q + i] = t; ss += t * t; }
                const f32x4 o = {xn[8 * j + 4 * q], xn[8 * j + 4 * q + 1], xn[8 * j + 4 * q + 2], xn[8 * j + 4 * q + 3]};
                if (last) *(f32x4*)(F.out + (size_t)r * DM + c) = o;
                else *(unsigned long long*)(F.X() + (size_t)r * DM + c) = (unsigned long long)pk2(o.x, o.y) | ((unsigned long long)pk2(o.z, o.w) << 32); }
        if (!last) {
            const float rinv = rsqrtf(wave_sum(ss) * (1.f / DM) + EPS);
            const float* mod1 = F.MOD() + (size_t)((L + 1) * 3 + v) * 6144;
#pragma unroll
            for (int j = 0; j < 2; ++j) { const int c = 8 * lane + 512 * j; float h[8];
#pragma unroll
                for (int q = 0; q < 2; ++q) { const f32x4 g = *(const f32x4*)(F.n1g() + (L + 1) * DM + c + 4 * q), sh = *(const f32x4*)(mod1 + c + 4 * q), sc = *(const f32x4*)(mod1 + 1024 + c + 4 * q);
#pragma unroll
                    for (int i = 0; i < 4; ++i) h[4 * q + i] = xn[8 * j + 4 * q + i] * rinv * g[i] * (1.f + sc[i]) + sh[i]; }
                v4u w; w.x = pk2(h[0], h[1]); w.y = pk2(h[2], h[3]); w.z = pk2(h[4], h[5]); w.w = pk2(h[6], h[7]);
                *(v4u*)(F.HN() + (size_t)r * DM + c) = w; }
        }
    }
}


constexpr int LDP = 136, LDQK = 72;

__device__ __forceinline__ void ret_rot(const Frame& F, const bf16* zh, int p, bool lat, int n, float scale, float (&o1)[8], float (&o2)[8]) {
    const bf16x8 r1 = *(const bf16x8*)(zh + 8 * p), r2 = *(const bf16x8*)(zh + 32 + 8 * p);
    float cs[8], sn[8];
    if (lat) { const float* R = F.RETT() + (size_t)n * 64 + 8 * p; const f32x4 c0 = *(const f32x4*)R, c1 = *(const f32x4*)(R + 4), s0 = *(const f32x4*)(R + 32), s1 = *(const f32x4*)(R + 36);
#pragma unroll
        for (int i = 0; i < 4; ++i) { cs[i] = c0[i]; cs[4 + i] = c1[i]; sn[i] = s0[i]; sn[4 + i] = s1[i]; } }
    else {
#pragma unroll
        for (int i = 0; i < 8; ++i) { cs[i] = 1.f; sn[i] = 0.f; } }
#pragma unroll
    for (int i = 0; i < 8; ++i) { const float x1 = bf2f((bf16)r1[i]) * scale, x2 = bf2f((bf16)r2[i]) * scale; o1[i] = x1 * cs[i] - x2 * sn[i]; o2[i] = x1 * sn[i] + x2 * cs[i]; }
}
__device__ __forceinline__ void unit_retkv(const Frame& F, int L, int b, int h, int cc) {
    const int tid = F.tid, lane = F.lane, wave = F.wave;
    LAS bf16* vT = (LAS bf16*)F.lds;
    LAS bf16* kfT = vT + 64 * LDP;
    LAS bf16* kbT = kfT + 64 * LDP;
    const int row0 = chunk_row0(b, cc);
    const float lgf = F.LP()[L * 16 + 2 + h], lgb = F.LP()[L * 16 + 6 + h];
    { const int j = tid >> 2, p = tid & 3;
      const bf16* zr = F.Z() + (size_t)(row0 + j) * INC;
      float k1[8], k2[8];
      ret_rot(F, zr + ZRK + h * 64, p, cc >= 2, (cc - 2) * 128 + j, 0.125f, k1, k2);
      const bf16x8 v1 = *(const bf16x8*)(zr + ZRV + h * 64 + 8 * p), v2 = *(const bf16x8*)(zr + ZRV + h * 64 + 32 + 8 * p);
      const float df = __expf(lgf * (float)(127 - j)), db = __expf(lgb * (float)j);
#pragma unroll
      for (int i = 0; i < 8; ++i) { const int d1 = 8 * p + i, d2 = 32 + 8 * p + i;
          kfT[d1 * LDP + j] = (bf16)f2bf(k1[i] * df); kbT[d1 * LDP + j] = (bf16)f2bf(k1[i] * db); vT[d1 * LDP + j] = (bf16)v1[i];
          kfT[d2 * LDP + j] = (bf16)f2bf(k2[i] * df); kbT[d2 * LDP + j] = (bf16)f2bf(k2[i] * db); vT[d2 * LDP + j] = (bf16)v2[i]; } }
    __syncthreads();
    { const int dir = wave >> 2, ti = (wave >> 1) & 1, tj = wave & 1, r32 = lane & 31, hi = lane >> 5;
      f32x16 acc = {};
      acc = mma_nt(vT + ti * 32 * LDP, LDP, (dir ? kbT : kfT) + tj * 32 * LDP, LDP, 128, acc, lane);
      float* dst = F.KVT() + ((size_t)(((b * 4 + h) * 2 + dir) * NCH + cc)) * 4096;
#pragma unroll
      for (int x = 0; x < 16; ++x) dst[(ti * 32 + crow(x, hi)) * 64 + tj * 32 + r32] = acc[x]; }
    __syncthreads();
}

__device__ __forceinline__ void ph_scan(const Frame& F, int L) {
    const int t = F.bid * NTHR + F.tid;
    if (t < 65536) {
        const int elem = t & 4095, sq = t >> 12, dir = sq & 1, h = (sq >> 1) & 3, b = sq >> 3;
        const size_t base = (size_t)(((b * 4 + h) * 2 + dir) * NCH);
        const float decay = expf(F.LP()[L * 16 + 2 + dir * 4 + h] * 128.f);
        float kv[NCH];
#pragma unroll
        for (int step = 0; step < NCH; ++step) { const int cc = dir == 0 ? step : (step < 2 ? 1 - step : 67 - step); kv[step] = F.KVT()[(base + cc) * 4096 + elem]; }
        float s = 0.f;
#pragma unroll
        for (int step = 0; step < NCH; ++step) { const int cc = dir == 0 ? step : (step < 2 ? 1 - step : 67 - step);
            F.SPREV()[(base + cc) * 4096 + elem] = (bf16)f2bf(s); s = s * decay + kv[step]; }
    }
}

__device__ __forceinline__ void unit_retout(const Frame& F, int L, int b, int h, int cc) {
    int tid = F.tid; asm volatile("" : "+v"(tid));
    const int lane = tid & 63, wave = F.wave, r32 = lane & 31, hi = lane >> 5;
    LAS bf16* q_s = (LAS bf16*)F.lds;
    LAS bf16* k_s = q_s + 128 * LDQK;
    LAS bf16* vT = k_s + 128 * LDQK;
    LAS bf16* SfT = vT + 64 * LDP;
    LAS bf16* SbT = SfT + 64 * LDQK;
    LAS bf16* P = SbT + 64 * LDQK;
    LAS float* O_s = (LAS float*)P;
    constexpr int LDO = 66;
    const int row0 = chunk_row0(b, cc);
    const float lgf = F.LP()[L * 16 + 2 + h], lgb = F.LP()[L * 16 + 6 + h];
    { const int j = tid >> 2, p = tid & 3;
      const bf16* zr = F.Z() + (size_t)(row0 + j) * INC;
      float a1[8], a2[8];
      ret_rot(F, zr + ZRQ + h * 64, p, cc >= 2, (cc - 2) * 128 + j, 1.f, a1, a2);
      { v4u w; w.x = pk2(a1[0], a1[1]); w.y = pk2(a1[2], a1[3]); w.z = pk2(a1[4], a1[5]); w.w = pk2(a1[6], a1[7]); *(LAS v4u*)(q_s + j * LDQK + 8 * p) = w;
        w.x = pk2(a2[0], a2[1]); w.y = pk2(a2[2], a2[3]); w.z = pk2(a2[4], a2[5]); w.w = pk2(a2[6], a2[7]); *(LAS v4u*)(q_s + j * LDQK + 32 + 8 * p) = w; }
      ret_rot(F, zr + ZRK + h * 64, p, cc >= 2, (cc - 2) * 128 + j, 0.125f, a1, a2);
      { v4u w; w.x = pk2(a1[0], a1[1]); w.y = pk2(a1[2], a1[3]); w.z = pk2(a1[4], a1[5]); w.w = pk2(a1[6], a1[7]); *(LAS v4u*)(k_s + j * LDQK + 8 * p) = w;
        w.x = pk2(a2[0], a2[1]); w.y = pk2(a2[2], a2[3]); w.z = pk2(a2[4], a2[5]); w.w = pk2(a2[6], a2[7]); *(LAS v4u*)(k_s + j * LDQK + 32 + 8 * p) = w; }
      const bf16x8 v1 = *(const bf16x8*)(zr + ZRV + h * 64 + 8 * p), v2 = *(const bf16x8*)(zr + ZRV + h * 64 + 32 + 8 * p);
#pragma unroll
      for (int i = 0; i < 8; ++i) { vT[(8 * p + i) * LDP + j] = (bf16)v1[i]; vT[(32 + 8 * p + i) * LDP + j] = (bf16)v2[i]; } }
    { const bf16* sf = F.SPREV() + ((size_t)(((b * 4 + h) * 2 + 0) * NCH + cc)) * 4096;
      const bf16* sb = F.SPREV() + ((size_t)(((b * 4 + h) * 2 + 1) * NCH + cc)) * 4096;
      { const int dv = tid >> 3, c8 = (tid & 7) * 8;
          *(LAS v4u*)(SfT + dv * LDQK + c8) = *(const v4u*)(sf + dv * 64 + c8);
          *(LAS v4u*)(SbT + dv * LDQK + c8) = *(const v4u*)(sb + dv * 64 + c8); } }
    __syncthreads();
    const int sti = wave >> 1, stj0 = (wave & 1) * 2;
    f32x16 S0 = {}, S1 = {};
    S0 = mma_nt(q_s + sti * 32 * LDQK, LDQK, k_s + stj0 * 32 * LDQK, LDQK, 64, S0, lane);
    S1 = mma_nt(q_s + sti * 32 * LDQK, LDQK, k_s + (stj0 + 1) * 32 * LDQK, LDQK, 64, S1, lane);
    const int ei = tid >> 2, ec = (tid & 3) * 16;
    float yo[16];
#pragma unroll
    for (int dir = 0; dir < 2; ++dir) {
        const float lg = dir ? lgb : lgf;
#pragma unroll
        for (int x = 0; x < 16; ++x) { const int i = sti * 32 + crow(x, hi);
            const int j0 = stj0 * 32 + r32, j1 = j0 + 32; const int d0 = dir ? j0 - i : i - j0, d1 = dir ? j1 - i : i - j1;
            const float p0 = d0 >= 0 ? S0[x] * __expf(lg * (float)d0) : 0.f, p1 = d1 >= 0 ? S1[x] * __expf(lg * (float)d1) : 0.f;
            const unsigned pk = pg8::cvt_pk_bf16(p0, p1);
            P[i * LDP + j0] = (bf16)(pk & 0xffffu); P[i * LDP + j1] = (bf16)(pk >> 16);
            if ((x & 3) == 3) __builtin_amdgcn_sched_barrier(0); }
        __syncthreads();
        const int oti = wave >> 1, otj = wave & 1;
        f32x16 a0 = {}, c0 = {};
        { const LAS bf16* ST = dir ? SbT : SfT;
          a0 = mma_nt(P + oti * 32 * LDP, LDP, vT + otj * 32 * LDP, LDP, 128, a0, lane);
          c0 = mma_nt(q_s + oti * 32 * LDQK, LDQK, ST + otj * 32 * LDQK, LDQK, 64, c0, lane); }
        __syncthreads();
#pragma unroll
        for (int x = 0; x < 16; ++x) { const int i = oti * 32 + crow(x, hi);
            const float qd = __expf(lg * (float)(dir ? 128 - i : i + 1));
            O_s[i * LDO + otj * 32 + r32] = a0[x] + c0[x] * qd;
            if ((x & 3) == 3) __builtin_amdgcn_sched_barrier(0); }
        __syncthreads();
        { float o[16]; float s = 0.f;
#pragma unroll
          for (int c = 0; c < 16; ++c) { o[c] = O_s[ei * LDO + ec + c]; s += o[c]; }
          s += __shfl_xor(s, 1); s += __shfl_xor(s, 2);
          const float mu = s * (1.f / 64.f); float s2 = 0.f;
#pragma unroll
          for (int c = 0; c < 16; ++c) { o[c] -= mu; s2 += o[c] * o[c]; }
          s2 += __shfl_xor(s2, 1); s2 += __shfl_xor(s2, 2);
          const float rs = rsqrtf(s2 * (1.f / 64.f) + EPS);
          const bf16* zr = F.Z() + (size_t)(row0 + ei) * INC + (dir ? ZGB : ZGF) + h * 64 + ec;
          const bf16x8 ga = *(const bf16x8*)zr, gb = *(const bf16x8*)(zr + 8);
#pragma unroll
          for (int c = 0; c < 16; ++c) { const float g = bf2f((bf16)(c < 8 ? ga[c & 7] : gb[c & 7])); const float y = o[c] * rs * silu_f(g);
              if (dir == 0) yo[c] = y; else yo[c] += y; }
          if (dir == 1) { bf16* mr = F.MIX() + (size_t)(row0 + ei) * DM + 512 + h * 64 + ec;
              v4u w0, w1; w0.x = pk2(yo[0], yo[1]); w0.y = pk2(yo[2], yo[3]); w0.z = pk2(yo[4], yo[5]); w0.w = pk2(yo[6], yo[7]);
              w1.x = pk2(yo[8], yo[9]); w1.y = pk2(yo[10], yo[11]); w1.z = pk2(yo[12], yo[13]); w1.w = pk2(yo[14], yo[15]);
              *(v4u*)mr = w0; *(v4u*)(mr + 8) = w1; } }
        __syncthreads();
    }
}

__device__ __forceinline__ void unit_sg(const Frame& F, int L, int b, int g, int cc) {
    const int tid = F.tid, lane = F.lane, wave = F.wave, r32 = lane & 31, hi = lane >> 5;
    LAS bf16* W_s = (LAS bf16*)F.lds;
    LAS bf16* vT = W_s + 128 * LDP;
    const int row0 = chunk_row0(b, cc);
    const bf16* Wg = F.SGW() + (size_t)(L * 4 + g) * 128 * 128;
#pragma unroll
    for (int q = 0; q < 4; ++q) { const int idx = tid + NTHR * q, i = idx >> 4, c8 = (idx & 15) * 8; *(LAS bf16x8*)(W_s + i * LDP + c8) = *(const bf16x8*)(Wg + i * 128 + c8); }
    { const int j = tid >> 2, qd = tid & 3;
      const bf16* zr = F.Z() + (size_t)(row0 + j) * INC + ZSV + 64 * qd;
      float gv[64]; float sum = 0.f;
#pragma unroll
      for (int c = 0; c < 8; ++c) { const bf16x8 raw = *(const bf16x8*)(zr + 8 * c);
#pragma unroll
          for (int i = 0; i < 8; ++i) { const float t = gelu_t(bf2f((bf16)raw[i])); gv[8 * c + i] = t; sum += t; } }
      sum += __shfl_xor(sum, 1); sum += __shfl_xor(sum, 2);
      const float mu = sum * (1.f / 256.f); float s2 = 0.f;
#pragma unroll
      for (int c = 0; c < 64; ++c) { gv[c] -= mu; s2 += gv[c] * gv[c]; }
      s2 += __shfl_xor(s2, 1); s2 += __shfl_xor(s2, 2);
      const float rs = rsqrtf(s2 * (1.f / 256.f) + EPS);
      if (qd == g) { const float* gn = F.sgng() + L * 256 + g * 64;
#pragma unroll
          for (int c = 0; c < 64; ++c) vT[c * LDP + j] = (bf16)f2bf(gv[c] * rs * gn[c]); } }
    __syncthreads();
    LAS float* O_s = (LAS float*)W_s;
    { const int ti = wave >> 1, tj = wave & 1;
      f32x16 acc = {};
      acc = mma_nt(W_s + ti * 32 * LDP, LDP, vT + tj * 32 * LDP, LDP, 128, acc, lane);
      __syncthreads();
#pragma unroll
      for (int x = 0; x < 16; ++x) O_s[(ti * 32 + crow(x, hi)) * 66 + tj * 32 + r32] = acc[x]; }
    __syncthreads();
    { const int i = tid >> 2, ec = (tid & 3) * 16;
      const bf16* zu = F.Z() + (size_t)(row0 + i) * INC + ZSU + g * 64 + ec;
      const bf16x8 u0 = *(const bf16x8*)zu, u1 = *(const bf16x8*)(zu + 8);
      const float bi = F.sgb()[(L * 4 + g) * 128 + i];
      float o[16];
#pragma unroll
      for (int c = 0; c < 16; ++c) o[c] = gelu_t(bf2f((bf16)(c < 8 ? u0[c & 7] : u1[c & 7]))) * (O_s[i * 66 + ec + c] + bi);
      bf16* mr = F.MIX() + (size_t)(row0 + i) * DM + 768 + g * 64 + ec;
      v4u w0, w1; w0.x = pk2(o[0], o[1]); w0.y = pk2(o[2], o[3]); w0.z = pk2(o[4], o[5]); w0.w = pk2(o[6], o[7]);
      w1.x = pk2(o[8], o[9]); w1.y = pk2(o[10], o[11]); w1.z = pk2(o[12], o[13]); w1.w = pk2(o[14], o[15]);
      *(v4u*)mr = w0; *(v4u*)(mr + 8) = w1; }
    __syncthreads();
}

__device__ __forceinline__ void unit_out_ctx(const Frame& F, int L, int mu) {
    int tid = F.tid; asm volatile("" : "+v"(tid));
    const int lane = tid & 63, wave = F.wave, r32 = lane & 31, hi = lane >> 5;
    const int rb = mu >> 5, cb = mu & 31, k0 = wave * 128 + 8 * hi;
    LAS float* P = (LAS float*)F.lds;
    const bf16* A0 = F.MIX() + (size_t)(NLAT + rb * 64 + r32) * DM + k0;
    const bf16* B0 = F.WOUT() + (size_t)L * DM * DM + (size_t)(cb * 32 + r32) * DM + k0;
    bf16x8 a0[8], a1[8], bb[8];
#pragma unroll
    for (int s = 0; s < 8; ++s) { a0[s] = *(const bf16x8*)(A0 + 16 * s); a1[s] = *(const bf16x8*)(A0 + 32 * DM + 16 * s); bb[s] = *(const bf16x8*)(B0 + 16 * s); }
    f32x16 c0 = {}, c1 = {};
#pragma unroll
    for (int s = 0; s < 8; ++s) { c0 = __builtin_amdgcn_mfma_f32_32x32x16_bf16(a0[s], bb[s], c0, 0, 0, 0); c1 = __builtin_amdgcn_mfma_f32_32x32x16_bf16(a1[s], bb[s], c1, 0, 0, 0); }
#pragma unroll
    for (int x = 0; x < 16; ++x) { P[((wave * 2 + 0) * 16 + x) * 64 + lane] = c0[x]; P[((wave * 2 + 1) * 16 + x) * 64 + lane] = c1[x]; }
    __syncthreads();
    const float* g1 = F.MOD() + (size_t)(L * 3 + 2) * 6144 + 2048 + cb * 32;
#pragma unroll
    for (int q = 0; q < 4; ++q) {
        const int idx = tid + NTHR * q, ln = idx & 63, x = (idx >> 6) & 15, t = idx >> 10;
        float s = 0.f;
#pragma unroll
        for (int w = 0; w < 8; ++w) s += P[((w * 2 + t) * 16 + x) * 64 + ln];
        const int row = 32 * t + crow(x, ln >> 5), col = ln & 31;
        const size_t xo = (size_t)(rb * 64 + row) * DM + cb * 32 + col;
        F.X()[(size_t)NLAT * DM + xo] = (bf16)f2bf((L == 0 ? F.ctx_in()[xo] : bf2f(F.X()[(size_t)NLAT * DM + xo])) + g1[col] * s);
    }
    __syncthreads();
}

namespace att {
constexpr int KVBLK = 64;
constexpr float SCALE = 0.125f, THR = 8.f;
constexpr int LDQ = 512, LDK = 512, LDV = 512;
constexpr int SHM_V = KVBLK * 128 * 2, SHM_K = KVBLK * 64 * 2, SHM_ATTN = 2 * SHM_V + 2 * SHM_K + NWAVES * 64 * 4;
#define KSWZ(row, colB) ((row) * 128 + ((colB) ^ ((((row) >> 1) & 7) << 4)))
#define SBAR() __builtin_amdgcn_sched_barrier(0)
__device__ __forceinline__ unsigned cvtpk(float lo, float hi) { unsigned r; asm volatile("v_cvt_pk_bf16_f32 %0, %1, %2" : "=v"(r) : "v"(lo), "v"(hi)); return r; }
template <bool OFF> __device__ __forceinline__ void partialSM(f32x16& p0, f32x16& p1, float off) {
#pragma unroll
    for (int r = 0; r < 16; ++r) { if (OFF) { p0[r] += off; p1[r] += off; } p0[r] = __builtin_amdgcn_exp2f(p0[r]); }
}
__device__ __forceinline__ void finishSM(f32x16& p0, f32x16& p1, float& l_reg, bf16x8& pa0, bf16x8& pa1, bf16x8& pa2, bf16x8& pa3) {
#pragma unroll
    for (int r = 0; r < 16; ++r) p1[r] = __builtin_amdgcn_exp2f(p1[r]);
    float ps = 0;
#pragma unroll
    for (int r = 0; r < 16; ++r) ps += p0[r];
#pragma unroll
    for (int r = 0; r < 16; ++r) ps += p1[r];
    { auto rr = __builtin_amdgcn_permlane32_swap(__float_as_uint(ps), __float_as_uint(ps), false, false);
      ps = __uint_as_float(rr[0]) + __uint_as_float(rr[1]); }
    l_reg += ps;
#define PK4(P, BASE, OUT) do { unsigned a0 = cvtpk(P[BASE + 0], P[BASE + 1]), a1 = cvtpk(P[BASE + 2], P[BASE + 3]);   \
    unsigned b0 = cvtpk(P[BASE + 4], P[BASE + 5]), b1 = cvtpk(P[BASE + 6], P[BASE + 7]);                              \
    auto r0 = __builtin_amdgcn_permlane32_swap(a0, b0, false, false); auto r1 = __builtin_amdgcn_permlane32_swap(a1, b1, false, false); \
    v4u w = {r0[0], r1[0], r0[1], r1[1]}; OUT = __builtin_bit_cast(bf16x8, w); } while (0)
    PK4(p0, 0, pa0); PK4(p0, 8, pa1); PK4(p1, 0, pa2); PK4(p1, 8, pa3);
#undef PK4
}
template <bool OFF> __device__ __forceinline__ void kload(bf16x8 (&kf)[8], const LAS char* Ks, int r32, int hi) {
    if (OFF) return;
#pragma unroll
    for (int d0 = 0; d0 < 4; ++d0) { const int cb = (d0 * 16 + hi * 8) * 2;
        kf[2 * d0] = *(const LAS bf16x8*)(Ks + KSWZ(r32, cb)); kf[2 * d0 + 1] = *(const LAS bf16x8*)(Ks + KSWZ(32 + r32, cb)); }
}
template <bool OFF> __device__ __forceinline__ void qkmma(f32x16& p0, f32x16& p1, const bf16x8 (&kf)[8], const bf16x8* qr, const LAS char* Ks, int r32, int hi) {
    p0 = f32x16{}; p1 = f32x16{};
#pragma unroll
    for (int d0 = 0; d0 < 4; ++d0) {
        if (OFF) { const int cb = (d0 * 16 + hi * 8) * 2;
            const bf16x8 b0 = *(const LAS bf16x8*)(Ks + KSWZ(r32, cb)), b1 = *(const LAS bf16x8*)(Ks + KSWZ(32 + r32, cb));
            p0 = __builtin_amdgcn_mfma_f32_32x32x16_bf16(b0, qr[d0], p0, 0, 0, 0); p1 = __builtin_amdgcn_mfma_f32_32x32x16_bf16(b1, qr[d0], p1, 0, 0, 0); }
        else { p0 = __builtin_amdgcn_mfma_f32_32x32x16_bf16(kf[2 * d0], qr[d0], p0, 0, 0, 0); p1 = __builtin_amdgcn_mfma_f32_32x32x16_bf16(kf[2 * d0 + 1], qr[d0], p1, 0, 0, 0); } }
}
__device__ __forceinline__ int v_st(int k, int c) { const int kk = (k & ~0xC) | ((k & 4) << 1) | ((k & 8) >> 1); return ((kk >> 3) * 4 + (c >> 5)) * 512 + ((kk & 7) * 32 + (c & 31)) * 2; }
__device__ __forceinline__ int v_rd_base(int lane) { return ((lane & 3) << 3) | (((lane >> 2) & 3) << 6) | (((lane >> 4) & 1) << 5) | (((lane >> 5) & 1) << 8); }
constexpr int v_rd_off(int d0, int ks, int half) { return d0 * 512 + ks * 4096 + half * 2048; }
template <int OFF> __device__ __forceinline__ s16x4 tr_read(int vb) {
    s16x4 r; asm volatile("ds_read_b64_tr_b16 %0, %1 offset:%2" : "=&v"(r) : "v"(vb), "i"(OFF) : "memory"); return r;
}
template <int D0> __device__ __forceinline__ void pv_one(f32x16& od, int vb, bf16x8 pa0, bf16x8 pa1, bf16x8 pa2, bf16x8 pa3) {
    const s16x4 l0 = tr_read<v_rd_off(D0, 0, 0)>(vb), h0 = tr_read<v_rd_off(D0, 0, 1)>(vb), l1 = tr_read<v_rd_off(D0, 1, 0)>(vb), h1 = tr_read<v_rd_off(D0, 1, 1)>(vb);
    const s16x4 l2 = tr_read<v_rd_off(D0, 2, 0)>(vb), h2 = tr_read<v_rd_off(D0, 2, 1)>(vb), l3 = tr_read<v_rd_off(D0, 3, 0)>(vb), h3 = tr_read<v_rd_off(D0, 3, 1)>(vb);
    asm volatile("s_waitcnt lgkmcnt(0)" ::: "memory"); SBAR();
#define PK(Lo, Hi) (bf16x8){Lo[0], Lo[1], Lo[2], Lo[3], Hi[0], Hi[1], Hi[2], Hi[3]}
    od = __builtin_amdgcn_mfma_f32_32x32x16_bf16(pa0, PK(l0, h0), od, 0, 0, 0);
    od = __builtin_amdgcn_mfma_f32_32x32x16_bf16(pa1, PK(l1, h1), od, 0, 0, 0);
    od = __builtin_amdgcn_mfma_f32_32x32x16_bf16(pa2, PK(l2, h2), od, 0, 0, 0);
    od = __builtin_amdgcn_mfma_f32_32x32x16_bf16(pa3, PK(l3, h3), od, 0, 0, 0);
#undef PK
}
__device__ __forceinline__ void pv_d0(f32x16* o, int vb, bf16x8 pa0, bf16x8 pa1, bf16x8 pa2, bf16x8 pa3) {
    pv_one<0>(o[0], vb, pa0, pa1, pa2, pa3); pv_one<1>(o[1], vb, pa0, pa1, pa2, pa3); pv_one<2>(o[2], vb, pa0, pa1, pa2, pa3); pv_one<3>(o[3], vb, pa0, pa1, pa2, pa3);
}
template <bool OFF> __device__ __forceinline__ void body(const bf16* __restrict__ Qb, const bf16* __restrict__ Kh, const bf16* __restrict__ Vh, int seq, float mfix, LAS char* lds, f32x16 (&o)[4]) {
    int tid = threadIdx.x; asm volatile("" : "+v"(tid));
    const int wid = __builtin_amdgcn_readfirstlane(tid >> 6), lane = tid & 63, r32 = lane & 31, hi = lane >> 5;
    LAS char* V_lds = lds; LAS char* K_lds = lds + 2 * SHM_V;
    LAS float* ws = (LAS float*)(lds + 2 * SHM_V + 2 * SHM_K) + wid * 64; LAS float* li_l = ws; LAS float* al_l = ws + 32;
    float l_reg = 0;
    const float soff = -mfix * (SCALE * 1.4426950408889634f);
#pragma unroll
    for (int d = 0; d < 4; ++d) o[d] = f32x16{};
    bf16x8 qr[4];
    const bf16* Qw = Qb + (long)(wid * 32 + r32) * LDQ + hi * 8;
#pragma unroll
    for (int d0 = 0; d0 < 4; ++d0) qr[d0] = *(const bf16x8*)(Qw + d0 * 16);
    const int sr = tid >> 4, sc = (tid & 15) * 8, vst0 = v_st(sr, sc), vst1 = v_st(32 + sr, sc);
    const int kr = tid >> 3, kc = (tid & 7) * 8, kst = KSWZ(kr, kc * 2);
    const int vb0 = (int)(uintptr_t)V_lds + v_rd_base(lane);
    struct { bf16x8 vs0, vs1, ks0; } sr_[2];
#define SLOAD(i, k0) do { sr_[i].vs0 = *(const bf16x8*)(&Vh[(long)((k0) + sr) * LDV + sc]); sr_[i].vs1 = *(const bf16x8*)(&Vh[(long)((k0) + 32 + sr) * LDV + sc]); \
    sr_[i].ks0 = *(const bf16x8*)(&Kh[(long)((k0) + kr) * LDK + kc]); } while (0)
#define SWRITE(b, i) do { *(LAS bf16x8*)(V_lds + (b) * SHM_V + vst0) = sr_[i].vs0; *(LAS bf16x8*)(V_lds + (b) * SHM_V + vst1) = sr_[i].vs1; \
    *(LAS bf16x8*)(K_lds + (b) * SHM_K + kst) = sr_[i].ks0; } while (0)
#define SWAIT() asm volatile("s_waitcnt vmcnt(3)" ::: "memory")
    f32x16 pA0, pA1, pB0, pB1; bf16x8 pa0, pa1, pa2, pa3; const int NT = seq / KVBLK;
    constexpr int SE = 0, SO = 1;
    SLOAD(SE, 0); asm volatile("s_waitcnt vmcnt(0)" ::: "memory"); SWRITE(0, SE); __syncthreads();
    bf16x8 kf[8];
    kload<OFF>(kf, K_lds, r32, hi); qkmma<OFF>(pA0, pA1, kf, qr, K_lds, r32, hi); partialSM<OFF>(pA0, pA1, soff);
    SLOAD(SO, KVBLK); if (2 < NT) SLOAD(SE, 2 * KVBLK);
    SWAIT(); SWRITE(1, SO); __syncthreads();
    for (int j = 1; j + 1 < NT; j += 2) {
        SBAR(); kload<OFF>(kf, K_lds + SHM_K, r32, hi); SBAR();
        qkmma<OFF>(pB0, pB1, kf, qr, K_lds + SHM_K, r32, hi); finishSM(pA0, pA1, l_reg, pa0, pa1, pa2, pa3); SBAR();
        SLOAD(SO, (j + 2) * KVBLK); SBAR();
        pv_d0(o, vb0, pa0, pa1, pa2, pa3); partialSM<OFF>(pB0, pB1, soff);
        __syncthreads(); SWAIT(); SWRITE(0, SE);
        __syncthreads();
        SBAR(); kload<OFF>(kf, K_lds, r32, hi); SBAR();
        qkmma<OFF>(pA0, pA1, kf, qr, K_lds, r32, hi); finishSM(pB0, pB1, l_reg, pa0, pa1, pa2, pa3); SBAR();
        if (j + 3 < NT) SLOAD(SE, (j + 3) * KVBLK); SBAR();
        pv_d0(o, vb0 + (int)SHM_V, pa0, pa1, pa2, pa3); partialSM<OFF>(pA0, pA1, soff);
        __syncthreads(); SWAIT(); SWRITE(1, SO);
        __syncthreads();
    }
    SBAR(); kload<OFF>(kf, K_lds + SHM_K, r32, hi); SBAR();
    qkmma<OFF>(pB0, pB1, kf, qr, K_lds + SHM_K, r32, hi); finishSM(pA0, pA1, l_reg, pa0, pa1, pa2, pa3); SBAR();
    pv_d0(o, vb0, pa0, pa1, pa2, pa3); partialSM<OFF>(pB0, pB1, soff);
    __syncthreads();
    finishSM(pB0, pB1, l_reg, pa0, pa1, pa2, pa3); SBAR();
    pv_d0(o, vb0 + (int)SHM_V, pa0, pa1, pa2, pa3);
    if (hi == 0) li_l[r32] = l_reg; asm volatile("s_waitcnt lgkmcnt(0)" ::: "memory");
#pragma unroll
    for (int r = 0; r < 16; ++r) { const float rl = __builtin_amdgcn_rcpf(li_l[crow(r, hi)]);
#pragma unroll
        for (int d0 = 0; d0 < 4; ++d0) o[d0][r] *= rl; }
    __syncthreads();
#undef SLOAD
#undef SWRITE
#undef SWAIT
}

constexpr int SLK = 8192, SLV = 16384, L_K = 0, L_V = 3 * SLK, L_WS = L_V + 3 * SLV;
typedef const LAS char* lds_cptr;
typedef short v4i16_t __attribute__((ext_vector_type(4)));
#define PIN(x) asm volatile("" : "+v"(x))
#define MFMA32(a, b, c) __builtin_amdgcn_mfma_f32_32x32x16_bf16(a, b, c, 0, 0, 0)
#define WAIT_BAR(N) asm volatile("s_waitcnt vmcnt(" #N ") lgkmcnt(0)\n\ts_barrier" ::: "memory")
__device__ __forceinline__ unsigned cvtpk2(float lo, float hi) { unsigned r; asm("v_cvt_pk_bf16_f32 %0, %1, %2" : "=v"(r) : "v"(lo), "v"(hi)); return r; }
__device__ __forceinline__ void glds16(const void* g, unsigned lds_base) {
    unsigned sv; asm volatile("s_mov_b32 %0, m0\n\ts_mov_b32 m0, %2\n\ts_nop 0\n\tglobal_load_lds_dwordx4 %1, off\n\ts_mov_b32 m0, %0" : "=&s"(sv) : "v"(g), "s"(lds_base) : "memory"); }
__device__ __forceinline__ void kload2(bf16x8* kf, lds_cptr kp, int d0) { kf[2 * d0] = *(const LAS bf16x8*)(kp + d0 * 2048); kf[2 * d0 + 1] = *(const LAS bf16x8*)(kp + d0 * 2048 + 512); }
__device__ __forceinline__ s16x4 vtr(lds_cptr p) { return __builtin_bit_cast(s16x4, __builtin_amdgcn_ds_read_tr16_b64_v4i16((LAS v4i16_t*)p)); }
__device__ __forceinline__ void body_fast(const bf16* __restrict__ Qb, const bf16* __restrict__ Kh, const bf16* __restrict__ Vh, int seq, LAS char* lds, f32x16 (&o)[4]) {
    int tid = threadIdx.x; asm volatile("" : "+v"(tid));
    const int wid = __builtin_amdgcn_readfirstlane(tid >> 6), lane = tid & 63, r32 = lane & 31, hi = lane >> 5;
    const int NT = seq / KVBLK;
    const unsigned lds0 = (unsigned)(uintptr_t)lds; LAS float* wsf = (LAS float*)(lds + L_WS) + wid * 64;
    const bool dma = wid < 4;
    const int w4 = wid & 3, kr0 = 8 * w4 + (lane >> 3);
    const unsigned kvo0 = (unsigned)(kr0 * (LDK * 2) + (((lane & 7) ^ ((kr0 >> 1) & 7)) * 16)), kvo1 = kvo0 + 32 * (LDK * 2);
    const unsigned vvo0 = (unsigned)((4 * w4 + ((lane >> 2) & 3)) * (LDV * 2) + (lane >> 4) * 64 + (lane & 3) * 16), vvo1 = vvo0 + 16 * (LDV * 2), vvo2 = vvo0 + 32 * (LDV * 2), vvo3 = vvo0 + 48 * (LDV * 2);
    const unsigned kdst = lds0 + L_K + w4 * 1024, vdst = lds0 + L_V + w4 * 1024;
#define DMA_K(t, slot) do { if (dma) { unsigned sv_; asm volatile("s_mov_b32 %0, m0\n\ts_mov_b32 m0, %4\n\ts_nop 0\n\tglobal_load_lds_dwordx4 %1, %3\n\ts_add_u32 m0, m0, 0x1000\n\ts_nop 0\n\t" \
        "global_load_lds_dwordx4 %2, %3\n\ts_mov_b32 m0, %0" : "=&s"(sv_) : "v"(kvo0), "v"(kvo1), "s"((const char*)Kh + (size_t)(t) * (KVBLK * LDK * 2)), "s"(kdst + (slot)) : "memory", "scc"); } } while (0)
#define DMA_V(t, slot) do { if (dma) { unsigned sv_; asm volatile("s_mov_b32 %0, m0\n\ts_mov_b32 m0, %6\n\ts_nop 0\n\tglobal_load_lds_dwordx4 %1, %5\n\ts_add_u32 m0, m0, 0x1000\n\ts_nop 0\n\t" \
        "global_load_lds_dwordx4 %2, %5\n\ts_add_u32 m0, m0, 0x1000\n\ts_nop 0\n\tglobal_load_lds_dwordx4 %3, %5\n\ts_add_u32 m0, m0, 0x1000\n\ts_nop 0\n\t" \
        "global_load_lds_dwordx4 %4, %5\n\ts_mov_b32 m0, %0" : "=&s"(sv_) : "v"(vvo0), "v"(vvo1), "v"(vvo2), "v"(vvo3), "s"((const char*)Vh + (size_t)(t) * (KVBLK * LDV * 2)), "s"(vdst + 2 * (slot)) : "memory", "scc"); } } while (0)
    const lds_cptr vp0 = (lds_cptr)lds + L_V + hi * 1024 + ((lane & 15) >> 2) * 64 + ((lane >> 4) & 1) * 32 + (lane & 3) * 8;
    const lds_cptr kp0 = (lds_cptr)lds + L_K + r32 * 128;
    const int kx = (r32 >> 1) & 7;
    const lds_cptr ka0 = kp0 + (((0 + hi) ^ kx) * 16), ka1 = kp0 + (((2 + hi) ^ kx) * 16), ka2 = kp0 + (((4 + hi) ^ kx) * 16), ka3 = kp0 + (((6 + hi) ^ kx) * 16);
#define KL2(d0, off) do { kf[2 * (d0)] = *(const LAS bf16x8*)(ka##d0 + (off)); kf[2 * (d0) + 1] = *(const LAS bf16x8*)(ka##d0 + (off) + 4096); } while (0)
    DMA_K(0, 0); DMA_V(0, 0); DMA_K(1, SLK);
    bf16x8 qr[4];
    const bf16* Qw = Qb + (long)(wid * 32 + r32) * LDQ + hi * 8;
#pragma unroll
    for (int d0 = 0; d0 < 4; ++d0) qr[d0] = *(const bf16x8*)(Qw + d0 * 16);
    float l_reg = 0.f;
#pragma unroll
    for (int d = 0; d < 4; ++d) o[d] = f32x16{};
    f32x16 pA0, pA1, pB0, pB1; bf16x8 kf[8]; s16x4 vlo[8], vhi[8]; v4u pw0, pw1, pw2, pw3;
    int sl_prev = 0, sl_cur = 0, sl_next = SLK;
#define ROT() do { sl_prev = sl_cur; sl_cur = sl_next; sl_next = (sl_next == 2 * SLK) ? 0 : sl_next + SLK; } while (0)
#define EX(v) __builtin_amdgcn_exp2f(v)
    DMA_K(2, 2 * SLK);
    WAIT_BAR(4);
    KL2(0, 0); KL2(1, 0); KL2(2, 0); KL2(3, 0);
    pA0 = MFMA32(kf[0], qr[0], f32x16{}); pA1 = MFMA32(kf[1], qr[0], f32x16{}); pA0 = MFMA32(kf[2], qr[1], pA0); pA1 = MFMA32(kf[3], qr[1], pA1);
    pA0 = MFMA32(kf[4], qr[2], pA0); pA1 = MFMA32(kf[5], qr[2], pA1); pA0 = MFMA32(kf[6], qr[3], pA0); pA1 = MFMA32(kf[7], qr[3], pA1);
#pragma unroll
    for (int r = 0; r < 16; ++r) { pA0[r] = EX(pA0[r]); pA1[r] = EX(pA1[r]); }
    WAIT_BAR(0);
    DMA_K(3, 0); DMA_V(1, SLK); ROT();
    KL2(0, sl_cur); KL2(1, sl_cur); KL2(2, sl_cur); KL2(3, sl_cur);
    WAIT_BAR(6);
#define PKW(P, i) cvtpk2(P[i], P[i + 1])
#define PAF(k) __builtin_bit_cast(bf16x8, pw##k)
#define VFR(i) (bf16x8){vlo[i][0], vlo[i][1], vlo[i][2], vlo[i][3], vhi[i][0], vhi[i][1], vhi[i][2], vhi[i][3]}
#define VRD(s, fi) do { vlo[s] = vtr(vp_ + (((fi) >> 2) * 256 + ((fi) & 3) * 4096)); vhi[s] = vtr(vp_ + (((fi) >> 2) * 256 + ((fi) & 3) * 4096 + 2048)); } while (0)
#define KRD(G, d0) do { if (G) { KL2(d0, sl_next); SBAR(); } } while (0)
#define GAPA(MF, a0, a1, a2, a3, W0, W1, PW) do { MF; sacc += a0; sacc2 += a1; sacc += a2; sacc2 += a3; W0; W1; PIN(PW); PIN(sacc); PIN(sacc2); SBAR(); } while (0)
#define GAPB(MF, X, i) do { MF; X[i] = EX(X[i]); X[i + 1] = EX(X[i + 1]); PIN(X); SBAR(); } while (0)
#define STEP(C0, C1, P0, P1, t, GK, GV, GL) do { SBAR(); \
    const lds_cptr vp_ = vp0 + 2 * sl_prev; \
    VRD(0, 0); SBAR(); float sacc = P0[0], sacc2 = P0[1]; \
                       GAPA(C0 = MFMA32(kf[0], qr[0], f32x16{}), P0[2], P0[3], P0[4], P0[5],     pw0[0] = PKW(P0, 0),  pw0[1] = PKW(P0, 2),  pw0); \
    VRD(4, 4); SBAR(); GAPA(C1 = MFMA32(kf[1], qr[0], f32x16{}), P0[6], P0[7], P0[8], P0[9],     pw0[2] = PKW(P0, 4),  pw0[3] = PKW(P0, 6),  pw0); \
    VRD(1, 1); SBAR(); GAPA(C0 = MFMA32(kf[2], qr[1], C0),       P0[10], P0[11], P0[12], P0[13], pw1[0] = PKW(P0, 8),  pw1[1] = PKW(P0, 10), pw1); \
    VRD(5, 5); SBAR(); GAPA(C1 = MFMA32(kf[3], qr[1], C1),       P0[14], P0[15], P1[0], P1[1],   pw1[2] = PKW(P0, 12), pw1[3] = PKW(P0, 14), pw1); \
    VRD(2, 2); SBAR(); GAPA(C0 = MFMA32(kf[4], qr[2], C0),       P1[2], P1[3], P1[4], P1[5],     pw2[0] = PKW(P1, 0),  pw2[1] = PKW(P1, 2),  pw2); \
    VRD(6, 6); SBAR(); GAPA(C1 = MFMA32(kf[5], qr[2], C1),       P1[6], P1[7], P1[8], P1[9],     pw2[2] = PKW(P1, 4),  pw2[3] = PKW(P1, 6),  pw2); \
    VRD(3, 3); SBAR(); GAPA(C0 = MFMA32(kf[6], qr[3], C0),       P1[10], P1[11], P1[12], P1[13], pw3[0] = PKW(P1, 8),  pw3[1] = PKW(P1, 10), pw3); \
    VRD(7, 7); SBAR(); GAPA(C1 = MFMA32(kf[7], qr[3], C1),       P1[14], P1[15], 0.f, 0.f,       pw3[2] = PKW(P1, 12), pw3[3] = PKW(P1, 14), pw3); \
    l_reg += sacc + sacc2; SBAR(); \
    GAPB(o[0] = MFMA32(PAF(0), VFR(0), o[0]), C0, 0);  VRD(0, 8);  SBAR(); \
    GAPB(o[1] = MFMA32(PAF(0), VFR(4), o[1]), C0, 2);  VRD(4, 12); SBAR(); \
    GAPB(o[0] = MFMA32(PAF(1), VFR(1), o[0]), C0, 4);  VRD(1, 9);  SBAR(); \
    GAPB(o[1] = MFMA32(PAF(1), VFR(5), o[1]), C0, 6);  VRD(5, 13); SBAR(); \
    GAPB(o[0] = MFMA32(PAF(2), VFR(2), o[0]), C0, 8);  VRD(2, 10); SBAR(); \
    GAPB(o[1] = MFMA32(PAF(2), VFR(6), o[1]), C0, 10); VRD(6, 14); SBAR(); \
    GAPB(o[0] = MFMA32(PAF(3), VFR(3), o[0]), C0, 12); VRD(3, 11); SBAR(); \
    GAPB(o[1] = MFMA32(PAF(3), VFR(7), o[1]), C0, 14); VRD(7, 15); SBAR(); \
    KRD(GL, 0); GAPB(o[2] = MFMA32(PAF(0), VFR(0), o[2]), C1, 0); \
    KRD(GL, 1); GAPB(o[3] = MFMA32(PAF(0), VFR(4), o[3]), C1, 2); \
    KRD(GL, 2); GAPB(o[2] = MFMA32(PAF(1), VFR(1), o[2]), C1, 4); \
    KRD(GL, 3); GAPB(o[3] = MFMA32(PAF(1), VFR(5), o[3]), C1, 6); \
    GAPB(o[2] = MFMA32(PAF(2), VFR(2), o[2]), C1, 8);  if (dma) { if (GK) DMA_K((t) + 3, sl_cur); if (GV) DMA_V((t) + 1, sl_next); } SBAR(); \
    GAPB(o[3] = MFMA32(PAF(2), VFR(6), o[3]), C1, 10); \
    GAPB(o[2] = MFMA32(PAF(3), VFR(3), o[2]), C1, 12); \
    GAPB(o[3] = MFMA32(PAF(3), VFR(7), o[3]), C1, 14); \
    } while (0)
    int t = 1;
    for (; t + 5 < NT; t += 2) {
        STEP(pB0, pB1, pA0, pA1, t, true, true, true);     WAIT_BAR(6); ROT();
        STEP(pA0, pA1, pB0, pB1, t + 1, true, true, true); WAIT_BAR(6); ROT();
    }
#define ENDW(tt) do { if ((tt) + 3 < NT) { WAIT_BAR(6); } else if ((tt) + 2 < NT) { WAIT_BAR(4); } else { WAIT_BAR(0); } } while (0)
    for (; t + 1 < NT; t += 2) {
        STEP(pB0, pB1, pA0, pA1, t, (t + 3 < NT), (t + 1 < NT), (t + 1 < NT));         ENDW(t);     ROT();
        STEP(pA0, pA1, pB0, pB1, t + 1, (t + 4 < NT), (t + 2 < NT), (t + 2 < NT));     ENDW(t + 1); ROT();
    }
    STEP(pB0, pB1, pA0, pA1, NT - 1, false, false, false);
    { float sacc = pB0[0] + pB0[1];
#pragma unroll
      for (int r = 2; r < 16; ++r) sacc += pB0[r];
#pragma unroll
      for (int r = 0; r < 16; ++r) sacc += pB1[r];
      l_reg += sacc;
      pw0 = (v4u){PKW(pB0, 0), PKW(pB0, 2), PKW(pB0, 4), PKW(pB0, 6)}; pw1 = (v4u){PKW(pB0, 8), PKW(pB0, 10), PKW(pB0, 12), PKW(pB0, 14)};
      pw2 = (v4u){PKW(pB1, 0), PKW(pB1, 2), PKW(pB1, 4), PKW(pB1, 6)}; pw3 = (v4u){PKW(pB1, 8), PKW(pB1, 10), PKW(pB1, 12), PKW(pB1, 14)};
      const lds_cptr vp_ = vp0 + 2 * sl_cur;
      _Pragma("unroll") for (int i = 0; i < 8; ++i) VRD(i, i);
      o[0] = MFMA32(PAF(0), VFR(0), o[0]); o[1] = MFMA32(PAF(0), VFR(4), o[1]); o[0] = MFMA32(PAF(1), VFR(1), o[0]); o[1] = MFMA32(PAF(1), VFR(5), o[1]);
      o[0] = MFMA32(PAF(2), VFR(2), o[0]); o[1] = MFMA32(PAF(2), VFR(6), o[1]); o[0] = MFMA32(PAF(3), VFR(3), o[0]); o[1] = MFMA32(PAF(3), VFR(7), o[1]);
      SBAR();
      _Pragma("unroll") for (int i = 0; i < 8; ++i) VRD(i, 8 + i);
      o[2] = MFMA32(PAF(0), VFR(0), o[2]); o[3] = MFMA32(PAF(0), VFR(4), o[3]); o[2] = MFMA32(PAF(1), VFR(1), o[2]); o[3] = MFMA32(PAF(1), VFR(5), o[3]);
      o[2] = MFMA32(PAF(2), VFR(2), o[2]); o[3] = MFMA32(PAF(2), VFR(6), o[3]); o[2] = MFMA32(PAF(3), VFR(3), o[2]); o[3] = MFMA32(PAF(3), VFR(7), o[3]); }
    { auto rr = __builtin_amdgcn_permlane32_swap(__float_as_uint(l_reg), __float_as_uint(l_reg), false, false); l_reg = __uint_as_float(rr[0]) + __uint_as_float(rr[1]); }
    if (hi == 0) wsf[32 + r32] = l_reg; asm volatile("s_waitcnt lgkmcnt(0)" ::: "memory");
#pragma unroll
    for (int r = 0; r < 16; ++r) { const float rl = __builtin_amdgcn_rcpf(wsf[32 + crow(r, hi)]);
#pragma unroll
        for (int d0 = 0; d0 < 4; ++d0) o[d0][r] *= rl; }
    asm volatile("s_waitcnt lgkmcnt(0)\n\ts_barrier" ::: "memory");
#undef DMA_K
#undef DMA_V
#undef ROT
#undef EX
#undef PKW
#undef PAF
#undef VFR
#undef VRD
#undef KRD
#undef KL2
#undef ENDW
#undef GAPA
#undef GAPB
#undef STEP
}
}

__device__ __forceinline__ void unit_attn(const Frame& F, int L, int b, int h, int qrow0  , int seq) {
    f32x16 o[4];
    for (int m = 0; m < 2; ++m) {
        const float mfix = F.LP()[L * 16 + 10];
        if (__builtin_expect(mfix * (att::SCALE * 1.4426950408889634f) > 64.f, 0))
            att::body<true>(F.QH() + (size_t)qrow0 * 512 + (h * 2 + m) * 64, F.KH() + (size_t)b * NKEY * 512 + (h * 2 + m) * 64, F.VH() + (size_t)b * NKEY * 512 + h * 128, seq, mfix, (LAS char*)F.lds, o);
        else
            att::body_fast(F.QH() + (size_t)qrow0 * 512 + (h * 2 + m) * 64, F.KH() + (size_t)b * NKEY * 512 + (h * 2 + m) * 64, F.VH() + (size_t)b * NKEY * 512 + h * 128, seq, (LAS char*)F.lds, o);
        if (m == 0) {
            int tid = F.tid; asm volatile("" : "+v"(tid));
            const int lane = tid & 63, wave = __builtin_amdgcn_readfirstlane(tid >> 6), r32 = lane & 31, hi = lane >> 5;
            float* scr = F.SCR() + (size_t)F.bid * 256 * 128 + (size_t)(wave * 32) * 128;
#pragma unroll
            for (int r = 0; r < 16; ++r)
#pragma unroll
                for (int d0 = 0; d0 < 4; ++d0) scr[crow(r, hi) * 128 + d0 * 32 + r32] = o[d0][r];
            asm volatile("s_waitcnt vmcnt(0)" ::: "memory");
        }
    }
    int tid = F.tid; asm volatile("" : "+v"(tid));
    const int lane = tid & 63, wave = __builtin_amdgcn_readfirstlane(tid >> 6), r32 = lane & 31, hi = lane >> 5;
    const float lam = F.LP()[L * 16 + 0], oscale = F.LP()[L * 16 + 1];
    const float* scr = F.SCR() + (size_t)F.bid * 256 * 128 + (size_t)(wave * 32) * 128;
    float sg[4];
#pragma unroll
    for (int d0 = 0; d0 < 4; ++d0) sg[d0] = F.subg()[L * 128 + d0 * 32 + r32] * oscale;
#pragma unroll
    for (int r = 0; r < 16; ++r) {
        float d[4]; float ss = 0.f;
#pragma unroll
        for (int d0 = 0; d0 < 4; ++d0) { d[d0] = scr[crow(r, hi) * 128 + d0 * 32 + r32] - lam * o[d0][r]; ss += d[d0] * d[d0]; }
        const float rs = rsqrtf(half_sum32(ss) * (1.f / 128.f) + EPS);
        bf16* mr = F.MIX() + (size_t)(qrow0 + wave * 32 + crow(r, hi)) * DM + h * 128;
#pragma unroll
        for (int d0 = 0; d0 < 4; ++d0) mr[d0 * 32 + r32] = (bf16)f2bf(d[d0] * rs * sg[d0]);
    }
}


constexpr int NPH_L = 12, NPHASE = 2 + DEPTH * NPH_L;
struct Args { const float* in[25]; float* out; unsigned char* ws; int gp_lo, gp_hi; };
__global__ void __launch_bounds__(NTHR, 2) fwd(Args args) {
    extern __shared__ __attribute__((aligned(16))) unsigned char lds[];
    Frame F;
    F.lds = (LAS unsigned char*)lds;
    F.tid = threadIdx.x; F.lane = F.tid & 63; F.wave = __builtin_amdgcn_readfirstlane(F.tid >> 6); F.bid = blockIdx.x; F.G = gridDim.x;
    F.in = args.in; F.out = args.out; F.ws = args.ws;
    unsigned char* ws = args.ws;
    volatile LAS unsigned* MISC = (volatile LAS unsigned*)(F.lds + MISC_OFF);
    for (int u = F.tid; u < (LDS_BYTES - RING_BYTES) / 4; u += NTHR) ((LAS unsigned*)(F.lds + RING_BYTES))[u] = 0u;
    __syncthreads();
#if MK_ONE_LAUNCH
    constexpr int lo = 0, hi = NPHASE;
#else
    const int lo = args.gp_lo, hi = args.gp_hi;
#endif
    unsigned* barw = (unsigned*)(ws + WS_CTL) + CW_BAR;
    XcdBarrier bar; bar.bar = barw; bar.x = 0; bar.st = nullptr;
    if (hi - lo > 1) bar = xcd_barrier_post(barw, MISC + 8);
#ifndef N_CV_N2
#define N_CV_N2 2
#endif
#ifndef N_CV_INP
#define N_CV_INP 1
#endif
#ifndef N_CV_OUT
#define N_CV_OUT 1
#endif
#ifndef N_CV_TOPK
#define N_CV_TOPK 1
#endif
#ifndef N_CV_DOWN
#define N_CV_DOWN 1
#endif
#ifndef PHM
#define PHM 0xFFFF
#endif
#define PB(i) (((PHM) >> (i)) & 1)
#ifndef DBLM
#define DBLM 0
#endif
#define REP(i) for (int rep_ = 0; rep_ < ((((DBLM) >> (i)) & 1) ? 2 : 1); ++rep_)
#define IN(k) (lo <= (k) && (k) < hi)
#ifndef BARX
#define BARX 1
#endif
#define SEAM(k) do { if (IN(k) && IN((k) + 1)) { for (int bx_ = 0; bx_ < BARX; ++bx_) xcd_barrier(bar); } } while (0)

    if (PB(0) && IN(0)) REP(0) ph_prologue(F);
    SEAM(0);
    if (PB(1) && IN(1)) REP(1) ph_norm1_first(F);
    SEAM(1);
    for (int L = 0; L < DEPTH; ++L) {
        const int base = 2 + NPH_L * L;
#define FRESH() do { F.tid = threadIdx.x; asm volatile("" : "+v"(F.tid)); F.lane = F.tid & 63; } while (0)
        if (PB(2) && IN(base + 0)) REP(2) {
            pg8::Gemm g{F.HN(), F.WIN() + (size_t)L * INC * DM, NROW, INC, DM}; pg8::StaticOrder S; S.init(NROW, INC, F.G, F.bid);
            EpiZ E{F.Z(), F.VH(), F.QH(), F.KH(), F.LP() + DEPTH * 16 + L * 128, F.ROPE()};
            pg8::gemm_phase<EpiZ, pg8::StaticOrder, true, true>(F.lds, g, S, E);
            if (F.bid >= (66 * 13) % 256) { FRESH(); conv_n(F, N_CV_INP); }
        }
        SEAM(base + 0);
        if (PB(3) && IN(base + 1)) REP(3) {
            FRESH();
            for (int u = F.bid; u < 1056; u += F.G) {
                const int v = u < 528 ? u : u - 528; const int b = v / 264, hh = (v / NCH) & 3, cc = v % NCH;
                if (u < 528) unit_retkv(F, L, b, hh, cc); else if (!(L == DEPTH - 1 && cc < 2)) unit_sg(F, L, b, hh, cc);
            }
        }
        SEAM(base + 1);
        if (PB(5) && IN(base + 3)) REP(5) { FRESH(); ph_scan(F, L); }
        SEAM(base + 3);
        if (PB(6) && IN(base + 4)) REP(6) {
            FRESH();
            for (int u = F.bid; u < 264 + 528; u += F.G) {
                if (u < 264) {
                    int b, hh, qrow0, seq;
                    if (u < 256) { const int bh = u & 7, qb = u >> 3; b = bh >> 2; hh = bh & 3; qrow0 = b * SEQ + qb * 256; seq = NKEY; }
                    else { if (L == DEPTH - 1) continue; const int v = u - 256; b = v >> 2; hh = v & 3; qrow0 = NLAT + b * CTXL; seq = CTXL; }
#ifndef NO_ATTN
                    unit_attn(F, L, b, hh, qrow0, seq);
#endif
                } else {
#ifndef NO_RETOUT
                    const int v = u - 264; if (!(L == DEPTH - 1 && (v % NCH) < 2)) unit_retout(F, L, v / 264, (v / NCH) & 3, v % NCH);
#endif
                }
            }
        }
        SEAM(base + 4);
        if (PB(7) && IN(base + 5)) REP(7) {
            pg8::Gemm g{F.MIX(), F.WOUT() + (size_t)L * DM * DM, NLAT, DM, DM}; pg8::StaticOrder S; S.init(NLAT, DM, F.G, F.bid);
#ifdef PROBE_OUT2
            { EpiResid E0{(bf16*)(F.ws + WS_Y), F.MOD() + (size_t)L * 3 * 6144 + 2048, L == 0 ? F.x_in() : nullptr}; pg8::gemm_phase<EpiResid, pg8::StaticOrder, true, true>(F.lds, g, S, E0); }
#endif
            EpiResid E{F.X(), F.MOD() + (size_t)L * 3 * 6144 + 2048, L == 0 ? F.x_in() : nullptr};
            pg8::gemm_phase<EpiResid, pg8::StaticOrder, true, true>(F.lds, g, S, E);
            if (L < DEPTH - 1) { FRESH(); for (int mu = F.bid; mu < 256; mu += F.G) unit_out_ctx(F, L, mu); }
        }
        SEAM(base + 5);
        if (PB(8) && IN(base + 6)) REP(8) { FRESH(); ph_norm2_router(F, L); if (F.bid >= (((L == DEPTH - 1) ? NLAT : NROW) / 16 + NWAVES - 1) / NWAVES) conv_n(F, N_CV_N2); }
        SEAM(base + 6);
        if (PB(9) && IN(base + 7)) REP(9) { FRESH(); ph_topk(F, L); if (F.bid >= ((L == DEPTH - 1) ? 32 : 64)) conv_n(F, N_CV_TOPK);
            conv_until(F, CONV_SEG0 + (unsigned)(L + 1) * CONV_PER_L); }
        SEAM(base + 7);
        if (PB(11) && IN(base + 9)) REP(11) {
            pg8::Gemm g{F.HN(), F.WGU() + (size_t)L * NE * 4096 * DM, NE * EROWS, NE * 4096, DM};        const int npm = (L == DEPTH - 1) ? 8 : 9; MoeOrder S{F.G, F.bid, 16, npm, NE * npm * 16};
            EpiSwiglu E{F.HH()};
            pg8::gemm_phase_ga<EpiSwiglu, MoeOrder>(F.lds, g, S, E, F.ROWIDX(), NROW, (LAS int*)(F.lds + ISLOT_OFF));
        }
        SEAM(base + 9);
        if (PB(12) && IN(base + 10)) REP(12) {
            pg8::Gemm g{F.HH(), F.WD() + (size_t)L * NE * DM * FF, NE * EROWS, NE * DM, FF}; const int npm = (L == DEPTH - 1) ? 8 : 9; MoeOrder S{F.G, F.bid, 4, npm, NE * npm * 4};
            pg8::EpiBf16<0> E{F.Y(), DM, nullptr, DM, 0, 1.f};
            pg8::gemm_phase<pg8::EpiBf16<0>, MoeOrder, true, true>(F.lds, g, S, E);
            if (L < DEPTH - 1 && F.bid >= 64) { FRESH(); conv_n(F, N_CV_DOWN); }
        }
        SEAM(base + 10);
        if (PB(13) && IN(base + 11)) REP(13) { FRESH(); ph_combine(F, L); }
        SEAM(base + 11);
    }
#undef IN
#undef SEAM
}

extern "C" void kernel_launch(void* const* d_in, const int* in_sizes, int n_in, void* d_out, int out_size, void* d_ws, size_t ws_size, hipStream_t stream) {
    static int grid = 0;
    if (grid == 0) {
        if (n_in != 25 || in_sizes[0] != NLAT * DM || out_size != NLAT * DM || ws_size < WS_END) {
            fprintf(stderr, "kernel_launch: built for 25 inputs, x/out of %d floats, >= %zu bytes of workspace; got n_in %d, in0 %d, out %d, ws %zu; nothing launched\n", NLAT * DM, (size_t)WS_END, n_in, n_in > 0 ? in_sizes[0] : -1, out_size, ws_size);
            grid = -1; return; }
        int dev = 0, cus = 0, per_cu = 0;
        if (hipGetDevice(&dev) != hipSuccess || hipDeviceGetAttribute(&cus, hipDeviceAttributeMultiprocessorCount, dev) != hipSuccess) { fprintf(stderr, "kernel_launch: device query failed\n"); grid = -1; return; }
        if (hipFuncSetAttribute((const void*)fwd, hipFuncAttributeMaxDynamicSharedMemorySize, LDS_BYTES) != hipSuccess) { fprintf(stderr, "kernel_launch: hipFuncSetAttribute failed\n"); grid = -1; return; }
        if (hipOccupancyMaxActiveBlocksPerMultiprocessor(&per_cu, (const void*)fwd, NTHR, LDS_BYTES) != hipSuccess || per_cu < 1)
            fprintf(stderr, "kernel_launch: note: occupancy query reports %d workgroups per CU\n", per_cu);
        (void)hipGetLastError();
        grid = cus;
    }
    if (grid < 0) return;
    if (hipMemsetAsync((char*)d_ws + WS_CTL, 0, CTL_ZERO_BYTES, stream) != hipSuccess) { fprintf(stderr, "kernel_launch: memset failed\n"); return; }
    Args a{};
    for (int i = 0; i < 25; ++i) a.in[i] = (const float*)d_in[i];
    a.out = (float*)d_out; a.ws = (unsigned char*)d_ws;
#if MK_ONE_LAUNCH
    a.gp_lo = 0; a.gp_hi = NPHASE;
    hipLaunchKernelGGL(fwd, dim3(grid), dim3(NTHR), LDS_BYTES, stream, a);
#else
    for (int gp = 0; gp < NPHASE; ++gp) { a.gp_lo = gp; a.gp_hi = gp + 1; hipLaunchKernelGGL(fwd, dim3(grid), dim3(NTHR), LDS_BYTES, stream, a); }
#endif
    const hipError_t le = hipPeekAtLastError();
    if (le != hipSuccess) fprintf(stderr, "kernel_launch: launch failed: %s\n", hipGetErrorName(le));
}
```

```cpp
#include <hip/hip_runtime.h>
#include <cstdio>
#include <cstdint>
#ifndef MK_ONE_LAUNCH
#define MK_ONE_LAUNCH 1
#endif
namespace pg8 {
#define PG8_LAS __attribute__((address_space(3)))
typedef unsigned short bf16_t;
typedef short bf16x8 __attribute__((ext_vector_type(8)));
typedef float f32x4 __attribute__((ext_vector_type(4)));
typedef unsigned u32x4 __attribute__((ext_vector_type(4)));
constexpr int BM = 256, BK = 64, HALF = 128, HTB = HALF * BK * 2  , STAGE_BYTES = 8 * HTB, NXCD = 8, WGM = 8;

__host__ __device__ __forceinline__ int lds_byte(int r, int c) { const int st = (r >> 4) * 2 + (c >> 5), rr = r & 15, cc = c & 31, ob = rr * 64 + cc * 2; return st * 1024 + (ob ^ (((ob >> 9) & 1) << 5)); }
__host__ __device__ __forceinline__ void stage_rc(int b, int& R, int& C) { const int st = b / 1024, sb = b % 1024, swz = sb ^ (((sb >> 9) & 1) << 5); R = (st >> 1) * 16 + swz / 64; C = (st & 1) * 32 + (swz % 64) / 2; }
__host__ __device__ __forceinline__ int perm32(int rho) { const int n = rho >> 4, i = rho & 15; return 8 * (i >> 2) + 4 * n + (i & 3); }

struct Unit { int pm, pn; };
struct Gemm { const bf16_t* A; const bf16_t* Bt; int M, N, K; };

struct StaticOrder {
    int nM, nN, nwg, G, c;
    __host__ __device__ void init(int M, int N, int G_, int c_) { nM = M / BM; nN = N / BM; nwg = nM * nN; G = G_; c = c_; }
    __host__ __device__ bool next(int i, Unit& u) const {
        const long L = (long)i * G + c; if (L >= nwg) return false;
        int wgid = (int)L; { const int q = nwg / NXCD, r = nwg % NXCD, xcd = wgid % NXCD, off = wgid / NXCD; wgid = (xcd < r ? xcd * (q + 1) : r * (q + 1) + (xcd - r) * q) + off; }
        const int nig = WGM * nN, gid = wgid / nig, fm = gid * WGM, gsz = (nM - fm) < WGM ? (nM - fm) : WGM;
        u.pm = fm + ((wgid % nig) % gsz); u.pn = (wgid % nig) / gsz; return true;
    }
    __device__ __forceinline__ void a_ready(const Unit&) const {}
    __device__ __forceinline__ void done(const Unit&) const {}
    __device__ __forceinline__ bool half_only(const Unit&) const { return false; }
};

__device__ __forceinline__ unsigned cvt_pk_bf16(float lo, float hi) { unsigned r; asm volatile("v_cvt_pk_bf16_f32 %0, %1, %2" : "=v"(r) : "v"(lo), "v"(hi)); return r; }
typedef float f32x2 __attribute__((ext_vector_type(2)));
__device__ __forceinline__ f32x2 gelu_pk(f32x2 v) {
    const f32x2 av = __builtin_elementwise_abs(v), d = av * 0.2316418882f + 1.0f;
    f32x2 t; t.x = __builtin_amdgcn_rcpf(d.x); t.y = __builtin_amdgcn_rcpf(d.y);
    f32x2 q = t * 0.5307027145f + (-0.7265760135f); q = q * t + 0.7107068705f; q = q * t + (-0.142248368f); q = q * t + 0.127414796f; q = q * t;
    const f32x2 s = (v * v) * (-0.72134752044f);
    f32x2 e; e.x = __builtin_amdgcn_exp2f(s.x); e.y = __builtin_amdgcn_exp2f(s.y);
    const f32x2 m = v * (q * e), r = v - m;
    f32x2 o; o.x = v.x < 0.f ? m.x : r.x; o.y = v.y < 0.f ? m.y : r.y; return o;
}

template <int ACT  > struct EpiBf16 {
    static constexpr bool PERM = true, AFTER_DRAIN = false; static_assert(ACT == 0 || ACT == 1, "EpiBf16: ACT is 0 (none) or 1 (gelu_pk)");
    bf16_t* O; int ldc; const float* bias; int split_cols; size_t split_stride; float scale0;
    __device__ __forceinline__ void operator()(const f32x4 (&acc)[2][2][4][2], const Unit& u, int wr, int wc, int fr, int fq) const {
        const int row0 = u.pm * BM + wr * 64 + fr; int colt = u.pn * BM; bf16_t* base = O;
        float sc = 1.f; if (split_cols) { const int t = colt / split_cols; base += (size_t)t * split_stride; colt -= t * split_cols; if (t == 0) sc = scale0; }
        const int col0 = colt + wc * 32 + 8 * fq, bcol0 = u.pn * BM + wc * 32 + 8 * fq;
        f32x4 bv[2][2];
#pragma unroll
        for (int bj = 0; bj < 2; ++bj)
#pragma unroll
            for (int n = 0; n < 2; ++n) bv[bj][n] = bias ? *(const f32x4*)(bias + bcol0 + bj * HALF + 4 * n) : (f32x4){0.f, 0.f, 0.f, 0.f};
#pragma unroll
        for (int ai = 0; ai < 2; ++ai)
#pragma unroll
            for (int m = 0; m < 4; ++m) { bf16_t* rowp = base + (size_t)(row0 + ai * HALF + m * 16) * ldc + col0;
#pragma unroll
                for (int bj = 0; bj < 2; ++bj) { f32x4 v0 = acc[ai][bj][m][0] + bv[bj][0], v1 = acc[ai][bj][m][1] + bv[bj][1];
                    if (ACT == 1) { f32x2 a = gelu_pk((f32x2){v0[0], v0[1]}), b = gelu_pk((f32x2){v0[2], v0[3]}), c = gelu_pk((f32x2){v1[0], v1[1]}), d = gelu_pk((f32x2){v1[2], v1[3]});
                        v0 = (f32x4){a.x, a.y, b.x, b.y}; v1 = (f32x4){c.x, c.y, d.x, d.y}; }
                    v0 = v0 * sc; v1 = v1 * sc; u32x4 w; w.x = cvt_pk_bf16(v0[0], v0[1]); w.y = cvt_pk_bf16(v0[2], v0[3]); w.z = cvt_pk_bf16(v1[0], v1[1]); w.w = cvt_pk_bf16(v1[2], v1[3]);
                    *(u32x4*)(rowp + bj * HALF) = w; } }
    }
};
template <class Epi, class Sched, bool ALIGN_EPI = false, bool SP2 = false>
__device__ __forceinline__ void gemm_phase(PG8_LAS unsigned char* lds, const Gemm g, const Sched& S, const Epi& E) {
    int tid = threadIdx.x; asm volatile("" : "+v"(tid));
    const int wid = __builtin_amdgcn_readfirstlane(tid >> 6), lane = tid & 63, wr = wid >> 2, wc = wid & 3, fr = lane & 15, fq = lane >> 4;
    const int K = g.K, nt = K / BK;
    unsigned voffA[2], voffB[2];
#pragma unroll
    for (int i = 0; i < 2; ++i) { int R, C; stage_rc(tid * 16 + i * 8192, R, C); const int Rb = Epi::PERM ? ((R & ~31) + perm32(R & 31)) : R;
        voffA[i] = (unsigned)(R * K + C) * 2u; voffB[i] = (unsigned)(Rb * K + C) * 2u; }
    const size_t kstep = (size_t)(BK * 2);
    const size_t hstep = (size_t)HALF * K * 2;
    const size_t tstep = 2 * hstep;
    const unsigned ldsw = (unsigned)wid * 1024u;
    const int aoff = lds_byte(wr * 64 + fr, fq * 8), boff = lds_byte(wc * 32 + fr, fq * 8);
#define PG8_SA(b, h) (((b) * 2 + (h)) * HTB)
#define PG8_SB(b, h) ((4 + (b) * 2 + (h)) * HTB)
#define PG8_STAGE(bufoff, gbase, voff) do { _Pragma("unroll") for (int _i = 0; _i < 2; ++_i) \
        __builtin_amdgcn_global_load_lds((const unsigned*)((const char*)(gbase) + (voff)[_i]), (PG8_LAS unsigned*)(lds + (bufoff) + ldsw + _i * 8192), 16, 0, 0); } while (0)
#define PG8_LDA(dst, b, h) do { _Pragma("unroll") for (int m = 0; m < 4; ++m) _Pragma("unroll") for (int k = 0; k < 2; ++k) dst[m][k] = *(const PG8_LAS bf16x8*)(lds + PG8_SA(b, h) + aoff + m * 2048 + k * 1024); } while (0)
#define PG8_LDB(dst, b, h) do { _Pragma("unroll") for (int n = 0; n < 2; ++n) _Pragma("unroll") for (int k = 0; k < 2; ++k) dst[n][k] = *(const PG8_LAS bf16x8*)(lds + PG8_SB(b, h) + boff + n * 2048 + k * 1024); } while (0)
#define PG8_MMA(ai, bj, At, Bt) do { __builtin_amdgcn_s_setprio(1); _Pragma("unroll") for (int m = 0; m < 4; ++m) _Pragma("unroll") for (int n = 0; n < 2; ++n) _Pragma("unroll") for (int k = 0; k < 2; ++k) \
        acc[ai][bj][m][n] = __builtin_amdgcn_mfma_f32_16x16x32_bf16(Bt[n][k], At[m][k], acc[ai][bj][m][n], 0, 0, 0); __builtin_amdgcn_s_setprio(0); } while (0)
#define PG8_WAIT_V(n) asm volatile("s_waitcnt vmcnt(" #n ")" ::: "memory")
#define PG8_WAIT_L(n) asm volatile("s_waitcnt lgkmcnt(" #n ")" ::: "memory")
#define PG8_BAR __builtin_amdgcn_s_barrier()
#define PG8_SCHED __builtin_amdgcn_sched_barrier(0)
    Unit cur, nxt; int ui = 0;
    if (!S.next(0, cur)) return;
    f32x4 acc[2][2][4][2];
#pragma unroll
    for (int a = 0; a < 2; ++a)
#pragma unroll
        for (int b = 0; b < 2; ++b)
#pragma unroll
            for (int m = 0; m < 4; ++m)
#pragma unroll
                for (int n = 0; n < 2; ++n) acc[a][b][m][n] = (f32x4){0.f, 0.f, 0.f, 0.f};
    bf16x8 At[4][2], B0[2][2], B1[2][2];
    const char* cA = (const char*)g.A + (size_t)cur.pm * tstep; const char* cB = (const char*)g.Bt + (size_t)cur.pn * tstep;
    S.a_ready(cur);
    if constexpr (SP2) {
        PG8_STAGE(PG8_SB(0, 0), cB, voffB); PG8_STAGE(PG8_SB(0, 1), cB + hstep, voffB); PG8_STAGE(PG8_SA(0, 0), cA, voffA); PG8_STAGE(PG8_SA(0, 1), cA + hstep, voffA);
        if (wr == 1) PG8_BAR;
        PG8_WAIT_V(2); PG8_BAR;
        PG8_STAGE(PG8_SB(1, 0), cB + kstep, voffB); PG8_STAGE(PG8_SA(1, 0), cA + kstep, voffA); PG8_STAGE(PG8_SB(1, 1), cB + hstep + kstep, voffB);
        PG8_WAIT_V(6); PG8_BAR;
    } else {
        PG8_STAGE(PG8_SB(0, 0), cB, voffB); PG8_STAGE(PG8_SA(0, 0), cA, voffA); PG8_STAGE(PG8_SB(0, 1), cB + hstep, voffB); PG8_STAGE(PG8_SA(0, 1), cA + hstep, voffA);
        if (wr == 1) PG8_BAR;
        PG8_WAIT_V(4); PG8_BAR;
        PG8_STAGE(PG8_SB(1, 0), cB + kstep, voffB); PG8_STAGE(PG8_SA(1, 0), cA + kstep, voffA); PG8_STAGE(PG8_SB(1, 1), cB + hstep + kstep, voffB);
        PG8_WAIT_V(6); PG8_BAR;
    }
    for (;;) {
        const bool has_next = S.next(ui + 1, nxt);
        const bool ho = S.half_only(cur);
        const char* nA = has_next ? (const char*)g.A + (size_t)nxt.pm * tstep : cA; const char* nB = has_next ? (const char*)g.Bt + (size_t)nxt.pn * tstep : cB;
        for (int t = 0; t < nt; t += 2) {
            const bool last = (t == nt - 2);
            const char* a1 = cA + (size_t)(t + 1) * kstep;
            const char* a2 = last ? nA : cA + (size_t)(t + 2) * kstep; const char* b2 = last ? nB : cB + (size_t)(t + 2) * kstep;
            const char* a3 = a2 + kstep; const char* b3 = b2 + kstep;
            if (last && has_next) S.a_ready(nxt);
            if constexpr (SP2) {
            PG8_LDB(B0, 0, 0); PG8_LDB(B1, 0, 1); PG8_SCHED; PG8_LDA(At, 0, 0); PG8_STAGE(PG8_SA(1, 1), a1 + hstep, voffA);
            PG8_WAIT_V(8); PG8_WAIT_L(0); PG8_BAR; PG8_MMA(0, 0, At, B0); PG8_MMA(0, 1, At, B1); PG8_BAR; PG8_SCHED;
            PG8_LDA(At, 0, 1); PG8_STAGE(PG8_SB(0, 0), b2, voffB); PG8_STAGE(PG8_SB(0, 1), b2 + hstep, voffB); PG8_STAGE(PG8_SA(0, 0), a2, voffA);
            PG8_WAIT_V(8); PG8_WAIT_L(0); PG8_BAR; if (!ho) { PG8_MMA(1, 0, At, B0); PG8_MMA(1, 1, At, B1); } PG8_BAR; PG8_SCHED;
            PG8_LDB(B0, 1, 0); PG8_LDB(B1, 1, 1); PG8_SCHED; PG8_LDA(At, 1, 0); PG8_STAGE(PG8_SA(0, 1), a2 + hstep, voffA);
            PG8_WAIT_V(8); PG8_WAIT_L(0); PG8_BAR; PG8_MMA(0, 0, At, B0); PG8_MMA(0, 1, At, B1); PG8_BAR; PG8_SCHED;
            PG8_LDA(At, 1, 1); PG8_STAGE(PG8_SB(1, 0), b3, voffB); PG8_STAGE(PG8_SB(1, 1), b3 + hstep, voffB); PG8_STAGE(PG8_SA(1, 0), a3, voffA);
            PG8_WAIT_V(8); PG8_WAIT_L(0); PG8_BAR; if (!ho) { PG8_MMA(1, 0, At, B0); PG8_MMA(1, 1, At, B1); } PG8_BAR; PG8_SCHED;
            } else {
            PG8_LDB(B0, 0, 0); PG8_SCHED; PG8_LDA(At, 0, 0); PG8_STAGE(PG8_SA(1, 1), a1 + hstep, voffA);
            PG8_WAIT_L(8); PG8_BAR; PG8_WAIT_L(0); PG8_MMA(0, 0, At, B0); PG8_BAR; PG8_SCHED;
            PG8_LDB(B1, 0, 1); PG8_STAGE(PG8_SB(0, 0), b2, voffB);
            PG8_BAR; PG8_WAIT_L(0); PG8_MMA(0, 1, At, B1); PG8_BAR;
            PG8_LDA(At, 0, 1); PG8_STAGE(PG8_SA(0, 0), a2, voffA);
            PG8_BAR; PG8_WAIT_L(0); PG8_MMA(1, 0, At, B0); PG8_BAR; PG8_SCHED;
            PG8_STAGE(PG8_SB(0, 1), b2 + hstep, voffB);
            PG8_WAIT_V(6); PG8_BAR; PG8_MMA(1, 1, At, B1); PG8_BAR;
            PG8_LDB(B0, 1, 0); PG8_SCHED; PG8_LDA(At, 1, 0); PG8_STAGE(PG8_SA(0, 1), a2 + hstep, voffA);
            PG8_WAIT_L(8); PG8_BAR; PG8_WAIT_L(0); PG8_MMA(0, 0, At, B0); PG8_BAR; PG8_SCHED;
            PG8_LDB(B1, 1, 1); PG8_STAGE(PG8_SB(1, 0), b3, voffB);
            PG8_BAR; PG8_WAIT_L(0); PG8_MMA(0, 1, At, B1); PG8_BAR;
            PG8_LDA(At, 1, 1); PG8_STAGE(PG8_SA(1, 0), a3, voffA);
            PG8_BAR; PG8_WAIT_L(0); PG8_MMA(1, 0, At, B0); PG8_BAR; PG8_SCHED;
            PG8_STAGE(PG8_SB(1, 1), b3 + hstep, voffB);
            PG8_WAIT_V(6); PG8_BAR; PG8_MMA(1, 1, At, B1); PG8_BAR;
            }
        }
        if constexpr (ALIGN_EPI) { if (wr == 0) PG8_BAR; }
        if constexpr (!Epi::AFTER_DRAIN) { E(acc, cur, wr, wc, fr, fq); S.done(cur); }
        if (!has_next) break;
#pragma unroll
        for (int a = 0; a < 2; ++a)
#pragma unroll
            for (int b = 0; b < 2; ++b)
#pragma unroll
                for (int m = 0; m < 4; ++m)
#pragma unroll
                    for (int n = 0; n < 2; ++n) acc[a][b][m][n] = (f32x4){0.f, 0.f, 0.f, 0.f};
        cur = nxt; cA = nA; cB = nB; ++ui;
        if constexpr (ALIGN_EPI) { if (wr == 1) PG8_BAR; }
    }
    PG8_WAIT_V(0);
    if constexpr (!ALIGN_EPI) { if (wr == 0) PG8_BAR; }
    PG8_BAR;
    if constexpr (Epi::AFTER_DRAIN) { E.fused(acc, cur, wr, wc, fr, fq, lds, wid, lane); S.done(cur); }
#undef PG8_SA
#undef PG8_SB
#undef PG8_STAGE
#undef PG8_LDA
#undef PG8_LDB
#undef PG8_MMA
#undef PG8_WAIT_V
#undef PG8_WAIT_L
#undef PG8_BAR
#undef PG8_SCHED
}
}
namespace pg8 {
template <class Epi, class Sched>
__device__ __forceinline__ void gemm_phase_ga(PG8_LAS unsigned char* lds, const Gemm g, const Sched& S, const Epi& E, const int* rowidx, int zrow, PG8_LAS int* islot) {
    constexpr bool ALIGN_EPI = true;
    int tid = threadIdx.x; asm volatile("" : "+v"(tid));
    const int wid = __builtin_amdgcn_readfirstlane(tid >> 6), lane = tid & 63, wr = wid >> 2, wc = wid & 3, fr = lane & 15, fq = lane >> 4;
    const int K = g.K, nt = K / BK;
    unsigned voffB[2]; int RA[2], CA[2];
#pragma unroll
    for (int i = 0; i < 2; ++i) { int R, C; stage_rc(tid * 16 + i * 8192, R, C); const int Rb = Epi::PERM ? ((R & ~31) + perm32(R & 31)) : R;
        RA[i] = R; CA[i] = C; voffB[i] = (unsigned)(Rb * K + C) * 2u; }
    unsigned voC[2][2], voN[2][2];
    const size_t kstep = (size_t)(BK * 2);
    const size_t hstep = (size_t)HALF * K * 2;
    const size_t tstep = 2 * hstep;
    const unsigned ldsw = (unsigned)wid * 1024u;
    const int aoff = lds_byte(wr * 64 + fr, fq * 8), boff = lds_byte(wc * 32 + fr, fq * 8);
#define PG8_SA(b, h) (((b) * 2 + (h)) * HTB)
#define PG8_SB(b, h) ((4 + (b) * 2 + (h)) * HTB)
#define PG8_STAGE(bufoff, gbase, voff) do { _Pragma("unroll") for (int _i = 0; _i < 2; ++_i) \
        __builtin_amdgcn_global_load_lds((const unsigned*)((const char*)(gbase) + (voff)[_i]), (PG8_LAS unsigned*)(lds + (bufoff) + ldsw + _i * 8192), 16, 0, 0); } while (0)
#define PG8_LDA(dst, b, h) do { _Pragma("unroll") for (int m = 0; m < 4; ++m) _Pragma("unroll") for (int k = 0; k < 2; ++k) dst[m][k] = *(const PG8_LAS bf16x8*)(lds + PG8_SA(b, h) + aoff + m * 2048 + k * 1024); } while (0)
#define PG8_LDB(dst, b, h) do { _Pragma("unroll") for (int n = 0; n < 2; ++n) _Pragma("unroll") for (int k = 0; k < 2; ++k) dst[n][k] = *(const PG8_LAS bf16x8*)(lds + PG8_SB(b, h) + boff + n * 2048 + k * 1024); } while (0)
#define PG8_MMA(ai, bj, At, Bt) do { __builtin_amdgcn_s_setprio(1); _Pragma("unroll") for (int m = 0; m < 4; ++m) _Pragma("unroll") for (int n = 0; n < 2; ++n) _Pragma("unroll") for (int k = 0; k < 2; ++k) \
        acc[ai][bj][m][n] = __builtin_amdgcn_mfma_f32_16x16x32_bf16(Bt[n][k], At[m][k], acc[ai][bj][m][n], 0, 0, 0); __builtin_amdgcn_s_setprio(0); } while (0)
#define PG8_WAIT_V(n) asm volatile("s_waitcnt vmcnt(" #n ")" ::: "memory")
#define PG8_WAIT_L(n) asm volatile("s_waitcnt lgkmcnt(" #n ")" ::: "memory")
#define PG8_BAR __builtin_amdgcn_s_barrier()
#define PG8_SCHED __builtin_amdgcn_sched_barrier(0)
    constexpr bool SP2 = true;
    Unit cur, nxt; int ui = 0;
    if (!S.next(0, cur)) return;
    f32x4 acc[2][2][4][2];
#pragma unroll
    for (int a = 0; a < 2; ++a)
#pragma unroll
        for (int b = 0; b < 2; ++b)
#pragma unroll
            for (int m = 0; m < 4; ++m)
#pragma unroll
                for (int n = 0; n < 2; ++n) acc[a][b][m][n] = (f32x4){0.f, 0.f, 0.f, 0.f};
    bf16x8 At[4][2], B0[2][2], B1[2][2];
    const char* const Ab = (const char*)g.A; const char* cB = (const char*)g.Bt + (size_t)cur.pn * tstep;
    S.a_ready(cur);
#pragma unroll
    for (int h = 0; h < 2; ++h)
#pragma unroll
        for (int i = 0; i < 2; ++i) { const int s = rowidx[cur.pm * BM + h * HALF + RA[i]]; voC[h][i] = (unsigned)((s < 0 ? zrow : s) * K + CA[i]) * 2u; voN[h][i] = voC[h][i]; }
    asm volatile("s_waitcnt vmcnt(0)" ::: "memory");
    if constexpr (SP2) {
        PG8_STAGE(PG8_SB(0, 0), cB, voffB); PG8_STAGE(PG8_SB(0, 1), cB + hstep, voffB); PG8_STAGE(PG8_SA(0, 0), Ab, voC[0]); PG8_STAGE(PG8_SA(0, 1), Ab, voC[1]);
        if (wr == 1) PG8_BAR;
        PG8_WAIT_V(2); PG8_BAR;
        PG8_STAGE(PG8_SB(1, 0), cB + kstep, voffB); PG8_STAGE(PG8_SA(1, 0), Ab + kstep, voC[0]); PG8_STAGE(PG8_SB(1, 1), cB + hstep + kstep, voffB);
        PG8_WAIT_V(6); PG8_BAR;
    }
    for (;;) {
        const bool has_next = S.next(ui + 1, nxt);
        const bool ho = S.half_only(cur);
        const char* nB = has_next ? (const char*)g.Bt + (size_t)nxt.pn * tstep : cB;
        if (has_next && wid == 0) __builtin_amdgcn_global_load_lds((const unsigned*)(rowidx + nxt.pm * BM + lane * 4), (PG8_LAS unsigned*)(islot + ((ui + 1) & 1) * BM), 16, 0, 0);
        for (int t = 0; t < nt; t += 2) {
            const bool last = (t == nt - 2);
            const char* a1 = Ab + (size_t)(t + 1) * kstep;
            const char* a2 = last ? Ab : Ab + (size_t)(t + 2) * kstep; const char* b2 = last ? nB : cB + (size_t)(t + 2) * kstep;
            const char* a3 = a2 + kstep; const char* b3 = b2 + kstep;
            if (last && has_next) { S.a_ready(nxt);
                const PG8_LAS int* sl = islot + ((ui + 1) & 1) * BM;
#pragma unroll
                for (int h = 0; h < 2; ++h)
#pragma unroll
                    for (int i = 0; i < 2; ++i) { const int s = sl[h * HALF + RA[i]]; voN[h][i] = (unsigned)((s < 0 ? zrow : s) * K + CA[i]) * 2u; } }
            unsigned vo2[2][2];
#pragma unroll
            for (int h = 0; h < 2; ++h)
#pragma unroll
                for (int i = 0; i < 2; ++i) vo2[h][i] = last ? voN[h][i] : voC[h][i];
            if constexpr (SP2) {
            PG8_LDB(B0, 0, 0); PG8_LDB(B1, 0, 1); PG8_SCHED; PG8_LDA(At, 0, 0); PG8_STAGE(PG8_SA(1, 1), a1, voC[1]);
            PG8_WAIT_V(8); PG8_WAIT_L(0); PG8_BAR; PG8_MMA(0, 0, At, B0); PG8_MMA(0, 1, At, B1); PG8_BAR; PG8_SCHED;
            PG8_LDA(At, 0, 1); PG8_STAGE(PG8_SB(0, 0), b2, voffB); PG8_STAGE(PG8_SB(0, 1), b2 + hstep, voffB); PG8_STAGE(PG8_SA(0, 0), a2, vo2[0]);
            PG8_WAIT_V(8); PG8_WAIT_L(0); PG8_BAR; if (!ho) { PG8_MMA(1, 0, At, B0); PG8_MMA(1, 1, At, B1); } PG8_BAR; PG8_SCHED;
            PG8_LDB(B0, 1, 0); PG8_LDB(B1, 1, 1); PG8_SCHED; PG8_LDA(At, 1, 0); PG8_STAGE(PG8_SA(0, 1), a2, vo2[1]);
            PG8_WAIT_V(8); PG8_WAIT_L(0); PG8_BAR; PG8_MMA(0, 0, At, B0); PG8_MMA(0, 1, At, B1); PG8_BAR; PG8_SCHED;
            PG8_LDA(At, 1, 1); PG8_STAGE(PG8_SB(1, 0), b3, voffB); PG8_STAGE(PG8_SB(1, 1), b3 + hstep, voffB); PG8_STAGE(PG8_SA(1, 0), a3, vo2[0]);
            PG8_WAIT_V(8); PG8_WAIT_L(0); PG8_BAR; if (!ho) { PG8_MMA(1, 0, At, B0); PG8_MMA(1, 1, At, B1); } PG8_BAR; PG8_SCHED;
            }
        }
        if constexpr (ALIGN_EPI) { if (wr == 0) PG8_BAR; }
        if constexpr (!Epi::AFTER_DRAIN) { E(acc, cur, wr, wc, fr, fq); S.done(cur); }
        if (!has_next) break;
#pragma unroll
        for (int a = 0; a < 2; ++a)
#pragma unroll
            for (int b = 0; b < 2; ++b)
#pragma unroll
                for (int m = 0; m < 4; ++m)
#pragma unroll
                    for (int n = 0; n < 2; ++n) acc[a][b][m][n] = (f32x4){0.f, 0.f, 0.f, 0.f};
        cur = nxt; cB = nB; ++ui;
#pragma unroll
        for (int h = 0; h < 2; ++h)
#pragma unroll
            for (int i = 0; i < 2; ++i) voC[h][i] = voN[h][i];
        if constexpr (ALIGN_EPI) { if (wr == 1) PG8_BAR; }
    }
    PG8_WAIT_V(0);
    if constexpr (!ALIGN_EPI) { if (wr == 0) PG8_BAR; }
    PG8_BAR;
    if constexpr (Epi::AFTER_DRAIN) { E.fused(acc, cur, wr, wc, fr, fq, lds, wid, lane); S.done(cur); }
#undef PG8_SA
#undef PG8_SB
#undef PG8_STAGE
#undef PG8_LDA
#undef PG8_LDB
#undef PG8_MMA
#undef PG8_WAIT_V
#undef PG8_WAIT_L
#undef PG8_BAR
#undef PG8_SCHED
}
}

constexpr int DM = 1024, NB = 2, SEQ = 8192, CTXL = 256, DEPTH = 4;
constexpr int NLAT = NB * SEQ, NCTX = NB * CTXL, NROW = NLAT + NCTX;
constexpr int INC = 3328, NKEY = CTXL + SEQ;
constexpr int NE = 16, FF = 2048, EROWS = 2304;
constexpr int NCH = 66;
constexpr float EPS = 1e-6f;
constexpr int ZQ = 0, ZK = 512, ZV = 1024, ZRQ = 1536, ZRK = 1792, ZRV = 2048, ZGF = 2304, ZGB = 2560, ZSU = 2816, ZSV = 3072;
constexpr int NWAVES = 8, NTHR = 512;
constexpr int RWLD = DM + 8;

constexpr size_t MiB = 1u << 20;
constexpr size_t WS_CTL = 0, CTL_ZERO_BYTES = 1 * MiB;
constexpr size_t WS_MOD = 1 * MiB;
constexpr size_t WS_LP = WS_MOD + 512 * 1024;
constexpr size_t WS_ROPE = 2 * MiB, WS_RETT = 4 * MiB;
constexpr size_t WS_SGW = 6 * MiB;
constexpr size_t WS_RWS = 7 * MiB;
constexpr size_t WS_WIN = 8 * MiB;
constexpr size_t WS_WOUT = WS_WIN + 26 * MiB;
constexpr size_t WS_WGU = WS_WOUT + 8 * MiB;
constexpr size_t WS_WD = WS_WGU + 512 * MiB;
constexpr size_t WS_X = WS_WD + 256 * MiB;
constexpr size_t WS_HN = WS_X + 66 * MiB;
constexpr size_t WS_Z = WS_HN + 34 * MiB;
constexpr size_t WS_QH = WS_Z + 108 * MiB;
constexpr size_t WS_KH = WS_QH + 17 * MiB;
constexpr size_t WS_VH = WS_KH + 17 * MiB;
constexpr size_t WS_RQ = WS_VH + 17 * MiB;
constexpr size_t WS_RK = WS_RQ + 9 * MiB;
constexpr size_t WS_SVN = WS_RK + 9 * MiB;
constexpr size_t WS_KVT = WS_SVN + 9 * MiB;
constexpr size_t WS_SPREV = WS_KVT + 17 * MiB;
constexpr size_t WS_MIX = WS_SPREV + 17 * MiB;
constexpr size_t WS_SCR = WS_MIX + 33 * MiB;
constexpr size_t WS_AFF = WS_SCR + 32 * MiB;
constexpr size_t WS_SLOT = WS_AFF + 2 * MiB;
constexpr size_t WS_ROWIDX = WS_SLOT + 2 * MiB;
constexpr size_t WS_GATE = WS_ROWIDX + 1 * MiB;
constexpr size_t WS_XS = WS_GATE + 1 * MiB;
constexpr size_t WS_HH = WS_XS + 72 * MiB;
constexpr size_t WS_Y = WS_HH + 144 * MiB;
constexpr size_t WS_END = WS_Y + 72 * MiB;
static_assert((size_t)4 * INC * DM * 2 <= 26 * MiB && (size_t)NROW * DM * 4 <= 66 * MiB && (size_t)NROW * INC * 2 <= 108 * MiB && (size_t)NROW * 512 * 2 <= 17 * MiB, "ws map");
static_assert((size_t)NB * 4 * 2 * NCH * 4096 * 4 <= 17 * MiB && (size_t)NE * EROWS * DM * 2 <= 72 * MiB && (size_t)NE * EROWS * FF * 2 <= 144 * MiB, "ws map");
constexpr int CW_BAR = 4096;

constexpr int RING_BYTES = 131072;
constexpr int MISC_OFF = RING_BYTES + 320;
constexpr int ISLOT_OFF = RING_BYTES + 1024;
constexpr int LDS_BYTES = 147456;

#define GAS __attribute__((address_space(1)))
#define LAS __attribute__((address_space(3)))
typedef unsigned short bf16;
typedef unsigned v4u __attribute__((ext_vector_type(4)));
typedef float f32x4 __attribute__((ext_vector_type(4)));
typedef short bf16x8 __attribute__((ext_vector_type(8)));
typedef GAS unsigned gu32;
typedef GAS unsigned long long gu64;
#define RLX_AGENT __ATOMIC_RELAXED, __HIP_MEMORY_SCOPE_AGENT
#define LDS_WAIT() asm volatile("s_waitcnt lgkmcnt(0)" ::: "memory")
#define VM_WAIT() asm volatile("s_waitcnt vmcnt(0)" ::: "memory")
__device__ __forceinline__ unsigned long long rt() { return __builtin_amdgcn_s_memrealtime(); }
__device__ __forceinline__ unsigned f2bf(float f) { unsigned u = __builtin_bit_cast(unsigned, f); return (u + 0x7fffu + ((u >> 16) & 1u)) >> 16; }
__device__ __forceinline__ unsigned pk2(float lo, float hi) { return f2bf(lo) | (f2bf(hi) << 16); }

#define XB_TMO      128
#define XB_XCNT(j)  (256  + 64 * (j))
#define XB_XSUB(j)  (1280 + 64 * (j))
#define XB_XGEN(j)  (2304 + 64 * (j))
#define XB_TOP      3328
#define XB_TOPGEN   3392
#define XCD_BAR_WORDS 3456
#define XB_SPIN_CAP (1u << 18)

__device__ __forceinline__ unsigned xb_ld(unsigned* p)              { return __hip_atomic_load(p, __ATOMIC_RELAXED, __HIP_MEMORY_SCOPE_AGENT); }
__device__ __forceinline__ unsigned xb_add(unsigned* p, unsigned v) { return __hip_atomic_fetch_add(p, v, __ATOMIC_RELAXED, __HIP_MEMORY_SCOPE_AGENT); }
__device__ __forceinline__ unsigned xb_xcc_id() { return (unsigned)__builtin_amdgcn_s_getreg((3 << 11) | 20) & 0xFu; }
#define XB_SPIN(cond, bar) do { unsigned _sp = 0; while (cond) { __builtin_amdgcn_s_sleep(1); \
    if ((++_sp & 255u) == 0u) { if (xb_ld(&(bar)[XB_TMO])) break; if (_sp > XB_SPIN_CAP) { atomicAdd(&(bar)[XB_TMO], 1u); break; } } } } while (0)

struct XcdBarrier {
    unsigned* bar; unsigned x;
    volatile LAS unsigned* st;
};

__device__ __forceinline__ XcdBarrier xcd_barrier_post(unsigned* bar, volatile LAS unsigned* st) {
    XcdBarrier b; b.bar = bar; b.x = xb_xcc_id(); b.st = st;
    if (threadIdx.x == 0) (void)xb_add(&bar[XB_XCNT(b.x)], 1u);
    return b;
}
__device__ __forceinline__ void xcd_barrier_complete(unsigned* bar, unsigned x, unsigned& nloc, unsigned& nx) {
    const unsigned G = gridDim.x * gridDim.y * gridDim.z;
    unsigned sum, cnt, mine, sp = 0u;
    for (;;) {
        sum = 0u; cnt = 0u; mine = 0u;
#pragma unroll
        for (unsigned j = 0; j < 16; ++j) { const unsigned c = xb_ld(&bar[XB_XCNT(j)]); sum += c; cnt += (c > 0u) ? 1u : 0u; mine = (j == x) ? c : mine; }
        if (sum == G) break;
        __builtin_amdgcn_s_sleep(1);
        if ((++sp & 255u) == 0u) { if (xb_ld(&bar[XB_TMO])) break; if (sp > XB_SPIN_CAP) { atomicAdd(&bar[XB_TMO], 1u); break; } }
    }
    nloc = mine > 0u ? mine : 1u; nx = cnt > 0u ? cnt : 1u;
}

__device__ __forceinline__ void xcd_barrier(const XcdBarrier& b) {
    asm volatile("s_waitcnt vmcnt(0)" ::: "memory");
    __syncthreads();
    if (threadIdx.x == 0) {
        unsigned* bar = b.bar;
        __builtin_amdgcn_s_waitcnt(0);
        unsigned nloc = b.st[0], nx = b.st[1];
        if (nloc == 0u) { xcd_barrier_complete(bar, b.x, nloc, nx); b.st[0] = nloc; b.st[1] = nx; }
        const unsigned old = xb_add(&bar[XB_XSUB(b.x)], 1u);
        const unsigned gen = old / nloc;
        if (old + 1u == (gen + 1u) * nloc) {
            __builtin_amdgcn_fence(__ATOMIC_RELEASE, "agent");
            asm volatile("s_waitcnt vmcnt(0)" ::: "memory");
            const unsigned og = xb_add(&bar[XB_TOP], 1u);
            const unsigned tg = og / nx;
            if (og + 1u == (tg + 1u) * nx) xb_add(&bar[XB_TOPGEN], 1u);
            else XB_SPIN(xb_ld(&bar[XB_TOPGEN]) == tg, bar);
            __builtin_amdgcn_fence(__ATOMIC_ACQUIRE, "agent");
            xb_add(&bar[XB_XGEN(b.x)], 1u);
            asm volatile("s_waitcnt vmcnt(0)" ::: "memory");
        } else {
            XB_SPIN(xb_ld(&bar[XB_XGEN(b.x)]) == gen, bar);
            __builtin_amdgcn_fence(__ATOMIC_ACQUIRE, "agent");
            asm volatile("s_waitcnt vmcnt(0)" ::: "memory");
        }
    }
    __syncthreads();
}

typedef float f32x16 __attribute__((ext_vector_type(16)));
typedef short s16x4 __attribute__((ext_vector_type(4)));
typedef unsigned short u16x4 __attribute__((ext_vector_type(4)));
struct Frame {
    LAS unsigned char* lds;
    int tid, lane, wave, bid, G;
    const float* const* in;
    float* out;
    unsigned char* ws;
    __device__ __forceinline__ const float* x_in() const { return in[0]; }
    __device__ __forceinline__ const float* c_in() const { return in[1]; }
    __device__ __forceinline__ const float* ctx_in() const { return in[2]; }
    __device__ __forceinline__ const float* cctx_in() const { return in[3]; }
    __device__ __forceinline__ const float* w_mod() const { return in[4]; }
    __device__ __forceinline__ const float* b_mod() const { return in[5]; }
    __device__ __forceinline__ const float* n1g() const { return in[6]; }
    __device__ __forceinline__ const float* n2g() const { return in[7]; }
    __device__ __forceinline__ const float* w_in() const { return in[8]; }
    __device__ __forceinline__ const float* w_out() const { return in[9]; }
    __device__ __forceinline__ const float* qng() const { return in[10]; }
    __device__ __forceinline__ const float* kng() const { return in[11]; }
    __device__ __forceinline__ const float* lq1() const { return in[12]; }
    __device__ __forceinline__ const float* lk1() const { return in[13]; }
    __device__ __forceinline__ const float* lq2() const { return in[14]; }
    __device__ __forceinline__ const float* lk2() const { return in[15]; }
    __device__ __forceinline__ const float* subg() const { return in[16]; }
    __device__ __forceinline__ const float* retd() const { return in[17]; }
    __device__ __forceinline__ const float* sgng() const { return in[18]; }
    __device__ __forceinline__ const float* sgw() const { return in[19]; }
    __device__ __forceinline__ const float* sgb() const { return in[20]; }
    __device__ __forceinline__ const float* rw() const { return in[21]; }
    __device__ __forceinline__ const float* wg() const { return in[22]; }
    __device__ __forceinline__ const float* wu() const { return in[23]; }
    __device__ __forceinline__ const float* wd() const { return in[24]; }
    __device__ __forceinline__ float* MOD() const { return (float*)(ws + WS_MOD); }
    __device__ __forceinline__ float* LP() const { return (float*)(ws + WS_LP); }
    __device__ __forceinline__ float* ROPE() const { return (float*)(ws + WS_ROPE); }
    __device__ __forceinline__ float* RETT() const { return (float*)(ws + WS_RETT); }
    __device__ __forceinline__ bf16* X() const { return (bf16*)(ws + WS_X); }
    __device__ __forceinline__ float* KVT() const { return (float*)(ws + WS_KVT); }
    __device__ __forceinline__ bf16* SPREV() const { return (bf16*)(ws + WS_SPREV); }
    __device__ __forceinline__ float* SCR() const { return (float*)(ws + WS_SCR); }
    __device__ __forceinline__ float* AFF() const { return (float*)(ws + WS_AFF); }
    __device__ __forceinline__ float* GATE() const { return (float*)(ws + WS_GATE); }
    __device__ __forceinline__ bf16* SGW() const { return (bf16*)(ws + WS_SGW); }
    __device__ __forceinline__ bf16* WIN() const { return (bf16*)(ws + WS_WIN); }
    __device__ __forceinline__ bf16* WOUT() const { return (bf16*)(ws + WS_WOUT); }
    __device__ __forceinline__ bf16* WGU() const { return (bf16*)(ws + WS_WGU); }
    __device__ __forceinline__ bf16* WD() const { return (bf16*)(ws + WS_WD); }
    __device__ __forceinline__ bf16* HN() const { return (bf16*)(ws + WS_HN); }
    __device__ __forceinline__ bf16* Z() const { return (bf16*)(ws + WS_Z); }
    __device__ __forceinline__ bf16* QH() const { return (bf16*)(ws + WS_QH); }
    __device__ __forceinline__ bf16* KH() const { return (bf16*)(ws + WS_KH); }
    __device__ __forceinline__ bf16* VH() const { return (bf16*)(ws + WS_VH); }
    __device__ __forceinline__ bf16* RQ() const { return (bf16*)(ws + WS_RQ); }
    __device__ __forceinline__ bf16* RK() const { return (bf16*)(ws + WS_RK); }
    __device__ __forceinline__ bf16* SVN() const { return (bf16*)(ws + WS_SVN); }
    __device__ __forceinline__ bf16* MIX() const { return (bf16*)(ws + WS_MIX); }
    __device__ __forceinline__ bf16* XS() const { return (bf16*)(ws + WS_XS); }
    __device__ __forceinline__ bf16* HH() const { return (bf16*)(ws + WS_HH); }
    __device__ __forceinline__ bf16* Y() const { return (bf16*)(ws + WS_Y); }
    __device__ __forceinline__ bf16* RWS() const { return (bf16*)(ws + WS_RWS); }
    __device__ __forceinline__ int* SLOT() const { return (int*)(ws + WS_SLOT); }
    __device__ __forceinline__ int* ROWIDX() const { return (int*)(ws + WS_ROWIDX); }
};
__device__ __forceinline__ float bf2f(bf16 v) { return __builtin_bit_cast(float, (unsigned)v << 16); }
__device__ __forceinline__ float wave_sum(float v) {
#pragma unroll
    for (int o = 1; o < 64; o <<= 1) v += __shfl_xor(v, o);
    return v;
}
__device__ __forceinline__ float half_sum32(float v) {
#pragma unroll
    for (int o = 1; o < 32; o <<= 1) v += __shfl_xor(v, o);
    return v;
}
__device__ __forceinline__ float wave_max(float v) {
#pragma unroll
    for (int o = 1; o < 64; o <<= 1) v = fmaxf(v, __shfl_xor(v, o));
    return v;
}
__device__ __forceinline__ int crow(int r, int hi) { return (r & 3) + 8 * (r >> 2) + 4 * hi; }
__device__ __forceinline__ float gelu_t(float x) {
    const float u = 0.7978845608028654f * (x + 0.044715f * x * x * x);
    const float t = 1.f - 2.f * __builtin_amdgcn_rcpf(1.f + __expf(2.f * u));
    return 0.5f * x * (1.f + t);
}
__device__ __forceinline__ float silu_f(float x) { return x * __builtin_amdgcn_rcpf(1.f + __expf(-x)); }
__device__ __forceinline__ int row_vec(int r) { return r < SEQ ? 0 : (r < NLAT ? 1 : 2); }
__device__ __forceinline__ int chunk_row0(int b, int cc) { return cc < 2 ? NLAT + b * CTXL + cc * 128 : b * SEQ + (cc - 2) * 128; }

__device__ __forceinline__ f32x16 mma_nt(const LAS bf16* A, int lda, const LAS bf16* B, int ldb, int K, f32x16 acc, int lane) {
    const int r = lane & 31, h = lane >> 5;
#pragma unroll 2
    for (int k0 = 0; k0 < K; k0 += 16) {
        const bf16x8 a = *(const LAS bf16x8*)(A + r * lda + k0 + 8 * h);
        const bf16x8 b = *(const LAS bf16x8*)(B + r * ldb + k0 + 8 * h);
        acc = __builtin_amdgcn_mfma_f32_32x32x16_bf16(a, b, acc, 0, 0, 0);
    }
    return acc;
}

constexpr float QSCALE = 0.125f * 1.4426950408889634f;
struct EpiResid {
    static constexpr bool PERM = true, AFTER_DRAIN = false;
    bf16* X; const float* modg;
    const float* Xin;
    __device__ __forceinline__ void operator()(const pg8::f32x4 (&acc)[2][2][4][2], const pg8::Unit& u, int wr, int wc, int fr, int fq) const {
        const int row0 = u.pm * 256 + wr * 64 + fr, col0 = u.pn * 256 + wc * 32 + 8 * fq;
        const int v = u.pm < 32 ? 0 : (u.pm < 64 ? 1 : 2);
        pg8::f32x4 gv[2][2];
#pragma unroll
        for (int bj = 0; bj < 2; ++bj)
#pragma unroll
            for (int n = 0; n < 2; ++n) gv[bj][n] = *(const pg8::f32x4*)(modg + v * 6144 + col0 + bj * 128 + 4 * n);
        const bool in32 = Xin != nullptr;
#pragma unroll
        for (int ai = 0; ai < 2; ++ai)
#pragma unroll
            for (int m = 0; m < 4; ++m) { const size_t off = (size_t)(row0 + ai * 128 + m * 16) * DM + col0;
#pragma unroll
                for (int bj = 0; bj < 2; ++bj) {
                    pg8::f32x4 x0, x1;
                    if (in32) { x0 = *(const pg8::f32x4*)(Xin + off + bj * 128); x1 = *(const pg8::f32x4*)(Xin + off + bj * 128 + 4); }
                    else { const pg8::u32x4 w = *(const pg8::u32x4*)(X + off + bj * 128);
                        x0 = (pg8::f32x4){__builtin_bit_cast(float, w.x << 16), __builtin_bit_cast(float, w.x & 0xffff0000u), __builtin_bit_cast(float, w.y << 16), __builtin_bit_cast(float, w.y & 0xffff0000u)};
                        x1 = (pg8::f32x4){__builtin_bit_cast(float, w.z << 16), __builtin_bit_cast(float, w.z & 0xffff0000u), __builtin_bit_cast(float, w.w << 16), __builtin_bit_cast(float, w.w & 0xffff0000u)}; }
                    x0 = x0 + gv[bj][0] * acc[ai][bj][m][0]; x1 = x1 + gv[bj][1] * acc[ai][bj][m][1];
                    pg8::u32x4 o; o.x = pg8::cvt_pk_bf16(x0.x, x0.y); o.y = pg8::cvt_pk_bf16(x0.z, x0.w); o.z = pg8::cvt_pk_bf16(x1.x, x1.y); o.w = pg8::cvt_pk_bf16(x1.z, x1.w);
                    *(pg8::u32x4*)(X + off + bj * 128) = o; } }
    }
};
struct EpiZ {
    static constexpr bool PERM = true, AFTER_DRAIN = false;
    bf16* Z; bf16* VH; bf16* QH; bf16* KH; const float* gqk; const float* rope;
    __device__ __forceinline__ void operator()(const pg8::f32x4 (&acc)[2][2][4][2], const pg8::Unit& u, int wr, int wc, int fr, int fq) const {
        if (u.pn < 4) {
            const bool isk = u.pn >= 2; const int grp = (u.pn & 1) * 4 + wc;
            const float* g = gqk + (isk ? 64 : 0); const float sc = isk ? 1.f : QSCALE;
            float ga[2][8];
#pragma unroll
            for (int bj = 0; bj < 2; ++bj)
#pragma unroll
                for (int e = 0; e < 8; ++e) ga[bj][e] = g[32 * bj + 8 * fq + e] * sc;
            const bool first = fq < 2; const int i16 = 8 * (fq & 1);
            const bool lat = u.pm < 64;
#pragma unroll
            for (int ai = 0; ai < 2; ++ai) {
                float rc[8], rn[8];
                if (lat) { const float* T = rope + (size_t)(((u.pm * 256 + ai * 128 + wr * 64) & (SEQ - 1)) & ~63) * 64 + i16;
                    const pg8::f32x4 c0 = *(const pg8::f32x4*)T, c1 = *(const pg8::f32x4*)(T + 4), s0 = *(const pg8::f32x4*)(T + 32), s1 = *(const pg8::f32x4*)(T + 36);
#pragma unroll
                    for (int e = 0; e < 4; ++e) { rc[e] = c0[e]; rc[4 + e] = c1[e]; rn[e] = s0[e]; rn[4 + e] = s1[e]; } }
#pragma unroll
                for (int m = 0; m < 4; ++m) {
                    float ccm[8], cnm[8];
                    if (lat) { const float* T = rope + (size_t)(m * 16 + fr) * 64 + 16 + i16;
                        const pg8::f32x4 c0 = *(const pg8::f32x4*)T, c1 = *(const pg8::f32x4*)(T + 4), s0 = *(const pg8::f32x4*)(T + 32), s1 = *(const pg8::f32x4*)(T + 36);
#pragma unroll
                        for (int e = 0; e < 4; ++e) { ccm[e] = c0[e]; ccm[4 + e] = c1[e]; cnm[e] = s0[e]; cnm[4 + e] = s1[e]; } }
                    const int r = u.pm * 256 + ai * 128 + wr * 64 + m * 16 + fr;
                    const int b = lat ? (r >> 13) : ((r - NLAT) >> 8), n = lat ? (r & (SEQ - 1)) : ((r - NLAT) & (CTXL - 1));
                    float v[2][8]; float ss = 0.f;
#pragma unroll
                    for (int bj = 0; bj < 2; ++bj)
#pragma unroll
                        for (int e = 0; e < 8; ++e) { v[bj][e] = acc[ai][bj][m][e >> 2][e & 3]; ss += v[bj][e] * v[bj][e]; }
                    ss += __shfl_xor(ss, 16);
                    { const auto sw = __builtin_amdgcn_permlane32_swap(__float_as_uint(ss), __float_as_uint(ss), false, false); ss = __uint_as_float(sw[0]) + __uint_as_float(sw[1]); }
                    const float rinv = __builtin_amdgcn_rsqf(ss * (1.f / 64.f) + EPS);
                    bf16* dst = (isk ? KH + ((size_t)b * NKEY + (lat ? CTXL + n : n)) * 512 : QH + (size_t)r * 512) + grp * 64 + 8 * fq;
#pragma unroll
                    for (int bj = 0; bj < 2; ++bj) {
                        float y[8], o[8];
#pragma unroll
                        for (int e = 0; e < 8; ++e) y[e] = v[bj][e] * rinv * ga[bj][e];
                        if (lat) {
#pragma unroll
                            for (int e = 0; e < 8; ++e) { const auto sw = __builtin_amdgcn_permlane32_swap(__float_as_uint(y[e]), __float_as_uint(y[e]), false, false);
                                const float pp = __uint_as_float(first ? sw[1] : sw[0]); const float c = bj ? ccm[e] : rc[e], s = bj ? cnm[e] : rn[e];
                                o[e] = first ? y[e] * c - pp * s : pp * s + y[e] * c; }
                        } else {
#pragma unroll
                            for (int e = 0; e < 8; ++e) o[e] = y[e];
                        }
                        pg8::u32x4 w; w.x = pg8::cvt_pk_bf16(o[0], o[1]); w.y = pg8::cvt_pk_bf16(o[2], o[3]); w.z = pg8::cvt_pk_bf16(o[4], o[5]); w.w = pg8::cvt_pk_bf16(o[6], o[7]);
                        *(pg8::u32x4*)(dst + 32 * bj) = w;
                    }
                }
            }
            return;
        }
        const bool isv = (u.pn == 4) | (u.pn == 5);
        const size_t prow0 = isv ? (u.pm < 64 ? (size_t)u.pm * 256 + (size_t)((u.pm >> 5) + 1) * CTXL : (size_t)(u.pm - 64) * NKEY) : (size_t)u.pm * 256;
        bf16* base = isv ? VH + (u.pn - 4) * 256 : Z + u.pn * 256; const int ldc = isv ? 512 : INC;
        const int col0 = wc * 32 + 8 * fq;
#pragma unroll
        for (int ai = 0; ai < 2; ++ai)
#pragma unroll
            for (int m = 0; m < 4; ++m) { bf16* rowp = base + (prow0 + wr * 64 + fr + ai * 128 + m * 16) * ldc + col0;
#pragma unroll
                for (int bj = 0; bj < 2; ++bj) { const pg8::f32x4 v0 = acc[ai][bj][m][0], v1 = acc[ai][bj][m][1];
                    pg8::u32x4 w; w.x = pg8::cvt_pk_bf16(v0[0], v0[1]); w.y = pg8::cvt_pk_bf16(v0[2], v0[3]); w.z = pg8::cvt_pk_bf16(v1[0], v1[1]); w.w = pg8::cvt_pk_bf16(v1[2], v1[3]);
                    *(pg8::u32x4*)(rowp + bj * 128) = w; } }
    }
};
struct EpiSwiglu {
    static constexpr bool PERM = true, AFTER_DRAIN = false;
    bf16* H;
    __device__ __forceinline__ void operator()(const pg8::f32x4 (&acc)[2][2][4][2], const pg8::Unit& u, int wr, int wc, int fr, int fq) const {
        const int row0 = u.pm * 256 + wr * 64 + fr, col0 = (u.pn & 15) * 128 + wc * 32 + 8 * fq;
#pragma unroll
        for (int ai = 0; ai < 2; ++ai)
#pragma unroll
            for (int m = 0; m < 4; ++m) { bf16* rowp = H + (size_t)(row0 + ai * 128 + m * 16) * FF + col0;
                float h[8];
#pragma unroll
                for (int n = 0; n < 2; ++n)
#pragma unroll
                    for (int i = 0; i < 4; ++i) { const float g = acc[ai][0][m][n][i], up = acc[ai][1][m][n][i]; h[4 * n + i] = silu_f(g) * up; }
                pg8::u32x4 w; w.x = pg8::cvt_pk_bf16(h[0], h[1]); w.y = pg8::cvt_pk_bf16(h[2], h[3]); w.z = pg8::cvt_pk_bf16(h[4], h[5]); w.w = pg8::cvt_pk_bf16(h[6], h[7]);
                *(pg8::u32x4*)rowp = w; }
    }
};
struct MoeOrder {
    int G, c, npn, npm, total;
    __device__ __forceinline__ bool next(int i, pg8::Unit& u) const {
        const int per = npm * npn;
        if ((G & 7) == 0) {
            const int W = G >> 3, x = c & 7, r = c >> 3, q = i * W + r;
            if (q >= 2 * per) return false;
            const int e = 2 * x + q / per, rem = q % per, pn = rem / npm, pm = rem % npm;
            u.pm = e * 9 + pm; u.pn = e * npn + pn; return true;
        }
        const long L = (long)i * G + c; if (L >= total) return false;
        const int e = (int)L / per, rem = (int)L % per; const int pn = rem / npm, pm = rem % npm;
        u.pm = e * 9 + pm; u.pn = e * npn + pn; return true;
    }
    __device__ __forceinline__ void a_ready(const pg8::Unit&) const {}
    __device__ __forceinline__ void done(const pg8::Unit&) const {}
    __device__ __forceinline__ bool half_only(const pg8::Unit& u) const { return (u.pm % 9) == 8; }
};

__device__ __forceinline__ void transpose_item(const float* W, int N, bf16* WT, int K, int k0, int n0, size_t drow0, LAS float* scr, int lane) {
    f32x4 v[8];
#pragma unroll
    for (int i = 0; i < 8; ++i) v[i] = __builtin_nontemporal_load((const f32x4*)(W + (size_t)(k0 + 8 * i + (lane >> 3)) * N + n0 + 4 * (lane & 7)));
#pragma unroll
    for (int i = 0; i < 8; ++i) { LAS float* d = scr + (8 * i + (lane >> 3)) * 33 + 4 * (lane & 7); d[0] = v[i].x; d[1] = v[i].y; d[2] = v[i].z; d[3] = v[i].w; }
    LDS_WAIT(); asm volatile("" ::: "memory");
    const int c = lane & 7;
#pragma unroll
    for (int j = 0; j < 4; ++j) { const int n = (lane >> 3) + 8 * j; const LAS float* s = scr + (8 * c) * 33 + n;
        v4u o; o.x = pk2(s[0 * 33], s[1 * 33]); o.y = pk2(s[2 * 33], s[3 * 33]); o.z = pk2(s[4 * 33], s[5 * 33]); o.w = pk2(s[6 * 33], s[7 * 33]);
        *(GAS v4u*)(WT + (drow0 + n) * K + k0 + 8 * c) = o; }
    LDS_WAIT(); asm volatile("" ::: "memory");
}
constexpr unsigned CV_IN = 16 * 104, CV_OUT = 16 * 32, CV_EX = 1024;
constexpr unsigned CONV_SEG0 = DEPTH * (CV_IN + CV_OUT), CONV_PER_L = 3 * NE * CV_EX, CONV_TOTAL = CONV_SEG0 + DEPTH * CONV_PER_L;
constexpr int CW_Q = 64;
static_assert(CONV_TOTAL % 64 == 0, "whole batches");
__device__ __forceinline__ void conv_item(const Frame& F, unsigned it, LAS float* scr, int lane) {
    if (it < DEPTH * CV_IN) { const int L = it / CV_IN, q = it % CV_IN, kb = q / 104, nb = q % 104, n0 = nb * 32;
        const size_t drow0 = n0 < 1024 ? (size_t)(n0 & ~255) + 128 * ((n0 & 63) >> 5) + 32 * ((n0 & 255) >> 6) : (size_t)n0;
        transpose_item(F.w_in() + (size_t)L * DM * INC, INC, F.WIN() + (size_t)L * INC * DM, DM, kb * 64, n0, drow0, scr, lane); return; }
    it -= DEPTH * CV_IN;
    if (it < DEPTH * CV_OUT) { const int L = it / CV_OUT, q = it % CV_OUT, kb = q / 32, nb = q % 32;
        transpose_item(F.w_out() + (size_t)L * DM * DM, DM, F.WOUT() + (size_t)L * DM * DM, DM, kb * 64, nb * 32, (size_t)nb * 32, scr, lane); return; }
    it -= DEPTH * CV_OUT;
    const int L = it / CONV_PER_L, q0 = it % CONV_PER_L, kind = q0 / (NE * CV_EX), r = q0 % (NE * CV_EX), le = L * NE + r / CV_EX, q = r % CV_EX;
    if (kind < 2) { const int kb = q / 64, nb = q % 64, n0 = nb * 32;
        const size_t drow0 = (size_t)(n0 >> 7) * 256 + (n0 & 127) + (kind ? 128 : 0);
        transpose_item((kind ? F.wu() : F.wg()) + (size_t)le * DM * FF, FF, F.WGU() + (size_t)le * 4096 * DM, DM, kb * 64, n0, drow0, scr, lane); }
    else { const int kb = q / 32, nb = q % 32;
        transpose_item(F.wd() + (size_t)le * FF * DM, DM, F.WD() + (size_t)le * DM * FF, FF, kb * 64, nb * 32, (size_t)nb * 32, scr, lane); }
}
__device__ __forceinline__ bool conv_batch(const Frame& F) {
    LAS unsigned* bc = (LAS unsigned*)(F.lds + MISC_OFF + 64);
    LAS float* scr = (LAS float*)(F.lds + 32768 + F.wave * 8704);
    if (F.tid == 0) *bc = __hip_atomic_fetch_add((unsigned*)(F.ws + WS_CTL) + CW_Q, 64u, __ATOMIC_RELAXED, __HIP_MEMORY_SCOPE_AGENT);
    __syncthreads();
    const unsigned base = *bc;
    __syncthreads();
    if (base >= CONV_TOTAL) return false;
    for (int k = 0; k < 8; ++k) conv_item(F, base + 8 * k + F.wave, scr, F.lane);
    return true;
}
__device__ __forceinline__ void conv_n(const Frame& F, int n) { for (int i = 0; i < n; ++i) if (!conv_batch(F)) break; __syncthreads(); }
__device__ __forceinline__ void conv_until(const Frame& F, unsigned target) {
    for (;;) {
        const unsigned h = __hip_atomic_load((unsigned*)(F.ws + WS_CTL) + CW_Q, __ATOMIC_RELAXED, __HIP_MEMORY_SCOPE_AGENT);
        LAS unsigned* bc = (LAS unsigned*)(F.lds + MISC_OFF + 68);
        if (F.tid == 0) *bc = h;
        __syncthreads();
        const unsigned hh = *bc;
        __syncthreads();
        if (hh >= target) break;
        if (!conv_batch(F)) break;
    }
}
__device__ __forceinline__ void ph_prologue(const Frame& F) {
    const int tid = F.tid, lane = F.lane, wave = F.wave;
    LAS float* sc = (LAS float*)F.lds;
    LAS float* red = sc + 3072;
    for (int i = tid; i < 3072; i += NTHR) { const int v = i >> 10, k = i & 1023; const float c = v < 2 ? F.c_in()[v * DM + k] : F.cctx_in()[k]; sc[i] = c / (1.f + expf(-c)); }
    __syncthreads();
    for (int t = F.bid; t < 384; t += F.G) {
        const int L = t / 96, j0 = (t % 96) * 64;
        const float* W = F.w_mod() + (size_t)L * DM * 6144 + j0 + lane;
        float a0 = 0.f, a1 = 0.f, a2 = 0.f;
#pragma unroll 8
        for (int kk = 0; kk < 128; ++kk) { const int k = wave * 128 + kk; const float w = W[(size_t)k * 6144]; a0 += sc[k] * w; a1 += sc[1024 + k] * w; a2 += sc[2048 + k] * w; }
        red[(wave * 3 + 0) * 64 + lane] = a0; red[(wave * 3 + 1) * 64 + lane] = a1; red[(wave * 3 + 2) * 64 + lane] = a2;
        __syncthreads();
        if (tid < 192) { const int v = tid >> 6, l = tid & 63; float s = 0.f;
#pragma unroll
            for (int w = 0; w < 8; ++w) s += red[(w * 3 + v) * 64 + l];
            F.MOD()[(size_t)(L * 3 + v) * 6144 + j0 + l] = s + F.b_mod()[L * 6144 + j0 + l]; }
        __syncthreads();
    }
    if (F.bid == 0 && wave == 0) {
        for (int L = 0; L < DEPTH; ++L) {
            const float d1 = wave_sum(F.lq1()[L * 64 + lane] * F.lk1()[L * 64 + lane]), d2 = wave_sum(F.lq2()[L * 64 + lane] * F.lk2()[L * 64 + lane]);
            const float linit = 0.8f - 0.6f * expf(-0.3f * (float)L);
            if (lane == 0) { F.LP()[L * 16 + 0] = expf(d1) - expf(d2) + linit; F.LP()[L * 16 + 1] = 1.f - linit; }
            if (lane < 8) { const float xd = F.retd()[L * 8 + lane]; F.LP()[L * 16 + 2 + lane] = -log1pf(expf(-xd)); }
            F.LP()[DEPTH * 16 + L * 128 + lane] = F.qng()[L * 64 + lane]; F.LP()[DEPTH * 16 + L * 128 + 64 + lane] = F.kng()[L * 64 + lane];
            { const float mq = wave_max(fabsf(F.qng()[L * 64 + lane])), mk = wave_max(fabsf(F.kng()[L * 64 + lane])); if (lane == 0) F.LP()[L * 16 + 10] = 64.f * mq * mk * 1.02f; }
        }
    }
    const int gw = F.bid * NWAVES + wave, NGW = F.G * NWAVES;
    {
        const int i16 = lane & 15, which = lane >> 4, i32 = lane & 31;
        const float inv_a = powf(10000.f, -(float)i16 / 16.f);
        const float inv_r = 1.f / powf(10000.f, (float)i32 / 31.f);
        for (int n = gw; n < SEQ; n += NGW) {
            const float pos = (which & 1) ? (float)(n & 63) : (float)(n >> 6);
            const float ang = pos * inv_a;
            F.ROPE()[(size_t)n * 64 + lane] = (which < 2) ? (float)cos((double)ang) : (float)sin((double)ang);
            const float ang2 = (float)n * inv_r;
            F.RETT()[(size_t)n * 64 + lane] = (lane < 32) ? (float)cos((double)ang2) : (float)sin((double)ang2);
        }
    }
    if (F.bid == 0) for (int i = tid; i < DM / 2; i += NTHR) ((unsigned*)(F.HN() + (size_t)NROW * DM))[i] = 0u;
    for (int i = F.bid * NTHR + tid; i < DEPTH * 16 * DM; i += F.G * NTHR) { const int Lr = i / (16 * DM), q = i % (16 * DM), k = q >> 4, e = q & 15;
        const float w = F.rw()[i]; const unsigned h = f2bf(w); const float wl = w - __builtin_bit_cast(float, h << 16);
        F.RWS()[((size_t)(Lr * 2 + 0) * 16 + e) * RWLD + k] = (bf16)h; F.RWS()[((size_t)(Lr * 2 + 1) * 16 + e) * RWLD + k] = (bf16)f2bf(wl); }
    for (int i = F.bid * NTHR + tid; i < DEPTH * 4 * 128 * 128; i += F.G * NTHR) F.SGW()[i] = (bf16)f2bf(F.sgw()[i]);
    conv_until(F, CONV_SEG0);
}

__device__ __forceinline__ void ph_norm1_first(const Frame& F) {
    const int lane = F.lane, gw = F.bid * NWAVES + F.wave, NGW = F.G * NWAVES;
    for (int r = gw; r < NROW; r += NGW) {
        const float* src = r < NLAT ? F.x_in() + (size_t)r * DM : F.ctx_in() + (size_t)(r - NLAT) * DM;
        const float* mod = F.MOD() + (size_t)row_vec(r) * 6144;
        f32x4 v[4]; float ss = 0.f;
#pragma unroll
        for (int j = 0; j < 4; ++j) { v[j] = *(const f32x4*)(src + 4 * lane + 256 * j); ss += (v[j].x * v[j].x + v[j].y * v[j].y) + (v[j].z * v[j].z + v[j].w * v[j].w); }
        const float rinv = rsqrtf(wave_sum(ss) * (1.f / DM) + EPS);
#pragma unroll
        for (int j = 0; j < 4; ++j) { const int c = 4 * lane + 256 * j;
            const f32x4 g = *(const f32x4*)(F.n1g() + c), sh = *(const f32x4*)(mod + c), sc = *(const f32x4*)(mod + 1024 + c);
            const f32x4 h = v[j] * rinv * g * (sc + 1.f) + sh;
            *(unsigned long long*)(F.HN() + (size_t)r * DM + c) = (unsigned long long)pk2(h.x, h.y) | ((unsigned long long)pk2(h.z, h.w) << 32); }
    }
}

__device__ __forceinline__ void ph_prep(const Frame& F, int L) {
    const int lane = F.lane, gw = F.bid * NWAVES + F.wave, NGW = F.G * NWAVES;
    const int grp8 = lane >> 3, half = (lane >> 2) & 1, t4 = lane & 3, dA = half * 32 + 4 * t4;
    const f32x4 gqA = *(const f32x4*)(F.qng() + L * 64 + dA), gqB = *(const f32x4*)(F.qng() + L * 64 + dA + 16);
    const f32x4 gkA = *(const f32x4*)(F.kng() + L * 64 + dA), gkB = *(const f32x4*)(F.kng() + L * 64 + dA + 16);
    const int rsel = lane >> 5, rhead = (lane >> 3) & 3, t8 = lane & 7;
    const float rscale = rsel ? 0.125f : 1.f;
    const f32x4 sgn = *(const f32x4*)(F.sgng() + L * 256 + lane * 4);
    for (int r = gw; r < NROW; r += NGW) {
        const bf16* zr = F.Z() + (size_t)r * INC;
        const bool lat = r < NLAT; const int b = lat ? (r >> 13) : ((r - NLAT) >> 8), n = lat ? (r & (SEQ - 1)) : ((r - NLAT) & (CTXL - 1));
        const size_t krow = (size_t)b * NKEY + (lat ? CTXL + n : n);
        f32x4 cs = {1.f, 1.f, 1.f, 1.f}, sn = {0.f, 0.f, 0.f, 0.f}, cs2 = cs, sn2 = sn;
        if (lat) { const float* T = F.ROPE() + (size_t)n * 64; cs = *(const f32x4*)(T + half * 16 + 4 * t4); sn = *(const f32x4*)(T + 32 + half * 16 + 4 * t4);
                   const float* R = F.RETT() + (size_t)n * 64; cs2 = *(const f32x4*)(R + 4 * t8); sn2 = *(const f32x4*)(R + 32 + 4 * t8); }
#pragma unroll
        for (int pass = 0; pass < 2; ++pass) {
            const int col = pass * 512 + grp8 * 64 + dA;
            const u16x4 ra = *(const u16x4*)(zr + col), rb = *(const u16x4*)(zr + col + 16);
            f32x4 x1, x2; float ss = 0.f;
#pragma unroll
            for (int e = 0; e < 4; ++e) { x1[e] = bf2f(ra[e]); x2[e] = bf2f(rb[e]); ss += x1[e] * x1[e] + x2[e] * x2[e]; }
            ss += __shfl_xor(ss, 1); ss += __shfl_xor(ss, 2); ss += __shfl_xor(ss, 4);
            const float rinv = rsqrtf(ss * (1.f / 64.f) + EPS);
            const f32x4 y1 = x1 * rinv * (pass ? gkA : gqA * QSCALE), y2 = x2 * rinv * (pass ? gkB : gqB * QSCALE);
            const f32x4 o1 = y1 * cs - y2 * sn, o2 = y1 * sn + y2 * cs;
            bf16* dst = (pass ? F.KH() + krow * 512 : F.QH() + (size_t)r * 512) + grp8 * 64 + dA;
            *(unsigned long long*)dst = (unsigned long long)pk2(o1.x, o1.y) | ((unsigned long long)pk2(o1.z, o1.w) << 32);
            *(unsigned long long*)(dst + 16) = (unsigned long long)pk2(o2.x, o2.y) | ((unsigned long long)pk2(o2.z, o2.w) << 32);
        }
    }
}

__device__ __forceinline__ void ph_norm2_router(const Frame& F, int L) {
    const int lane = F.lane, tid = F.tid, gw = F.bid * NWAVES + F.wave, NGW = F.G * NWAVES;
    LAS bf16* rwl = (LAS bf16*)F.lds;
    { const bf16* src = F.RWS() + (size_t)L * 2 * 16 * RWLD;
      for (int i = tid; i < 2 * 16 * RWLD / 8; i += NTHR) *(LAS bf16x8*)(rwl + i * 8) = *(const bf16x8*)(src + i * 8); }
    __syncthreads();
    const int ntile = ((L == DEPTH - 1) ? NLAT : NROW) / 16;
    const int rr = lane & 15, kq = lane >> 4;
    for (int tile = gw; tile < ntile; tile += NGW) {
        const int r = tile * 16 + rr;
        const bf16* xr = F.X() + (size_t)r * DM + 8 * kq;
        const float* mod = F.MOD() + (size_t)(L * 3 + row_vec(tile * 16)) * 6144 + 8 * kq;
        const float* gn = F.n2g() + L * DM + 8 * kq;
        float ss = 0.f;
#pragma unroll 8
        for (int st = 0; st < 32; ++st) { const v4u w = *(const v4u*)(xr + 32 * st);
            const f32x4 a = {__builtin_bit_cast(float, w.x << 16), __builtin_bit_cast(float, w.x & 0xffff0000u), __builtin_bit_cast(float, w.y << 16), __builtin_bit_cast(float, w.y & 0xffff0000u)};
            const f32x4 c = {__builtin_bit_cast(float, w.z << 16), __builtin_bit_cast(float, w.z & 0xffff0000u), __builtin_bit_cast(float, w.w << 16), __builtin_bit_cast(float, w.w & 0xffff0000u)};
            ss += (a.x * a.x + a.y * a.y) + (a.z * a.z + a.w * a.w) + (c.x * c.x + c.y * c.y) + (c.z * c.z + c.w * c.w); }
        ss += __shfl_xor(ss, 16); ss += __shfl_xor(ss, 32);
        const float rinv = rsqrtf(ss * (1.f / DM) + EPS);
        f32x4 acc = {0.f, 0.f, 0.f, 0.f};
        bf16* hrow = F.HN() + (size_t)r * DM + 8 * kq;
#pragma unroll 4
        for (int st = 0; st < 32; ++st) {
            float f[8];
            const v4u xw = *(const v4u*)(xr + 32 * st);
#pragma unroll
            for (int q = 0; q < 2; ++q) { const unsigned w0 = q ? xw.z : xw.x, w1 = q ? xw.w : xw.y;
                const f32x4 xv = {__builtin_bit_cast(float, w0 << 16), __builtin_bit_cast(float, w0 & 0xffff0000u), __builtin_bit_cast(float, w1 << 16), __builtin_bit_cast(float, w1 & 0xffff0000u)};
                const f32x4 g = *(const f32x4*)(gn + 32 * st + 4 * q),
                                                      sh = *(const f32x4*)(mod + 3072 + 32 * st + 4 * q), sc = *(const f32x4*)(mod + 4096 + 32 * st + 4 * q);
                const f32x4 y = xv * rinv * g * (sc + 1.f) + sh; f[4 * q] = y.x; f[4 * q + 1] = y.y; f[4 * q + 2] = y.z; f[4 * q + 3] = y.w; }
            v4u hi, lo;
            hi.x = pk2(f[0], f[1]); hi.y = pk2(f[2], f[3]); hi.z = pk2(f[4], f[5]); hi.w = pk2(f[6], f[7]);
#define LOPK(w, i0, i1) pk2(f[i0] - __builtin_bit_cast(float, (w) << 16), f[i1] - __builtin_bit_cast(float, (w) & 0xffff0000u))
            lo.x = LOPK(hi.x, 0, 1); lo.y = LOPK(hi.y, 2, 3); lo.z = LOPK(hi.z, 4, 5); lo.w = LOPK(hi.w, 6, 7);
#undef LOPK
            *(v4u*)(hrow + 32 * st) = hi;
            const bf16x8 ah = __builtin_bit_cast(bf16x8, hi), al = __builtin_bit_cast(bf16x8, lo);
            const bf16x8 bh = *(const LAS bf16x8*)(rwl + rr * RWLD + 32 * st + 8 * kq), bl = *(const LAS bf16x8*)(rwl + (16 + rr) * RWLD + 32 * st + 8 * kq);
            acc = __builtin_amdgcn_mfma_f32_16x16x32_bf16(ah, bh, acc, 0, 0, 0);
            acc = __builtin_amdgcn_mfma_f32_16x16x32_bf16(ah, bl, acc, 0, 0, 0);
            acc = __builtin_amdgcn_mfma_f32_16x16x32_bf16(al, bh, acc, 0, 0, 0);
        }
#pragma unroll
        for (int q = 0; q < 4; ++q) {
            float mx = acc[q];
#pragma unroll
            for (int o = 1; o < 16; o <<= 1) mx = fmaxf(mx, __shfl_xor(mx, o));
            const float ex = expf(acc[q] - mx); float sum = ex;
#pragma unroll
            for (int o = 1; o < 16; o <<= 1) sum += __shfl_xor(sum, o);
            F.AFF()[(size_t)(tile * 16 + 4 * kq + q) * 16 + rr] = ex / sum;
        }
    }
    __syncthreads();
}

__device__ __forceinline__ unsigned block_excl_scan(unsigned v, LAS unsigned* wtot, int lane, int wave) {
    unsigned inc = v;
#pragma unroll
    for (int o = 1; o < 64; o <<= 1) { const unsigned t = __shfl_up(inc, o); if (lane >= o) inc += t; }
    if (lane == 63) wtot[wave] = inc;
    __syncthreads();
    unsigned off = 0;
    for (int w = 0; w < wave; ++w) off += wtot[w];
    __syncthreads();
    return off + inc - v;
}
__device__ __forceinline__ void ph_topk(const Frame& F, int L) {
    const int tid = F.tid, lane = F.lane, wave = F.wave;
    LAS unsigned* keys = (LAS unsigned*)F.lds;
    LAS unsigned* hist = keys + 8192;
    LAS unsigned* wtot = hist + 256;
    LAS unsigned* bc = wtot + 16;
    const int nprob = (L == DEPTH - 1) ? 32 : 64;
    for (int p = F.bid; p < 64; p += F.G) {
        const int s = p >> 4, e = p & 15;
        const int n = s < 2 ? SEQ : CTXL, k = n >> 3;
        const int base = s < 2 ? s * SEQ : NLAT + (s - 2) * CTXL;
        const int sbase = s == 0 ? 0 : (s == 1 ? 1024 : (s == 2 ? 2048 : 2080));
        if (p >= nprob) {
            for (int i = tid; i < 32; i += NTHR) { F.ROWIDX()[e * EROWS + sbase + i] = -1; F.GATE()[e * EROWS + sbase + i] = 0.f; }
            if (s == 3) for (int rr = 2112 + tid; rr < EROWS; rr += NTHR) { F.ROWIDX()[e * EROWS + rr] = -1; F.GATE()[e * EROWS + rr] = 0.f; }
            continue; }
        for (int i = tid; i < n; i += NTHR) keys[i] = __float_as_uint(F.AFF()[(size_t)(base + i) * 16 + e]);
        __syncthreads();
        unsigned prefix = 0u, mask = 0u, need = (unsigned)k;
        for (int pass = 0; pass < 4; ++pass) {
            const int shift = 24 - 8 * pass;
            if (tid < 256) hist[tid] = 0u;
            __syncthreads();
            for (int i = tid; i < n; i += NTHR) { const unsigned key = keys[i]; if ((key & mask) == prefix) atomicAdd((unsigned*)&hist[(key >> shift) & 255u], 1u); }
            __syncthreads();
            if (wave == 0) {
                const unsigned h0 = hist[4 * lane], h1 = hist[4 * lane + 1], h2 = hist[4 * lane + 2], h3 = hist[4 * lane + 3];
                const unsigned tot = h0 + h1 + h2 + h3;
                unsigned suf = tot;
#pragma unroll
                for (int o = 1; o < 64; o <<= 1) { const unsigned t = __shfl_down(suf, o); if (lane + o < 64) suf += t; }
                const unsigned above = suf - tot;
                if (suf >= need && above < need) {
                    unsigned rem = need - above, bsel;
                    if (rem <= h3) bsel = 3u; else { rem -= h3; if (rem <= h2) bsel = 2u; else { rem -= h2; if (rem <= h1) bsel = 1u; else { rem -= h1; bsel = 0u; } } }
                    bc[0] = 4u * lane + bsel; bc[1] = rem;
                }
            }
            __syncthreads();
            prefix |= bc[0] << shift; mask |= 255u << shift; need = bc[1];
            __syncthreads();
        }
        const unsigned T = prefix;
        const int per = n >= NTHR ? n / NTHR : 1;
        const int i0 = tid * per; const bool act = i0 < n;
        unsigned eqc = 0u;
        if (act) for (int q = 0; q < per; ++q) eqc += (keys[i0 + q] == T) ? 1u : 0u;
        unsigned eqr = block_excl_scan(eqc, wtot, lane, wave);
        unsigned selc = 0u;
        if (act) for (int q = 0; q < per; ++q) { const unsigned key = keys[i0 + q]; if (key > T) ++selc; else if (key == T) { if (eqr < need) ++selc; ++eqr; } }
        unsigned slot = block_excl_scan(selc, wtot, lane, wave);
        eqr -= eqc;
        if (act) for (int q = 0; q < per; ++q) {
            const unsigned key = keys[i0 + q]; bool sel = key > T;
            if (key == T) { sel = eqr < need; ++eqr; }
            const int tok = base + i0 + q;
            if (sel) { const int rr = sbase + (int)slot; ++slot; F.ROWIDX()[e * EROWS + rr] = tok; F.GATE()[e * EROWS + rr] = __uint_as_float(key); F.SLOT()[(size_t)tok * 16 + e] = rr; }
            else F.SLOT()[(size_t)tok * 16 + e] = -1;
        }
        if (s == 3) for (int rr = 2112 + tid; rr < EROWS; rr += NTHR) { F.ROWIDX()[e * EROWS + rr] = -1; F.GATE()[e * EROWS + rr] = 0.f; }
        __syncthreads();
    }
}

__device__ __forceinline__ void ph_gather(const Frame& F) {
    const int lane = F.lane, gw = F.bid * NWAVES + F.wave, NGW = F.G * NWAVES;
    for (int idx = gw; idx < NE * EROWS; idx += NGW) {
        const int src = F.ROWIDX()[idx];
        bf16x8 a = {0, 0, 0, 0, 0, 0, 0, 0}, b = a;
        if (src >= 0) { a = *(const bf16x8*)(F.HN() + (size_t)src * DM + 8 * lane); b = *(const bf16x8*)(F.HN() + (size_t)src * DM + 512 + 8 * lane); }
        *(bf16x8*)(F.XS() + (size_t)idx * DM + 8 * lane) = a; *(bf16x8*)(F.XS() + (size_t)idx * DM + 512 + 8 * lane) = b;
    }
}

__device__ __forceinline__ void ph_combine(const Frame& F, int L) {
    const int lane = F.lane, gw = F.bid * NWAVES + F.wave, NGW = F.G * NWAVES;
    const bool last = (L == DEPTH - 1);
    const int nrows = last ? NLAT : NROW;
    int sl_nx = (lane < 16 && gw < nrows) ? F.SLOT()[(size_t)gw * 16 + lane] : -1;
    for (int r = gw; r < nrows; r += NGW) {
        const int v = row_vec(r);
        const int sl = sl_nx;
        { const int rn = r + NGW; sl_nx = (lane < 16 && rn < nrows) ? F.SLOT()[(size_t)rn * 16 + lane] : -1; }
        const float* mod = F.MOD() + (size_t)(L * 3 + v) * 6144;
        f32x4 xv[4], g2[4];
#pragma unroll
        for (int j = 0; j < 2; ++j)
#pragma unroll
            for (int q = 0; q < 2; ++q) { const int c = 8 * lane + 512 * j + 4 * q; const unsigned long long w = *(const unsigned long long*)(F.X() + (size_t)r * DM + c);
                const unsigned w0 = (unsigned)w, w1 = (unsigned)(w >> 32);
                xv[2 * j + q] = (f32x4){__builtin_bit_cast(float, w0 << 16), __builtin_bit_cast(float, w0 & 0xffff0000u), __builtin_bit_cast(float, w1 << 16), __builtin_bit_cast(float, w1 & 0xffff0000u)};
                g2[2 * j + q] = *(const f32x4*)(mod + 5120 + c); }
        float acc[16];
#pragma unroll
        for (int i = 0; i < 16; ++i) acc[i] = 0.f;
        unsigned long long m = __ballot(sl >= 0);
        while (m) {
            const int e0 = __builtin_ctzll(m); m &= m - 1;
            const int e1 = m ? __builtin_ctzll(m) : -1; if (m) m &= m - 1;
            const int s0 = __shfl(sl, e0), s1 = e1 >= 0 ? __shfl(sl, e1) : 0;
            const float gv0 = F.GATE()[e0 * EROWS + s0]; const bf16* y0 = F.Y() + ((size_t)e0 * EROWS + s0) * DM;
            const bf16x8 a0 = *(const bf16x8*)(y0 + 8 * lane), a1 = *(const bf16x8*)(y0 + 8 * lane + 512);
            float gv1 = 0.f; bf16x8 b0 = {0, 0, 0, 0, 0, 0, 0, 0}, b1 = b0;
            if (e1 >= 0) { gv1 = F.GATE()[e1 * EROWS + s1]; const bf16* y1 = F.Y() + ((size_t)e1 * EROWS + s1) * DM; b0 = *(const bf16x8*)(y1 + 8 * lane); b1 = *(const bf16x8*)(y1 + 8 * lane + 512); }
#pragma unroll
            for (int i = 0; i < 8; ++i) { acc[i] += gv0 * bf2f((bf16)a0[i]); acc[8 + i] += gv0 * bf2f((bf16)a1[i]); }
            if (e1 >= 0) {
#pragma unroll
                for (int i = 0; i < 8; ++i) { acc[i] += gv1 * bf2f((bf16)b0[i]); acc[8 + i] += gv1 * bf2f((bf16)b1[i]); } }
        }
        float xn[16]; float ss = 0.f;
#pragma unroll
        for (int j = 0; j < 2; ++j)
#pragma unroll
            for (int q = 0; q < 2; ++q) { const int c = 8 * lane + 512 * j + 4 * q;
#pragma unroll
                for (int i = 0; i < 4; ++i) { const float t = xv[2 * j + q][i] + g2[2 * j + q][i] * acc[8 * j + 4 * q + i]; xn[8 * j + 4 * q + i] = t; ss += t * t; }
                const f32x4 o = {xn[8 * j + 4 * q], xn[8 * j + 4 * q + 1], xn[8 * j + 4 * q + 2], xn[8 * j + 4 * q + 3]};
                if (last) *(f32x4*)(F.out + (size_t)r * DM + c) = o;
                else *(unsigned long long*)(F.X() + (size_t)r * DM + c) = (unsigned long long)pk2(o.x, o.y) | ((unsigned long long)pk2(o.z, o.w) << 32); }
        if (!last) {
            const float rinv = rsqrtf(wave_sum(ss) * (1.f / DM) + EPS);
            const float* mod1 = F.MOD() + (size_t)((L + 1) * 3 + v) * 6144;
#pragma unroll
            for (int j = 0; j < 2; ++j) { const int c = 8 * lane + 512 * j; float h[8];
#pragma unroll
                for (int q = 0; q < 2; ++q) { const f32x4 g = *(const f32x4*)(F.n1g() + (L + 1) * DM + c + 4 * q), sh = *(const f32x4*)(mod1 + c + 4 * q), sc = *(const f32x4*)(mod1 + 1024 + c + 4 * q);
#pragma unroll
                    for (int i = 0; i < 4; ++i) h[4 * q + i] = xn[8 * j + 4 * q + i] * rinv * g[i] * (1.f + sc[i]) + sh[i]; }
                v4u w; w.x = pk2(h[0], h[1]); w.y = pk2(h[2], h[3]); w.z = pk2(h[4], h[5]); w.w = pk2(h[6], h[7]);
                *(v4u*)(F.HN() + (size_t)r * DM + c) = w; }
        }
    }
}


constexpr int LDP = 136, LDQK = 72;

__device__ __forceinline__ void ret_rot(const Frame& F, const bf16* zh, int p, bool lat, int n, float scale, float (&o1)[8], float (&o2)[8]) {
    const bf16x8 r1 = *(const bf16x8*)(zh + 8 * p), r2 = *(const bf16x8*)(zh + 32 + 8 * p);
    float cs[8], sn[8];
    if (lat) { const float* R = F.RETT() + (size_t)n * 64 + 8 * p; const f32x4 c0 = *(const f32x4*)R, c1 = *(const f32x4*)(R + 4), s0 = *(const f32x4*)(R + 32), s1 = *(const f32x4*)(R + 36);
#pragma unroll
        for (int i = 0; i < 4; ++i) { cs[i] = c0[i]; cs[4 + i] = c1[i]; sn[i] = s0[i]; sn[4 + i] = s1[i]; } }
    else {
#pragma unroll
        for (int i = 0; i < 8; ++i) { cs[i] = 1.f; sn[i] = 0.f; } }
#pragma unroll
    for (int i = 0; i < 8; ++i) { const float x1 = bf2f((bf16)r1[i]) * scale, x2 = bf2f((bf16)r2[i]) * scale; o1[i] = x1 * cs[i] - x2 * sn[i]; o2[i] = x1 * sn[i] + x2 * cs[i]; }
}
__device__ __forceinline__ void unit_retkv(const Frame& F, int L, int b, int h, int cc) {
    const int tid = F.tid, lane = F.lane, wave = F.wave;
    LAS bf16* vT = (LAS bf16*)F.lds;
    LAS bf16* kfT = vT + 64 * LDP;
    LAS bf16* kbT = kfT + 64 * LDP;
    const int row0 = chunk_row0(b, cc);
    const float lgf = F.LP()[L * 16 + 2 + h], lgb = F.LP()[L * 16 + 6 + h];
    { const int j = tid >> 2, p = tid & 3;
      const bf16* zr = F.Z() + (size_t)(row0 + j) * INC;
      float k1[8], k2[8];
      ret_rot(F, zr + ZRK + h * 64, p, cc >= 2, (cc - 2) * 128 + j, 0.125f, k1, k2);
      const bf16x8 v1 = *(const bf16x8*)(zr + ZRV + h * 64 + 8 * p), v2 = *(const bf16x8*)(zr + ZRV + h * 64 + 32 + 8 * p);
      const float df = __expf(lgf * (float)(127 - j)), db = __expf(lgb * (float)j);
#pragma unroll
      for (int i = 0; i < 8; ++i) { const int d1 = 8 * p + i, d2 = 32 + 8 * p + i;
          kfT[d1 * LDP + j] = (bf16)f2bf(k1[i] * df); kbT[d1 * LDP + j] = (bf16)f2bf(k1[i] * db); vT[d1 * LDP + j] = (bf16)v1[i];
          kfT[d2 * LDP + j] = (bf16)f2bf(k2[i] * df); kbT[d2 * LDP + j] = (bf16)f2bf(k2[i] * db); vT[d2 * LDP + j] = (bf16)v2[i]; } }
    __syncthreads();
    { const int dir = wave >> 2, ti = (wave >> 1) & 1, tj = wave & 1, r32 = lane & 31, hi = lane >> 5;
      f32x16 acc = {};
      acc = mma_nt(vT + ti * 32 * LDP, LDP, (dir ? kbT : kfT) + tj * 32 * LDP, LDP, 128, acc, lane);
      float* dst = F.KVT() + ((size_t)(((b * 4 + h) * 2 + dir) * NCH + cc)) * 4096;
#pragma unroll
      for (int x = 0; x < 16; ++x) dst[(ti * 32 + crow(x, hi)) * 64 + tj * 32 + r32] = acc[x]; }
    __syncthreads();
}

__device__ __forceinline__ void ph_scan(const Frame& F, int L) {
    const int t = F.bid * NTHR + F.tid;
    if (t < 65536) {
        const int elem = t & 4095, sq = t >> 12, dir = sq & 1, h = (sq >> 1) & 3, b = sq >> 3;
        const size_t base = (size_t)(((b * 4 + h) * 2 + dir) * NCH);
        const float decay = expf(F.LP()[L * 16 + 2 + dir * 4 + h] * 128.f);
        float kv[NCH];
#pragma unroll
        for (int step = 0; step < NCH; ++step) { const int cc = dir == 0 ? step : (step < 2 ? 1 - step : 67 - step); kv[step] = F.KVT()[(base + cc) * 4096 + elem]; }
        float s = 0.f;
#pragma unroll
        for (int step = 0; step < NCH; ++step) { const int cc = dir == 0 ? step : (step < 2 ? 1 - step : 67 - step);
            F.SPREV()[(base + cc) * 4096 + elem] = (bf16)f2bf(s); s = s * decay + kv[step]; }
    }
}

__device__ __forceinline__ void unit_retout(const Frame& F, int L, int b, int h, int cc) {
    int tid = F.tid; asm volatile("" : "+v"(tid));
    const int lane = tid & 63, wave = F.wave, r32 = lane & 31, hi = lane >> 5;
    LAS bf16* q_s = (LAS bf16*)F.lds;
    LAS bf16* k_s = q_s + 128 * LDQK;
    LAS bf16* vT = k_s + 128 * LDQK;
    LAS bf16* SfT = vT + 64 * LDP;
    LAS bf16* SbT = SfT + 64 * LDQK;
    LAS bf16* P = SbT + 64 * LDQK;
    LAS float* O_s = (LAS float*)P;
    constexpr int LDO = 66;
    const int row0 = chunk_row0(b, cc);
    const float lgf = F.LP()[L * 16 + 2 + h], lgb = F.LP()[L * 16 + 6 + h];
    { const int j = tid >> 2, p = tid & 3;
      const bf16* zr = F.Z() + (size_t)(row0 + j) * INC;
      float a1[8], a2[8];
      ret_rot(F, zr + ZRQ + h * 64, p, cc >= 2, (cc - 2) * 128 + j, 1.f, a1, a2);
      { v4u w; w.x = pk2(a1[0], a1[1]); w.y = pk2(a1[2], a1[3]); w.z = pk2(a1[4], a1[5]); w.w = pk2(a1[6], a1[7]); *(LAS v4u*)(q_s + j * LDQK + 8 * p) = w;
        w.x = pk2(a2[0], a2[1]); w.y = pk2(a2[2], a2[3]); w.z = pk2(a2[4], a2[5]); w.w = pk2(a2[6], a2[7]); *(LAS v4u*)(q_s + j * LDQK + 32 + 8 * p) = w; }
      ret_rot(F, zr + ZRK + h * 64, p, cc >= 2, (cc - 2) * 128 + j, 0.125f, a1, a2);
      { v4u w; w.x = pk2(a1[0], a1[1]); w.y = pk2(a1[2], a1[3]); w.z = pk2(a1[4], a1[5]); w.w = pk2(a1[6], a1[7]); *(LAS v4u*)(k_s + j * LDQK + 8 * p) = w;
        w.x = pk2(a2[0], a2[1]); w.y = pk2(a2[2], a2[3]); w.z = pk2(a2[4], a2[5]); w.w = pk2(a2[6], a2[7]); *(LAS v4u*)(k_s + j * LDQK + 32 + 8 * p) = w; }
      const bf16x8 v1 = *(const bf16x8*)(zr + ZRV + h * 64 + 8 * p), v2 = *(const bf16x8*)(zr + ZRV + h * 64 + 32 + 8 * p);
#pragma unroll
      for (int i = 0; i < 8; ++i) { vT[(8 * p + i) * LDP + j] = (bf16)v1[i]; vT[(32 + 8 * p + i) * LDP + j] = (bf16)v2[i]; } }
    { const bf16* sf = F.SPREV() + ((size_t)(((b * 4 + h) * 2 + 0) * NCH + cc)) * 4096;
      const bf16* sb = F.SPREV() + ((size_t)(((b * 4 + h) * 2 + 1) * NCH + cc)) * 4096;
      { const int dv = tid >> 3, c8 = (tid & 7) * 8;
          *(LAS v4u*)(SfT + dv * LDQK + c8) = *(const v4u*)(sf + dv * 64 + c8);
          *(LAS v4u*)(SbT + dv * LDQK + c8) = *(const v4u*)(sb + dv * 64 + c8); } }
    __syncthreads();
    const int sti = wave >> 1, stj0 = (wave & 1) * 2;
    f32x16 S0 = {}, S1 = {};
    S0 = mma_nt(q_s + sti * 32 * LDQK, LDQK, k_s + stj0 * 32 * LDQK, LDQK, 64, S0, lane);
    S1 = mma_nt(q_s + sti * 32 * LDQK, LDQK, k_s + (stj0 + 1) * 32 * LDQK, LDQK, 64, S1, lane);
    const int ei = tid >> 2, ec = (tid & 3) * 16;
    float yo[16];
#pragma unroll
    for (int dir = 0; dir < 2; ++dir) {
        const float lg = dir ? lgb : lgf;
#pragma unroll
        for (int x = 0; x < 16; ++x) { const int i = sti * 32 + crow(x, hi);
            const int j0 = stj0 * 32 + r32, j1 = j0 + 32; const int d0 = dir ? j0 - i : i - j0, d1 = dir ? j1 - i : i - j1;
            const float p0 = d0 >= 0 ? S0[x] * __expf(lg * (float)d0) : 0.f, p1 = d1 >= 0 ? S1[x] * __expf(lg * (float)d1) : 0.f;
            const unsigned pk = pg8::cvt_pk_bf16(p0, p1);
            P[i * LDP + j0] = (bf16)(pk & 0xffffu); P[i * LDP + j1] = (bf16)(pk >> 16);
            if ((x & 3) == 3) __builtin_amdgcn_sched_barrier(0); }
        __syncthreads();
        const int oti = wave >> 1, otj = wave & 1;
        f32x16 a0 = {}, c0 = {};
        { const LAS bf16* ST = dir ? SbT : SfT;
          a0 = mma_nt(P + oti * 32 * LDP, LDP, vT + otj * 32 * LDP, LDP, 128, a0, lane);
          c0 = mma_nt(q_s + oti * 32 * LDQK, LDQK, ST + otj * 32 * LDQK, LDQK, 64, c0, lane); }
        __syncthreads();
#pragma unroll
        for (int x = 0; x < 16; ++x) { const int i = oti * 32 + crow(x, hi);
            const float qd = __expf(lg * (float)(dir ? 128 - i : i + 1));
            O_s[i * LDO + otj * 32 + r32] = a0[x] + c0[x] * qd;
            if ((x & 3) == 3) __builtin_amdgcn_sched_barrier(0); }
        __syncthreads();
        { float o[16]; float s = 0.f;
#pragma unroll
          for (int c = 0; c < 16; ++c) { o[c] = O_s[ei * LDO + ec + c]; s += o[c]; }
          s += __shfl_xor(s, 1); s += __shfl_xor(s, 2);
          const float mu = s * (1.f / 64.f); float s2 = 0.f;
#pragma unroll
          for (int c = 0; c < 16; ++c) { o[c] -= mu; s2 += o[c] * o[c]; }
          s2 += __shfl_xor(s2, 1); s2 += __shfl_xor(s2, 2);
          const float rs = rsqrtf(s2 * (1.f / 64.f) + EPS);
          const bf16* zr = F.Z() + (size_t)(row0 + ei) * INC + (dir ? ZGB : ZGF) + h * 64 + ec;
          const bf16x8 ga = *(const bf16x8*)zr, gb = *(const bf16x8*)(zr + 8);
#pragma unroll
          for (int c = 0; c < 16; ++c) { const float g = bf2f((bf16)(c < 8 ? ga[c & 7] : gb[c & 7])); const float y = o[c] * rs * silu_f(g);
              if (dir == 0) yo[c] = y; else yo[c] += y; }
          if (dir == 1) { bf16* mr = F.MIX() + (size_t)(row0 + ei) * DM + 512 + h * 64 + ec;
              v4u w0, w1; w0.x = pk2(yo[0], yo[1]); w0.y = pk2(yo[2], yo[3]); w0.z = pk2(yo[4], yo[5]); w0.w = pk2(yo[6], yo[7]);
              w1.x = pk2(yo[8], yo[9]); w1.y = pk2(yo[10], yo[11]); w1.z = pk2(yo[12], yo[13]); w1.w = pk2(yo[14], yo[15]);
              *(v4u*)mr = w0; *(v4u*)(mr + 8) = w1; } }
        __syncthreads();
    }
}

__device__ __forceinline__ void unit_sg(const Frame& F, int L, int b, int g, int cc) {
    const int tid = F.tid, lane = F.lane, wave = F.wave, r32 = lane & 31, hi = lane >> 5;
    LAS bf16* W_s = (LAS bf16*)F.lds;
    LAS bf16* vT = W_s + 128 * LDP;
    const int row0 = chunk_row0(b, cc);
    const bf16* Wg = F.SGW() + (size_t)(L * 4 + g) * 128 * 128;
#pragma unroll
    for (int q = 0; q < 4; ++q) { const int idx = tid + NTHR * q, i = idx >> 4, c8 = (idx & 15) * 8; *(LAS bf16x8*)(W_s + i * LDP + c8) = *(const bf16x8*)(Wg + i * 128 + c8); }
    { const int j = tid >> 2, qd = tid & 3;
      const bf16* zr = F.Z() + (size_t)(row0 + j) * INC + ZSV + 64 * qd;
      float gv[64]; float sum = 0.f;
#pragma unroll
      for (int c = 0; c < 8; ++c) { const bf16x8 raw = *(const bf16x8*)(zr + 8 * c);
#pragma unroll
          for (int i = 0; i < 8; ++i) { const float t = gelu_t(bf2f((bf16)raw[i])); gv[8 * c + i] = t; sum += t; } }
      sum += __shfl_xor(sum, 1); sum += __shfl_xor(sum, 2);
      const float mu = sum * (1.f / 256.f); float s2 = 0.f;
#pragma unroll
      for (int c = 0; c < 64; ++c) { gv[c] -= mu; s2 += gv[c] * gv[c]; }
      s2 += __shfl_xor(s2, 1); s2 += __shfl_xor(s2, 2);
      const float rs = rsqrtf(s2 * (1.f / 256.f) + EPS);
      if (qd == g) { const float* gn = F.sgng() + L * 256 + g * 64;
#pragma unroll
          for (int c = 0; c < 64; ++c) vT[c * LDP + j] = (bf16)f2bf(gv[c] * rs * gn[c]); } }
    __syncthreads();
    LAS float* O_s = (LAS float*)W_s;
    { const int ti = wave >> 1, tj = wave & 1;
      f32x16 acc = {};
      acc = mma_nt(W_s + ti * 32 * LDP, LDP, vT + tj * 32 * LDP, LDP, 128, acc, lane);
      __syncthreads();
#pragma unroll
      for (int x = 0; x < 16; ++x) O_s[(ti * 32 + crow(x, hi)) * 66 + tj * 32 + r32] = acc[x]; }
    __syncthreads();
    { const int i = tid >> 2, ec = (tid & 3) * 16;
      const bf16* zu = F.Z() + (size_t)(row0 + i) * INC + ZSU + g * 64 + ec;
      const bf16x8 u0 = *(const bf16x8*)zu, u1 = *(const bf16x8*)(zu + 8);
      const float bi = F.sgb()[(L * 4 + g) * 128 + i];
      float o[16];
#pragma unroll
      for (int c = 0; c < 16; ++c) o[c] = gelu_t(bf2f((bf16)(c < 8 ? u0[c & 7] : u1[c & 7]))) * (O_s[i * 66 + ec + c] + bi);
      bf16* mr = F.MIX() + (size_t)(row0 + i) * DM + 768 + g * 64 + ec;
      v4u w0, w1; w0.x = pk2(o[0], o[1]); w0.y = pk2(o[2], o[3]); w0.z = pk2(o[4], o[5]); w0.w = pk2(o[6], o[7]);
      w1.x = pk2(o[8], o[9]); w1.y = pk2(o[10], o[11]); w1.z = pk2(o[12], o[13]); w1.w = pk2(o[14], o[15]);
      *(v4u*)mr = w0; *(v4u*)(mr + 8) = w1; }
    __syncthreads();
}

__device__ __forceinline__ void unit_out_ctx(const Frame& F, int L, int mu) {
    int tid = F.tid; asm volatile("" : "+v"(tid));
    const int lane = tid & 63, wave = F.wave, r32 = lane & 31, hi = lane >> 5;
    const int rb = mu >> 5, cb = mu & 31, k0 = wave * 128 + 8 * hi;
    LAS float* P = (LAS float*)F.lds;
    const bf16* A0 = F.MIX() + (size_t)(NLAT + rb * 64 + r32) * DM + k0;
    const bf16* B0 = F.WOUT() + (size_t)L * DM * DM + (size_t)(cb * 32 + r32) * DM + k0;
    bf16x8 a0[8], a1[8], bb[8];
#pragma unroll
    for (int s = 0; s < 8; ++s) { a0[s] = *(const bf16x8*)(A0 + 16 * s); a1[s] = *(const bf16x8*)(A0 + 32 * DM + 16 * s); bb[s] = *(const bf16x8*)(B0 + 16 * s); }
    f32x16 c0 = {}, c1 = {};
#pragma unroll
    for (int s = 0; s < 8; ++s) { c0 = __builtin_amdgcn_mfma_f32_32x32x16_bf16(a0[s], bb[s], c0, 0, 0, 0); c1 = __builtin_amdgcn_mfma_f32_32x32x16_bf16(a1[s], bb[s], c1, 0, 0, 0); }
#pragma unroll
    for (int x = 0; x < 16; ++x) { P[((wave * 2 + 0) * 16 + x) * 64 + lane] = c0[x]; P[((wave * 2 + 1) * 16 + x) * 64 + lane] = c1[x]; }
    __syncthreads();
    const float* g1 = F.MOD() + (size_t)(L * 3 + 2) * 6144 + 2048 + cb * 32;
#pragma unroll
    for (int q = 0; q < 4; ++q) {
        const int idx = tid + NTHR * q, ln = idx & 63, x = (idx >> 6) & 15, t = idx >> 10;
        float s = 0.f;
#pragma unroll
        for (int w = 0; w < 8; ++w) s += P[((w * 2 + t) * 16 + x) * 64 + ln];
        const int row = 32 * t + crow(x, ln >> 5), col = ln & 31;
        const size_t xo = (size_t)(rb * 64 + row) * DM + cb * 32 + col;
        F.X()[(size_t)NLAT * DM + xo] = (bf16)f2bf((L == 0 ? F.ctx_in()[xo] : bf2f(F.X()[(size_t)NLAT * DM + xo])) + g1[col] * s);
    }
    __syncthreads();
}

namespace att {
constexpr int KVBLK = 64;
constexpr float SCALE = 0.125f, THR = 8.f;
constexpr int LDQ = 512, LDK = 512, LDV = 512;
constexpr int SHM_V = KVBLK * 128 * 2, SHM_K = KVBLK * 64 * 2, SHM_ATTN = 2 * SHM_V + 2 * SHM_K + NWAVES * 64 * 4;
#define KSWZ(row, colB) ((row) * 128 + ((colB) ^ ((((row) >> 1) & 7) << 4)))
#define SBAR() __builtin_amdgcn_sched_barrier(0)
__device__ __forceinline__ unsigned cvtpk(float lo, float hi) { unsigned r; asm volatile("v_cvt_pk_bf16_f32 %0, %1, %2" : "=v"(r) : "v"(lo), "v"(hi)); return r; }
template <bool OFF> __device__ __forceinline__ void partialSM(f32x16& p0, f32x16& p1, float off) {
#pragma unroll
    for (int r = 0; r < 16; ++r) { if (OFF) { p0[r] += off; p1[r] += off; } p0[r] = __builtin_amdgcn_exp2f(p0[r]); }
}
__device__ __forceinline__ void finishSM(f32x16& p0, f32x16& p1, float& l_reg, bf16x8& pa0, bf16x8& pa1, bf16x8& pa2, bf16x8& pa3) {
#pragma unroll
    for (int r = 0; r < 16; ++r) p1[r] = __builtin_amdgcn_exp2f(p1[r]);
    float ps = 0;
#pragma unroll
    for (int r = 0; r < 16; ++r) ps += p0[r];
#pragma unroll
    for (int r = 0; r < 16; ++r) ps += p1[r];
    { auto rr = __builtin_amdgcn_permlane32_swap(__float_as_uint(ps), __float_as_uint(ps), false, false);
      ps = __uint_as_float(rr[0]) + __uint_as_float(rr[1]); }
    l_reg += ps;
#define PK4(P, BASE, OUT) do { unsigned a0 = cvtpk(P[BASE + 0], P[BASE + 1]), a1 = cvtpk(P[BASE + 2], P[BASE + 3]);   \
    unsigned b0 = cvtpk(P[BASE + 4], P[BASE + 5]), b1 = cvtpk(P[BASE + 6], P[BASE + 7]);                              \
    auto r0 = __builtin_amdgcn_permlane32_swap(a0, b0, false, false); auto r1 = __builtin_amdgcn_permlane32_swap(a1, b1, false, false); \
    v4u w = {r0[0], r1[0], r0[1], r1[1]}; OUT = __builtin_bit_cast(bf16x8, w); } while (0)
    PK4(p0, 0, pa0); PK4(p0, 8, pa1); PK4(p1, 0, pa2); PK4(p1, 8, pa3);
#undef PK4
}
template <bool OFF> __device__ __forceinline__ void kload(bf16x8 (&kf)[8], const LAS char* Ks, int r32, int hi) {
    if (OFF) return;
#pragma unroll
    for (int d0 = 0; d0 < 4; ++d0) { const int cb = (d0 * 16 + hi * 8) * 2;
        kf[2 * d0] = *(const LAS bf16x8*)(Ks + KSWZ(r32, cb)); kf[2 * d0 + 1] = *(const LAS bf16x8*)(Ks + KSWZ(32 + r32, cb)); }
}
template <bool OFF> __device__ __forceinline__ void qkmma(f32x16& p0, f32x16& p1, const bf16x8 (&kf)[8], const bf16x8* qr, const LAS char* Ks, int r32, int hi) {
    p0 = f32x16{}; p1 = f32x16{};
#pragma unroll
    for (int d0 = 0; d0 < 4; ++d0) {
        if (OFF) { const int cb = (d0 * 16 + hi * 8) * 2;
            const bf16x8 b0 = *(const LAS bf16x8*)(Ks + KSWZ(r32, cb)), b1 = *(const LAS bf16x8*)(Ks + KSWZ(32 + r32, cb));
            p0 = __builtin_amdgcn_mfma_f32_32x32x16_bf16(b0, qr[d0], p0, 0, 0, 0); p1 = __builtin_amdgcn_mfma_f32_32x32x16_bf16(b1, qr[d0], p1, 0, 0, 0); }
        else { p0 = __builtin_amdgcn_mfma_f32_32x32x16_bf16(kf[2 * d0], qr[d0], p0, 0, 0, 0); p1 = __builtin_amdgcn_mfma_f32_32x32x16_bf16(kf[2 * d0 + 1], qr[d0], p1, 0, 0, 0); } }
}
__device__ __forceinline__ int v_st(int k, int c) { const int kk = (k & ~0xC) | ((k & 4) << 1) | ((k & 8) >> 1); return ((kk >> 3) * 4 + (c >> 5)) * 512 + ((kk & 7) * 32 + (c & 31)) * 2; }
__device__ __forceinline__ int v_rd_base(int lane) { return ((lane & 3) << 3) | (((lane >> 2) & 3) << 6) | (((lane >> 4) & 1) << 5) | (((lane >> 5) & 1) << 8); }
constexpr int v_rd_off(int d0, int ks, int half) { return d0 * 512 + ks * 4096 + half * 2048; }
template <int OFF> __device__ __forceinline__ s16x4 tr_read(int vb) {
    s16x4 r; asm volatile("ds_read_b64_tr_b16 %0, %1 offset:%2" : "=&v"(r) : "v"(vb), "i"(OFF) : "memory"); return r;
}
template <int D0> __device__ __forceinline__ void pv_one(f32x16& od, int vb, bf16x8 pa0, bf16x8 pa1, bf16x8 pa2, bf16x8 pa3) {
    const s16x4 l0 = tr_read<v_rd_off(D0, 0, 0)>(vb), h0 = tr_read<v_rd_off(D0, 0, 1)>(vb), l1 = tr_read<v_rd_off(D0, 1, 0)>(vb), h1 = tr_read<v_rd_off(D0, 1, 1)>(vb);
    const s16x4 l2 = tr_read<v_rd_off(D0, 2, 0)>(vb), h2 = tr_read<v_rd_off(D0, 2, 1)>(vb), l3 = tr_read<v_rd_off(D0, 3, 0)>(vb), h3 = tr_read<v_rd_off(D0, 3, 1)>(vb);
    asm volatile("s_waitcnt lgkmcnt(0)" ::: "memory"); SBAR();
#define PK(Lo, Hi) (bf16x8){Lo[0], Lo[1], Lo[2], Lo[3], Hi[0], Hi[1], Hi[2], Hi[3]}
    od = __builtin_amdgcn_mfma_f32_32x32x16_bf16(pa0, PK(l0, h0), od, 0, 0, 0);
    od = __builtin_amdgcn_mfma_f32_32x32x16_bf16(pa1, PK(l1, h1), od, 0, 0, 0);
    od = __builtin_amdgcn_mfma_f32_32x32x16_bf16(pa2, PK(l2, h2), od, 0, 0, 0);
    od = __builtin_amdgcn_mfma_f32_32x32x16_bf16(pa3, PK(l3, h3), od, 0, 0, 0);
#undef PK
}
__device__ __forceinline__ void pv_d0(f32x16* o, int vb, bf16x8 pa0, bf16x8 pa1, bf16x8 pa2, bf16x8 pa3) {
    pv_one<0>(o[0], vb, pa0, pa1, pa2, pa3); pv_one<1>(o[1], vb, pa0, pa1, pa2, pa3); pv_one<2>(o[2], vb, pa0, pa1, pa2, pa3); pv_one<3>(o[3], vb, pa0, pa1, pa2, pa3);
}
template <bool OFF> __device__ __forceinline__ void body(const bf16* __restrict__ Qb, const bf16* __restrict__ Kh, const bf16* __restrict__ Vh, int seq, float mfix, LAS char* lds, f32x16 (&o)[4]) {
    int tid = threadIdx.x; asm volatile("" : "+v"(tid));
    const int wid = __builtin_amdgcn_readfirstlane(tid >> 6), lane = tid & 63, r32 = lane & 31, hi = lane >> 5;
    LAS char* V_lds = lds; LAS char* K_lds = lds + 2 * SHM_V;
    LAS float* ws = (LAS float*)(lds + 2 * SHM_V + 2 * SHM_K) + wid * 64; LAS float* li_l = ws; LAS float* al_l = ws + 32;
    float l_reg = 0;
    const float soff = -mfix * (SCALE * 1.4426950408889634f);
#pragma unroll
    for (int d = 0; d < 4; ++d) o[d] = f32x16{};
    bf16x8 qr[4];
    const bf16* Qw = Qb + (long)(wid * 32 + r32) * LDQ + hi * 8;
#pragma unroll
    for (int d0 = 0; d0 < 4; ++d0) qr[d0] = *(const bf16x8*)(Qw + d0 * 16);
    const int sr = tid >> 4, sc = (tid & 15) * 8, vst0 = v_st(sr, sc), vst1 = v_st(32 + sr, sc);
    const int kr = tid >> 3, kc = (tid & 7) * 8, kst = KSWZ(kr, kc * 2);
    const int vb0 = (int)(uintptr_t)V_lds + v_rd_base(lane);
    struct { bf16x8 vs0, vs1, ks0; } sr_[2];
#define SLOAD(i, k0) do { sr_[i].vs0 = *(const bf16x8*)(&Vh[(long)((k0) + sr) * LDV + sc]); sr_[i].vs1 = *(const bf16x8*)(&Vh[(long)((k0) + 32 + sr) * LDV + sc]); \
    sr_[i].ks0 = *(const bf16x8*)(&Kh[(long)((k0) + kr) * LDK + kc]); } while (0)
#define SWRITE(b, i) do { *(LAS bf16x8*)(V_lds + (b) * SHM_V + vst0) = sr_[i].vs0; *(LAS bf16x8*)(V_lds + (b) * SHM_V + vst1) = sr_[i].vs1; \
    *(LAS bf16x8*)(K_lds + (b) * SHM_K + kst) = sr_[i].ks0; } while (0)
#define SWAIT() asm volatile("s_waitcnt vmcnt(3)" ::: "memory")
    f32x16 pA0, pA1, pB0, pB1; bf16x8 pa0, pa1, pa2, pa3; const int NT = seq / KVBLK;
    constexpr int SE = 0, SO = 1;
    SLOAD(SE, 0); asm volatile("s_waitcnt vmcnt(0)" ::: "memory"); SWRITE(0, SE); __syncthreads();
    bf16x8 kf[8];
    kload<OFF>(kf, K_lds, r32, hi); qkmma<OFF>(pA0, pA1, kf, qr, K_lds, r32, hi); partialSM<OFF>(pA0, pA1, soff);
    SLOAD(SO, KVBLK); if (2 < NT) SLOAD(SE, 2 * KVBLK);
    SWAIT(); SWRITE(1, SO); __syncthreads();
    for (int j = 1; j + 1 < NT; j += 2) {
        SBAR(); kload<OFF>(kf, K_lds + SHM_K, r32, hi); SBAR();
        qkmma<OFF>(pB0, pB1, kf, qr, K_lds + SHM_K, r32, hi); finishSM(pA0, pA1, l_reg, pa0, pa1, pa2, pa3); SBAR();
        SLOAD(SO, (j + 2) * KVBLK); SBAR();
        pv_d0(o, vb0, pa0, pa1, pa2, pa3); partialSM<OFF>(pB0, pB1, soff);
        __syncthreads(); SWAIT(); SWRITE(0, SE);
        __syncthreads();
        SBAR(); kload<OFF>(kf, K_lds, r32, hi); SBAR();
        qkmma<OFF>(pA0, pA1, kf, qr, K_lds, r32, hi); finishSM(pB0, pB1, l_reg, pa0, pa1, pa2, pa3); SBAR();
        if (j + 3 < NT) SLOAD(SE, (j + 3) * KVBLK); SBAR();
        pv_d0(o, vb0 + (int)SHM_V, pa0, pa1, pa2, pa3); partialSM<OFF>(pA0, pA1, soff);
        __syncthreads(); SWAIT(); SWRITE(1, SO);
        __syncthreads();
    }
    SBAR(); kload<OFF>(kf, K_lds + SHM_K, r32, hi); SBAR();
    qkmma<OFF>(pB0, pB1, kf, qr, K_lds + SHM_K, r32, hi); finishSM(pA0, pA1, l_reg, pa0, pa1, pa2, pa3); SBAR();
    pv_d0(o, vb0, pa0, pa1, pa2, pa3); partialSM<OFF>(pB0, pB1, soff);
    __syncthreads();
    finishSM(pB0, pB1, l_reg, pa0, pa1, pa2, pa3); SBAR();
    pv_d0(o, vb0 + (int)SHM_V, pa0, pa1, pa2, pa3);
    if (hi == 0) li_l[r32] = l_reg; asm volatile("s_waitcnt lgkmcnt(0)" ::: "memory");
#pragma unroll
    for (int r = 0; r < 16; ++r) { const float rl = __builtin_amdgcn_rcpf(li_l[crow(r, hi)]);
#pragma unroll
        for (int d0 = 0; d0 < 4; ++d0) o[d0][r] *= rl; }
    __syncthreads();
#undef SLOAD
#undef SWRITE
#undef SWAIT
}

constexpr int SLK = 8192, SLV = 16384, L_K = 0, L_V = 3 * SLK, L_WS = L_V + 3 * SLV;
typedef const LAS char* lds_cptr;
typedef short v4i16_t __attribute__((ext_vector_type(4)));
#define PIN(x) asm volatile("" : "+v"(x))
#define MFMA32(a, b, c) __builtin_amdgcn_mfma_f32_32x32x16_bf16(a, b, c, 0, 0, 0)
#define WAIT_BAR(N) asm volatile("s_waitcnt vmcnt(" #N ") lgkmcnt(0)\n\ts_barrier" ::: "memory")
__device__ __forceinline__ unsigned cvtpk2(float lo, float hi) { unsigned r; asm("v_cvt_pk_bf16_f32 %0, %1, %2" : "=v"(r) : "v"(lo), "v"(hi)); return r; }
__device__ __forceinline__ void glds16(const void* g, unsigned lds_base) {
    unsigned sv; asm volatile("s_mov_b32 %0, m0\n\ts_mov_b32 m0, %2\n\ts_nop 0\n\tglobal_load_lds_dwordx4 %1, off\n\ts_mov_b32 m0, %0" : "=&s"(sv) : "v"(g), "s"(lds_base) : "memory"); }
__device__ __forceinline__ void kload2(bf16x8* kf, lds_cptr kp, int d0) { kf[2 * d0] = *(const LAS bf16x8*)(kp + d0 * 2048); kf[2 * d0 + 1] = *(const LAS bf16x8*)(kp + d0 * 2048 + 512); }
__device__ __forceinline__ s16x4 vtr(lds_cptr p) { return __builtin_bit_cast(s16x4, __builtin_amdgcn_ds_read_tr16_b64_v4i16((LAS v4i16_t*)p)); }
__device__ __forceinline__ void body_fast(const bf16* __restrict__ Qb, const bf16* __restrict__ Kh, const bf16* __restrict__ Vh, int seq, LAS char* lds, f32x16 (&o)[4]) {
    int tid = threadIdx.x; asm volatile("" : "+v"(tid));
    const int wid = __builtin_amdgcn_readfirstlane(tid >> 6), lane = tid & 63, r32 = lane & 31, hi = lane >> 5;
    const int NT = seq / KVBLK;
    const unsigned lds0 = (unsigned)(uintptr_t)lds; LAS float* wsf = (LAS float*)(lds + L_WS) + wid * 64;
    const bool dma = wid < 4;
    const int w4 = wid & 3, kr0 = 8 * w4 + (lane >> 3);
    const unsigned kvo0 = (unsigned)(kr0 * (LDK * 2) + (((lane & 7) ^ ((kr0 >> 1) & 7)) * 16)), kvo1 = kvo0 + 32 * (LDK * 2);
    const unsigned vvo0 = (unsigned)((4 * w4 + ((lane >> 2) & 3)) * (LDV * 2) + (lane >> 4) * 64 + (lane & 3) * 16), vvo1 = vvo0 + 16 * (LDV * 2), vvo2 = vvo0 + 32 * (LDV * 2), vvo3 = vvo0 + 48 * (LDV * 2);
    const unsigned kdst = lds0 + L_K + w4 * 1024, vdst = lds0 + L_V + w4 * 1024;
#define DMA_K(t, slot) do { if (dma) { unsigned sv_; asm volatile("s_mov_b32 %0, m0\n\ts_mov_b32 m0, %4\n\ts_nop 0\n\tglobal_load_lds_dwordx4 %1, %3\n\ts_add_u32 m0, m0, 0x1000\n\ts_nop 0\n\t" \
        "global_load_lds_dwordx4 %2, %3\n\ts_mov_b32 m0, %0" : "=&s"(sv_) : "v"(kvo0), "v"(kvo1), "s"((const char*)Kh + (size_t)(t) * (KVBLK * LDK * 2)), "s"(kdst + (slot)) : "memory", "scc"); } } while (0)
#define DMA_V(t, slot) do { if (dma) { unsigned sv_; asm volatile("s_mov_b32 %0, m0\n\ts_mov_b32 m0, %6\n\ts_nop 0\n\tglobal_load_lds_dwordx4 %1, %5\n\ts_add_u32 m0, m0, 0x1000\n\ts_nop 0\n\t" \
        "global_load_lds_dwordx4 %2, %5\n\ts_add_u32 m0, m0, 0x1000\n\ts_nop 0\n\tglobal_load_lds_dwordx4 %3, %5\n\ts_add_u32 m0, m0, 0x1000\n\ts_nop 0\n\t" \
        "global_load_lds_dwordx4 %4, %5\n\ts_mov_b32 m0, %0" : "=&s"(sv_) : "v"(vvo0), "v"(vvo1), "v"(vvo2), "v"(vvo3), "s"((const char*)Vh + (size_t)(t) * (KVBLK * LDV * 2)), "s"(vdst + 2 * (slot)) : "memory", "scc"); } } while (0)
    const lds_cptr vp0 = (lds_cptr)lds + L_V + hi * 1024 + ((lane & 15) >> 2) * 64 + ((lane >> 4) & 1) * 32 + (lane & 3) * 8;
    const lds_cptr kp0 = (lds_cptr)lds + L_K + r32 * 128;
    const int kx = (r32 >> 1) & 7;
    const lds_cptr ka0 = kp0 + (((0 + hi) ^ kx) * 16), ka1 = kp0 + (((2 + hi) ^ kx) * 16), ka2 = kp0 + (((4 + hi) ^ kx) * 16), ka3 = kp0 + (((6 + hi) ^ kx) * 16);
#define KL2(d0, off) do { kf[2 * (d0)] = *(const LAS bf16x8*)(ka##d0 + (off)); kf[2 * (d0) + 1] = *(const LAS bf16x8*)(ka##d0 + (off) + 4096); } while (0)
    DMA_K(0, 0); DMA_V(0, 0); DMA_K(1, SLK);
    bf16x8 qr[4];
    const bf16* Qw = Qb + (long)(wid * 32 + r32) * LDQ + hi * 8;
#pragma unroll
    for (int d0 = 0; d0 < 4; ++d0) qr[d0] = *(const bf16x8*)(Qw + d0 * 16);
    float l_reg = 0.f;
#pragma unroll
    for (int d = 0; d < 4; ++d) o[d] = f32x16{};
    f32x16 pA0, pA1, pB0, pB1; bf16x8 kf[8]; s16x4 vlo[8], vhi[8]; v4u pw0, pw1, pw2, pw3;
    int sl_prev = 0, sl_cur = 0, sl_next = SLK;
#define ROT() do { sl_prev = sl_cur; sl_cur = sl_next; sl_next = (sl_next == 2 * SLK) ? 0 : sl_next + SLK; } while (0)
#define EX(v) __builtin_amdgcn_exp2f(v)
    DMA_K(2, 2 * SLK);
    WAIT_BAR(4);
    KL2(0, 0); KL2(1, 0); KL2(2, 0); KL2(3, 0);
    pA0 = MFMA32(kf[0], qr[0], f32x16{}); pA1 = MFMA32(kf[1], qr[0], f32x16{}); pA0 = MFMA32(kf[2], qr[1], pA0); pA1 = MFMA32(kf[3], qr[1], pA1);
    pA0 = MFMA32(kf[4], qr[2], pA0); pA1 = MFMA32(kf[5], qr[2], pA1); pA0 = MFMA32(kf[6], qr[3], pA0); pA1 = MFMA32(kf[7], qr[3], pA1);
#pragma unroll
    for (int r = 0; r < 16; ++r) { pA0[r] = EX(pA0[r]); pA1[r] = EX(pA1[r]); }
    WAIT_BAR(0);
    DMA_K(3, 0); DMA_V(1, SLK); ROT();
    KL2(0, sl_cur); KL2(1, sl_cur); KL2(2, sl_cur); KL2(3, sl_cur);
    WAIT_BAR(6);
#define PKW(P, i) cvtpk2(P[i], P[i + 1])
#define PAF(k) __builtin_bit_cast(bf16x8, pw##k)
#define VFR(i) (bf16x8){vlo[i][0], vlo[i][1], vlo[i][2], vlo[i][3], vhi[i][0], vhi[i][1], vhi[i][2], vhi[i][3]}
#define VRD(s, fi) do { vlo[s] = vtr(vp_ + (((fi) >> 2) * 256 + ((fi) & 3) * 4096)); vhi[s] = vtr(vp_ + (((fi) >> 2) * 256 + ((fi) & 3) * 4096 + 2048)); } while (0)
#define KRD(G, d0) do { if (G) { KL2(d0, sl_next); SBAR(); } } while (0)
#define GAPA(MF, a0, a1, a2, a3, W0, W1, PW) do { MF; sacc += a0; sacc2 += a1; sacc += a2; sacc2 += a3; W0; W1; PIN(PW); PIN(sacc); PIN(sacc2); SBAR(); } while (0)
#define GAPB(MF, X, i) do { MF; X[i] = EX(X[i]); X[i + 1] = EX(X[i + 1]); PIN(X); SBAR(); } while (0)
#define STEP(C0, C1, P0, P1, t, GK, GV, GL) do { SBAR(); \
    const lds_cptr vp_ = vp0 + 2 * sl_prev; \
    VRD(0, 0); SBAR(); float sacc = P0[0], sacc2 = P0[1]; \
                       GAPA(C0 = MFMA32(kf[0], qr[0], f32x16{}), P0[2], P0[3], P0[4], P0[5],     pw0[0] = PKW(P0, 0),  pw0[1] = PKW(P0, 2),  pw0); \
    VRD(4, 4); SBAR(); GAPA(C1 = MFMA32(kf[1], qr[0], f32x16{}), P0[6], P0[7], P0[8], P0[9],     pw0[2] = PKW(P0, 4),  pw0[3] = PKW(P0, 6),  pw0); \
    VRD(1, 1); SBAR(); GAPA(C0 = MFMA32(kf[2], qr[1], C0),       P0[10], P0[11], P0[12], P0[13], pw1[0] = PKW(P0, 8),  pw1[1] = PKW(P0, 10), pw1); \
    VRD(5, 5); SBAR(); GAPA(C1 = MFMA32(kf[3], qr[1], C1),       P0[14], P0[15], P1[0], P1[1],   pw1[2] = PKW(P0, 12), pw1[3] = PKW(P0, 14), pw1); \
    VRD(2, 2); SBAR(); GAPA(C0 = MFMA32(kf[4], qr[2], C0),       P1[2], P1[3], P1[4], P1[5],     pw2[0] = PKW(P1, 0),  pw2[1] = PKW(P1, 2),  pw2); \
    VRD(6, 6); SBAR(); GAPA(C1 = MFMA32(kf[5], qr[2], C1),       P1[6], P1[7], P1[8], P1[9],     pw2[2] = PKW(P1, 4),  pw2[3] = PKW(P1, 6),  pw2); \
    VRD(3, 3); SBAR(); GAPA(C0 = MFMA32(kf[6], qr[3], C0),       P1[10], P1[11], P1[12], P1[13], pw3[0] = PKW(P1, 8),  pw3[1] = PKW(P1, 10), pw3); \
    VRD(7, 7); SBAR(); GAPA(C1 = MFMA32(kf[7], qr[3], C1),       P1[14], P1[15], 0.f, 0.f,       pw3[2] = PKW(P1, 12), pw3[3] = PKW(P1, 14), pw3); \
    l_reg += sacc + sacc2; SBAR(); \
    GAPB(o[0] = MFMA32(PAF(0), VFR(0), o[0]), C0, 0);  VRD(0, 8);  SBAR(); \
    GAPB(o[1] = MFMA32(PAF(0), VFR(4), o[1]), C0, 2);  VRD(4, 12); SBAR(); \
    GAPB(o[0] = MFMA32(PAF(1), VFR(1), o[0]), C0, 4);  VRD(1, 9);  SBAR(); \
    GAPB(o[1] = MFMA32(PAF(1), VFR(5), o[1]), C0, 6);  VRD(5, 13); SBAR(); \
    GAPB(o[0] = MFMA32(PAF(2), VFR(2), o[0]), C0, 8);  VRD(2, 10); SBAR(); \
    GAPB(o[1] = MFMA32(PAF(2), VFR(6), o[1]), C0, 10); VRD(6, 14); SBAR(); \
    GAPB(o[0] = MFMA32(PAF(3), VFR(3), o[0]), C0, 12); VRD(3, 11); SBAR(); \
    GAPB(o[1] = MFMA32(PAF(3), VFR(7), o[1]), C0, 14); VRD(7, 15); SBAR(); \
    KRD(GL, 0); GAPB(o[2] = MFMA32(PAF(0), VFR(0), o[2]), C1, 0); \
    KRD(GL, 1); GAPB(o[3] = MFMA32(PAF(0), VFR(4), o[3]), C1, 2); \
    KRD(GL, 2); GAPB(o[2] = MFMA32(PAF(1), VFR(1), o[2]), C1, 4); \
    KRD(GL, 3); GAPB(o[3] = MFMA32(PAF(1), VFR(5), o[3]), C1, 6); \
    GAPB(o[2] = MFMA32(PAF(2), VFR(2), o[2]), C1, 8);  if (dma) { if (GK) DMA_K((t) + 3, sl_cur); if (GV) DMA_V((t) + 1, sl_next); } SBAR(); \
    GAPB(o[3] = MFMA32(PAF(2), VFR(6), o[3]), C1, 10); \
    GAPB(o[2] = MFMA32(PAF(3), VFR(3), o[2]), C1, 12); \
    GAPB(o[3] = MFMA32(PAF(3), VFR(7), o[3]), C1, 14); \
    } while (0)
    int t = 1;
    for (; t + 5 < NT; t += 2) {
        STEP(pB0, pB1, pA0, pA1, t, true, true, true);     WAIT_BAR(6); ROT();
        STEP(pA0, pA1, pB0, pB1, t + 1, true, true, true); WAIT_BAR(6); ROT();
    }
#define ENDW(tt) do { if ((tt) + 3 < NT) { WAIT_BAR(6); } else if ((tt) + 2 < NT) { WAIT_BAR(4); } else { WAIT_BAR(0); } } while (0)
    for (; t + 1 < NT; t += 2) {
        STEP(pB0, pB1, pA0, pA1, t, (t + 3 < NT), (t + 1 < NT), (t + 1 < NT));         ENDW(t);     ROT();
        STEP(pA0, pA1, pB0, pB1, t + 1, (t + 4 < NT), (t + 2 < NT), (t + 2 < NT));     ENDW(t + 1); ROT();
    }
    STEP(pB0, pB1, pA0, pA1, NT - 1, false, false, false);
    { float sacc = pB0[0] + pB0[1];
#pragma unroll
      for (int r = 2; r < 16; ++r) sacc += pB0[r];
#pragma unroll
      for (int r = 0; r < 16; ++r) sacc += pB1[r];
      l_reg += sacc;
      pw0 = (v4u){PKW(pB0, 0), PKW(pB0, 2), PKW(pB0, 4), PKW(pB0, 6)}; pw1 = (v4u){PKW(pB0, 8), PKW(pB0, 10), PKW(pB0, 12), PKW(pB0, 14)};
      pw2 = (v4u){PKW(pB1, 0), PKW(pB1, 2), PKW(pB1, 4), PKW(pB1, 6)}; pw3 = (v4u){PKW(pB1, 8), PKW(pB1, 10), PKW(pB1, 12), PKW(pB1, 14)};
      const lds_cptr vp_ = vp0 + 2 * sl_cur;
      _Pragma("unroll") for (int i = 0; i < 8; ++i) VRD(i, i);
      o[0] = MFMA32(PAF(0), VFR(0), o[0]); o[1] = MFMA32(PAF(0), VFR(4), o[1]); o[0] = MFMA32(PAF(1), VFR(1), o[0]); o[1] = MFMA32(PAF(1), VFR(5), o[1]);
      o[0] = MFMA32(PAF(2), VFR(2), o[0]); o[1] = MFMA32(PAF(2), VFR(6), o[1]); o[0] = MFMA32(PAF(3), VFR(3), o[0]); o[1] = MFMA32(PAF(3), VFR(7), o[1]);
      SBAR();
      _Pragma("unroll") for (int i = 0; i < 8; ++i) VRD(i, 8 + i);
      o[2] = MFMA32(PAF(0), VFR(0), o[2]); o[3] = MFMA32(PAF(0), VFR(4), o[3]); o[2] = MFMA32(PAF(1), VFR(1), o[2]); o[3] = MFMA32(PAF(1), VFR(5), o[3]);
      o[2] = MFMA32(PAF(2), VFR(2), o[2]); o[3] = MFMA32(PAF(2), VFR(6), o[3]); o[2] = MFMA32(PAF(3), VFR(3), o[2]); o[3] = MFMA32(PAF(3), VFR(7), o[3]); }
    { auto rr = __builtin_amdgcn_permlane32_swap(__float_as_uint(l_reg), __float_as_uint(l_reg), false, false); l_reg = __uint_as_float(rr[0]) + __uint_as_float(rr[1]); }
    if (hi == 0) wsf[32 + r32] = l_reg; asm volatile("s_waitcnt lgkmcnt(0)" ::: "memory");
#pragma unroll
    for (int r = 0; r < 16; ++r) { const float rl = __builtin_amdgcn_rcpf(wsf[32 + crow(r, hi)]);
#pragma unroll
        for (int d0 = 0; d0 < 4; ++d0) o[d0][r] *= rl; }
    asm volatile("s_waitcnt lgkmcnt(0)\n\ts_barrier" ::: "memory");
#undef DMA_K
#undef DMA_V
#undef ROT
#undef EX
#undef PKW
#undef PAF
#undef VFR
#undef VRD
#undef KRD
#undef KL2
#undef ENDW
#undef GAPA
#undef GAPB
#undef STEP
}
}

__device__ __forceinline__ void unit_attn(const Frame& F, int L, int b, int h, int qrow0  , int seq) {
    f32x16 o[4];
    for (int m = 0; m < 2; ++m) {
        const float mfix = F.LP()[L * 16 + 10];
        if (__builtin_expect(mfix * (att::SCALE * 1.4426950408889634f) > 64.f, 0))
            att::body<true>(F.QH() + (size_t)qrow0 * 512 + (h * 2 + m) * 64, F.KH() + (size_t)b * NKEY * 512 + (h * 2 + m) * 64, F.VH() + (size_t)b * NKEY * 512 + h * 128, seq, mfix, (LAS char*)F.lds, o);
        else
            att::body_fast(F.QH() + (size_t)qrow0 * 512 + (h * 2 + m) * 64, F.KH() + (size_t)b * NKEY * 512 + (h * 2 + m) * 64, F.VH() + (size_t)b * NKEY * 512 + h * 128, seq, (LAS char*)F.lds, o);
        if (m == 0) {
            int tid = F.tid; asm volatile("" : "+v"(tid));
            const int lane = tid & 63, wave = __builtin_amdgcn_readfirstlane(tid >> 6), r32 = lane & 31, hi = lane >> 5;
            float* scr = F.SCR() + (size_t)F.bid * 256 * 128 + (size_t)(wave * 32) * 128;
#pragma unroll
            for (int r = 0; r < 16; ++r)
#pragma unroll
                for (int d0 = 0; d0 < 4; ++d0) scr[crow(r, hi) * 128 + d0 * 32 + r32] = o[d0][r];
            asm volatile("s_waitcnt vmcnt(0)" ::: "memory");
        }
    }
    int tid = F.tid; asm volatile("" : "+v"(tid));
    const int lane = tid & 63, wave = __builtin_amdgcn_readfirstlane(tid >> 6), r32 = lane & 31, hi = lane >> 5;
    const float lam = F.LP()[L * 16 + 0], oscale = F.LP()[L * 16 + 1];
    const float* scr = F.SCR() + (size_t)F.bid * 256 * 128 + (size_t)(wave * 32) * 128;
    float sg[4];
#pragma unroll
    for (int d0 = 0; d0 < 4; ++d0) sg[d0] = F.subg()[L * 128 + d0 * 32 + r32] * oscale;
#pragma unroll
    for (int r = 0; r < 16; ++r) {
        float d[4]; float ss = 0.f;
#pragma unroll
        for (int d0 = 0; d0 < 4; ++d0) { d[d0] = scr[crow(r, hi) * 128 + d0 * 32 + r32] - lam * o[d0][r]; ss += d[d0] * d[d0]; }
        const float rs = rsqrtf(half_sum32(ss) * (1.f / 128.f) + EPS);
        bf16* mr = F.MIX() + (size_t)(qrow0 + wave * 32 + crow(r, hi)) * DM + h * 128;
#pragma unroll
        for (int d0 = 0; d0 < 4; ++d0) mr[d0 * 32 + r32] = (bf16)f2bf(d[d0] * rs * sg[d0]);
    }
}


constexpr int NPH_L = 12, NPHASE = 2 + DEPTH * NPH_L;
struct Args { const float* in[25]; float* out; unsigned char* ws; int gp_lo, gp_hi; };
__global__ void __launch_bounds__(NTHR, 2) fwd(Args args) {
    extern __shared__ __attribute__((aligned(16))) unsigned char lds[];
    Frame F;
    F.lds = (LAS unsigned char*)lds;
    F.tid = threadIdx.x; F.lane = F.tid & 63; F.wave = __builtin_amdgcn_readfirstlane(F.tid >> 6); F.bid = blockIdx.x; F.G = gridDim.x;
    F.in = args.in; F.out = args.out; F.ws = args.ws;
    unsigned char* ws = args.ws;
    volatile LAS unsigned* MISC = (volatile LAS unsigned*)(F.lds + MISC_OFF);
    for (int u = F.tid; u < (LDS_BYTES - RING_BYTES) / 4; u += NTHR) ((LAS unsigned*)(F.lds + RING_BYTES))[u] = 0u;
    __syncthreads();
#if MK_ONE_LAUNCH
    constexpr int lo = 0, hi = NPHASE;
#else
    const int lo = args.gp_lo, hi = args.gp_hi;
#endif
    unsigned* barw = (unsigned*)(ws + WS_CTL) + CW_BAR;
    XcdBarrier bar; bar.bar = barw; bar.x = 0; bar.st = nullptr;
    if (hi - lo > 1) bar = xcd_barrier_post(barw, MISC + 8);
#ifndef N_CV_N2
#define N_CV_N2 2
#endif
#ifndef N_CV_INP
#define N_CV_INP 1
#endif
#ifndef N_CV_OUT
#define N_CV_OUT 1
#endif
#ifndef N_CV_TOPK
#define N_CV_TOPK 1
#endif
#ifndef N_CV_DOWN
#define N_CV_DOWN 1
#endif
#ifndef PHM
#define PHM 0xFFFF
#endif
#define PB(i) (((PHM) >> (i)) & 1)
#ifndef DBLM
#define DBLM 0
#endif
#define REP(i) for (int rep_ = 0; rep_ < ((((DBLM) >> (i)) & 1) ? 2 : 1); ++rep_)
#define IN(k) (lo <= (k) && (k) < hi)
#ifndef BARX
#define BARX 1
#endif
#define SEAM(k) do { if (IN(k) && IN((k) + 1)) { for (int bx_ = 0; bx_ < BARX; ++bx_) xcd_barrier(bar); } } while (0)

    if (PB(0) && IN(0)) REP(0) ph_prologue(F);
    SEAM(0);
    if (PB(1) && IN(1)) REP(1) ph_norm1_first(F);
    SEAM(1);
    for (int L = 0; L < DEPTH; ++L) {
        const int base = 2 + NPH_L * L;
#define FRESH() do { F.tid = threadIdx.x; asm volatile("" : "+v"(F.tid)); F.lane = F.tid & 63; } while (0)
        if (PB(2) && IN(base + 0)) REP(2) {
            pg8::Gemm g{F.HN(), F.WIN() + (size_t)L * INC * DM, NROW, INC, DM}; pg8::StaticOrder S; S.init(NROW, INC, F.G, F.bid);
            EpiZ E{F.Z(), F.VH(), F.QH(), F.KH(), F.LP() + DEPTH * 16 + L * 128, F.ROPE()};
            pg8::gemm_phase<EpiZ, pg8::StaticOrder, true, true>(F.lds, g, S, E);
            if (F.bid >= (66 * 13) % 256) { FRESH(); conv_n(F, N_CV_INP); }
        }
        SEAM(base + 0);
        if (PB(3) && IN(base + 1)) REP(3) {
            FRESH();
            for (int u = F.bid; u < 1056; u += F.G) {
                const int v = u < 528 ? u : u - 528; const int b = v / 264, hh = (v / NCH) & 3, cc = v % NCH;
                if (u < 528) unit_retkv(F, L, b, hh, cc); else if (!(L == DEPTH - 1 && cc < 2)) unit_sg(F, L, b, hh, cc);
            }
        }
        SEAM(base + 1);
        if (PB(5) && IN(base + 3)) REP(5) { FRESH(); ph_scan(F, L); }
        SEAM(base + 3);
        if (PB(6) && IN(base + 4)) REP(6) {
            FRESH();
            for (int u = F.bid; u < 264 + 528; u += F.G) {
                if (u < 264) {
                    int b, hh, qrow0, seq;
                    if (u < 256) { const int bh = u & 7, qb = u >> 3; b = bh >> 2; hh = bh & 3; qrow0 = b * SEQ + qb * 256; seq = NKEY; }
                    else { if (L == DEPTH - 1) continue; const int v = u - 256; b = v >> 2; hh = v & 3; qrow0 = NLAT + b * CTXL; seq = CTXL; }
#ifndef NO_ATTN
                    unit_attn(F, L, b, hh, qrow0, seq);
#endif
                } else {
#ifndef NO_RETOUT
                    const int v = u - 264; if (!(L == DEPTH - 1 && (v % NCH) < 2)) unit_retout(F, L, v / 264, (v / NCH) & 3, v % NCH);
#endif
                }
            }
        }
        SEAM(base + 4);
        if (PB(7) && IN(base + 5)) REP(7) {
            pg8::Gemm g{F.MIX(), F.WOUT() + (size_t)L * DM * DM, NLAT, DM, DM}; pg8::StaticOrder S; S.init(NLAT, DM, F.G, F.bid);
#ifdef PROBE_OUT2
            { EpiResid E0{(bf16*)(F.ws + WS_Y), F.MOD() + (size_t)L * 3 * 6144 + 2048, L == 0 ? F.x_in() : nullptr}; pg8::gemm_phase<EpiResid, pg8::StaticOrder, true, true>(F.lds, g, S, E0); }
#endif
            EpiResid E{F.X(), F.MOD() + (size_t)L * 3 * 6144 + 2048, L == 0 ? F.x_in() : nullptr};
            pg8::gemm_phase<EpiResid, pg8::StaticOrder, true, true>(F.lds, g, S, E);
            if (L < DEPTH - 1) { FRESH(); for (int mu = F.bid; mu < 256; mu += F.G) unit_out_ctx(F, L, mu); }
        }
        SEAM(base + 5);
        if (PB(8) && IN(base + 6)) REP(8) { FRESH(); ph_norm2_router(F, L); if (F.bid >= (((L == DEPTH - 1) ? NLAT : NROW) / 16 + NWAVES - 1) / NWAVES) conv_n(F, N_CV_N2); }
        SEAM(base + 6);
        if (PB(9) && IN(base + 7)) REP(9) { FRESH(); ph_topk(F, L); if (F.bid >= ((L == DEPTH - 1) ? 32 : 64)) conv_n(F, N_CV_TOPK);
            conv_until(F, CONV_SEG0 + (unsigned)(L + 1) * CONV_PER_L); }
        SEAM(base + 7);
        if (PB(11) && IN(base + 9)) REP(11) {
            pg8::Gemm g{F.HN(), F.WGU() + (size_t)L * NE * 4096 * DM, NE * EROWS, NE * 4096, DM};        const int npm = (L == DEPTH - 1) ? 8 : 9; MoeOrder S{F.G, F.bid, 16, npm, NE * npm * 16};
            EpiSwiglu E{F.HH()};
            pg8::gemm_phase_ga<EpiSwiglu, MoeOrder>(F.lds, g, S, E, F.ROWIDX(), NROW, (LAS int*)(F.lds + ISLOT_OFF));
        }
        SEAM(base + 9);
        if (PB(12) && IN(base + 10)) REP(12) {
            pg8::Gemm g{F.HH(), F.WD() + (size_t)L * NE * DM * FF, NE * EROWS, NE * DM, FF}; const int npm = (L == DEPTH - 1) ? 8 : 9; MoeOrder S{F.G, F.bid, 4, npm, NE * npm * 4};
            pg8::EpiBf16<0> E{F.Y(), DM, nullptr, DM, 0, 1.f};
            pg8::gemm_phase<pg8::EpiBf16<0>, MoeOrder, true, true>(F.lds, g, S, E);
            if (L < DEPTH - 1 && F.bid >= 64) { FRESH(); conv_n(F, N_CV_DOWN); }
        }
        SEAM(base + 10);
        if (PB(13) && IN(base + 11)) REP(13) { FRESH(); ph_combine(F, L); }
        SEAM(base + 11);
    }
#undef IN
#undef SEAM
}

extern "C" void kernel_launch(void* const* d_in, const int* in_sizes, int n_in, void* d_out, int out_size, void* d_ws, size_t ws_size, hipStream_t stream) {
    static int grid = 0;
    if (grid == 0) {
        if (n_in != 25 || in_sizes[0] != NLAT * DM || out_size != NLAT * DM || ws_size < WS_END) {
            fprintf(stderr, "kernel_launch: built for 25 inputs, x/out of %d floats, >= %zu bytes of workspace; got n_in %d, in0 %d, out %d, ws %zu; nothing launched\n", NLAT * DM, (size_t)WS_END, n_in, n_in > 0 ? in_sizes[0] : -1, out_size, ws_size);
            grid = -1; return; }
        int dev = 0, cus = 0, per_cu = 0;
        if (hipGetDevice(&dev) != hipSuccess || hipDeviceGetAttribute(&cus, hipDeviceAttributeMultiprocessorCount, dev) != hipSuccess) { fprintf(stderr, "kernel_launch: device query failed\n"); grid = -1; return; }
        if (hipFuncSetAttribute((const void*)fwd, hipFuncAttributeMaxDynamicSharedMemorySize, LDS_BYTES) != hipSuccess) { fprintf(stderr, "kernel_launch: hipFuncSetAttribute failed\n"); grid = -1; return; }
        if (hipOccupancyMaxActiveBlocksPerMultiprocessor(&per_cu, (const void*)fwd, NTHR, LDS_BYTES) != hipSuccess || per_cu < 1)
            fprintf(stderr, "kernel_launch: note: occupancy query reports %d workgroups per CU\n", per_cu);
        (void)hipGetLastError();
        grid = cus;
    }
    if (grid < 0) return;
    if (hipMemsetAsync((char*)d_ws + WS_CTL, 0, CTL_ZERO_BYTES, stream) != hipSuccess) { fprintf(stderr, "kernel_launch: memset failed\n"); return; }
    Args a{};
    for (int i = 0; i < 25; ++i) a.in[i] = (const float*)d_in[i];
    a.out = (float*)d_out; a.ws = (unsigned char*)d_ws;
#if MK_ONE_LAUNCH
    a.gp_lo = 0; a.gp_hi = NPHASE;
    hipLaunchKernelGGL(fwd, dim3(grid), dim3(NTHR), LDS_BYTES, stream, a);
#else
    for (int gp = 0; gp < NPHASE; ++gp) { a.gp_lo = gp; a.gp_hi = gp + 1; hipLaunchKernelGGL(fwd, dim3(grid), dim3(NTHR), LDS_BYTES, stream, a); }
#endif
    const hipError_t le = hipPeekAtLastError();
    if (le != hipSuccess) fprintf(stderr, "kernel_launch: launch failed: %s\n", hipGetErrorName(le));
}
```
